# Optimizing an MI355X kernel written in HIP

```python
import math
import jax, jax.numpy as jnp
from jax import lax
import numpy as np

D_MODEL = 1024
BATCH = 8
SEQ = 8192
DEPTH = 2
DEC_BATCH = 16
DEC_SEQ = 2048
PAST_LEN = 128

GRID_W = 64
Q_BLOCK = 128
HEAD_DIM = 64
EPS = 1e-6

HY_WIDTH = 512
HY_ORDER = 2
SHORT_K = 3
FILT_EMB = 33
FILT_ORDER = 64
FILT_INNER = 2
HY_FAST_DECAY = 0.3
HY_SLOW_DECAY = 1.5
HY_TARGET = 1e-2
HY_SHIFT = 0.0

GQA_HEADS = 8
GQA_KV_HEADS = 2
ROPE_THETA = 10000.0

DIFF_HEADS = 4
REL_BUCKETS = 32
REL_MAX_DIST = 128

N_BRANCH = 3
COL_SIZES = (
    (HY_ORDER + 1) * HY_WIDTH,
    HY_WIDTH,
    GQA_HEADS * HEAD_DIM,
    GQA_KV_HEADS * HEAD_DIM,
    GQA_KV_HEADS * HEAD_DIM,
    GQA_HEADS * HEAD_DIM,
    DIFF_HEADS * 2 * HEAD_DIM,
    DIFF_HEADS * 2 * HEAD_DIM,
    DIFF_HEADS * 2 * HEAD_DIM,
    DIFF_HEADS * 2 * HEAD_DIM,
)
IN_COLS = sum(COL_SIZES)
GQA_WIDTH = GQA_HEADS * HEAD_DIM
DIFF_WIDTH = DIFF_HEADS * 2 * HEAD_DIM

kernel_name = 'hybrid_hyena_gqa_diffattn_encoder'


def rms_norm(x, g):
    xf = x.astype(jnp.float32)
    y = xf * lax.rsqrt(jnp.mean(xf * xf, axis=-1, keepdims=True) + EPS)
    return (y * g.astype(jnp.float32)).astype(x.dtype)


def split_columns(u):
    parts, start = [], 0
    for size in COL_SIZES:
        parts.append(u[..., start:start + size])
        start += size
    return parts


def axial_rope_tables(L):
    rows = L // GRID_W
    row = jnp.broadcast_to(jnp.arange(rows, dtype=jnp.float32)[:, None], (rows, GRID_W)).reshape(L)
    col = jnp.broadcast_to(jnp.arange(GRID_W, dtype=jnp.float32)[None, :], (rows, GRID_W)).reshape(L)
    n_freq = HEAD_DIM // 4
    inv_freq = ROPE_THETA ** (-jnp.arange(n_freq, dtype=jnp.float32) / n_freq)
    ang = jnp.concatenate([row[:, None] * inv_freq, col[:, None] * inv_freq], axis=-1)
    return jnp.cos(ang), jnp.sin(ang)


def apply_rope(x, cos, sin):
    half = x.shape[-1] // 2
    x1, x2 = x[..., :half], x[..., half:]
    c, s = cos[None, :, None, :], sin[None, :, None, :]
    return jnp.concatenate([x1 * c - x2 * s, x2 * c + x1 * s], axis=-1).astype(x.dtype)


def t5_bucket(rel):
    nb = REL_BUCKETS // 2
    max_exact = nb // 2
    ret = (rel > 0).astype(jnp.int32) * nb
    n = jnp.abs(rel)
    nf = jnp.maximum(n, 1).astype(jnp.float32)
    large = max_exact + (jnp.log(nf / max_exact) / math.log(REL_MAX_DIST / max_exact)
                         * (nb - max_exact)).astype(jnp.int32)
    large = jnp.minimum(large, nb - 1)
    return ret + jnp.where(n < max_exact, n, large)


def hyena_positions(L):
    t01 = jnp.linspace(0.0, 1.0, L, dtype=jnp.float32)[:, None]
    bands = (FILT_EMB - 1) // 2
    w = 2.0 * math.pi * jnp.arange(L, dtype=jnp.float32)[:, None] / L
    f = jnp.linspace(1e-4, bands - 1, bands, dtype=jnp.float32)[None, :]
    z = jnp.concatenate([t01, jnp.cos(f * w), -jnp.sin(f * w)], axis=-1)
    max_decay = math.log(HY_TARGET) / HY_FAST_DECAY
    min_decay = math.log(HY_TARGET) / HY_SLOW_DECAY
    deltas = jnp.linspace(min_decay, max_decay, HY_WIDTH, dtype=jnp.float32)
    window = jnp.exp(-t01 * jnp.abs(deltas)[None, :]) + HY_SHIFT
    return z, window


def centred_short_conv(u, w, b):
    L = u.shape[1]
    pad = SHORT_K // 2
    up = jnp.pad(u, ((0, 0), (pad, pad), (0, 0)))
    out = up[:, 0:L] * w[0]
    for j in range(1, SHORT_K):
        out = out + up[:, j:j + L] * w[j]
    return out + b


def hyena_filter(z, window, w1, b1, w2, b2, wout, freq):
    a = jnp.sin(freq * (z @ w1 + b1))
    for i in range(FILT_INNER):
        a = jnp.sin(freq * (a @ w2[i] + b2[i]))
    hf = (a @ wout).reshape(-1, 2, HY_WIDTH) * window[:, None, :]
    fwd, bwd = hf[:, 0], hf[:, 1]
    return jnp.concatenate([fwd, jnp.zeros_like(fwd[:1]), bwd[:0:-1]], axis=0).astype(jnp.float32)


def bidir_fftconv(u, c):
    L = u.shape[1]
    uf = jnp.fft.rfft(u.astype(jnp.float32), n=2 * L, axis=1)
    cf = jnp.fft.rfft(c, n=2 * L, axis=0)
    y = jnp.fft.irfft(uf * cf[None], n=2 * L, axis=1)[:, :L]
    return y.astype(u.dtype)


def gqa_attention(q, k, v):
    B, L, H, D = q.shape
    G = H // GQA_KV_HEADS
    nb = L // Q_BLOCK
    qb = q.reshape(B, nb, Q_BLOCK, GQA_KV_HEADS, G, D).transpose(1, 0, 2, 3, 4, 5)
    scale = D ** -0.5

    def block(qi):
        s = jnp.einsum('bqkgd,bskd->bkgqs', qi, k).astype(jnp.float32) * scale
        p = jax.nn.softmax(s, axis=-1).astype(v.dtype)
        return jnp.einsum('bkgqs,bskd->bqkgd', p, v)

    o = lax.map(block, qb)
    return o.transpose(1, 0, 2, 3, 4, 5).reshape(B, L, H * D)


def diff_attention(q, k, v, rel_bias, lam, lam_init, subln_g):
    B, L, H, _, D = q.shape
    nb = L // Q_BLOCK
    qb = q.reshape(B, nb, Q_BLOCK, H, 2, D).transpose(1, 0, 2, 3, 4, 5)
    starts = jnp.arange(nb, dtype=jnp.int32) * Q_BLOCK
    kpos = jnp.arange(L, dtype=jnp.int32)
    scale = D ** -0.5

    def block(args):
        qi, q0 = args
        qpos = q0 + jnp.arange(Q_BLOCK, dtype=jnp.int32)
        bucket = t5_bucket(kpos[None, :] - qpos[:, None])
        bias = jnp.take(rel_bias, bucket, axis=0).transpose(2, 0, 1).astype(jnp.float32)
        s = jnp.einsum('bqhcd,bshcd->bhcqs', qi, k).astype(jnp.float32) * scale + bias[None, :, None]
        p = jax.nn.softmax(s, axis=-1)
        a = p[:, :, 0] - lam * p[:, :, 1]
        return jnp.einsum('bhqs,bshe->bqhe', a.astype(v.dtype), v)

    o = lax.map(block, (qb, starts))
    o = o.transpose(1, 0, 2, 3, 4).reshape(B, L, H, 2 * D)
    o = rms_norm(o, subln_g) * (1.0 - lam_init)
    return o.reshape(B, L, H * 2 * D)


def mixer_layer(x, l, p, rope_cos, rope_sin, z, window, rel_bias):
    B, L, _ = x.shape
    h = rms_norm(x, p['norm_g'][l])
    u = h @ p['w_in'][l]
    (hy_u, hy_gate, gq_q, gq_k, gq_v, gq_gate, df_q, df_k, df_v, df_gate) = split_columns(u)

    hy = centred_short_conv(hy_u, p['hy_conv_w'][l], p['hy_conv_b'][l])
    x0, x1, hv = hy[..., :HY_WIDTH], hy[..., HY_WIDTH:2 * HY_WIDTH], hy[..., 2 * HY_WIDTH:]
    filt = hyena_filter(z, window, p['hy_f_w1'][l], p['hy_f_b1'][l], p['hy_f_w2'][l],
                        p['hy_f_b2'][l], p['hy_f_wout'][l], p['hy_f_freq'][l])
    hv = hv * x1
    hv = bidir_fftconv(hv, filt) + hv * p['hy_bias'][l]
    y_hy = (hv * x0) * jax.nn.silu(hy_gate)

    q = gq_q.reshape(B, L, GQA_HEADS, HEAD_DIM)
    k = gq_k.reshape(B, L, GQA_KV_HEADS, HEAD_DIM)
    v = gq_v.reshape(B, L, GQA_KV_HEADS, HEAD_DIM)
    q = apply_rope(rms_norm(q, p['q_norm_g'][l]), rope_cos, rope_sin)
    k = apply_rope(rms_norm(k, p['k_norm_g'][l]), rope_cos, rope_sin)
    y_gq = gqa_attention(q, k, v) * jax.nn.silu(gq_gate)

    dq = df_q.reshape(B, L, DIFF_HEADS, 2, HEAD_DIM)
    dk = df_k.reshape(B, L, DIFF_HEADS, 2, HEAD_DIM)
    dv = df_v.reshape(B, L, DIFF_HEADS, 2 * HEAD_DIM)
    lam_init = 0.8 - 0.6 * math.exp(-0.3 * l)
    lam = (jnp.exp(jnp.sum(p['lam_q1'][l].astype(jnp.float32) * p['lam_k1'][l].astype(jnp.float32)))
           - jnp.exp(jnp.sum(p['lam_q2'][l].astype(jnp.float32) * p['lam_k2'][l].astype(jnp.float32)))
           + lam_init)
    y_df = diff_attention(dq, dk, dv, rel_bias, lam, lam_init, p['diff_subln_g'][l]) * jax.nn.silu(df_gate)

    gates = jax.nn.sigmoid((h @ p['w_merge'][l] + p['b_merge'][l]).astype(jnp.float32))
    gates = gates.reshape(B, L, N_BRANCH, D_MODEL).astype(x.dtype)
    merged = (gates[:, :, 0] * (y_hy @ p['w_branch_hy'][l])
              + gates[:, :, 1] * (y_gq @ p['w_branch_gqa'][l])
              + gates[:, :, 2] * (y_df @ p['w_branch_diff'][l]))
    return merged @ p['w_out'][l]


def encoder_trunk(x, p, rel_bias, final_g):
    L = x.shape[1]
    rope_cos, rope_sin = axial_rope_tables(L)
    z, window = hyena_positions(L)
    for l in range(DEPTH):
        x = x + mixer_layer(x, l, p, rope_cos, rope_sin, z, window, rel_bias)
    return rms_norm(x, final_g)


def setup_inputs(seed: int = 0) -> dict:
    key = jax.random.key(seed)
    ks = iter(list(jax.random.split(key, 40)))

    def nrm(shape, scale):
        return jax.random.normal(next(ks), shape, jnp.float32) * scale

    def gain(shape, base=1.0):
        return base + 0.02 * jax.random.normal(next(ks), shape, jnp.float32)

    d = {}
    d['x_prompt'] = nrm((BATCH, SEQ, D_MODEL), 1.0)
    d['x_sample'] = nrm((DEC_BATCH, DEC_SEQ, D_MODEL), 1.0)
    d['rel_bias'] = nrm((REL_BUCKETS, DIFF_HEADS), 0.5)
    d['norm_g'] = gain((DEPTH, D_MODEL))
    d['w_in'] = nrm((DEPTH, D_MODEL, IN_COLS), D_MODEL ** -0.5)
    d['hy_conv_w'] = nrm((DEPTH, SHORT_K, (HY_ORDER + 1) * HY_WIDTH), SHORT_K ** -0.5)
    d['hy_conv_b'] = nrm((DEPTH, (HY_ORDER + 1) * HY_WIDTH), 0.02)
    d['hy_f_w1'] = nrm((DEPTH, FILT_EMB, FILT_ORDER), FILT_EMB ** -0.5)
    d['hy_f_b1'] = nrm((DEPTH, FILT_ORDER), 0.1)
    d['hy_f_w2'] = nrm((DEPTH, FILT_INNER, FILT_ORDER, FILT_ORDER), FILT_ORDER ** -0.5)
    d['hy_f_b2'] = nrm((DEPTH, FILT_INNER, FILT_ORDER), 0.1)
    d['hy_f_wout'] = nrm((DEPTH, FILT_ORDER, 2 * HY_WIDTH), 0.05 * FILT_ORDER ** -0.5)
    d['hy_f_freq'] = gain((DEPTH, FILT_ORDER))
    d['hy_bias'] = nrm((DEPTH, HY_WIDTH), 1.0)
    d['q_norm_g'] = gain((DEPTH, HEAD_DIM))
    d['k_norm_g'] = gain((DEPTH, HEAD_DIM))
    d['lam_q1'] = nrm((DEPTH, HEAD_DIM), 0.1)
    d['lam_k1'] = nrm((DEPTH, HEAD_DIM), 0.1)
    d['lam_q2'] = nrm((DEPTH, HEAD_DIM), 0.1)
    d['lam_k2'] = nrm((DEPTH, HEAD_DIM), 0.1)
    d['diff_subln_g'] = gain((DEPTH, 2 * HEAD_DIM))
    d['w_branch_hy'] = nrm((DEPTH, HY_WIDTH, D_MODEL), HY_WIDTH ** -0.5)
    d['w_branch_gqa'] = nrm((DEPTH, GQA_WIDTH, D_MODEL), GQA_WIDTH ** -0.5)
    d['w_branch_diff'] = nrm((DEPTH, DIFF_WIDTH, D_MODEL), DIFF_WIDTH ** -0.5)
    d['w_merge'] = nrm((DEPTH, D_MODEL, N_BRANCH * D_MODEL), D_MODEL ** -0.5)
    d['b_merge'] = nrm((DEPTH, N_BRANCH * D_MODEL), 0.02)
    d['w_out'] = nrm((DEPTH, D_MODEL, D_MODEL), D_MODEL ** -0.5)
    d['final_g'] = gain((D_MODEL,))
    return d


def reference(x_prompt, x_sample, rel_bias, norm_g, w_in, hy_conv_w, hy_conv_b, hy_f_w1, hy_f_b1,
              hy_f_w2, hy_f_b2, hy_f_wout, hy_f_freq, hy_bias, q_norm_g, k_norm_g, lam_q1, lam_k1,
              lam_q2, lam_k2, diff_subln_g, w_branch_hy, w_branch_gqa, w_branch_diff, w_merge, b_merge,
              w_out, final_g):
    p = dict(norm_g=norm_g, w_in=w_in, hy_conv_w=hy_conv_w, hy_conv_b=hy_conv_b, hy_f_w1=hy_f_w1,
             hy_f_b1=hy_f_b1, hy_f_w2=hy_f_w2, hy_f_b2=hy_f_b2, hy_f_wout=hy_f_wout, hy_f_freq=hy_f_freq,
             hy_bias=hy_bias, q_norm_g=q_norm_g, k_norm_g=k_norm_g, lam_q1=lam_q1, lam_k1=lam_k1,
             lam_q2=lam_q2, lam_k2=lam_k2, diff_subln_g=diff_subln_g, w_branch_hy=w_branch_hy,
             w_branch_gqa=w_branch_gqa, w_branch_diff=w_branch_diff, w_merge=w_merge, b_merge=b_merge,
             w_out=w_out)
    y_prompt = encoder_trunk(x_prompt, p, rel_bias, final_g)
    y_sample = encoder_trunk(x_sample, p, rel_bias, final_g)
    return (y_prompt, y_sample)
```

```cpp
#include <hip/hip_runtime.h>
#include <hip/hip_cooperative_groups.h>
#include <cstdio>
#include <cstdint>
namespace cg = cooperative_groups;
__device__ __forceinline__ int ltid() { int t = (int)threadIdx.x; asm volatile("" : "+v"(t)); return t; }
__device__ __forceinline__ int lbid() { int b = (int)blockIdx.x; asm volatile("" : "+s"(b)); return b; }
namespace pg8 {
#define PG8_LAS __attribute__((address_space(3)))
typedef unsigned short bf16_t;
typedef short bf16x8 __attribute__((ext_vector_type(8)));
typedef float f32x4 __attribute__((ext_vector_type(4)));
typedef unsigned u32x4 __attribute__((ext_vector_type(4)));
constexpr int BM = 256, BK = 64, HALF = 128, HTB = HALF * BK * 2  , STAGE_BYTES = 8 * HTB, NXCD = 8, WGM = 8;

__host__ __device__ __forceinline__ int lds_byte(int r, int c) { const int st = (r >> 4) * 2 + (c >> 5), rr = r & 15, cc = c & 31, ob = rr * 64 + cc * 2; return st * 1024 + (ob ^ (((ob >> 9) & 1) << 5)); }
__host__ __device__ __forceinline__ void stage_rc(int b, int& R, int& C) { const int st = b / 1024, sb = b % 1024, swz = sb ^ (((sb >> 9) & 1) << 5); R = (st >> 1) * 16 + swz / 64; C = (st & 1) * 32 + (swz % 64) / 2; }
__host__ __device__ __forceinline__ int perm32(int rho) { const int n = rho >> 4, i = rho & 15; return 8 * (i >> 2) + 4 * n + (i & 3); }

struct Unit { int pm, pn; };
struct Gemm { const bf16_t* A; const bf16_t* Bt; int M, N, K; };

struct StaticOrder {
    int nM, nN, nwg, G, c;
    __host__ __device__ void init(int M, int N, int G_, int c_) { nM = M / BM; nN = N / BM; nwg = nM * nN; G = G_; c = c_; }
    __host__ __device__ bool next(int i, Unit& u) const {
        const long L = (long)i * G + c; if (L >= nwg) return false;
        int wgid = (int)L; { const int q = nwg / NXCD, r = nwg % NXCD, xcd = wgid % NXCD, off = wgid / NXCD; wgid = (xcd < r ? xcd * (q + 1) : r * (q + 1) + (xcd - r) * q) + off; }
        const int nig = WGM * nN, gid = wgid / nig, fm = gid * WGM, gsz = (nM - fm) < WGM ? (nM - fm) : WGM;
        u.pm = fm + ((wgid % nig) % gsz); u.pn = (wgid % nig) / gsz; return true;
    }
    __device__ __forceinline__ void a_ready(const Unit&) const {}
    __device__ __forceinline__ void done(const Unit&) const {}
};

__device__ __forceinline__ unsigned cvt_pk_bf16(float lo, float hi) { unsigned r; asm volatile("v_cvt_pk_bf16_f32 %0, %1, %2" : "=v"(r) : "v"(lo), "v"(hi)); return r; }
template <class Epi, class Sched, bool ALIGN_EPI = false, bool SP2 = false>
__device__ __forceinline__ void gemm_phase(PG8_LAS unsigned char* lds, const Gemm g, const Sched& S, const Epi& E) {
    const int tid = ltid(), wid = __builtin_amdgcn_readfirstlane(tid >> 6), lane = tid & 63, wr = wid >> 2, wc = wid & 3, fr = lane & 15, fq = lane >> 4;
    const int K = g.K, nt = K / BK;
    unsigned voffA[2], voffB[2];
#pragma unroll
    for (int i = 0; i < 2; ++i) { int R, C; stage_rc(tid * 16 + i * 8192, R, C); const int Rb = Epi::PERM ? ((R & ~31) + perm32(R & 31)) : R;
        voffA[i] = (unsigned)(R * K + C) * 2u; voffB[i] = (unsigned)(Rb * K + C) * 2u; }
    const size_t kstep = (size_t)(BK * 2);
    const size_t hstep = (size_t)HALF * K * 2;
    const size_t tstep = 2 * hstep;
    const unsigned ldsw = (unsigned)wid * 1024u;
    const int aoff = lds_byte(wr * 64 + fr, fq * 8), boff = lds_byte(wc * 32 + fr, fq * 8);
#define PG8_SA(b, h) (((b) * 2 + (h)) * HTB)
#define PG8_SB(b, h) ((4 + (b) * 2 + (h)) * HTB)
#define PG8_STAGE(bufoff, gbase, voff) do { _Pragma("unroll") for (int _i = 0; _i < 2; ++_i) \
        __builtin_amdgcn_global_load_lds((const unsigned*)((const char*)(gbase) + (voff)[_i]), (PG8_LAS unsigned*)(lds + (bufoff) + ldsw + _i * 8192), 16, 0, 0); } while (0)
#define PG8_LDA(dst, b, h) do { _Pragma("unroll") for (int m = 0; m < 4; ++m) _Pragma("unroll") for (int k = 0; k < 2; ++k) dst[m][k] = *(const PG8_LAS bf16x8*)(lds + PG8_SA(b, h) + aoff + m * 2048 + k * 1024); } while (0)
#define PG8_LDB(dst, b, h) do { _Pragma("unroll") for (int n = 0; n < 2; ++n) _Pragma("unroll") for (int k = 0; k < 2; ++k) dst[n][k] = *(const PG8_LAS bf16x8*)(lds + PG8_SB(b, h) + boff + n * 2048 + k * 1024); } while (0)
#define PG8_MMA(ai, bj, At, Bt) do { __builtin_amdgcn_s_setprio(1); _Pragma("unroll") for (int m = 0; m < 4; ++m) _Pragma("unroll") for (int n = 0; n < 2; ++n) _Pragma("unroll") for (int k = 0; k < 2; ++k) \
        acc[ai][bj][m][n] = __builtin_amdgcn_mfma_f32_16x16x32_bf16(Bt[n][k], At[m][k], acc[ai][bj][m][n], 0, 0, 0); __builtin_amdgcn_s_setprio(0); } while (0)
#define PG8_WAIT_V(n) asm volatile("s_waitcnt vmcnt(" #n ")" ::: "memory")
#define PG8_WAIT_L(n) asm volatile("s_waitcnt lgkmcnt(" #n ")" ::: "memory")
#define PG8_BAR __builtin_amdgcn_s_barrier()
#define PG8_SCHED __builtin_amdgcn_sched_barrier(0)
    Unit cur, nxt; int ui = 0;
    if (!S.next(0, cur)) return;
    f32x4 acc[2][2][4][2];
#pragma unroll
    for (int a = 0; a < 2; ++a)
#pragma unroll
        for (int b = 0; b < 2; ++b)
#pragma unroll
            for (int m = 0; m < 4; ++m)
#pragma unroll
                for (int n = 0; n < 2; ++n) acc[a][b][m][n] = (f32x4){0.f, 0.f, 0.f, 0.f};
    bf16x8 At[4][2], B0[2][2], B1[2][2];
    const char* cA = (const char*)g.A + (size_t)cur.pm * tstep; const char* cB = (const char*)g.Bt + (size_t)cur.pn * tstep;
    S.a_ready(cur);
    if constexpr (SP2) {
        PG8_STAGE(PG8_SB(0, 0), cB, voffB); PG8_STAGE(PG8_SB(0, 1), cB + hstep, voffB); PG8_STAGE(PG8_SA(0, 0), cA, voffA); PG8_STAGE(PG8_SA(0, 1), cA + hstep, voffA);
        if (wr == 1) PG8_BAR;
        PG8_WAIT_V(2); PG8_BAR;
        PG8_STAGE(PG8_SB(1, 0), cB + kstep, voffB); PG8_STAGE(PG8_SA(1, 0), cA + kstep, voffA); PG8_STAGE(PG8_SB(1, 1), cB + hstep + kstep, voffB);
        PG8_WAIT_V(6); PG8_BAR;
    } else {
        PG8_STAGE(PG8_SB(0, 0), cB, voffB); PG8_STAGE(PG8_SA(0, 0), cA, voffA); PG8_STAGE(PG8_SB(0, 1), cB + hstep, voffB); PG8_STAGE(PG8_SA(0, 1), cA + hstep, voffA);
        if (wr == 1) PG8_BAR;
        PG8_WAIT_V(4); PG8_BAR;
        PG8_STAGE(PG8_SB(1, 0), cB + kstep, voffB); PG8_STAGE(PG8_SA(1, 0), cA + kstep, voffA); PG8_STAGE(PG8_SB(1, 1), cB + hstep + kstep, voffB);
        PG8_WAIT_V(6); PG8_BAR;
    }
    for (;;) {
        const bool has_next = S.next(ui + 1, nxt);
        const char* nA = has_next ? (const char*)g.A + (size_t)nxt.pm * tstep : cA; const char* nB = has_next ? (const char*)g.Bt + (size_t)nxt.pn * tstep : cB;
        for (int t = 0; t < nt; t += 2) {
            const bool last = (t == nt - 2);
            const char* a1 = cA + (size_t)(t + 1) * kstep;
            const char* a2 = last ? nA : cA + (size_t)(t + 2) * kstep; const char* b2 = last ? nB : cB + (size_t)(t + 2) * kstep;
            const char* a3 = a2 + kstep; const char* b3 = b2 + kstep;
            if (last && has_next) S.a_ready(nxt);
            if constexpr (SP2) {
            PG8_LDB(B0, 0, 0); PG8_LDB(B1, 0, 1); PG8_SCHED; PG8_LDA(At, 0, 0); PG8_STAGE(PG8_SA(1, 1), a1 + hstep, voffA);
            PG8_WAIT_V(8); PG8_WAIT_L(0); PG8_BAR; PG8_MMA(0, 0, At, B0); PG8_MMA(0, 1, At, B1); PG8_BAR; PG8_SCHED;
            PG8_LDA(At, 0, 1); PG8_STAGE(PG8_SB(0, 0), b2, voffB); PG8_STAGE(PG8_SB(0, 1), b2 + hstep, voffB); PG8_STAGE(PG8_SA(0, 0), a2, voffA);
            PG8_WAIT_V(8); PG8_WAIT_L(0); PG8_BAR; PG8_MMA(1, 0, At, B0); PG8_MMA(1, 1, At, B1); PG8_BAR; PG8_SCHED;
            PG8_LDB(B0, 1, 0); PG8_LDB(B1, 1, 1); PG8_SCHED; PG8_LDA(At, 1, 0); PG8_STAGE(PG8_SA(0, 1), a2 + hstep, voffA);
            PG8_WAIT_V(8); PG8_WAIT_L(0); PG8_BAR; PG8_MMA(0, 0, At, B0); PG8_MMA(0, 1, At, B1); PG8_BAR; PG8_SCHED;
            PG8_LDA(At, 1, 1); PG8_STAGE(PG8_SB(1, 0), b3, voffB); PG8_STAGE(PG8_SB(1, 1), b3 + hstep, voffB); PG8_STAGE(PG8_SA(1, 0), a3, voffA);
            PG8_WAIT_V(8); PG8_WAIT_L(0); PG8_BAR; PG8_MMA(1, 0, At, B0); PG8_MMA(1, 1, At, B1); PG8_BAR; PG8_SCHED;
            } else {
            PG8_LDB(B0, 0, 0); PG8_SCHED; PG8_LDA(At, 0, 0); PG8_STAGE(PG8_SA(1, 1), a1 + hstep, voffA);
            PG8_WAIT_L(8); PG8_BAR; PG8_WAIT_L(0); PG8_MMA(0, 0, At, B0); PG8_BAR; PG8_SCHED;
            PG8_LDB(B1, 0, 1); PG8_STAGE(PG8_SB(0, 0), b2, voffB);
            PG8_BAR; PG8_WAIT_L(0); PG8_MMA(0, 1, At, B1); PG8_BAR;
            PG8_LDA(At, 0, 1); PG8_STAGE(PG8_SA(0, 0), a2, voffA);
            PG8_BAR; PG8_WAIT_L(0); PG8_MMA(1, 0, At, B0); PG8_BAR; PG8_SCHED;
            PG8_STAGE(PG8_SB(0, 1), b2 + hstep, voffB);
            PG8_WAIT_V(6); PG8_BAR; PG8_MMA(1, 1, At, B1); PG8_BAR;
            PG8_LDB(B0, 1, 0); PG8_SCHED; PG8_LDA(At, 1, 0); PG8_STAGE(PG8_SA(0, 1), a2 + hstep, voffA);
            PG8_WAIT_L(8); PG8_BAR; PG8_WAIT_L(0); PG8_MMA(0, 0, At, B0); PG8_BAR; PG8_SCHED;
            PG8_LDB(B1, 1, 1); PG8_STAGE(PG8_SB(1, 0), b3, voffB);
            PG8_BAR; PG8_WAIT_L(0); PG8_MMA(0, 1, At, B1); PG8_BAR;
            PG8_LDA(At, 1, 1); PG8_STAGE(PG8_SA(1, 0), a3, voffA);
            PG8_BAR; PG8_WAIT_L(0); PG8_MMA(1, 0, At, B0); PG8_BAR; PG8_SCHED;
            PG8_STAGE(PG8_SB(1, 1), b3 + hstep, voffB);
            PG8_WAIT_V(6); PG8_BAR; PG8_MMA(1, 1, At, B1); PG8_BAR;
            }
        }
        if constexpr (ALIGN_EPI) { if (wr == 0) PG8_BAR; }
        if constexpr (!Epi::AFTER_DRAIN) { E(acc, cur, wr, wc, fr, fq); S.done(cur); }
        if (!has_next) break;
#pragma unroll
        for (int a = 0; a < 2; ++a)
#pragma unroll
            for (int b = 0; b < 2; ++b)
#pragma unroll
                for (int m = 0; m < 4; ++m)
#pragma unroll
                    for (int n = 0; n < 2; ++n) acc[a][b][m][n] = (f32x4){0.f, 0.f, 0.f, 0.f};
        cur = nxt; cA = nA; cB = nB; ++ui;
        if constexpr (ALIGN_EPI) { if (wr == 1) PG8_BAR; }
    }
    PG8_WAIT_V(0);
    if constexpr (!ALIGN_EPI) { if (wr == 0) PG8_BAR; }
    PG8_BAR;
    if constexpr (Epi::AFTER_DRAIN) { E.fused(acc, cur, wr, wc, fr, fq, lds, wid, lane); S.done(cur); }
#undef PG8_SA
#undef PG8_SB
#undef PG8_STAGE
#undef PG8_LDA
#undef PG8_LDB
#undef PG8_MMA
#undef PG8_WAIT_V
#undef PG8_WAIT_L
#undef PG8_BAR
#undef PG8_SCHED
}
__device__ __forceinline__ float bf2f(unsigned short h) { return __uint_as_float(((unsigned)h) << 16); }
__device__ __forceinline__ float fast_sigmoid(float x) { return __builtin_amdgcn_rcpf(1.0f + __builtin_amdgcn_exp2f(-1.4426950408889634f * x)); }
struct EpiG1 {
    static constexpr bool PERM = true, AFTER_DRAIN = false;
    bf16_t* U; bf16_t* G; const float* bias;
    __device__ __forceinline__ void operator()(const f32x4 (&acc)[2][2][4][2], const Unit& u, int wr, int wc, int fr, int fq) const {
        const int row0 = u.pm * BM + wr * 64 + fr; int colt = u.pn * BM; const bool isg = colt >= 5376;
        bf16_t* base = U; int ldc = 5376; if (isg) { colt -= 5376; base = G; ldc = 3072; }
        const int col0 = colt + wc * 32 + 8 * fq;
        f32x4 bv[2][2];
#pragma unroll
        for (int bj = 0; bj < 2; ++bj)
#pragma unroll
            for (int n = 0; n < 2; ++n) bv[bj][n] = isg ? *(const f32x4*)(bias + col0 + bj * HALF + 4 * n) : (f32x4){0.f, 0.f, 0.f, 0.f};
#pragma unroll
        for (int ai = 0; ai < 2; ++ai)
#pragma unroll
            for (int m = 0; m < 4; ++m) { bf16_t* rowp = base + (size_t)(row0 + ai * HALF + m * 16) * ldc + col0;
#pragma unroll
                for (int bj = 0; bj < 2; ++bj) { f32x4 v0 = acc[ai][bj][m][0] + bv[bj][0], v1 = acc[ai][bj][m][1] + bv[bj][1];
                    if (isg) {
#pragma unroll
                        for (int e = 0; e < 4; ++e) { v0[e] = fast_sigmoid(v0[e]); v1[e] = fast_sigmoid(v1[e]); } }
                    u32x4 w; w.x = cvt_pk_bf16(v0[0], v0[1]); w.y = cvt_pk_bf16(v0[2], v0[3]); w.z = cvt_pk_bf16(v1[0], v1[1]); w.w = cvt_pk_bf16(v1[2], v1[3]);
                    *(u32x4*)(rowp + bj * HALF) = w; } }
    }
};
struct EpiG2 {
    static constexpr bool PERM = true, AFTER_DRAIN = false;
    const bf16_t* G; float* T; bf16_t* Mg; int npan;
    __device__ __forceinline__ void operator()(const f32x4 (&acc)[2][2][4][2], const Unit& u, int wr, int wc, int fr, int fq) const {
        const int b = u.pm / npan, pm = u.pm - b * npan, pn = u.pn & 3;
        const int row0 = pm * BM + wr * 64 + fr, col0 = pn * BM + wc * 32 + 8 * fq;
#pragma unroll
        for (int ai = 0; ai < 2; ++ai)
#pragma unroll
            for (int m = 0; m < 4; ++m) { const size_t row = (size_t)(row0 + ai * HALF + m * 16);
#pragma unroll
                for (int bj = 0; bj < 2; ++bj) { const int col = col0 + bj * HALF;
                    const u32x4 g = *(const u32x4*)(G + row * 3072 + b * 1024 + col);
                    f32x4 v0 = acc[ai][bj][m][0], v1 = acc[ai][bj][m][1];
                    v0[0] *= __uint_as_float(g.x << 16); v0[1] *= __uint_as_float(g.x & 0xffff0000u); v0[2] *= __uint_as_float(g.y << 16); v0[3] *= __uint_as_float(g.y & 0xffff0000u);
                    v1[0] *= __uint_as_float(g.z << 16); v1[1] *= __uint_as_float(g.z & 0xffff0000u); v1[2] *= __uint_as_float(g.w << 16); v1[3] *= __uint_as_float(g.w & 0xffff0000u);
                    bf16_t* mp = Mg + row * 1024 + col;
                    if (b > 0) { const u32x4 t = *(const u32x4*)mp;
                        v0[0] += __uint_as_float(t.x << 16); v0[1] += __uint_as_float(t.x & 0xffff0000u); v0[2] += __uint_as_float(t.y << 16); v0[3] += __uint_as_float(t.y & 0xffff0000u);
                        v1[0] += __uint_as_float(t.z << 16); v1[1] += __uint_as_float(t.z & 0xffff0000u); v1[2] += __uint_as_float(t.w << 16); v1[3] += __uint_as_float(t.w & 0xffff0000u); }
                    u32x4 w; w.x = cvt_pk_bf16(v0[0], v0[1]); w.y = cvt_pk_bf16(v0[2], v0[3]); w.z = cvt_pk_bf16(v1[0], v1[1]); w.w = cvt_pk_bf16(v1[2], v1[3]);
                    *(u32x4*)mp = w; } }
    }
};
struct OrderG2 {
    int npan, G, c;
    __device__ bool next(int i, Unit& u) const { const int ti = i / 3, b = i - 3 * ti, t = ti * G + c; if (t >= npan * 4) return false;
        const int pm = t >> 2, pn = t & 3; u.pm = b * npan + pm; u.pn = b * 4 + pn; return true; }
    __device__ __forceinline__ void a_ready(const Unit&) const {}
    __device__ __forceinline__ void done(const Unit&) const {}
};
struct EpiG3 {
    static constexpr bool PERM = true, AFTER_DRAIN = false;
    const float* X; float* O;
    __device__ __forceinline__ void operator()(const f32x4 (&acc)[2][2][4][2], const Unit& u, int wr, int wc, int fr, int fq) const {
        const int row0 = u.pm * BM + wr * 64 + fr, col0 = u.pn * BM + wc * 32 + 8 * fq;
#pragma unroll
        for (int ai = 0; ai < 2; ++ai)
#pragma unroll
            for (int m = 0; m < 4; ++m) { const size_t row = (size_t)(row0 + ai * HALF + m * 16);
#pragma unroll
                for (int bj = 0; bj < 2; ++bj) { const size_t p = row * 1024 + col0 + bj * HALF;
                    const f32x4 x0 = *(const f32x4*)(X + p), x1 = *(const f32x4*)(X + p + 4);
                    *(f32x4*)(O + p) = x0 + acc[ai][bj][m][0]; *(f32x4*)(O + p + 4) = x1 + acc[ai][bj][m][1]; } }
    }
};
struct EpiAll {
    static constexpr bool PERM = true, AFTER_DRAIN = false;
    int mode; EpiG1 e1; EpiG2 e2; EpiG3 e3;
    __device__ __forceinline__ void operator()(const f32x4 (&acc)[2][2][4][2], const Unit& u, int wr, int wc, int fr, int fq) const {
        if (mode == 1) e1(acc, u, wr, wc, fr, fq); else if (mode == 2) e2(acc, u, wr, wc, fr, fq); else e3(acc, u, wr, wc, fr, fq); }
};
struct OrderAll {
    int mode; StaticOrder so; OrderG2 o2;
    __device__ __forceinline__ bool next(int i, Unit& u) const { return mode == 2 ? o2.next(i, u) : so.next(i, u); }
    __device__ __forceinline__ void a_ready(const Unit&) const {}
    __device__ __forceinline__ void done(const Unit&) const {}
};
}
#ifndef DUP_MASK
#define DUP_MASK 0
#endif
#ifndef EN_MASK
#define EN_MASK 0xffff
#endif
#define EN(i) ((EN_MASK >> (i)) & 1)
#define LAS __attribute__((address_space(3)))
typedef unsigned short bf16;
typedef float f32x4 __attribute__((ext_vector_type(4)));
typedef float f32x2 __attribute__((ext_vector_type(2)));
typedef unsigned u32x4 __attribute__((ext_vector_type(4)));
typedef unsigned u32x2 __attribute__((ext_vector_type(2)));
constexpr int DM = 1024, NTOK_P = 65536, NTOK_S = 32768, NTOK = NTOK_P + NTOK_S, LP = 8192, LS = 2048;
constexpr int CH = 16384, NCHUNK = NTOK / CH, NCH_P = NTOK_P / CH;
constexpr int UP = 5376, NCAT = 8448, GP = 3072;
constexpr int C_X0 = 0, C_X1 = 512, C_HV = 1024, C_HG = 1536, C_GQ = 2048, C_GK = 2560, C_GV = 2688, C_GG = 2816, C_DQ = 3328, C_DK = 3840, C_DV = 4352, C_DG = 4864;
constexpr float EPS = 1e-6f, LOG2E = 1.4426950408889634f;
constexpr int NT = 512, NWAVES = 8;
enum { I_XP = 0, I_XS, I_RELB, I_NORMG, I_WIN, I_CONVW, I_CONVB, I_FW1, I_FB1, I_FW2, I_FB2, I_FWOUT, I_FFREQ, I_HYBIAS, I_QNG, I_KNG, I_LQ1, I_LK1, I_LQ2, I_LK2, I_SUBLN, I_WBHY, I_WBGQ, I_WBDF, I_WMERGE, I_BMERGE, I_WOUT, I_FINALG, N_IN };
constexpr size_t MiB = 1u << 20;
constexpr size_t WS_CTL = 0, CTL_BYTES = 64 * 1024;
constexpr size_t WS_TW = 1 * MiB;
constexpr size_t WS_WCAT = 2 * MiB, WCAT_BYTES = (size_t)NCAT * 1024 * 2;
constexpr size_t WS_WBT = 40 * MiB, WBT_BYTES = (size_t)3 * 1024 * 512 * 2;
constexpr size_t WS_WOT = 46 * MiB, WOT_BYTES = (size_t)1024 * 1024 * 2;
constexpr int SPS_P = LP + 16, SPS_S = LS + 16;
constexpr size_t SPEC_P_BYTES = (size_t)256 * SPS_P * 8, SPEC_S_BYTES = (size_t)256 * SPS_S * 8;
constexpr size_t SPEC_LAYER = 2 * SPEC_P_BYTES + 2 * SPEC_S_BYTES;
constexpr size_t WS_SPEC = 52 * MiB;
constexpr size_t WS_HN = 140 * MiB, WS_U = 172 * MiB, WS_G = 340 * MiB, WS_Y = 436 * MiB, WS_MG = 484 * MiB, WS_TMP = 516 * MiB, WS_DT = 580 * MiB, WS_HVP = 612 * MiB, WS_PMP = 644 * MiB, WS_ROPE = 676 * MiB, WS_HN0 = 680 * MiB, WS_END = 872 * MiB;
constexpr size_t HF_P_BYTES = (size_t)LP * 1024 * 4, HF_S_BYTES = (size_t)LS * 1024 * 4;
static_assert(WS_WCAT + 2 * WCAT_BYTES <= WS_WBT && WS_WBT + 2 * WBT_BYTES <= WS_WOT && WS_WOT + 2 * WOT_BYTES <= WS_SPEC && WS_SPEC + 2 * SPEC_LAYER <= WS_HN, "ws map");
static_assert(WS_HN + (size_t)CH * 1024 * 2 <= WS_U && WS_U + (size_t)CH * UP * 2 <= WS_G && WS_G + (size_t)CH * GP * 2 <= WS_Y && WS_Y + (size_t)3 * CH * 512 * 2 <= WS_MG && WS_MG + (size_t)CH * 1024 * 2 <= WS_TMP && WS_TMP + (size_t)CH * 1024 * 4 <= WS_DT && WS_DT + (size_t)CH * 512 * 4 <= WS_END, "ws map 2");
static_assert(2 * (HF_P_BYTES + HF_S_BYTES) <= (size_t)CH * UP * 2, "hf overlay");
constexpr int LDS_MAIN = 139264, LDS_BYTES = LDS_MAIN + 1024;
constexpr int CW_BAR = 4096;

struct Args { const float* in[N_IN]; float* out; unsigned char* ws; int lo, hi; };
typedef const __attribute__((address_space(4))) unsigned long long* kargp_t;
struct AV { kargp_t p; };
#define AIN(i) ((const float*)(a.p[(i)]))
#define AOUT ((float*)(a.p[N_IN]))
#define AWS ((unsigned char*)(a.p[N_IN + 1]))


__device__ __forceinline__ float bf2f(unsigned short h) { return __uint_as_float(((unsigned)h) << 16); }
__device__ __forceinline__ float bflo(unsigned w) { return __uint_as_float(w << 16); }
__device__ __forceinline__ float bfhi(unsigned w) { return __uint_as_float(w & 0xffff0000u); }
__device__ __forceinline__ unsigned f2bf(float f) { unsigned u = __builtin_bit_cast(unsigned, f); return (u + 0x7fffu + ((u >> 16) & 1u)) >> 16; }
__device__ __forceinline__ unsigned pk2(float lo, float hi) { return f2bf(lo) | (f2bf(hi) << 16); }
__device__ __forceinline__ float silu(float x) { return x * __builtin_amdgcn_rcpf(1.0f + __builtin_amdgcn_exp2f(-LOG2E * x)); }
__device__ __forceinline__ float wave_sum(float v) {
#pragma unroll
    for (int o = 1; o < 64; o <<= 1) v += __shfl_xor(v, o);
    return v;
}
__device__ __forceinline__ double kd(double v) { asm volatile("" : "+s"(v)); return v; }
__device__ __forceinline__ void sincos_rev(double r, float& s, float& c) {
    r -= __builtin_rint(r);
    const double k = __builtin_rint(r * 4.0);
    const double x = (r - k * 0.25) * kd(6.283185307179586476925);
    const double x2 = x * x;
    double sp = kd(1.0 / 6227020800.0); sp = sp * x2 + kd(-1.0 / 39916800); sp = sp * x2 + kd(1.0 / 362880); sp = sp * x2 + kd(-1.0 / 5040); sp = sp * x2 + kd(1.0 / 120); sp = sp * x2 + kd(-1.0 / 6); sp = sp * x2 + 1.0; sp *= x;
    double cp = kd(-1.0 / 87178291200.0); cp = cp * x2 + kd(1.0 / 479001600.0); cp = cp * x2 + kd(-1.0 / 3628800); cp = cp * x2 + kd(1.0 / 40320); cp = cp * x2 + kd(-1.0 / 720); cp = cp * x2 + kd(1.0 / 24); cp = cp * x2 + (-0.5); cp = cp * x2 + 1.0;
    const int q = ((int)k) & 3;
    const float sf = (float)sp, cf = (float)cp;
    s = (q == 0) ? sf : (q == 1) ? cf : (q == 2) ? -sf : -cf;
    c = (q == 0) ? cf : (q == 1) ? -sf : (q == 2) ? -cf : sf;
}
__device__ __forceinline__ float sin_acc(float x) { float s, c; sincos_rev((double)x * 0.15915494309189533577, s, c); return s; }

__device__ __forceinline__ void transpose_item(const float* W, int K, int N, bf16* WT, int row_off, LAS float* scr, int item, int lane) {
    const int nblk = N / 32, kb = item / nblk, nb = item % nblk, k0 = 64 * kb, n0 = 32 * nb;
#pragma unroll 8
    for (int i = 0; i < 32; ++i) { const int kk = 2 * i + (lane >> 5); scr[kk * 33 + (lane & 31)] = W[(size_t)(k0 + kk) * N + n0 + (lane & 31)]; }
    asm volatile("s_waitcnt lgkmcnt(0)" ::: "memory");
    const int c = lane & 7;
#pragma unroll
    for (int j = 0; j < 4; ++j) { const int n = (lane >> 3) + 8 * j; const LAS float* s = scr + (8 * c) * 33 + n;
        u32x4 o; o.x = pk2(s[0 * 33], s[1 * 33]); o.y = pk2(s[2 * 33], s[3 * 33]); o.z = pk2(s[4 * 33], s[5 * 33]); o.w = pk2(s[6 * 33], s[7 * 33]);
        *(u32x4*)(WT + (size_t)(row_off + n0 + n) * K + k0 + 8 * c) = o; }
    asm volatile("s_waitcnt lgkmcnt(0)" ::: "memory");
}

__device__ __forceinline__ f32x2 cmul(f32x2 a, f32x2 b) { return (f32x2){a.x * b.x - a.y * b.y, a.x * b.y + a.y * b.x}; }
__device__ __forceinline__ f32x2 cmulc(f32x2 a, f32x2 b) { return (f32x2){a.x * b.x + a.y * b.y, a.y * b.x - a.x * b.y}; }
__device__ __forceinline__ f32x2 cconj(f32x2 a) { return (f32x2){a.x, -a.y}; }
template <int LOG4> __device__ __forceinline__ int digitrev(int k) { unsigned x = __builtin_bitreverse32((unsigned)k) >> (32 - 2 * LOG4); return (int)(((x & 0x55555555u) << 1) | ((x >> 1) & 0x55555555u)); }
#define PADI(i) ((i) + ((i) >> 4))
#define W16C 0.92387953251128674f
#define W16S 0.38268343236508977f
#define W16H 0.70710678118654752f
__device__ __forceinline__ f32x2 w16(int m) { return m == 0 ? (f32x2){1.f, 0.f} : m == 1 ? (f32x2){W16C, -W16S} : m == 2 ? (f32x2){W16H, -W16H} : m == 3 ? (f32x2){W16S, -W16C} : m == 4 ? (f32x2){0.f, -1.f} : m == 6 ? (f32x2){-W16H, -W16H} : (f32x2){-W16C, W16S}; }
__device__ __forceinline__ void bfly_fwd(f32x2& a0, f32x2& a1, f32x2& a2, f32x2& a3) {
    const f32x2 t0 = a0 + a2, t1 = a0 - a2, t2 = a1 + a3, t3 = a1 - a3;
    a0 = t0 + t2; a2 = t0 - t2; a1 = (f32x2){t1.x + t3.y, t1.y - t3.x}; a3 = (f32x2){t1.x - t3.y, t1.y + t3.x};
}
__device__ __forceinline__ void bfly_inv(f32x2& b0, f32x2& b1, f32x2& b2, f32x2& b3) {
    const f32x2 t0 = b0 + b2, t1 = b0 - b2, t2 = b1 + b3, t3 = b1 - b3;
    b0 = t0 + t2; b2 = t0 - t2; b1 = (f32x2){t1.x - t3.y, t1.y + t3.x}; b3 = (f32x2){t1.x + t3.y, t1.y - t3.x};
}
template <int LOG4, int BATCH = 1> __device__ __forceinline__ void fft_fwd(LAS f32x2* buf, const f32x2* __restrict__ tw, int tid) {
    constexpr int N = 1 << (2 * LOG4), TWS = 16384 / N;
#pragma unroll 1
    for (int pass = 0; pass < LOG4 - 2; ++pass) {
        const int lq = 2 * (LOG4 - pass) - 2, q4 = 1 << lq, n = q4 << 2, tstep = TWS << (2 * pass);
        constexpr int IT = BATCH * N / 4 / NT, NPAD = N + N / 16;
        f32x2 wl[IT];
#pragma unroll
        for (int i = 0; i < IT; ++i) wl[i] = tw[((tid + i * NT) & (q4 - 1)) * tstep];
#pragma unroll
        for (int i = 0; i < IT; ++i) { const int jg = tid + i * NT, bo = (jg >> (2 * LOG4 - 2)) * NPAD, j = jg & (N / 4 - 1);
            const int blk = j >> lq, jj = j & (q4 - 1), base = blk * n + jj;
            const int i0 = bo + PADI(base), i1 = bo + PADI(base + q4), i2 = bo + PADI(base + 2 * q4), i3 = bo + PADI(base + 3 * q4);
            const f32x2 w1 = wl[i];
            f32x2 a0 = buf[i0], a1 = buf[i1], a2 = buf[i2], a3 = buf[i3];
            bfly_fwd(a0, a1, a2, a3);
            const f32x2 w2 = cmul(w1, w1), w3 = cmul(w2, w1);
            buf[i0] = a0; buf[i1] = cmul(a1, w1); buf[i2] = cmul(a2, w2); buf[i3] = cmul(a3, w3);
        }
        __syncthreads();
    }
#pragma unroll 1
    for (int b = tid; b < BATCH * N / 16; b += NT) {
        LAS f32x2* xb = buf + 17 * b; f32x2 x[16];
#pragma unroll
        for (int e = 0; e < 16; ++e) x[e] = xb[e];
#pragma unroll
        for (int jj = 0; jj < 4; ++jj) { bfly_fwd(x[jj], x[jj + 4], x[jj + 8], x[jj + 12]); if (jj) { x[jj + 4] = cmul(x[jj + 4], w16(jj)); x[jj + 8] = cmul(x[jj + 8], w16(2 * jj)); x[jj + 12] = cmul(x[jj + 12], w16(3 * jj)); } }
#pragma unroll
        for (int q = 0; q < 4; ++q) bfly_fwd(x[4 * q], x[4 * q + 1], x[4 * q + 2], x[4 * q + 3]);
#pragma unroll
        for (int e = 0; e < 16; ++e) xb[e] = x[e];
    }
    __syncthreads();
}
template <int LOG4, int BATCH = 1> __device__ __forceinline__ void fft_inv(LAS f32x2* buf, const f32x2* __restrict__ tw, int tid) {
    constexpr int N = 1 << (2 * LOG4), TWS = 16384 / N;
#pragma unroll 1
    for (int b = tid; b < BATCH * N / 16; b += NT) {
        LAS f32x2* xb = buf + 17 * b; f32x2 x[16];
#pragma unroll
        for (int e = 0; e < 16; ++e) x[e] = xb[e];
#pragma unroll
        for (int q = 0; q < 4; ++q) bfly_inv(x[4 * q], x[4 * q + 1], x[4 * q + 2], x[4 * q + 3]);
#pragma unroll
        for (int jj = 0; jj < 4; ++jj) { if (jj) { x[jj + 4] = cmulc(x[jj + 4], w16(jj)); x[jj + 8] = cmulc(x[jj + 8], w16(2 * jj)); x[jj + 12] = cmulc(x[jj + 12], w16(3 * jj)); } bfly_inv(x[jj], x[jj + 4], x[jj + 8], x[jj + 12]); }
#pragma unroll
        for (int e = 0; e < 16; ++e) xb[e] = x[e];
    }
    __syncthreads();
#pragma unroll 1
    for (int pass = LOG4 - 3; pass >= 0; --pass) {
        const int lq = 2 * (LOG4 - pass) - 2, q4 = 1 << lq, n = q4 << 2, tstep = TWS << (2 * pass);
        constexpr int IT = BATCH * N / 4 / NT, NPAD = N + N / 16;
        f32x2 wl[IT];
#pragma unroll
        for (int i = 0; i < IT; ++i) wl[i] = tw[((tid + i * NT) & (q4 - 1)) * tstep];
#pragma unroll
        for (int i = 0; i < IT; ++i) { const int jg = tid + i * NT, bo = (jg >> (2 * LOG4 - 2)) * NPAD, j = jg & (N / 4 - 1);
            const int blk = j >> lq, jj = j & (q4 - 1), base = blk * n + jj;
            const int i0 = bo + PADI(base), i1 = bo + PADI(base + q4), i2 = bo + PADI(base + 2 * q4), i3 = bo + PADI(base + 3 * q4);
            const f32x2 w1 = wl[i];
            const f32x2 w2 = cmul(w1, w1), w3 = cmul(w2, w1);
            f32x2 b0 = buf[i0], b1 = cmulc(buf[i1], w1), b2 = cmulc(buf[i2], w2), b3 = cmulc(buf[i3], w3);
            bfly_inv(b0, b1, b2, b3);
            buf[i0] = b0; buf[i1] = b1; buf[i2] = b2; buf[i3] = b3;
        }
        __syncthreads();
    }
}
__device__ const double ROPE_IF[16] = {1.0, 0.5623413251903491, 0.31622776601683794, 0.1778279410038923, 0.1, 0.05623413251903491, 0.03162277660168379, 0.01778279410038923,
    0.01, 0.005623413251903491, 0.0031622776601683794, 0.0017782794100389228, 0.001, 0.0005623413251903491, 0.00031622776601683794, 0.00017782794100389227};
struct Chunk { int tok0, L, nseq; };
__device__ __forceinline__ Chunk chunk_of(int c) { Chunk k; k.tok0 = c * CH; if (c < NCH_P) { k.L = LP; k.nseq = CH / LP; } else { k.L = LS; k.nseq = CH / LS; } return k; }
__device__ __forceinline__ const float* xin_rows(const AV& a, int tok0) { return tok0 < NTOK_P ? AIN(I_XP) + (size_t)tok0 * DM : AIN(I_XS) + (size_t)(tok0 - NTOK_P) * DM; }
__device__ __forceinline__ void hf_group(LAS float* sm, const AV& a, int layer, int L, int t0, float* hf, int tid) {
    LAS float* zs = sm; LAS float* A = sm + 512; LAS float* B = sm + 1024;
    const float* w1 = AIN(I_FW1) + layer * 33 * 64; const float* b1 = AIN(I_FB1) + layer * 64;
    const float* w2 = AIN(I_FW2) + layer * 2 * 64 * 64; const float* b2 = AIN(I_FB2) + layer * 2 * 64;
    const float* wo = AIN(I_FWOUT) + layer * 64 * 1024; const float* fr = AIN(I_FFREQ) + layer * 64;
    const int tt = tid >> 6, j = tid & 63, t = t0 + tt;
    const float t01 = (float)t / (float)(L - 1);
    if (j < 33) {
        float v;
        if (j == 0) v = t01;
        else { const int k = (j - 1) & 15; const double f = kd(1e-4) + (double)k * kd((15.0 - 1e-4) / 15.0); float s, c; sincos_rev(f * (double)t / (double)L, s, c); v = (j <= 16) ? c : -s; }
        zs[tt * 40 + j] = v;
    }
    __syncthreads();
    const float fq = fr[j];
    { float acc = b1[j]; for (int i = 0; i < 33; ++i) acc += zs[tt * 40 + i] * w1[i * 64 + j]; A[tt * 64 + j] = sin_acc(fq * acc); }
    __syncthreads();
    { float acc = b2[j]; for (int i = 0; i < 64; ++i) acc += A[tt * 64 + i] * w2[i * 64 + j]; B[tt * 64 + j] = sin_acc(fq * acc); }
    __syncthreads();
    { float acc = b2[64 + j]; for (int i = 0; i < 64; ++i) acc += B[tt * 64 + i] * w2[4096 + i * 64 + j]; A[tt * 64 + j] = sin_acc(fq * acc); }
    __syncthreads();
    { float acc0[8], acc1[8];
#pragma unroll
      for (int q = 0; q < 8; ++q) { acc0[q] = 0.f; acc1[q] = 0.f; }
#pragma unroll 8
      for (int i = 0; i < 64; ++i) { const float wa = wo[i * 1024 + tid], wb = wo[i * 1024 + 512 + tid];
#pragma unroll
          for (int q = 0; q < 8; ++q) { const float av = A[q * 64 + i]; acc0[q] += av * wa; acc1[q] += av * wb; } }
      const float ad = 3.070113457325394f + (float)tid * ((15.350567286626973f - 3.070113457325394f) / 511.0f);
#pragma unroll
      for (int q = 0; q < 8; ++q) { const float tq = (float)(t0 + q) / (float)(L - 1); const float win = __expf(-tq * ad);
          hf[(size_t)(t0 + q) * 1024 + tid] = acc0[q] * win; hf[(size_t)(t0 + q) * 1024 + 512 + tid] = acc1[q] * win; } }
    __syncthreads();
}
__device__ __forceinline__ void step_pro_a(const AV& a, LAS unsigned char* lds) {
    const int tid = ltid(), lane = tid & 63, wave = tid >> 6, G = gridDim.x;
    unsigned char* ws = AWS;
    { f32x2* tw = (f32x2*)(ws + WS_TW); for (int m = lbid() * NT + tid; m < 16384; m += G * NT) { float s, c; sincos_rev((double)m / 16384.0, s, c); tw[m] = (f32x2){c, -s}; } }
    { f32x2* rt = (f32x2*)(ws + WS_ROPE);
      for (int e = lbid() * NT + tid; e < 8192 * 32; e += G * NT) { const int pos = e >> 5, i = e & 31; const int pp = (i < 16) ? (pos >> 6) : (pos & 63);
          const double inv = ROPE_IF[i & 15]; float sn, cs; sincos_rev((double)pp * inv * 0.15915494309189533577, sn, cs); rt[e] = (f32x2){cs, sn}; } }
    { const float* g = AIN(I_NORMG); bf16* HN0 = (bf16*)(ws + WS_HN0); f32x4 gv[4];
#pragma unroll
      for (int j = 0; j < 4; ++j) gv[j] = *((const f32x4*)g + lane + 64 * j);
      for (int m = lbid() * NWAVES + wave; m < NTOK; m += G * NWAVES) {
          const f32x4* xr = (const f32x4*)(xin_rows(a, m)) + lane; f32x4 v[4]; float ssum = 0.f;
#pragma unroll
          for (int j = 0; j < 4; ++j) { v[j] = xr[64 * j]; ssum += (v[j].x * v[j].x + v[j].y * v[j].y) + (v[j].z * v[j].z + v[j].w * v[j].w); }
          const float rs = 1.0f / sqrtf(wave_sum(ssum) * (1.0f / DM) + EPS);
          u32x2* o8 = (u32x2*)(HN0 + (size_t)m * DM) + lane;
#pragma unroll
          for (int j = 0; j < 4; ++j) { u32x2 w; w.x = pk2(v[j].x * rs * gv[j].x, v[j].y * rs * gv[j].y); w.y = pk2(v[j].z * rs * gv[j].z, v[j].w * rs * gv[j].w); o8[64 * j] = w; } } }
    { LAS float* scr = (LAS float*)(lds + wave * 16384);
      constexpr int I_IN = 16 * (UP / 32), I_MG = 16 * (GP / 32), I_BR = 8 * 32, I_OU = 16 * 32, PER = I_IN + I_MG + 3 * I_BR + I_OU;
      for (int it = lbid() * NWAVES + wave; it < 2 * PER; it += G * NWAVES) {
          const int l = it / PER; int r = it - l * PER;
          bf16* wcat = (bf16*)(ws + WS_WCAT + l * WCAT_BYTES); bf16* wbt = (bf16*)(ws + WS_WBT + l * WBT_BYTES); bf16* wot = (bf16*)(ws + WS_WOT + l * WOT_BYTES);
          if (r < I_IN) { transpose_item(AIN(I_WIN) + (size_t)l * 1024 * UP, 1024, UP, wcat, 0, scr, r, lane); continue; } r -= I_IN;
          if (r < I_MG) { transpose_item(AIN(I_WMERGE) + (size_t)l * 1024 * GP, 1024, GP, wcat, UP, scr, r, lane); continue; } r -= I_MG;
          if (r < I_BR) { transpose_item(AIN(I_WBHY) + (size_t)l * 512 * 1024, 512, 1024, wbt, 0, scr, r, lane); continue; } r -= I_BR;
          if (r < I_BR) { transpose_item(AIN(I_WBGQ) + (size_t)l * 512 * 1024, 512, 1024, wbt, 1024, scr, r, lane); continue; } r -= I_BR;
          if (r < I_BR) { transpose_item(AIN(I_WBDF) + (size_t)l * 512 * 1024, 512, 1024, wbt, 2048, scr, r, lane); continue; } r -= I_BR;
          transpose_item(AIN(I_WOUT) + (size_t)l * 1024 * 1024, 1024, 1024, wot, 0, scr, r, lane);
      } }
}
__device__ __forceinline__ void step_pro_a2(const AV& a, LAS unsigned char* lds) {
    const int tid = ltid(), G = gridDim.x; unsigned char* ws = AWS;
    { constexpr int GPL = LP / 8 + LS / 8;
      for (int g = lbid(); g < 2 * GPL; g += G) { const int l = g / GPL; int r = g - l * GPL;
          float* hfp = (float*)(ws + WS_U + l * (HF_P_BYTES + HF_S_BYTES));
          if (r < LP / 8) hf_group((LAS float*)lds, a, l, LP, r * 8, hfp, tid);
          else hf_group((LAS float*)lds, a, l, LS, (r - LP / 8) * 8, (float*)((unsigned char*)hfp + HF_P_BYTES), tid); } }
}
template <int LOG4> __device__ __forceinline__ void filt_unit(const AV& a, LAS unsigned char* lds, int layer, int pr, const float* hf, f32x2* Pg, f32x2* Mg) {
    constexpr int N = 1 << (2 * LOG4), L = N / 2;
    const int tid = ltid(); LAS f32x2* buf = (LAS f32x2*)lds; const int c0 = 2 * pr;
    for (int n = tid; n < N; n += NT) { f32x2 v = (f32x2){0.f, 0.f};
        if (n < L) v = *(const f32x2*)(hf + (size_t)n * 1024 + c0); else if (n > L) v = *(const f32x2*)(hf + (size_t)(N - n) * 1024 + 512 + c0);
        buf[PADI(n)] = v; }
    __syncthreads();
    fft_fwd<LOG4>(buf, (const f32x2*)(AWS + WS_TW), tid);
    const float ba = AIN(I_HYBIAS)[layer * 512 + c0], bb = AIN(I_HYBIAS)[layer * 512 + c0 + 1]; const float sc = 1.0f / (float)N;
    for (int k = tid; k <= L; k += NT) { const int q1 = digitrev<LOG4>(k), q2 = digitrev<LOG4>((N - k) & (N - 1)); const f32x2 z1 = buf[PADI(q1)], z2 = buf[PADI(q2)];
        f32x2 ca = (f32x2){0.5f * (z1.x + z2.x), 0.5f * (z1.y - z2.y)}; const float dx = z1.x - z2.x, dy = z1.y + z2.y; f32x2 cb = (f32x2){0.5f * dy, -0.5f * dx};
        ca.x += ba; cb.x += bb;
        Pg[k] = (f32x2){0.5f * sc * (ca.x + cb.x), 0.5f * sc * (ca.y + cb.y)}; Mg[k] = (f32x2){0.5f * sc * (ca.x - cb.x), 0.5f * sc * (ca.y - cb.y)}; }
    __syncthreads();
}
__device__ __forceinline__ void step_pro_b(const AV& a, LAS unsigned char* lds) {
    for (int u = lbid(); u < 1024; u += gridDim.x) { const int l = u >> 9, r = u & 511; unsigned char* sp = AWS + WS_SPEC + l * SPEC_LAYER; const float* hfp = (const float*)(AWS + WS_U + l * (HF_P_BYTES + HF_S_BYTES));
        if (r < 256) filt_unit<7>(a, lds, l, r, hfp, (f32x2*)sp + (size_t)r * SPS_P, (f32x2*)(sp + SPEC_P_BYTES) + (size_t)r * SPS_P);
        else { const int pr = r - 256; filt_unit<6>(a, lds, l, pr, (const float*)((const unsigned char*)hfp + HF_P_BYTES), (f32x2*)(sp + 2 * SPEC_P_BYTES) + (size_t)pr * SPS_S, (f32x2*)(sp + 2 * SPEC_P_BYTES + SPEC_S_BYTES) + (size_t)pr * SPS_S); } }
}
__device__ __forceinline__ void step_norm(const AV& a, int c, int layer) {
    const int tid = ltid(), lane = tid & 63, wave = tid >> 6; const Chunk ck = chunk_of(c);
    const float* X = layer == 0 ? xin_rows(a, ck.tok0) : AOUT + (size_t)ck.tok0 * DM; bf16* HN = (bf16*)(AWS + WS_HN); const float* g = AIN(I_NORMG) + layer * DM;
    f32x4 gv[4];
#pragma unroll
    for (int j = 0; j < 4; ++j) gv[j] = *((const f32x4*)g + lane + 64 * j);
    for (int m = lbid() * NWAVES + wave; m < CH; m += gridDim.x * NWAVES) {
        const f32x4* xr = (const f32x4*)(X + (size_t)m * DM) + lane; f32x4 v[4]; float s = 0.f;
#pragma unroll
        for (int j = 0; j < 4; ++j) { v[j] = xr[64 * j]; s += (v[j].x * v[j].x + v[j].y * v[j].y) + (v[j].z * v[j].z + v[j].w * v[j].w); }
        const float rs = 1.0f / sqrtf(wave_sum(s) * (1.0f / DM) + EPS);
        u32x2* o8 = (u32x2*)(HN + (size_t)m * DM) + lane;
#pragma unroll
        for (int j = 0; j < 4; ++j) { u32x2 w; w.x = pk2(v[j].x * rs * gv[j].x, v[j].y * rs * gv[j].y); w.y = pk2(v[j].z * rs * gv[j].z, v[j].w * rs * gv[j].w); o8[64 * j] = w; }
    }
}
__device__ __forceinline__ void step_final(const AV& a) {
    const int tid = ltid(), lane = tid & 63, wave = tid >> 6; const float* g = AIN(I_FINALG);
    f32x4 gv[4];
#pragma unroll
    for (int j = 0; j < 4; ++j) gv[j] = *((const f32x4*)g + lane + 64 * j);
    for (int m = lbid() * NWAVES + wave; m < NTOK; m += gridDim.x * NWAVES) {
        f32x4* xr = (f32x4*)(AOUT + (size_t)m * DM) + lane; f32x4 v[4]; float s = 0.f;
#pragma unroll
        for (int j = 0; j < 4; ++j) { v[j] = xr[64 * j]; s += (v[j].x * v[j].x + v[j].y * v[j].y) + (v[j].z * v[j].z + v[j].w * v[j].w); }
        const float rs = 1.0f / sqrtf(wave_sum(s) * (1.0f / DM) + EPS);
#pragma unroll
        for (int j = 0; j < 4; ++j) xr[64 * j] = v[j] * rs * gv[j];
    }
}
__device__ __forceinline__ void step_prep(const AV& a, int c, int layer) {
    const Chunk ck = chunk_of(c); bf16* U = (bf16*)(AWS + WS_U);
    for (int it = lbid() * NT + ltid(); it < CH * 10; it += gridDim.x * NT) {
        const int tok = it / 10, hd = it - tok * 10; const int pos = tok & (ck.L - 1);
        bf16* p = U + (size_t)tok * UP + (hd < 8 ? C_GQ + 64 * hd : C_GK + 64 * (hd - 8));
        const float* g = (hd < 8 ? AIN(I_QNG) : AIN(I_KNG)) + layer * 64;
        float x[64];
#pragma unroll
        for (int i = 0; i < 8; ++i) { const u32x4 w = *((const u32x4*)p + i);
            x[8 * i + 0] = bflo(w.x); x[8 * i + 1] = bfhi(w.x); x[8 * i + 2] = bflo(w.y); x[8 * i + 3] = bfhi(w.y); x[8 * i + 4] = bflo(w.z); x[8 * i + 5] = bfhi(w.z); x[8 * i + 6] = bflo(w.w); x[8 * i + 7] = bfhi(w.w); }
        float ss = 0.f;
#pragma unroll
        for (int i = 0; i < 64; ++i) ss += x[i] * x[i];
        const float rs = 1.0f / sqrtf(ss * (1.0f / 64.0f) + EPS);
#pragma unroll
        for (int i = 0; i < 64; ++i) x[i] = x[i] * rs * g[i];
        const f32x4* rt = (const f32x4*)(AWS + WS_ROPE) + (size_t)pos * 16;
#pragma unroll
        for (int i2 = 0; i2 < 16; ++i2) { const f32x4 cs2 = rt[i2];
#pragma unroll
            for (int e = 0; e < 2; ++e) { const int i = 2 * i2 + e; const float cs = e ? cs2.z : cs2.x, sn = e ? cs2.w : cs2.y; const float x1 = x[i], x2 = x[i + 32]; x[i] = x1 * cs - x2 * sn; x[i + 32] = x2 * cs + x1 * sn; } }
#pragma unroll
        for (int i = 0; i < 8; ++i) { u32x4 w; w.x = pk2(x[8 * i], x[8 * i + 1]); w.y = pk2(x[8 * i + 2], x[8 * i + 3]); w.z = pk2(x[8 * i + 4], x[8 * i + 5]); w.w = pk2(x[8 * i + 6], x[8 * i + 7]); *((u32x4*)p + i) = w; }
    }
}
__device__ __forceinline__ void step_prep_hy(const AV& a, LAS unsigned char* lds, int c, int layer) {
    const Chunk ck = chunk_of(c); const bf16* U = (const bf16*)(AWS + WS_U);
    f32x2* HVP = (f32x2*)(AWS + WS_HVP); f32x2* PMP = (f32x2*)(AWS + WS_PMP);
    const int tid = ltid(), lane = tid & 63, wave = tid >> 6;
    LAS f32x2* th = (LAS f32x2*)(lds + wave * 17408); LAS f32x2* tp = th + 64 * 17;
    const float* cw = AIN(I_CONVW) + layer * 3 * 1536; const float* cb = AIN(I_CONVB) + layer * 1536;
    for (int it = lbid() * NWAVES + wave; it < (CH / 16) * 4; it += gridDim.x * NWAVES) {
        const int cbk = it & 3, tg = it >> 2, t0 = tg * 16, ch = cbk * 128 + 2 * lane;
        const int pos0 = t0 & (ck.L - 1);
        float w[3][3][2], bb[3][2];
#pragma unroll
        for (int ar = 0; ar < 3; ++ar) {
#pragma unroll
            for (int j = 0; j < 3; ++j) { const f32x2 v = *(const f32x2*)(cw + j * 1536 + ar * 512 + ch); w[ar][j][0] = v.x; w[ar][j][1] = v.y; }
            const f32x2 v = *(const f32x2*)(cb + ar * 512 + ch); bb[ar][0] = v.x; bb[ar][1] = v.y; }
        const bf16* r0 = U + (size_t)t0 * UP + ch;
        unsigned pv[3], cv[3], nv[3];
#pragma unroll
        for (int ar = 0; ar < 3; ++ar) { pv[ar] = pos0 > 0 ? *(const unsigned*)(r0 - UP + ar * 512) : 0u; cv[ar] = *(const unsigned*)(r0 + ar * 512); }
#pragma unroll 4
        for (int t = 0; t < 16; ++t) {
            const bf16* rt = r0 + (size_t)t * UP; const bool last = (pos0 + t + 1 >= ck.L);
#pragma unroll
            for (int ar = 0; ar < 3; ++ar) nv[ar] = last ? 0u : *(const unsigned*)(rt + UP + ar * 512);
            const unsigned gw = *(const unsigned*)(rt + C_HG);
            float o[3][2];
#pragma unroll
            for (int ar = 0; ar < 3; ++ar) { o[ar][0] = w[ar][0][0] * bflo(pv[ar]) + w[ar][1][0] * bflo(cv[ar]) + w[ar][2][0] * bflo(nv[ar]) + bb[ar][0];
                o[ar][1] = w[ar][0][1] * bfhi(pv[ar]) + w[ar][1][1] * bfhi(cv[ar]) + w[ar][2][1] * bfhi(nv[ar]) + bb[ar][1]; pv[ar] = cv[ar]; cv[ar] = nv[ar]; }
            th[lane * 17 + t] = (f32x2){o[2][0] * o[1][0], o[2][1] * o[1][1]};
            tp[lane * 17 + t] = (f32x2){o[0][0] * silu(bflo(gw)), o[0][1] * silu(bfhi(gw))};
        }
        asm volatile("s_waitcnt lgkmcnt(0)" ::: "memory");
#pragma unroll 4
        for (int i = 0; i < 16; ++i) { const int pl = 4 * i + (lane >> 4), tt = lane & 15; const size_t o = (size_t)(cbk * 64 + pl) * CH + t0 + tt;
            HVP[o] = th[pl * 17 + tt]; PMP[o] = tp[pl * 17 + tt]; }
        asm volatile("s_waitcnt lgkmcnt(0)" ::: "memory");
    }
}
typedef short bf16x8 __attribute__((ext_vector_type(8)));
typedef short s16x4 __attribute__((ext_vector_type(4)));
typedef float f32x16 __attribute__((ext_vector_type(16)));
typedef float f32x2_t __attribute__((ext_vector_type(2)));
typedef __bf16 bf16x2_t __attribute__((ext_vector_type(2)));
__device__ __forceinline__ unsigned cvtpk(float lo, float hi) { f32x2_t v = {lo, hi}; bf16x2_t b = __builtin_convertvector(v, bf16x2_t); return __builtin_bit_cast(unsigned, b); }
__device__ __forceinline__ int crow(int r, int hi) { return (r & 3) + 8 * (r >> 2) + 4 * hi; }
__device__ __forceinline__ s16x4 vtr(const LAS unsigned char* p) { return __builtin_bit_cast(s16x4, __builtin_amdgcn_ds_read_tr16_b64_v4i16((LAS s16x4*)p)); }
constexpr int ATT_K = 0;
constexpr int ATT_TB_DIFF = 4 * 8192 + 4 * 16384;
constexpr float C1 = 0.125f * LOG2E;
__device__ __forceinline__ void glds16(const void* gsrc, unsigned lds_dst) { unsigned keep;
    asm volatile("s_mov_b32 %0, m0\n\ts_mov_b32 m0, %2\n\ts_nop 0\n\tglobal_load_lds_dwordx4 %1, off\n\ts_mov_b32 m0, %0" : "=&s"(keep) : "v"(gsrc), "s"(lds_dst) : "memory"); }

template <int VD, bool BIAS, bool OMAX, int G>
__device__ __forceinline__ void flash_pass(LAS unsigned char* lds, const bf16* Qrow, const bf16* Kg, const bf16* Vg, int L, int qpos, int qw0, float bl, float br, f32x16 (&o)[VD / 32], float& l_out) {
    const int tid = ltid(), lane = tid & 63, r32 = lane & 31, hi = lane >> 5;
    constexpr int VROW = VD * 2, VT = 64 * VROW, NVL = VD / 64, NSL = 2 * G, ATT_V = NSL * 8192, ATT_TB = ATT_V + NSL * VT;
    const LAS float* tb = (const LAS float*)(lds + ATT_TB);
    typedef const __attribute__((address_space(1))) u32x4* g4p;
    const int wv = __builtin_amdgcn_readfirstlane(tid >> 6); const int ldsa = (int)(unsigned)(uintptr_t)lds;
    const bf16* ksrc; { const int X = wv * 1024 + lane * 16, line = X >> 8, c16 = ((X >> 4) & 15) ^ (line & 15), key = 2 * line + (c16 >> 3), ch = c16 & 7; ksrc = Kg + (size_t)key * UP + ch * 8; }
    const bf16* vsrc[NVL];
#pragma unroll
    for (int i = 0; i < NVL; ++i) { const int X = i * 8192 + wv * 1024 + lane * 16; const int key = (VD == 64) ? (X >> 7) : (X >> 8), posb = (VD == 64) ? (X & 127) : (X & 255);
        const int swz = (VD == 64) ? (((key >> 1) & 1) << 6) : ((key & 3) << 6); vsrc[i] = Vg + (size_t)key * UP + ((posb ^ swz) >> 1); }
#define ATT_DMA(tt_, sl_) do { const size_t go_ = (size_t)(tt_) * 64 * UP; \
        glds16(ksrc + go_, (unsigned)__builtin_amdgcn_readfirstlane(ldsa + ATT_K + (sl_) * 8192 + wv * 1024)); \
        _Pragma("unroll") for (int i_ = 0; i_ < NVL; ++i_) glds16(vsrc[i_] + go_, (unsigned)__builtin_amdgcn_readfirstlane(ldsa + ATT_V + (sl_) * VT + i_ * 8192 + wv * 1024)); } while (0)
#define ATT_DMAGROUP(g_) do { _Pragma("unroll") for (int j_ = 0; j_ < G; ++j_) { const int tt_ = (g_) * G + j_; ATT_DMA(tt_, tt_ & (NSL - 1)); } } while (0)
#define ATT_BAR() do { __builtin_amdgcn_s_barrier(); asm volatile("" ::: "memory"); } while (0)
    int koff[2][4];
#pragma unroll
    for (int kb = 0; kb < 2; ++kb)
#pragma unroll
        for (int s = 0; s < 4; ++s) { const int key = 32 * kb + r32, line = key >> 1, c16 = ((key & 1) << 3) | (2 * s + hi); koff[kb][s] = line * 256 + ((c16 ^ (line & 15)) << 4); }
    const int q4 = (lane & 15) >> 2, p4 = lane & 3, g1 = (lane >> 4) & 1;
    const int vsw = (VD == 64) ? ((q4 >> 1) & 1) : q4;
    const int vbase = (4 * hi + q4) * VROW + 32 * g1 + 8 * p4;
    bf16x8 qf[4];
#pragma unroll
    for (int s = 0; s < 4; ++s) qf[s] = __builtin_bit_cast(bf16x8, *(g4p)(Qrow + 16 * s + 8 * hi));
    float m_run = OMAX ? -1e30f : 0.f, l_run = 0.f;
    const int nt = L >> 6;
    asm volatile("" :: "v"(qf[0]), "v"(qf[1]), "v"(qf[2]), "v"(qf[3]) : "memory");
    asm volatile("s_waitcnt vmcnt(0)" ::: "memory");
    const int ng = nt / G;
    ATT_DMAGROUP(0); if (ng > 1) ATT_DMAGROUP(1);
    if (ng > 1) { if (G * (1 + NVL) == 8) asm volatile("s_waitcnt vmcnt(8)" ::: "memory"); else asm volatile("s_waitcnt vmcnt(6)" ::: "memory"); } else asm volatile("s_waitcnt vmcnt(0)" ::: "memory");
    static_assert(G * (1 + NVL) == 8 || G * (1 + NVL) == 6, "vmcnt immediates above");
    ATT_BAR();
#pragma unroll 1
    for (int t = 0; t < nt; ++t) {
        const int cur = t & (NSL - 1);
        const LAS unsigned char* kbuf = lds + ATT_K + cur * 8192; const LAS unsigned char* vbuf = lds + ATT_V + cur * VT;
        f32x16 p[2];
        { bf16x8 kf[2][4];
#pragma unroll
          for (int kb = 0; kb < 2; ++kb)
#pragma unroll
            for (int s = 0; s < 4; ++s) kf[kb][s] = *(const LAS bf16x8*)(kbuf + koff[kb][s]);
          __builtin_amdgcn_sched_barrier(0);
#pragma unroll
          for (int kb = 0; kb < 2; ++kb) { f32x16 acc;
#pragma unroll
            for (int r = 0; r < 16; ++r) acc[r] = 0.f;
#pragma unroll
            for (int s = 0; s < 4; ++s) acc = __builtin_amdgcn_mfma_f32_32x32x16_bf16(kf[kb][s], qf[s], acc, 0, 0, 0);
            p[kb] = acc; } }
        s16x4 vlo[2][4], vhi[2][4];
#define VREAD(buf_, db_) do { const int cofs_ = (((db_) ^ vsw) << 6); _Pragma("unroll") for (int kb = 0; kb < 2; ++kb) _Pragma("unroll") for (int ss = 0; ss < 2; ++ss) { \
            const LAS unsigned char* vp_ = vbuf + vbase + (32 * kb + 16 * ss) * VROW + cofs_; vlo[buf_][2 * kb + ss] = vtr(vp_); vhi[buf_][2 * kb + ss] = vtr(vp_ + 8 * VROW); } } while (0)
        VREAD(0, 0);
        __builtin_amdgcn_sched_barrier(0);
        const int k0 = t * 64; float mulc, bconst, mx = -3e38f; bool nearT = false;
        if (BIAS) { const int rlo = k0 - qw0 - 31, rhi = k0 + 63 - qw0; nearT = !(rhi <= -128 || rlo >= 128); }
        if (BIAS && nearT) {
#pragma unroll
            for (int kb = 0; kb < 2; ++kb)
#pragma unroll
                for (int r4 = 0; r4 < 4; ++r4) {
#pragma unroll
                    for (int e = 0; e < 4; ++e) { const int r = 4 * r4 + e; int rel = k0 + 32 * kb + crow(r, hi) - qpos; rel = rel < -128 ? -128 : (rel > 128 ? 128 : rel); const float v = p[kb][r] * C1 + tb[rel + 128]; p[kb][r] = v; mx = fmaxf(mx, v); }
                    __builtin_amdgcn_sched_barrier(0); }
            mulc = 1.0f; bconst = 0.f;
        } else {
            if (OMAX) {
#pragma unroll
                for (int kb = 0; kb < 2; ++kb)
#pragma unroll
                    for (int r = 0; r < 16; ++r) mx = fmaxf(mx, p[kb][r]); }
            bconst = BIAS ? (k0 < qw0 ? bl : br) : 0.f; mx = mx * C1 + bconst; mulc = C1;
        }
        if (OMAX) {
            mx = fmaxf(mx, __shfl_xor(mx, 32));
            if (__any(mx > m_run)) { const float mn = fmaxf(m_run, mx), al = __builtin_amdgcn_exp2f(m_run - mn); l_run *= al;
#pragma unroll
                for (int db = 0; db < VD / 32; ++db) o[db] *= al;
                m_run = mn; }
        }
        const f32x2 mul2 = (f32x2){mulc, mulc}, add2 = (f32x2){bconst - m_run, bconst - m_run}; f32x2 ls2 = (f32x2){0.f, 0.f};
#pragma unroll
        for (int kb = 0; kb < 2; ++kb)
#pragma unroll
            for (int r = 0; r < 16; r += 2) { f32x2 v = (f32x2){p[kb][r], p[kb][r + 1]}; v = v * mul2 + add2; f32x2 e; e.x = __builtin_amdgcn_exp2f(v.x); e.y = __builtin_amdgcn_exp2f(v.y); ls2 += e; p[kb][r] = e.x; p[kb][r + 1] = e.y; }
        l_run += ls2.x + ls2.y;
        bf16x8 pk[2][2];
#pragma unroll
        for (int kb = 0; kb < 2; ++kb)
#pragma unroll
            for (int ss = 0; ss < 2; ++ss) { u32x4 w; w.x = cvtpk(p[kb][8 * ss + 0], p[kb][8 * ss + 1]); w.y = cvtpk(p[kb][8 * ss + 2], p[kb][8 * ss + 3]); w.z = cvtpk(p[kb][8 * ss + 4], p[kb][8 * ss + 5]); w.w = cvtpk(p[kb][8 * ss + 6], p[kb][8 * ss + 7]);
                pk[kb][ss] = __builtin_bit_cast(bf16x8, w); }
        __builtin_amdgcn_sched_barrier(0);
#pragma unroll
        for (int db = 0; db < VD / 32; ++db) {
            if (db + 1 < VD / 32) { if ((db + 1) & 1) VREAD(1, db + 1); else VREAD(0, db + 1); }
#pragma unroll
            for (int kb = 0; kb < 2; ++kb)
#pragma unroll
                for (int ss = 0; ss < 2; ++ss) { const bf16x8 vf = (db & 1) ? __builtin_shufflevector(vlo[1][2 * kb + ss], vhi[1][2 * kb + ss], 0, 1, 2, 3, 4, 5, 6, 7) : __builtin_shufflevector(vlo[0][2 * kb + ss], vhi[0][2 * kb + ss], 0, 1, 2, 3, 4, 5, 6, 7);
                    o[db] = __builtin_amdgcn_mfma_f32_32x32x16_bf16(vf, pk[kb][ss], o[db], 0, 0, 0); }
            __builtin_amdgcn_sched_barrier(0); }
#undef VREAD
        if (((t + 1) & (G - 1)) == 0) {
            asm volatile("s_waitcnt vmcnt(0)" ::: "memory"); ATT_BAR();
            const int g2 = (t + 1) / G + 1; if (g2 < ng) ATT_DMAGROUP(g2); }
    }
#undef ATT_DMA
#undef ATT_DMAGROUP
#undef ATT_BAR
    l_out = l_run + __shfl_xor(l_run, 32);
}
__device__ __forceinline__ void gqa_unit(const AV& a, LAS unsigned char* lds, int seqrow0, int L, int h, int qb) {
    const int tid = ltid(), lane = tid & 63, wave = tid >> 6, r32 = lane & 31, hi = lane >> 5;
    const bf16* U = (const bf16*)(AWS + WS_U); bf16* Y = (bf16*)(AWS + WS_Y) + (size_t)1 * CH * 512;
    const int qw0 = qb * 256 + wave * 32, qpos = qw0 + r32; const size_t row = (size_t)(seqrow0 + qpos);
    f32x16 o[2];
#pragma unroll
    for (int db = 0; db < 2; ++db)
#pragma unroll
        for (int r = 0; r < 16; ++r) o[db][r] = 0.f;
    float l;
    flash_pass<64, false, false, 4>(lds, U + row * UP + C_GQ + 64 * h, U + (size_t)seqrow0 * UP + C_GK + 64 * (h >> 2), U + (size_t)seqrow0 * UP + C_GV + 64 * (h >> 2), L, qpos, qw0, 0.f, 0.f, o, l);
    const float inv = 1.0f / l;
#pragma unroll
    for (int db = 0; db < 2; ++db)
#pragma unroll
        for (int g = 0; g < 4; ++g) { const int d = 32 * db + 8 * g + 4 * hi; const u32x2 gw = *(const u32x2*)(U + row * UP + C_GG + 64 * h + d);
            const float y0 = o[db][4 * g] * inv * silu(bflo(gw.x)), y1 = o[db][4 * g + 1] * inv * silu(bfhi(gw.x)), y2 = o[db][4 * g + 2] * inv * silu(bflo(gw.y)), y3 = o[db][4 * g + 3] * inv * silu(bfhi(gw.y));
            u32x2 w; w.x = cvtpk(y0, y1); w.y = cvtpk(y2, y3); *(u32x2*)(Y + row * 512 + 64 * h + d) = w; }
}
__device__ __forceinline__ void diff_unit(const AV& a, LAS unsigned char* lds, int seqrow0, int L, int h, int qb, int layer) {
    const int tid = ltid(), lane = tid & 63, wave = tid >> 6, r32 = lane & 31, hi = lane >> 5;
    const bf16* U = (const bf16*)(AWS + WS_U); bf16* Y = (bf16*)(AWS + WS_Y) + (size_t)2 * CH * 512; float* DT = (float*)(AWS + WS_DT);
    const float* relb = AIN(I_RELB);
    LAS float* tb = (LAS float*)(lds + ATT_TB_DIFF);
    for (int i = tid; i < 257; i += NT) { const int rel = i - 128, n = rel < 0 ? -rel : rel; int b = rel > 0 ? 16 : 0;
        if (n < 8) b += n; else { const int v = 8 + (31 - __builtin_clz((unsigned)(n * n))) - 6; b += v < 15 ? v : 15; }
        tb[i] = relb[b * 4 + h] * LOG2E; }
    const float bl = relb[15 * 4 + h] * LOG2E, br = relb[31 * 4 + h] * LOG2E;
    const float li = 0.8f - 0.6f * __expf(-0.3f * (float)layer);
    float d1, d2; { const float q1 = AIN(I_LQ1)[layer * 64 + lane], k1 = AIN(I_LK1)[layer * 64 + lane], q2 = AIN(I_LQ2)[layer * 64 + lane], k2 = AIN(I_LK2)[layer * 64 + lane]; d1 = wave_sum(q1 * k1); d2 = wave_sum(q2 * k2); }
    const float lam = __expf(d1) - __expf(d2) + li;
    const int qw0 = qb * 256 + wave * 32, qpos = qw0 + r32; const size_t row = (size_t)(seqrow0 + qpos);
    __syncthreads();
    f32x16 o[4]; float l; float ss = 0.f;
#pragma unroll 1
    for (int c = 0; c < 2; ++c) {
#pragma unroll
        for (int db = 0; db < 4; ++db)
#pragma unroll
            for (int r = 0; r < 16; ++r) o[db][r] = 0.f;
        flash_pass<128, true, true, 2>(lds, U + row * UP + C_DQ + 128 * h + 64 * c, U + (size_t)seqrow0 * UP + C_DK + 128 * h + 64 * c, U + (size_t)seqrow0 * UP + C_DV + 128 * h, L, qpos, qw0, bl, br, o, l);
        if (c == 0) { const float inv = 1.0f / l;
#pragma unroll
            for (int db = 0; db < 4; ++db)
#pragma unroll
                for (int g = 0; g < 4; ++g) { const int d = 32 * db + 8 * g + 4 * hi; *(f32x4*)(DT + row * 512 + 128 * h + d) = (f32x4){o[db][4 * g] * inv, o[db][4 * g + 1] * inv, o[db][4 * g + 2] * inv, o[db][4 * g + 3] * inv}; }
        } else { const float inv = lam / l;
#pragma unroll
            for (int db = 0; db < 4; ++db)
#pragma unroll
                for (int g = 0; g < 4; ++g) { const int d = 32 * db + 8 * g + 4 * hi; const f32x4 o0 = *(const f32x4*)(DT + row * 512 + 128 * h + d);
#pragma unroll
                    for (int e = 0; e < 4; ++e) { const float v = o0[e] - o[db][4 * g + e] * inv; o[db][4 * g + e] = v; ss += v * v; } }
        }
    }
    ss += __shfl_xor(ss, 32);
    const float rs = (1.0f / sqrtf(ss * (1.0f / 128.0f) + EPS)) * (1.0f - li);
    const float* sg = AIN(I_SUBLN) + layer * 128;
#pragma unroll
    for (int db = 0; db < 4; ++db)
#pragma unroll
        for (int g = 0; g < 4; ++g) { const int d = 32 * db + 8 * g + 4 * hi; const u32x2 gw = *(const u32x2*)(U + row * UP + C_DG + 128 * h + d); const f32x4 gn = *(const f32x4*)(sg + d);
            const float y0 = o[db][4 * g] * rs * gn.x * silu(bflo(gw.x)), y1 = o[db][4 * g + 1] * rs * gn.y * silu(bfhi(gw.x)), y2 = o[db][4 * g + 2] * rs * gn.z * silu(bflo(gw.y)), y3 = o[db][4 * g + 3] * rs * gn.w * silu(bfhi(gw.y));
            u32x2 w; w.x = cvtpk(y0, y1); w.y = cvtpk(y2, y3); *(u32x2*)(Y + row * 512 + 128 * h + d) = w; }
}
template <int LOG4, int BATCH> __device__ __forceinline__ void hyena_unit(const AV& a, LAS unsigned char* lds, int seqrow0, int pr0, int layer) {
    constexpr int N = 1 << (2 * LOG4), L = N / 2, NPAD = N + N / 16;
    const int tid = ltid(); LAS f32x2* buf = (LAS f32x2*)lds;
    bf16* Y = (bf16*)(AWS + WS_Y) + (size_t)seqrow0 * 512;
    const unsigned char* sp = AWS + WS_SPEC + layer * SPEC_LAYER;
    constexpr int SPS = (LOG4 == 7) ? SPS_P : SPS_S;
    const f32x2* Pg = ((LOG4 == 7) ? (const f32x2*)sp : (const f32x2*)(sp + 2 * SPEC_P_BYTES)) + (size_t)pr0 * SPS;
    const f32x2* Mg = ((LOG4 == 7) ? (const f32x2*)(sp + SPEC_P_BYTES) : (const f32x2*)(sp + 2 * SPEC_P_BYTES + SPEC_S_BYTES)) + (size_t)pr0 * SPS;
    const f32x2* hvp = (const f32x2*)(AWS + WS_HVP) + (size_t)pr0 * CH + seqrow0; const f32x2* pmp = (const f32x2*)(AWS + WS_PMP) + (size_t)pr0 * CH + seqrow0;
#pragma unroll
    for (int b = 0; b < BATCH; ++b)
        for (int t = tid; t < L; t += NT) { buf[b * NPAD + PADI(t)] = hvp[(size_t)b * CH + t]; buf[b * NPAD + PADI(t + L)] = (f32x2){0.f, 0.f}; }
    __syncthreads();
    const f32x2* tw = (const f32x2*)(AWS + WS_TW);
    fft_fwd<LOG4, BATCH>(buf, tw, tid);
#pragma unroll
    for (int b = 0; b < BATCH; ++b)
        for (int k = tid; k <= L; k += NT) { const int p1 = b * NPAD + PADI(digitrev<LOG4>(k)), p2 = b * NPAD + PADI(digitrev<LOG4>((N - k) & (N - 1))); const f32x2 z1 = buf[p1], z2 = buf[p2], P = Pg[(size_t)b * SPS + k], M = Mg[(size_t)b * SPS + k];
            const f32x2 y1 = cmul(z1, P) + cmul(cconj(z2), M), y2 = cmulc(z2, P) + cmulc(cconj(z1), M);
            buf[p1] = y1; if (p2 != p1) buf[p2] = y2; }
    __syncthreads();
    fft_inv<LOG4, BATCH>(buf, tw, tid);
    for (int t = tid; t < L; t += NT) { unsigned w[BATCH];
#pragma unroll
        for (int b = 0; b < BATCH; ++b) { const f32x2 y = buf[b * NPAD + PADI(t)], m = pmp[(size_t)b * CH + t]; w[b] = cvtpk(y.x * m.x, y.y * m.y); }
        if (BATCH == 4) *(u32x4*)(Y + (size_t)t * 512 + 2 * pr0) = (u32x4){w[0], w[BATCH > 1 ? 1 : 0], w[BATCH > 2 ? 2 : 0], w[BATCH > 3 ? 3 : 0]};
        else *(unsigned*)(Y + (size_t)t * 512 + 2 * pr0) = w[0]; }
    __syncthreads();
}
#define XB_TMO      128
#define XB_XCNT(j)  (256  + 64 * (j))
#define XB_XSUB(j)  (1280 + 64 * (j))
#define XB_XGEN(j)  (2304 + 64 * (j))
#define XB_TOP      3328
#define XB_TOPGEN   3392
#define XCD_BAR_WORDS 3456
#define XB_SPIN_CAP (1u << 18)

__device__ __forceinline__ unsigned xb_ld(unsigned* p)              { return __hip_atomic_load(p, __ATOMIC_RELAXED, __HIP_MEMORY_SCOPE_AGENT); }
__device__ __forceinline__ unsigned xb_add(unsigned* p, unsigned v) { return __hip_atomic_fetch_add(p, v, __ATOMIC_RELAXED, __HIP_MEMORY_SCOPE_AGENT); }
__device__ __forceinline__ unsigned xb_xcc_id() { return (unsigned)__builtin_amdgcn_s_getreg((3 << 11) | 20) & 0xFu; }
#define XB_SPIN(cond, bar) do { unsigned _sp = 0; while (cond) { __builtin_amdgcn_s_sleep(1); \
    if ((++_sp & 255u) == 0u) { if (xb_ld(&(bar)[XB_TMO])) break; if (_sp > XB_SPIN_CAP) { atomicAdd(&(bar)[XB_TMO], 1u); break; } } } } while (0)

struct XcdBarrier {
    unsigned* bar; unsigned x;
    volatile LAS unsigned* st;
};

__device__ __forceinline__ XcdBarrier xcd_barrier_post(unsigned* bar, volatile LAS unsigned* st) {
    XcdBarrier b; b.bar = bar; b.x = xb_xcc_id(); b.st = st;
    if (threadIdx.x == 0) (void)xb_add(&bar[XB_XCNT(b.x)], 1u);
    return b;
}
__device__ __forceinline__ void xcd_barrier_complete(unsigned* bar, unsigned x, unsigned& nloc, unsigned& nx) {
    const unsigned G = gridDim.x * gridDim.y * gridDim.z;
    unsigned sum, cnt, mine, sp = 0u;
    for (;;) {
        sum = 0u; cnt = 0u; mine = 0u;
#pragma unroll
        for (unsigned j = 0; j < 16; ++j) { const unsigned c = xb_ld(&bar[XB_XCNT(j)]); sum += c; cnt += (c > 0u) ? 1u : 0u; mine = (j == x) ? c : mine; }
        if (sum == G) break;
        __builtin_amdgcn_s_sleep(1);
        if ((++sp & 255u) == 0u) { if (xb_ld(&bar[XB_TMO])) break; if (sp > XB_SPIN_CAP) { atomicAdd(&bar[XB_TMO], 1u); break; } }
    }
    nloc = mine > 0u ? mine : 1u; nx = cnt > 0u ? cnt : 1u;
}

__device__ __forceinline__ void xcd_barrier(const XcdBarrier& b) {
    asm volatile("s_waitcnt vmcnt(0)" ::: "memory");
    __syncthreads();
    if (threadIdx.x == 0) {
        unsigned* bar = b.bar;
        __builtin_amdgcn_s_waitcnt(0);
        unsigned nloc = b.st[0], nx = b.st[1];
        if (nloc == 0u) { xcd_barrier_complete(bar, b.x, nloc, nx); b.st[0] = nloc; b.st[1] = nx; }
        const unsigned old = xb_add(&bar[XB_XSUB(b.x)], 1u);
        const unsigned gen = old / nloc;
        if (old + 1u == (gen + 1u) * nloc) {
            __builtin_amdgcn_fence(__ATOMIC_RELEASE, "agent");
            asm volatile("s_waitcnt vmcnt(0)" ::: "memory");
            const unsigned og = xb_add(&bar[XB_TOP], 1u);
            const unsigned tg = og / nx;
            if (og + 1u == (tg + 1u) * nx) xb_add(&bar[XB_TOPGEN], 1u);
            else XB_SPIN(xb_ld(&bar[XB_TOPGEN]) == tg, bar);
            __builtin_amdgcn_fence(__ATOMIC_ACQUIRE, "agent");
            xb_add(&bar[XB_XGEN(b.x)], 1u);
            asm volatile("s_waitcnt vmcnt(0)" ::: "memory");
        } else {
            XB_SPIN(xb_ld(&bar[XB_XGEN(b.x)]) == gen, bar);
            __builtin_amdgcn_fence(__ATOMIC_ACQUIRE, "agent");
            asm volatile("s_waitcnt vmcnt(0)" ::: "memory");
        }
    }
    __syncthreads();
}

__device__ __forceinline__ void step_mix(const AV& a, LAS unsigned char* lds, int c, int layer, unsigned* ctr, int tmask) {
    const Chunk ck = chunk_of(c); const int nqb = ck.L / 256, nD = ck.nseq * 4 * nqb, nG = ck.nseq * 8 * nqb, nF = (ck.L == LP) ? ck.nseq * 256 : ck.nseq * 64, total = nD + nG + nF;
    volatile LAS unsigned* wq = (volatile LAS unsigned*)(lds + LDS_MAIN);
    for (;;) {
        if (ltid() == 0) wq[0] = atomicAdd(ctr, 1u);
        __syncthreads();
        const int u = (int)wq[0];
        __syncthreads();
        if (u >= total) break;
        if (u < nD) { if (tmask & 1) { const int qb = u % nqb, sh = u / nqb, h = sh & 3, s = sh >> 2; diff_unit(a, lds, s * ck.L, ck.L, h, qb, layer); } }
        else if (u < nD + nG) { if (tmask & 2) { const int v = u - nD, qb = v % nqb, sh = v / nqb, h = sh & 7, s = sh >> 3; gqa_unit(a, lds, s * ck.L, ck.L, h, qb); } }
        else { if (tmask & 4) { const int v = u - nD - nG; if (ck.L == LP) hyena_unit<7, 1>(a, lds, (v >> 8) * LP, v & 255, layer); else hyena_unit<6, 4>(a, lds, (v >> 6) * LS, (v & 63) * 4, layer); } }
    }
}
constexpr int STEPS_PER = 6, NPRO = 3, NSTEPS = NPRO + NCHUNK * 2 * STEPS_PER + 1;
__global__ void __launch_bounds__(NT, 2) mega_fwd(Args kargs) {
    extern __shared__ __attribute__((aligned(16))) unsigned char lds_raw[];
    LAS unsigned char* lds = (LAS unsigned char*)lds_raw;
    cg::grid_group grid = cg::this_grid();
    kargp_t kp = (kargp_t)__builtin_amdgcn_kernarg_segment_ptr();
    { volatile LAS unsigned* misc = (volatile LAS unsigned*)(lds + LDS_MAIN + 64); if (ltid() < 16) misc[ltid()] = 0u; }
    __syncthreads();
    XcdBarrier xbar = xcd_barrier_post((unsigned*)(kargs.ws + WS_CTL) + CW_BAR, (volatile LAS unsigned*)(lds + LDS_MAIN + 64 + 32));
    const int step_lo = kargs.lo, step_hi = kargs.hi;
#pragma unroll 1
    for (int step = step_lo; step < step_hi; ++step) {
        asm volatile("" : "+s"(kp));
        AV a; a.p = kp; unsigned char* ws = AWS;
        if (step == 0) { if (EN(0)) step_pro_a(a, lds); }
        else if (step == 1) { if (EN(11)) { step_pro_a2(a, lds); if (DUP_MASK & 32) { xcd_barrier(xbar); step_pro_a2(a, lds); } } }
        else if (step == 2) { if (EN(1)) { step_pro_b(a, lds); if (DUP_MASK & 64) { xcd_barrier(xbar); step_pro_b(a, lds); } } }
        else if (step == NSTEPS - 1) { if (DUP_MASK & 256) { for (int q = 0; q < 100; ++q) xcd_barrier(xbar); } if (EN(2)) step_final(a); }
        else {
            const int s2 = step - NPRO, cl = s2 / STEPS_PER, k = s2 - cl * STEPS_PER, c = cl >> 1, layer = cl & 1;
            const Chunk ck = chunk_of(c);
            if (k == 0) { if (layer == 0) continue;
                if (EN(3)) { step_norm(a, c, layer); if (DUP_MASK & 128) { xcd_barrier(xbar); step_norm(a, c, layer); } } }
            else if (k == 2) { if (EN(5)) { step_prep(a, c, layer); step_prep_hy(a, lds, c, layer); } }
            else if (k == 3) {
#pragma unroll 1
                for (int rep = 0; rep < ((DUP_MASK & 7) ? 2 : 1); ++rep) { if (rep) xcd_barrier(xbar); step_mix(a, lds, c, layer, (unsigned*)(ws + WS_CTL) + step * 16 + 4 * rep, rep ? (DUP_MASK & 7) : 7); } }
            else { if (EN(4)) {
                pg8::Gemm g; pg8::OrderAll S; pg8::EpiAll E; const int G = (int)gridDim.x, bid = lbid();
                S.so.init(CH, k == 1 ? NCAT : 1024, G, bid); S.o2 = pg8::OrderG2{CH / 256, G, bid}; S.mode = (k == 4) ? 2 : 1;
                float* O = AOUT + (size_t)ck.tok0 * DM; const float* X = layer == 0 ? xin_rows(a, ck.tok0) : O;
                E.mode = (k == 1) ? 1 : (k == 4) ? 2 : 3;
                E.e1 = pg8::EpiG1{(pg8::bf16_t*)(ws + WS_U), (pg8::bf16_t*)(ws + WS_G), AIN(I_BMERGE) + layer * GP};
                E.e2 = pg8::EpiG2{(const pg8::bf16_t*)(ws + WS_G), (float*)(ws + WS_TMP), (pg8::bf16_t*)(ws + WS_MG), CH / 256};
                E.e3 = pg8::EpiG3{X, O};
                if (k == 1) g = pg8::Gemm{layer == 0 ? (const pg8::bf16_t*)(ws + WS_HN0) + (size_t)ck.tok0 * DM : (const pg8::bf16_t*)(ws + WS_HN), (const pg8::bf16_t*)(ws + WS_WCAT + layer * WCAT_BYTES), CH, NCAT, 1024};
                else if (k == 4) g = pg8::Gemm{(const pg8::bf16_t*)(ws + WS_Y), (const pg8::bf16_t*)(ws + WS_WBT + layer * WBT_BYTES), 3 * CH, 3072, 512};
                else g = pg8::Gemm{(const pg8::bf16_t*)(ws + WS_MG), (const pg8::bf16_t*)(ws + WS_WOT + layer * WOT_BYTES), CH, 1024, 1024};
                const int nrep = (((DUP_MASK & 8) && k == 1) || ((DUP_MASK & 16) && k == 4)) ? 2 : 1;
#pragma unroll 1
                for (int rep = 0; rep < nrep; ++rep) { if (rep) xcd_barrier(xbar); pg8::gemm_phase<pg8::EpiAll, pg8::OrderAll, true, true>(lds, g, S, E); }
            } }
        }
        if (step + 1 < step_hi) { if (step == 0) grid.sync(); else xcd_barrier(xbar); }
    }
}
#ifndef MK_MULTI
#define MK_MULTI 0
#endif
extern "C" void kernel_launch(void* const* d_in, const int* in_sizes, int n_in, void* d_out, int out_size, void* d_ws, size_t ws_size, hipStream_t stream) {
    static int grid = 0;
    if (grid == 0) {
        if (n_in != N_IN || out_size != NTOK * DM || ws_size < WS_END) { fprintf(stderr, "kernel_launch: unexpected shapes (n_in %d, out %d, ws %zu)\n", n_in, out_size, ws_size); grid = -1; return; }
        int dev = 0, cus = 0, per_cu = 0;
        hipGetDevice(&dev); hipDeviceGetAttribute(&cus, hipDeviceAttributeMultiprocessorCount, dev);
        if (hipFuncSetAttribute((const void*)mega_fwd, hipFuncAttributeMaxDynamicSharedMemorySize, LDS_BYTES) != hipSuccess) { fprintf(stderr, "kernel_launch: hipFuncSetAttribute failed\n"); grid = -1; return; }
        hipOccupancyMaxActiveBlocksPerMultiprocessor(&per_cu, (const void*)mega_fwd, NT, LDS_BYTES);
        (void)hipGetLastError();
        if (per_cu < 1) per_cu = 1;
        grid = cus * 1;
        fprintf(stderr, "kernel_launch: cus %d per_cu %d grid %d\n", cus, per_cu, grid);
    }
    if (grid < 0) return;
    hipMemsetAsync((char*)d_ws + WS_CTL, 0, CTL_BYTES, stream);
    Args a{};
    for (int i = 0; i < N_IN; ++i) a.in[i] = (const float*)d_in[i];
    a.out = (float*)d_out; a.ws = (unsigned char*)d_ws;
#if MK_MULTI
    for (int s = 0; s < NSTEPS; ++s) { a.lo = s; a.hi = s + 1; hipLaunchKernelGGL(mega_fwd, dim3(grid), dim3(NT), LDS_BYTES, stream, a); }
#else
    a.lo = 0; a.hi = NSTEPS;
    void* args[] = {&a};
    hipError_t e = hipLaunchCooperativeKernel((const void*)mega_fwd, dim3(grid), dim3(NT), args, LDS_BYTES, stream);
    if (e != hipSuccess) fprintf(stderr, "cooperative launch failed: %s (grid %d)\n", hipGetErrorString(e), grid);
#endif
}
```

```cpp
#include <hip/hip_runtime.h>
#include <hip/hip_cooperative_groups.h>
#include <cstdio>
#include <cstdint>
namespace cg = cooperative_groups;
__device__ __forceinline__ int ltid() { int t = (int)threadIdx.x; asm volatile("" : "+v"(t)); return t; }
__device__ __forceinline__ int lbid() { int b = (int)blockIdx.x; asm volatile("" : "+s"(b)); return b; }
namespace pg8 {
#define PG8_LAS __attribute__((address_space(3)))
typedef unsigned short bf16_t;
typedef short bf16x8 __attribute__((ext_vector_type(8)));
typedef float f32x4 __attribute__((ext_vector_type(4)));
typedef unsigned u32x4 __attribute__((ext_vector_type(4)));
constexpr int BM = 256, BK = 64, HALF = 128, HTB = HALF * BK * 2  , STAGE_BYTES = 8 * HTB, NXCD = 8, WGM = 8;

__host__ __device__ __forceinline__ int lds_byte(int r, int c) { const int st = (r >> 4) * 2 + (c >> 5), rr = r & 15, cc = c & 31, ob = rr * 64 + cc * 2; return st * 1024 + (ob ^ (((ob >> 9) & 1) << 5)); }
__host__ __device__ __forceinline__ void stage_rc(int b, int& R, int& C) { const int st = b / 1024, sb = b % 1024, swz = sb ^ (((sb >> 9) & 1) << 5); R = (st >> 1) * 16 + swz / 64; C = (st & 1) * 32 + (swz % 64) / 2; }
__host__ __device__ __forceinline__ int perm32(int rho) { const int n = rho >> 4, i = rho & 15; return 8 * (i >> 2) + 4 * n + (i & 3); }

struct Unit { int pm, pn; };
struct Gemm { const bf16_t* A; const bf16_t* Bt; int M, N, K; };

struct StaticOrder {
    int nM, nN, nwg, G, c;
    __host__ __device__ void init(int M, int N, int G_, int c_) { nM = M / BM; nN = N / BM; nwg = nM * nN; G = G_; c = c_; }
    __host__ __device__ bool next(int i, Unit& u) const {
        const long L = (long)i * G + c; if (L >= nwg) return false;
        int wgid = (int)L; { const int q = nwg / NXCD, r = nwg % NXCD, xcd = wgid % NXCD, off = wgid / NXCD; wgid = (xcd < r ? xcd * (q + 1) : r * (q + 1) + (xcd - r) * q) + off; }
        const int nig = WGM * nN, gid = wgid / nig, fm = gid * WGM, gsz = (nM - fm) < WGM ? (nM - fm) : WGM;
        u.pm = fm + ((wgid % nig) % gsz); u.pn = (wgid % nig) / gsz; return true;
    }
    __device__ __forceinline__ void a_ready(const Unit&) const {}
    __device__ __forceinline__ void done(const Unit&) const {}
};

__device__ __forceinline__ unsigned cvt_pk_bf16(float lo, float hi) { unsigned r; asm volatile("v_cvt_pk_bf16_f32 %0, %1, %2" : "=v"(r) : "v"(lo), "v"(hi)); return r; }
template <class Epi, class Sched, bool ALIGN_EPI = false, bool SP2 = false>
__device__ __forceinline__ void gemm_phase(PG8_LAS unsigned char* lds, const Gemm g, const Sched& S, const Epi& E) {
    const int tid = ltid(), wid = __builtin_amdgcn_readfirstlane(tid >> 6), lane = tid & 63, wr = wid >> 2, wc = wid & 3, fr = lane & 15, fq = lane >> 4;
    const int K = g.K, nt = K / BK;
    unsigned voffA[2], voffB[2];
#pragma unroll
    for (int i = 0; i < 2; ++i) { int R, C; stage_rc(tid * 16 + i * 8192, R, C); const int Rb = Epi::PERM ? ((R & ~31) + perm32(R & 31)) : R;
        voffA[i] = (unsigned)(R * K + C) * 2u; voffB[i] = (unsigned)(Rb * K + C) * 2u; }
    const size_t kstep = (size_t)(BK * 2);
    const size_t hstep = (size_t)HALF * K * 2;
    const size_t tstep = 2 * hstep;
    const unsigned ldsw = (unsigned)wid * 1024u;
    const int aoff = lds_byte(wr * 64 + fr, fq * 8), boff = lds_byte(wc * 32 + fr, fq * 8);
#define PG8_SA(b, h) (((b) * 2 + (h)) * HTB)
#define PG8_SB(b, h) ((4 + (b) * 2 + (h)) * HTB)
#define PG8_STAGE(bufoff, gbase, voff) do { _Pragma("unroll") for (int _i = 0; _i < 2; ++_i) \
        __builtin_amdgcn_global_load_lds((const unsigned*)((const char*)(gbase) + (voff)[_i]), (PG8_LAS unsigned*)(lds + (bufoff) + ldsw + _i * 8192), 16, 0, 0); } while (0)
#define PG8_LDA(dst, b, h) do { _Pragma("unroll") for (int m = 0; m < 4; ++m) _Pragma("unroll") for (int k = 0; k < 2; ++k) dst[m][k] = *(const PG8_LAS bf16x8*)(lds + PG8_SA(b, h) + aoff + m * 2048 + k * 1024); } while (0)
#define PG8_LDB(dst, b, h) do { _Pragma("unroll") for (int n = 0; n < 2; ++n) _Pragma("unroll") for (int k = 0; k < 2; ++k) dst[n][k] = *(const PG8_LAS bf16x8*)(lds + PG8_SB(b, h) + boff + n * 2048 + k * 1024); } while (0)
#define PG8_MMA(ai, bj, At, Bt) do { __builtin_amdgcn_s_setprio(1); _Pragma("unroll") for (int m = 0; m < 4; ++m) _Pragma("unroll") for (int n = 0; n < 2; ++n) _Pragma("unroll") for (int k = 0; k < 2; ++k) \
        acc[ai][bj][m][n] = __builtin_amdgcn_mfma_f32_16x16x32_bf16(Bt[n][k], At[m][k], acc[ai][bj][m][n], 0, 0, 0); __builtin_amdgcn_s_setprio(0); } while (0)
#define PG8_WAIT_V(n) asm volatile("s_waitcnt vmcnt(" #n ")" ::: "memory")
#define PG8_WAIT_L(n) asm volatile("s_waitcnt lgkmcnt(" #n ")" ::: "memory")
#define PG8_BAR __builtin_amdgcn_s_barrier()
#define PG8_SCHED __builtin_amdgcn_sched_barrier(0)
    Unit cur, nxt; int ui = 0;
    if (!S.next(0, cur)) return;
    f32x4 acc[2][2][4][2];
#pragma unroll
    for (int a = 0; a < 2; ++a)
#pragma unroll
        for (int b = 0; b < 2; ++b)
#pragma unroll
            for (int m = 0; m < 4; ++m)
#pragma unroll
                for (int n = 0; n < 2; ++n) acc[a][b][m][n] = (f32x4){0.f, 0.f, 0.f, 0.f};
    bf16x8 At[4][2], B0[2][2], B1[2][2];
    const char* cA = (const char*)g.A + (size_t)cur.pm * tstep; const char* cB = (const char*)g.Bt + (size_t)cur.pn * tstep;
    S.a_ready(cur);
    if constexpr (SP2) {
        PG8_STAGE(PG8_SB(0, 0), cB, voffB); PG8_STAGE(PG8_SB(0, 1), cB + hstep, voffB); PG8_STAGE(PG8_SA(0, 0), cA, voffA); PG8_STAGE(PG8_SA(0, 1), cA + hstep, voffA);
        if (wr == 1) PG8_BAR;
        PG8_WAIT_V(2); PG8_BAR;
        PG8_STAGE(PG8_SB(1, 0), cB + kstep, voffB); PG8_STAGE(PG8_SA(1, 0), cA + kstep, voffA); PG8_STAGE(PG8_SB(1, 1), cB + hstep + kstep, voffB);
        PG8_WAIT_V(6); PG8_BAR;
    } else {
        PG8_STAGE(PG8_SB(0, 0), cB, voffB); PG8_STAGE(PG8_SA(0, 0), cA, voffA); PG8_STAGE(PG8_SB(0, 1), cB + hstep, voffB); PG8_STAGE(PG8_SA(0, 1), cA + hstep, voffA);
        if (wr == 1) PG8_BAR;
        PG8_WAIT_V(4); PG8_BAR;
        PG8_STAGE(PG8_SB(1, 0), cB + kstep, voffB); PG8_STAGE(PG8_SA(1, 0), cA + kstep, voffA); PG8_STAGE(PG8_SB(1, 1), cB + hstep + kstep, voffB);
        PG8_WAIT_V(6); PG8_BAR;
    }
    for (;;) {
        const bool has_next = S.next(ui + 1, nxt);
        const char* nA = has_next ? (const char*)g.A + (size_t)nxt.pm * tstep : cA; const char* nB = has_next ? (const char*)g.Bt + (size_t)nxt.pn * tstep : cB;
        for (int t = 0; t < nt; t += 2) {
            const bool last = (t == nt - 2);
            const char* a1 = cA + (size_t)(t + 1) * kstep;
            const char* a2 = last ? nA : cA + (size_t)(t + 2) * kstep; const char* b2 = last ? nB : cB + (size_t)(t + 2) * kstep;
            const char* a3 = a2 + kstep; const char* b3 = b2 + kstep;
            if (last && has_next) S.a_ready(nxt);
            if constexpr (SP2) {
            PG8_LDB(B0, 0, 0); PG8_LDB(B1, 0, 1); PG8_SCHED; PG8_LDA(At, 0, 0); PG8_STAGE(PG8_SA(1, 1), a1 + hstep, voffA);
            PG8_WAIT_V(8); PG8_WAIT_L(0); PG8_BAR; PG8_MMA(0, 0, At, B0); PG8_MMA(0, 1, At, B1); PG8_BAR; PG8_SCHED;
            PG8_LDA(At, 0, 1); PG8_STAGE(PG8_SB(0, 0), b2, voffB); PG8_STAGE(PG8_SB(0, 1), b2 + hstep, voffB); PG8_STAGE(PG8_SA(0, 0), a2, voffA);
            PG8_WAIT_V(8); PG8_WAIT_L(0); PG8_BAR; PG8_MMA(1, 0, At, B0); PG8_MMA(1, 1, At, B1); PG8_BAR; PG8_SCHED;
            PG8_LDB(B0, 1, 0); PG8_LDB(B1, 1, 1); PG8_SCHED; PG8_LDA(At, 1, 0); PG8_STAGE(PG8_SA(0, 1), a2 + hstep, voffA);
            PG8_WAIT_V(8); PG8_WAIT_L(0); PG8_BAR; PG8_MMA(0, 0, At, B0); PG8_MMA(0, 1, At, B1); PG8_BAR; PG8_SCHED;
            PG8_LDA(At, 1, 1); PG8_STAGE(PG8_SB(1, 0), b3, voffB); PG8_STAGE(PG8_SB(1, 1), b3 + hstep, voffB); PG8_STAGE(PG8_SA(1, 0), a3, voffA);
            PG8_WAIT_V(8); PG8_WAIT_L(0); PG8_BAR; PG8_MMA(1, 0, At, B0); PG8_MMA(1, 1, At, B1); PG8_BAR; PG8_SCHED;
            } else {
            PG8_LDB(B0, 0, 0); PG8_SCHED; PG8_LDA(At, 0, 0); PG8_STAGE(PG8_SA(1, 1), a1 + hstep, voffA);
            PG8_WAIT_L(8); PG8_BAR; PG8_WAIT_L(0); PG8_MMA(0, 0, At, B0); PG8_BAR; PG8_SCHED;
            PG8_LDB(B1, 0, 1); PG8_STAGE(PG8_SB(0, 0), b2, voffB);
            PG8_BAR; PG8_WAIT_L(0); PG8_MMA(0, 1, At, B1); PG8_BAR;
            PG8_LDA(At, 0, 1); PG8_STAGE(PG8_SA(0, 0), a2, voffA);
            PG8_BAR; PG8_WAIT_L(0); PG8_MMA(1, 0, At, B0); PG8_BAR; PG8_SCHED;
            PG8_STAGE(PG8_SB(0, 1), b2 + hstep, voffB);
            PG8_WAIT_V(6); PG8_BAR; PG8_MMA(1, 1, At, B1); PG8_BAR;
            PG8_LDB(B0, 1, 0); PG8_SCHED; PG8_LDA(At, 1, 0); PG8_STAGE(PG8_SA(0, 1), a2 + hstep, voffA);
            PG8_WAIT_L(8); PG8_BAR; PG8_WAIT_L(0); PG8_MMA(0, 0, At, B0); PG8_BAR; PG8_SCHED;
            PG8_LDB(B1, 1, 1); PG8_STAGE(PG8_SB(1, 0), b3, voffB);
            PG8_BAR; PG8_WAIT_L(0); PG8_MMA(0, 1, At, B1); PG8_BAR;
            PG8_LDA(At, 1, 1); PG8_STAGE(PG8_SA(1, 0), a3, voffA);
            PG8_BAR; PG8_WAIT_L(0); PG8_MMA(1, 0, At, B0); PG8_BAR; PG8_SCHED;
            PG8_STAGE(PG8_SB(1, 1), b3 + hstep, voffB);
            PG8_WAIT_V(6); PG8_BAR; PG8_MMA(1, 1, At, B1); PG8_BAR;
            }
        }
        if constexpr (ALIGN_EPI) { if (wr == 0) PG8_BAR; }
        if constexpr (!Epi::AFTER_DRAIN) { E(acc, cur, wr, wc, fr, fq); S.done(cur); }
        if (!has_next) break;
#pragma unroll
        for (int a = 0; a < 2; ++a)
#pragma unroll
            for (int b = 0; b < 2; ++b)
#pragma unroll
                for (int m = 0; m < 4; ++m)
#pragma unroll
                    for (int n = 0; n < 2; ++n) acc[a][b][m][n] = (f32x4){0.f, 0.f, 0.f, 0.f};
        cur = nxt; cA = nA; cB = nB; ++ui;
        if constexpr (ALIGN_EPI) { if (wr == 1) PG8_BAR; }
    }
    PG8_WAIT_V(0);
    if constexpr (!ALIGN_EPI) { if (wr == 0) PG8_BAR; }
    PG8_BAR;
    if constexpr (Epi::AFTER_DRAIN) { E.fused(acc, cur, wr, wc, fr, fq, lds, wid, lane); S.done(cur); }
#undef PG8_SA
#undef PG8_SB
#undef PG8_STAGE
#undef PG8_LDA
#undef PG8_LDB
#undef PG8_MMA
#undef PG8_WAIT_V
#undef PG8_WAIT_L
#undef PG8_BAR
#undef PG8_SCHED
}
__device__ __forceinline__ float bf2f(unsigned short h) { return __uint_as_float(((unsigned)h) << 16); }
__device__ __forceinline__ float fast_sigmoid(float x) { return __builtin_amdgcn_rcpf(1.0f + __builtin_amdgcn_exp2f(-1.4426950408889634f * x)); }
struct EpiG1 {
    static constexpr bool PERM = true, AFTER_DRAIN = false;
    bf16_t* U; bf16_t* G; const float* bias;
    __device__ __forceinline__ void operator()(const f32x4 (&acc)[2][2][4][2], const Unit& u, int wr, int wc, int fr, int fq) const {
        const int row0 = u.pm * BM + wr * 64 + fr; int colt = u.pn * BM; const bool isg = colt >= 5376;
        bf16_t* base = U; int ldc = 5376; if (isg) { colt -= 5376; base = G; ldc = 3072; }
        const int col0 = colt + wc * 32 + 8 * fq;
        f32x4 bv[2][2];
#pragma unroll
        for (int bj = 0; bj < 2; ++bj)
#pragma unroll
            for (int n = 0; n < 2; ++n) bv[bj][n] = isg ? *(const f32x4*)(bias + col0 + bj * HALF + 4 * n) : (f32x4){0.f, 0.f, 0.f, 0.f};
#pragma unroll
        for (int ai = 0; ai < 2; ++ai)
#pragma unroll
            for (int m = 0; m < 4; ++m) { bf16_t* rowp = base + (size_t)(row0 + ai * HALF + m * 16) * ldc + col0;
#pragma unroll
                for (int bj = 0; bj < 2; ++bj) { f32x4 v0 = acc[ai][bj][m][0] + bv[bj][0], v1 = acc[ai][bj][m][1] + bv[bj][1];
                    if (isg) {
#pragma unroll
                        for (int e = 0; e < 4; ++e) { v0[e] = fast_sigmoid(v0[e]); v1[e] = fast_sigmoid(v1[e]); } }
                    u32x4 w; w.x = cvt_pk_bf16(v0[0], v0[1]); w.y = cvt_pk_bf16(v0[2], v0[3]); w.z = cvt_pk_bf16(v1[0], v1[1]); w.w = cvt_pk_bf16(v1[2], v1[3]);
                    *(u32x4*)(rowp + bj * HALF) = w; } }
    }
};
struct EpiG2 {
    static constexpr bool PERM = true, AFTER_DRAIN = false;
    const bf16_t* G; float* T; bf16_t* Mg; int npan;
    __device__ __forceinline__ void operator()(const f32x4 (&acc)[2][2][4][2], const Unit& u, int wr, int wc, int fr, int fq) const {
        const int b = u.pm / npan, pm = u.pm - b * npan, pn = u.pn & 3;
        const int row0 = pm * BM + wr * 64 + fr, col0 = pn * BM + wc * 32 + 8 * fq;
#pragma unroll
        for (int ai = 0; ai < 2; ++ai)
#pragma unroll
            for (int m = 0; m < 4; ++m) { const size_t row = (size_t)(row0 + ai * HALF + m * 16);
#pragma unroll
                for (int bj = 0; bj < 2; ++bj) { const int col = col0 + bj * HALF;
                    const u32x4 g = *(const u32x4*)(G + row * 3072 + b * 1024 + col);
                    f32x4 v0 = acc[ai][bj][m][0], v1 = acc[ai][bj][m][1];
                    v0[0] *= __uint_as_float(g.x << 16); v0[1] *= __uint_as_float(g.x & 0xffff0000u); v0[2] *= __uint_as_float(g.y << 16); v0[3] *= __uint_as_float(g.y & 0xffff0000u);
                    v1[0] *= __uint_as_float(g.z << 16); v1[1] *= __uint_as_float(g.z & 0xffff0000u); v1[2] *= __uint_as_float(g.w << 16); v1[3] *= __uint_as_float(g.w & 0xffff0000u);
                    bf16_t* mp = Mg + row * 1024 + col;
                    if (b > 0) { const u32x4 t = *(const u32x4*)mp;
                        v0[0] += __uint_as_float(t.x << 16); v0[1] += __uint_as_float(t.x & 0xffff0000u); v0[2] += __uint_as_float(t.y << 16); v0[3] += __uint_as_float(t.y & 0xffff0000u);
                        v1[0] += __uint_as_float(t.z << 16); v1[1] += __uint_as_float(t.z & 0xffff0000u); v1[2] += __uint_as_float(t.w << 16); v1[3] += __uint_as_float(t.w & 0xffff0000u); }
                    u32x4 w; w.x = cvt_pk_bf16(v0[0], v0[1]); w.y = cvt_pk_bf16(v0[2], v0[3]); w.z = cvt_pk_bf16(v1[0], v1[1]); w.w = cvt_pk_bf16(v1[2], v1[3]);
                    *(u32x4*)mp = w; } }
    }
};
struct OrderG2 {
    int npan, G, c;
    __device__ bool next(int i, Unit& u) const { const int ti = i / 3, b = i - 3 * ti, t = ti * G + c; if (t >= npan * 4) return false;
        const int pm = t >> 2, pn = t & 3; u.pm = b * npan + pm; u.pn = b * 4 + pn; return true; }
    __device__ __forceinline__ void a_ready(const Unit&) const {}
    __device__ __forceinline__ void done(const Unit&) const {}
};
struct EpiG3 {
    static constexpr bool PERM = true, AFTER_DRAIN = false;
    const float* X; float* O;
    __device__ __forceinline__ void operator()(const f32x4 (&acc)[2][2][4][2], const Unit& u, int wr, int wc, int fr, int fq) const {
        const int row0 = u.pm * BM + wr * 64 + fr, col0 = u.pn * BM + wc * 32 + 8 * fq;
#pragma unroll
        for (int ai = 0; ai < 2; ++ai)
#pragma unroll
            for (int m = 0; m < 4; ++m) { const size_t row = (size_t)(row0 + ai * HALF + m * 16);
#pragma unroll
                for (int bj = 0; bj < 2; ++bj) { const size_t p = row * 1024 + col0 + bj * HALF;
                    const f32x4 x0 = *(const f32x4*)(X + p), x1 = *(const f32x4*)(X + p + 4);
                    *(f32x4*)(O + p) = x0 + acc[ai][bj][m][0]; *(f32x4*)(O + p + 4) = x1 + acc[ai][bj][m][1]; } }
    }
};
struct EpiAll {
    static constexpr bool PERM = true, AFTER_DRAIN = false;
    int mode; EpiG1 e1; EpiG2 e2; EpiG3 e3;
    __device__ __forceinline__ void operator()(const f32x4 (&acc)[2][2][4][2], const Unit& u, int wr, int wc, int fr, int fq) const {
        if (mode == 1) e1(acc, u, wr, wc, fr, fq); else if (mode == 2) e2(acc, u, wr, wc, fr, fq); else e3(acc, u, wr, wc, fr, fq); }
};
struct OrderAll {
    int mode; StaticOrder so; OrderG2 o2;
    __device__ __forceinline__ bool next(int i, Unit& u) const { return mode == 2 ? o2.next(i, u) : so.next(i, u); }
    __device__ __forceinline__ void a_ready(const Unit&) const {}
    __device__ __forceinline__ void done(const Unit&) const {}
};
}
#ifndef DUP_MASK
#define DUP_MASK 0
#endif
#ifndef EN_MASK
#define EN_MASK 0xffff
#endif
#define EN(i) ((EN_MASK >> (i)) & 1)
#define LAS __attribute__((address_space(3)))
typedef unsigned short bf16;
typedef float f32x4 __attribute__((ext_vector_type(4)));
typedef float f32x2 __attribute__((ext_vector_type(2)));
typedef unsigned u32x4 __attribute__((ext_vector_type(4)));
typedef unsigned u32x2 __attribute__((ext_vector_type(2)));
constexpr int DM = 1024, NTOK_P = 65536, NTOK_S = 32768, NTOK = NTOK_P + NTOK_S, LP = 8192, LS = 2048;
constexpr int CH = 16384, NCHUNK = NTOK / CH, NCH_P = NTOK_P / CH;
constexpr int UP = 5376, NCAT = 8448, GP = 3072;
constexpr int C_X0 = 0, C_X1 = 512, C_HV = 1024, C_HG = 1536, C_GQ = 2048, C_GK = 2560, C_GV = 2688, C_GG = 2816, C_DQ = 3328, C_DK = 3840, C_DV = 4352, C_DG = 4864;
constexpr float EPS = 1e-6f, LOG2E = 1.4426950408889634f;
constexpr int NT = 512, NWAVES = 8;
enum { I_XP = 0, I_XS, I_RELB, I_NORMG, I_WIN, I_CONVW, I_CONVB, I_FW1, I_FB1, I_FW2, I_FB2, I_FWOUT, I_FFREQ, I_HYBIAS, I_QNG, I_KNG, I_LQ1, I_LK1, I_LQ2, I_LK2, I_SUBLN, I_WBHY, I_WBGQ, I_WBDF, I_WMERGE, I_BMERGE, I_WOUT, I_FINALG, N_IN };
constexpr size_t MiB = 1u << 20;
constexpr size_t WS_CTL = 0, CTL_BYTES = 64 * 1024;
constexpr size_t WS_TW = 1 * MiB;
constexpr size_t WS_WCAT = 2 * MiB, WCAT_BYTES = (size_t)NCAT * 1024 * 2;
constexpr size_t WS_WBT = 40 * MiB, WBT_BYTES = (size_t)3 * 1024 * 512 * 2;
constexpr size_t WS_WOT = 46 * MiB, WOT_BYTES = (size_t)1024 * 1024 * 2;
constexpr int SPS_P = LP + 16, SPS_S = LS + 16;
constexpr size_t SPEC_P_BYTES = (size_t)256 * SPS_P * 8, SPEC_S_BYTES = (size_t)256 * SPS_S * 8;
constexpr size_t SPEC_LAYER = 2 * SPEC_P_BYTES + 2 * SPEC_S_BYTES;
constexpr size_t WS_SPEC = 52 * MiB;
constexpr size_t WS_HN = 140 * MiB, WS_U = 172 * MiB, WS_G = 340 * MiB, WS_Y = 436 * MiB, WS_MG = 484 * MiB, WS_TMP = 516 * MiB, WS_DT = 580 * MiB, WS_HVP = 612 * MiB, WS_PMP = 644 * MiB, WS_ROPE = 676 * MiB, WS_HN0 = 680 * MiB, WS_END = 872 * MiB;
constexpr size_t HF_P_BYTES = (size_t)LP * 1024 * 4, HF_S_BYTES = (size_t)LS * 1024 * 4;
static_assert(WS_WCAT + 2 * WCAT_BYTES <= WS_WBT && WS_WBT + 2 * WBT_BYTES <= WS_WOT && WS_WOT + 2 * WOT_BYTES <= WS_SPEC && WS_SPEC + 2 * SPEC_LAYER <= WS_HN, "ws map");
static_assert(WS_HN + (size_t)CH * 1024 * 2 <= WS_U && WS_U + (size_t)CH * UP * 2 <= WS_G && WS_G + (size_t)CH * GP * 2 <= WS_Y && WS_Y + (size_t)3 * CH * 512 * 2 <= WS_MG && WS_MG + (size_t)CH * 1024 * 2 <= WS_TMP && WS_TMP + (size_t)CH * 1024 * 4 <= WS_DT && WS_DT + (size_t)CH * 512 * 4 <= WS_END, "ws map 2");
static_assert(2 * (HF_P_BYTES + HF_S_BYTES) <= (size_t)CH * UP * 2, "hf overlay");
constexpr int LDS_MAIN = 139264, LDS_BYTES = LDS_MAIN + 1024;
constexpr int CW_BAR = 4096;

struct Args { const float* in[N_IN]; float* out; unsigned char* ws; int lo, hi; };
typedef const __attribute__((address_space(4))) unsigned long long* kargp_t;
struct AV { kargp_t p; };
#define AIN(i) ((const float*)(a.p[(i)]))
#define AOUT ((float*)(a.p[N_IN]))
#define AWS ((unsigned char*)(a.p[N_IN + 1]))


__device__ __forceinline__ float bf2f(unsigned short h) { return __uint_as_float(((unsigned)h) << 16); }
__device__ __forceinline__ float bflo(unsigned w) { return __uint_as_float(w << 16); }
__device__ __forceinline__ float bfhi(unsigned w) { return __uint_as_float(w & 0xffff0000u); }
__device__ __forceinline__ unsigned f2bf(float f) { unsigned u = __builtin_bit_cast(unsigned, f); return (u + 0x7fffu + ((u >> 16) & 1u)) >> 16; }
__device__ __forceinline__ unsigned pk2(float lo, float hi) { return f2bf(lo) | (f2bf(hi) << 16); }
__device__ __forceinline__ float silu(float x) { return x * __builtin_amdgcn_rcpf(1.0f + __builtin_amdgcn_exp2f(-LOG2E * x)); }
__device__ __forceinline__ float wave_sum(float v) {
#pragma unroll
    for (int o = 1; o < 64; o <<= 1) v += __shfl_xor(v, o);
    return v;
}
__device__ __forceinline__ double kd(double v) { asm volatile("" : "+s"(v)); return v; }
__device__ __forceinline__ void sincos_rev(double r, float& s, float& c) {
    r -= __builtin_rint(r);
    const double k = __builtin_rint(r * 4.0);
    const double x = (r - k * 0.25) * kd(6.283185307179586476925);
    const double x2 = x * x;
    double sp = kd(1.0 / 6227020800.0); sp = sp * x2 + kd(-1.0 / 39916800); sp = sp * x2 + kd(1.0 / 362880); sp = sp * x2 + kd(-1.0 / 5040); sp = sp * x2 + kd(1.0 / 120); sp = sp * x2 + kd(-1.0 / 6); sp = sp * x2 + 1.0; sp *= x;
    double cp = kd(-1.0 / 87178291200.0); cp = cp * x2 + kd(1.0 / 479001600.0); cp = cp * x2 + kd(-1.0 / 3628800); cp = cp * x2 + kd(1.0 / 40320); cp = cp * x2 + kd(-1.0 / 720); cp = cp * x2 + kd(1.0 / 24); cp = cp * x2 + (-0.5); cp = cp * x2 + 1.0;
    const int q = ((int)k) & 3;
    const float sf = (float)sp, cf = (float)cp;
    s = (q == 0) ? sf : (q == 1) ? cf : (q == 2) ? -sf : -cf;
    c = (q == 0) ? cf : (q == 1) ? -sf : (q == 2) ? -cf : sf;
}
__device__ __forceinline__ float sin_acc(float x) { float s, c; sincos_rev((double)x * 0.15915494309189533577, s, c); return s; }

__device__ __forceinline__ void transpose_item(const float* W, int K, int N, bf16* WT, int row_off, LAS float* scr, int item, int lane) {
    const int nblk = N / 32, kb = item / nblk, nb = item % nblk, k0 = 64 * kb, n0 = 32 * nb;
#pragma unroll 8
    for (int i = 0; i < 32; ++i) { const int kk = 2 * i + (lane >> 5); scr[kk * 33 + (lane & 31)] = W[(size_t)(k0 + kk) * N + n0 + (lane & 31)]; }
    asm volatile("s_waitcnt lgkmcnt(0)" ::: "memory");
    const int c = lane & 7;
#pragma unroll
    for (int j = 0; j < 4; ++j) { const int n = (lane >> 3) + 8 * j; const LAS float* s = scr + (8 * c) * 33 + n;
        u32x4 o; o.x = pk2(s[0 * 33], s[1 * 33]); o.y = pk2(s[2 * 33], s[3 * 33]); o.z = pk2(s[4 * 33], s[5 * 33]); o.w = pk2(s[6 * 33], s[7 * 33]);
        *(u32x4*)(WT + (size_t)(row_off + n0 + n) * K + k0 + 8 * c) = o; }
    asm volatile("s_waitcnt lgkmcnt(0)" ::: "memory");
}

__device__ __forceinline__ f32x2 cmul(f32x2 a, f32x2 b) { return (f32x2){a.x * b.x - a.y * b.y, a.x * b.y + a.y * b.x}; }
__device__ __forceinline__ f32x2 cmulc(f32x2 a, f32x2 b) { return (f32x2){a.x * b.x + a.y * b.y, a.y * b.x - a.x * b.y}; }
__device__ __forceinline__ f32x2 cconj(f32x2 a) { return (f32x2){a.x, -a.y}; }
template <int LOG4> __device__ __forceinline__ int digitrev(int k) { unsigned x = __builtin_bitreverse32((unsigned)k) >> (32 - 2 * LOG4); return (int)(((x & 0x55555555u) << 1) | ((x >> 1) & 0x55555555u)); }
#define PADI(i) ((i) + ((i) >> 4))
#define W16C 0.92387953251128674f
#define W16S 0.38268343236508977f
#define W16H 0.70710678118654752f
__device__ __forceinline__ f32x2 w16(int m) { return m == 0 ? (f32x2){1.f, 0.f} : m == 1 ? (f32x2){W16C, -W16S} : m == 2 ? (f32x2){W16H, -W16H} : m == 3 ? (f32x2){W16S, -W16C} : m == 4 ? (f32x2){0.f, -1.f} : m == 6 ? (f32x2){-W16H, -W16H} : (f32x2){-W16C, W16S}; }
__device__ __forceinline__ void bfly_fwd(f32x2& a0, f32x2& a1, f32x2& a2, f32x2& a3) {
    const f32x2 t0 = a0 + a2, t1 = a0 - a2, t2 = a1 + a3, t3 = a1 - a3;
    a0 = t0 + t2; a2 = t0 - t2; a1 = (f32x2){t1.x + t3.y, t1.y - t3.x}; a3 = (f32x2){t1.x - t3.y, t1.y + t3.x};
}
__device__ __forceinline__ void bfly_inv(f32x2& b0, f32x2& b1, f32x2& b2, f32x2& b3) {
    const f32x2 t0 = b0 + b2, t1 = b0 - b2, t2 = b1 + b3, t3 = b1 - b3;
    b0 = t0 + t2; b2 = t0 - t2; b1 = (f32x2){t1.x - t3.y, t1.y + t3.x}; b3 = (f32x2){t1.x + t3.y, t1.y - t3.x};
}
template <int LOG4, int BATCH = 1> __device__ __forceinline__ void fft_fwd(LAS f32x2* buf, const f32x2* __restrict__ tw, int tid) {
    constexpr int N = 1 << (2 * LOG4), TWS = 16384 / N;
#pragma unroll 1
    for (int pass = 0; pass < LOG4 - 2; ++pass) {
        const int lq = 2 * (LOG4 - pass) - 2, q4 = 1 << lq, n = q4 << 2, tstep = TWS << (2 * pass);
        constexpr int IT = BATCH * N / 4 / NT, NPAD = N + N / 16;
        f32x2 wl[IT];
#pragma unroll
        for (int i = 0; i < IT; ++i) wl[i] = tw[((tid + i * NT) & (q4 - 1)) * tstep];
#pragma unroll
        for (int i = 0; i < IT; ++i) { const int jg = tid + i * NT, bo = (jg >> (2 * LOG4 - 2)) * NPAD, j = jg & (N / 4 - 1);
            const int blk = j >> lq, jj = j & (q4 - 1), base = blk * n + jj;
            const int i0 = bo + PADI(base), i1 = bo + PADI(base + q4), i2 = bo + PADI(base + 2 * q4), i3 = bo + PADI(base + 3 * q4);
            const f32x2 w1 = wl[i];
            f32x2 a0 = buf[i0], a1 = buf[i1], a2 = buf[i2], a3 = buf[i3];
            bfly_fwd(a0, a1, a2, a3);
            const f32x2 w2 = cmul(w1, w1), w3 = cmul(w2, w1);
            buf[i0] = a0; buf[i1] = cmul(a1, w1); buf[i2] = cmul(a2, w2); buf[i3] = cmul(a3, w3);
        }
        __syncthreads();
    }
#pragma unroll 1
    for (int b = tid; b < BATCH * N / 16; b += NT) {
        LAS f32x2* xb = buf + 17 * b; f32x2 x[16];
#pragma unroll
        for (int e = 0; e < 16; ++e) x[e] = xb[e];
#pragma unroll
        for (int jj = 0; jj < 4; ++jj) { bfly_fwd(x[jj], x[jj + 4], x[jj + 8], x[jj + 12]); if (jj) { x[jj + 4] = cmul(x[jj + 4], w16(jj)); x[jj + 8] = cmul(x[jj + 8], w16(2 * jj)); x[jj + 12] = cmul(x[jj + 12], w16(3 * jj)); } }
#pragma unroll
        for (int q = 0; q < 4; ++q) bfly_fwd(x[4 * q], x[4 * q + 1], x[4 * q + 2], x[4 * q + 3]);
#pragma unroll
        for (int e = 0; e < 16; ++e) xb[e] = x[e];
    }
    __syncthreads();
}
template <int LOG4, int BATCH = 1> __device__ __forceinline__ void fft_inv(LAS f32x2* buf, const f32x2* __restrict__ tw, int tid) {
    constexpr int N = 1 << (2 * LOG4), TWS = 16384 / N;
#pragma unroll 1
    for (int b = tid; b < BATCH * N / 16; b += NT) {
        LAS f32x2* xb = buf + 17 * b; f32x2 x[16];
#pragma unroll
        for (int e = 0; e < 16; ++e) x[e] = xb[e];
#pragma unroll
        for (int q = 0; q < 4; ++q) bfly_inv(x[4 * q], x[4 * q + 1], x[4 * q + 2], x[4 * q + 3]);
#pragma unroll
        for (int jj = 0; jj < 4; ++jj) { if (jj) { x[jj + 4] = cmulc(x[jj + 4], w16(jj)); x[jj + 8] = cmulc(x[jj + 8], w16(2 * jj)); x[jj + 12] = cmulc(x[jj + 12], w16(3 * jj)); } bfly_inv(x[jj], x[jj + 4], x[jj + 8], x[jj + 12]); }
#pragma unroll
        for (int e = 0; e < 16; ++e) xb[e] = x[e];
    }
    __syncthreads();
#pragma unroll 1
    for (int pass = LOG4 - 3; pass >= 0; --pass) {
        const int lq = 2 * (LOG4 - pass) - 2, q4 = 1 << lq, n = q4 << 2, tstep = TWS << (2 * pass);
        constexpr int IT = BATCH * N / 4 / NT, NPAD = N + N / 16;
        f32x2 wl[IT];
#pragma unroll
        for (int i = 0; i < IT; ++i) wl[i] = tw[((tid + i * NT) & (q4 - 1)) * tstep];
#pragma unroll
        for (int i = 0; i < IT; ++i) { const int jg = tid + i * NT, bo = (jg >> (2 * LOG4 - 2)) * NPAD, j = jg & (N / 4 - 1);
            const int blk = j >> lq, jj = j & (q4 - 1), base = blk * n + jj;
            const int i0 = bo + PADI(base), i1 = bo + PADI(base + q4), i2 = bo + PADI(base + 2 * q4), i3 = bo + PADI(base + 3 * q4);
            const f32x2 w1 = wl[i];
            const f32x2 w2 = cmul(w1, w1), w3 = cmul(w2, w1);
            f32x2 b0 = buf[i0], b1 = cmulc(buf[i1], w1), b2 = cmulc(buf[i2], w2), b3 = cmulc(buf[i3], w3);
            bfly_inv(b0, b1, b2, b3);
            buf[i0] = b0; buf[i1] = b1; buf[i2] = b2; buf[i3] = b3;
        }
        __syncthreads();
    }
}
__device__ const double ROPE_IF[16] = {1.0, 0.5623413251903491, 0.31622776601683794, 0.1778279410038923, 0.1, 0.05623413251903491, 0.03162277660168379, 0.01778279410038923,
    0.01, 0.005623413251903491, 0.0031622776601683794, 0.0017782794100389228, 0.001, 0.0005623413251903491, 0.00031622776601683794, 0.00017782794100389227};
struct Chunk { int tok0, L, nseq; };
__device__ __forceinline__ Chunk chunk_of(int c) { Chunk k; k.tok0 = c * CH; if (c < NCH_P) { k.L = LP; k.nseq = CH / LP; } else { k.L = LS; k.nseq = CH / LS; } return k; }
__device__ __forceinline__ const float* xin_rows(const AV& a, int tok0) { return tok0 < NTOK_P ? AIN(I_XP) + (size_t)tok0 * DM : AIN(I_XS) + (size_t)(tok0 - NTOK_P) * DM; }
__device__ __forceinline__ void hf_group(LAS float* sm, const AV& a, int layer, int L, int t0, float* hf, int tid) {
    LAS float* zs = sm; LAS float* A = sm + 512; LAS float* B = sm + 1024;
    const float* w1 = AIN(I_FW1) + layer * 33 * 64; const float* b1 = AIN(I_FB1) + layer * 64;
    const float* w2 = AIN(I_FW2) + layer * 2 * 64 * 64; const float* b2 = AIN(I_FB2) + layer * 2 * 64;
    const float* wo = AIN(I_FWOUT) + layer * 64 * 1024; const float* fr = AIN(I_FFREQ) + layer * 64;
    const int tt = tid >> 6, j = tid & 63, t = t0 + tt;
    const float t01 = (float)t / (float)(L - 1);
    if (j < 33) {
        float v;
        if (j == 0) v = t01;
        else { const int k = (j - 1) & 15; const double f = kd(1e-4) + (double)k * kd((15.0 - 1e-4) / 15.0); float s, c; sincos_rev(f * (double)t / (double)L, s, c); v = (j <= 16) ? c : -s; }
        zs[tt * 40 + j] = v;
    }
    __syncthreads();
    const float fq = fr[j];
    { float acc = b1[j]; for (int i = 0; i < 33; ++i) acc += zs[tt * 40 + i] * w1[i * 64 + j]; A[tt * 64 + j] = sin_acc(fq * acc); }
    __syncthreads();
    { float acc = b2[j]; for (int i = 0; i < 64; ++i) acc += A[tt * 64 + i] * w2[i * 64 + j]; B[tt * 64 + j] = sin_acc(fq * acc); }
    __syncthreads();
    { float acc = b2[64 + j]; for (int i = 0; i < 64; ++i) acc += B[tt * 64 + i] * w2[4096 + i * 64 + j]; A[tt * 64 + j] = sin_acc(fq * acc); }
    __syncthreads();
    { float acc0[8], acc1[8];
#pragma unroll
      for (int q = 0; q < 8; ++q) { acc0[q] = 0.f; acc1[q] = 0.f; }
#pragma unroll 8
      for (int i = 0; i < 64; ++i) { const float wa = wo[i * 1024 + tid], wb = wo[i * 1024 + 512 + tid];
#pragma unroll
          for (int q = 0; q < 8; ++q) { const float av = A[q * 64 + i]; acc0[q] += av * wa; acc1[q] += av * wb; } }
      const float ad = 3.070113457325394f + (float)tid * ((15.350567286626973f - 3.070113457325394f) / 511.0f);
#pragma unroll
      for (int q = 0; q < 8; ++q) { const float tq = (float)(t0 + q) / (float)(L - 1); const float win = __expf(-tq * ad);
          hf[(size_t)(t0 + q) * 1024 + tid] = acc0[q] * win; hf[(size_t)(t0 + q) * 1024 + 512 + tid] = acc1[q] * win; } }
    __syncthreads();
}
__device__ __forceinline__ void step_pro_a(const AV& a, LAS unsigned char* lds) {
    const int tid = ltid(), lane = tid & 63, wave = tid >> 6, G = gridDim.x;
    unsigned char* ws = AWS;
    { f32x2* tw = (f32x2*)(ws + WS_TW); for (int m = lbid() * NT + tid; m < 16384; m += G * NT) { float s, c; sincos_rev((double)m / 16384.0, s, c); tw[m] = (f32x2){c, -s}; } }
    { f32x2* rt = (f32x2*)(ws + WS_ROPE);
      for (int e = lbid() * NT + tid; e < 8192 * 32; e += G * NT) { const int pos = e >> 5, i = e & 31; const int pp = (i < 16) ? (pos >> 6) : (pos & 63);
          const double inv = ROPE_IF[i & 15]; float sn, cs; sincos_rev((double)pp * inv * 0.15915494309189533577, sn, cs); rt[e] = (f32x2){cs, sn}; } }
    { const float* g = AIN(I_NORMG); bf16* HN0 = (bf16*)(ws + WS_HN0); f32x4 gv[4];
#pragma unroll
      for (int j = 0; j < 4; ++j) gv[j] = *((const f32x4*)g + lane + 64 * j);
      for (int m = lbid() * NWAVES + wave; m < NTOK; m += G * NWAVES) {
          const f32x4* xr = (const f32x4*)(xin_rows(a, m)) + lane; f32x4 v[4]; float ssum = 0.f;
#pragma unroll
          for (int j = 0; j < 4; ++j) { v[j] = xr[64 * j]; ssum += (v[j].x * v[j].x + v[j].y * v[j].y) + (v[j].z * v[j].z + v[j].w * v[j].w); }
          const float rs = 1.0f / sqrtf(wave_sum(ssum) * (1.0f / DM) + EPS);
          u32x2* o8 = (u32x2*)(HN0 + (size_t)m * DM) + lane;
#pragma unroll
          for (int j = 0; j < 4; ++j) { u32x2 w; w.x = pk2(v[j].x * rs * gv[j].x, v[j].y * rs * gv[j].y); w.y = pk2(v[j].z * rs * gv[j].z, v[j].w * rs * gv[j].w); o8[64 * j] = w; } } }
    { LAS float* scr = (LAS float*)(lds + wave * 16384);
      constexpr int I_IN = 16 * (UP / 32), I_MG = 16 * (GP / 32), I_BR = 8 * 32, I_OU = 16 * 32, PER = I_IN + I_MG + 3 * I_BR + I_OU;
      for (int it = lbid() * NWAVES + wave; it < 2 * PER; it += G * NWAVES) {
          const int l = it / PER; int r = it - l * PER;
          bf16* wcat = (bf16*)(ws + WS_WCAT + l * WCAT_BYTES); bf16* wbt = (bf16*)(ws + WS_WBT + l * WBT_BYTES); bf16* wot = (bf16*)(ws + WS_WOT + l * WOT_BYTES);
          if (r < I_IN) { transpose_item(AIN(I_WIN) + (size_t)l * 1024 * UP, 1024, UP, wcat, 0, scr, r, lane); continue; } r -= I_IN;
          if (r < I_MG) { transpose_item(AIN(I_WMERGE) + (size_t)l * 1024 * GP, 1024, GP, wcat, UP, scr, r, lane); continue; } r -= I_MG;
          if (r < I_BR) { transpose_item(AIN(I_WBHY) + (size_t)l * 512 * 1024, 512, 1024, wbt, 0, scr, r, lane); continue; } r -= I_BR;
          if (r < I_BR) { transpose_item(AIN(I_WBGQ) + (size_t)l * 512 * 1024, 512, 1024, wbt, 1024, scr, r, lane); continue; } r -= I_BR;
          if (r < I_BR) { transpose_item(AIN(I_WBDF) + (size_t)l * 512 * 1024, 512, 1024, wbt, 2048, scr, r, lane); continue; } r -= I_BR;
          transpose_item(AIN(I_WOUT) + (size_t)l * 1024 * 1024, 1024, 1024, wot, 0, scr, r, lane);
      } }
}
__device__ __forceinline__ void step_pro_a2(const AV& a, LAS unsigned char* lds) {
    const int tid = ltid(), G = gridDim.x; unsigned char* ws = AWS;
    { constexpr int GPL = LP / 8 + LS / 8;
      for (int g = lbid(); g < 2 * GPL; g += G) { const int l = g / GPL; int r = g - l * GPL;
          float* hfp = (float*)(ws + WS_U + l * (HF_P_BYTES + HF_S_BYTES));
          if (r < LP / 8) hf_group((LAS float*)lds, a, l, LP, r * 8, hfp, tid);
          else hf_group((LAS float*)lds, a, l, LS, (r - LP / 8) * 8, (float*)((unsigned char*)hfp + HF_P_BYTES), tid); } }
}
template <int LOG4> __device__ __forceinline__ void filt_unit(const AV& a, LAS unsigned char* lds, int layer, int pr, const float* hf, f32x2* Pg, f32x2* Mg) {
    constexpr int N = 1 << (2 * LOG4), L = N / 2;
    const int tid = ltid(); LAS f32x2* buf = (LAS f32x2*)lds; const int c0 = 2 * pr;
    for (int n = tid; n < N; n += NT) { f32x2 v = (f32x2){0.f, 0.f};
        if (n < L) v = *(const f32x2*)(hf + (size_t)n * 1024 + c0); else if (n > L) v = *(const f32x2*)(hf + (size_t)(N - n) * 1024 + 512 + c0);
        buf[PADI(n)] = v; }
    __syncthreads();
    fft_fwd<LOG4>(buf, (const f32x2*)(AWS + WS_TW), tid);
    const float ba = AIN(I_HYBIAS)[layer * 512 + c0], bb = AIN(I_HYBIAS)[layer * 512 + c0 + 1]; const float sc = 1.0f / (float)N;
    for (int k = tid; k <= L; k += NT) { const int q1 = digitrev<LOG4>(k), q2 = digitrev<LOG4>((N - k) & (N - 1)); const f32x2 z1 = buf[PADI(q1)], z2 = buf[PADI(q2)];
        f32x2 ca = (f32x2){0.5f * (z1.x + z2.x), 0.5f * (z1.y - z2.y)}; const float dx = z1.x - z2.x, dy = z1.y + z2.y; f32x2 cb = (f32x2){0.5f * dy, -0.5f * dx};
        ca.x += ba; cb.x += bb;
        Pg[k] = (f32x2){0.5f * sc * (ca.x + cb.x), 0.5f * sc * (ca.y + cb.y)}; Mg[k] = (f32x2){0.5f * sc * (ca.x - cb.x), 0.5f * sc * (ca.y - cb.y)}; }
    __syncthreads();
}
__device__ __forceinline__ void step_pro_b(const AV& a, LAS unsigned char* lds) {
    for (int u = lbid(); u < 1024; u += gridDim.x) { const int l = u >> 9, r = u & 511; unsigned char* sp = AWS + WS_SPEC + l * SPEC_LAYER; const float* hfp = (const float*)(AWS + WS_U + l * (HF_P_BYTES + HF_S_BYTES));
        if (r < 256) filt_unit<7>(a, lds, l, r, hfp, (f32x2*)sp + (size_t)r * SPS_P, (f32x2*)(sp + SPEC_P_BYTES) + (size_t)r * SPS_P);
        else { const int pr = r - 256; filt_unit<6>(a, lds, l, pr, (const float*)((const unsigned char*)hfp + HF_P_BYTES), (f32x2*)(sp + 2 * SPEC_P_BYTES) + (size_t)pr * SPS_S, (f32x2*)(sp + 2 * SPEC_P_BYTES + SPEC_S_BYTES) + (size_t)pr * SPS_S); } }
}
__device__ __forceinline__ void step_norm(const AV& a, int c, int layer) {
    const int tid = ltid(), lane = tid & 63, wave = tid >> 6; const Chunk ck = chunk_of(c);
    const float* X = layer == 0 ? xin_rows(a, ck.tok0) : AOUT + (size_t)ck.tok0 * DM; bf16* HN = (bf16*)(AWS + WS_HN); const float* g = AIN(I_NORMG) + layer * DM;
    f32x4 gv[4];
#pragma unroll
    for (int j = 0; j < 4; ++j) gv[j] = *((const f32x4*)g + lane + 64 * j);
    for (int m = lbid() * NWAVES + wave; m < CH; m += gridDim.x * NWAVES) {
        const f32x4* xr = (const f32x4*)(X + (size_t)m * DM) + lane; f32x4 v[4]; float s = 0.f;
#pragma unroll
        for (int j = 0; j < 4; ++j) { v[j] = xr[64 * j]; s += (v[j].x * v[j].x + v[j].y * v[j].y) + (v[j].z * v[j].z + v[j].w * v[j].w); }
        const float rs = 1.0f / sqrtf(wave_sum(s) * (1.0f / DM) + EPS);
        u32x2* o8 = (u32x2*)(HN + (size_t)m * DM) + lane;
#pragma unroll
        for (int j = 0; j < 4; ++j) { u32x2 w; w.x = pk2(v[j].x * rs * gv[j].x, v[j].y * rs * gv[j].y); w.y = pk2(v[j].z * rs * gv[j].z, v[j].w * rs * gv[j].w); o8[64 * j] = w; }
    }
}
__device__ __forceinline__ void step_final(const AV& a) {
    const int tid = ltid(), lane = tid & 63, wave = tid >> 6; const float* g = AIN(I_FINALG);
    f32x4 gv[4];
#pragma unroll
    for (int j = 0; j < 4; ++j) gv[j] = *((const f32x4*)g + lane + 64 * j);
    for (int m = lbid() * NWAVES + wave; m < NTOK; m += gridDim.x * NWAVES) {
        f32x4* xr = (f32x4*)(AOUT + (size_t)m * DM) + lane; f32x4 v[4]; float s = 0.f;
#pragma unroll
        for (int j = 0; j < 4; ++j) { v[j] = xr[64 * j]; s += (v[j].x * v[j].x + v[j].y * v[j].y) + (v[j].z * v[j].z + v[j].w * v[j].w); }
        const float rs = 1.0f / sqrtf(wave_sum(s) * (1.0f / DM) + EPS);
#pragma unroll
        for (int j = 0; j < 4; ++j) xr[64 * j] = v[j] * rs * gv[j];
    }
}
__device__ __forceinline__ void step_prep(const AV& a, int c, int layer) {
    const Chunk ck = chunk_of(c); bf16* U = (bf16*)(AWS + WS_U);
    for (int it = lbid() * NT + ltid(); it < CH * 10; it += gridDim.x * NT) {
        const int tok = it / 10, hd = it - tok * 10; const int pos = tok & (ck.L - 1);
        bf16* p = U + (size_t)tok * UP + (hd < 8 ? C_GQ + 64 * hd : C_GK + 64 * (hd - 8));
        const float* g = (hd < 8 ? AIN(I_QNG) : AIN(I_KNG)) + layer * 64;
        float x[64];
#pragma unroll
        for (int i = 0; i < 8; ++i) { const u32x4 w = *((const u32x4*)p + i);
            x[8 * i + 0] = bflo(w.x); x[8 * i + 1] = bfhi(w.x); x[8 * i + 2] = bflo(w.y); x[8 * i + 3] = bfhi(w.y); x[8 * i + 4] = bflo(w.z); x[8 * i + 5] = bfhi(w.z); x[8 * i + 6] = bflo(w.w); x[8 * i + 7] = bfhi(w.w); }
        float ss = 0.f;
#pragma unroll
        for (int i = 0; i < 64; ++i) ss += x[i] * x[i];
        const float rs = 1.0f / sqrtf(ss * (1.0f / 64.0f) + EPS);
#pragma unroll
        for (int i = 0; i < 64; ++i) x[i] = x[i] * rs * g[i];
        const f32x4* rt = (const f32x4*)(AWS + WS_ROPE) + (size_t)pos * 16;
#pragma unroll
        for (int i2 = 0; i2 < 16; ++i2) { const f32x4 cs2 = rt[i2];
#pragma unroll
            for (int e = 0; e < 2; ++e) { const int i = 2 * i2 + e; const float cs = e ? cs2.z : cs2.x, sn = e ? cs2.w : cs2.y; const float x1 = x[i], x2 = x[i + 32]; x[i] = x1 * cs - x2 * sn; x[i + 32] = x2 * cs + x1 * sn; } }
#pragma unroll
        for (int i = 0; i < 8; ++i) { u32x4 w; w.x = pk2(x[8 * i], x[8 * i + 1]); w.y = pk2(x[8 * i + 2], x[8 * i + 3]); w.z = pk2(x[8 * i + 4], x[8 * i + 5]); w.w = pk2(x[8 * i + 6], x[8 * i + 7]); *((u32x4*)p + i) = w; }
    }
}
__device__ __forceinline__ void step_prep_hy(const AV& a, LAS unsigned char* lds, int c, int layer) {
    const Chunk ck = chunk_of(c); const bf16* U = (const bf16*)(AWS + WS_U);
    f32x2* HVP = (f32x2*)(AWS + WS_HVP); f32x2* PMP = (f32x2*)(AWS + WS_PMP);
    const int tid = ltid(), lane = tid & 63, wave = tid >> 6;
    LAS f32x2* th = (LAS f32x2*)(lds + wave * 17408); LAS f32x2* tp = th + 64 * 17;
    const float* cw = AIN(I_CONVW) + layer * 3 * 1536; const float* cb = AIN(I_CONVB) + layer * 1536;
    for (int it = lbid() * NWAVES + wave; it < (CH / 16) * 4; it += gridDim.x * NWAVES) {
        const int cbk = it & 3, tg = it >> 2, t0 = tg * 16, ch = cbk * 128 + 2 * lane;
        const int pos0 = t0 & (ck.L - 1);
        float w[3][3][2], bb[3][2];
#pragma unroll
        for (int ar = 0; ar < 3; ++ar) {
#pragma unroll
            for (int j = 0; j < 3; ++j) { const f32x2 v = *(const f32x2*)(cw + j * 1536 + ar * 512 + ch); w[ar][j][0] = v.x; w[ar][j][1] = v.y; }
            const f32x2 v = *(const f32x2*)(cb + ar * 512 + ch); bb[ar][0] = v.x; bb[ar][1] = v.y; }
        const bf16* r0 = U + (size_t)t0 * UP + ch;
        unsigned pv[3], cv[3], nv[3];
#pragma unroll
        for (int ar = 0; ar < 3; ++ar) { pv[ar] = pos0 > 0 ? *(const unsigned*)(r0 - UP + ar * 512) : 0u; cv[ar] = *(const unsigned*)(r0 + ar * 512); }
#pragma unroll 4
        for (int t = 0; t < 16; ++t) {
            const bf16* rt = r0 + (size_t)t * UP; const bool last = (pos0 + t + 1 >= ck.L);
#pragma unroll
            for (int ar = 0; ar < 3; ++ar) nv[ar] = last ? 0u : *(const unsigned*)(rt + UP + ar * 512);
            const unsigned gw = *(const unsigned*)(rt + C_HG);
            float o[3][2];
#pragma unroll
            for (int ar = 0; ar < 3; ++ar) { o[ar][0] = w[ar][0][0] * bflo(pv[ar]) + w[ar][1][0] * bflo(cv[ar]) + w[ar][2][0] * bflo(nv[ar]) + bb[ar][0];
                o[ar][1] = w[ar][0][1] * bfhi(pv[ar]) + w[ar][1][1] * bfhi(cv[ar]) + w[ar][2][1] * bfhi(nv[ar]) + bb[ar][1]; pv[ar] = cv[ar]; cv[ar] = nv[ar]; }
            th[lane * 17 + t] = (f32x2){o[2][0] * o[1][0], o[2][1] * o[1][1]};
            tp[lane * 17 + t] = (f32x2){o[0][0] * silu(bflo(gw)), o[0][1] * silu(bfhi(gw))};
        }
        asm volatile("s_waitcnt lgkmcnt(0)" ::: "memory");
#pragma unroll 4
        for (int i = 0; i < 16; ++i) { const int pl = 4 * i + (lane >> 4), tt = lane & 15; const size_t o = (size_t)(cbk * 64 + pl) * CH + t0 + tt;
            HVP[o] = th[pl * 17 + tt]; PMP[o] = tp[pl * 17 + tt]; }
        asm volatile("s_waitcnt lgkmcnt(0)" ::: "memory");
    }
}
typedef short bf16x8 __attribute__((ext_vector_type(8)));
typedef short s16x4 __attribute__((ext_vector_type(4)));
typedef float f32x16 __attribute__((ext_vector_type(16)));
typedef float f32x2_t __attribute__((ext_vector_type(2)));
typedef __bf16 bf16x2_t __attribute__((ext_vector_type(2)));
__device__ __forceinline__ unsigned cvtpk(float lo, float hi) { f32x2_t v = {lo, hi}; bf16x2_t b = __builtin_convertvector(v, bf16x2_t); return __builtin_bit_cast(unsigned, b); }
__device__ __forceinline__ int crow(int r, int hi) { return (r & 3) + 8 * (r >> 2) + 4 * hi; }
__device__ __forceinline__ s16x4 vtr(const LAS unsigned char* p) { return __builtin_bit_cast(s16x4, __builtin_amdgcn_ds_read_tr16_b64_v4i16((LAS s16x4*)p)); }
constexpr int ATT_K = 0;
constexpr int ATT_TB_DIFF = 4 * 8192 + 4 * 16384;
constexpr float C1 = 0.125f * LOG2E;
__device__ __forceinline__ void glds16(const void* gsrc, unsigned lds_dst) { unsigned keep;
    asm volatile("s_mov_b32 %0, m0\n\ts_mov_b32 m0, %2\n\ts_nop 0\n\tglobal_load_lds_dwordx4 %1, off\n\ts_mov_b32 m0, %0" : "=&s"(keep) : "v"(gsrc), "s"(lds_dst) : "memory"); }

template <int VD, bool BIAS, bool OMAX, int G>
__device__ __forceinline__ void flash_pass(LAS unsigned char* lds, const bf16* Qrow, const bf16* Kg, const bf16* Vg, int L, int qpos, int qw0, float bl, float br, f32x16 (&o)[VD / 32], float& l_out) {
    const int tid = ltid(), lane = tid & 63, r32 = lane & 31, hi = lane >> 5;
    constexpr int VROW = VD * 2, VT = 64 * VROW, NVL = VD / 64, NSL = 2 * G, ATT_V = NSL * 8192, ATT_TB = ATT_V + NSL * VT;
    const LAS float* tb = (const LAS float*)(lds + ATT_TB);
    typedef const __attribute__((address_space(1))) u32x4* g4p;
    const int wv = __builtin_amdgcn_readfirstlane(tid >> 6); const int ldsa = (int)(unsigned)(uintptr_t)lds;
    const bf16* ksrc; { const int X = wv * 1024 + lane * 16, line = X >> 8, c16 = ((X >> 4) & 15) ^ (line & 15), key = 2 * line + (c16 >> 3), ch = c16 & 7; ksrc = Kg + (size_t)key * UP + ch * 8; }
    const bf16* vsrc[NVL];
#pragma unroll
    for (int i = 0; i < NVL; ++i) { const int X = i * 8192 + wv * 1024 + lane * 16; const int key = (VD == 64) ? (X >> 7) : (X >> 8), posb = (VD == 64) ? (X & 127) : (X & 255);
        const int swz = (VD == 64) ? (((key >> 1) & 1) << 6) : ((key & 3) << 6); vsrc[i] = Vg + (size_t)key * UP + ((posb ^ swz) >> 1); }
#define ATT_DMA(tt_, sl_) do { const size_t go_ = (size_t)(tt_) * 64 * UP; \
        glds16(ksrc + go_, (unsigned)__builtin_amdgcn_readfirstlane(ldsa + ATT_K + (sl_) * 8192 + wv * 1024)); \
        _Pragma("unroll") for (int i_ = 0; i_ < NVL; ++i_) glds16(vsrc[i_] + go_, (unsigned)__builtin_amdgcn_readfirstlane(ldsa + ATT_V + (sl_) * VT + i_ * 8192 + wv * 1024)); } while (0)
#define ATT_DMAGROUP(g_) do { _Pragma("unroll") for (int j_ = 0; j_ < G; ++j_) { const int tt_ = (g_) * G + j_; ATT_DMA(tt_, tt_ & (NSL - 1)); } } while (0)
#define ATT_BAR() do { __builtin_amdgcn_s_barrier(); asm volatile("" ::: "memory"); } while (0)
    int koff[2][4];
#pragma unroll
    for (int kb = 0; kb < 2; ++kb)
#pragma unroll
        for (int s = 0; s < 4; ++s) { const int key = 32 * kb + r32, line = key >> 1, c16 = ((key & 1) << 3) | (2 * s + hi); koff[kb][s] = line * 256 + ((c16 ^ (line & 15)) << 4); }
    const int q4 = (lane & 15) >> 2, p4 = lane & 3, g1 = (lane >> 4) & 1;
    const int vsw = (VD == 64) ? ((q4 >> 1) & 1) : q4;
    const int vbase = (4 * hi + q4) * VROW + 32 * g1 + 8 * p4;
    bf16x8 qf[4];
#pragma unroll
    for (int s = 0; s < 4; ++s) qf[s] = __builtin_bit_cast(bf16x8, *(g4p)(Qrow + 16 * s + 8 * hi));
    float m_run = OMAX ? -1e30f : 0.f, l_run = 0.f;
    const int nt = L >> 6;
    asm volatile("" :: "v"(qf[0]), "v"(qf[1]), "v"(qf[2]), "v"(qf[3]) : "memory");
    asm volatile("s_waitcnt vmcnt(0)" ::: "memory");
    const int ng = nt / G;
    ATT_DMAGROUP(0); if (ng > 1) ATT_DMAGROUP(1);
    if (ng > 1) { if (G * (1 + NVL) == 8) asm volatile("s_waitcnt vmcnt(8)" ::: "memory"); else asm volatile("s_waitcnt vmcnt(6)" ::: "memory"); } else asm volatile("s_waitcnt vmcnt(0)" ::: "memory");
    static_assert(G * (1 + NVL) == 8 || G * (1 + NVL) == 6, "vmcnt immediates above");
    ATT_BAR();
#pragma unroll 1
    for (int t = 0; t < nt; ++t) {
        const int cur = t & (NSL - 1);
        const LAS unsigned char* kbuf = lds + ATT_K + cur * 8192; const LAS unsigned char* vbuf = lds + ATT_V + cur * VT;
        f32x16 p[2];
        { bf16x8 kf[2][4];
#pragma unroll
          for (int kb = 0; kb < 2; ++kb)
#pragma unroll
            for (int s = 0; s < 4; ++s) kf[kb][s] = *(const LAS bf16x8*)(kbuf + koff[kb][s]);
          __builtin_amdgcn_sched_barrier(0);
#pragma unroll
          for (int kb = 0; kb < 2; ++kb) { f32x16 acc;
#pragma unroll
            for (int r = 0; r < 16; ++r) acc[r] = 0.f;
#pragma unroll
            for (int s = 0; s < 4; ++s) acc = __builtin_amdgcn_mfma_f32_32x32x16_bf16(kf[kb][s], qf[s], acc, 0, 0, 0);
            p[kb] = acc; } }
        s16x4 vlo[2][4], vhi[2][4];
#define VREAD(buf_, db_) do { const int cofs_ = (((db_) ^ vsw) << 6); _Pragma("unroll") for (int kb = 0; kb < 2; ++kb) _Pragma("unroll") for (int ss = 0; ss < 2; ++ss) { \
            const LAS unsigned char* vp_ = vbuf + vbase + (32 * kb + 16 * ss) * VROW + cofs_; vlo[buf_][2 * kb + ss] = vtr(vp_); vhi[buf_][2 * kb + ss] = vtr(vp_ + 8 * VROW); } } while (0)
        VREAD(0, 0);
        __builtin_amdgcn_sched_barrier(0);
        const int k0 = t * 64; float mulc, bconst, mx = -3e38f; bool nearT = false;
        if (BIAS) { const int rlo = k0 - qw0 - 31, rhi = k0 + 63 - qw0; nearT = !(rhi <= -128 || rlo >= 128); }
        if (BIAS && nearT) {
#pragma unroll
            for (int kb = 0; kb < 2; ++kb)
#pragma unroll
                for (int r4 = 0; r4 < 4; ++r4) {
#pragma unroll
                    for (int e = 0; e < 4; ++e) { const int r = 4 * r4 + e; int rel = k0 + 32 * kb + crow(r, hi) - qpos; rel = rel < -128 ? -128 : (rel > 128 ? 128 : rel); const float v = p[kb][r] * C1 + tb[rel + 128]; p[kb][r] = v; mx = fmaxf(mx, v); }
                    __builtin_amdgcn_sched_barrier(0); }
            mulc = 1.0f; bconst = 0.f;
        } else {
            if (OMAX) {
#pragma unroll
                for (int kb = 0; kb < 2; ++kb)
#pragma unroll
                    for (int r = 0; r < 16; ++r) mx = fmaxf(mx, p[kb][r]); }
            bconst = BIAS ? (k0 < qw0 ? bl : br) : 0.f; mx = mx * C1 + bconst; mulc = C1;
        }
        if (OMAX) {
            mx = fmaxf(mx, __shfl_xor(mx, 32));
            if (__any(mx > m_run)) { const float mn = fmaxf(m_run, mx), al = __builtin_amdgcn_exp2f(m_run - mn); l_run *= al;
#pragma unroll
                for (int db = 0; db < VD / 32; ++db) o[db] *= al;
                m_run = mn; }
        }
        const f32x2 mul2 = (f32x2){mulc, mulc}, add2 = (f32x2){bconst - m_run, bconst - m_run}; f32x2 ls2 = (f32x2){0.f, 0.f};
#pragma unroll
        for (int kb = 0; kb < 2; ++kb)
#pragma unroll
            for (int r = 0; r < 16; r += 2) { f32x2 v = (f32x2){p[kb][r], p[kb][r + 1]}; v = v * mul2 + add2; f32x2 e; e.x = __builtin_amdgcn_exp2f(v.x); e.y = __builtin_amdgcn_exp2f(v.y); ls2 += e; p[kb][r] = e.x; p[kb][r + 1] = e.y; }
        l_run += ls2.x + ls2.y;
        bf16x8 pk[2][2];
#pragma unroll
        for (int kb = 0; kb < 2; ++kb)
#pragma unroll
            for (int ss = 0; ss < 2; ++ss) { u32x4 w; w.x = cvtpk(p[kb][8 * ss + 0], p[kb][8 * ss + 1]); w.y = cvtpk(p[kb][8 * ss + 2], p[kb][8 * ss + 3]); w.z = cvtpk(p[kb][8 * ss + 4], p[kb][8 * ss + 5]); w.w = cvtpk(p[kb][8 * ss + 6], p[kb][8 * ss + 7]);
                pk[kb][ss] = __builtin_bit_cast(bf16x8, w); }
        __builtin_amdgcn_sched_barrier(0);
#pragma unroll
        for (int db = 0; db < VD / 32; ++db) {
            if (db + 1 < VD / 32) { if ((db + 1) & 1) VREAD(1, db + 1); else VREAD(0, db + 1); }
#pragma unroll
            for (int kb = 0; kb < 2; ++kb)
#pragma unroll
                for (int ss = 0; ss < 2; ++ss) { const bf16x8 vf = (db & 1) ? __builtin_shufflevector(vlo[1][2 * kb + ss], vhi[1][2 * kb + ss], 0, 1, 2, 3, 4, 5, 6, 7) : __builtin_shufflevector(vlo[0][2 * kb + ss], vhi[0][2 * kb + ss], 0, 1, 2, 3, 4, 5, 6, 7);
                    o[db] = __builtin_amdgcn_mfma_f32_32x32x16_bf16(vf, pk[kb][ss], o[db], 0, 0, 0); }
            __builtin_amdgcn_sched_barrier(0); }
#undef VREAD
        if (((t + 1) & (G - 1)) == 0) {
            asm volatile("s_waitcnt vmcnt(0)" ::: "memory"); ATT_BAR();
            const int g2 = (t + 1) / G + 1; if (g2 < ng) ATT_DMAGROUP(g2); }
    }
#undef ATT_DMA
#undef ATT_DMAGROUP
#undef ATT_BAR
    l_out = l_run + __shfl_xor(l_run, 32);
}
__device__ __forceinline__ void gqa_unit(const AV& a, LAS unsigned char* lds, int seqrow0, int L, int h, int qb) {
    const int tid = ltid(), lane = tid & 63, r32 = lane & 31, hi = lane >> 5;
    const bf16* U = (const bf16*)(AWS + WS_U); bf16* Y = (bf16*)(AWS + WS_Y) + (size_t)1 * CH * 512;
    constexpr int G = 4, NSL = 2 * G, VROW = 128, VT = 8192, ATT_V = NSL * 8192;
    typedef const __attribute__((address_space(1))) u32x4* g4p;
    const int wv = __builtin_amdgcn_readfirstlane(tid >> 6); const int ldsa = (int)(unsigned)(uintptr_t)lds;
    const int qw0 = qb * 512 + wv * 64;
    const bf16* Kg = U + (size_t)seqrow0 * UP + C_GK + 64 * (h >> 2); const bf16* Vg = U + (size_t)seqrow0 * UP + C_GV + 64 * (h >> 2);
    const bf16* ksrc; { const int X = wv * 1024 + lane * 16, line = X >> 8, c16 = ((X >> 4) & 15) ^ (line & 15), key = 2 * line + (c16 >> 3), ch = c16 & 7; ksrc = Kg + (size_t)key * UP + ch * 8; }
    const bf16* vsrc; { const int X = wv * 1024 + lane * 16, key = X >> 7, posb = X & 127, swz = ((key >> 1) & 1) << 6; vsrc = Vg + (size_t)key * UP + ((posb ^ swz) >> 1); }
#define GQ_DMA(tt_, sl_) do { const size_t go_ = (size_t)(tt_) * 64 * UP; \
        glds16(ksrc + go_, (unsigned)__builtin_amdgcn_readfirstlane(ldsa + ATT_K + (sl_) * 8192 + wv * 1024)); \
        glds16(vsrc + go_, (unsigned)__builtin_amdgcn_readfirstlane(ldsa + ATT_V + (sl_) * VT + wv * 1024)); } while (0)
#define GQ_DMAGROUP(g_) do { _Pragma("unroll") for (int j_ = 0; j_ < G; ++j_) { const int tt_ = (g_) * G + j_; GQ_DMA(tt_, tt_ & (NSL - 1)); } } while (0)
#define GQ_BAR() do { __builtin_amdgcn_s_barrier(); asm volatile("" ::: "memory"); } while (0)
    int koff[2][4];
#pragma unroll
    for (int kb = 0; kb < 2; ++kb)
#pragma unroll
        for (int s = 0; s < 4; ++s) { const int key = 32 * kb + r32, line = key >> 1, c16 = ((key & 1) << 3) | (2 * s + hi); koff[kb][s] = line * 256 + ((c16 ^ (line & 15)) << 4); }
    const int q4 = (lane & 15) >> 2, p4 = lane & 3, g1 = (lane >> 4) & 1;
    const int vsw = (q4 >> 1) & 1;
    const int vbase = (4 * hi + q4) * VROW + 32 * g1 + 8 * p4;
    bf16x8 qf[2][4];
#pragma unroll
    for (int j = 0; j < 2; ++j)
#pragma unroll
        for (int s = 0; s < 4; ++s) qf[j][s] = __builtin_bit_cast(bf16x8, *(g4p)(U + (size_t)(seqrow0 + qw0 + 32 * j + r32) * UP + C_GQ + 64 * h + 16 * s + 8 * hi));
    f32x16 o[2][2];
#pragma unroll
    for (int j = 0; j < 2; ++j)
#pragma unroll
        for (int db = 0; db < 2; ++db)
#pragma unroll
            for (int r = 0; r < 16; ++r) o[j][db][r] = 0.f;
    float lrun[2] = {0.f, 0.f};
    const int nt = L >> 6, ng = nt / G;
    asm volatile("" :: "v"(qf[0][0]), "v"(qf[0][1]), "v"(qf[0][2]), "v"(qf[0][3]), "v"(qf[1][0]), "v"(qf[1][1]), "v"(qf[1][2]), "v"(qf[1][3]) : "memory");
    asm volatile("s_waitcnt vmcnt(0)" ::: "memory");
    GQ_DMAGROUP(0); if (ng > 1) GQ_DMAGROUP(1);
    if (ng > 1) asm volatile("s_waitcnt vmcnt(8)" ::: "memory"); else asm volatile("s_waitcnt vmcnt(0)" ::: "memory");
    GQ_BAR();
#pragma unroll 1
    for (int t = 0; t < nt; ++t) {
        const int cur = t & (NSL - 1);
        const LAS unsigned char* kbuf = lds + ATT_K + cur * 8192; const LAS unsigned char* vbuf = lds + ATT_V + cur * VT;
        f32x16 p[2][2];
        { bf16x8 kf[2][4];
#pragma unroll
          for (int kb = 0; kb < 2; ++kb)
#pragma unroll
            for (int s = 0; s < 4; ++s) kf[kb][s] = *(const LAS bf16x8*)(kbuf + koff[kb][s]);
          __builtin_amdgcn_sched_barrier(0);
#pragma unroll
          for (int kb = 0; kb < 2; ++kb)
#pragma unroll
            for (int j = 0; j < 2; ++j) { f32x16 acc;
#pragma unroll
              for (int r = 0; r < 16; ++r) acc[r] = 0.f;
#pragma unroll
              for (int s = 0; s < 4; ++s) acc = __builtin_amdgcn_mfma_f32_32x32x16_bf16(kf[kb][s], qf[j][s], acc, 0, 0, 0);
              p[j][kb] = acc; } }
        s16x4 vlo[2][4], vhi[2][4];
#define GQ_VREAD(buf_, db_) do { const int cofs_ = (((db_) ^ vsw) << 6); _Pragma("unroll") for (int kb = 0; kb < 2; ++kb) _Pragma("unroll") for (int ss = 0; ss < 2; ++ss) { \
            const LAS unsigned char* vp_ = vbuf + vbase + (32 * kb + 16 * ss) * VROW + cofs_; vlo[buf_][2 * kb + ss] = vtr(vp_); vhi[buf_][2 * kb + ss] = vtr(vp_ + 8 * VROW); } } while (0)
        bf16x8 pk[2][2][2];
#pragma unroll
        for (int j = 0; j < 2; ++j) { float ls0 = 0.f, ls1 = 0.f;
#pragma unroll
            for (int kb = 0; kb < 2; ++kb) {
#pragma unroll
                for (int r = 0; r < 16; r += 2) { const float e0 = __builtin_amdgcn_exp2f(p[j][kb][r] * C1), e1 = __builtin_amdgcn_exp2f(p[j][kb][r + 1] * C1); ls0 += e0; ls1 += e1; p[j][kb][r] = e0; p[j][kb][r + 1] = e1; }
#pragma unroll
                for (int ss = 0; ss < 2; ++ss) { u32x4 w; w.x = cvtpk(p[j][kb][8 * ss + 0], p[j][kb][8 * ss + 1]); w.y = cvtpk(p[j][kb][8 * ss + 2], p[j][kb][8 * ss + 3]); w.z = cvtpk(p[j][kb][8 * ss + 4], p[j][kb][8 * ss + 5]); w.w = cvtpk(p[j][kb][8 * ss + 6], p[j][kb][8 * ss + 7]);
                    pk[j][kb][ss] = __builtin_bit_cast(bf16x8, w); } }
            lrun[j] += ls0 + ls1; }
        __builtin_amdgcn_sched_barrier(0);
        GQ_VREAD(0, 0); GQ_VREAD(1, 1);
#pragma unroll
        for (int db = 0; db < 2; ++db) {
#pragma unroll
            for (int kb = 0; kb < 2; ++kb)
#pragma unroll
                for (int ss = 0; ss < 2; ++ss) { const bf16x8 vf = db ? __builtin_shufflevector(vlo[1][2 * kb + ss], vhi[1][2 * kb + ss], 0, 1, 2, 3, 4, 5, 6, 7) : __builtin_shufflevector(vlo[0][2 * kb + ss], vhi[0][2 * kb + ss], 0, 1, 2, 3, 4, 5, 6, 7);
#pragma unroll
                    for (int j = 0; j < 2; ++j) o[j][db] = __builtin_amdgcn_mfma_f32_32x32x16_bf16(vf, pk[j][kb][ss], o[j][db], 0, 0, 0); }
            __builtin_amdgcn_sched_barrier(0); }
#undef GQ_VREAD
        if (((t + 1) & (G - 1)) == 0) { asm volatile("s_waitcnt vmcnt(0)" ::: "memory"); GQ_BAR(); const int g2 = (t + 1) / G + 1; if (g2 < ng) GQ_DMAGROUP(g2); }
    }
#undef GQ_DMA
#undef GQ_DMAGROUP
#undef GQ_BAR
#pragma unroll
    for (int j = 0; j < 2; ++j) { const float l = lrun[j] + __shfl_xor(lrun[j], 32); const float inv = 1.0f / l; const size_t row = (size_t)(seqrow0 + qw0 + 32 * j + r32);
#pragma unroll
        for (int db = 0; db < 2; ++db)
#pragma unroll
            for (int g = 0; g < 4; ++g) { const int d = 32 * db + 8 * g + 4 * hi; const u32x2 gw = *(const u32x2*)(U + row * UP + C_GG + 64 * h + d);
                const float y0 = o[j][db][4 * g] * inv * silu(bflo(gw.x)), y1 = o[j][db][4 * g + 1] * inv * silu(bfhi(gw.x)), y2 = o[j][db][4 * g + 2] * inv * silu(bflo(gw.y)), y3 = o[j][db][4 * g + 3] * inv * silu(bfhi(gw.y));
                u32x2 w; w.x = cvtpk(y0, y1); w.y = cvtpk(y2, y3); *(u32x2*)(Y + row * 512 + 64 * h + d) = w; } }
}
__device__ __forceinline__ void diff_unit(const AV& a, LAS unsigned char* lds, int seqrow0, int L, int h, int qb, int layer) {
    const int tid = ltid(), lane = tid & 63, wave = tid >> 6, r32 = lane & 31, hi = lane >> 5;
    const bf16* U = (const bf16*)(AWS + WS_U); bf16* Y = (bf16*)(AWS + WS_Y) + (size_t)2 * CH * 512; float* DT = (float*)(AWS + WS_DT);
    const float* relb = AIN(I_RELB);
    LAS float* tb = (LAS float*)(lds + ATT_TB_DIFF);
    for (int i = tid; i < 257; i += NT) { const int rel = i - 128, n = rel < 0 ? -rel : rel; int b = rel > 0 ? 16 : 0;
        if (n < 8) b += n; else { const int v = 8 + (31 - __builtin_clz((unsigned)(n * n))) - 6; b += v < 15 ? v : 15; }
        tb[i] = relb[b * 4 + h] * LOG2E; }
    const float bl = relb[15 * 4 + h] * LOG2E, br = relb[31 * 4 + h] * LOG2E;
    const float li = 0.8f - 0.6f * __expf(-0.3f * (float)layer);
    float d1, d2; { const float q1 = AIN(I_LQ1)[layer * 64 + lane], k1 = AIN(I_LK1)[layer * 64 + lane], q2 = AIN(I_LQ2)[layer * 64 + lane], k2 = AIN(I_LK2)[layer * 64 + lane]; d1 = wave_sum(q1 * k1); d2 = wave_sum(q2 * k2); }
    const float lam = __expf(d1) - __expf(d2) + li;
    const int qw0 = qb * 256 + wave * 32, qpos = qw0 + r32; const size_t row = (size_t)(seqrow0 + qpos);
    __syncthreads();
    f32x16 o[4]; float l; float ss = 0.f;
#pragma unroll 1
    for (int c = 0; c < 2; ++c) {
#pragma unroll
        for (int db = 0; db < 4; ++db)
#pragma unroll
            for (int r = 0; r < 16; ++r) o[db][r] = 0.f;
        flash_pass<128, true, true, 2>(lds, U + row * UP + C_DQ + 128 * h + 64 * c, U + (size_t)seqrow0 * UP + C_DK + 128 * h + 64 * c, U + (size_t)seqrow0 * UP + C_DV + 128 * h, L, qpos, qw0, bl, br, o, l);
        if (c == 0) { const float inv = 1.0f / l;
#pragma unroll
            for (int db = 0; db < 4; ++db)
#pragma unroll
                for (int g = 0; g < 4; ++g) { const int d = 32 * db + 8 * g + 4 * hi; *(f32x4*)(DT + row * 512 + 128 * h + d) = (f32x4){o[db][4 * g] * inv, o[db][4 * g + 1] * inv, o[db][4 * g + 2] * inv, o[db][4 * g + 3] * inv}; }
        } else { const float inv = lam / l;
#pragma unroll
            for (int db = 0; db < 4; ++db)
#pragma unroll
                for (int g = 0; g < 4; ++g) { const int d = 32 * db + 8 * g + 4 * hi; const f32x4 o0 = *(const f32x4*)(DT + row * 512 + 128 * h + d);
#pragma unroll
                    for (int e = 0; e < 4; ++e) { const float v = o0[e] - o[db][4 * g + e] * inv; o[db][4 * g + e] = v; ss += v * v; } }
        }
    }
    ss += __shfl_xor(ss, 32);
    const float rs = (1.0f / sqrtf(ss * (1.0f / 128.0f) + EPS)) * (1.0f - li);
    const float* sg = AIN(I_SUBLN) + layer * 128;
#pragma unroll
    for (int db = 0; db < 4; ++db)
#pragma unroll
        for (int g = 0; g < 4; ++g) { const int d = 32 * db + 8 * g + 4 * hi; const u32x2 gw = *(const u32x2*)(U + row * UP + C_DG + 128 * h + d); const f32x4 gn = *(const f32x4*)(sg + d);
            const float y0 = o[db][4 * g] * rs * gn.x * silu(bflo(gw.x)), y1 = o[db][4 * g + 1] * rs * gn.y * silu(bfhi(gw.x)), y2 = o[db][4 * g + 2] * rs * gn.z * silu(bflo(gw.y)), y3 = o[db][4 * g + 3] * rs * gn.w * silu(bfhi(gw.y));
            u32x2 w; w.x = cvtpk(y0, y1); w.y = cvtpk(y2, y3); *(u32x2*)(Y + row * 512 + 128 * h + d) = w; }
}
template <int LOG4, int BATCH> __device__ __forceinline__ void hyena_unit(const AV& a, LAS unsigned char* lds, int seqrow0, int pr0, int layer) {
    constexpr int N = 1 << (2 * LOG4), L = N / 2, NPAD = N + N / 16;
    const int tid = ltid(); LAS f32x2* buf = (LAS f32x2*)lds;
    bf16* Y = (bf16*)(AWS + WS_Y) + (size_t)seqrow0 * 512;
    const unsigned char* sp = AWS + WS_SPEC + layer * SPEC_LAYER;
    constexpr int SPS = (LOG4 == 7) ? SPS_P : SPS_S;
    const f32x2* Pg = ((LOG4 == 7) ? (const f32x2*)sp : (const f32x2*)(sp + 2 * SPEC_P_BYTES)) + (size_t)pr0 * SPS;
    const f32x2* Mg = ((LOG4 == 7) ? (const f32x2*)(sp + SPEC_P_BYTES) : (const f32x2*)(sp + 2 * SPEC_P_BYTES + SPEC_S_BYTES)) + (size_t)pr0 * SPS;
    const f32x2* hvp = (const f32x2*)(AWS + WS_HVP) + (size_t)pr0 * CH + seqrow0; const f32x2* pmp = (const f32x2*)(AWS + WS_PMP) + (size_t)pr0 * CH + seqrow0;
#pragma unroll
    for (int b = 0; b < BATCH; ++b)
        for (int t = tid; t < L; t += NT) { buf[b * NPAD + PADI(t)] = hvp[(size_t)b * CH + t]; buf[b * NPAD + PADI(t + L)] = (f32x2){0.f, 0.f}; }
    __syncthreads();
    const f32x2* tw = (const f32x2*)(AWS + WS_TW);
    fft_fwd<LOG4, BATCH>(buf, tw, tid);
#pragma unroll
    for (int b = 0; b < BATCH; ++b)
        for (int k = tid; k <= L; k += NT) { const int p1 = b * NPAD + PADI(digitrev<LOG4>(k)), p2 = b * NPAD + PADI(digitrev<LOG4>((N - k) & (N - 1))); const f32x2 z1 = buf[p1], z2 = buf[p2], P = Pg[(size_t)b * SPS + k], M = Mg[(size_t)b * SPS + k];
            const f32x2 y1 = cmul(z1, P) + cmul(cconj(z2), M), y2 = cmulc(z2, P) + cmulc(cconj(z1), M);
            buf[p1] = y1; if (p2 != p1) buf[p2] = y2; }
    __syncthreads();
    fft_inv<LOG4, BATCH>(buf, tw, tid);
    for (int t = tid; t < L; t += NT) { unsigned w[BATCH];
#pragma unroll
        for (int b = 0; b < BATCH; ++b) { const f32x2 y = buf[b * NPAD + PADI(t)], m = pmp[(size_t)b * CH + t]; w[b] = cvtpk(y.x * m.x, y.y * m.y); }
        if (BATCH == 4) *(u32x4*)(Y + (size_t)t * 512 + 2 * pr0) = (u32x4){w[0], w[BATCH > 1 ? 1 : 0], w[BATCH > 2 ? 2 : 0], w[BATCH > 3 ? 3 : 0]};
        else *(unsigned*)(Y + (size_t)t * 512 + 2 * pr0) = w[0]; }
    __syncthreads();
}
#define XB_TMO      128
#define XB_XCNT(j)  (256  + 64 * (j))
#define XB_XSUB(j)  (1280 + 64 * (j))
#define XB_XGEN(j)  (2304 + 64 * (j))
#define XB_TOP      3328
#define XB_TOPGEN   3392
#define XCD_BAR_WORDS 3456
#define XB_SPIN_CAP (1u << 18)

__device__ __forceinline__ unsigned xb_ld(unsigned* p)              { return __hip_atomic_load(p, __ATOMIC_RELAXED, __HIP_MEMORY_SCOPE_AGENT); }
__device__ __forceinline__ unsigned xb_add(unsigned* p, unsigned v) { return __hip_atomic_fetch_add(p, v, __ATOMIC_RELAXED, __HIP_MEMORY_SCOPE_AGENT); }
__device__ __forceinline__ unsigned xb_xcc_id() { return (unsigned)__builtin_amdgcn_s_getreg((3 << 11) | 20) & 0xFu; }
#define XB_SPIN(cond, bar) do { unsigned _sp = 0; while (cond) { __builtin_amdgcn_s_sleep(1); \
    if ((++_sp & 255u) == 0u) { if (xb_ld(&(bar)[XB_TMO])) break; if (_sp > XB_SPIN_CAP) { atomicAdd(&(bar)[XB_TMO], 1u); break; } } } } while (0)

struct XcdBarrier {
    unsigned* bar; unsigned x;
    volatile LAS unsigned* st;
};

__device__ __forceinline__ XcdBarrier xcd_barrier_post(unsigned* bar, volatile LAS unsigned* st) {
    XcdBarrier b; b.bar = bar; b.x = xb_xcc_id(); b.st = st;
    if (threadIdx.x == 0) (void)xb_add(&bar[XB_XCNT(b.x)], 1u);
    return b;
}
__device__ __forceinline__ void xcd_barrier_complete(unsigned* bar, unsigned x, unsigned& nloc, unsigned& nx) {
    const unsigned G = gridDim.x * gridDim.y * gridDim.z;
    unsigned sum, cnt, mine, sp = 0u;
    for (;;) {
        sum = 0u; cnt = 0u; mine = 0u;
#pragma unroll
        for (unsigned j = 0; j < 16; ++j) { const unsigned c = xb_ld(&bar[XB_XCNT(j)]); sum += c; cnt += (c > 0u) ? 1u : 0u; mine = (j == x) ? c : mine; }
        if (sum == G) break;
        __builtin_amdgcn_s_sleep(1);
        if ((++sp & 255u) == 0u) { if (xb_ld(&bar[XB_TMO])) break; if (sp > XB_SPIN_CAP) { atomicAdd(&bar[XB_TMO], 1u); break; } }
    }
    nloc = mine > 0u ? mine : 1u; nx = cnt > 0u ? cnt : 1u;
}

__device__ __forceinline__ void xcd_barrier(const XcdBarrier& b) {
    asm volatile("s_waitcnt vmcnt(0)" ::: "memory");
    __syncthreads();
    if (threadIdx.x == 0) {
        unsigned* bar = b.bar;
        __builtin_amdgcn_s_waitcnt(0);
        unsigned nloc = b.st[0], nx = b.st[1];
        if (nloc == 0u) { xcd_barrier_complete(bar, b.x, nloc, nx); b.st[0] = nloc; b.st[1] = nx; }
        const unsigned old = xb_add(&bar[XB_XSUB(b.x)], 1u);
        const unsigned gen = old / nloc;
        if (old + 1u == (gen + 1u) * nloc) {
            __builtin_amdgcn_fence(__ATOMIC_RELEASE, "agent");
            asm volatile("s_waitcnt vmcnt(0)" ::: "memory");
            const unsigned og = xb_add(&bar[XB_TOP], 1u);
            const unsigned tg = og / nx;
            if (og + 1u == (tg + 1u) * nx) xb_add(&bar[XB_TOPGEN], 1u);
            else XB_SPIN(xb_ld(&bar[XB_TOPGEN]) == tg, bar);
            __builtin_amdgcn_fence(__ATOMIC_ACQUIRE, "agent");
            xb_add(&bar[XB_XGEN(b.x)], 1u);
            asm volatile("s_waitcnt vmcnt(0)" ::: "memory");
        } else {
            XB_SPIN(xb_ld(&bar[XB_XGEN(b.x)]) == gen, bar);
            __builtin_amdgcn_fence(__ATOMIC_ACQUIRE, "agent");
            asm volatile("s_waitcnt vmcnt(0)" ::: "memory");
        }
    }
    __syncthreads();
}

__device__ __forceinline__ void step_mix(const AV& a, LAS unsigned char* lds, int c, int layer, unsigned* ctr, int tmask) {
    const Chunk ck = chunk_of(c); const int nqb = ck.L / 256, nqg = ck.L / 512, nD = ck.nseq * 4 * nqb, nG = ck.nseq * 8 * nqg, nF = (ck.L == LP) ? ck.nseq * 256 : ck.nseq * 64, total = nD + nG + nF;
    volatile LAS unsigned* wq = (volatile LAS unsigned*)(lds + LDS_MAIN);
    for (;;) {
        if (ltid() == 0) wq[0] = atomicAdd(ctr, 1u);
        __syncthreads();
        const int u = (int)wq[0];
        __syncthreads();
        if (u >= total) break;
        if (u < nD) { if (tmask & 1) { const int qb = u % nqb, sh = u / nqb, h = sh & 3, s = sh >> 2; diff_unit(a, lds, s * ck.L, ck.L, h, qb, layer); } }
        else if (u < nD + nG) { if (tmask & 2) { const int v = u - nD, qb = v % nqg, sh = v / nqg, h = sh & 7, s = sh >> 3; gqa_unit(a, lds, s * ck.L, ck.L, h, qb); } }
        else { if (tmask & 4) { const int v = u - nD - nG; if (ck.L == LP) hyena_unit<7, 1>(a, lds, (v >> 8) * LP, v & 255, layer); else hyena_unit<6, 4>(a, lds, (v >> 6) * LS, (v & 63) * 4, layer); } }
    }
}
constexpr int STEPS_PER = 6, NPRO = 3, NSTEPS = NPRO + NCHUNK * 2 * STEPS_PER + 1;
__global__ void __launch_bounds__(NT, 2) mega_fwd(Args kargs) {
    extern __shared__ __attribute__((aligned(16))) unsigned char lds_raw[];
    LAS unsigned char* lds = (LAS unsigned char*)lds_raw;
    cg::grid_group grid = cg::this_grid();
    kargp_t kp = (kargp_t)__builtin_amdgcn_kernarg_segment_ptr();
    { volatile LAS unsigned* misc = (volatile LAS unsigned*)(lds + LDS_MAIN + 64); if (ltid() < 16) misc[ltid()] = 0u; }
    __syncthreads();
    XcdBarrier xbar = xcd_barrier_post((unsigned*)(kargs.ws + WS_CTL) + CW_BAR, (volatile LAS unsigned*)(lds + LDS_MAIN + 64 + 32));
    const int step_lo = kargs.lo, step_hi = kargs.hi;
#pragma unroll 1
    for (int step = step_lo; step < step_hi; ++step) {
        asm volatile("" : "+s"(kp));
        AV a; a.p = kp; unsigned char* ws = AWS;
        if (step == 0) { if (EN(0)) step_pro_a(a, lds); }
        else if (step == 1) { if (EN(11)) { step_pro_a2(a, lds); if (DUP_MASK & 32) { xcd_barrier(xbar); step_pro_a2(a, lds); } } }
        else if (step == 2) { if (EN(1)) { step_pro_b(a, lds); if (DUP_MASK & 64) { xcd_barrier(xbar); step_pro_b(a, lds); } } }
        else if (step == NSTEPS - 1) { if (DUP_MASK & 256) { for (int q = 0; q < 100; ++q) xcd_barrier(xbar); } if (EN(2)) step_final(a); }
        else {
            const int s2 = step - NPRO, cl = s2 / STEPS_PER, k = s2 - cl * STEPS_PER, c = cl >> 1, layer = cl & 1;
            const Chunk ck = chunk_of(c);
            if (k == 0) { if (layer == 0) continue;
                if (EN(3)) { step_norm(a, c, layer); if (DUP_MASK & 128) { xcd_barrier(xbar); step_norm(a, c, layer); } } }
            else if (k == 2) { if (EN(5)) { step_prep(a, c, layer); step_prep_hy(a, lds, c, layer); } }
            else if (k == 3) {
#pragma unroll 1
                for (int rep = 0; rep < ((DUP_MASK & 7) ? 2 : 1); ++rep) { if (rep) xcd_barrier(xbar); step_mix(a, lds, c, layer, (unsigned*)(ws + WS_CTL) + step * 16 + 4 * rep, rep ? (DUP_MASK & 7) : 7); } }
            else { if (EN(4)) {
                pg8::Gemm g; pg8::OrderAll S; pg8::EpiAll E; const int G = (int)gridDim.x, bid = lbid();
                S.so.init(CH, k == 1 ? NCAT : 1024, G, bid); S.o2 = pg8::OrderG2{CH / 256, G, bid}; S.mode = (k == 4) ? 2 : 1;
                float* O = AOUT + (size_t)ck.tok0 * DM; const float* X = layer == 0 ? xin_rows(a, ck.tok0) : O;
                E.mode = (k == 1) ? 1 : (k == 4) ? 2 : 3;
                E.e1 = pg8::EpiG1{(pg8::bf16_t*)(ws + WS_U), (pg8::bf16_t*)(ws + WS_G), AIN(I_BMERGE) + layer * GP};
                E.e2 = pg8::EpiG2{(const pg8::bf16_t*)(ws + WS_G), (float*)(ws + WS_TMP), (pg8::bf16_t*)(ws + WS_MG), CH / 256};
                E.e3 = pg8::EpiG3{X, O};
                if (k == 1) g = pg8::Gemm{layer == 0 ? (const pg8::bf16_t*)(ws + WS_HN0) + (size_t)ck.tok0 * DM : (const pg8::bf16_t*)(ws + WS_HN), (const pg8::bf16_t*)(ws + WS_WCAT + layer * WCAT_BYTES), CH, NCAT, 1024};
                else if (k == 4) g = pg8::Gemm{(const pg8::bf16_t*)(ws + WS_Y), (const pg8::bf16_t*)(ws + WS_WBT + layer * WBT_BYTES), 3 * CH, 3072, 512};
                else g = pg8::Gemm{(const pg8::bf16_t*)(ws + WS_MG), (const pg8::bf16_t*)(ws + WS_WOT + layer * WOT_BYTES), CH, 1024, 1024};
                const int nrep = (((DUP_MASK & 8) && k == 1) || ((DUP_MASK & 16) && k == 4)) ? 2 : 1;
#pragma unroll 1
                for (int rep = 0; rep < nrep; ++rep) { if (rep) xcd_barrier(xbar); pg8::gemm_phase<pg8::EpiAll, pg8::OrderAll, true, true>(lds, g, S, E); }
            } }
        }
        if (step + 1 < step_hi) { if (step == 0) grid.sync(); else xcd_barrier(xbar); }
    }
}
#ifndef MK_MULTI
#define MK_MULTI 0
#endif
extern "C" void kernel_launch(void* const* d_in, const int* in_sizes, int n_in, void* d_out, int out_size, void* d_ws, size_t ws_size, hipStream_t stream) {
    static int grid = 0;
    if (grid == 0) {
        if (n_in != N_IN || out_size != NTOK * DM || ws_size < WS_END) { fprintf(stderr, "kernel_launch: unexpected shapes (n_in %d, out %d, ws %zu)\n", n_in, out_size, ws_size); grid = -1; return; }
        int dev = 0, cus = 0, per_cu = 0;
        hipGetDevice(&dev); hipDeviceGetAttribute(&cus, hipDeviceAttributeMultiprocessorCount, dev);
        if (hipFuncSetAttribute((const void*)mega_fwd, hipFuncAttributeMaxDynamicSharedMemorySize, LDS_BYTES) != hipSuccess) { fprintf(stderr, "kernel_launch: hipFuncSetAttribute failed\n"); grid = -1; return; }
        hipOccupancyMaxActiveBlocksPerMultiprocessor(&per_cu, (const void*)mega_fwd, NT, LDS_BYTES);
        (void)hipGetLastError();
        if (per_cu < 1) per_cu = 1;
        grid = cus * 1;
        fprintf(stderr, "kernel_launch: cus %d per_cu %d grid %d\n", cus, per_cu, grid);
    }
    if (grid < 0) return;
    hipMemsetAsync((char*)d_ws + WS_CTL, 0, CTL_BYTES, stream);
    Args a{};
    for (int i = 0; i < N_IN; ++i) a.in[i] = (const float*)d_in[i];
    a.out = (float*)d_out; a.ws = (unsigned char*)d_ws;
#if MK_MULTI
    for (int s = 0; s < NSTEPS; ++s) { a.lo = s; a.hi = s + 1; hipLaunchKernelGGL(mega_fwd, dim3(grid), dim3(NT), LDS_BYTES, stream, a); }
#else
    a.lo = 0; a.hi = NSTEPS;
    void* args[] = {&a};
    hipError_t e = hipLaunchCooperativeKernel((const void*)mega_fwd, dim3(grid), dim3(NT), args, LDS_BYTES, stream);
    if (e != hipSuccess) fprintf(stderr, "cooperative launch failed: %s (grid %d)\n", hipGetErrorString(e), grid);
#endif
}
```

```cpp
#include <hip/hip_runtime.h>
#include <hip/hip_cooperative_groups.h>
#include <cstdio>
#include <cstdint>
namespace cg = cooperative_groups;
__device__ __forceinline__ int ltid() { int t = (int)threadIdx.x; asm volatile("" : "+v"(t)); return t; }
__device__ __forceinline__ int lbid() { int b = (int)blockIdx.x; asm volatile("" : "+s"(b)); return b; }
namespace pg8 {
#define PG8_LAS __attribute__((address_space(3)))
typedef unsigned short bf16_t;
typedef short bf16x8 __attribute__((ext_vector_type(8)));
typedef float f32x4 __attribute__((ext_vector_type(4)));
typedef unsigned u32x4 __attribute__((ext_vector_type(4)));
constexpr int BM = 256, BK = 64, HALF = 128, HTB = HALF * BK * 2  , STAGE_BYTES = 8 * HTB, NXCD = 8, WGM = 8;

__host__ __device__ __forceinline__ int lds_byte(int r, int c) { const int st = (r >> 4) * 2 + (c >> 5), rr = r & 15, cc = c & 31, ob = rr * 64 + cc * 2; return st * 1024 + (ob ^ (((ob >> 9) & 1) << 5)); }
__host__ __device__ __forceinline__ void stage_rc(int b, int& R, int& C) { const int st = b / 1024, sb = b % 1024, swz = sb ^ (((sb >> 9) & 1) << 5); R = (st >> 1) * 16 + swz / 64; C = (st & 1) * 32 + (swz % 64) / 2; }
__host__ __device__ __forceinline__ int perm32(int rho) { const int n = rho >> 4, i = rho & 15; return 8 * (i >> 2) + 4 * n + (i & 3); }

struct Unit { int pm, pn; };
struct Gemm { const bf16_t* A; const bf16_t* Bt; int M, N, K; };

struct StaticOrder {
    int nM, nN, nwg, G, c;
    __host__ __device__ void init(int M, int N, int G_, int c_) { nM = M / BM; nN = N / BM; nwg = nM * nN; G = G_; c = c_; }
    __host__ __device__ bool next(int i, Unit& u) const {
        const long L = (long)i * G + c; if (L >= nwg) return false;
        int wgid = (int)L; { const int q = nwg / NXCD, r = nwg % NXCD, xcd = wgid % NXCD, off = wgid / NXCD; wgid = (xcd < r ? xcd * (q + 1) : r * (q + 1) + (xcd - r) * q) + off; }
        const int nig = WGM * nN, gid = wgid / nig, fm = gid * WGM, gsz = (nM - fm) < WGM ? (nM - fm) : WGM;
        u.pm = fm + ((wgid % nig) % gsz); u.pn = (wgid % nig) / gsz; return true;
    }
    __device__ __forceinline__ void a_ready(const Unit&) const {}
    __device__ __forceinline__ void done(const Unit&) const {}
};

__device__ __forceinline__ unsigned cvt_pk_bf16(float lo, float hi) { unsigned r; asm volatile("v_cvt_pk_bf16_f32 %0, %1, %2" : "=v"(r) : "v"(lo), "v"(hi)); return r; }
template <class Epi, class Sched, bool ALIGN_EPI = false, bool SP2 = false>
__device__ __forceinline__ void gemm_phase(PG8_LAS unsigned char* lds, const Gemm g, const Sched& S, const Epi& E) {
    const int tid = ltid(), wid = __builtin_amdgcn_readfirstlane(tid >> 6), lane = tid & 63, wr = wid >> 2, wc = wid & 3, fr = lane & 15, fq = lane >> 4;
    const int K = g.K, nt = K / BK;
    unsigned voffA[2], voffB[2];
#pragma unroll
    for (int i = 0; i < 2; ++i) { int R, C; stage_rc(tid * 16 + i * 8192, R, C); const int Rb = Epi::PERM ? ((R & ~31) + perm32(R & 31)) : R;
        voffA[i] = (unsigned)(R * K + C) * 2u; voffB[i] = (unsigned)(Rb * K + C) * 2u; }
    const size_t kstep = (size_t)(BK * 2);
    const size_t hstep = (size_t)HALF * K * 2;
    const size_t tstep = 2 * hstep;
    const unsigned ldsw = (unsigned)wid * 1024u;
    const int aoff = lds_byte(wr * 64 + fr, fq * 8), boff = lds_byte(wc * 32 + fr, fq * 8);
#define PG8_SA(b, h) (((b) * 2 + (h)) * HTB)
#define PG8_SB(b, h) ((4 + (b) * 2 + (h)) * HTB)
#define PG8_STAGE(bufoff, gbase, voff) do { _Pragma("unroll") for (int _i = 0; _i < 2; ++_i) \
        __builtin_amdgcn_global_load_lds((const unsigned*)((const char*)(gbase) + (voff)[_i]), (PG8_LAS unsigned*)(lds + (bufoff) + ldsw + _i * 8192), 16, 0, 0); } while (0)
#define PG8_LDA(dst, b, h) do { _Pragma("unroll") for (int m = 0; m < 4; ++m) _Pragma("unroll") for (int k = 0; k < 2; ++k) dst[m][k] = *(const PG8_LAS bf16x8*)(lds + PG8_SA(b, h) + aoff + m * 2048 + k * 1024); } while (0)
#define PG8_LDB(dst, b, h) do { _Pragma("unroll") for (int n = 0; n < 2; ++n) _Pragma("unroll") for (int k = 0; k < 2; ++k) dst[n][k] = *(const PG8_LAS bf16x8*)(lds + PG8_SB(b, h) + boff + n * 2048 + k * 1024); } while (0)
#define PG8_MMA(ai, bj, At, Bt) do { __builtin_amdgcn_s_setprio(1); _Pragma("unroll") for (int m = 0; m < 4; ++m) _Pragma("unroll") for (int n = 0; n < 2; ++n) _Pragma("unroll") for (int k = 0; k < 2; ++k) \
        acc[ai][bj][m][n] = __builtin_amdgcn_mfma_f32_16x16x32_bf16(Bt[n][k], At[m][k], acc[ai][bj][m][n], 0, 0, 0); __builtin_amdgcn_s_setprio(0); } while (0)
#define PG8_WAIT_V(n) asm volatile("s_waitcnt vmcnt(" #n ")" ::: "memory")
#define PG8_WAIT_L(n) asm volatile("s_waitcnt lgkmcnt(" #n ")" ::: "memory")
#define PG8_BAR __builtin_amdgcn_s_barrier()
#define PG8_SCHED __builtin_amdgcn_sched_barrier(0)
    Unit cur, nxt; int ui = 0;
    if (!S.next(0, cur)) return;
    f32x4 acc[2][2][4][2];
#pragma unroll
    for (int a = 0; a < 2; ++a)
#pragma unroll
        for (int b = 0; b < 2; ++b)
#pragma unroll
            for (int m = 0; m < 4; ++m)
#pragma unroll
                for (int n = 0; n < 2; ++n) acc[a][b][m][n] = (f32x4){0.f, 0.f, 0.f, 0.f};
    bf16x8 At[4][2], B0[2][2], B1[2][2];
    const char* cA = (const char*)g.A + (size_t)cur.pm * tstep; const char* cB = (const char*)g.Bt + (size_t)cur.pn * tstep;
    S.a_ready(cur);
    if constexpr (SP2) {
        PG8_STAGE(PG8_SB(0, 0), cB, voffB); PG8_STAGE(PG8_SB(0, 1), cB + hstep, voffB); PG8_STAGE(PG8_SA(0, 0), cA, voffA); PG8_STAGE(PG8_SA(0, 1), cA + hstep, voffA);
        if (wr == 1) PG8_BAR;
        PG8_WAIT_V(2); PG8_BAR;
        PG8_STAGE(PG8_SB(1, 0), cB + kstep, voffB); PG8_STAGE(PG8_SA(1, 0), cA + kstep, voffA); PG8_STAGE(PG8_SB(1, 1), cB + hstep + kstep, voffB);
        PG8_WAIT_V(6); PG8_BAR;
    } else {
        PG8_STAGE(PG8_SB(0, 0), cB, voffB); PG8_STAGE(PG8_SA(0, 0), cA, voffA); PG8_STAGE(PG8_SB(0, 1), cB + hstep, voffB); PG8_STAGE(PG8_SA(0, 1), cA + hstep, voffA);
        if (wr == 1) PG8_BAR;
        PG8_WAIT_V(4); PG8_BAR;
        PG8_STAGE(PG8_SB(1, 0), cB + kstep, voffB); PG8_STAGE(PG8_SA(1, 0), cA + kstep, voffA); PG8_STAGE(PG8_SB(1, 1), cB + hstep + kstep, voffB);
        PG8_WAIT_V(6); PG8_BAR;
    }
    for (;;) {
        const bool has_next = S.next(ui + 1, nxt);
        const char* nA = has_next ? (const char*)g.A + (size_t)nxt.pm * tstep : cA; const char* nB = has_next ? (const char*)g.Bt + (size_t)nxt.pn * tstep : cB;
        for (int t = 0; t < nt; t += 2) {
            const bool last = (t == nt - 2);
            const char* a1 = cA + (size_t)(t + 1) * kstep;
            const char* a2 = last ? nA : cA + (size_t)(t + 2) * kstep; const char* b2 = last ? nB : cB + (size_t)(t + 2) * kstep;
            const char* a3 = a2 + kstep; const char* b3 = b2 + kstep;
            if (last && has_next) S.a_ready(nxt);
            if constexpr (SP2) {
            PG8_LDB(B0, 0, 0); PG8_LDB(B1, 0, 1); PG8_SCHED; PG8_LDA(At, 0, 0); PG8_STAGE(PG8_SA(1, 1), a1 + hstep, voffA);
            PG8_WAIT_V(8); PG8_WAIT_L(0); PG8_BAR; PG8_MMA(0, 0, At, B0); PG8_MMA(0, 1, At, B1); PG8_BAR; PG8_SCHED;
            PG8_LDA(At, 0, 1); PG8_STAGE(PG8_SB(0, 0), b2, voffB); PG8_STAGE(PG8_SB(0, 1), b2 + hstep, voffB); PG8_STAGE(PG8_SA(0, 0), a2, voffA);
            PG8_WAIT_V(8); PG8_WAIT_L(0); PG8_BAR; PG8_MMA(1, 0, At, B0); PG8_MMA(1, 1, At, B1); PG8_BAR; PG8_SCHED;
            PG8_LDB(B0, 1, 0); PG8_LDB(B1, 1, 1); PG8_SCHED; PG8_LDA(At, 1, 0); PG8_STAGE(PG8_SA(0, 1), a2 + hstep, voffA);
            PG8_WAIT_V(8); PG8_WAIT_L(0); PG8_BAR; PG8_MMA(0, 0, At, B0); PG8_MMA(0, 1, At, B1); PG8_BAR; PG8_SCHED;
            PG8_LDA(At, 1, 1); PG8_STAGE(PG8_SB(1, 0), b3, voffB); PG8_STAGE(PG8_SB(1, 1), b3 + hstep, voffB); PG8_STAGE(PG8_SA(1, 0), a3, voffA);
            PG8_WAIT_V(8); PG8_WAIT_L(0); PG8_BAR; PG8_MMA(1, 0, At, B0); PG8_MMA(1, 1, At, B1); PG8_BAR; PG8_SCHED;
            } else {
            PG8_LDB(B0, 0, 0); PG8_SCHED; PG8_LDA(At, 0, 0); PG8_STAGE(PG8_SA(1, 1), a1 + hstep, voffA);
            PG8_WAIT_L(8); PG8_BAR; PG8_WAIT_L(0); PG8_MMA(0, 0, At, B0); PG8_BAR; PG8_SCHED;
            PG8_LDB(B1, 0, 1); PG8_STAGE(PG8_SB(0, 0), b2, voffB);
            PG8_BAR; PG8_WAIT_L(0); PG8_MMA(0, 1, At, B1); PG8_BAR;
            PG8_LDA(At, 0, 1); PG8_STAGE(PG8_SA(0, 0), a2, voffA);
            PG8_BAR; PG8_WAIT_L(0); PG8_MMA(1, 0, At, B0); PG8_BAR; PG8_SCHED;
            PG8_STAGE(PG8_SB(0, 1), b2 + hstep, voffB);
            PG8_WAIT_V(6); PG8_BAR; PG8_MMA(1, 1, At, B1); PG8_BAR;
            PG8_LDB(B0, 1, 0); PG8_SCHED; PG8_LDA(At, 1, 0); PG8_STAGE(PG8_SA(0, 1), a2 + hstep, voffA);
            PG8_WAIT_L(8); PG8_BAR; PG8_WAIT_L(0); PG8_MMA(0, 0, At, B0); PG8_BAR; PG8_SCHED;
            PG8_LDB(B1, 1, 1); PG8_STAGE(PG8_SB(1, 0), b3, voffB);
            PG8_BAR; PG8_WAIT_L(0); PG8_MMA(0, 1, At, B1); PG8_BAR;
            PG8_LDA(At, 1, 1); PG8_STAGE(PG8_SA(1, 0), a3, voffA);
            PG8_BAR; PG8_WAIT_L(0); PG8_MMA(1, 0, At, B0); PG8_BAR; PG8_SCHED;
            PG8_STAGE(PG8_SB(1, 1), b3 + hstep, voffB);
            PG8_WAIT_V(6); PG8_BAR; PG8_MMA(1, 1, At, B1); PG8_BAR;
            }
        }
        if constexpr (ALIGN_EPI) { if (wr == 0) PG8_BAR; }
        if constexpr (!Epi::AFTER_DRAIN) { E(acc, cur, wr, wc, fr, fq); S.done(cur); }
        if (!has_next) break;
#pragma unroll
        for (int a = 0; a < 2; ++a)
#pragma unroll
            for (int b = 0; b < 2; ++b)
#pragma unroll
                for (int m = 0; m < 4; ++m)
#pragma unroll
                    for (int n = 0; n < 2; ++n) acc[a][b][m][n] = (f32x4){0.f, 0.f, 0.f, 0.f};
        cur = nxt; cA = nA; cB = nB; ++ui;
        if constexpr (ALIGN_EPI) { if (wr == 1) PG8_BAR; }
    }
    PG8_WAIT_V(0);
    if constexpr (!ALIGN_EPI) { if (wr == 0) PG8_BAR; }
    PG8_BAR;
    if constexpr (Epi::AFTER_DRAIN) { E.fused(acc, cur, wr, wc, fr, fq, lds, wid, lane); S.done(cur); }
#undef PG8_SA
#undef PG8_SB
#undef PG8_STAGE
#undef PG8_LDA
#undef PG8_LDB
#undef PG8_MMA
#undef PG8_WAIT_V
#undef PG8_WAIT_L
#undef PG8_BAR
#undef PG8_SCHED
}
__device__ __forceinline__ float bf2f(unsigned short h) { return __uint_as_float(((unsigned)h) << 16); }
__device__ __forceinline__ float fast_sigmoid(float x) { return __builtin_amdgcn_rcpf(1.0f + __builtin_amdgcn_exp2f(-1.4426950408889634f * x)); }
struct EpiG1 {
    static constexpr bool PERM = true, AFTER_DRAIN = false;
    bf16_t* U; bf16_t* G; const float* bias;
    __device__ __forceinline__ void operator()(const f32x4 (&acc)[2][2][4][2], const Unit& u, int wr, int wc, int fr, int fq) const {
        const int row0 = u.pm * BM + wr * 64 + fr; int colt = u.pn * BM; const bool isg = colt >= 5376;
        bf16_t* base = U; int ldc = 5376; if (isg) { colt -= 5376; base = G; ldc = 3072; }
        const int col0 = colt + wc * 32 + 8 * fq;
        f32x4 bv[2][2];
#pragma unroll
        for (int bj = 0; bj < 2; ++bj)
#pragma unroll
            for (int n = 0; n < 2; ++n) bv[bj][n] = isg ? *(const f32x4*)(bias + col0 + bj * HALF + 4 * n) : (f32x4){0.f, 0.f, 0.f, 0.f};
#pragma unroll
        for (int ai = 0; ai < 2; ++ai)
#pragma unroll
            for (int m = 0; m < 4; ++m) { bf16_t* rowp = base + (size_t)(row0 + ai * HALF + m * 16) * ldc + col0;
#pragma unroll
                for (int bj = 0; bj < 2; ++bj) { f32x4 v0 = acc[ai][bj][m][0] + bv[bj][0], v1 = acc[ai][bj][m][1] + bv[bj][1];
                    if (isg) {
#pragma unroll
                        for (int e = 0; e < 4; ++e) { v0[e] = fast_sigmoid(v0[e]); v1[e] = fast_sigmoid(v1[e]); } }
                    u32x4 w; w.x = cvt_pk_bf16(v0[0], v0[1]); w.y = cvt_pk_bf16(v0[2], v0[3]); w.z = cvt_pk_bf16(v1[0], v1[1]); w.w = cvt_pk_bf16(v1[2], v1[3]);
                    *(u32x4*)(rowp + bj * HALF) = w; } }
    }
};
struct EpiG2 {
    static constexpr bool PERM = true, AFTER_DRAIN = false;
    const bf16_t* G; float* T; bf16_t* Mg; int npan;
    __device__ __forceinline__ void operator()(const f32x4 (&acc)[2][2][4][2], const Unit& u, int wr, int wc, int fr, int fq) const {
        const int b = u.pm / npan, pm = u.pm - b * npan, pn = u.pn & 3;
        const int row0 = pm * BM + wr * 64 + fr, col0 = pn * BM + wc * 32 + 8 * fq;
#pragma unroll
        for (int ai = 0; ai < 2; ++ai)
#pragma unroll
            for (int m = 0; m < 4; ++m) { const size_t row = (size_t)(row0 + ai * HALF + m * 16);
#pragma unroll
                for (int bj = 0; bj < 2; ++bj) { const int col = col0 + bj * HALF;
                    const u32x4 g = *(const u32x4*)(G + row * 3072 + b * 1024 + col);
                    f32x4 v0 = acc[ai][bj][m][0], v1 = acc[ai][bj][m][1];
                    v0[0] *= __uint_as_float(g.x << 16); v0[1] *= __uint_as_float(g.x & 0xffff0000u); v0[2] *= __uint_as_float(g.y << 16); v0[3] *= __uint_as_float(g.y & 0xffff0000u);
                    v1[0] *= __uint_as_float(g.z << 16); v1[1] *= __uint_as_float(g.z & 0xffff0000u); v1[2] *= __uint_as_float(g.w << 16); v1[3] *= __uint_as_float(g.w & 0xffff0000u);
                    bf16_t* mp = Mg + row * 1024 + col;
                    if (b > 0) { const u32x4 t = *(const u32x4*)mp;
                        v0[0] += __uint_as_float(t.x << 16); v0[1] += __uint_as_float(t.x & 0xffff0000u); v0[2] += __uint_as_float(t.y << 16); v0[3] += __uint_as_float(t.y & 0xffff0000u);
                        v1[0] += __uint_as_float(t.z << 16); v1[1] += __uint_as_float(t.z & 0xffff0000u); v1[2] += __uint_as_float(t.w << 16); v1[3] += __uint_as_float(t.w & 0xffff0000u); }
                    u32x4 w; w.x = cvt_pk_bf16(v0[0], v0[1]); w.y = cvt_pk_bf16(v0[2], v0[3]); w.z = cvt_pk_bf16(v1[0], v1[1]); w.w = cvt_pk_bf16(v1[2], v1[3]);
                    *(u32x4*)mp = w; } }
    }
};
struct OrderG2 {
    int npan, G, c;
    __device__ bool next(int i, Unit& u) const { const int ti = i / 3, b = i - 3 * ti, t = ti * G + c; if (t >= npan * 4) return false;
        const int pm = t >> 2, pn = t & 3; u.pm = b * npan + pm; u.pn = b * 4 + pn; return true; }
    __device__ __forceinline__ void a_ready(const Unit&) const {}
    __device__ __forceinline__ void done(const Unit&) const {}
};
struct EpiG3 {
    static constexpr bool PERM = true, AFTER_DRAIN = false;
    const float* X; float* O;
    __device__ __forceinline__ void operator()(const f32x4 (&acc)[2][2][4][2], const Unit& u, int wr, int wc, int fr, int fq) const {
        const int row0 = u.pm * BM + wr * 64 + fr, col0 = u.pn * BM + wc * 32 + 8 * fq;
#pragma unroll
        for (int ai = 0; ai < 2; ++ai)
#pragma unroll
            for (int m = 0; m < 4; ++m) { const size_t row = (size_t)(row0 + ai * HALF + m * 16);
#pragma unroll
                for (int bj = 0; bj < 2; ++bj) { const size_t p = row * 1024 + col0 + bj * HALF;
                    const f32x4 x0 = *(const f32x4*)(X + p), x1 = *(const f32x4*)(X + p + 4);
                    *(f32x4*)(O + p) = x0 + acc[ai][bj][m][0]; *(f32x4*)(O + p + 4) = x1 + acc[ai][bj][m][1]; } }
    }
};
struct EpiAll {
    static constexpr bool PERM = true, AFTER_DRAIN = false;
    int mode; EpiG1 e1; EpiG2 e2; EpiG3 e3;
    __device__ __forceinline__ void operator()(const f32x4 (&acc)[2][2][4][2], const Unit& u, int wr, int wc, int fr, int fq) const {
        if (mode == 1) e1(acc, u, wr, wc, fr, fq); else if (mode == 2) e2(acc, u, wr, wc, fr, fq); else e3(acc, u, wr, wc, fr, fq); }
};
struct OrderAll {
    int mode; StaticOrder so; OrderG2 o2;
    __device__ __forceinline__ bool next(int i, Unit& u) const { return mode == 2 ? o2.next(i, u) : so.next(i, u); }
    __device__ __forceinline__ void a_ready(const Unit&) const {}
    __device__ __forceinline__ void done(const Unit&) const {}
};
}
#ifndef DUP_MASK
#define DUP_MASK 0
#endif
#ifndef EN_MASK
#define EN_MASK 0xffff
#endif
#define EN(i) ((EN_MASK >> (i)) & 1)
#define LAS __attribute__((address_space(3)))
typedef unsigned short bf16;
typedef float f32x4 __attribute__((ext_vector_type(4)));
typedef float f32x2 __attribute__((ext_vector_type(2)));
typedef unsigned u32x4 __attribute__((ext_vector_type(4)));
typedef unsigned u32x2 __attribute__((ext_vector_type(2)));
constexpr int DM = 1024, NTOK_P = 65536, NTOK_S = 32768, NTOK = NTOK_P + NTOK_S, LP = 8192, LS = 2048;
constexpr int CH = 16384, NCHUNK = NTOK / CH, NCH_P = NTOK_P / CH;
constexpr int UP = 5376, NCAT = 8448, GP = 3072;
constexpr int C_X0 = 0, C_X1 = 512, C_HV = 1024, C_HG = 1536, C_GQ = 2048, C_GK = 2560, C_GV = 2688, C_GG = 2816, C_DQ = 3328, C_DK = 3840, C_DV = 4352, C_DG = 4864;
constexpr float EPS = 1e-6f, LOG2E = 1.4426950408889634f;
constexpr int NT = 512, NWAVES = 8;
enum { I_XP = 0, I_XS, I_RELB, I_NORMG, I_WIN, I_CONVW, I_CONVB, I_FW1, I_FB1, I_FW2, I_FB2, I_FWOUT, I_FFREQ, I_HYBIAS, I_QNG, I_KNG, I_LQ1, I_LK1, I_LQ2, I_LK2, I_SUBLN, I_WBHY, I_WBGQ, I_WBDF, I_WMERGE, I_BMERGE, I_WOUT, I_FINALG, N_IN };
constexpr size_t MiB = 1u << 20;
constexpr size_t WS_CTL = 0, CTL_BYTES = 64 * 1024;
constexpr size_t WS_TW = 1 * MiB;
constexpr size_t WS_WCAT = 2 * MiB, WCAT_BYTES = (size_t)NCAT * 1024 * 2;
constexpr size_t WS_WBT = 40 * MiB, WBT_BYTES = (size_t)3 * 1024 * 512 * 2;
constexpr size_t WS_WOT = 46 * MiB, WOT_BYTES = (size_t)1024 * 1024 * 2;
constexpr int SPS_P = LP + 16, SPS_S = LS + 16;
constexpr size_t SPEC_P_BYTES = (size_t)256 * SPS_P * 8, SPEC_S_BYTES = (size_t)256 * SPS_S * 8;
constexpr size_t SPEC_LAYER = 2 * SPEC_P_BYTES + 2 * SPEC_S_BYTES;
constexpr size_t WS_SPEC = 52 * MiB;
constexpr size_t WS_HN = 140 * MiB, WS_U = 172 * MiB, WS_G = 340 * MiB, WS_Y = 436 * MiB, WS_MG = 484 * MiB, WS_TMP = 516 * MiB, WS_DT = 580 * MiB, WS_HVP = 612 * MiB, WS_PMP = 644 * MiB, WS_ROPE = 676 * MiB, WS_HN0 = 680 * MiB, WS_END = 872 * MiB;
constexpr size_t HF_P_BYTES = (size_t)LP * 1024 * 4, HF_S_BYTES = (size_t)LS * 1024 * 4;
static_assert(WS_WCAT + 2 * WCAT_BYTES <= WS_WBT && WS_WBT + 2 * WBT_BYTES <= WS_WOT && WS_WOT + 2 * WOT_BYTES <= WS_SPEC && WS_SPEC + 2 * SPEC_LAYER <= WS_HN, "ws map");
static_assert(WS_HN + (size_t)CH * 1024 * 2 <= WS_U && WS_U + (size_t)CH * UP * 2 <= WS_G && WS_G + (size_t)CH * GP * 2 <= WS_Y && WS_Y + (size_t)3 * CH * 512 * 2 <= WS_MG && WS_MG + (size_t)CH * 1024 * 2 <= WS_TMP && WS_TMP + (size_t)CH * 1024 * 4 <= WS_DT && WS_DT + (size_t)CH * 512 * 4 <= WS_END, "ws map 2");
static_assert(2 * (HF_P_BYTES + HF_S_BYTES) <= (size_t)CH * UP * 2, "hf overlay");
constexpr int LDS_MAIN = 139264, LDS_BYTES = LDS_MAIN + 1024;
constexpr int CW_BAR = 4096;

struct Args { const float* in[N_IN]; float* out; unsigned char* ws; int lo, hi; };
typedef const __attribute__((address_space(4))) unsigned long long* kargp_t;
struct AV { kargp_t p; };
#define AIN(i) ((const float*)(a.p[(i)]))
#define AOUT ((float*)(a.p[N_IN]))
#define AWS ((unsigned char*)(a.p[N_IN + 1]))


__device__ __forceinline__ float bf2f(unsigned short h) { return __uint_as_float(((unsigned)h) << 16); }
__device__ __forceinline__ float bflo(unsigned w) { return __uint_as_float(w << 16); }
__device__ __forceinline__ float bfhi(unsigned w) { return __uint_as_float(w & 0xffff0000u); }
__device__ __forceinline__ unsigned f2bf(float f) { unsigned u = __builtin_bit_cast(unsigned, f); return (u + 0x7fffu + ((u >> 16) & 1u)) >> 16; }
__device__ __forceinline__ unsigned pk2(float lo, float hi) { return f2bf(lo) | (f2bf(hi) << 16); }
__device__ __forceinline__ float silu(float x) { return x * __builtin_amdgcn_rcpf(1.0f + __builtin_amdgcn_exp2f(-LOG2E * x)); }
__device__ __forceinline__ float wave_sum(float v) {
#pragma unroll
    for (int o = 1; o < 64; o <<= 1) v += __shfl_xor(v, o);
    return v;
}
__device__ __forceinline__ double kd(double v) { asm volatile("" : "+s"(v)); return v; }
__device__ __forceinline__ void sincos_rev(double r, float& s, float& c) {
    r -= __builtin_rint(r);
    const double k = __builtin_rint(r * 4.0);
    const double x = (r - k * 0.25) * kd(6.283185307179586476925);
    const double x2 = x * x;
    double sp = kd(1.0 / 6227020800.0); sp = sp * x2 + kd(-1.0 / 39916800); sp = sp * x2 + kd(1.0 / 362880); sp = sp * x2 + kd(-1.0 / 5040); sp = sp * x2 + kd(1.0 / 120); sp = sp * x2 + kd(-1.0 / 6); sp = sp * x2 + 1.0; sp *= x;
    double cp = kd(-1.0 / 87178291200.0); cp = cp * x2 + kd(1.0 / 479001600.0); cp = cp * x2 + kd(-1.0 / 3628800); cp = cp * x2 + kd(1.0 / 40320); cp = cp * x2 + kd(-1.0 / 720); cp = cp * x2 + kd(1.0 / 24); cp = cp * x2 + (-0.5); cp = cp * x2 + 1.0;
    const int q = ((int)k) & 3;
    const float sf = (float)sp, cf = (float)cp;
    s = (q == 0) ? sf : (q == 1) ? cf : (q == 2) ? -sf : -cf;
    c = (q == 0) ? cf : (q == 1) ? -sf : (q == 2) ? -cf : sf;
}
__device__ __forceinline__ float sin_acc(float x) { float s, c; sincos_rev((double)x * 0.15915494309189533577, s, c); return s; }

__device__ __forceinline__ void transpose_item(const float* W, int K, int N, bf16* WT, int row_off, LAS float* scr, int item, int lane) {
    const int nblk = N / 32, kb = item / nblk, nb = item % nblk, k0 = 64 * kb, n0 = 32 * nb;
#pragma unroll 8
    for (int i = 0; i < 32; ++i) { const int kk = 2 * i + (lane >> 5); scr[kk * 33 + (lane & 31)] = W[(size_t)(k0 + kk) * N + n0 + (lane & 31)]; }
    asm volatile("s_waitcnt lgkmcnt(0)" ::: "memory");
    const int c = lane & 7;
#pragma unroll
    for (int j = 0; j < 4; ++j) { const int n = (lane >> 3) + 8 * j; const LAS float* s = scr + (8 * c) * 33 + n;
        u32x4 o; o.x = pk2(s[0 * 33], s[1 * 33]); o.y = pk2(s[2 * 33], s[3 * 33]); o.z = pk2(s[4 * 33], s[5 * 33]); o.w = pk2(s[6 * 33], s[7 * 33]);
        *(u32x4*)(WT + (size_t)(row_off + n0 + n) * K + k0 + 8 * c) = o; }
    asm volatile("s_waitcnt lgkmcnt(0)" ::: "memory");
}

__device__ __forceinline__ f32x2 cmul(f32x2 a, f32x2 b) { return (f32x2){a.x * b.x - a.y * b.y, a.x * b.y + a.y * b.x}; }
__device__ __forceinline__ f32x2 cmulc(f32x2 a, f32x2 b) { return (f32x2){a.x * b.x + a.y * b.y, a.y * b.x - a.x * b.y}; }
__device__ __forceinline__ f32x2 cconj(f32x2 a) { return (f32x2){a.x, -a.y}; }
template <int LOG4> __device__ __forceinline__ int digitrev(int k) { unsigned x = __builtin_bitreverse32((unsigned)k) >> (32 - 2 * LOG4); return (int)(((x & 0x55555555u) << 1) | ((x >> 1) & 0x55555555u)); }
#define PADI(i) ((i) + ((i) >> 4))
#define W16C 0.92387953251128674f
#define W16S 0.38268343236508977f
#define W16H 0.70710678118654752f
__device__ __forceinline__ f32x2 w16(int m) { return m == 0 ? (f32x2){1.f, 0.f} : m == 1 ? (f32x2){W16C, -W16S} : m == 2 ? (f32x2){W16H, -W16H} : m == 3 ? (f32x2){W16S, -W16C} : m == 4 ? (f32x2){0.f, -1.f} : m == 6 ? (f32x2){-W16H, -W16H} : (f32x2){-W16C, W16S}; }
__device__ __forceinline__ void bfly_fwd(f32x2& a0, f32x2& a1, f32x2& a2, f32x2& a3) {
    const f32x2 t0 = a0 + a2, t1 = a0 - a2, t2 = a1 + a3, t3 = a1 - a3;
    a0 = t0 + t2; a2 = t0 - t2; a1 = (f32x2){t1.x + t3.y, t1.y - t3.x}; a3 = (f32x2){t1.x - t3.y, t1.y + t3.x};
}
__device__ __forceinline__ void bfly_inv(f32x2& b0, f32x2& b1, f32x2& b2, f32x2& b3) {
    const f32x2 t0 = b0 + b2, t1 = b0 - b2, t2 = b1 + b3, t3 = b1 - b3;
    b0 = t0 + t2; b2 = t0 - t2; b1 = (f32x2){t1.x - t3.y, t1.y + t3.x}; b3 = (f32x2){t1.x + t3.y, t1.y - t3.x};
}
template <int LOG4, int BATCH = 1> __device__ __forceinline__ void fft_fwd(LAS f32x2* buf, const f32x2* __restrict__ tw, int tid) {
    constexpr int N = 1 << (2 * LOG4), TWS = 16384 / N;
#pragma unroll 1
    for (int pass = 0; pass < LOG4 - 2; ++pass) {
        const int lq = 2 * (LOG4 - pass) - 2, q4 = 1 << lq, n = q4 << 2, tstep = TWS << (2 * pass);
        constexpr int IT = BATCH * N / 4 / NT, NPAD = N + N / 16;
        f32x2 wl[IT];
#pragma unroll
        for (int i = 0; i < IT; ++i) wl[i] = tw[((tid + i * NT) & (q4 - 1)) * tstep];
#pragma unroll
        for (int i = 0; i < IT; ++i) { const int jg = tid + i * NT, bo = (jg >> (2 * LOG4 - 2)) * NPAD, j = jg & (N / 4 - 1);
            const int blk = j >> lq, jj = j & (q4 - 1), base = blk * n + jj;
            const int i0 = bo + PADI(base), i1 = bo + PADI(base + q4), i2 = bo + PADI(base + 2 * q4), i3 = bo + PADI(base + 3 * q4);
            const f32x2 w1 = wl[i];
            f32x2 a0 = buf[i0], a1 = buf[i1], a2 = buf[i2], a3 = buf[i3];
            bfly_fwd(a0, a1, a2, a3);
            const f32x2 w2 = cmul(w1, w1), w3 = cmul(w2, w1);
            buf[i0] = a0; buf[i1] = cmul(a1, w1); buf[i2] = cmul(a2, w2); buf[i3] = cmul(a3, w3);
        }
        __syncthreads();
    }
#pragma unroll 1
    for (int b = tid; b < BATCH * N / 16; b += NT) {
        LAS f32x2* xb = buf + 17 * b; f32x2 x[16];
#pragma unroll
        for (int e = 0; e < 16; ++e) x[e] = xb[e];
#pragma unroll
        for (int jj = 0; jj < 4; ++jj) { bfly_fwd(x[jj], x[jj + 4], x[jj + 8], x[jj + 12]); if (jj) { x[jj + 4] = cmul(x[jj + 4], w16(jj)); x[jj + 8] = cmul(x[jj + 8], w16(2 * jj)); x[jj + 12] = cmul(x[jj + 12], w16(3 * jj)); } }
#pragma unroll
        for (int q = 0; q < 4; ++q) bfly_fwd(x[4 * q], x[4 * q + 1], x[4 * q + 2], x[4 * q + 3]);
#pragma unroll
        for (int e = 0; e < 16; ++e) xb[e] = x[e];
    }
    __syncthreads();
}
template <int LOG4, int BATCH = 1> __device__ __forceinline__ void fft_inv(LAS f32x2* buf, const f32x2* __restrict__ tw, int tid) {
    constexpr int N = 1 << (2 * LOG4), TWS = 16384 / N;
#pragma unroll 1
    for (int b = tid; b < BATCH * N / 16; b += NT) {
        LAS f32x2* xb = buf + 17 * b; f32x2 x[16];
#pragma unroll
        for (int e = 0; e < 16; ++e) x[e] = xb[e];
#pragma unroll
        for (int q = 0; q < 4; ++q) bfly_inv(x[4 * q], x[4 * q + 1], x[4 * q + 2], x[4 * q + 3]);
#pragma unroll
        for (int jj = 0; jj < 4; ++jj) { if (jj) { x[jj + 4] = cmulc(x[jj + 4], w16(jj)); x[jj + 8] = cmulc(x[jj + 8], w16(2 * jj)); x[jj + 12] = cmulc(x[jj + 12], w16(3 * jj)); } bfly_inv(x[jj], x[jj + 4], x[jj + 8], x[jj + 12]); }
#pragma unroll
        for (int e = 0; e < 16; ++e) xb[e] = x[e];
    }
    __syncthreads();
#pragma unroll 1
    for (int pass = LOG4 - 3; pass >= 0; --pass) {
        const int lq = 2 * (LOG4 - pass) - 2, q4 = 1 << lq, n = q4 << 2, tstep = TWS << (2 * pass);
        constexpr int IT = BATCH * N / 4 / NT, NPAD = N + N / 16;
        f32x2 wl[IT];
#pragma unroll
        for (int i = 0; i < IT; ++i) wl[i] = tw[((tid + i * NT) & (q4 - 1)) * tstep];
#pragma unroll
        for (int i = 0; i < IT; ++i) { const int jg = tid + i * NT, bo = (jg >> (2 * LOG4 - 2)) * NPAD, j = jg & (N / 4 - 1);
            const int blk = j >> lq, jj = j & (q4 - 1), base = blk * n + jj;
            const int i0 = bo + PADI(base), i1 = bo + PADI(base + q4), i2 = bo + PADI(base + 2 * q4), i3 = bo + PADI(base + 3 * q4);
            const f32x2 w1 = wl[i];
            const f32x2 w2 = cmul(w1, w1), w3 = cmul(w2, w1);
            f32x2 b0 = buf[i0], b1 = cmulc(buf[i1], w1), b2 = cmulc(buf[i2], w2), b3 = cmulc(buf[i3], w3);
            bfly_inv(b0, b1, b2, b3);
            buf[i0] = b0; buf[i1] = b1; buf[i2] = b2; buf[i3] = b3;
        }
        __syncthreads();
    }
}
__device__ const double ROPE_IF[16] = {1.0, 0.5623413251903491, 0.31622776601683794, 0.1778279410038923, 0.1, 0.05623413251903491, 0.03162277660168379, 0.01778279410038923,
    0.01, 0.005623413251903491, 0.0031622776601683794, 0.0017782794100389228, 0.001, 0.0005623413251903491, 0.00031622776601683794, 0.00017782794100389227};
struct Chunk { int tok0, L, nseq; };
__device__ __forceinline__ Chunk chunk_of(int c) { Chunk k; k.tok0 = c * CH; if (c < NCH_P) { k.L = LP; k.nseq = CH / LP; } else { k.L = LS; k.nseq = CH / LS; } return k; }
__device__ __forceinline__ const float* xin_rows(const AV& a, int tok0) { return tok0 < NTOK_P ? AIN(I_XP) + (size_t)tok0 * DM : AIN(I_XS) + (size_t)(tok0 - NTOK_P) * DM; }
__device__ __forceinline__ void hf_group(LAS float* sm, const AV& a, int layer, int L, int t0, float* hf, int tid) {
    LAS float* zs = sm; LAS float* A = sm + 512; LAS float* B = sm + 1024;
    const float* w1 = AIN(I_FW1) + layer * 33 * 64; const float* b1 = AIN(I_FB1) + layer * 64;
    const float* w2 = AIN(I_FW2) + layer * 2 * 64 * 64; const float* b2 = AIN(I_FB2) + layer * 2 * 64;
    const float* wo = AIN(I_FWOUT) + layer * 64 * 1024; const float* fr = AIN(I_FFREQ) + layer * 64;
    const int tt = tid >> 6, j = tid & 63, t = t0 + tt;
    const float t01 = (float)t / (float)(L - 1);
    if (j < 33) {
        float v;
        if (j == 0) v = t01;
        else { const int k = (j - 1) & 15; const double f = kd(1e-4) + (double)k * kd((15.0 - 1e-4) / 15.0); float s, c; sincos_rev(f * (double)t / (double)L, s, c); v = (j <= 16) ? c : -s; }
        zs[tt * 40 + j] = v;
    }
    __syncthreads();
    const float fq = fr[j];
    { float acc = b1[j]; for (int i = 0; i < 33; ++i) acc += zs[tt * 40 + i] * w1[i * 64 + j]; A[tt * 64 + j] = sin_acc(fq * acc); }
    __syncthreads();
    { float acc = b2[j]; for (int i = 0; i < 64; ++i) acc += A[tt * 64 + i] * w2[i * 64 + j]; B[tt * 64 + j] = sin_acc(fq * acc); }
    __syncthreads();
    { float acc = b2[64 + j]; for (int i = 0; i < 64; ++i) acc += B[tt * 64 + i] * w2[4096 + i * 64 + j]; A[tt * 64 + j] = sin_acc(fq * acc); }
    __syncthreads();
    { float acc0[8], acc1[8];
#pragma unroll
      for (int q = 0; q < 8; ++q) { acc0[q] = 0.f; acc1[q] = 0.f; }
#pragma unroll 8
      for (int i = 0; i < 64; ++i) { const float wa = wo[i * 1024 + tid], wb = wo[i * 1024 + 512 + tid];
#pragma unroll
          for (int q = 0; q < 8; ++q) { const float av = A[q * 64 + i]; acc0[q] += av * wa; acc1[q] += av * wb; } }
      const float ad = 3.070113457325394f + (float)tid * ((15.350567286626973f - 3.070113457325394f) / 511.0f);
#pragma unroll
      for (int q = 0; q < 8; ++q) { const float tq = (float)(t0 + q) / (float)(L - 1); const float win = __expf(-tq * ad);
          hf[(size_t)(t0 + q) * 1024 + tid] = acc0[q] * win; hf[(size_t)(t0 + q) * 1024 + 512 + tid] = acc1[q] * win; } }
    __syncthreads();
}
__device__ __forceinline__ void step_pro_a(const AV& a, LAS unsigned char* lds) {
    const int tid = ltid(), lane = tid & 63, wave = tid >> 6, G = gridDim.x;
    unsigned char* ws = AWS;
    { f32x2* tw = (f32x2*)(ws + WS_TW); for (int m = lbid() * NT + tid; m < 16384; m += G * NT) { float s, c; sincos_rev((double)m / 16384.0, s, c); tw[m] = (f32x2){c, -s}; } }
    { f32x2* rt = (f32x2*)(ws + WS_ROPE);
      for (int e = lbid() * NT + tid; e < 8192 * 32; e += G * NT) { const int pos = e >> 5, i = e & 31; const int pp = (i < 16) ? (pos >> 6) : (pos & 63);
          const double inv = ROPE_IF[i & 15]; float sn, cs; sincos_rev((double)pp * inv * 0.15915494309189533577, sn, cs); rt[e] = (f32x2){cs, sn}; } }
    { const float* g = AIN(I_NORMG); bf16* HN0 = (bf16*)(ws + WS_HN0); f32x4 gv[4];
#pragma unroll
      for (int j = 0; j < 4; ++j) gv[j] = *((const f32x4*)g + lane + 64 * j);
      for (int m = lbid() * NWAVES + wave; m < NTOK; m += G * NWAVES) {
          const f32x4* xr = (const f32x4*)(xin_rows(a, m)) + lane; f32x4 v[4]; float ssum = 0.f;
#pragma unroll
          for (int j = 0; j < 4; ++j) { v[j] = xr[64 * j]; ssum += (v[j].x * v[j].x + v[j].y * v[j].y) + (v[j].z * v[j].z + v[j].w * v[j].w); }
          const float rs = 1.0f / sqrtf(wave_sum(ssum) * (1.0f / DM) + EPS);
          u32x2* o8 = (u32x2*)(HN0 + (size_t)m * DM) + lane;
#pragma unroll
          for (int j = 0; j < 4; ++j) { u32x2 w; w.x = pk2(v[j].x * rs * gv[j].x, v[j].y * rs * gv[j].y); w.y = pk2(v[j].z * rs * gv[j].z, v[j].w * rs * gv[j].w); o8[64 * j] = w; } } }
    { LAS float* scr = (LAS float*)(lds + wave * 16384);
      constexpr int I_IN = 16 * (UP / 32), I_MG = 16 * (GP / 32), I_BR = 8 * 32, I_OU = 16 * 32, PER = I_IN + I_MG + 3 * I_BR + I_OU;
      for (int it = lbid() * NWAVES + wave; it < 2 * PER; it += G * NWAVES) {
          const int l = it / PER; int r = it - l * PER;
          bf16* wcat = (bf16*)(ws + WS_WCAT + l * WCAT_BYTES); bf16* wbt = (bf16*)(ws + WS_WBT + l * WBT_BYTES); bf16* wot = (bf16*)(ws + WS_WOT + l * WOT_BYTES);
          if (r < I_IN) { transpose_item(AIN(I_WIN) + (size_t)l * 1024 * UP, 1024, UP, wcat, 0, scr, r, lane); continue; } r -= I_IN;
          if (r < I_MG) { transpose_item(AIN(I_WMERGE) + (size_t)l * 1024 * GP, 1024, GP, wcat, UP, scr, r, lane); continue; } r -= I_MG;
          if (r < I_BR) { transpose_item(AIN(I_WBHY) + (size_t)l * 512 * 1024, 512, 1024, wbt, 0, scr, r, lane); continue; } r -= I_BR;
          if (r < I_BR) { transpose_item(AIN(I_WBGQ) + (size_t)l * 512 * 1024, 512, 1024, wbt, 1024, scr, r, lane); continue; } r -= I_BR;
          if (r < I_BR) { transpose_item(AIN(I_WBDF) + (size_t)l * 512 * 1024, 512, 1024, wbt, 2048, scr, r, lane); continue; } r -= I_BR;
          transpose_item(AIN(I_WOUT) + (size_t)l * 1024 * 1024, 1024, 1024, wot, 0, scr, r, lane);
      } }
}
__device__ __forceinline__ void step_pro_a2(const AV& a, LAS unsigned char* lds) {
    const int tid = ltid(), G = gridDim.x; unsigned char* ws = AWS;
    { constexpr int GPL = LP / 8 + LS / 8;
      for (int g = lbid(); g < 2 * GPL; g += G) { const int l = g / GPL; int r = g - l * GPL;
          float* hfp = (float*)(ws + WS_U + l * (HF_P_BYTES + HF_S_BYTES));
          if (r < LP / 8) hf_group((LAS float*)lds, a, l, LP, r * 8, hfp, tid);
          else hf_group((LAS float*)lds, a, l, LS, (r - LP / 8) * 8, (float*)((unsigned char*)hfp + HF_P_BYTES), tid); } }
}
template <int LOG4> __device__ __forceinline__ void filt_unit(const AV& a, LAS unsigned char* lds, int layer, int pr, const float* hf, f32x2* Pg, f32x2* Mg) {
    constexpr int N = 1 << (2 * LOG4), L = N / 2;
    const int tid = ltid(); LAS f32x2* buf = (LAS f32x2*)lds; const int c0 = 2 * pr;
    for (int n = tid; n < N; n += NT) { f32x2 v = (f32x2){0.f, 0.f};
        if (n < L) v = *(const f32x2*)(hf + (size_t)n * 1024 + c0); else if (n > L) v = *(const f32x2*)(hf + (size_t)(N - n) * 1024 + 512 + c0);
        buf[PADI(n)] = v; }
    __syncthreads();
    fft_fwd<LOG4>(buf, (const f32x2*)(AWS + WS_TW), tid);
    const float ba = AIN(I_HYBIAS)[layer * 512 + c0], bb = AIN(I_HYBIAS)[layer * 512 + c0 + 1]; const float sc = 1.0f / (float)N;
    for (int k = tid; k <= L; k += NT) { const int q1 = digitrev<LOG4>(k), q2 = digitrev<LOG4>((N - k) & (N - 1)); const f32x2 z1 = buf[PADI(q1)], z2 = buf[PADI(q2)];
        f32x2 ca = (f32x2){0.5f * (z1.x + z2.x), 0.5f * (z1.y - z2.y)}; const float dx = z1.x - z2.x, dy = z1.y + z2.y; f32x2 cb = (f32x2){0.5f * dy, -0.5f * dx};
        ca.x += ba; cb.x += bb;
        Pg[k] = (f32x2){0.5f * sc * (ca.x + cb.x), 0.5f * sc * (ca.y + cb.y)}; Mg[k] = (f32x2){0.5f * sc * (ca.x - cb.x), 0.5f * sc * (ca.y - cb.y)}; }
    __syncthreads();
}
__device__ __forceinline__ void step_pro_b(const AV& a, LAS unsigned char* lds) {
    for (int u = lbid(); u < 1024; u += gridDim.x) { const int l = u >> 9, r = u & 511; unsigned char* sp = AWS + WS_SPEC + l * SPEC_LAYER; const float* hfp = (const float*)(AWS + WS_U + l * (HF_P_BYTES + HF_S_BYTES));
        if (r < 256) filt_unit<7>(a, lds, l, r, hfp, (f32x2*)sp + (size_t)r * SPS_P, (f32x2*)(sp + SPEC_P_BYTES) + (size_t)r * SPS_P);
        else { const int pr = r - 256; filt_unit<6>(a, lds, l, pr, (const float*)((const unsigned char*)hfp + HF_P_BYTES), (f32x2*)(sp + 2 * SPEC_P_BYTES) + (size_t)pr * SPS_S, (f32x2*)(sp + 2 * SPEC_P_BYTES + SPEC_S_BYTES) + (size_t)pr * SPS_S); } }
}
__device__ __forceinline__ void step_norm(const AV& a, int c, int layer) {
    const int tid = ltid(), lane = tid & 63, wave = tid >> 6; const Chunk ck = chunk_of(c);
    const float* X = layer == 0 ? xin_rows(a, ck.tok0) : AOUT + (size_t)ck.tok0 * DM; bf16* HN = (bf16*)(AWS + WS_HN); const float* g = AIN(I_NORMG) + layer * DM;
    f32x4 gv[4];
#pragma unroll
    for (int j = 0; j < 4; ++j) gv[j] = *((const f32x4*)g + lane + 64 * j);
    for (int m = lbid() * NWAVES + wave; m < CH; m += gridDim.x * NWAVES) {
        const f32x4* xr = (const f32x4*)(X + (size_t)m * DM) + lane; f32x4 v[4]; float s = 0.f;
#pragma unroll
        for (int j = 0; j < 4; ++j) { v[j] = xr[64 * j]; s += (v[j].x * v[j].x + v[j].y * v[j].y) + (v[j].z * v[j].z + v[j].w * v[j].w); }
        const float rs = 1.0f / sqrtf(wave_sum(s) * (1.0f / DM) + EPS);
        u32x2* o8 = (u32x2*)(HN + (size_t)m * DM) + lane;
#pragma unroll
        for (int j = 0; j < 4; ++j) { u32x2 w; w.x = pk2(v[j].x * rs * gv[j].x, v[j].y * rs * gv[j].y); w.y = pk2(v[j].z * rs * gv[j].z, v[j].w * rs * gv[j].w); o8[64 * j] = w; }
    }
}
__device__ __forceinline__ void step_final(const AV& a) {
    const int tid = ltid(), lane = tid & 63, wave = tid >> 6; const float* g = AIN(I_FINALG);
    f32x4 gv[4];
#pragma unroll
    for (int j = 0; j < 4; ++j) gv[j] = *((const f32x4*)g + lane + 64 * j);
    for (int m = lbid() * NWAVES + wave; m < NTOK; m += gridDim.x * NWAVES) {
        f32x4* xr = (f32x4*)(AOUT + (size_t)m * DM) + lane; f32x4 v[4]; float s = 0.f;
#pragma unroll
        for (int j = 0; j < 4; ++j) { v[j] = xr[64 * j]; s += (v[j].x * v[j].x + v[j].y * v[j].y) + (v[j].z * v[j].z + v[j].w * v[j].w); }
        const float rs = 1.0f / sqrtf(wave_sum(s) * (1.0f / DM) + EPS);
#pragma unroll
        for (int j = 0; j < 4; ++j) xr[64 * j] = v[j] * rs * gv[j];
    }
}
__device__ __forceinline__ void step_prep(const AV& a, int c, int layer) {
    const Chunk ck = chunk_of(c); bf16* U = (bf16*)(AWS + WS_U);
    for (int it = lbid() * NT + ltid(); it < CH * 10; it += gridDim.x * NT) {
        const int tok = it / 10, hd = it - tok * 10; const int pos = tok & (ck.L - 1);
        bf16* p = U + (size_t)tok * UP + (hd < 8 ? C_GQ + 64 * hd : C_GK + 64 * (hd - 8));
        const float* g = (hd < 8 ? AIN(I_QNG) : AIN(I_KNG)) + layer * 64;
        float x[64];
#pragma unroll
        for (int i = 0; i < 8; ++i) { const u32x4 w = *((const u32x4*)p + i);
            x[8 * i + 0] = bflo(w.x); x[8 * i + 1] = bfhi(w.x); x[8 * i + 2] = bflo(w.y); x[8 * i + 3] = bfhi(w.y); x[8 * i + 4] = bflo(w.z); x[8 * i + 5] = bfhi(w.z); x[8 * i + 6] = bflo(w.w); x[8 * i + 7] = bfhi(w.w); }
        float ss = 0.f;
#pragma unroll
        for (int i = 0; i < 64; ++i) ss += x[i] * x[i];
        const float rs = (1.0f / sqrtf(ss * (1.0f / 64.0f) + EPS)) * (hd < 8 ? 0.125f * LOG2E : 1.0f);
#pragma unroll
        for (int i = 0; i < 64; ++i) x[i] = x[i] * rs * g[i];
        const f32x4* rt = (const f32x4*)(AWS + WS_ROPE) + (size_t)pos * 16;
#pragma unroll
        for (int i2 = 0; i2 < 16; ++i2) { const f32x4 cs2 = rt[i2];
#pragma unroll
            for (int e = 0; e < 2; ++e) { const int i = 2 * i2 + e; const float cs = e ? cs2.z : cs2.x, sn = e ? cs2.w : cs2.y; const float x1 = x[i], x2 = x[i + 32]; x[i] = x1 * cs - x2 * sn; x[i + 32] = x2 * cs + x1 * sn; } }
#pragma unroll
        for (int i = 0; i < 8; ++i) { u32x4 w; w.x = pk2(x[8 * i], x[8 * i + 1]); w.y = pk2(x[8 * i + 2], x[8 * i + 3]); w.z = pk2(x[8 * i + 4], x[8 * i + 5]); w.w = pk2(x[8 * i + 6], x[8 * i + 7]); *((u32x4*)p + i) = w; }
    }
}
__device__ __forceinline__ void step_prep_hy(const AV& a, LAS unsigned char* lds, int c, int layer) {
    const Chunk ck = chunk_of(c); const bf16* U = (const bf16*)(AWS + WS_U);
    f32x2* HVP = (f32x2*)(AWS + WS_HVP); f32x2* PMP = (f32x2*)(AWS + WS_PMP);
    const int tid = ltid(), lane = tid & 63, wave = tid >> 6;
    LAS f32x2* th = (LAS f32x2*)(lds + wave * 17408); LAS f32x2* tp = th + 64 * 17;
    const float* cw = AIN(I_CONVW) + layer * 3 * 1536; const float* cb = AIN(I_CONVB) + layer * 1536;
    for (int it = lbid() * NWAVES + wave; it < (CH / 16) * 4; it += gridDim.x * NWAVES) {
        const int cbk = it & 3, tg = it >> 2, t0 = tg * 16, ch = cbk * 128 + 2 * lane;
        const int pos0 = t0 & (ck.L - 1);
        float w[3][3][2], bb[3][2];
#pragma unroll
        for (int ar = 0; ar < 3; ++ar) {
#pragma unroll
            for (int j = 0; j < 3; ++j) { const f32x2 v = *(const f32x2*)(cw + j * 1536 + ar * 512 + ch); w[ar][j][0] = v.x; w[ar][j][1] = v.y; }
            const f32x2 v = *(const f32x2*)(cb + ar * 512 + ch); bb[ar][0] = v.x; bb[ar][1] = v.y; }
        const bf16* r0 = U + (size_t)t0 * UP + ch;
        unsigned pv[3], cv[3], nv[3];
#pragma unroll
        for (int ar = 0; ar < 3; ++ar) { pv[ar] = pos0 > 0 ? *(const unsigned*)(r0 - UP + ar * 512) : 0u; cv[ar] = *(const unsigned*)(r0 + ar * 512); }
#pragma unroll 4
        for (int t = 0; t < 16; ++t) {
            const bf16* rt = r0 + (size_t)t * UP; const bool last = (pos0 + t + 1 >= ck.L);
#pragma unroll
            for (int ar = 0; ar < 3; ++ar) nv[ar] = last ? 0u : *(const unsigned*)(rt + UP + ar * 512);
            const unsigned gw = *(const unsigned*)(rt + C_HG);
            float o[3][2];
#pragma unroll
            for (int ar = 0; ar < 3; ++ar) { o[ar][0] = w[ar][0][0] * bflo(pv[ar]) + w[ar][1][0] * bflo(cv[ar]) + w[ar][2][0] * bflo(nv[ar]) + bb[ar][0];
                o[ar][1] = w[ar][0][1] * bfhi(pv[ar]) + w[ar][1][1] * bfhi(cv[ar]) + w[ar][2][1] * bfhi(nv[ar]) + bb[ar][1]; pv[ar] = cv[ar]; cv[ar] = nv[ar]; }
            th[lane * 17 + t] = (f32x2){o[2][0] * o[1][0], o[2][1] * o[1][1]};
            tp[lane * 17 + t] = (f32x2){o[0][0] * silu(bflo(gw)), o[0][1] * silu(bfhi(gw))};
        }
        asm volatile("s_waitcnt lgkmcnt(0)" ::: "memory");
#pragma unroll 4
        for (int i = 0; i < 16; ++i) { const int pl = 4 * i + (lane >> 4), tt = lane & 15; const size_t o = (size_t)(cbk * 64 + pl) * CH + t0 + tt;
            HVP[o] = th[pl * 17 + tt]; PMP[o] = tp[pl * 17 + tt]; }
        asm volatile("s_waitcnt lgkmcnt(0)" ::: "memory");
    }
}
typedef short bf16x8 __attribute__((ext_vector_type(8)));
typedef short s16x4 __attribute__((ext_vector_type(4)));
typedef float f32x16 __attribute__((ext_vector_type(16)));
typedef float f32x2_t __attribute__((ext_vector_type(2)));
typedef __bf16 bf16x2_t __attribute__((ext_vector_type(2)));
__device__ __forceinline__ unsigned cvtpk(float lo, float hi) { f32x2_t v = {lo, hi}; bf16x2_t b = __builtin_convertvector(v, bf16x2_t); return __builtin_bit_cast(unsigned, b); }
__device__ __forceinline__ int crow(int r, int hi) { return (r & 3) + 8 * (r >> 2) + 4 * hi; }
__device__ __forceinline__ s16x4 vtr(const LAS unsigned char* p) { return __builtin_bit_cast(s16x4, __builtin_amdgcn_ds_read_tr16_b64_v4i16((LAS s16x4*)p)); }
constexpr int ATT_K = 0;
constexpr int ATT_TB_DIFF = 4 * 8192 + 4 * 16384;
constexpr float C1 = 0.125f * LOG2E;
__device__ __forceinline__ void glds16(const void* gsrc, unsigned lds_dst) { unsigned keep;
    asm volatile("s_mov_b32 %0, m0\n\ts_mov_b32 m0, %2\n\ts_nop 0\n\tglobal_load_lds_dwordx4 %1, off\n\ts_mov_b32 m0, %0" : "=&s"(keep) : "v"(gsrc), "s"(lds_dst) : "memory"); }

template <int VD, bool BIAS, bool OMAX, int G>
__device__ __forceinline__ void flash_pass(LAS unsigned char* lds, const bf16* Qrow, const bf16* Kg, const bf16* Vg, int L, int qpos, int qw0, float bl, float br, f32x16 (&o)[VD / 32], float& l_out) {
    const int tid = ltid(), lane = tid & 63, r32 = lane & 31, hi = lane >> 5;
    constexpr int VROW = VD * 2, VT = 64 * VROW, NVL = VD / 64, NSL = 2 * G, ATT_V = NSL * 8192, ATT_TB = ATT_V + NSL * VT;
    const LAS float* tb = (const LAS float*)(lds + ATT_TB);
    typedef const __attribute__((address_space(1))) u32x4* g4p;
    const int wv = __builtin_amdgcn_readfirstlane(tid >> 6); const int ldsa = (int)(unsigned)(uintptr_t)lds;
    const bf16* ksrc; { const int X = wv * 1024 + lane * 16, line = X >> 8, c16 = ((X >> 4) & 15) ^ (line & 15), key = 2 * line + (c16 >> 3), ch = c16 & 7; ksrc = Kg + (size_t)key * UP + ch * 8; }
    const bf16* vsrc[NVL];
#pragma unroll
    for (int i = 0; i < NVL; ++i) { const int X = i * 8192 + wv * 1024 + lane * 16; const int key = (VD == 64) ? (X >> 7) : (X >> 8), posb = (VD == 64) ? (X & 127) : (X & 255);
        const int swz = (VD == 64) ? (((key >> 1) & 1) << 6) : ((key & 3) << 6); vsrc[i] = Vg + (size_t)key * UP + ((posb ^ swz) >> 1); }
#define ATT_DMA(tt_, sl_) do { const size_t go_ = (size_t)(tt_) * 64 * UP; \
        glds16(ksrc + go_, (unsigned)__builtin_amdgcn_readfirstlane(ldsa + ATT_K + (sl_) * 8192 + wv * 1024)); \
        _Pragma("unroll") for (int i_ = 0; i_ < NVL; ++i_) glds16(vsrc[i_] + go_, (unsigned)__builtin_amdgcn_readfirstlane(ldsa + ATT_V + (sl_) * VT + i_ * 8192 + wv * 1024)); } while (0)
#define ATT_DMAGROUP(g_) do { _Pragma("unroll") for (int j_ = 0; j_ < G; ++j_) { const int tt_ = (g_) * G + j_; ATT_DMA(tt_, tt_ & (NSL - 1)); } } while (0)
#define ATT_BAR() do { __builtin_amdgcn_s_barrier(); asm volatile("" ::: "memory"); } while (0)
    int koff[2][4];
#pragma unroll
    for (int kb = 0; kb < 2; ++kb)
#pragma unroll
        for (int s = 0; s < 4; ++s) { const int key = 32 * kb + r32, line = key >> 1, c16 = ((key & 1) << 3) | (2 * s + hi); koff[kb][s] = line * 256 + ((c16 ^ (line & 15)) << 4); }
    const int q4 = (lane & 15) >> 2, p4 = lane & 3, g1 = (lane >> 4) & 1;
    const int vsw = (VD == 64) ? ((q4 >> 1) & 1) : q4;
    const int vbase = (4 * hi + q4) * VROW + 32 * g1 + 8 * p4;
    bf16x8 qf[4];
#pragma unroll
    for (int s = 0; s < 4; ++s) qf[s] = __builtin_bit_cast(bf16x8, *(g4p)(Qrow + 16 * s + 8 * hi));
    float m_run = OMAX ? -1e30f : 0.f, l_run = 0.f;
    const int nt = L >> 6;
    asm volatile("" :: "v"(qf[0]), "v"(qf[1]), "v"(qf[2]), "v"(qf[3]) : "memory");
    asm volatile("s_waitcnt vmcnt(0)" ::: "memory");
    const int ng = nt / G;
    ATT_DMAGROUP(0); if (ng > 1) ATT_DMAGROUP(1);
    if (ng > 1) { if (G * (1 + NVL) == 8) asm volatile("s_waitcnt vmcnt(8)" ::: "memory"); else asm volatile("s_waitcnt vmcnt(6)" ::: "memory"); } else asm volatile("s_waitcnt vmcnt(0)" ::: "memory");
    static_assert(G * (1 + NVL) == 8 || G * (1 + NVL) == 6, "vmcnt immediates above");
    ATT_BAR();
#pragma unroll 1
    for (int t = 0; t < nt; ++t) {
        const int cur = t & (NSL - 1);
        const LAS unsigned char* kbuf = lds + ATT_K + cur * 8192; const LAS unsigned char* vbuf = lds + ATT_V + cur * VT;
        f32x16 p[2];
        { bf16x8 kf[2][4];
#pragma unroll
          for (int kb = 0; kb < 2; ++kb)
#pragma unroll
            for (int s = 0; s < 4; ++s) kf[kb][s] = *(const LAS bf16x8*)(kbuf + koff[kb][s]);
          __builtin_amdgcn_sched_barrier(0);
#pragma unroll
          for (int kb = 0; kb < 2; ++kb) { f32x16 acc;
#pragma unroll
            for (int r = 0; r < 16; ++r) acc[r] = 0.f;
#pragma unroll
            for (int s = 0; s < 4; ++s) acc = __builtin_amdgcn_mfma_f32_32x32x16_bf16(kf[kb][s], qf[s], acc, 0, 0, 0);
            p[kb] = acc; } }
        s16x4 vlo[2][4], vhi[2][4];
#define VREAD(buf_, db_) do { const int cofs_ = (((db_) ^ vsw) << 6); _Pragma("unroll") for (int kb = 0; kb < 2; ++kb) _Pragma("unroll") for (int ss = 0; ss < 2; ++ss) { \
            const LAS unsigned char* vp_ = vbuf + vbase + (32 * kb + 16 * ss) * VROW + cofs_; vlo[buf_][2 * kb + ss] = vtr(vp_); vhi[buf_][2 * kb + ss] = vtr(vp_ + 8 * VROW); } } while (0)
        VREAD(0, 0);
        __builtin_amdgcn_sched_barrier(0);
        const int k0 = t * 64; float mulc, bconst, mx = -3e38f; bool nearT = false;
        if (BIAS) { const int rlo = k0 - qw0 - 31, rhi = k0 + 63 - qw0; nearT = !(rhi <= -128 || rlo >= 128); }
        if (BIAS && nearT) {
#pragma unroll
            for (int kb = 0; kb < 2; ++kb)
#pragma unroll
                for (int r4 = 0; r4 < 4; ++r4) {
#pragma unroll
                    for (int e = 0; e < 4; ++e) { const int r = 4 * r4 + e; int rel = k0 + 32 * kb + crow(r, hi) - qpos; rel = rel < -128 ? -128 : (rel > 128 ? 128 : rel); const float v = p[kb][r] * C1 + tb[rel + 128]; p[kb][r] = v; mx = fmaxf(mx, v); }
                    __builtin_amdgcn_sched_barrier(0); }
            mulc = 1.0f; bconst = 0.f;
        } else {
            if (OMAX) {
#pragma unroll
                for (int kb = 0; kb < 2; ++kb)
#pragma unroll
                    for (int r = 0; r < 16; ++r) mx = fmaxf(mx, p[kb][r]); }
            bconst = BIAS ? (k0 < qw0 ? bl : br) : 0.f; mx = mx * C1 + bconst; mulc = C1;
        }
        if (OMAX) {
            mx = fmaxf(mx, __shfl_xor(mx, 32));
            if (__any(mx > m_run)) { const float mn = fmaxf(m_run, mx), al = __builtin_amdgcn_exp2f(m_run - mn); l_run *= al;
#pragma unroll
                for (int db = 0; db < VD / 32; ++db) o[db] *= al;
                m_run = mn; }
        }
        const f32x2 mul2 = (f32x2){mulc, mulc}, add2 = (f32x2){bconst - m_run, bconst - m_run}; f32x2 ls2 = (f32x2){0.f, 0.f};
#pragma unroll
        for (int kb = 0; kb < 2; ++kb)
#pragma unroll
            for (int r = 0; r < 16; r += 2) { f32x2 v = (f32x2){p[kb][r], p[kb][r + 1]}; v = v * mul2 + add2; f32x2 e; e.x = __builtin_amdgcn_exp2f(v.x); e.y = __builtin_amdgcn_exp2f(v.y); ls2 += e; p[kb][r] = e.x; p[kb][r + 1] = e.y; }
        l_run += ls2.x + ls2.y;
        bf16x8 pk[2][2];
#pragma unroll
        for (int kb = 0; kb < 2; ++kb)
#pragma unroll
            for (int ss = 0; ss < 2; ++ss) { u32x4 w; w.x = cvtpk(p[kb][8 * ss + 0], p[kb][8 * ss + 1]); w.y = cvtpk(p[kb][8 * ss + 2], p[kb][8 * ss + 3]); w.z = cvtpk(p[kb][8 * ss + 4], p[kb][8 * ss + 5]); w.w = cvtpk(p[kb][8 * ss + 6], p[kb][8 * ss + 7]);
                pk[kb][ss] = __builtin_bit_cast(bf16x8, w); }
        __builtin_amdgcn_sched_barrier(0);
#pragma unroll
        for (int db = 0; db < VD / 32; ++db) {
            if (db + 1 < VD / 32) { if ((db + 1) & 1) VREAD(1, db + 1); else VREAD(0, db + 1); }
#pragma unroll
            for (int kb = 0; kb < 2; ++kb)
#pragma unroll
                for (int ss = 0; ss < 2; ++ss) { const bf16x8 vf = (db & 1) ? __builtin_shufflevector(vlo[1][2 * kb + ss], vhi[1][2 * kb + ss], 0, 1, 2, 3, 4, 5, 6, 7) : __builtin_shufflevector(vlo[0][2 * kb + ss], vhi[0][2 * kb + ss], 0, 1, 2, 3, 4, 5, 6, 7);
                    o[db] = __builtin_amdgcn_mfma_f32_32x32x16_bf16(vf, pk[kb][ss], o[db], 0, 0, 0); }
            __builtin_amdgcn_sched_barrier(0); }
#undef VREAD
        if (((t + 1) & (G - 1)) == 0) {
            asm volatile("s_waitcnt vmcnt(0)" ::: "memory"); ATT_BAR();
            const int g2 = (t + 1) / G + 1; if (g2 < ng) ATT_DMAGROUP(g2); }
    }
#undef ATT_DMA
#undef ATT_DMAGROUP
#undef ATT_BAR
    l_out = l_run + __shfl_xor(l_run, 32);
}
__device__ __forceinline__ void gqa_unit(const AV& a, LAS unsigned char* lds, int seqrow0, int L, int h, int qb) {
    const int tid = ltid(), lane = tid & 63, r32 = lane & 31, hi = lane >> 5;
    const bf16* U = (const bf16*)(AWS + WS_U); bf16* Y = (bf16*)(AWS + WS_Y) + (size_t)1 * CH * 512;
    constexpr int G = 4, NSL = 2 * G, VROW = 128, VT = 8192, ATT_V = NSL * 8192;
    typedef const __attribute__((address_space(1))) u32x4* g4p;
    const int wv = __builtin_amdgcn_readfirstlane(tid >> 6); const int ldsa = (int)(unsigned)(uintptr_t)lds;
    const int qw0 = qb * 512 + wv * 64;
    const bf16* Kg = U + (size_t)seqrow0 * UP + C_GK + 64 * (h >> 2); const bf16* Vg = U + (size_t)seqrow0 * UP + C_GV + 64 * (h >> 2);
    const bf16* ksrc; { const int X = wv * 1024 + lane * 16, line = X >> 8, c16 = ((X >> 4) & 15) ^ (line & 15), key = 2 * line + (c16 >> 3), ch = c16 & 7; ksrc = Kg + (size_t)key * UP + ch * 8; }
    const bf16* vsrc; { const int X = wv * 1024 + lane * 16, key = X >> 7, posb = X & 127, swz = ((key >> 1) & 1) << 6; vsrc = Vg + (size_t)key * UP + ((posb ^ swz) >> 1); }
#define GQ_DMA(tt_, sl_) do { const size_t go_ = (size_t)(tt_) * 64 * UP; \
        glds16(ksrc + go_, (unsigned)__builtin_amdgcn_readfirstlane(ldsa + ATT_K + (sl_) * 8192 + wv * 1024)); \
        glds16(vsrc + go_, (unsigned)__builtin_amdgcn_readfirstlane(ldsa + ATT_V + (sl_) * VT + wv * 1024)); } while (0)
#define GQ_DMAGROUP(g_) do { _Pragma("unroll") for (int j_ = 0; j_ < G; ++j_) { const int tt_ = (g_) * G + j_; GQ_DMA(tt_, tt_ & (NSL - 1)); } } while (0)
#define GQ_BAR() do { __builtin_amdgcn_s_barrier(); asm volatile("" ::: "memory"); } while (0)
    int koff[2][4];
#pragma unroll
    for (int kb = 0; kb < 2; ++kb)
#pragma unroll
        for (int s = 0; s < 4; ++s) { const int key = 32 * kb + r32, line = key >> 1, c16 = ((key & 1) << 3) | (2 * s + hi); koff[kb][s] = line * 256 + ((c16 ^ (line & 15)) << 4); }
    const int q4 = (lane & 15) >> 2, p4 = lane & 3, g1 = (lane >> 4) & 1;
    const int vsw = (q4 >> 1) & 1;
    const int vbase = (4 * hi + q4) * VROW + 32 * g1 + 8 * p4;
    bf16x8 qf[2][4];
#pragma unroll
    for (int j = 0; j < 2; ++j)
#pragma unroll
        for (int s = 0; s < 4; ++s) qf[j][s] = __builtin_bit_cast(bf16x8, *(g4p)(U + (size_t)(seqrow0 + qw0 + 32 * j + r32) * UP + C_GQ + 64 * h + 16 * s + 8 * hi));
    f32x16 o[2][2];
#pragma unroll
    for (int j = 0; j < 2; ++j)
#pragma unroll
        for (int db = 0; db < 2; ++db)
#pragma unroll
            for (int r = 0; r < 16; ++r) o[j][db][r] = 0.f;
    float lrun[2] = {0.f, 0.f};
    const int nt = L >> 6, ng = nt / G;
    asm volatile("" :: "v"(qf[0][0]), "v"(qf[0][1]), "v"(qf[0][2]), "v"(qf[0][3]), "v"(qf[1][0]), "v"(qf[1][1]), "v"(qf[1][2]), "v"(qf[1][3]) : "memory");
    asm volatile("s_waitcnt vmcnt(0)" ::: "memory");
    GQ_DMAGROUP(0); if (ng > 1) GQ_DMAGROUP(1);
    if (ng > 1) asm volatile("s_waitcnt vmcnt(8)" ::: "memory"); else asm volatile("s_waitcnt vmcnt(0)" ::: "memory");
    GQ_BAR();
#pragma unroll 1
    for (int t = 0; t < nt; ++t) {
        const int cur = t & (NSL - 1);
        const LAS unsigned char* kbuf = lds + ATT_K + cur * 8192; const LAS unsigned char* vbuf = lds + ATT_V + cur * VT;
        f32x16 p[2][2];
        { bf16x8 kf[2][4];
#pragma unroll
          for (int kb = 0; kb < 2; ++kb)
#pragma unroll
            for (int s = 0; s < 4; ++s) kf[kb][s] = *(const LAS bf16x8*)(kbuf + koff[kb][s]);
          __builtin_amdgcn_sched_barrier(0);
#pragma unroll
          for (int kb = 0; kb < 2; ++kb)
#pragma unroll
            for (int j = 0; j < 2; ++j) { f32x16 acc;
#pragma unroll
              for (int r = 0; r < 16; ++r) acc[r] = 0.f;
#pragma unroll
              for (int s = 0; s < 4; ++s) acc = __builtin_amdgcn_mfma_f32_32x32x16_bf16(kf[kb][s], qf[j][s], acc, 0, 0, 0);
              p[j][kb] = acc; } }
        s16x4 vlo[2][4], vhi[2][4];
#define GQ_VREAD(buf_, db_) do { const int cofs_ = (((db_) ^ vsw) << 6); _Pragma("unroll") for (int kb = 0; kb < 2; ++kb) _Pragma("unroll") for (int ss = 0; ss < 2; ++ss) { \
            const LAS unsigned char* vp_ = vbuf + vbase + (32 * kb + 16 * ss) * VROW + cofs_; vlo[buf_][2 * kb + ss] = vtr(vp_); vhi[buf_][2 * kb + ss] = vtr(vp_ + 8 * VROW); } } while (0)
        bf16x8 pk[2][2][2];
#pragma unroll
        for (int j = 0; j < 2; ++j) { float ls0 = 0.f, ls1 = 0.f;
#pragma unroll
            for (int kb = 0; kb < 2; ++kb) {
#pragma unroll
                for (int r = 0; r < 16; r += 2) { const float e0 = __builtin_amdgcn_exp2f(p[j][kb][r]), e1 = __builtin_amdgcn_exp2f(p[j][kb][r + 1]); ls0 += e0; ls1 += e1; p[j][kb][r] = e0; p[j][kb][r + 1] = e1; }
#pragma unroll
                for (int ss = 0; ss < 2; ++ss) { u32x4 w; w.x = cvtpk(p[j][kb][8 * ss + 0], p[j][kb][8 * ss + 1]); w.y = cvtpk(p[j][kb][8 * ss + 2], p[j][kb][8 * ss + 3]); w.z = cvtpk(p[j][kb][8 * ss + 4], p[j][kb][8 * ss + 5]); w.w = cvtpk(p[j][kb][8 * ss + 6], p[j][kb][8 * ss + 7]);
                    pk[j][kb][ss] = __builtin_bit_cast(bf16x8, w); } }
            lrun[j] += ls0 + ls1; }
        __builtin_amdgcn_sched_barrier(0);
        GQ_VREAD(0, 0); GQ_VREAD(1, 1);
#pragma unroll
        for (int db = 0; db < 2; ++db) {
#pragma unroll
            for (int kb = 0; kb < 2; ++kb)
#pragma unroll
                for (int ss = 0; ss < 2; ++ss) { const bf16x8 vf = db ? __builtin_shufflevector(vlo[1][2 * kb + ss], vhi[1][2 * kb + ss], 0, 1, 2, 3, 4, 5, 6, 7) : __builtin_shufflevector(vlo[0][2 * kb + ss], vhi[0][2 * kb + ss], 0, 1, 2, 3, 4, 5, 6, 7);
#pragma unroll
                    for (int j = 0; j < 2; ++j) o[j][db] = __builtin_amdgcn_mfma_f32_32x32x16_bf16(vf, pk[j][kb][ss], o[j][db], 0, 0, 0); }
            __builtin_amdgcn_sched_barrier(0); }
#undef GQ_VREAD
        if (((t + 1) & (G - 1)) == 0) { asm volatile("s_waitcnt vmcnt(0)" ::: "memory"); GQ_BAR(); const int g2 = (t + 1) / G + 1; if (g2 < ng) GQ_DMAGROUP(g2); }
    }
#undef GQ_DMA
#undef GQ_DMAGROUP
#undef GQ_BAR
#pragma unroll
    for (int j = 0; j < 2; ++j) { const float l = lrun[j] + __shfl_xor(lrun[j], 32); const float inv = 1.0f / l; const size_t row = (size_t)(seqrow0 + qw0 + 32 * j + r32);
#pragma unroll
        for (int db = 0; db < 2; ++db)
#pragma unroll
            for (int g = 0; g < 4; ++g) { const int d = 32 * db + 8 * g + 4 * hi; const u32x2 gw = *(const u32x2*)(U + row * UP + C_GG + 64 * h + d);
                const float y0 = o[j][db][4 * g] * inv * silu(bflo(gw.x)), y1 = o[j][db][4 * g + 1] * inv * silu(bfhi(gw.x)), y2 = o[j][db][4 * g + 2] * inv * silu(bflo(gw.y)), y3 = o[j][db][4 * g + 3] * inv * silu(bfhi(gw.y));
                u32x2 w; w.x = cvtpk(y0, y1); w.y = cvtpk(y2, y3); *(u32x2*)(Y + row * 512 + 64 * h + d) = w; } }
}
__device__ __forceinline__ void diff_unit(const AV& a, LAS unsigned char* lds, int seqrow0, int L, int h, int qb, int layer) {
    const int tid = ltid(), lane = tid & 63, wave = tid >> 6, r32 = lane & 31, hi = lane >> 5;
    const bf16* U = (const bf16*)(AWS + WS_U); bf16* Y = (bf16*)(AWS + WS_Y) + (size_t)2 * CH * 512; float* DT = (float*)(AWS + WS_DT);
    const float* relb = AIN(I_RELB);
    LAS float* tb = (LAS float*)(lds + ATT_TB_DIFF);
    for (int i = tid; i < 257; i += NT) { const int rel = i - 128, n = rel < 0 ? -rel : rel; int b = rel > 0 ? 16 : 0;
        if (n < 8) b += n; else { const int v = 8 + (31 - __builtin_clz((unsigned)(n * n))) - 6; b += v < 15 ? v : 15; }
        tb[i] = relb[b * 4 + h] * LOG2E; }
    const float bl = relb[15 * 4 + h] * LOG2E, br = relb[31 * 4 + h] * LOG2E;
    const float li = 0.8f - 0.6f * __expf(-0.3f * (float)layer);
    float d1, d2; { const float q1 = AIN(I_LQ1)[layer * 64 + lane], k1 = AIN(I_LK1)[layer * 64 + lane], q2 = AIN(I_LQ2)[layer * 64 + lane], k2 = AIN(I_LK2)[layer * 64 + lane]; d1 = wave_sum(q1 * k1); d2 = wave_sum(q2 * k2); }
    const float lam = __expf(d1) - __expf(d2) + li;
    const int qw0 = qb * 256 + wave * 32, qpos = qw0 + r32; const size_t row = (size_t)(seqrow0 + qpos);
    __syncthreads();
    f32x16 o[4]; float l; float ss = 0.f;
#pragma unroll 1
    for (int c = 0; c < 2; ++c) {
#pragma unroll
        for (int db = 0; db < 4; ++db)
#pragma unroll
            for (int r = 0; r < 16; ++r) o[db][r] = 0.f;
        flash_pass<128, true, true, 2>(lds, U + row * UP + C_DQ + 128 * h + 64 * c, U + (size_t)seqrow0 * UP + C_DK + 128 * h + 64 * c, U + (size_t)seqrow0 * UP + C_DV + 128 * h, L, qpos, qw0, bl, br, o, l);
        if (c == 0) { const float inv = 1.0f / l;
#pragma unroll
            for (int db = 0; db < 4; ++db)
#pragma unroll
                for (int g = 0; g < 4; ++g) { const int d = 32 * db + 8 * g + 4 * hi; *(f32x4*)(DT + row * 512 + 128 * h + d) = (f32x4){o[db][4 * g] * inv, o[db][4 * g + 1] * inv, o[db][4 * g + 2] * inv, o[db][4 * g + 3] * inv}; }
        } else { const float inv = lam / l;
#pragma unroll
            for (int db = 0; db < 4; ++db)
#pragma unroll
                for (int g = 0; g < 4; ++g) { const int d = 32 * db + 8 * g + 4 * hi; const f32x4 o0 = *(const f32x4*)(DT + row * 512 + 128 * h + d);
#pragma unroll
                    for (int e = 0; e < 4; ++e) { const float v = o0[e] - o[db][4 * g + e] * inv; o[db][4 * g + e] = v; ss += v * v; } }
        }
    }
    ss += __shfl_xor(ss, 32);
    const float rs = (1.0f / sqrtf(ss * (1.0f / 128.0f) + EPS)) * (1.0f - li);
    const float* sg = AIN(I_SUBLN) + layer * 128;
#pragma unroll
    for (int db = 0; db < 4; ++db)
#pragma unroll
        for (int g = 0; g < 4; ++g) { const int d = 32 * db + 8 * g + 4 * hi; const u32x2 gw = *(const u32x2*)(U + row * UP + C_DG + 128 * h + d); const f32x4 gn = *(const f32x4*)(sg + d);
            const float y0 = o[db][4 * g] * rs * gn.x * silu(bflo(gw.x)), y1 = o[db][4 * g + 1] * rs * gn.y * silu(bfhi(gw.x)), y2 = o[db][4 * g + 2] * rs * gn.z * silu(bflo(gw.y)), y3 = o[db][4 * g + 3] * rs * gn.w * silu(bfhi(gw.y));
            u32x2 w; w.x = cvtpk(y0, y1); w.y = cvtpk(y2, y3); *(u32x2*)(Y + row * 512 + 128 * h + d) = w; }
}
template <int LOG4, int BATCH> __device__ __forceinline__ void hyena_unit(const AV& a, LAS unsigned char* lds, int seqrow0, int pr0, int layer) {
    constexpr int N = 1 << (2 * LOG4), L = N / 2, NPAD = N + N / 16;
    const int tid = ltid(); LAS f32x2* buf = (LAS f32x2*)lds;
    bf16* Y = (bf16*)(AWS + WS_Y) + (size_t)seqrow0 * 512;
    const unsigned char* sp = AWS + WS_SPEC + layer * SPEC_LAYER;
    constexpr int SPS = (LOG4 == 7) ? SPS_P : SPS_S;
    const f32x2* Pg = ((LOG4 == 7) ? (const f32x2*)sp : (const f32x2*)(sp + 2 * SPEC_P_BYTES)) + (size_t)pr0 * SPS;
    const f32x2* Mg = ((LOG4 == 7) ? (const f32x2*)(sp + SPEC_P_BYTES) : (const f32x2*)(sp + 2 * SPEC_P_BYTES + SPEC_S_BYTES)) + (size_t)pr0 * SPS;
    const f32x2* hvp = (const f32x2*)(AWS + WS_HVP) + (size_t)pr0 * CH + seqrow0; const f32x2* pmp = (const f32x2*)(AWS + WS_PMP) + (size_t)pr0 * CH + seqrow0;
#pragma unroll
    for (int b = 0; b < BATCH; ++b)
        for (int t = tid; t < L; t += NT) { buf[b * NPAD + PADI(t)] = hvp[(size_t)b * CH + t]; buf[b * NPAD + PADI(t + L)] = (f32x2){0.f, 0.f}; }
    __syncthreads();
    const f32x2* tw = (const f32x2*)(AWS + WS_TW);
    fft_fwd<LOG4, BATCH>(buf, tw, tid);
#pragma unroll
    for (int b = 0; b < BATCH; ++b)
        for (int k = tid; k <= L; k += NT) { const int p1 = b * NPAD + PADI(digitrev<LOG4>(k)), p2 = b * NPAD + PADI(digitrev<LOG4>((N - k) & (N - 1))); const f32x2 z1 = buf[p1], z2 = buf[p2], P = Pg[(size_t)b * SPS + k], M = Mg[(size_t)b * SPS + k];
            const f32x2 y1 = cmul(z1, P) + cmul(cconj(z2), M), y2 = cmulc(z2, P) + cmulc(cconj(z1), M);
            buf[p1] = y1; if (p2 != p1) buf[p2] = y2; }
    __syncthreads();
    fft_inv<LOG4, BATCH>(buf, tw, tid);
    for (int t = tid; t < L; t += NT) { unsigned w[BATCH];
#pragma unroll
        for (int b = 0; b < BATCH; ++b) { const f32x2 y = buf[b * NPAD + PADI(t)], m = pmp[(size_t)b * CH + t]; w[b] = cvtpk(y.x * m.x, y.y * m.y); }
        if (BATCH == 4) *(u32x4*)(Y + (size_t)t * 512 + 2 * pr0) = (u32x4){w[0], w[BATCH > 1 ? 1 : 0], w[BATCH > 2 ? 2 : 0], w[BATCH > 3 ? 3 : 0]};
        else *(unsigned*)(Y + (size_t)t * 512 + 2 * pr0) = w[0]; }
    __syncthreads();
}
#define XB_TMO      128
#define XB_XCNT(j)  (256  + 64 * (j))
#define XB_XSUB(j)  (1280 + 64 * (j))
#define XB_XGEN(j)  (2304 + 64 * (j))
#define XB_TOP      3328
#define XB_TOPGEN   3392
#define XCD_BAR_WORDS 3456
#define XB_SPIN_CAP (1u << 18)

__device__ __forceinline__ unsigned xb_ld(unsigned* p)              { return __hip_atomic_load(p, __ATOMIC_RELAXED, __HIP_MEMORY_SCOPE_AGENT); }
__device__ __forceinline__ unsigned xb_add(unsigned* p, unsigned v) { return __hip_atomic_fetch_add(p, v, __ATOMIC_RELAXED, __HIP_MEMORY_SCOPE_AGENT); }
__device__ __forceinline__ unsigned xb_xcc_id() { return (unsigned)__builtin_amdgcn_s_getreg((3 << 11) | 20) & 0xFu; }
#define XB_SPIN(cond, bar) do { unsigned _sp = 0; while (cond) { __builtin_amdgcn_s_sleep(1); \
    if ((++_sp & 255u) == 0u) { if (xb_ld(&(bar)[XB_TMO])) break; if (_sp > XB_SPIN_CAP) { atomicAdd(&(bar)[XB_TMO], 1u); break; } } } } while (0)

struct XcdBarrier {
    unsigned* bar; unsigned x;
    volatile LAS unsigned* st;
};

__device__ __forceinline__ XcdBarrier xcd_barrier_post(unsigned* bar, volatile LAS unsigned* st) {
    XcdBarrier b; b.bar = bar; b.x = xb_xcc_id(); b.st = st;
    if (threadIdx.x == 0) (void)xb_add(&bar[XB_XCNT(b.x)], 1u);
    return b;
}
__device__ __forceinline__ void xcd_barrier_complete(unsigned* bar, unsigned x, unsigned& nloc, unsigned& nx) {
    const unsigned G = gridDim.x * gridDim.y * gridDim.z;
    unsigned sum, cnt, mine, sp = 0u;
    for (;;) {
        sum = 0u; cnt = 0u; mine = 0u;
#pragma unroll
        for (unsigned j = 0; j < 16; ++j) { const unsigned c = xb_ld(&bar[XB_XCNT(j)]); sum += c; cnt += (c > 0u) ? 1u : 0u; mine = (j == x) ? c : mine; }
        if (sum == G) break;
        __builtin_amdgcn_s_sleep(1);
        if ((++sp & 255u) == 0u) { if (xb_ld(&bar[XB_TMO])) break; if (sp > XB_SPIN_CAP) { atomicAdd(&bar[XB_TMO], 1u); break; } }
    }
    nloc = mine > 0u ? mine : 1u; nx = cnt > 0u ? cnt : 1u;
}

__device__ __forceinline__ void xcd_barrier(const XcdBarrier& b) {
    asm volatile("s_waitcnt vmcnt(0)" ::: "memory");
    __syncthreads();
    if (threadIdx.x == 0) {
        unsigned* bar = b.bar;
        __builtin_amdgcn_s_waitcnt(0);
        unsigned nloc = b.st[0], nx = b.st[1];
        if (nloc == 0u) { xcd_barrier_complete(bar, b.x, nloc, nx); b.st[0] = nloc; b.st[1] = nx; }
        const unsigned old = xb_add(&bar[XB_XSUB(b.x)], 1u);
        const unsigned gen = old / nloc;
        if (old + 1u == (gen + 1u) * nloc) {
            __builtin_amdgcn_fence(__ATOMIC_RELEASE, "agent");
            asm volatile("s_waitcnt vmcnt(0)" ::: "memory");
            const unsigned og = xb_add(&bar[XB_TOP], 1u);
            const unsigned tg = og / nx;
            if (og + 1u == (tg + 1u) * nx) xb_add(&bar[XB_TOPGEN], 1u);
            else XB_SPIN(xb_ld(&bar[XB_TOPGEN]) == tg, bar);
            __builtin_amdgcn_fence(__ATOMIC_ACQUIRE, "agent");
            xb_add(&bar[XB_XGEN(b.x)], 1u);
            asm volatile("s_waitcnt vmcnt(0)" ::: "memory");
        } else {
            XB_SPIN(xb_ld(&bar[XB_XGEN(b.x)]) == gen, bar);
            __builtin_amdgcn_fence(__ATOMIC_ACQUIRE, "agent");
            asm volatile("s_waitcnt vmcnt(0)" ::: "memory");
        }
    }
    __syncthreads();
}

__device__ __forceinline__ void step_mix(const AV& a, LAS unsigned char* lds, int c, int layer, unsigned* ctr, int tmask) {
    const Chunk ck = chunk_of(c); const int nqb = ck.L / 256, nqg = ck.L / 512, nD = ck.nseq * 4 * nqb, nG = ck.nseq * 8 * nqg, nF = (ck.L == LP) ? ck.nseq * 256 : ck.nseq * 64, total = nD + nG + nF;
    volatile LAS unsigned* wq = (volatile LAS unsigned*)(lds + LDS_MAIN);
    for (;;) {
        if (ltid() == 0) wq[0] = atomicAdd(ctr, 1u);
        __syncthreads();
        const int u = (int)wq[0];
        __syncthreads();
        if (u >= total) break;
        if (u < nD) { if (tmask & 1) { const int qb = u % nqb, sh = u / nqb, h = sh & 3, s = sh >> 2; diff_unit(a, lds, s * ck.L, ck.L, h, qb, layer); } }
        else if (u < nD + nG) { if (tmask & 2) { const int v = u - nD, qb = v % nqg, sh = v / nqg, h = sh & 7, s = sh >> 3; gqa_unit(a, lds, s * ck.L, ck.L, h, qb); } }
        else { if (tmask & 4) { const int v = u - nD - nG; if (ck.L == LP) hyena_unit<7, 1>(a, lds, (v >> 8) * LP, v & 255, layer); else hyena_unit<6, 4>(a, lds, (v >> 6) * LS, (v & 63) * 4, layer); } }
    }
}
constexpr int STEPS_PER = 6, NPRO = 3, NSTEPS = NPRO + NCHUNK * 2 * STEPS_PER + 1;
__global__ void __launch_bounds__(NT, 2) mega_fwd(Args kargs) {
    extern __shared__ __attribute__((aligned(16))) unsigned char lds_raw[];
    LAS unsigned char* lds = (LAS unsigned char*)lds_raw;
    cg::grid_group grid = cg::this_grid();
    kargp_t kp = (kargp_t)__builtin_amdgcn_kernarg_segment_ptr();
    { volatile LAS unsigned* misc = (volatile LAS unsigned*)(lds + LDS_MAIN + 64); if (ltid() < 16) misc[ltid()] = 0u; }
    __syncthreads();
    XcdBarrier xbar = xcd_barrier_post((unsigned*)(kargs.ws + WS_CTL) + CW_BAR, (volatile LAS unsigned*)(lds + LDS_MAIN + 64 + 32));
    const int step_lo = kargs.lo, step_hi = kargs.hi;
#pragma unroll 1
    for (int step = step_lo; step < step_hi; ++step) {
        asm volatile("" : "+s"(kp));
        AV a; a.p = kp; unsigned char* ws = AWS;
        if (step == 0) { if (EN(0)) step_pro_a(a, lds); }
        else if (step == 1) { if (EN(11)) { step_pro_a2(a, lds); if (DUP_MASK & 32) { xcd_barrier(xbar); step_pro_a2(a, lds); } } }
        else if (step == 2) { if (EN(1)) { step_pro_b(a, lds); if (DUP_MASK & 64) { xcd_barrier(xbar); step_pro_b(a, lds); } } }
        else if (step == NSTEPS - 1) { if (DUP_MASK & 256) { for (int q = 0; q < 100; ++q) xcd_barrier(xbar); } if (EN(2)) step_final(a); }
        else {
            const int s2 = step - NPRO, cl = s2 / STEPS_PER, k = s2 - cl * STEPS_PER, c = cl >> 1, layer = cl & 1;
            const Chunk ck = chunk_of(c);
            if (k == 0) { if (layer == 0) continue;
                if (EN(3)) { step_norm(a, c, layer); if (DUP_MASK & 128) { xcd_barrier(xbar); step_norm(a, c, layer); } } }
            else if (k == 2) { if (EN(5)) { step_prep(a, c, layer); step_prep_hy(a, lds, c, layer); } }
            else if (k == 3) {
#pragma unroll 1
                for (int rep = 0; rep < ((DUP_MASK & 7) ? 2 : 1); ++rep) { if (rep) xcd_barrier(xbar); step_mix(a, lds, c, layer, (unsigned*)(ws + WS_CTL) + step * 16 + 4 * rep, rep ? (DUP_MASK & 7) : 7); } }
            else { if (EN(4)) {
                pg8::Gemm g; pg8::OrderAll S; pg8::EpiAll E; const int G = (int)gridDim.x, bid = lbid();
                S.so.init(CH, k == 1 ? NCAT : 1024, G, bid); S.o2 = pg8::OrderG2{CH / 256, G, bid}; S.mode = (k == 4) ? 2 : 1;
                float* O = AOUT + (size_t)ck.tok0 * DM; const float* X = layer == 0 ? xin_rows(a, ck.tok0) : O;
                E.mode = (k == 1) ? 1 : (k == 4) ? 2 : 3;
                E.e1 = pg8::EpiG1{(pg8::bf16_t*)(ws + WS_U), (pg8::bf16_t*)(ws + WS_G), AIN(I_BMERGE) + layer * GP};
                E.e2 = pg8::EpiG2{(const pg8::bf16_t*)(ws + WS_G), (float*)(ws + WS_TMP), (pg8::bf16_t*)(ws + WS_MG), CH / 256};
                E.e3 = pg8::EpiG3{X, O};
                if (k == 1) g = pg8::Gemm{layer == 0 ? (const pg8::bf16_t*)(ws + WS_HN0) + (size_t)ck.tok0 * DM : (const pg8::bf16_t*)(ws + WS_HN), (const pg8::bf16_t*)(ws + WS_WCAT + layer * WCAT_BYTES), CH, NCAT, 1024};
                else if (k == 4) g = pg8::Gemm{(const pg8::bf16_t*)(ws + WS_Y), (const pg8::bf16_t*)(ws + WS_WBT + layer * WBT_BYTES), 3 * CH, 3072, 512};
                else g = pg8::Gemm{(const pg8::bf16_t*)(ws + WS_MG), (const pg8::bf16_t*)(ws + WS_WOT + layer * WOT_BYTES), CH, 1024, 1024};
                const int nrep = (((DUP_MASK & 8) && k == 1) || ((DUP_MASK & 16) && k == 4)) ? 2 : 1;
#pragma unroll 1
                for (int rep = 0; rep < nrep; ++rep) { if (rep) xcd_barrier(xbar); pg8::gemm_phase<pg8::EpiAll, pg8::OrderAll, true, true>(lds, g, S, E); }
            } }
        }
        if (step + 1 < step_hi) { if (step == 0) grid.sync(); else xcd_barrier(xbar); }
    }
}
#ifndef MK_MULTI
#define MK_MULTI 0
#endif
extern "C" void kernel_launch(void* const* d_in, const int* in_sizes, int n_in, void* d_out, int out_size, void* d_ws, size_t ws_size, hipStream_t stream) {
    static int grid = 0;
    if (grid == 0) {
        if (n_in != N_IN || out_size != NTOK * DM || ws_size < WS_END) { fprintf(stderr, "kernel_launch: unexpected shapes (n_in %d, out %d, ws %zu)\n", n_in, out_size, ws_size); grid = -1; return; }
        int dev = 0, cus = 0, per_cu = 0;
        hipGetDevice(&dev); hipDeviceGetAttribute(&cus, hipDeviceAttributeMultiprocessorCount, dev);
        if (hipFuncSetAttribute((const void*)mega_fwd, hipFuncAttributeMaxDynamicSharedMemorySize, LDS_BYTES) != hipSuccess) { fprintf(stderr, "kernel_launch: hipFuncSetAttribute failed\n"); grid = -1; return; }
        hipOccupancyMaxActiveBlocksPerMultiprocessor(&per_cu, (const void*)mega_fwd, NT, LDS_BYTES);
        (void)hipGetLastError();
        if (per_cu < 1) per_cu = 1;
        grid = cus * 1;
        fprintf(stderr, "kernel_launch: cus %d per_cu %d grid %d\n", cus, per_cu, grid);
    }
    if (grid < 0) return;
    hipMemsetAsync((char*)d_ws + WS_CTL, 0, CTL_BYTES, stream);
    Args a{};
    for (int i = 0; i < N_IN; ++i) a.in[i] = (const float*)d_in[i];
    a.out = (float*)d_out; a.ws = (unsigned char*)d_ws;
#if MK_MULTI
    for (int s = 0; s < NSTEPS; ++s) { a.lo = s; a.hi = s + 1; hipLaunchKernelGGL(mega_fwd, dim3(grid), dim3(NT), LDS_BYTES, stream, a); }
#else
    a.lo = 0; a.hi = NSTEPS;
    void* args[] = {&a};
    hipError_t e = hipLaunchCooperativeKernel((const void*)mega_fwd, dim3(grid), dim3(NT), args, LDS_BYTES, stream);
    if (e != hipSuccess) fprintf(stderr, "cooperative launch failed: %s (grid %d)\n", hipGetErrorString(e), grid);
#endif
}
```

```cpp
#include <hip/hip_runtime.h>
#include <hip/hip_cooperative_groups.h>
#include <cstdio>
#include <cstdint>
namespace cg = cooperative_groups;
__device__ __forceinline__ int ltid() { int t = (int)threadIdx.x; asm volatile("" : "+v"(t)); return t; }
__device__ __forceinline__ int lbid() { int b = (int)blockIdx.x; asm volatile("" : "+s"(b)); return b; }
namespace pg8 {
#define PG8_LAS __attribute__((address_space(3)))
typedef unsigned short bf16_t;
typedef short bf16x8 __attribute__((ext_vector_type(8)));
typedef float f32x4 __attribute__((ext_vector_type(4)));
typedef unsigned u32x4 __attribute__((ext_vector_type(4)));
constexpr int BM = 256, BK = 64, HALF = 128, HTB = HALF * BK * 2  , STAGE_BYTES = 8 * HTB, NXCD = 8, WGM = 8;

__host__ __device__ __forceinline__ int lds_byte(int r, int c) { const int st = (r >> 4) * 2 + (c >> 5), rr = r & 15, cc = c & 31, ob = rr * 64 + cc * 2; return st * 1024 + (ob ^ (((ob >> 9) & 1) << 5)); }
__host__ __device__ __forceinline__ void stage_rc(int b, int& R, int& C) { const int st = b / 1024, sb = b % 1024, swz = sb ^ (((sb >> 9) & 1) << 5); R = (st >> 1) * 16 + swz / 64; C = (st & 1) * 32 + (swz % 64) / 2; }
__host__ __device__ __forceinline__ int perm32(int rho) { const int n = rho >> 4, i = rho & 15; return 8 * (i >> 2) + 4 * n + (i & 3); }

struct Unit { int pm, pn; };
struct Gemm { const bf16_t* A; const bf16_t* Bt; int M, N, K; };

struct StaticOrder {
    int nM, nN, nwg, G, c;
    __host__ __device__ void init(int M, int N, int G_, int c_) { nM = M / BM; nN = N / BM; nwg = nM * nN; G = G_; c = c_; }
    __host__ __device__ bool next(int i, Unit& u) const {
        const long L = (long)i * G + c; if (L >= nwg) return false;
        int wgid = (int)L; { const int q = nwg / NXCD, r = nwg % NXCD, xcd = wgid % NXCD, off = wgid / NXCD; wgid = (xcd < r ? xcd * (q + 1) : r * (q + 1) + (xcd - r) * q) + off; }
        const int nig = WGM * nN, gid = wgid / nig, fm = gid * WGM, gsz = (nM - fm) < WGM ? (nM - fm) : WGM;
        u.pm = fm + ((wgid % nig) % gsz); u.pn = (wgid % nig) / gsz; return true;
    }
    __device__ __forceinline__ void a_ready(const Unit&) const {}
    __device__ __forceinline__ void done(const Unit&) const {}
};

__device__ __forceinline__ unsigned cvt_pk_bf16(float lo, float hi) { unsigned r; asm volatile("v_cvt_pk_bf16_f32 %0, %1, %2" : "=v"(r) : "v"(lo), "v"(hi)); return r; }
template <class Epi, class Sched, bool ALIGN_EPI = false, bool SP2 = false>
__device__ __forceinline__ void gemm_phase(PG8_LAS unsigned char* lds, const Gemm g, const Sched& S, const Epi& E) {
    const int tid = ltid(), wid = __builtin_amdgcn_readfirstlane(tid >> 6), lane = tid & 63, wr = wid >> 2, wc = wid & 3, fr = lane & 15, fq = lane >> 4;
    const int K = g.K, nt = K / BK;
    unsigned voffA[2], voffB[2];
#pragma unroll
    for (int i = 0; i < 2; ++i) { int R, C; stage_rc(tid * 16 + i * 8192, R, C); const int Rb = Epi::PERM ? ((R & ~31) + perm32(R & 31)) : R;
        voffA[i] = (unsigned)(R * K + C) * 2u; voffB[i] = (unsigned)(Rb * K + C) * 2u; }
    const size_t kstep = (size_t)(BK * 2);
    const size_t hstep = (size_t)HALF * K * 2;
    const size_t tstep = 2 * hstep;
    const unsigned ldsw = (unsigned)wid * 1024u;
    const int aoff = lds_byte(wr * 64 + fr, fq * 8), boff = lds_byte(wc * 32 + fr, fq * 8);
#define PG8_SA(b, h) (((b) * 2 + (h)) * HTB)
#define PG8_SB(b, h) ((4 + (b) * 2 + (h)) * HTB)
#define PG8_STAGE(bufoff, gbase, voff) do { _Pragma("unroll") for (int _i = 0; _i < 2; ++_i) \
        __builtin_amdgcn_global_load_lds((const unsigned*)((const char*)(gbase) + (voff)[_i]), (PG8_LAS unsigned*)(lds + (bufoff) + ldsw + _i * 8192), 16, 0, 0); } while (0)
#define PG8_LDA(dst, b, h) do { _Pragma("unroll") for (int m = 0; m < 4; ++m) _Pragma("unroll") for (int k = 0; k < 2; ++k) dst[m][k] = *(const PG8_LAS bf16x8*)(lds + PG8_SA(b, h) + aoff + m * 2048 + k * 1024); } while (0)
#define PG8_LDB(dst, b, h) do { _Pragma("unroll") for (int n = 0; n < 2; ++n) _Pragma("unroll") for (int k = 0; k < 2; ++k) dst[n][k] = *(const PG8_LAS bf16x8*)(lds + PG8_SB(b, h) + boff + n * 2048 + k * 1024); } while (0)
#define PG8_MMA(ai, bj, At, Bt) do { __builtin_amdgcn_s_setprio(1); _Pragma("unroll") for (int m = 0; m < 4; ++m) _Pragma("unroll") for (int n = 0; n < 2; ++n) _Pragma("unroll") for (int k = 0; k < 2; ++k) \
        acc[ai][bj][m][n] = __builtin_amdgcn_mfma_f32_16x16x32_bf16(Bt[n][k], At[m][k], acc[ai][bj][m][n], 0, 0, 0); __builtin_amdgcn_s_setprio(0); } while (0)
#define PG8_WAIT_V(n) asm volatile("s_waitcnt vmcnt(" #n ")" ::: "memory")
#define PG8_WAIT_L(n) asm volatile("s_waitcnt lgkmcnt(" #n ")" ::: "memory")
#define PG8_BAR __builtin_amdgcn_s_barrier()
#define PG8_SCHED __builtin_amdgcn_sched_barrier(0)
    Unit cur, nxt; int ui = 0;
    if (!S.next(0, cur)) return;
    f32x4 acc[2][2][4][2];
#pragma unroll
    for (int a = 0; a < 2; ++a)
#pragma unroll
        for (int b = 0; b < 2; ++b)
#pragma unroll
            for (int m = 0; m < 4; ++m)
#pragma unroll
                for (int n = 0; n < 2; ++n) acc[a][b][m][n] = (f32x4){0.f, 0.f, 0.f, 0.f};
    bf16x8 At[4][2], B0[2][2], B1[2][2];
    const char* cA = (const char*)g.A + (size_t)cur.pm * tstep; const char* cB = (const char*)g.Bt + (size_t)cur.pn * tstep;
    S.a_ready(cur);
    if constexpr (SP2) {
        PG8_STAGE(PG8_SB(0, 0), cB, voffB); PG8_STAGE(PG8_SB(0, 1), cB + hstep, voffB); PG8_STAGE(PG8_SA(0, 0), cA, voffA); PG8_STAGE(PG8_SA(0, 1), cA + hstep, voffA);
        if (wr == 1) PG8_BAR;
        PG8_WAIT_V(2); PG8_BAR;
        PG8_STAGE(PG8_SB(1, 0), cB + kstep, voffB); PG8_STAGE(PG8_SA(1, 0), cA + kstep, voffA); PG8_STAGE(PG8_SB(1, 1), cB + hstep + kstep, voffB);
        PG8_WAIT_V(6); PG8_BAR;
    } else {
        PG8_STAGE(PG8_SB(0, 0), cB, voffB); PG8_STAGE(PG8_SA(0, 0), cA, voffA); PG8_STAGE(PG8_SB(0, 1), cB + hstep, voffB); PG8_STAGE(PG8_SA(0, 1), cA + hstep, voffA);
        if (wr == 1) PG8_BAR;
        PG8_WAIT_V(4); PG8_BAR;
        PG8_STAGE(PG8_SB(1, 0), cB + kstep, voffB); PG8_STAGE(PG8_SA(1, 0), cA + kstep, voffA); PG8_STAGE(PG8_SB(1, 1), cB + hstep + kstep, voffB);
        PG8_WAIT_V(6); PG8_BAR;
    }
    for (;;) {
        const bool has_next = S.next(ui + 1, nxt);
        const char* nA = has_next ? (const char*)g.A + (size_t)nxt.pm * tstep : cA; const char* nB = has_next ? (const char*)g.Bt + (size_t)nxt.pn * tstep : cB;
        for (int t = 0; t < nt; t += 2) {
            const bool last = (t == nt - 2);
            const char* a1 = cA + (size_t)(t + 1) * kstep;
            const char* a2 = last ? nA : cA + (size_t)(t + 2) * kstep; const char* b2 = last ? nB : cB + (size_t)(t + 2) * kstep;
            const char* a3 = a2 + kstep; const char* b3 = b2 + kstep;
            if (last && has_next) S.a_ready(nxt);
            if constexpr (SP2) {
            PG8_LDB(B0, 0, 0); PG8_LDB(B1, 0, 1); PG8_SCHED; PG8_LDA(At, 0, 0); PG8_STAGE(PG8_SA(1, 1), a1 + hstep, voffA);
            PG8_WAIT_V(8); PG8_WAIT_L(0); PG8_BAR; PG8_MMA(0, 0, At, B0); PG8_MMA(0, 1, At, B1); PG8_BAR; PG8_SCHED;
            PG8_LDA(At, 0, 1); PG8_STAGE(PG8_SB(0, 0), b2, voffB); PG8_STAGE(PG8_SB(0, 1), b2 + hstep, voffB); PG8_STAGE(PG8_SA(0, 0), a2, voffA);
            PG8_WAIT_V(8); PG8_WAIT_L(0); PG8_BAR; PG8_MMA(1, 0, At, B0); PG8_MMA(1, 1, At, B1); PG8_BAR; PG8_SCHED;
            PG8_LDB(B0, 1, 0); PG8_LDB(B1, 1, 1); PG8_SCHED; PG8_LDA(At, 1, 0); PG8_STAGE(PG8_SA(0, 1), a2 + hstep, voffA);
            PG8_WAIT_V(8); PG8_WAIT_L(0); PG8_BAR; PG8_MMA(0, 0, At, B0); PG8_MMA(0, 1, At, B1); PG8_BAR; PG8_SCHED;
            PG8_LDA(At, 1, 1); PG8_STAGE(PG8_SB(1, 0), b3, voffB); PG8_STAGE(PG8_SB(1, 1), b3 + hstep, voffB); PG8_STAGE(PG8_SA(1, 0), a3, voffA);
            PG8_WAIT_V(8); PG8_WAIT_L(0); PG8_BAR; PG8_MMA(1, 0, At, B0); PG8_MMA(1, 1, At, B1); PG8_BAR; PG8_SCHED;
            } else {
            PG8_LDB(B0, 0, 0); PG8_SCHED; PG8_LDA(At, 0, 0); PG8_STAGE(PG8_SA(1, 1), a1 + hstep, voffA);
            PG8_WAIT_L(8); PG8_BAR; PG8_WAIT_L(0); PG8_MMA(0, 0, At, B0); PG8_BAR; PG8_SCHED;
            PG8_LDB(B1, 0, 1); PG8_STAGE(PG8_SB(0, 0), b2, voffB);
            PG8_BAR; PG8_WAIT_L(0); PG8_MMA(0, 1, At, B1); PG8_BAR;
            PG8_LDA(At, 0, 1); PG8_STAGE(PG8_SA(0, 0), a2, voffA);
            PG8_BAR; PG8_WAIT_L(0); PG8_MMA(1, 0, At, B0); PG8_BAR; PG8_SCHED;
            PG8_STAGE(PG8_SB(0, 1), b2 + hstep, voffB);
            PG8_WAIT_V(6); PG8_BAR; PG8_MMA(1, 1, At, B1); PG8_BAR;
            PG8_LDB(B0, 1, 0); PG8_SCHED; PG8_LDA(At, 1, 0); PG8_STAGE(PG8_SA(0, 1), a2 + hstep, voffA);
            PG8_WAIT_L(8); PG8_BAR; PG8_WAIT_L(0); PG8_MMA(0, 0, At, B0); PG8_BAR; PG8_SCHED;
            PG8_LDB(B1, 1, 1); PG8_STAGE(PG8_SB(1, 0), b3, voffB);
            PG8_BAR; PG8_WAIT_L(0); PG8_MMA(0, 1, At, B1); PG8_BAR;
            PG8_LDA(At, 1, 1); PG8_STAGE(PG8_SA(1, 0), a3, voffA);
            PG8_BAR; PG8_WAIT_L(0); PG8_MMA(1, 0, At, B0); PG8_BAR; PG8_SCHED;
            PG8_STAGE(PG8_SB(1, 1), b3 + hstep, voffB);
            PG8_WAIT_V(6); PG8_BAR; PG8_MMA(1, 1, At, B1); PG8_BAR;
            }
        }
        if constexpr (ALIGN_EPI) { if (wr == 0) PG8_BAR; }
        if constexpr (!Epi::AFTER_DRAIN) { E(acc, cur, wr, wc, fr, fq); S.done(cur); }
        if (!has_next) break;
#pragma unroll
        for (int a = 0; a < 2; ++a)
#pragma unroll
            for (int b = 0; b < 2; ++b)
#pragma unroll
                for (int m = 0; m < 4; ++m)
#pragma unroll
                    for (int n = 0; n < 2; ++n) acc[a][b][m][n] = (f32x4){0.f, 0.f, 0.f, 0.f};
        cur = nxt; cA = nA; cB = nB; ++ui;
        if constexpr (ALIGN_EPI) { if (wr == 1) PG8_BAR; }
    }
    PG8_WAIT_V(0);
    if constexpr (!ALIGN_EPI) { if (wr == 0) PG8_BAR; }
    PG8_BAR;
    if constexpr (Epi::AFTER_DRAIN) { E.fused(acc, cur, wr, wc, fr, fq, lds, wid, lane); S.done(cur); }
#undef PG8_SA
#undef PG8_SB
#undef PG8_STAGE
#undef PG8_LDA
#undef PG8_LDB
#undef PG8_MMA
#undef PG8_WAIT_V
#undef PG8_WAIT_L
#undef PG8_BAR
#undef PG8_SCHED
}
__device__ __forceinline__ float bf2f(unsigned short h) { return __uint_as_float(((unsigned)h) << 16); }
__device__ __forceinline__ float fast_sigmoid(float x) { return __builtin_amdgcn_rcpf(1.0f + __builtin_amdgcn_exp2f(-1.4426950408889634f * x)); }
struct EpiG1 {
    static constexpr bool PERM = true, AFTER_DRAIN = false;
    bf16_t* U; bf16_t* G; const float* bias;
    __device__ __forceinline__ void operator()(const f32x4 (&acc)[2][2][4][2], const Unit& u, int wr, int wc, int fr, int fq) const {
        const int row0 = u.pm * BM + wr * 64 + fr; int colt = u.pn * BM; const bool isg = colt >= 5376;
        bf16_t* base = U; int ldc = 5376; if (isg) { colt -= 5376; base = G; ldc = 3072; }
        const int col0 = colt + wc * 32 + 8 * fq;
        f32x4 bv[2][2];
#pragma unroll
        for (int bj = 0; bj < 2; ++bj)
#pragma unroll
            for (int n = 0; n < 2; ++n) bv[bj][n] = isg ? *(const f32x4*)(bias + col0 + bj * HALF + 4 * n) : (f32x4){0.f, 0.f, 0.f, 0.f};
#pragma unroll
        for (int ai = 0; ai < 2; ++ai)
#pragma unroll
            for (int m = 0; m < 4; ++m) { bf16_t* rowp = base + (size_t)(row0 + ai * HALF + m * 16) * ldc + col0;
#pragma unroll
                for (int bj = 0; bj < 2; ++bj) { f32x4 v0 = acc[ai][bj][m][0] + bv[bj][0], v1 = acc[ai][bj][m][1] + bv[bj][1];
                    if (isg) {
#pragma unroll
                        for (int e = 0; e < 4; ++e) { v0[e] = fast_sigmoid(v0[e]); v1[e] = fast_sigmoid(v1[e]); } }
                    u32x4 w; w.x = cvt_pk_bf16(v0[0], v0[1]); w.y = cvt_pk_bf16(v0[2], v0[3]); w.z = cvt_pk_bf16(v1[0], v1[1]); w.w = cvt_pk_bf16(v1[2], v1[3]);
                    *(u32x4*)(rowp + bj * HALF) = w; } }
    }
};
struct EpiG2 {
    static constexpr bool PERM = true, AFTER_DRAIN = false;
    const bf16_t* G; float* T; bf16_t* Mg; int npan;
    __device__ __forceinline__ void operator()(const f32x4 (&acc)[2][2][4][2], const Unit& u, int wr, int wc, int fr, int fq) const {
        const int b = u.pm / npan, pm = u.pm - b * npan, pn = u.pn & 3;
        const int row0 = pm * BM + wr * 64 + fr, col0 = pn * BM + wc * 32 + 8 * fq;
#pragma unroll
        for (int ai = 0; ai < 2; ++ai)
#pragma unroll
            for (int m = 0; m < 4; ++m) { const size_t row = (size_t)(row0 + ai * HALF + m * 16);
#pragma unroll
                for (int bj = 0; bj < 2; ++bj) { const int col = col0 + bj * HALF;
                    const u32x4 g = *(const u32x4*)(G + row * 3072 + b * 1024 + col);
                    f32x4 v0 = acc[ai][bj][m][0], v1 = acc[ai][bj][m][1];
                    v0[0] *= __uint_as_float(g.x << 16); v0[1] *= __uint_as_float(g.x & 0xffff0000u); v0[2] *= __uint_as_float(g.y << 16); v0[3] *= __uint_as_float(g.y & 0xffff0000u);
                    v1[0] *= __uint_as_float(g.z << 16); v1[1] *= __uint_as_float(g.z & 0xffff0000u); v1[2] *= __uint_as_float(g.w << 16); v1[3] *= __uint_as_float(g.w & 0xffff0000u);
                    bf16_t* mp = Mg + row * 1024 + col;
                    if (b > 0) { const u32x4 t = *(const u32x4*)mp;
                        v0[0] += __uint_as_float(t.x << 16); v0[1] += __uint_as_float(t.x & 0xffff0000u); v0[2] += __uint_as_float(t.y << 16); v0[3] += __uint_as_float(t.y & 0xffff0000u);
                        v1[0] += __uint_as_float(t.z << 16); v1[1] += __uint_as_float(t.z & 0xffff0000u); v1[2] += __uint_as_float(t.w << 16); v1[3] += __uint_as_float(t.w & 0xffff0000u); }
                    u32x4 w; w.x = cvt_pk_bf16(v0[0], v0[1]); w.y = cvt_pk_bf16(v0[2], v0[3]); w.z = cvt_pk_bf16(v1[0], v1[1]); w.w = cvt_pk_bf16(v1[2], v1[3]);
                    *(u32x4*)mp = w; } }
    }
};
struct OrderG2 {
    int npan, G, c;
    __device__ bool next(int i, Unit& u) const { const int ti = i / 3, b = i - 3 * ti, t = ti * G + c; if (t >= npan * 4) return false;
        const int pm = t >> 2, pn = t & 3; u.pm = b * npan + pm; u.pn = b * 4 + pn; return true; }
    __device__ __forceinline__ void a_ready(const Unit&) const {}
    __device__ __forceinline__ void done(const Unit&) const {}
};
struct EpiG3 {
    static constexpr bool PERM = true, AFTER_DRAIN = false;
    const float* X; float* O;
    __device__ __forceinline__ void operator()(const f32x4 (&acc)[2][2][4][2], const Unit& u, int wr, int wc, int fr, int fq) const {
        const int row0 = u.pm * BM + wr * 64 + fr, col0 = u.pn * BM + wc * 32 + 8 * fq;
#pragma unroll
        for (int ai = 0; ai < 2; ++ai)
#pragma unroll
            for (int m = 0; m < 4; ++m) { const size_t row = (size_t)(row0 + ai * HALF + m * 16);
#pragma unroll
                for (int bj = 0; bj < 2; ++bj) { const size_t p = row * 1024 + col0 + bj * HALF;
                    const f32x4 x0 = *(const f32x4*)(X + p), x1 = *(const f32x4*)(X + p + 4);
                    *(f32x4*)(O + p) = x0 + acc[ai][bj][m][0]; *(f32x4*)(O + p + 4) = x1 + acc[ai][bj][m][1]; } }
    }
};
struct EpiAll {
    static constexpr bool PERM = true, AFTER_DRAIN = false;
    int mode; EpiG1 e1; EpiG2 e2; EpiG3 e3;
    __device__ __forceinline__ void operator()(const f32x4 (&acc)[2][2][4][2], const Unit& u, int wr, int wc, int fr, int fq) const {
        if (mode == 1) e1(acc, u, wr, wc, fr, fq); else if (mode == 2) e2(acc, u, wr, wc, fr, fq); else e3(acc, u, wr, wc, fr, fq); }
};
struct OrderAll {
    int mode; StaticOrder so; OrderG2 o2;
    __device__ __forceinline__ bool next(int i, Unit& u) const { return mode == 2 ? o2.next(i, u) : so.next(i, u); }
    __device__ __forceinline__ void a_ready(const Unit&) const {}
    __device__ __forceinline__ void done(const Unit&) const {}
};
}
#ifndef DUP_MASK
#define DUP_MASK 0
#endif
#ifndef EN_MASK
#define EN_MASK 0xffff
#endif
#define EN(i) ((EN_MASK >> (i)) & 1)
#define LAS __attribute__((address_space(3)))
typedef unsigned short bf16;
typedef float f32x4 __attribute__((ext_vector_type(4)));
typedef float f32x2 __attribute__((ext_vector_type(2)));
typedef unsigned u32x4 __attribute__((ext_vector_type(4)));
typedef unsigned u32x2 __attribute__((ext_vector_type(2)));
constexpr int DM = 1024, NTOK_P = 65536, NTOK_S = 32768, NTOK = NTOK_P + NTOK_S, LP = 8192, LS = 2048;
constexpr int CH = 16384, NCHUNK = NTOK / CH, NCH_P = NTOK_P / CH;
constexpr int UP = 5376, NCAT = 8448, GP = 3072;
constexpr int C_X0 = 0, C_X1 = 512, C_HV = 1024, C_HG = 1536, C_GQ = 2048, C_GK = 2560, C_GV = 2688, C_GG = 2816, C_DQ = 3328, C_DK = 3840, C_DV = 4352, C_DG = 4864;
constexpr float EPS = 1e-6f, LOG2E = 1.4426950408889634f;
constexpr int NT = 512, NWAVES = 8;
enum { I_XP = 0, I_XS, I_RELB, I_NORMG, I_WIN, I_CONVW, I_CONVB, I_FW1, I_FB1, I_FW2, I_FB2, I_FWOUT, I_FFREQ, I_HYBIAS, I_QNG, I_KNG, I_LQ1, I_LK1, I_LQ2, I_LK2, I_SUBLN, I_WBHY, I_WBGQ, I_WBDF, I_WMERGE, I_BMERGE, I_WOUT, I_FINALG, N_IN };
constexpr size_t MiB = 1u << 20;
constexpr size_t WS_CTL = 0, CTL_BYTES = 64 * 1024;
constexpr size_t WS_TW = 1 * MiB;
constexpr size_t WS_WCAT = 2 * MiB, WCAT_BYTES = (size_t)NCAT * 1024 * 2;
constexpr size_t WS_WBT = 40 * MiB, WBT_BYTES = (size_t)3 * 1024 * 512 * 2;
constexpr size_t WS_WOT = 46 * MiB, WOT_BYTES = (size_t)1024 * 1024 * 2;
constexpr int SPS_P = LP + 16, SPS_S = LS + 16;
constexpr size_t SPEC_P_BYTES = (size_t)256 * SPS_P * 8, SPEC_S_BYTES = (size_t)256 * SPS_S * 8;
constexpr size_t SPEC_LAYER = 2 * SPEC_P_BYTES + 2 * SPEC_S_BYTES;
constexpr size_t WS_SPEC = 52 * MiB;
constexpr size_t WS_HN = 140 * MiB, WS_U = 172 * MiB, WS_G = 340 * MiB, WS_Y = 436 * MiB, WS_MG = 484 * MiB, WS_TMP = 516 * MiB, WS_DT = 580 * MiB, WS_HVP = 612 * MiB, WS_PMP = 644 * MiB, WS_ROPE = 676 * MiB, WS_HN0 = 680 * MiB, WS_END = 872 * MiB;
constexpr size_t HF_P_BYTES = (size_t)LP * 1024 * 4, HF_S_BYTES = (size_t)LS * 1024 * 4;
static_assert(WS_WCAT + 2 * WCAT_BYTES <= WS_WBT && WS_WBT + 2 * WBT_BYTES <= WS_WOT && WS_WOT + 2 * WOT_BYTES <= WS_SPEC && WS_SPEC + 2 * SPEC_LAYER <= WS_HN, "ws map");
static_assert(WS_HN + (size_t)CH * 1024 * 2 <= WS_U && WS_U + (size_t)CH * UP * 2 <= WS_G && WS_G + (size_t)CH * GP * 2 <= WS_Y && WS_Y + (size_t)3 * CH * 512 * 2 <= WS_MG && WS_MG + (size_t)CH * 1024 * 2 <= WS_TMP && WS_TMP + (size_t)CH * 1024 * 4 <= WS_DT && WS_DT + (size_t)CH * 512 * 4 <= WS_END, "ws map 2");
static_assert(2 * (HF_P_BYTES + HF_S_BYTES) <= (size_t)CH * UP * 2, "hf overlay");
constexpr int LDS_MAIN = 139264, LDS_BYTES = LDS_MAIN + 1024;
constexpr int CW_BAR = 4096;

struct Args { const float* in[N_IN]; float* out; unsigned char* ws; int lo, hi; };
typedef const __attribute__((address_space(4))) unsigned long long* kargp_t;
struct AV { kargp_t p; };
#define AIN(i) ((const float*)(a.p[(i)]))
#define AOUT ((float*)(a.p[N_IN]))
#define AWS ((unsigned char*)(a.p[N_IN + 1]))


__device__ __forceinline__ float bf2f(unsigned short h) { return __uint_as_float(((unsigned)h) << 16); }
__device__ __forceinline__ float bflo(unsigned w) { return __uint_as_float(w << 16); }
__device__ __forceinline__ float bfhi(unsigned w) { return __uint_as_float(w & 0xffff0000u); }
__device__ __forceinline__ unsigned f2bf(float f) { unsigned u = __builtin_bit_cast(unsigned, f); return (u + 0x7fffu + ((u >> 16) & 1u)) >> 16; }
__device__ __forceinline__ unsigned pk2(float lo, float hi) { return f2bf(lo) | (f2bf(hi) << 16); }
__device__ __forceinline__ float silu(float x) { return x * __builtin_amdgcn_rcpf(1.0f + __builtin_amdgcn_exp2f(-LOG2E * x)); }
__device__ __forceinline__ float wave_sum(float v) {
#pragma unroll
    for (int o = 1; o < 64; o <<= 1) v += __shfl_xor(v, o);
    return v;
}
__device__ __forceinline__ double kd(double v) { asm volatile("" : "+s"(v)); return v; }
__device__ __forceinline__ void sincos_rev(double r, float& s, float& c) {
    r -= __builtin_rint(r);
    const double k = __builtin_rint(r * 4.0);
    const double x = (r - k * 0.25) * kd(6.283185307179586476925);
    const double x2 = x * x;
    double sp = kd(1.0 / 6227020800.0); sp = sp * x2 + kd(-1.0 / 39916800); sp = sp * x2 + kd(1.0 / 362880); sp = sp * x2 + kd(-1.0 / 5040); sp = sp * x2 + kd(1.0 / 120); sp = sp * x2 + kd(-1.0 / 6); sp = sp * x2 + 1.0; sp *= x;
    double cp = kd(-1.0 / 87178291200.0); cp = cp * x2 + kd(1.0 / 479001600.0); cp = cp * x2 + kd(-1.0 / 3628800); cp = cp * x2 + kd(1.0 / 40320); cp = cp * x2 + kd(-1.0 / 720); cp = cp * x2 + kd(1.0 / 24); cp = cp * x2 + (-0.5); cp = cp * x2 + 1.0;
    const int q = ((int)k) & 3;
    const float sf = (float)sp, cf = (float)cp;
    s = (q == 0) ? sf : (q == 1) ? cf : (q == 2) ? -sf : -cf;
    c = (q == 0) ? cf : (q == 1) ? -sf : (q == 2) ? -cf : sf;
}
__device__ __forceinline__ float sin_acc(float x) { float s, c; sincos_rev((double)x * 0.15915494309189533577, s, c); return s; }

__device__ __forceinline__ void transpose_item(const float* W, int K, int N, bf16* WT, int row_off, LAS float* scr, int item, int lane) {
    const int nblk = N / 32, kb = item / nblk, nb = item % nblk, k0 = 64 * kb, n0 = 32 * nb;
#pragma unroll 8
    for (int i = 0; i < 32; ++i) { const int kk = 2 * i + (lane >> 5); scr[kk * 33 + (lane & 31)] = W[(size_t)(k0 + kk) * N + n0 + (lane & 31)]; }
    asm volatile("s_waitcnt lgkmcnt(0)" ::: "memory");
    const int c = lane & 7;
#pragma unroll
    for (int j = 0; j < 4; ++j) { const int n = (lane >> 3) + 8 * j; const LAS float* s = scr + (8 * c) * 33 + n;
        u32x4 o; o.x = pk2(s[0 * 33], s[1 * 33]); o.y = pk2(s[2 * 33], s[3 * 33]); o.z = pk2(s[4 * 33], s[5 * 33]); o.w = pk2(s[6 * 33], s[7 * 33]);
        *(u32x4*)(WT + (size_t)(row_off + n0 + n) * K + k0 + 8 * c) = o; }
    asm volatile("s_waitcnt lgkmcnt(0)" ::: "memory");
}

__device__ __forceinline__ f32x2 cmul(f32x2 a, f32x2 b) { return (f32x2){a.x * b.x - a.y * b.y, a.x * b.y + a.y * b.x}; }
__device__ __forceinline__ f32x2 cmulc(f32x2 a, f32x2 b) { return (f32x2){a.x * b.x + a.y * b.y, a.y * b.x - a.x * b.y}; }
__device__ __forceinline__ f32x2 cconj(f32x2 a) { return (f32x2){a.x, -a.y}; }
template <int LOG4> __device__ __forceinline__ int digitrev(int k) { unsigned x = __builtin_bitreverse32((unsigned)k) >> (32 - 2 * LOG4); return (int)(((x & 0x55555555u) << 1) | ((x >> 1) & 0x55555555u)); }
#define PADI(i) ((i) + ((i) >> 4))
#define W16C 0.92387953251128674f
#define W16S 0.38268343236508977f
#define W16H 0.70710678118654752f
__device__ __forceinline__ f32x2 w16(int m) { return m == 0 ? (f32x2){1.f, 0.f} : m == 1 ? (f32x2){W16C, -W16S} : m == 2 ? (f32x2){W16H, -W16H} : m == 3 ? (f32x2){W16S, -W16C} : m == 4 ? (f32x2){0.f, -1.f} : m == 6 ? (f32x2){-W16H, -W16H} : (f32x2){-W16C, W16S}; }
__device__ __forceinline__ void bfly_fwd(f32x2& a0, f32x2& a1, f32x2& a2, f32x2& a3) {
    const f32x2 t0 = a0 + a2, t1 = a0 - a2, t2 = a1 + a3, t3 = a1 - a3;
    a0 = t0 + t2; a2 = t0 - t2; a1 = (f32x2){t1.x + t3.y, t1.y - t3.x}; a3 = (f32x2){t1.x - t3.y, t1.y + t3.x};
}
__device__ __forceinline__ void bfly_inv(f32x2& b0, f32x2& b1, f32x2& b2, f32x2& b3) {
    const f32x2 t0 = b0 + b2, t1 = b0 - b2, t2 = b1 + b3, t3 = b1 - b3;
    b0 = t0 + t2; b2 = t0 - t2; b1 = (f32x2){t1.x - t3.y, t1.y + t3.x}; b3 = (f32x2){t1.x + t3.y, t1.y - t3.x};
}
template <int LOG4, int BATCH = 1> __device__ __forceinline__ void fft_fwd(LAS f32x2* buf, const f32x2* __restrict__ tw, int tid) {
    constexpr int N = 1 << (2 * LOG4), TWS = 16384 / N;
#pragma unroll 1
    for (int pass = 0; pass < LOG4 - 2; ++pass) {
        const int lq = 2 * (LOG4 - pass) - 2, q4 = 1 << lq, n = q4 << 2, tstep = TWS << (2 * pass);
        constexpr int IT = BATCH * N / 4 / NT, NPAD = N + N / 16;
        f32x2 wl[IT];
#pragma unroll
        for (int i = 0; i < IT; ++i) wl[i] = tw[((tid + i * NT) & (q4 - 1)) * tstep];
#pragma unroll
        for (int i = 0; i < IT; ++i) { const int jg = tid + i * NT, bo = (jg >> (2 * LOG4 - 2)) * NPAD, j = jg & (N / 4 - 1);
            const int blk = j >> lq, jj = j & (q4 - 1), base = blk * n + jj;
            const int i0 = bo + PADI(base), i1 = bo + PADI(base + q4), i2 = bo + PADI(base + 2 * q4), i3 = bo + PADI(base + 3 * q4);
            const f32x2 w1 = wl[i];
            f32x2 a0 = buf[i0], a1 = buf[i1], a2 = buf[i2], a3 = buf[i3];
            bfly_fwd(a0, a1, a2, a3);
            const f32x2 w2 = cmul(w1, w1), w3 = cmul(w2, w1);
            buf[i0] = a0; buf[i1] = cmul(a1, w1); buf[i2] = cmul(a2, w2); buf[i3] = cmul(a3, w3);
        }
        __syncthreads();
    }
#pragma unroll 1
    for (int b = tid; b < BATCH * N / 16; b += NT) {
        LAS f32x2* xb = buf + 17 * b; f32x2 x[16];
#pragma unroll
        for (int e = 0; e < 16; ++e) x[e] = xb[e];
#pragma unroll
        for (int jj = 0; jj < 4; ++jj) { bfly_fwd(x[jj], x[jj + 4], x[jj + 8], x[jj + 12]); if (jj) { x[jj + 4] = cmul(x[jj + 4], w16(jj)); x[jj + 8] = cmul(x[jj + 8], w16(2 * jj)); x[jj + 12] = cmul(x[jj + 12], w16(3 * jj)); } }
#pragma unroll
        for (int q = 0; q < 4; ++q) bfly_fwd(x[4 * q], x[4 * q + 1], x[4 * q + 2], x[4 * q + 3]);
#pragma unroll
        for (int e = 0; e < 16; ++e) xb[e] = x[e];
    }
    __syncthreads();
}
template <int LOG4, int BATCH = 1> __device__ __forceinline__ void fft_inv(LAS f32x2* buf, const f32x2* __restrict__ tw, int tid) {
    constexpr int N = 1 << (2 * LOG4), TWS = 16384 / N;
#pragma unroll 1
    for (int b = tid; b < BATCH * N / 16; b += NT) {
        LAS f32x2* xb = buf + 17 * b; f32x2 x[16];
#pragma unroll
        for (int e = 0; e < 16; ++e) x[e] = xb[e];
#pragma unroll
        for (int q = 0; q < 4; ++q) bfly_inv(x[4 * q], x[4 * q + 1], x[4 * q + 2], x[4 * q + 3]);
#pragma unroll
        for (int jj = 0; jj < 4; ++jj) { if (jj) { x[jj + 4] = cmulc(x[jj + 4], w16(jj)); x[jj + 8] = cmulc(x[jj + 8], w16(2 * jj)); x[jj + 12] = cmulc(x[jj + 12], w16(3 * jj)); } bfly_inv(x[jj], x[jj + 4], x[jj + 8], x[jj + 12]); }
#pragma unroll
        for (int e = 0; e < 16; ++e) xb[e] = x[e];
    }
    __syncthreads();
#pragma unroll 1
    for (int pass = LOG4 - 3; pass >= 0; --pass) {
        const int lq = 2 * (LOG4 - pass) - 2, q4 = 1 << lq, n = q4 << 2, tstep = TWS << (2 * pass);
        constexpr int IT = BATCH * N / 4 / NT, NPAD = N + N / 16;
        f32x2 wl[IT];
#pragma unroll
        for (int i = 0; i < IT; ++i) wl[i] = tw[((tid + i * NT) & (q4 - 1)) * tstep];
#pragma unroll
        for (int i = 0; i < IT; ++i) { const int jg = tid + i * NT, bo = (jg >> (2 * LOG4 - 2)) * NPAD, j = jg & (N / 4 - 1);
            const int blk = j >> lq, jj = j & (q4 - 1), base = blk * n + jj;
            const int i0 = bo + PADI(base), i1 = bo + PADI(base + q4), i2 = bo + PADI(base + 2 * q4), i3 = bo + PADI(base + 3 * q4);
            const f32x2 w1 = wl[i];
            const f32x2 w2 = cmul(w1, w1), w3 = cmul(w2, w1);
            f32x2 b0 = buf[i0], b1 = cmulc(buf[i1], w1), b2 = cmulc(buf[i2], w2), b3 = cmulc(buf[i3], w3);
            bfly_inv(b0, b1, b2, b3);
            buf[i0] = b0; buf[i1] = b1; buf[i2] = b2; buf[i3] = b3;
        }
        __syncthreads();
    }
}
__device__ const double ROPE_IF[16] = {1.0, 0.5623413251903491, 0.31622776601683794, 0.1778279410038923, 0.1, 0.05623413251903491, 0.03162277660168379, 0.01778279410038923,
    0.01, 0.005623413251903491, 0.0031622776601683794, 0.0017782794100389228, 0.001, 0.0005623413251903491, 0.00031622776601683794, 0.00017782794100389227};
struct Chunk { int tok0, L, nseq; };
__device__ __forceinline__ Chunk chunk_of(int c) { Chunk k; k.tok0 = c * CH; if (c < NCH_P) { k.L = LP; k.nseq = CH / LP; } else { k.L = LS; k.nseq = CH / LS; } return k; }
__device__ __forceinline__ const float* xin_rows(const AV& a, int tok0) { return tok0 < NTOK_P ? AIN(I_XP) + (size_t)tok0 * DM : AIN(I_XS) + (size_t)(tok0 - NTOK_P) * DM; }
__device__ __forceinline__ void hf_group(LAS float* sm, const AV& a, int layer, int L, int t0, float* hf, int tid) {
    LAS float* zs = sm; LAS float* A = sm + 512; LAS float* B = sm + 1024;
    const float* w1 = AIN(I_FW1) + layer * 33 * 64; const float* b1 = AIN(I_FB1) + layer * 64;
    const float* w2 = AIN(I_FW2) + layer * 2 * 64 * 64; const float* b2 = AIN(I_FB2) + layer * 2 * 64;
    const float* wo = AIN(I_FWOUT) + layer * 64 * 1024; const float* fr = AIN(I_FFREQ) + layer * 64;
    const int tt = tid >> 6, j = tid & 63, t = t0 + tt;
    const float t01 = (float)t / (float)(L - 1);
    if (j < 33) {
        float v;
        if (j == 0) v = t01;
        else { const int k = (j - 1) & 15; const double f = kd(1e-4) + (double)k * kd((15.0 - 1e-4) / 15.0); float s, c; sincos_rev(f * (double)t / (double)L, s, c); v = (j <= 16) ? c : -s; }
        zs[tt * 40 + j] = v;
    }
    __syncthreads();
    const float fq = fr[j];
    { float acc = b1[j]; for (int i = 0; i < 33; ++i) acc += zs[tt * 40 + i] * w1[i * 64 + j]; A[tt * 64 + j] = sin_acc(fq * acc); }
    __syncthreads();
    { float acc = b2[j]; for (int i = 0; i < 64; ++i) acc += A[tt * 64 + i] * w2[i * 64 + j]; B[tt * 64 + j] = sin_acc(fq * acc); }
    __syncthreads();
    { float acc = b2[64 + j]; for (int i = 0; i < 64; ++i) acc += B[tt * 64 + i] * w2[4096 + i * 64 + j]; A[tt * 64 + j] = sin_acc(fq * acc); }
    __syncthreads();
    { float acc0[8], acc1[8];
#pragma unroll
      for (int q = 0; q < 8; ++q) { acc0[q] = 0.f; acc1[q] = 0.f; }
#pragma unroll 8
      for (int i = 0; i < 64; ++i) { const float wa = wo[i * 1024 + tid], wb = wo[i * 1024 + 512 + tid];
#pragma unroll
          for (int q = 0; q < 8; ++q) { const float av = A[q * 64 + i]; acc0[q] += av * wa; acc1[q] += av * wb; } }
      const float ad = 3.070113457325394f + (float)tid * ((15.350567286626973f - 3.070113457325394f) / 511.0f);
#pragma unroll
      for (int q = 0; q < 8; ++q) { const float tq = (float)(t0 + q) / (float)(L - 1); const float win = __expf(-tq * ad);
          hf[(size_t)(t0 + q) * 1024 + tid] = acc0[q] * win; hf[(size_t)(t0 + q) * 1024 + 512 + tid] = acc1[q] * win; } }
    __syncthreads();
}
__device__ __forceinline__ void step_pro_a(const AV& a, LAS unsigned char* lds) {
    const int tid = ltid(), lane = tid & 63, wave = tid >> 6, G = gridDim.x;
    unsigned char* ws = AWS;
    { f32x2* tw = (f32x2*)(ws + WS_TW); for (int m = lbid() * NT + tid; m < 16384; m += G * NT) { float s, c; sincos_rev((double)m / 16384.0, s, c); tw[m] = (f32x2){c, -s}; } }
    { f32x2* rt = (f32x2*)(ws + WS_ROPE);
      for (int e = lbid() * NT + tid; e < 8192 * 32; e += G * NT) { const int pos = e >> 5, i = e & 31; const int pp = (i < 16) ? (pos >> 6) : (pos & 63);
          const double inv = ROPE_IF[i & 15]; float sn, cs; sincos_rev((double)pp * inv * 0.15915494309189533577, sn, cs); rt[e] = (f32x2){cs, sn}; } }
    { const float* g = AIN(I_NORMG); bf16* HN0 = (bf16*)(ws + WS_HN0); f32x4 gv[4];
#pragma unroll
      for (int j = 0; j < 4; ++j) gv[j] = *((const f32x4*)g + lane + 64 * j);
      for (int m = lbid() * NWAVES + wave; m < NTOK; m += G * NWAVES) {
          const f32x4* xr = (const f32x4*)(xin_rows(a, m)) + lane; f32x4 v[4]; float ssum = 0.f;
#pragma unroll
          for (int j = 0; j < 4; ++j) { v[j] = xr[64 * j]; ssum += (v[j].x * v[j].x + v[j].y * v[j].y) + (v[j].z * v[j].z + v[j].w * v[j].w); }
          const float rs = 1.0f / sqrtf(wave_sum(ssum) * (1.0f / DM) + EPS);
          u32x2* o8 = (u32x2*)(HN0 + (size_t)m * DM) + lane;
#pragma unroll
          for (int j = 0; j < 4; ++j) { u32x2 w; w.x = pk2(v[j].x * rs * gv[j].x, v[j].y * rs * gv[j].y); w.y = pk2(v[j].z * rs * gv[j].z, v[j].w * rs * gv[j].w); o8[64 * j] = w; } } }
    { LAS float* scr = (LAS float*)(lds + wave * 16384);
      constexpr int I_IN = 16 * (UP / 32), I_MG = 16 * (GP / 32), I_BR = 8 * 32, I_OU = 16 * 32, PER = I_IN + I_MG + 3 * I_BR + I_OU;
      for (int it = lbid() * NWAVES + wave; it < 2 * PER; it += G * NWAVES) {
          const int l = it / PER; int r = it - l * PER;
          bf16* wcat = (bf16*)(ws + WS_WCAT + l * WCAT_BYTES); bf16* wbt = (bf16*)(ws + WS_WBT + l * WBT_BYTES); bf16* wot = (bf16*)(ws + WS_WOT + l * WOT_BYTES);
          if (r < I_IN) { transpose_item(AIN(I_WIN) + (size_t)l * 1024 * UP, 1024, UP, wcat, 0, scr, r, lane); continue; } r -= I_IN;
          if (r < I_MG) { transpose_item(AIN(I_WMERGE) + (size_t)l * 1024 * GP, 1024, GP, wcat, UP, scr, r, lane); continue; } r -= I_MG;
          if (r < I_BR) { transpose_item(AIN(I_WBHY) + (size_t)l * 512 * 1024, 512, 1024, wbt, 0, scr, r, lane); continue; } r -= I_BR;
          if (r < I_BR) { transpose_item(AIN(I_WBGQ) + (size_t)l * 512 * 1024, 512, 1024, wbt, 1024, scr, r, lane); continue; } r -= I_BR;
          if (r < I_BR) { transpose_item(AIN(I_WBDF) + (size_t)l * 512 * 1024, 512, 1024, wbt, 2048, scr, r, lane); continue; } r -= I_BR;
          transpose_item(AIN(I_WOUT) + (size_t)l * 1024 * 1024, 1024, 1024, wot, 0, scr, r, lane);
      } }
}
__device__ __forceinline__ void step_pro_a2(const AV& a, LAS unsigned char* lds) {
    const int tid = ltid(), G = gridDim.x; unsigned char* ws = AWS;
    { constexpr int GPL = LP / 8 + LS / 8;
      for (int g = lbid(); g < 2 * GPL; g += G) { const int l = g / GPL; int r = g - l * GPL;
          float* hfp = (float*)(ws + WS_U + l * (HF_P_BYTES + HF_S_BYTES));
          if (r < LP / 8) hf_group((LAS float*)lds, a, l, LP, r * 8, hfp, tid);
          else hf_group((LAS float*)lds, a, l, LS, (r - LP / 8) * 8, (float*)((unsigned char*)hfp + HF_P_BYTES), tid); } }
}
template <int LOG4> __device__ __forceinline__ void filt_unit(const AV& a, LAS unsigned char* lds, int layer, int pr, const float* hf, f32x2* Pg, f32x2* Mg) {
    constexpr int N = 1 << (2 * LOG4), L = N / 2;
    const int tid = ltid(); LAS f32x2* buf = (LAS f32x2*)lds; const int c0 = 2 * pr;
    for (int n = tid; n < N; n += NT) { f32x2 v = (f32x2){0.f, 0.f};
        if (n < L) v = *(const f32x2*)(hf + (size_t)n * 1024 + c0); else if (n > L) v = *(const f32x2*)(hf + (size_t)(N - n) * 1024 + 512 + c0);
        buf[PADI(n)] = v; }
    __syncthreads();
    fft_fwd<LOG4>(buf, (const f32x2*)(AWS + WS_TW), tid);
    const float ba = AIN(I_HYBIAS)[layer * 512 + c0], bb = AIN(I_HYBIAS)[layer * 512 + c0 + 1]; const float sc = 1.0f / (float)N;
    for (int k = tid; k <= L; k += NT) { const int q1 = digitrev<LOG4>(k), q2 = digitrev<LOG4>((N - k) & (N - 1)); const f32x2 z1 = buf[PADI(q1)], z2 = buf[PADI(q2)];
        f32x2 ca = (f32x2){0.5f * (z1.x + z2.x), 0.5f * (z1.y - z2.y)}; const float dx = z1.x - z2.x, dy = z1.y + z2.y; f32x2 cb = (f32x2){0.5f * dy, -0.5f * dx};
        ca.x += ba; cb.x += bb;
        Pg[k] = (f32x2){0.5f * sc * (ca.x + cb.x), 0.5f * sc * (ca.y + cb.y)}; Mg[k] = (f32x2){0.5f * sc * (ca.x - cb.x), 0.5f * sc * (ca.y - cb.y)}; }
    __syncthreads();
}
__device__ __forceinline__ void step_pro_b(const AV& a, LAS unsigned char* lds) {
    for (int u = lbid(); u < 1024; u += gridDim.x) { const int l = u >> 9, r = u & 511; unsigned char* sp = AWS + WS_SPEC + l * SPEC_LAYER; const float* hfp = (const float*)(AWS + WS_U + l * (HF_P_BYTES + HF_S_BYTES));
        if (r < 256) filt_unit<7>(a, lds, l, r, hfp, (f32x2*)sp + (size_t)r * SPS_P, (f32x2*)(sp + SPEC_P_BYTES) + (size_t)r * SPS_P);
        else { const int pr = r - 256; filt_unit<6>(a, lds, l, pr, (const float*)((const unsigned char*)hfp + HF_P_BYTES), (f32x2*)(sp + 2 * SPEC_P_BYTES) + (size_t)pr * SPS_S, (f32x2*)(sp + 2 * SPEC_P_BYTES + SPEC_S_BYTES) + (size_t)pr * SPS_S); } }
}
__device__ __forceinline__ void step_norm(const AV& a, int c, int layer) {
    const int tid = ltid(), lane = tid & 63, wave = tid >> 6; const Chunk ck = chunk_of(c);
    const float* X = layer == 0 ? xin_rows(a, ck.tok0) : AOUT + (size_t)ck.tok0 * DM; bf16* HN = (bf16*)(AWS + WS_HN); const float* g = AIN(I_NORMG) + layer * DM;
    f32x4 gv[4];
#pragma unroll
    for (int j = 0; j < 4; ++j) gv[j] = *((const f32x4*)g + lane + 64 * j);
    for (int m = lbid() * NWAVES + wave; m < CH; m += gridDim.x * NWAVES) {
        const f32x4* xr = (const f32x4*)(X + (size_t)m * DM) + lane; f32x4 v[4]; float s = 0.f;
#pragma unroll
        for (int j = 0; j < 4; ++j) { v[j] = xr[64 * j]; s += (v[j].x * v[j].x + v[j].y * v[j].y) + (v[j].z * v[j].z + v[j].w * v[j].w); }
        const float rs = 1.0f / sqrtf(wave_sum(s) * (1.0f / DM) + EPS);
        u32x2* o8 = (u32x2*)(HN + (size_t)m * DM) + lane;
#pragma unroll
        for (int j = 0; j < 4; ++j) { u32x2 w; w.x = pk2(v[j].x * rs * gv[j].x, v[j].y * rs * gv[j].y); w.y = pk2(v[j].z * rs * gv[j].z, v[j].w * rs * gv[j].w); o8[64 * j] = w; }
    }
}
__device__ __forceinline__ void step_final(const AV& a) {
    const int tid = ltid(), lane = tid & 63, wave = tid >> 6; const float* g = AIN(I_FINALG);
    f32x4 gv[4];
#pragma unroll
    for (int j = 0; j < 4; ++j) gv[j] = *((const f32x4*)g + lane + 64 * j);
    for (int m = lbid() * NWAVES + wave; m < NTOK; m += gridDim.x * NWAVES) {
        f32x4* xr = (f32x4*)(AOUT + (size_t)m * DM) + lane; f32x4 v[4]; float s = 0.f;
#pragma unroll
        for (int j = 0; j < 4; ++j) { v[j] = xr[64 * j]; s += (v[j].x * v[j].x + v[j].y * v[j].y) + (v[j].z * v[j].z + v[j].w * v[j].w); }
        const float rs = 1.0f / sqrtf(wave_sum(s) * (1.0f / DM) + EPS);
#pragma unroll
        for (int j = 0; j < 4; ++j) xr[64 * j] = v[j] * rs * gv[j];
    }
}
__device__ __forceinline__ void step_prep(const AV& a, int c, int layer) {
    const Chunk ck = chunk_of(c); bf16* U = (bf16*)(AWS + WS_U);
    for (int it = lbid() * NT + ltid(); it < CH * 10; it += gridDim.x * NT) {
        const int tok = it / 10, hd = it - tok * 10; const int pos = tok & (ck.L - 1);
        bf16* p = U + (size_t)tok * UP + (hd < 8 ? C_GQ + 64 * hd : C_GK + 64 * (hd - 8));
        const float* g = (hd < 8 ? AIN(I_QNG) : AIN(I_KNG)) + layer * 64;
        float x[64];
#pragma unroll
        for (int i = 0; i < 8; ++i) { const u32x4 w = *((const u32x4*)p + i);
            x[8 * i + 0] = bflo(w.x); x[8 * i + 1] = bfhi(w.x); x[8 * i + 2] = bflo(w.y); x[8 * i + 3] = bfhi(w.y); x[8 * i + 4] = bflo(w.z); x[8 * i + 5] = bfhi(w.z); x[8 * i + 6] = bflo(w.w); x[8 * i + 7] = bfhi(w.w); }
        float ss = 0.f;
#pragma unroll
        for (int i = 0; i < 64; ++i) ss += x[i] * x[i];
        const float rs = (1.0f / sqrtf(ss * (1.0f / 64.0f) + EPS)) * (hd < 8 ? 0.125f * LOG2E : 1.0f);
#pragma unroll
        for (int i = 0; i < 64; ++i) x[i] = x[i] * rs * g[i];
        const f32x4* rt = (const f32x4*)(AWS + WS_ROPE) + (size_t)pos * 16;
#pragma unroll
        for (int i2 = 0; i2 < 16; ++i2) { const f32x4 cs2 = rt[i2];
#pragma unroll
            for (int e = 0; e < 2; ++e) { const int i = 2 * i2 + e; const float cs = e ? cs2.z : cs2.x, sn = e ? cs2.w : cs2.y; const float x1 = x[i], x2 = x[i + 32]; x[i] = x1 * cs - x2 * sn; x[i + 32] = x2 * cs + x1 * sn; } }
#pragma unroll
        for (int i = 0; i < 8; ++i) { u32x4 w; w.x = pk2(x[8 * i], x[8 * i + 1]); w.y = pk2(x[8 * i + 2], x[8 * i + 3]); w.z = pk2(x[8 * i + 4], x[8 * i + 5]); w.w = pk2(x[8 * i + 6], x[8 * i + 7]); *((u32x4*)p + i) = w; }
    }
}
__device__ __forceinline__ void step_prep_hy(const AV& a, LAS unsigned char* lds, int c, int layer) {
    const Chunk ck = chunk_of(c); const bf16* U = (const bf16*)(AWS + WS_U);
    f32x2* HVP = (f32x2*)(AWS + WS_HVP); f32x2* PMP = (f32x2*)(AWS + WS_PMP);
    const int tid = ltid(), lane = tid & 63, wave = tid >> 6;
    LAS f32x2* th = (LAS f32x2*)(lds + wave * 17408); LAS f32x2* tp = th + 64 * 17;
    const float* cw = AIN(I_CONVW) + layer * 3 * 1536; const float* cb = AIN(I_CONVB) + layer * 1536;
    for (int it = lbid() * NWAVES + wave; it < (CH / 16) * 4; it += gridDim.x * NWAVES) {
        const int cbk = it & 3, tg = it >> 2, t0 = tg * 16, ch = cbk * 128 + 2 * lane;
        const int pos0 = t0 & (ck.L - 1);
        float w[3][3][2], bb[3][2];
#pragma unroll
        for (int ar = 0; ar < 3; ++ar) {
#pragma unroll
            for (int j = 0; j < 3; ++j) { const f32x2 v = *(const f32x2*)(cw + j * 1536 + ar * 512 + ch); w[ar][j][0] = v.x; w[ar][j][1] = v.y; }
            const f32x2 v = *(const f32x2*)(cb + ar * 512 + ch); bb[ar][0] = v.x; bb[ar][1] = v.y; }
        const bf16* r0 = U + (size_t)t0 * UP + ch;
        unsigned pv[3], cv[3], nv[3];
#pragma unroll
        for (int ar = 0; ar < 3; ++ar) { pv[ar] = pos0 > 0 ? *(const unsigned*)(r0 - UP + ar * 512) : 0u; cv[ar] = *(const unsigned*)(r0 + ar * 512); }
#pragma unroll 4
        for (int t = 0; t < 16; ++t) {
            const bf16* rt = r0 + (size_t)t * UP; const bool last = (pos0 + t + 1 >= ck.L);
#pragma unroll
            for (int ar = 0; ar < 3; ++ar) nv[ar] = last ? 0u : *(const unsigned*)(rt + UP + ar * 512);
            const unsigned gw = *(const unsigned*)(rt + C_HG);
            float o[3][2];
#pragma unroll
            for (int ar = 0; ar < 3; ++ar) { o[ar][0] = w[ar][0][0] * bflo(pv[ar]) + w[ar][1][0] * bflo(cv[ar]) + w[ar][2][0] * bflo(nv[ar]) + bb[ar][0];
                o[ar][1] = w[ar][0][1] * bfhi(pv[ar]) + w[ar][1][1] * bfhi(cv[ar]) + w[ar][2][1] * bfhi(nv[ar]) + bb[ar][1]; pv[ar] = cv[ar]; cv[ar] = nv[ar]; }
            th[lane * 17 + t] = (f32x2){o[2][0] * o[1][0], o[2][1] * o[1][1]};
            tp[lane * 17 + t] = (f32x2){o[0][0] * silu(bflo(gw)), o[0][1] * silu(bfhi(gw))};
        }
        asm volatile("s_waitcnt lgkmcnt(0)" ::: "memory");
#pragma unroll 4
        for (int i = 0; i < 16; ++i) { const int pl = 4 * i + (lane >> 4), tt = lane & 15; const size_t o = (size_t)(cbk * 64 + pl) * CH + t0 + tt;
            HVP[o] = th[pl * 17 + tt]; PMP[o] = tp[pl * 17 + tt]; }
        asm volatile("s_waitcnt lgkmcnt(0)" ::: "memory");
    }
}
typedef short bf16x8 __attribute__((ext_vector_type(8)));
typedef short s16x4 __attribute__((ext_vector_type(4)));
typedef float f32x16 __attribute__((ext_vector_type(16)));
typedef float f32x2_t __attribute__((ext_vector_type(2)));
typedef __bf16 bf16x2_t __attribute__((ext_vector_type(2)));
__device__ __forceinline__ unsigned cvtpk(float lo, float hi) { f32x2_t v = {lo, hi}; bf16x2_t b = __builtin_convertvector(v, bf16x2_t); return __builtin_bit_cast(unsigned, b); }
__device__ __forceinline__ int crow(int r, int hi) { return (r & 3) + 8 * (r >> 2) + 4 * hi; }
__device__ __forceinline__ s16x4 vtr(const LAS unsigned char* p) { return __builtin_bit_cast(s16x4, __builtin_amdgcn_ds_read_tr16_b64_v4i16((LAS s16x4*)p)); }
constexpr int ATT_K = 0;
constexpr int ATT_TB_DIFF = 4 * 8192 + 4 * 16384;
constexpr float C1 = 0.125f * LOG2E;
__device__ __forceinline__ void glds16(const void* gsrc, unsigned lds_dst) { unsigned keep;
    asm volatile("s_mov_b32 %0, m0\n\ts_mov_b32 m0, %2\n\ts_nop 0\n\tglobal_load_lds_dwordx4 %1, off\n\ts_mov_b32 m0, %0" : "=&s"(keep) : "v"(gsrc), "s"(lds_dst) : "memory"); }

template <int VD, bool BIAS, bool OMAX, int G>
__device__ __forceinline__ void flash_pass(LAS unsigned char* lds, const bf16* Qrow, const bf16* Kg, const bf16* Vg, int L, int qpos, int qw0, float bl, float br, f32x16 (&o)[VD / 32], float& l_out) {
    const int tid = ltid(), lane = tid & 63, r32 = lane & 31, hi = lane >> 5;
    constexpr int VROW = VD * 2, VT = 64 * VROW, NVL = VD / 64, NSL = 2 * G, ATT_V = NSL * 8192, ATT_TB = ATT_V + NSL * VT;
    const LAS float* tb = (const LAS float*)(lds + ATT_TB);
    typedef const __attribute__((address_space(1))) u32x4* g4p;
    const int wv = __builtin_amdgcn_readfirstlane(tid >> 6); const int ldsa = (int)(unsigned)(uintptr_t)lds;
    const bf16* ksrc; { const int X = wv * 1024 + lane * 16, line = X >> 8, c16 = ((X >> 4) & 15) ^ (line & 15), key = 2 * line + (c16 >> 3), ch = c16 & 7; ksrc = Kg + (size_t)key * UP + ch * 8; }
    const bf16* vsrc[NVL];
#pragma unroll
    for (int i = 0; i < NVL; ++i) { const int X = i * 8192 + wv * 1024 + lane * 16; const int key = (VD == 64) ? (X >> 7) : (X >> 8), posb = (VD == 64) ? (X & 127) : (X & 255);
        const int swz = (VD == 64) ? (((key >> 1) & 1) << 6) : ((key & 3) << 6); vsrc[i] = Vg + (size_t)key * UP + ((posb ^ swz) >> 1); }
#define ATT_DMA(tt_, sl_) do { const size_t go_ = (size_t)(tt_) * 64 * UP; \
        glds16(ksrc + go_, (unsigned)__builtin_amdgcn_readfirstlane(ldsa + ATT_K + (sl_) * 8192 + wv * 1024)); \
        _Pragma("unroll") for (int i_ = 0; i_ < NVL; ++i_) glds16(vsrc[i_] + go_, (unsigned)__builtin_amdgcn_readfirstlane(ldsa + ATT_V + (sl_) * VT + i_ * 8192 + wv * 1024)); } while (0)
#define ATT_DMAGROUP(g_) do { _Pragma("unroll") for (int j_ = 0; j_ < G; ++j_) { const int tt_ = (g_) * G + j_; ATT_DMA(tt_, tt_ & (NSL - 1)); } } while (0)
#define ATT_BAR() do { __builtin_amdgcn_s_barrier(); asm volatile("" ::: "memory"); } while (0)
    int koff[2][4];
#pragma unroll
    for (int kb = 0; kb < 2; ++kb)
#pragma unroll
        for (int s = 0; s < 4; ++s) { const int key = 32 * kb + r32, line = key >> 1, c16 = ((key & 1) << 3) | (2 * s + hi); koff[kb][s] = line * 256 + ((c16 ^ (line & 15)) << 4); }
    const int q4 = (lane & 15) >> 2, p4 = lane & 3, g1 = (lane >> 4) & 1;
    const int vsw = (VD == 64) ? ((q4 >> 1) & 1) : q4;
    const int vbase = (4 * hi + q4) * VROW + 32 * g1 + 8 * p4;
    bf16x8 qf[4];
#pragma unroll
    for (int s = 0; s < 4; ++s) qf[s] = __builtin_bit_cast(bf16x8, *(g4p)(Qrow + 16 * s + 8 * hi));
    float m_run = OMAX ? -1e30f : 0.f, l_run = 0.f;
    const int nt = L >> 6;
    asm volatile("" :: "v"(qf[0]), "v"(qf[1]), "v"(qf[2]), "v"(qf[3]) : "memory");
    asm volatile("s_waitcnt vmcnt(0)" ::: "memory");
    const int ng = nt / G;
    ATT_DMAGROUP(0); if (ng > 1) ATT_DMAGROUP(1);
    if (ng > 1) { if (G * (1 + NVL) == 8) asm volatile("s_waitcnt vmcnt(8)" ::: "memory"); else asm volatile("s_waitcnt vmcnt(6)" ::: "memory"); } else asm volatile("s_waitcnt vmcnt(0)" ::: "memory");
    static_assert(G * (1 + NVL) == 8 || G * (1 + NVL) == 6, "vmcnt immediates above");
    ATT_BAR();
#pragma unroll 1
    for (int t = 0; t < nt; ++t) {
        const int cur = t & (NSL - 1);
        const LAS unsigned char* kbuf = lds + ATT_K + cur * 8192; const LAS unsigned char* vbuf = lds + ATT_V + cur * VT;
        f32x16 p[2];
        { bf16x8 kf[2][4];
#pragma unroll
          for (int kb = 0; kb < 2; ++kb)
#pragma unroll
            for (int s = 0; s < 4; ++s) kf[kb][s] = *(const LAS bf16x8*)(kbuf + koff[kb][s]);
          __builtin_amdgcn_sched_barrier(0);
#pragma unroll
          for (int kb = 0; kb < 2; ++kb) { f32x16 acc;
#pragma unroll
            for (int r = 0; r < 16; ++r) acc[r] = 0.f;
#pragma unroll
            for (int s = 0; s < 4; ++s) acc = __builtin_amdgcn_mfma_f32_32x32x16_bf16(kf[kb][s], qf[s], acc, 0, 0, 0);
            p[kb] = acc; } }
        s16x4 vlo[2][4], vhi[2][4];
#define VREAD(buf_, db_) do { const int cofs_ = (((db_) ^ vsw) << 6); _Pragma("unroll") for (int kb = 0; kb < 2; ++kb) _Pragma("unroll") for (int ss = 0; ss < 2; ++ss) { \
            const LAS unsigned char* vp_ = vbuf + vbase + (32 * kb + 16 * ss) * VROW + cofs_; vlo[buf_][2 * kb + ss] = vtr(vp_); vhi[buf_][2 * kb + ss] = vtr(vp_ + 8 * VROW); } } while (0)
        VREAD(0, 0);
        __builtin_amdgcn_sched_barrier(0);
        const int k0 = t * 64; float mulc, bconst, mx = -3e38f; bool nearT = false;
        const bool domax = (t & 7) == 0;
        if (BIAS) { const int rlo = k0 - qw0 - 31, rhi = k0 + 63 - qw0; nearT = !(rhi <= -128 || rlo >= 128); }
        if (BIAS && nearT) {
#pragma unroll
            for (int kb = 0; kb < 2; ++kb)
#pragma unroll
                for (int r4 = 0; r4 < 4; ++r4) {
#pragma unroll
                    for (int e = 0; e < 4; ++e) { const int r = 4 * r4 + e; int rel = k0 + 32 * kb + crow(r, hi) - qpos; rel = rel < -128 ? -128 : (rel > 128 ? 128 : rel); const float v = p[kb][r] * C1 + tb[rel + 128]; p[kb][r] = v; mx = fmaxf(mx, v); }
                    __builtin_amdgcn_sched_barrier(0); }
            mulc = 1.0f; bconst = 0.f;
        } else {
            if (OMAX && domax) {
#pragma unroll
                for (int kb = 0; kb < 2; ++kb)
#pragma unroll
                    for (int r = 0; r < 16; ++r) mx = fmaxf(mx, p[kb][r]); }
            bconst = BIAS ? (k0 < qw0 ? bl : br) : 0.f; mx = mx * C1 + bconst; mulc = C1;
        }
        if (OMAX && (domax || (BIAS && nearT))) {
            mx = fmaxf(mx, __shfl_xor(mx, 32));
            if (__any(mx > m_run)) { const float mn = fmaxf(m_run, mx), al = __builtin_amdgcn_exp2f(m_run - mn); l_run *= al;
#pragma unroll
                for (int db = 0; db < VD / 32; ++db) o[db] *= al;
                m_run = mn; }
        }
        const f32x2 mul2 = (f32x2){mulc, mulc}, add2 = (f32x2){bconst - m_run, bconst - m_run}; f32x2 ls2 = (f32x2){0.f, 0.f};
#pragma unroll
        for (int kb = 0; kb < 2; ++kb)
#pragma unroll
            for (int r = 0; r < 16; r += 2) { f32x2 v = (f32x2){p[kb][r], p[kb][r + 1]}; v = v * mul2 + add2; f32x2 e; e.x = __builtin_amdgcn_exp2f(v.x); e.y = __builtin_amdgcn_exp2f(v.y); ls2 += e; p[kb][r] = e.x; p[kb][r + 1] = e.y; }
        l_run += ls2.x + ls2.y;
        bf16x8 pk[2][2];
#pragma unroll
        for (int kb = 0; kb < 2; ++kb)
#pragma unroll
            for (int ss = 0; ss < 2; ++ss) { u32x4 w; w.x = cvtpk(p[kb][8 * ss + 0], p[kb][8 * ss + 1]); w.y = cvtpk(p[kb][8 * ss + 2], p[kb][8 * ss + 3]); w.z = cvtpk(p[kb][8 * ss + 4], p[kb][8 * ss + 5]); w.w = cvtpk(p[kb][8 * ss + 6], p[kb][8 * ss + 7]);
                pk[kb][ss] = __builtin_bit_cast(bf16x8, w); }
        __builtin_amdgcn_sched_barrier(0);
#pragma unroll
        for (int db = 0; db < VD / 32; ++db) {
            if (db + 1 < VD / 32) { if ((db + 1) & 1) VREAD(1, db + 1); else VREAD(0, db + 1); }
#pragma unroll
            for (int kb = 0; kb < 2; ++kb)
#pragma unroll
                for (int ss = 0; ss < 2; ++ss) { const bf16x8 vf = (db & 1) ? __builtin_shufflevector(vlo[1][2 * kb + ss], vhi[1][2 * kb + ss], 0, 1, 2, 3, 4, 5, 6, 7) : __builtin_shufflevector(vlo[0][2 * kb + ss], vhi[0][2 * kb + ss], 0, 1, 2, 3, 4, 5, 6, 7);
                    o[db] = __builtin_amdgcn_mfma_f32_32x32x16_bf16(vf, pk[kb][ss], o[db], 0, 0, 0); }
            __builtin_amdgcn_sched_barrier(0); }
#undef VREAD
        if (((t + 1) & (G - 1)) == 0) {
            asm volatile("s_waitcnt vmcnt(0)" ::: "memory"); ATT_BAR();
            const int g2 = (t + 1) / G + 1; if (g2 < ng) ATT_DMAGROUP(g2); }
    }
#undef ATT_DMA
#undef ATT_DMAGROUP
#undef ATT_BAR
    l_out = l_run + __shfl_xor(l_run, 32);
}
__device__ __forceinline__ void gqa_unit(const AV& a, LAS unsigned char* lds, int seqrow0, int L, int h, int qb) {
    const int tid = ltid(), lane = tid & 63, r32 = lane & 31, hi = lane >> 5;
    const bf16* U = (const bf16*)(AWS + WS_U); bf16* Y = (bf16*)(AWS + WS_Y) + (size_t)1 * CH * 512;
    constexpr int G = 4, NSL = 2 * G, VROW = 128, VT = 8192, ATT_V = NSL * 8192;
    typedef const __attribute__((address_space(1))) u32x4* g4p;
    const int wv = __builtin_amdgcn_readfirstlane(tid >> 6); const int ldsa = (int)(unsigned)(uintptr_t)lds;
    const int qw0 = qb * 512 + wv * 64;
    const bf16* Kg = U + (size_t)seqrow0 * UP + C_GK + 64 * (h >> 2); const bf16* Vg = U + (size_t)seqrow0 * UP + C_GV + 64 * (h >> 2);
    const bf16* ksrc; { const int X = wv * 1024 + lane * 16, line = X >> 8, c16 = ((X >> 4) & 15) ^ (line & 15), key = 2 * line + (c16 >> 3), ch = c16 & 7; ksrc = Kg + (size_t)key * UP + ch * 8; }
    const bf16* vsrc; { const int X = wv * 1024 + lane * 16, key = X >> 7, posb = X & 127, swz = ((key >> 1) & 1) << 6; vsrc = Vg + (size_t)key * UP + ((posb ^ swz) >> 1); }
#define GQ_DMA(tt_, sl_) do { const size_t go_ = (size_t)(tt_) * 64 * UP; \
        glds16(ksrc + go_, (unsigned)__builtin_amdgcn_readfirstlane(ldsa + ATT_K + (sl_) * 8192 + wv * 1024)); \
        glds16(vsrc + go_, (unsigned)__builtin_amdgcn_readfirstlane(ldsa + ATT_V + (sl_) * VT + wv * 1024)); } while (0)
#define GQ_DMAGROUP(g_) do { _Pragma("unroll") for (int j_ = 0; j_ < G; ++j_) { const int tt_ = (g_) * G + j_; GQ_DMA(tt_, tt_ & (NSL - 1)); } } while (0)
#define GQ_BAR() do { __builtin_amdgcn_s_barrier(); asm volatile("" ::: "memory"); } while (0)
    int koff[2][4];
#pragma unroll
    for (int kb = 0; kb < 2; ++kb)
#pragma unroll
        for (int s = 0; s < 4; ++s) { const int key = 32 * kb + r32, line = key >> 1, c16 = ((key & 1) << 3) | (2 * s + hi); koff[kb][s] = line * 256 + ((c16 ^ (line & 15)) << 4); }
    const int q4 = (lane & 15) >> 2, p4 = lane & 3, g1 = (lane >> 4) & 1;
    const int vsw = (q4 >> 1) & 1;
    const int vbase = (4 * hi + q4) * VROW + 32 * g1 + 8 * p4;
    bf16x8 qf[2][4];
#pragma unroll
    for (int j = 0; j < 2; ++j)
#pragma unroll
        for (int s = 0; s < 4; ++s) qf[j][s] = __builtin_bit_cast(bf16x8, *(g4p)(U + (size_t)(seqrow0 + qw0 + 32 * j + r32) * UP + C_GQ + 64 * h + 16 * s + 8 * hi));
    f32x16 o[2][2];
#pragma unroll
    for (int j = 0; j < 2; ++j)
#pragma unroll
        for (int db = 0; db < 2; ++db)
#pragma unroll
            for (int r = 0; r < 16; ++r) o[j][db][r] = 0.f;
    float lrun[2] = {0.f, 0.f};
    const int nt = L >> 6, ng = nt / G;
    asm volatile("" :: "v"(qf[0][0]), "v"(qf[0][1]), "v"(qf[0][2]), "v"(qf[0][3]), "v"(qf[1][0]), "v"(qf[1][1]), "v"(qf[1][2]), "v"(qf[1][3]) : "memory");
    asm volatile("s_waitcnt vmcnt(0)" ::: "memory");
    GQ_DMAGROUP(0); if (ng > 1) GQ_DMAGROUP(1);
    if (ng > 1) asm volatile("s_waitcnt vmcnt(8)" ::: "memory"); else asm volatile("s_waitcnt vmcnt(0)" ::: "memory");
    GQ_BAR();
#pragma unroll 1
    for (int t = 0; t < nt; ++t) {
        const int cur = t & (NSL - 1);
        const LAS unsigned char* kbuf = lds + ATT_K + cur * 8192; const LAS unsigned char* vbuf = lds + ATT_V + cur * VT;
        f32x16 p[2][2];
        { bf16x8 kf[2][4];
#pragma unroll
          for (int kb = 0; kb < 2; ++kb)
#pragma unroll
            for (int s = 0; s < 4; ++s) kf[kb][s] = *(const LAS bf16x8*)(kbuf + koff[kb][s]);
          __builtin_amdgcn_sched_barrier(0);
#pragma unroll
          for (int kb = 0; kb < 2; ++kb)
#pragma unroll
            for (int j = 0; j < 2; ++j) { f32x16 acc;
#pragma unroll
              for (int r = 0; r < 16; ++r) acc[r] = 0.f;
#pragma unroll
              for (int s = 0; s < 4; ++s) acc = __builtin_amdgcn_mfma_f32_32x32x16_bf16(kf[kb][s], qf[j][s], acc, 0, 0, 0);
              p[j][kb] = acc; } }
        s16x4 vlo[2][4], vhi[2][4];
#define GQ_VREAD(buf_, db_) do { const int cofs_ = (((db_) ^ vsw) << 6); _Pragma("unroll") for (int kb = 0; kb < 2; ++kb) _Pragma("unroll") for (int ss = 0; ss < 2; ++ss) { \
            const LAS unsigned char* vp_ = vbuf + vbase + (32 * kb + 16 * ss) * VROW + cofs_; vlo[buf_][2 * kb + ss] = vtr(vp_); vhi[buf_][2 * kb + ss] = vtr(vp_ + 8 * VROW); } } while (0)
        bf16x8 pk[2][2][2];
#pragma unroll
        for (int j = 0; j < 2; ++j) { float ls0 = 0.f, ls1 = 0.f;
#pragma unroll
            for (int kb = 0; kb < 2; ++kb) {
#pragma unroll
                for (int r = 0; r < 16; r += 2) { const float e0 = __builtin_amdgcn_exp2f(p[j][kb][r]), e1 = __builtin_amdgcn_exp2f(p[j][kb][r + 1]); ls0 += e0; ls1 += e1; p[j][kb][r] = e0; p[j][kb][r + 1] = e1; }
#pragma unroll
                for (int ss = 0; ss < 2; ++ss) { u32x4 w; w.x = cvtpk(p[j][kb][8 * ss + 0], p[j][kb][8 * ss + 1]); w.y = cvtpk(p[j][kb][8 * ss + 2], p[j][kb][8 * ss + 3]); w.z = cvtpk(p[j][kb][8 * ss + 4], p[j][kb][8 * ss + 5]); w.w = cvtpk(p[j][kb][8 * ss + 6], p[j][kb][8 * ss + 7]);
                    pk[j][kb][ss] = __builtin_bit_cast(bf16x8, w); } }
            lrun[j] += ls0 + ls1; }
        __builtin_amdgcn_sched_barrier(0);
        GQ_VREAD(0, 0); GQ_VREAD(1, 1);
#pragma unroll
        for (int db = 0; db < 2; ++db) {
#pragma unroll
            for (int kb = 0; kb < 2; ++kb)
#pragma unroll
                for (int ss = 0; ss < 2; ++ss) { const bf16x8 vf = db ? __builtin_shufflevector(vlo[1][2 * kb + ss], vhi[1][2 * kb + ss], 0, 1, 2, 3, 4, 5, 6, 7) : __builtin_shufflevector(vlo[0][2 * kb + ss], vhi[0][2 * kb + ss], 0, 1, 2, 3, 4, 5, 6, 7);
#pragma unroll
                    for (int j = 0; j < 2; ++j) o[j][db] = __builtin_amdgcn_mfma_f32_32x32x16_bf16(vf, pk[j][kb][ss], o[j][db], 0, 0, 0); }
            __builtin_amdgcn_sched_barrier(0); }
#undef GQ_VREAD
        if (((t + 1) & (G - 1)) == 0) { asm volatile("s_waitcnt vmcnt(0)" ::: "memory"); GQ_BAR(); const int g2 = (t + 1) / G + 1; if (g2 < ng) GQ_DMAGROUP(g2); }
    }
#undef GQ_DMA
#undef GQ_DMAGROUP
#undef GQ_BAR
#pragma unroll
    for (int j = 0; j < 2; ++j) { const float l = lrun[j] + __shfl_xor(lrun[j], 32); const float inv = 1.0f / l; const size_t row = (size_t)(seqrow0 + qw0 + 32 * j + r32);
#pragma unroll
        for (int db = 0; db < 2; ++db)
#pragma unroll
            for (int g = 0; g < 4; ++g) { const int d = 32 * db + 8 * g + 4 * hi; const u32x2 gw = *(const u32x2*)(U + row * UP + C_GG + 64 * h + d);
                const float y0 = o[j][db][4 * g] * inv * silu(bflo(gw.x)), y1 = o[j][db][4 * g + 1] * inv * silu(bfhi(gw.x)), y2 = o[j][db][4 * g + 2] * inv * silu(bflo(gw.y)), y3 = o[j][db][4 * g + 3] * inv * silu(bfhi(gw.y));
                u32x2 w; w.x = cvtpk(y0, y1); w.y = cvtpk(y2, y3); *(u32x2*)(Y + row * 512 + 64 * h + d) = w; } }
}
__device__ __forceinline__ void diff_unit(const AV& a, LAS unsigned char* lds, int seqrow0, int L, int h, int qb, int layer) {
    const int tid = ltid(), lane = tid & 63, wave = tid >> 6, r32 = lane & 31, hi = lane >> 5;
    const bf16* U = (const bf16*)(AWS + WS_U); bf16* Y = (bf16*)(AWS + WS_Y) + (size_t)2 * CH * 512; float* DT = (float*)(AWS + WS_DT);
    const float* relb = AIN(I_RELB);
    LAS float* tb = (LAS float*)(lds + ATT_TB_DIFF);
    for (int i = tid; i < 257; i += NT) { const int rel = i - 128, n = rel < 0 ? -rel : rel; int b = rel > 0 ? 16 : 0;
        if (n < 8) b += n; else { const int v = 8 + (31 - __builtin_clz((unsigned)(n * n))) - 6; b += v < 15 ? v : 15; }
        tb[i] = relb[b * 4 + h] * LOG2E; }
    const float bl = relb[15 * 4 + h] * LOG2E, br = relb[31 * 4 + h] * LOG2E;
    const float li = 0.8f - 0.6f * __expf(-0.3f * (float)layer);
    float d1, d2; { const float q1 = AIN(I_LQ1)[layer * 64 + lane], k1 = AIN(I_LK1)[layer * 64 + lane], q2 = AIN(I_LQ2)[layer * 64 + lane], k2 = AIN(I_LK2)[layer * 64 + lane]; d1 = wave_sum(q1 * k1); d2 = wave_sum(q2 * k2); }
    const float lam = __expf(d1) - __expf(d2) + li;
    const int qw0 = qb * 256 + wave * 32, qpos = qw0 + r32; const size_t row = (size_t)(seqrow0 + qpos);
    __syncthreads();
    f32x16 o[4]; float l; float ss = 0.f;
#pragma unroll 1
    for (int c = 0; c < 2; ++c) {
#pragma unroll
        for (int db = 0; db < 4; ++db)
#pragma unroll
            for (int r = 0; r < 16; ++r) o[db][r] = 0.f;
        flash_pass<128, true, true, 2>(lds, U + row * UP + C_DQ + 128 * h + 64 * c, U + (size_t)seqrow0 * UP + C_DK + 128 * h + 64 * c, U + (size_t)seqrow0 * UP + C_DV + 128 * h, L, qpos, qw0, bl, br, o, l);
        if (c == 0) { const float inv = 1.0f / l;
#pragma unroll
            for (int db = 0; db < 4; ++db)
#pragma unroll
                for (int g = 0; g < 4; ++g) { const int d = 32 * db + 8 * g + 4 * hi; *(f32x4*)(DT + row * 512 + 128 * h + d) = (f32x4){o[db][4 * g] * inv, o[db][4 * g + 1] * inv, o[db][4 * g + 2] * inv, o[db][4 * g + 3] * inv}; }
        } else { const float inv = lam / l;
#pragma unroll
            for (int db = 0; db < 4; ++db)
#pragma unroll
                for (int g = 0; g < 4; ++g) { const int d = 32 * db + 8 * g + 4 * hi; const f32x4 o0 = *(const f32x4*)(DT + row * 512 + 128 * h + d);
#pragma unroll
                    for (int e = 0; e < 4; ++e) { const float v = o0[e] - o[db][4 * g + e] * inv; o[db][4 * g + e] = v; ss += v * v; } }
        }
    }
    ss += __shfl_xor(ss, 32);
    const float rs = (1.0f / sqrtf(ss * (1.0f / 128.0f) + EPS)) * (1.0f - li);
    const float* sg = AIN(I_SUBLN) + layer * 128;
#pragma unroll
    for (int db = 0; db < 4; ++db)
#pragma unroll
        for (int g = 0; g < 4; ++g) { const int d = 32 * db + 8 * g + 4 * hi; const u32x2 gw = *(const u32x2*)(U + row * UP + C_DG + 128 * h + d); const f32x4 gn = *(const f32x4*)(sg + d);
            const float y0 = o[db][4 * g] * rs * gn.x * silu(bflo(gw.x)), y1 = o[db][4 * g + 1] * rs * gn.y * silu(bfhi(gw.x)), y2 = o[db][4 * g + 2] * rs * gn.z * silu(bflo(gw.y)), y3 = o[db][4 * g + 3] * rs * gn.w * silu(bfhi(gw.y));
            u32x2 w; w.x = cvtpk(y0, y1); w.y = cvtpk(y2, y3); *(u32x2*)(Y + row * 512 + 128 * h + d) = w; }
}
template <int LOG4, int BATCH> __device__ __forceinline__ void hyena_unit(const AV& a, LAS unsigned char* lds, int seqrow0, int pr0, int layer) {
    constexpr int N = 1 << (2 * LOG4), L = N / 2, NPAD = N + N / 16;
    const int tid = ltid(); LAS f32x2* buf = (LAS f32x2*)lds;
    bf16* Y = (bf16*)(AWS + WS_Y) + (size_t)seqrow0 * 512;
    const unsigned char* sp = AWS + WS_SPEC + layer * SPEC_LAYER;
    constexpr int SPS = (LOG4 == 7) ? SPS_P : SPS_S;
    const f32x2* Pg = ((LOG4 == 7) ? (const f32x2*)sp : (const f32x2*)(sp + 2 * SPEC_P_BYTES)) + (size_t)pr0 * SPS;
    const f32x2* Mg = ((LOG4 == 7) ? (const f32x2*)(sp + SPEC_P_BYTES) : (const f32x2*)(sp + 2 * SPEC_P_BYTES + SPEC_S_BYTES)) + (size_t)pr0 * SPS;
    const f32x2* hvp = (const f32x2*)(AWS + WS_HVP) + (size_t)pr0 * CH + seqrow0; const f32x2* pmp = (const f32x2*)(AWS + WS_PMP) + (size_t)pr0 * CH + seqrow0;
#pragma unroll
    for (int b = 0; b < BATCH; ++b)
        for (int t = tid; t < L; t += NT) { buf[b * NPAD + PADI(t)] = hvp[(size_t)b * CH + t]; buf[b * NPAD + PADI(t + L)] = (f32x2){0.f, 0.f}; }
    __syncthreads();
    const f32x2* tw = (const f32x2*)(AWS + WS_TW);
    fft_fwd<LOG4, BATCH>(buf, tw, tid);
#pragma unroll
    for (int b = 0; b < BATCH; ++b)
        for (int k = tid; k <= L; k += NT) { const int p1 = b * NPAD + PADI(digitrev<LOG4>(k)), p2 = b * NPAD + PADI(digitrev<LOG4>((N - k) & (N - 1))); const f32x2 z1 = buf[p1], z2 = buf[p2], P = Pg[(size_t)b * SPS + k], M = Mg[(size_t)b * SPS + k];
            const f32x2 y1 = cmul(z1, P) + cmul(cconj(z2), M), y2 = cmulc(z2, P) + cmulc(cconj(z1), M);
            buf[p1] = y1; if (p2 != p1) buf[p2] = y2; }
    __syncthreads();
    fft_inv<LOG4, BATCH>(buf, tw, tid);
    for (int t = tid; t < L; t += NT) { unsigned w[BATCH];
#pragma unroll
        for (int b = 0; b < BATCH; ++b) { const f32x2 y = buf[b * NPAD + PADI(t)], m = pmp[(size_t)b * CH + t]; w[b] = cvtpk(y.x * m.x, y.y * m.y); }
        if (BATCH == 4) *(u32x4*)(Y + (size_t)t * 512 + 2 * pr0) = (u32x4){w[0], w[BATCH > 1 ? 1 : 0], w[BATCH > 2 ? 2 : 0], w[BATCH > 3 ? 3 : 0]};
        else *(unsigned*)(Y + (size_t)t * 512 + 2 * pr0) = w[0]; }
    __syncthreads();
}
#define XB_TMO      128
#define XB_XCNT(j)  (256  + 64 * (j))
#define XB_XSUB(j)  (1280 + 64 * (j))
#define XB_XGEN(j)  (2304 + 64 * (j))
#define XB_TOP      3328
#define XB_TOPGEN   3392
#define XCD_BAR_WORDS 3456
#define XB_SPIN_CAP (1u << 18)

__device__ __forceinline__ unsigned xb_ld(unsigned* p)              { return __hip_atomic_load(p, __ATOMIC_RELAXED, __HIP_MEMORY_SCOPE_AGENT); }
__device__ __forceinline__ unsigned xb_add(unsigned* p, unsigned v) { return __hip_atomic_fetch_add(p, v, __ATOMIC_RELAXED, __HIP_MEMORY_SCOPE_AGENT); }
__device__ __forceinline__ unsigned xb_xcc_id() { return (unsigned)__builtin_amdgcn_s_getreg((3 << 11) | 20) & 0xFu; }
#define XB_SPIN(cond, bar) do { unsigned _sp = 0; while (cond) { __builtin_amdgcn_s_sleep(1); \
    if ((++_sp & 255u) == 0u) { if (xb_ld(&(bar)[XB_TMO])) break; if (_sp > XB_SPIN_CAP) { atomicAdd(&(bar)[XB_TMO], 1u); break; } } } } while (0)

struct XcdBarrier {
    unsigned* bar; unsigned x;
    volatile LAS unsigned* st;
};

__device__ __forceinline__ XcdBarrier xcd_barrier_post(unsigned* bar, volatile LAS unsigned* st) {
    XcdBarrier b; b.bar = bar; b.x = xb_xcc_id(); b.st = st;
    if (threadIdx.x == 0) (void)xb_add(&bar[XB_XCNT(b.x)], 1u);
    return b;
}
__device__ __forceinline__ void xcd_barrier_complete(unsigned* bar, unsigned x, unsigned& nloc, unsigned& nx) {
    const unsigned G = gridDim.x * gridDim.y * gridDim.z;
    unsigned sum, cnt, mine, sp = 0u;
    for (;;) {
        sum = 0u; cnt = 0u; mine = 0u;
#pragma unroll
        for (unsigned j = 0; j < 16; ++j) { const unsigned c = xb_ld(&bar[XB_XCNT(j)]); sum += c; cnt += (c > 0u) ? 1u : 0u; mine = (j == x) ? c : mine; }
        if (sum == G) break;
        __builtin_amdgcn_s_sleep(1);
        if ((++sp & 255u) == 0u) { if (xb_ld(&bar[XB_TMO])) break; if (sp > XB_SPIN_CAP) { atomicAdd(&bar[XB_TMO], 1u); break; } }
    }
    nloc = mine > 0u ? mine : 1u; nx = cnt > 0u ? cnt : 1u;
}

__device__ __forceinline__ void xcd_barrier(const XcdBarrier& b) {
    asm volatile("s_waitcnt vmcnt(0)" ::: "memory");
    __syncthreads();
    if (threadIdx.x == 0) {
        unsigned* bar = b.bar;
        __builtin_amdgcn_s_waitcnt(0);
        unsigned nloc = b.st[0], nx = b.st[1];
        if (nloc == 0u) { xcd_barrier_complete(bar, b.x, nloc, nx); b.st[0] = nloc; b.st[1] = nx; }
        const unsigned old = xb_add(&bar[XB_XSUB(b.x)], 1u);
        const unsigned gen = old / nloc;
        if (old + 1u == (gen + 1u) * nloc) {
            __builtin_amdgcn_fence(__ATOMIC_RELEASE, "agent");
            asm volatile("s_waitcnt vmcnt(0)" ::: "memory");
            const unsigned og = xb_add(&bar[XB_TOP], 1u);
            const unsigned tg = og / nx;
            if (og + 1u == (tg + 1u) * nx) xb_add(&bar[XB_TOPGEN], 1u);
            else XB_SPIN(xb_ld(&bar[XB_TOPGEN]) == tg, bar);
            __builtin_amdgcn_fence(__ATOMIC_ACQUIRE, "agent");
            xb_add(&bar[XB_XGEN(b.x)], 1u);
            asm volatile("s_waitcnt vmcnt(0)" ::: "memory");
        } else {
            XB_SPIN(xb_ld(&bar[XB_XGEN(b.x)]) == gen, bar);
            __builtin_amdgcn_fence(__ATOMIC_ACQUIRE, "agent");
            asm volatile("s_waitcnt vmcnt(0)" ::: "memory");
        }
    }
    __syncthreads();
}

__device__ __forceinline__ void step_mix(const AV& a, LAS unsigned char* lds, int c, int layer, unsigned* ctr, int tmask) {
    const Chunk ck = chunk_of(c); const int nqb = ck.L / 256, nqg = ck.L / 512, nD = ck.nseq * 4 * nqb, nG = ck.nseq * 8 * nqg, nF = (ck.L == LP) ? ck.nseq * 256 : ck.nseq * 64, total = nD + nG + nF;
    volatile LAS unsigned* wq = (volatile LAS unsigned*)(lds + LDS_MAIN);
    for (;;) {
        if (ltid() == 0) wq[0] = atomicAdd(ctr, 1u);
        __syncthreads();
        const int u = (int)wq[0];
        __syncthreads();
        if (u >= total) break;
        if (u < nD) { if (tmask & 1) { const int qb = u % nqb, sh = u / nqb, h = sh & 3, s = sh >> 2; diff_unit(a, lds, s * ck.L, ck.L, h, qb, layer); } }
        else if (u < nD + nG) { if (tmask & 2) { const int v = u - nD, qb = v % nqg, sh = v / nqg, h = sh & 7, s = sh >> 3; gqa_unit(a, lds, s * ck.L, ck.L, h, qb); } }
        else { if (tmask & 4) { const int v = u - nD - nG; if (ck.L == LP) hyena_unit<7, 1>(a, lds, (v >> 8) * LP, v & 255, layer); else hyena_unit<6, 4>(a, lds, (v >> 6) * LS, (v & 63) * 4, layer); } }
    }
}
constexpr int STEPS_PER = 6, NPRO = 3, NSTEPS = NPRO + NCHUNK * 2 * STEPS_PER + 1;
__global__ void __launch_bounds__(NT, 2) mega_fwd(Args kargs) {
    extern __shared__ __attribute__((aligned(16))) unsigned char lds_raw[];
    LAS unsigned char* lds = (LAS unsigned char*)lds_raw;
    cg::grid_group grid = cg::this_grid();
    kargp_t kp = (kargp_t)__builtin_amdgcn_kernarg_segment_ptr();
    { volatile LAS unsigned* misc = (volatile LAS unsigned*)(lds + LDS_MAIN + 64); if (ltid() < 16) misc[ltid()] = 0u; }
    __syncthreads();
    XcdBarrier xbar = xcd_barrier_post((unsigned*)(kargs.ws + WS_CTL) + CW_BAR, (volatile LAS unsigned*)(lds + LDS_MAIN + 64 + 32));
    const int step_lo = kargs.lo, step_hi = kargs.hi;
#pragma unroll 1
    for (int step = step_lo; step < step_hi; ++step) {
        asm volatile("" : "+s"(kp));
        AV a; a.p = kp; unsigned char* ws = AWS;
        if (step == 0) { if (EN(0)) step_pro_a(a, lds); }
        else if (step == 1) { if (EN(11)) { step_pro_a2(a, lds); if (DUP_MASK & 32) { xcd_barrier(xbar); step_pro_a2(a, lds); } } }
        else if (step == 2) { if (EN(1)) { step_pro_b(a, lds); if (DUP_MASK & 64) { xcd_barrier(xbar); step_pro_b(a, lds); } } }
        else if (step == NSTEPS - 1) { if (DUP_MASK & 256) { for (int q = 0; q < 100; ++q) xcd_barrier(xbar); } if (EN(2)) step_final(a); }
        else {
            const int s2 = step - NPRO, cl = s2 / STEPS_PER, k = s2 - cl * STEPS_PER, c = cl >> 1, layer = cl & 1;
            const Chunk ck = chunk_of(c);
            if (k == 0) { if (layer == 0) continue;
                if (EN(3)) { step_norm(a, c, layer); if (DUP_MASK & 128) { xcd_barrier(xbar); step_norm(a, c, layer); } } }
            else if (k == 2) { if (EN(5)) { step_prep(a, c, layer); step_prep_hy(a, lds, c, layer); } }
            else if (k == 3) {
#pragma unroll 1
                for (int rep = 0; rep < ((DUP_MASK & 7) ? 2 : 1); ++rep) { if (rep) xcd_barrier(xbar); step_mix(a, lds, c, layer, (unsigned*)(ws + WS_CTL) + step * 16 + 4 * rep, rep ? (DUP_MASK & 7) : 7); } }
            else { if (EN(4)) {
                pg8::Gemm g; pg8::OrderAll S; pg8::EpiAll E; const int G = (int)gridDim.x, bid = lbid();
                S.so.init(CH, k == 1 ? NCAT : 1024, G, bid); S.o2 = pg8::OrderG2{CH / 256, G, bid}; S.mode = (k == 4) ? 2 : 1;
                float* O = AOUT + (size_t)ck.tok0 * DM; const float* X = layer == 0 ? xin_rows(a, ck.tok0) : O;
                E.mode = (k == 1) ? 1 : (k == 4) ? 2 : 3;
                E.e1 = pg8::EpiG1{(pg8::bf16_t*)(ws + WS_U), (pg8::bf16_t*)(ws + WS_G), AIN(I_BMERGE) + layer * GP};
                E.e2 = pg8::EpiG2{(const pg8::bf16_t*)(ws + WS_G), (float*)(ws + WS_TMP), (pg8::bf16_t*)(ws + WS_MG), CH / 256};
                E.e3 = pg8::EpiG3{X, O};
                if (k == 1) g = pg8::Gemm{layer == 0 ? (const pg8::bf16_t*)(ws + WS_HN0) + (size_t)ck.tok0 * DM : (const pg8::bf16_t*)(ws + WS_HN), (const pg8::bf16_t*)(ws + WS_WCAT + layer * WCAT_BYTES), CH, NCAT, 1024};
                else if (k == 4) g = pg8::Gemm{(const pg8::bf16_t*)(ws + WS_Y), (const pg8::bf16_t*)(ws + WS_WBT + layer * WBT_BYTES), 3 * CH, 3072, 512};
                else g = pg8::Gemm{(const pg8::bf16_t*)(ws + WS_MG), (const pg8::bf16_t*)(ws + WS_WOT + layer * WOT_BYTES), CH, 1024, 1024};
                const int nrep = (((DUP_MASK & 8) && k == 1) || ((DUP_MASK & 16) && k == 4)) ? 2 : 1;
#pragma unroll 1
                for (int rep = 0; rep < nrep; ++rep) { if (rep) xcd_barrier(xbar); pg8::gemm_phase<pg8::EpiAll, pg8::OrderAll, true, true>(lds, g, S, E); }
            } }
        }
        if (step + 1 < step_hi) { if (step == 0) grid.sync(); else xcd_barrier(xbar); }
    }
}
#ifndef MK_MULTI
#define MK_MULTI 0
#endif
extern "C" void kernel_launch(void* const* d_in, const int* in_sizes, int n_in, void* d_out, int out_size, void* d_ws, size_t ws_size, hipStream_t stream) {
    static int grid = 0;
    if (grid == 0) {
        if (n_in != N_IN || out_size != NTOK * DM || ws_size < WS_END) { fprintf(stderr, "kernel_launch: unexpected shapes (n_in %d, out %d, ws %zu)\n", n_in, out_size, ws_size); grid = -1; return; }
        int dev = 0, cus = 0, per_cu = 0;
        hipGetDevice(&dev); hipDeviceGetAttribute(&cus, hipDeviceAttributeMultiprocessorCount, dev);
        if (hipFuncSetAttribute((const void*)mega_fwd, hipFuncAttributeMaxDynamicSharedMemorySize, LDS_BYTES) != hipSuccess) { fprintf(stderr, "kernel_launch: hipFuncSetAttribute failed\n"); grid = -1; return; }
        hipOccupancyMaxActiveBlocksPerMultiprocessor(&per_cu, (const void*)mega_fwd, NT, LDS_BYTES);
        (void)hipGetLastError();
        if (per_cu < 1) per_cu = 1;
        grid = cus * 1;
        fprintf(stderr, "kernel_launch: cus %d per_cu %d grid %d\n", cus, per_cu, grid);
    }
    if (grid < 0) return;
    hipMemsetAsync((char*)d_ws + WS_CTL, 0, CTL_BYTES, stream);
    Args a{};
    for (int i = 0; i < N_IN; ++i) a.in[i] = (const float*)d_in[i];
    a.out = (float*)d_out; a.ws = (unsigned char*)d_ws;
#if MK_MULTI
    for (int s = 0; s < NSTEPS; ++s) { a.lo = s; a.hi = s + 1; hipLaunchKernelGGL(mega_fwd, dim3(grid), dim3(NT), LDS_BYTES, stream, a); }
#else
    a.lo = 0; a.hi = NSTEPS;
    void* args[] = {&a};
    hipError_t e = hipLaunchCooperativeKernel((const void*)mega_fwd, dim3(grid), dim3(NT), args, LDS_BYTES, stream);
    if (e != hipSuccess) fprintf(stderr, "cooperative launch failed: %s (grid %d)\n", hipGetErrorString(e), grid);
#endif
}
```

```cpp
#include <hip/hip_runtime.h>
#include <hip/hip_cooperative_groups.h>
#include <cstdio>
#include <cstdint>
namespace cg = cooperative_groups;
__device__ __forceinline__ int ltid() { int t = (int)threadIdx.x; asm volatile("" : "+v"(t)); return t; }
__device__ __forceinline__ int lbid() { int b = (int)blockIdx.x; asm volatile("" : "+s"(b)); return b; }
namespace pg8 {
#define PG8_LAS __attribute__((address_space(3)))
typedef unsigned short bf16_t;
typedef short bf16x8 __attribute__((ext_vector_type(8)));
typedef float f32x4 __attribute__((ext_vector_type(4)));
typedef unsigned u32x4 __attribute__((ext_vector_type(4)));
constexpr int BM = 256, BK = 64, HALF = 128, HTB = HALF * BK * 2  , STAGE_BYTES = 8 * HTB, NXCD = 8, WGM = 8;

__host__ __device__ __forceinline__ int lds_byte(int r, int c) { const int st = (r >> 4) * 2 + (c >> 5), rr = r & 15, cc = c & 31, ob = rr * 64 + cc * 2; return st * 1024 + (ob ^ (((ob >> 9) & 1) << 5)); }
__host__ __device__ __forceinline__ void stage_rc(int b, int& R, int& C) { const int st = b / 1024, sb = b % 1024, swz = sb ^ (((sb >> 9) & 1) << 5); R = (st >> 1) * 16 + swz / 64; C = (st & 1) * 32 + (swz % 64) / 2; }
__host__ __device__ __forceinline__ int perm32(int rho) { const int n = rho >> 4, i = rho & 15; return 8 * (i >> 2) + 4 * n + (i & 3); }

struct Unit { int pm, pn; };
struct Gemm { const bf16_t* A; const bf16_t* Bt; int M, N, K; };

struct StaticOrder {
    int nM, nN, nwg, G, c;
    __host__ __device__ void init(int M, int N, int G_, int c_) { nM = M / BM; nN = N / BM; nwg = nM * nN; G = G_; c = c_; }
    __host__ __device__ bool next(int i, Unit& u) const {
        const long L = (long)i * G + c; if (L >= nwg) return false;
        int wgid = (int)L; { const int q = nwg / NXCD, r = nwg % NXCD, xcd = wgid % NXCD, off = wgid / NXCD; wgid = (xcd < r ? xcd * (q + 1) : r * (q + 1) + (xcd - r) * q) + off; }
        const int nig = WGM * nN, gid = wgid / nig, fm = gid * WGM, gsz = (nM - fm) < WGM ? (nM - fm) : WGM;
        u.pm = fm + ((wgid % nig) % gsz); u.pn = (wgid % nig) / gsz; return true;
    }
    __device__ __forceinline__ void a_ready(const Unit&) const {}
    __device__ __forceinline__ void done(const Unit&) const {}
};

__device__ __forceinline__ unsigned cvt_pk_bf16(float lo, float hi) { unsigned r; asm volatile("v_cvt_pk_bf16_f32 %0, %1, %2" : "=v"(r) : "v"(lo), "v"(hi)); return r; }
template <class Epi, class Sched, bool ALIGN_EPI = false, bool SP2 = false>
__device__ __forceinline__ void gemm_phase(PG8_LAS unsigned char* lds, const Gemm g, const Sched& S, const Epi& E) {
    const int tid = ltid(), wid = __builtin_amdgcn_readfirstlane(tid >> 6), lane = tid & 63, wr = wid >> 2, wc = wid & 3, fr = lane & 15, fq = lane >> 4;
    const int K = g.K, nt = K / BK;
    unsigned voffA[2], voffB[2];
#pragma unroll
    for (int i = 0; i < 2; ++i) { int R, C; stage_rc(tid * 16 + i * 8192, R, C); const int Rb = Epi::PERM ? ((R & ~31) + perm32(R & 31)) : R;
        voffA[i] = (unsigned)(R * K + C) * 2u; voffB[i] = (unsigned)(Rb * K + C) * 2u; }
    const size_t kstep = (size_t)(BK * 2);
    const size_t hstep = (size_t)HALF * K * 2;
    const size_t tstep = 2 * hstep;
    const unsigned ldsw = (unsigned)wid * 1024u;
    const int aoff = lds_byte(wr * 64 + fr, fq * 8), boff = lds_byte(wc * 32 + fr, fq * 8);
#define PG8_SA(b, h) (((b) * 2 + (h)) * HTB)
#define PG8_SB(b, h) ((4 + (b) * 2 + (h)) * HTB)
#define PG8_STAGE(bufoff, gbase, voff) do { _Pragma("unroll") for (int _i = 0; _i < 2; ++_i) \
        __builtin_amdgcn_global_load_lds((const unsigned*)((const char*)(gbase) + (voff)[_i]), (PG8_LAS unsigned*)(lds + (bufoff) + ldsw + _i * 8192), 16, 0, 0); } while (0)
#define PG8_LDA(dst, b, h) do { _Pragma("unroll") for (int m = 0; m < 4; ++m) _Pragma("unroll") for (int k = 0; k < 2; ++k) dst[m][k] = *(const PG8_LAS bf16x8*)(lds + PG8_SA(b, h) + aoff + m * 2048 + k * 1024); } while (0)
#define PG8_LDB(dst, b, h) do { _Pragma("unroll") for (int n = 0; n < 2; ++n) _Pragma("unroll") for (int k = 0; k < 2; ++k) dst[n][k] = *(const PG8_LAS bf16x8*)(lds + PG8_SB(b, h) + boff + n * 2048 + k * 1024); } while (0)
#define PG8_MMA(ai, bj, At, Bt) do { __builtin_amdgcn_s_setprio(1); _Pragma("unroll") for (int m = 0; m < 4; ++m) _Pragma("unroll") for (int n = 0; n < 2; ++n) _Pragma("unroll") for (int k = 0; k < 2; ++k) \
        acc[ai][bj][m][n] = __builtin_amdgcn_mfma_f32_16x16x32_bf16(Bt[n][k], At[m][k], acc[ai][bj][m][n], 0, 0, 0); __builtin_amdgcn_s_setprio(0); } while (0)
#define PG8_WAIT_V(n) asm volatile("s_waitcnt vmcnt(" #n ")" ::: "memory")
#define PG8_WAIT_L(n) asm volatile("s_waitcnt lgkmcnt(" #n ")" ::: "memory")
#define PG8_BAR __builtin_amdgcn_s_barrier()
#define PG8_SCHED __builtin_amdgcn_sched_barrier(0)
    Unit cur, nxt; int ui = 0;
    if (!S.next(0, cur)) return;
    f32x4 acc[2][2][4][2];
#pragma unroll
    for (int a = 0; a < 2; ++a)
#pragma unroll
        for (int b = 0; b < 2; ++b)
#pragma unroll
            for (int m = 0; m < 4; ++m)
#pragma unroll
                for (int n = 0; n < 2; ++n) acc[a][b][m][n] = (f32x4){0.f, 0.f, 0.f, 0.f};
    bf16x8 At[4][2], B0[2][2], B1[2][2];
    const char* cA = (const char*)g.A + (size_t)cur.pm * tstep; const char* cB = (const char*)g.Bt + (size_t)cur.pn * tstep;
    S.a_ready(cur);
    if constexpr (SP2) {
        PG8_STAGE(PG8_SB(0, 0), cB, voffB); PG8_STAGE(PG8_SB(0, 1), cB + hstep, voffB); PG8_STAGE(PG8_SA(0, 0), cA, voffA); PG8_STAGE(PG8_SA(0, 1), cA + hstep, voffA);
        if (wr == 1) PG8_BAR;
        PG8_WAIT_V(2); PG8_BAR;
        PG8_STAGE(PG8_SB(1, 0), cB + kstep, voffB); PG8_STAGE(PG8_SA(1, 0), cA + kstep, voffA); PG8_STAGE(PG8_SB(1, 1), cB + hstep + kstep, voffB);
        PG8_WAIT_V(6); PG8_BAR;
    } else {
        PG8_STAGE(PG8_SB(0, 0), cB, voffB); PG8_STAGE(PG8_SA(0, 0), cA, voffA); PG8_STAGE(PG8_SB(0, 1), cB + hstep, voffB); PG8_STAGE(PG8_SA(0, 1), cA + hstep, voffA);
        if (wr == 1) PG8_BAR;
        PG8_WAIT_V(4); PG8_BAR;
        PG8_STAGE(PG8_SB(1, 0), cB + kstep, voffB); PG8_STAGE(PG8_SA(1, 0), cA + kstep, voffA); PG8_STAGE(PG8_SB(1, 1), cB + hstep + kstep, voffB);
        PG8_WAIT_V(6); PG8_BAR;
    }
    for (;;) {
        const bool has_next = S.next(ui + 1, nxt);
        const char* nA = has_next ? (const char*)g.A + (size_t)nxt.pm * tstep : cA; const char* nB = has_next ? (const char*)g.Bt + (size_t)nxt.pn * tstep : cB;
        for (int t = 0; t < nt; t += 2) {
            const bool last = (t == nt - 2);
            const char* a1 = cA + (size_t)(t + 1) * kstep;
            const char* a2 = last ? nA : cA + (size_t)(t + 2) * kstep; const char* b2 = last ? nB : cB + (size_t)(t + 2) * kstep;
            const char* a3 = a2 + kstep; const char* b3 = b2 + kstep;
            if (last && has_next) S.a_ready(nxt);
            if constexpr (SP2) {
            PG8_LDB(B0, 0, 0); PG8_LDB(B1, 0, 1); PG8_SCHED; PG8_LDA(At, 0, 0); PG8_STAGE(PG8_SA(1, 1), a1 + hstep, voffA);
            PG8_WAIT_V(8); PG8_WAIT_L(0); PG8_BAR; PG8_MMA(0, 0, At, B0); PG8_MMA(0, 1, At, B1); PG8_BAR; PG8_SCHED;
            PG8_LDA(At, 0, 1); PG8_STAGE(PG8_SB(0, 0), b2, voffB); PG8_STAGE(PG8_SB(0, 1), b2 + hstep, voffB); PG8_STAGE(PG8_SA(0, 0), a2, voffA);
            PG8_WAIT_V(8); PG8_WAIT_L(0); PG8_BAR; PG8_MMA(1, 0, At, B0); PG8_MMA(1, 1, At, B1); PG8_BAR; PG8_SCHED;
            PG8_LDB(B0, 1, 0); PG8_LDB(B1, 1, 1); PG8_SCHED; PG8_LDA(At, 1, 0); PG8_STAGE(PG8_SA(0, 1), a2 + hstep, voffA);
            PG8_WAIT_V(8); PG8_WAIT_L(0); PG8_BAR; PG8_MMA(0, 0, At, B0); PG8_MMA(0, 1, At, B1); PG8_BAR; PG8_SCHED;
            PG8_LDA(At, 1, 1); PG8_STAGE(PG8_SB(1, 0), b3, voffB); PG8_STAGE(PG8_SB(1, 1), b3 + hstep, voffB); PG8_STAGE(PG8_SA(1, 0), a3, voffA);
            PG8_WAIT_V(8); PG8_WAIT_L(0); PG8_BAR; PG8_MMA(1, 0, At, B0); PG8_MMA(1, 1, At, B1); PG8_BAR; PG8_SCHED;
            } else {
            PG8_LDB(B0, 0, 0); PG8_SCHED; PG8_LDA(At, 0, 0); PG8_STAGE(PG8_SA(1, 1), a1 + hstep, voffA);
            PG8_WAIT_L(8); PG8_BAR; PG8_WAIT_L(0); PG8_MMA(0, 0, At, B0); PG8_BAR; PG8_SCHED;
            PG8_LDB(B1, 0, 1); PG8_STAGE(PG8_SB(0, 0), b2, voffB);
            PG8_BAR; PG8_WAIT_L(0); PG8_MMA(0, 1, At, B1); PG8_BAR;
            PG8_LDA(At, 0, 1); PG8_STAGE(PG8_SA(0, 0), a2, voffA);
            PG8_BAR; PG8_WAIT_L(0); PG8_MMA(1, 0, At, B0); PG8_BAR; PG8_SCHED;
            PG8_STAGE(PG8_SB(0, 1), b2 + hstep, voffB);
            PG8_WAIT_V(6); PG8_BAR; PG8_MMA(1, 1, At, B1); PG8_BAR;
            PG8_LDB(B0, 1, 0); PG8_SCHED; PG8_LDA(At, 1, 0); PG8_STAGE(PG8_SA(0, 1), a2 + hstep, voffA);
            PG8_WAIT_L(8); PG8_BAR; PG8_WAIT_L(0); PG8_MMA(0, 0, At, B0); PG8_BAR; PG8_SCHED;
            PG8_LDB(B1, 1, 1); PG8_STAGE(PG8_SB(1, 0), b3, voffB);
            PG8_BAR; PG8_WAIT_L(0); PG8_MMA(0, 1, At, B1); PG8_BAR;
            PG8_LDA(At, 1, 1); PG8_STAGE(PG8_SA(1, 0), a3, voffA);
            PG8_BAR; PG8_WAIT_L(0); PG8_MMA(1, 0, At, B0); PG8_BAR; PG8_SCHED;
            PG8_STAGE(PG8_SB(1, 1), b3 + hstep, voffB);
            PG8_WAIT_V(6); PG8_BAR; PG8_MMA(1, 1, At, B1); PG8_BAR;
            }
        }
        if constexpr (ALIGN_EPI) { if (wr == 0) PG8_BAR; }
        if constexpr (!Epi::AFTER_DRAIN) { E(acc, cur, wr, wc, fr, fq); S.done(cur); }
        if (!has_next) break;
#pragma unroll
        for (int a = 0; a < 2; ++a)
#pragma unroll
            for (int b = 0; b < 2; ++b)
#pragma unroll
                for (int m = 0; m < 4; ++m)
#pragma unroll
                    for (int n = 0; n < 2; ++n) acc[a][b][m][n] = (f32x4){0.f, 0.f, 0.f, 0.f};
        cur = nxt; cA = nA; cB = nB; ++ui;
        if constexpr (ALIGN_EPI) { if (wr == 1) PG8_BAR; }
    }
    PG8_WAIT_V(0);
    if constexpr (!ALIGN_EPI) { if (wr == 0) PG8_BAR; }
    PG8_BAR;
    if constexpr (Epi::AFTER_DRAIN) { E.fused(acc, cur, wr, wc, fr, fq, lds, wid, lane); S.done(cur); }
#undef PG8_SA
#undef PG8_SB
#undef PG8_STAGE
#undef PG8_LDA
#undef PG8_LDB
#undef PG8_MMA
#undef PG8_WAIT_V
#undef PG8_WAIT_L
#undef PG8_BAR
#undef PG8_SCHED
}
__device__ __forceinline__ float bf2f(unsigned short h) { return __uint_as_float(((unsigned)h) << 16); }
__device__ __forceinline__ float fast_sigmoid(float x) { return __builtin_amdgcn_rcpf(1.0f + __builtin_amdgcn_exp2f(-1.4426950408889634f * x)); }
struct EpiG1 {
    static constexpr bool PERM = true, AFTER_DRAIN = false;
    bf16_t* U; bf16_t* G; const float* bias;
    __device__ __forceinline__ void operator()(const f32x4 (&acc)[2][2][4][2], const Unit& u, int wr, int wc, int fr, int fq) const {
        const int row0 = u.pm * BM + wr * 64 + fr; int colt = u.pn * BM; const bool isg = colt >= 5376;
        bf16_t* base = U; int ldc = 5376; if (isg) { colt -= 5376; base = G; ldc = 3072; }
        const int col0 = colt + wc * 32 + 8 * fq;
        f32x4 bv[2][2];
#pragma unroll
        for (int bj = 0; bj < 2; ++bj)
#pragma unroll
            for (int n = 0; n < 2; ++n) bv[bj][n] = isg ? *(const f32x4*)(bias + col0 + bj * HALF + 4 * n) : (f32x4){0.f, 0.f, 0.f, 0.f};
#pragma unroll
        for (int ai = 0; ai < 2; ++ai)
#pragma unroll
            for (int m = 0; m < 4; ++m) { bf16_t* rowp = base + (size_t)(row0 + ai * HALF + m * 16) * ldc + col0;
#pragma unroll
                for (int bj = 0; bj < 2; ++bj) { f32x4 v0 = acc[ai][bj][m][0] + bv[bj][0], v1 = acc[ai][bj][m][1] + bv[bj][1];
                    if (isg) {
#pragma unroll
                        for (int e = 0; e < 4; ++e) { v0[e] = fast_sigmoid(v0[e]); v1[e] = fast_sigmoid(v1[e]); } }
                    u32x4 w; w.x = cvt_pk_bf16(v0[0], v0[1]); w.y = cvt_pk_bf16(v0[2], v0[3]); w.z = cvt_pk_bf16(v1[0], v1[1]); w.w = cvt_pk_bf16(v1[2], v1[3]);
                    *(u32x4*)(rowp + bj * HALF) = w; } }
    }
};
struct EpiG2 {
    static constexpr bool PERM = true, AFTER_DRAIN = false;
    const bf16_t* G; float* T; bf16_t* Mg; int npan;
    __device__ __forceinline__ void operator()(const f32x4 (&acc)[2][2][4][2], const Unit& u, int wr, int wc, int fr, int fq) const {
        const int b = u.pm / npan, pm = u.pm - b * npan, pn = u.pn & 3;
        const int row0 = pm * BM + wr * 64 + fr, col0 = pn * BM + wc * 32 + 8 * fq;
#pragma unroll
        for (int ai = 0; ai < 2; ++ai)
#pragma unroll
            for (int m = 0; m < 4; ++m) { const size_t row = (size_t)(row0 + ai * HALF + m * 16);
#pragma unroll
                for (int bj = 0; bj < 2; ++bj) { const int col = col0 + bj * HALF;
                    const u32x4 g = *(const u32x4*)(G + row * 3072 + b * 1024 + col);
                    f32x4 v0 = acc[ai][bj][m][0], v1 = acc[ai][bj][m][1];
                    v0[0] *= __uint_as_float(g.x << 16); v0[1] *= __uint_as_float(g.x & 0xffff0000u); v0[2] *= __uint_as_float(g.y << 16); v0[3] *= __uint_as_float(g.y & 0xffff0000u);
                    v1[0] *= __uint_as_float(g.z << 16); v1[1] *= __uint_as_float(g.z & 0xffff0000u); v1[2] *= __uint_as_float(g.w << 16); v1[3] *= __uint_as_float(g.w & 0xffff0000u);
                    bf16_t* mp = Mg + row * 1024 + col;
                    if (b > 0) { const u32x4 t = *(const u32x4*)mp;
                        v0[0] += __uint_as_float(t.x << 16); v0[1] += __uint_as_float(t.x & 0xffff0000u); v0[2] += __uint_as_float(t.y << 16); v0[3] += __uint_as_float(t.y & 0xffff0000u);
                        v1[0] += __uint_as_float(t.z << 16); v1[1] += __uint_as_float(t.z & 0xffff0000u); v1[2] += __uint_as_float(t.w << 16); v1[3] += __uint_as_float(t.w & 0xffff0000u); }
                    u32x4 w; w.x = cvt_pk_bf16(v0[0], v0[1]); w.y = cvt_pk_bf16(v0[2], v0[3]); w.z = cvt_pk_bf16(v1[0], v1[1]); w.w = cvt_pk_bf16(v1[2], v1[3]);
                    *(u32x4*)mp = w; } }
    }
};
struct OrderG2 {
    int npan, G, c;
    __device__ bool next(int i, Unit& u) const { const int ti = i / 3, b = i - 3 * ti, t = ti * G + c; if (t >= npan * 4) return false;
        const int pm = t >> 2, pn = t & 3; u.pm = b * npan + pm; u.pn = b * 4 + pn; return true; }
    __device__ __forceinline__ void a_ready(const Unit&) const {}
    __device__ __forceinline__ void done(const Unit&) const {}
};
struct EpiG3 {
    static constexpr bool PERM = true, AFTER_DRAIN = false;
    const float* X; float* O;
    __device__ __forceinline__ void operator()(const f32x4 (&acc)[2][2][4][2], const Unit& u, int wr, int wc, int fr, int fq) const {
        const int row0 = u.pm * BM + wr * 64 + fr, col0 = u.pn * BM + wc * 32 + 8 * fq;
#pragma unroll
        for (int ai = 0; ai < 2; ++ai)
#pragma unroll
            for (int m = 0; m < 4; ++m) { const size_t row = (size_t)(row0 + ai * HALF + m * 16);
#pragma unroll
                for (int bj = 0; bj < 2; ++bj) { const size_t p = row * 1024 + col0 + bj * HALF;
                    const f32x4 x0 = *(const f32x4*)(X + p), x1 = *(const f32x4*)(X + p + 4);
                    *(f32x4*)(O + p) = x0 + acc[ai][bj][m][0]; *(f32x4*)(O + p + 4) = x1 + acc[ai][bj][m][1]; } }
    }
};
struct EpiAll {
    static constexpr bool PERM = true, AFTER_DRAIN = false;
    int mode; EpiG1 e1; EpiG2 e2; EpiG3 e3;
    __device__ __forceinline__ void operator()(const f32x4 (&acc)[2][2][4][2], const Unit& u, int wr, int wc, int fr, int fq) const {
        if (mode == 1) e1(acc, u, wr, wc, fr, fq); else if (mode == 2) e2(acc, u, wr, wc, fr, fq); else e3(acc, u, wr, wc, fr, fq); }
};
struct OrderAll {
    int mode; StaticOrder so; OrderG2 o2;
    __device__ __forceinline__ bool next(int i, Unit& u) const { return mode == 2 ? o2.next(i, u) : so.next(i, u); }
    __device__ __forceinline__ void a_ready(const Unit&) const {}
    __device__ __forceinline__ void done(const Unit&) const {}
};
}
#ifndef DUP_MASK
#define DUP_MASK 0
#endif
#ifndef EN_MASK
#define EN_MASK 0xffff
#endif
#define EN(i) ((EN_MASK >> (i)) & 1)
#define LAS __attribute__((address_space(3)))
typedef unsigned short bf16;
typedef float f32x4 __attribute__((ext_vector_type(4)));
typedef float f32x2 __attribute__((ext_vector_type(2)));
typedef unsigned u32x4 __attribute__((ext_vector_type(4)));
typedef unsigned u32x2 __attribute__((ext_vector_type(2)));
constexpr int DM = 1024, NTOK_P = 65536, NTOK_S = 32768, NTOK = NTOK_P + NTOK_S, LP = 8192, LS = 2048;
constexpr int CH = 16384, NCHUNK = NTOK / CH, NCH_P = NTOK_P / CH;
constexpr int UP = 5376, NCAT = 8448, GP = 3072;
constexpr int C_X0 = 0, C_X1 = 512, C_HV = 1024, C_HG = 1536, C_GQ = 2048, C_GK = 2560, C_GV = 2688, C_GG = 2816, C_DQ = 3328, C_DK = 3840, C_DV = 4352, C_DG = 4864;
constexpr float EPS = 1e-6f, LOG2E = 1.4426950408889634f;
constexpr int NT = 512, NWAVES = 8;
enum { I_XP = 0, I_XS, I_RELB, I_NORMG, I_WIN, I_CONVW, I_CONVB, I_FW1, I_FB1, I_FW2, I_FB2, I_FWOUT, I_FFREQ, I_HYBIAS, I_QNG, I_KNG, I_LQ1, I_LK1, I_LQ2, I_LK2, I_SUBLN, I_WBHY, I_WBGQ, I_WBDF, I_WMERGE, I_BMERGE, I_WOUT, I_FINALG, N_IN };
constexpr size_t MiB = 1u << 20;
constexpr size_t WS_CTL = 0, CTL_BYTES = 64 * 1024;
constexpr size_t WS_TW = 1 * MiB;
constexpr size_t WS_WCAT = 2 * MiB, WCAT_BYTES = (size_t)NCAT * 1024 * 2;
constexpr size_t WS_WBT = 40 * MiB, WBT_BYTES = (size_t)3 * 1024 * 512 * 2;
constexpr size_t WS_WOT = 46 * MiB, WOT_BYTES = (size_t)1024 * 1024 * 2;
constexpr int SPS_P = LP + 16, SPS_S = LS + 16;
constexpr size_t SPEC_P_BYTES = (size_t)256 * SPS_P * 8, SPEC_S_BYTES = (size_t)256 * SPS_S * 8;
constexpr size_t SPEC_LAYER = 2 * SPEC_P_BYTES + 2 * SPEC_S_BYTES;
constexpr size_t WS_SPEC = 52 * MiB;
constexpr size_t WS_HN = 140 * MiB, WS_U = 172 * MiB, WS_G = 340 * MiB, WS_Y = 436 * MiB, WS_MG = 484 * MiB, WS_TMP = 516 * MiB, WS_DT = 580 * MiB, WS_HVP = 612 * MiB, WS_PMP = 644 * MiB, WS_ROPE = 676 * MiB, WS_HN0 = 680 * MiB, WS_END = 872 * MiB;
constexpr size_t HF_P_BYTES = (size_t)LP * 1024 * 4, HF_S_BYTES = (size_t)LS * 1024 * 4;
static_assert(WS_WCAT + 2 * WCAT_BYTES <= WS_WBT && WS_WBT + 2 * WBT_BYTES <= WS_WOT && WS_WOT + 2 * WOT_BYTES <= WS_SPEC && WS_SPEC + 2 * SPEC_LAYER <= WS_HN, "ws map");
static_assert(WS_HN + (size_t)CH * 1024 * 2 <= WS_U && WS_U + (size_t)CH * UP * 2 <= WS_G && WS_G + (size_t)CH * GP * 2 <= WS_Y && WS_Y + (size_t)3 * CH * 512 * 2 <= WS_MG && WS_MG + (size_t)CH * 1024 * 2 <= WS_TMP && WS_TMP + (size_t)CH * 1024 * 4 <= WS_DT && WS_DT + (size_t)CH * 512 * 4 <= WS_END, "ws map 2");
static_assert(2 * (HF_P_BYTES + HF_S_BYTES) <= (size_t)CH * UP * 2, "hf overlay");
constexpr int LDS_MAIN = 139264, LDS_BYTES = LDS_MAIN + 1024;
constexpr int CW_BAR = 4096;

struct Args { const float* in[N_IN]; float* out; unsigned char* ws; int lo, hi; };
typedef const __attribute__((address_space(4))) unsigned long long* kargp_t;
struct AV { kargp_t p; };
#define AIN(i) ((const float*)(a.p[(i)]))
#define AOUT ((float*)(a.p[N_IN]))
#define AWS ((unsigned char*)(a.p[N_IN + 1]))


__device__ __forceinline__ float bf2f(unsigned short h) { return __uint_as_float(((unsigned)h) << 16); }
__device__ __forceinline__ float bflo(unsigned w) { return __uint_as_float(w << 16); }
__device__ __forceinline__ float bfhi(unsigned w) { return __uint_as_float(w & 0xffff0000u); }
__device__ __forceinline__ unsigned f2bf(float f) { unsigned u = __builtin_bit_cast(unsigned, f); return (u + 0x7fffu + ((u >> 16) & 1u)) >> 16; }
__device__ __forceinline__ unsigned pk2(float lo, float hi) { return f2bf(lo) | (f2bf(hi) << 16); }
__device__ __forceinline__ float silu(float x) { return x * __builtin_amdgcn_rcpf(1.0f + __builtin_amdgcn_exp2f(-LOG2E * x)); }
__device__ __forceinline__ float wave_sum(float v) {
#pragma unroll
    for (int o = 1; o < 64; o <<= 1) v += __shfl_xor(v, o);
    return v;
}
__device__ __forceinline__ double kd(double v) { asm volatile("" : "+s"(v)); return v; }
__device__ __forceinline__ void sincos_rev(double r, float& s, float& c) {
    r -= __builtin_rint(r);
    const double k = __builtin_rint(r * 4.0);
    const double x = (r - k * 0.25) * kd(6.283185307179586476925);
    const double x2 = x * x;
    double sp = kd(1.0 / 6227020800.0); sp = sp * x2 + kd(-1.0 / 39916800); sp = sp * x2 + kd(1.0 / 362880); sp = sp * x2 + kd(-1.0 / 5040); sp = sp * x2 + kd(1.0 / 120); sp = sp * x2 + kd(-1.0 / 6); sp = sp * x2 + 1.0; sp *= x;
    double cp = kd(-1.0 / 87178291200.0); cp = cp * x2 + kd(1.0 / 479001600.0); cp = cp * x2 + kd(-1.0 / 3628800); cp = cp * x2 + kd(1.0 / 40320); cp = cp * x2 + kd(-1.0 / 720); cp = cp * x2 + kd(1.0 / 24); cp = cp * x2 + (-0.5); cp = cp * x2 + 1.0;
    const int q = ((int)k) & 3;
    const float sf = (float)sp, cf = (float)cp;
    s = (q == 0) ? sf : (q == 1) ? cf : (q == 2) ? -sf : -cf;
    c = (q == 0) ? cf : (q == 1) ? -sf : (q == 2) ? -cf : sf;
}
__device__ __forceinline__ float sin_acc(float x) { float s, c; sincos_rev((double)x * 0.15915494309189533577, s, c); return s; }

__device__ __forceinline__ void transpose_item(const float* W, int K, int N, bf16* WT, int row_off, LAS float* scr, int item, int lane) {
    const int nblk = N / 32, kb = item / nblk, nb = item % nblk, k0 = 64 * kb, n0 = 32 * nb;
#pragma unroll 8
    for (int i = 0; i < 32; ++i) { const int kk = 2 * i + (lane >> 5); scr[kk * 33 + (lane & 31)] = W[(size_t)(k0 + kk) * N + n0 + (lane & 31)]; }
    asm volatile("s_waitcnt lgkmcnt(0)" ::: "memory");
    const int c = lane & 7;
#pragma unroll
    for (int j = 0; j < 4; ++j) { const int n = (lane >> 3) + 8 * j; const LAS float* s = scr + (8 * c) * 33 + n;
        u32x4 o; o.x = pk2(s[0 * 33], s[1 * 33]); o.y = pk2(s[2 * 33], s[3 * 33]); o.z = pk2(s[4 * 33], s[5 * 33]); o.w = pk2(s[6 * 33], s[7 * 33]);
        *(u32x4*)(WT + (size_t)(row_off + n0 + n) * K + k0 + 8 * c) = o; }
    asm volatile("s_waitcnt lgkmcnt(0)" ::: "memory");
}

__device__ __forceinline__ f32x2 cmul(f32x2 a, f32x2 b) { return (f32x2){a.x * b.x - a.y * b.y, a.x * b.y + a.y * b.x}; }
__device__ __forceinline__ f32x2 cmulc(f32x2 a, f32x2 b) { return (f32x2){a.x * b.x + a.y * b.y, a.y * b.x - a.x * b.y}; }
__device__ __forceinline__ f32x2 cconj(f32x2 a) { return (f32x2){a.x, -a.y}; }
template <int LOG4> __device__ __forceinline__ int digitrev(int k) { unsigned x = __builtin_bitreverse32((unsigned)k) >> (32 - 2 * LOG4); return (int)(((x & 0x55555555u) << 1) | ((x >> 1) & 0x55555555u)); }
#define PADI(i) ((i) + ((i) >> 4))
#define W16C 0.92387953251128674f
#define W16S 0.38268343236508977f
#define W16H 0.70710678118654752f
__device__ __forceinline__ f32x2 w16(int m) { return m == 0 ? (f32x2){1.f, 0.f} : m == 1 ? (f32x2){W16C, -W16S} : m == 2 ? (f32x2){W16H, -W16H} : m == 3 ? (f32x2){W16S, -W16C} : m == 4 ? (f32x2){0.f, -1.f} : m == 6 ? (f32x2){-W16H, -W16H} : (f32x2){-W16C, W16S}; }
__device__ __forceinline__ void bfly_fwd(f32x2& a0, f32x2& a1, f32x2& a2, f32x2& a3) {
    const f32x2 t0 = a0 + a2, t1 = a0 - a2, t2 = a1 + a3, t3 = a1 - a3;
    a0 = t0 + t2; a2 = t0 - t2; a1 = (f32x2){t1.x + t3.y, t1.y - t3.x}; a3 = (f32x2){t1.x - t3.y, t1.y + t3.x};
}
__device__ __forceinline__ void bfly_inv(f32x2& b0, f32x2& b1, f32x2& b2, f32x2& b3) {
    const f32x2 t0 = b0 + b2, t1 = b0 - b2, t2 = b1 + b3, t3 = b1 - b3;
    b0 = t0 + t2; b2 = t0 - t2; b1 = (f32x2){t1.x - t3.y, t1.y + t3.x}; b3 = (f32x2){t1.x + t3.y, t1.y - t3.x};
}
template <int LOG4, int BATCH = 1> __device__ __forceinline__ void fft_fwd(LAS f32x2* buf, const f32x2* __restrict__ tw, int tid) {
    constexpr int N = 1 << (2 * LOG4), TWS = 16384 / N;
#pragma unroll 1
    for (int pass = 0; pass < LOG4 - 2; ++pass) {
        const int lq = 2 * (LOG4 - pass) - 2, q4 = 1 << lq, n = q4 << 2, tstep = TWS << (2 * pass);
        constexpr int IT = BATCH * N / 4 / NT, NPAD = N + N / 16;
        f32x2 wl[IT];
#pragma unroll
        for (int i = 0; i < IT; ++i) wl[i] = tw[((tid + i * NT) & (q4 - 1)) * tstep];
#pragma unroll
        for (int i = 0; i < IT; ++i) { const int jg = tid + i * NT, bo = (jg >> (2 * LOG4 - 2)) * NPAD, j = jg & (N / 4 - 1);
            const int blk = j >> lq, jj = j & (q4 - 1), base = blk * n + jj;
            const int i0 = bo + PADI(base), i1 = bo + PADI(base + q4), i2 = bo + PADI(base + 2 * q4), i3 = bo + PADI(base + 3 * q4);
            const f32x2 w1 = wl[i];
            f32x2 a0 = buf[i0], a1 = buf[i1], a2 = buf[i2], a3 = buf[i3];
            bfly_fwd(a0, a1, a2, a3);
            const f32x2 w2 = cmul(w1, w1), w3 = cmul(w2, w1);
            buf[i0] = a0; buf[i1] = cmul(a1, w1); buf[i2] = cmul(a2, w2); buf[i3] = cmul(a3, w3);
        }
        __syncthreads();
    }
#pragma unroll 1
    for (int b = tid; b < BATCH * N / 16; b += NT) {
        LAS f32x2* xb = buf + 17 * b; f32x2 x[16];
#pragma unroll
        for (int e = 0; e < 16; ++e) x[e] = xb[e];
#pragma unroll
        for (int jj = 0; jj < 4; ++jj) { bfly_fwd(x[jj], x[jj + 4], x[jj + 8], x[jj + 12]); if (jj) { x[jj + 4] = cmul(x[jj + 4], w16(jj)); x[jj + 8] = cmul(x[jj + 8], w16(2 * jj)); x[jj + 12] = cmul(x[jj + 12], w16(3 * jj)); } }
#pragma unroll
        for (int q = 0; q < 4; ++q) bfly_fwd(x[4 * q], x[4 * q + 1], x[4 * q + 2], x[4 * q + 3]);
#pragma unroll
        for (int e = 0; e < 16; ++e) xb[e] = x[e];
    }
    __syncthreads();
}
template <int LOG4, int BATCH = 1> __device__ __forceinline__ void fft_inv(LAS f32x2* buf, const f32x2* __restrict__ tw, int tid) {
    constexpr int N = 1 << (2 * LOG4), TWS = 16384 / N;
#pragma unroll 1
    for (int b = tid; b < BATCH * N / 16; b += NT) {
        LAS f32x2* xb = buf + 17 * b; f32x2 x[16];
#pragma unroll
        for (int e = 0; e < 16; ++e) x[e] = xb[e];
#pragma unroll
        for (int q = 0; q < 4; ++q) bfly_inv(x[4 * q], x[4 * q + 1], x[4 * q + 2], x[4 * q + 3]);
#pragma unroll
        for (int jj = 0; jj < 4; ++jj) { if (jj) { x[jj + 4] = cmulc(x[jj + 4], w16(jj)); x[jj + 8] = cmulc(x[jj + 8], w16(2 * jj)); x[jj + 12] = cmulc(x[jj + 12], w16(3 * jj)); } bfly_inv(x[jj], x[jj + 4], x[jj + 8], x[jj + 12]); }
#pragma unroll
        for (int e = 0; e < 16; ++e) xb[e] = x[e];
    }
    __syncthreads();
#pragma unroll 1
    for (int pass = LOG4 - 3; pass >= 0; --pass) {
        const int lq = 2 * (LOG4 - pass) - 2, q4 = 1 << lq, n = q4 << 2, tstep = TWS << (2 * pass);
        constexpr int IT = BATCH * N / 4 / NT, NPAD = N + N / 16;
        f32x2 wl[IT];
#pragma unroll
        for (int i = 0; i < IT; ++i) wl[i] = tw[((tid + i * NT) & (q4 - 1)) * tstep];
#pragma unroll
        for (int i = 0; i < IT; ++i) { const int jg = tid + i * NT, bo = (jg >> (2 * LOG4 - 2)) * NPAD, j = jg & (N / 4 - 1);
            const int blk = j >> lq, jj = j & (q4 - 1), base = blk * n + jj;
            const int i0 = bo + PADI(base), i1 = bo + PADI(base + q4), i2 = bo + PADI(base + 2 * q4), i3 = bo + PADI(base + 3 * q4);
            const f32x2 w1 = wl[i];
            const f32x2 w2 = cmul(w1, w1), w3 = cmul(w2, w1);
            f32x2 b0 = buf[i0], b1 = cmulc(buf[i1], w1), b2 = cmulc(buf[i2], w2), b3 = cmulc(buf[i3], w3);
            bfly_inv(b0, b1, b2, b3);
            buf[i0] = b0; buf[i1] = b1; buf[i2] = b2; buf[i3] = b3;
        }
        __syncthreads();
    }
}
__device__ const double ROPE_IF[16] = {1.0, 0.5623413251903491, 0.31622776601683794, 0.1778279410038923, 0.1, 0.05623413251903491, 0.03162277660168379, 0.01778279410038923,
    0.01, 0.005623413251903491, 0.0031622776601683794, 0.0017782794100389228, 0.001, 0.0005623413251903491, 0.00031622776601683794, 0.00017782794100389227};
struct Chunk { int tok0, L, nseq; };
__device__ __forceinline__ Chunk chunk_of(int c) { Chunk k; k.tok0 = c * CH; if (c < NCH_P) { k.L = LP; k.nseq = CH / LP; } else { k.L = LS; k.nseq = CH / LS; } return k; }
__device__ __forceinline__ const float* xin_rows(const AV& a, int tok0) { return tok0 < NTOK_P ? AIN(I_XP) + (size_t)tok0 * DM : AIN(I_XS) + (size_t)(tok0 - NTOK_P) * DM; }
__device__ __forceinline__ void hf_group(LAS float* sm, const AV& a, int layer, int L, int t0, float* hf, int tid) {
    LAS float* zs = sm; LAS float* A = sm + 512; LAS float* B = sm + 1024;
    const float* w1 = AIN(I_FW1) + layer * 33 * 64; const float* b1 = AIN(I_FB1) + layer * 64;
    const float* w2 = AIN(I_FW2) + layer * 2 * 64 * 64; const float* b2 = AIN(I_FB2) + layer * 2 * 64;
    const float* wo = AIN(I_FWOUT) + layer * 64 * 1024; const float* fr = AIN(I_FFREQ) + layer * 64;
    const int tt = tid >> 6, j = tid & 63, t = t0 + tt;
    const float t01 = (float)t / (float)(L - 1);
    if (j < 33) {
        float v;
        if (j == 0) v = t01;
        else { const int k = (j - 1) & 15; const double f = kd(1e-4) + (double)k * kd((15.0 - 1e-4) / 15.0); float s, c; sincos_rev(f * (double)t / (double)L, s, c); v = (j <= 16) ? c : -s; }
        zs[tt * 40 + j] = v;
    }
    __syncthreads();
    const float fq = fr[j];
    { float acc = b1[j]; for (int i = 0; i < 33; ++i) acc += zs[tt * 40 + i] * w1[i * 64 + j]; A[tt * 64 + j] = sin_acc(fq * acc); }
    __syncthreads();
    { float acc = b2[j]; for (int i = 0; i < 64; ++i) acc += A[tt * 64 + i] * w2[i * 64 + j]; B[tt * 64 + j] = sin_acc(fq * acc); }
    __syncthreads();
    { float acc = b2[64 + j]; for (int i = 0; i < 64; ++i) acc += B[tt * 64 + i] * w2[4096 + i * 64 + j]; A[tt * 64 + j] = sin_acc(fq * acc); }
    __syncthreads();
    { float acc0[8], acc1[8];
#pragma unroll
      for (int q = 0; q < 8; ++q) { acc0[q] = 0.f; acc1[q] = 0.f; }
#pragma unroll 8
      for (int i = 0; i < 64; ++i) { const float wa = wo[i * 1024 + tid], wb = wo[i * 1024 + 512 + tid];
#pragma unroll
          for (int q = 0; q < 8; ++q) { const float av = A[q * 64 + i]; acc0[q] += av * wa; acc1[q] += av * wb; } }
      const float ad = 3.070113457325394f + (float)tid * ((15.350567286626973f - 3.070113457325394f) / 511.0f);
#pragma unroll
      for (int q = 0; q < 8; ++q) { const float tq = (float)(t0 + q) / (float)(L - 1); const float win = __expf(-tq * ad);
          hf[(size_t)(t0 + q) * 1024 + tid] = acc0[q] * win; hf[(size_t)(t0 + q) * 1024 + 512 + tid] = acc1[q] * win; } }
    __syncthreads();
}
__device__ __forceinline__ void step_pro_a(const AV& a, LAS unsigned char* lds) {
    const int tid = ltid(), lane = tid & 63, wave = tid >> 6, G = gridDim.x;
    unsigned char* ws = AWS;
    { f32x2* tw = (f32x2*)(ws + WS_TW); for (int m = lbid() * NT + tid; m < 16384; m += G * NT) { float s, c; sincos_rev((double)m / 16384.0, s, c); tw[m] = (f32x2){c, -s}; } }
    { f32x2* rt = (f32x2*)(ws + WS_ROPE);
      for (int e = lbid() * NT + tid; e < 8192 * 32; e += G * NT) { const int pos = e >> 5, i = e & 31; const int pp = (i < 16) ? (pos >> 6) : (pos & 63);
          const double inv = ROPE_IF[i & 15]; float sn, cs; sincos_rev((double)pp * inv * 0.15915494309189533577, sn, cs); rt[e] = (f32x2){cs, sn}; } }
    { const float* g = AIN(I_NORMG); bf16* HN0 = (bf16*)(ws + WS_HN0); f32x4 gv[4];
#pragma unroll
      for (int j = 0; j < 4; ++j) gv[j] = *((const f32x4*)g + lane + 64 * j);
      for (int m = lbid() * NWAVES + wave; m < NTOK; m += G * NWAVES) {
          const f32x4* xr = (const f32x4*)(xin_rows(a, m)) + lane; f32x4 v[4]; float ssum = 0.f;
#pragma unroll
          for (int j = 0; j < 4; ++j) { v[j] = xr[64 * j]; ssum += (v[j].x * v[j].x + v[j].y * v[j].y) + (v[j].z * v[j].z + v[j].w * v[j].w); }
          const float rs = 1.0f / sqrtf(wave_sum(ssum) * (1.0f / DM) + EPS);
          u32x2* o8 = (u32x2*)(HN0 + (size_t)m * DM) + lane;
#pragma unroll
          for (int j = 0; j < 4; ++j) { u32x2 w; w.x = pk2(v[j].x * rs * gv[j].x, v[j].y * rs * gv[j].y); w.y = pk2(v[j].z * rs * gv[j].z, v[j].w * rs * gv[j].w); o8[64 * j] = w; } } }
    { LAS float* scr = (LAS float*)(lds + wave * 16384);
      constexpr int I_IN = 16 * (UP / 32), I_MG = 16 * (GP / 32), I_BR = 8 * 32, I_OU = 16 * 32, PER = I_IN + I_MG + 3 * I_BR + I_OU;
      for (int it = lbid() * NWAVES + wave; it < 2 * PER; it += G * NWAVES) {
          const int l = it / PER; int r = it - l * PER;
          bf16* wcat = (bf16*)(ws + WS_WCAT + l * WCAT_BYTES); bf16* wbt = (bf16*)(ws + WS_WBT + l * WBT_BYTES); bf16* wot = (bf16*)(ws + WS_WOT + l * WOT_BYTES);
          if (r < I_IN) { transpose_item(AIN(I_WIN) + (size_t)l * 1024 * UP, 1024, UP, wcat, 0, scr, r, lane); continue; } r -= I_IN;
          if (r < I_MG) { transpose_item(AIN(I_WMERGE) + (size_t)l * 1024 * GP, 1024, GP, wcat, UP, scr, r, lane); continue; } r -= I_MG;
          if (r < I_BR) { transpose_item(AIN(I_WBHY) + (size_t)l * 512 * 1024, 512, 1024, wbt, 0, scr, r, lane); continue; } r -= I_BR;
          if (r < I_BR) { transpose_item(AIN(I_WBGQ) + (size_t)l * 512 * 1024, 512, 1024, wbt, 1024, scr, r, lane); continue; } r -= I_BR;
          if (r < I_BR) { transpose_item(AIN(I_WBDF) + (size_t)l * 512 * 1024, 512, 1024, wbt, 2048, scr, r, lane); continue; } r -= I_BR;
          transpose_item(AIN(I_WOUT) + (size_t)l * 1024 * 1024, 1024, 1024, wot, 0, scr, r, lane);
      } }
}
__device__ __forceinline__ void step_pro_a2(const AV& a, LAS unsigned char* lds) {
    const int tid = ltid(), G = gridDim.x; unsigned char* ws = AWS;
    { constexpr int GPL = LP / 8 + LS / 8;
      for (int g = lbid(); g < 2 * GPL; g += G) { const int l = g / GPL; int r = g - l * GPL;
          float* hfp = (float*)(ws + WS_U + l * (HF_P_BYTES + HF_S_BYTES));
          if (r < LP / 8) hf_group((LAS float*)lds, a, l, LP, r * 8, hfp, tid);
          else hf_group((LAS float*)lds, a, l, LS, (r - LP / 8) * 8, (float*)((unsigned char*)hfp + HF_P_BYTES), tid); } }
}
template <int LOG4> __device__ __forceinline__ void filt_unit(const AV& a, LAS unsigned char* lds, int layer, int pr, const float* hf, f32x2* Pg, f32x2* Mg) {
    constexpr int N = 1 << (2 * LOG4), L = N / 2;
    const int tid = ltid(); LAS f32x2* buf = (LAS f32x2*)lds; const int c0 = 2 * pr;
    for (int n = tid; n < N; n += NT) { f32x2 v = (f32x2){0.f, 0.f};
        if (n < L) v = *(const f32x2*)(hf + (size_t)n * 1024 + c0); else if (n > L) v = *(const f32x2*)(hf + (size_t)(N - n) * 1024 + 512 + c0);
        buf[PADI(n)] = v; }
    __syncthreads();
    fft_fwd<LOG4>(buf, (const f32x2*)(AWS + WS_TW), tid);
    const float ba = AIN(I_HYBIAS)[layer * 512 + c0], bb = AIN(I_HYBIAS)[layer * 512 + c0 + 1]; const float sc = 1.0f / (float)N;
    for (int k = tid; k <= L; k += NT) { const int q1 = digitrev<LOG4>(k), q2 = digitrev<LOG4>((N - k) & (N - 1)); const f32x2 z1 = buf[PADI(q1)], z2 = buf[PADI(q2)];
        f32x2 ca = (f32x2){0.5f * (z1.x + z2.x), 0.5f * (z1.y - z2.y)}; const float dx = z1.x - z2.x, dy = z1.y + z2.y; f32x2 cb = (f32x2){0.5f * dy, -0.5f * dx};
        ca.x += ba; cb.x += bb;
        Pg[k] = (f32x2){0.5f * sc * (ca.x + cb.x), 0.5f * sc * (ca.y + cb.y)}; Mg[k] = (f32x2){0.5f * sc * (ca.x - cb.x), 0.5f * sc * (ca.y - cb.y)}; }
    __syncthreads();
}
__device__ __forceinline__ void step_pro_b(const AV& a, LAS unsigned char* lds) {
    for (int u = lbid(); u < 1024; u += gridDim.x) { const int l = u >> 9, r = u & 511; unsigned char* sp = AWS + WS_SPEC + l * SPEC_LAYER; const float* hfp = (const float*)(AWS + WS_U + l * (HF_P_BYTES + HF_S_BYTES));
        if (r < 256) filt_unit<7>(a, lds, l, r, hfp, (f32x2*)sp + (size_t)r * SPS_P, (f32x2*)(sp + SPEC_P_BYTES) + (size_t)r * SPS_P);
        else { const int pr = r - 256; filt_unit<6>(a, lds, l, pr, (const float*)((const unsigned char*)hfp + HF_P_BYTES), (f32x2*)(sp + 2 * SPEC_P_BYTES) + (size_t)pr * SPS_S, (f32x2*)(sp + 2 * SPEC_P_BYTES + SPEC_S_BYTES) + (size_t)pr * SPS_S); } }
}
__device__ __forceinline__ void step_norm(const AV& a, int c, int layer) {
    const int tid = ltid(), lane = tid & 63, wave = tid >> 6; const Chunk ck = chunk_of(c);
    const float* X = layer == 0 ? xin_rows(a, ck.tok0) : AOUT + (size_t)ck.tok0 * DM; bf16* HN = (bf16*)(AWS + WS_HN); const float* g = AIN(I_NORMG) + layer * DM;
    f32x4 gv[4];
#pragma unroll
    for (int j = 0; j < 4; ++j) gv[j] = *((const f32x4*)g + lane + 64 * j);
    for (int m = lbid() * NWAVES + wave; m < CH; m += gridDim.x * NWAVES) {
        const f32x4* xr = (const f32x4*)(X + (size_t)m * DM) + lane; f32x4 v[4]; float s = 0.f;
#pragma unroll
        for (int j = 0; j < 4; ++j) { v[j] = xr[64 * j]; s += (v[j].x * v[j].x + v[j].y * v[j].y) + (v[j].z * v[j].z + v[j].w * v[j].w); }
        const float rs = 1.0f / sqrtf(wave_sum(s) * (1.0f / DM) + EPS);
        u32x2* o8 = (u32x2*)(HN + (size_t)m * DM) + lane;
#pragma unroll
        for (int j = 0; j < 4; ++j) { u32x2 w; w.x = pk2(v[j].x * rs * gv[j].x, v[j].y * rs * gv[j].y); w.y = pk2(v[j].z * rs * gv[j].z, v[j].w * rs * gv[j].w); o8[64 * j] = w; }
    }
}
__device__ __forceinline__ void step_final(const AV& a, int row0, int row1) {
    const int tid = ltid(), lane = tid & 63, wave = tid >> 6; const float* g = AIN(I_FINALG);
    f32x4 gv[4];
#pragma unroll
    for (int j = 0; j < 4; ++j) gv[j] = *((const f32x4*)g + lane + 64 * j);
    for (int m = row0 + lbid() * NWAVES + wave; m < row1; m += gridDim.x * NWAVES) {
        f32x4* xr = (f32x4*)(AOUT + (size_t)m * DM) + lane; f32x4 v[4]; float s = 0.f;
#pragma unroll
        for (int j = 0; j < 4; ++j) { v[j] = xr[64 * j]; s += (v[j].x * v[j].x + v[j].y * v[j].y) + (v[j].z * v[j].z + v[j].w * v[j].w); }
        const float rs = 1.0f / sqrtf(wave_sum(s) * (1.0f / DM) + EPS);
#pragma unroll
        for (int j = 0; j < 4; ++j) xr[64 * j] = v[j] * rs * gv[j];
    }
}
__device__ __forceinline__ void step_prep(const AV& a, int c, int layer) {
    const Chunk ck = chunk_of(c); bf16* U = (bf16*)(AWS + WS_U);
    for (int it = lbid() * NT + ltid(); it < CH * 10; it += gridDim.x * NT) {
        const int tok = it / 10, hd = it - tok * 10; const int pos = tok & (ck.L - 1);
        bf16* p = U + (size_t)tok * UP + (hd < 8 ? C_GQ + 64 * hd : C_GK + 64 * (hd - 8));
        const float* g = (hd < 8 ? AIN(I_QNG) : AIN(I_KNG)) + layer * 64;
        float x[64];
#pragma unroll
        for (int i = 0; i < 8; ++i) { const u32x4 w = *((const u32x4*)p + i);
            x[8 * i + 0] = bflo(w.x); x[8 * i + 1] = bfhi(w.x); x[8 * i + 2] = bflo(w.y); x[8 * i + 3] = bfhi(w.y); x[8 * i + 4] = bflo(w.z); x[8 * i + 5] = bfhi(w.z); x[8 * i + 6] = bflo(w.w); x[8 * i + 7] = bfhi(w.w); }
        float ss = 0.f;
#pragma unroll
        for (int i = 0; i < 64; ++i) ss += x[i] * x[i];
        const float rs = (1.0f / sqrtf(ss * (1.0f / 64.0f) + EPS)) * (hd < 8 ? 0.125f * LOG2E : 1.0f);
#pragma unroll
        for (int i = 0; i < 64; ++i) x[i] = x[i] * rs * g[i];
        const f32x4* rt = (const f32x4*)(AWS + WS_ROPE) + (size_t)pos * 16;
#pragma unroll
        for (int i2 = 0; i2 < 16; ++i2) { const f32x4 cs2 = rt[i2];
#pragma unroll
            for (int e = 0; e < 2; ++e) { const int i = 2 * i2 + e; const float cs = e ? cs2.z : cs2.x, sn = e ? cs2.w : cs2.y; const float x1 = x[i], x2 = x[i + 32]; x[i] = x1 * cs - x2 * sn; x[i + 32] = x2 * cs + x1 * sn; } }
#pragma unroll
        for (int i = 0; i < 8; ++i) { u32x4 w; w.x = pk2(x[8 * i], x[8 * i + 1]); w.y = pk2(x[8 * i + 2], x[8 * i + 3]); w.z = pk2(x[8 * i + 4], x[8 * i + 5]); w.w = pk2(x[8 * i + 6], x[8 * i + 7]); *((u32x4*)p + i) = w; }
    }
}
__device__ __forceinline__ void step_prep_hy(const AV& a, LAS unsigned char* lds, int c, int layer) {
    const Chunk ck = chunk_of(c); const bf16* U = (const bf16*)(AWS + WS_U);
    f32x2* HVP = (f32x2*)(AWS + WS_HVP); f32x2* PMP = (f32x2*)(AWS + WS_PMP);
    const int tid = ltid(), lane = tid & 63, wave = tid >> 6;
    LAS f32x2* th = (LAS f32x2*)(lds + wave * 17408); LAS f32x2* tp = th + 64 * 17;
    const float* cw = AIN(I_CONVW) + layer * 3 * 1536; const float* cb = AIN(I_CONVB) + layer * 1536;
    for (int it = lbid() * NWAVES + wave; it < (CH / 16) * 4; it += gridDim.x * NWAVES) {
        const int cbk = it & 3, tg = it >> 2, t0 = tg * 16, ch = cbk * 128 + 2 * lane;
        const int pos0 = t0 & (ck.L - 1);
        float w[3][3][2], bb[3][2];
#pragma unroll
        for (int ar = 0; ar < 3; ++ar) {
#pragma unroll
            for (int j = 0; j < 3; ++j) { const f32x2 v = *(const f32x2*)(cw + j * 1536 + ar * 512 + ch); w[ar][j][0] = v.x; w[ar][j][1] = v.y; }
            const f32x2 v = *(const f32x2*)(cb + ar * 512 + ch); bb[ar][0] = v.x; bb[ar][1] = v.y; }
        const bf16* r0 = U + (size_t)t0 * UP + ch;
        unsigned pv[3], cv[3], nv[3];
#pragma unroll
        for (int ar = 0; ar < 3; ++ar) { pv[ar] = pos0 > 0 ? *(const unsigned*)(r0 - UP + ar * 512) : 0u; cv[ar] = *(const unsigned*)(r0 + ar * 512); }
#pragma unroll 4
        for (int t = 0; t < 16; ++t) {
            const bf16* rt = r0 + (size_t)t * UP; const bool last = (pos0 + t + 1 >= ck.L);
#pragma unroll
            for (int ar = 0; ar < 3; ++ar) nv[ar] = last ? 0u : *(const unsigned*)(rt + UP + ar * 512);
            const unsigned gw = *(const unsigned*)(rt + C_HG);
            float o[3][2];
#pragma unroll
            for (int ar = 0; ar < 3; ++ar) { o[ar][0] = w[ar][0][0] * bflo(pv[ar]) + w[ar][1][0] * bflo(cv[ar]) + w[ar][2][0] * bflo(nv[ar]) + bb[ar][0];
                o[ar][1] = w[ar][0][1] * bfhi(pv[ar]) + w[ar][1][1] * bfhi(cv[ar]) + w[ar][2][1] * bfhi(nv[ar]) + bb[ar][1]; pv[ar] = cv[ar]; cv[ar] = nv[ar]; }
            th[lane * 17 + t] = (f32x2){o[2][0] * o[1][0], o[2][1] * o[1][1]};
            tp[lane * 17 + t] = (f32x2){o[0][0] * silu(bflo(gw)), o[0][1] * silu(bfhi(gw))};
        }
        asm volatile("s_waitcnt lgkmcnt(0)" ::: "memory");
#pragma unroll 4
        for (int i = 0; i < 16; ++i) { const int pl = 4 * i + (lane >> 4), tt = lane & 15; const size_t o = (size_t)(cbk * 64 + pl) * CH + t0 + tt;
            HVP[o] = th[pl * 17 + tt]; PMP[o] = tp[pl * 17 + tt]; }
        asm volatile("s_waitcnt lgkmcnt(0)" ::: "memory");
    }
}
typedef short bf16x8 __attribute__((ext_vector_type(8)));
typedef short s16x4 __attribute__((ext_vector_type(4)));
typedef float f32x16 __attribute__((ext_vector_type(16)));
typedef float f32x2_t __attribute__((ext_vector_type(2)));
typedef __bf16 bf16x2_t __attribute__((ext_vector_type(2)));
__device__ __forceinline__ unsigned cvtpk(float lo, float hi) { f32x2_t v = {lo, hi}; bf16x2_t b = __builtin_convertvector(v, bf16x2_t); return __builtin_bit_cast(unsigned, b); }
__device__ __forceinline__ int crow(int r, int hi) { return (r & 3) + 8 * (r >> 2) + 4 * hi; }
__device__ __forceinline__ s16x4 vtr(const LAS unsigned char* p) { return __builtin_bit_cast(s16x4, __builtin_amdgcn_ds_read_tr16_b64_v4i16((LAS s16x4*)p)); }
constexpr int ATT_K = 0;
constexpr int ATT_TB_DIFF = 4 * 8192 + 4 * 16384;
constexpr float C1 = 0.125f * LOG2E;
__device__ __forceinline__ void glds16(const void* gsrc, unsigned lds_dst) { unsigned keep;
    asm volatile("s_mov_b32 %0, m0\n\ts_mov_b32 m0, %2\n\ts_nop 0\n\tglobal_load_lds_dwordx4 %1, off\n\ts_mov_b32 m0, %0" : "=&s"(keep) : "v"(gsrc), "s"(lds_dst) : "memory"); }

template <int VD, bool BIAS, bool OMAX, int G>
__device__ __forceinline__ void flash_pass(LAS unsigned char* lds, const bf16* Qrow, const bf16* Kg, const bf16* Vg, int L, int qpos, int qw0, float bl, float br, f32x16 (&o)[VD / 32], float& l_out) {
    const int tid = ltid(), lane = tid & 63, r32 = lane & 31, hi = lane >> 5;
    constexpr int VROW = VD * 2, VT = 64 * VROW, NVL = VD / 64, NSL = 2 * G, ATT_V = NSL * 8192, ATT_TB = ATT_V + NSL * VT;
    const LAS float* tb = (const LAS float*)(lds + ATT_TB);
    typedef const __attribute__((address_space(1))) u32x4* g4p;
    const int wv = __builtin_amdgcn_readfirstlane(tid >> 6); const int ldsa = (int)(unsigned)(uintptr_t)lds;
    const bf16* ksrc; { const int X = wv * 1024 + lane * 16, line = X >> 8, c16 = ((X >> 4) & 15) ^ (line & 15), key = 2 * line + (c16 >> 3), ch = c16 & 7; ksrc = Kg + (size_t)key * UP + ch * 8; }
    const bf16* vsrc[NVL];
#pragma unroll
    for (int i = 0; i < NVL; ++i) { const int X = i * 8192 + wv * 1024 + lane * 16; const int key = (VD == 64) ? (X >> 7) : (X >> 8), posb = (VD == 64) ? (X & 127) : (X & 255);
        const int swz = (VD == 64) ? (((key >> 1) & 1) << 6) : ((key & 3) << 6); vsrc[i] = Vg + (size_t)key * UP + ((posb ^ swz) >> 1); }
#define ATT_DMA(tt_, sl_) do { const size_t go_ = (size_t)(tt_) * 64 * UP; \
        glds16(ksrc + go_, (unsigned)__builtin_amdgcn_readfirstlane(ldsa + ATT_K + (sl_) * 8192 + wv * 1024)); \
        _Pragma("unroll") for (int i_ = 0; i_ < NVL; ++i_) glds16(vsrc[i_] + go_, (unsigned)__builtin_amdgcn_readfirstlane(ldsa + ATT_V + (sl_) * VT + i_ * 8192 + wv * 1024)); } while (0)
#define ATT_DMAGROUP(g_) do { _Pragma("unroll") for (int j_ = 0; j_ < G; ++j_) { const int tt_ = (g_) * G + j_; ATT_DMA(tt_, tt_ & (NSL - 1)); } } while (0)
#define ATT_BAR() do { __builtin_amdgcn_s_barrier(); asm volatile("" ::: "memory"); } while (0)
    int koff[2][4];
#pragma unroll
    for (int kb = 0; kb < 2; ++kb)
#pragma unroll
        for (int s = 0; s < 4; ++s) { const int key = 32 * kb + r32, line = key >> 1, c16 = ((key & 1) << 3) | (2 * s + hi); koff[kb][s] = line * 256 + ((c16 ^ (line & 15)) << 4); }
    const int q4 = (lane & 15) >> 2, p4 = lane & 3, g1 = (lane >> 4) & 1;
    const int vsw = (VD == 64) ? ((q4 >> 1) & 1) : q4;
    const int vbase = (4 * hi + q4) * VROW + 32 * g1 + 8 * p4;
    bf16x8 qf[4];
#pragma unroll
    for (int s = 0; s < 4; ++s) qf[s] = __builtin_bit_cast(bf16x8, *(g4p)(Qrow + 16 * s + 8 * hi));
    float m_run = OMAX ? -1e30f : 0.f, l_run = 0.f;
    const int nt = L >> 6;
    asm volatile("" :: "v"(qf[0]), "v"(qf[1]), "v"(qf[2]), "v"(qf[3]) : "memory");
    asm volatile("s_waitcnt vmcnt(0)" ::: "memory");
    const int ng = nt / G;
    ATT_DMAGROUP(0); if (ng > 1) ATT_DMAGROUP(1);
    if (ng > 1) { if (G * (1 + NVL) == 8) asm volatile("s_waitcnt vmcnt(8)" ::: "memory"); else asm volatile("s_waitcnt vmcnt(6)" ::: "memory"); } else asm volatile("s_waitcnt vmcnt(0)" ::: "memory");
    static_assert(G * (1 + NVL) == 8 || G * (1 + NVL) == 6, "vmcnt immediates above");
    ATT_BAR();
#pragma unroll 1
    for (int t = 0; t < nt; ++t) {
        const int cur = t & (NSL - 1);
        const LAS unsigned char* kbuf = lds + ATT_K + cur * 8192; const LAS unsigned char* vbuf = lds + ATT_V + cur * VT;
        f32x16 p[2];
        { bf16x8 kf[2][4];
#pragma unroll
          for (int kb = 0; kb < 2; ++kb)
#pragma unroll
            for (int s = 0; s < 4; ++s) kf[kb][s] = *(const LAS bf16x8*)(kbuf + koff[kb][s]);
          __builtin_amdgcn_sched_barrier(0);
#pragma unroll
          for (int kb = 0; kb < 2; ++kb) { f32x16 acc;
#pragma unroll
            for (int r = 0; r < 16; ++r) acc[r] = 0.f;
#pragma unroll
            for (int s = 0; s < 4; ++s) acc = __builtin_amdgcn_mfma_f32_32x32x16_bf16(kf[kb][s], qf[s], acc, 0, 0, 0);
            p[kb] = acc; } }
        s16x4 vlo[2][4], vhi[2][4];
#define VREAD(buf_, db_) do { const int cofs_ = (((db_) ^ vsw) << 6); _Pragma("unroll") for (int kb = 0; kb < 2; ++kb) _Pragma("unroll") for (int ss = 0; ss < 2; ++ss) { \
            const LAS unsigned char* vp_ = vbuf + vbase + (32 * kb + 16 * ss) * VROW + cofs_; vlo[buf_][2 * kb + ss] = vtr(vp_); vhi[buf_][2 * kb + ss] = vtr(vp_ + 8 * VROW); } } while (0)
        VREAD(0, 0);
        __builtin_amdgcn_sched_barrier(0);
        const int k0 = t * 64; float mulc, bconst, mx = -3e38f; bool nearT = false;
        const bool domax = (t & 7) == 0;
        if (BIAS) { const int rlo = k0 - qw0 - 31, rhi = k0 + 63 - qw0; nearT = !(rhi <= -128 || rlo >= 128); }
        if (BIAS && nearT) {
#pragma unroll
            for (int kb = 0; kb < 2; ++kb)
#pragma unroll
                for (int r4 = 0; r4 < 4; ++r4) {
#pragma unroll
                    for (int e = 0; e < 4; ++e) { const int r = 4 * r4 + e; int rel = k0 + 32 * kb + crow(r, hi) - qpos; rel = rel < -128 ? -128 : (rel > 128 ? 128 : rel); const float v = p[kb][r] * C1 + tb[rel + 128]; p[kb][r] = v; mx = fmaxf(mx, v); }
                    __builtin_amdgcn_sched_barrier(0); }
            mulc = 1.0f; bconst = 0.f;
        } else {
            if (OMAX && domax) {
#pragma unroll
                for (int kb = 0; kb < 2; ++kb)
#pragma unroll
                    for (int r = 0; r < 16; ++r) mx = fmaxf(mx, p[kb][r]); }
            bconst = BIAS ? (k0 < qw0 ? bl : br) : 0.f; mx = mx * C1 + bconst; mulc = C1;
        }
        if (OMAX && (domax || (BIAS && nearT))) {
            mx = fmaxf(mx, __shfl_xor(mx, 32));
            if (__any(mx > m_run)) { const float mn = fmaxf(m_run, mx), al = __builtin_amdgcn_exp2f(m_run - mn); l_run *= al;
#pragma unroll
                for (int db = 0; db < VD / 32; ++db) o[db] *= al;
                m_run = mn; }
        }
        const f32x2 mul2 = (f32x2){mulc, mulc}, add2 = (f32x2){bconst - m_run, bconst - m_run}; f32x2 ls2 = (f32x2){0.f, 0.f};
#pragma unroll
        for (int kb = 0; kb < 2; ++kb)
#pragma unroll
            for (int r = 0; r < 16; r += 2) { f32x2 v = (f32x2){p[kb][r], p[kb][r + 1]}; v = v * mul2 + add2; f32x2 e; e.x = __builtin_amdgcn_exp2f(v.x); e.y = __builtin_amdgcn_exp2f(v.y); ls2 += e; p[kb][r] = e.x; p[kb][r + 1] = e.y; }
        l_run += ls2.x + ls2.y;
        bf16x8 pk[2][2];
#pragma unroll
        for (int kb = 0; kb < 2; ++kb)
#pragma unroll
            for (int ss = 0; ss < 2; ++ss) { u32x4 w; w.x = cvtpk(p[kb][8 * ss + 0], p[kb][8 * ss + 1]); w.y = cvtpk(p[kb][8 * ss + 2], p[kb][8 * ss + 3]); w.z = cvtpk(p[kb][8 * ss + 4], p[kb][8 * ss + 5]); w.w = cvtpk(p[kb][8 * ss + 6], p[kb][8 * ss + 7]);
                pk[kb][ss] = __builtin_bit_cast(bf16x8, w); }
        __builtin_amdgcn_sched_barrier(0);
#pragma unroll
        for (int db = 0; db < VD / 32; ++db) {
            if (db + 1 < VD / 32) { if ((db + 1) & 1) VREAD(1, db + 1); else VREAD(0, db + 1); }
#pragma unroll
            for (int kb = 0; kb < 2; ++kb)
#pragma unroll
                for (int ss = 0; ss < 2; ++ss) { const bf16x8 vf = (db & 1) ? __builtin_shufflevector(vlo[1][2 * kb + ss], vhi[1][2 * kb + ss], 0, 1, 2, 3, 4, 5, 6, 7) : __builtin_shufflevector(vlo[0][2 * kb + ss], vhi[0][2 * kb + ss], 0, 1, 2, 3, 4, 5, 6, 7);
                    o[db] = __builtin_amdgcn_mfma_f32_32x32x16_bf16(vf, pk[kb][ss], o[db], 0, 0, 0); }
            __builtin_amdgcn_sched_barrier(0); }
#undef VREAD
        if (((t + 1) & (G - 1)) == 0) {
            asm volatile("s_waitcnt vmcnt(0)" ::: "memory"); ATT_BAR();
            const int g2 = (t + 1) / G + 1; if (g2 < ng) ATT_DMAGROUP(g2); }
    }
#undef ATT_DMA
#undef ATT_DMAGROUP
#undef ATT_BAR
    l_out = l_run + __shfl_xor(l_run, 32);
}
__device__ __forceinline__ void gqa_unit(const AV& a, LAS unsigned char* lds, int seqrow0, int L, int h, int qb) {
    const int tid = ltid(), lane = tid & 63, r32 = lane & 31, hi = lane >> 5;
    const bf16* U = (const bf16*)(AWS + WS_U); bf16* Y = (bf16*)(AWS + WS_Y) + (size_t)1 * CH * 512;
    constexpr int G = 4, NSL = 2 * G, VROW = 128, VT = 8192, ATT_V = NSL * 8192;
    typedef const __attribute__((address_space(1))) u32x4* g4p;
    const int wv = __builtin_amdgcn_readfirstlane(tid >> 6); const int ldsa = (int)(unsigned)(uintptr_t)lds;
    const int qw0 = qb * 512 + wv * 64;
    const bf16* Kg = U + (size_t)seqrow0 * UP + C_GK + 64 * (h >> 2); const bf16* Vg = U + (size_t)seqrow0 * UP + C_GV + 64 * (h >> 2);
    const bf16* ksrc; { const int X = wv * 1024 + lane * 16, line = X >> 8, c16 = ((X >> 4) & 15) ^ (line & 15), key = 2 * line + (c16 >> 3), ch = c16 & 7; ksrc = Kg + (size_t)key * UP + ch * 8; }
    const bf16* vsrc; { const int X = wv * 1024 + lane * 16, key = X >> 7, posb = X & 127, swz = ((key >> 1) & 1) << 6; vsrc = Vg + (size_t)key * UP + ((posb ^ swz) >> 1); }
#define GQ_DMA(tt_, sl_) do { const size_t go_ = (size_t)(tt_) * 64 * UP; \
        glds16(ksrc + go_, (unsigned)__builtin_amdgcn_readfirstlane(ldsa + ATT_K + (sl_) * 8192 + wv * 1024)); \
        glds16(vsrc + go_, (unsigned)__builtin_amdgcn_readfirstlane(ldsa + ATT_V + (sl_) * VT + wv * 1024)); } while (0)
#define GQ_DMAGROUP(g_) do { _Pragma("unroll") for (int j_ = 0; j_ < G; ++j_) { const int tt_ = (g_) * G + j_; GQ_DMA(tt_, tt_ & (NSL - 1)); } } while (0)
#define GQ_BAR() do { __builtin_amdgcn_s_barrier(); asm volatile("" ::: "memory"); } while (0)
    int koff[2][4];
#pragma unroll
    for (int kb = 0; kb < 2; ++kb)
#pragma unroll
        for (int s = 0; s < 4; ++s) { const int key = 32 * kb + r32, line = key >> 1, c16 = ((key & 1) << 3) | (2 * s + hi); koff[kb][s] = line * 256 + ((c16 ^ (line & 15)) << 4); }
    const int q4 = (lane & 15) >> 2, p4 = lane & 3, g1 = (lane >> 4) & 1;
    const int vsw = (q4 >> 1) & 1;
    const int vbase = (4 * hi + q4) * VROW + 32 * g1 + 8 * p4;
    bf16x8 qf[2][4];
#pragma unroll
    for (int j = 0; j < 2; ++j)
#pragma unroll
        for (int s = 0; s < 4; ++s) qf[j][s] = __builtin_bit_cast(bf16x8, *(g4p)(U + (size_t)(seqrow0 + qw0 + 32 * j + r32) * UP + C_GQ + 64 * h + 16 * s + 8 * hi));
    f32x16 o[2][2];
#pragma unroll
    for (int j = 0; j < 2; ++j)
#pragma unroll
        for (int db = 0; db < 2; ++db)
#pragma unroll
            for (int r = 0; r < 16; ++r) o[j][db][r] = 0.f;
    float lrun[2] = {0.f, 0.f};
    const int nt = L >> 6, ng = nt / G;
    asm volatile("" :: "v"(qf[0][0]), "v"(qf[0][1]), "v"(qf[0][2]), "v"(qf[0][3]), "v"(qf[1][0]), "v"(qf[1][1]), "v"(qf[1][2]), "v"(qf[1][3]) : "memory");
    asm volatile("s_waitcnt vmcnt(0)" ::: "memory");
    GQ_DMAGROUP(0); if (ng > 1) GQ_DMAGROUP(1);
    if (ng > 1) asm volatile("s_waitcnt vmcnt(8)" ::: "memory"); else asm volatile("s_waitcnt vmcnt(0)" ::: "memory");
    GQ_BAR();
#pragma unroll 1
    for (int t = 0; t < nt; ++t) {
        const int cur = t & (NSL - 1);
        const LAS unsigned char* kbuf = lds + ATT_K + cur * 8192; const LAS unsigned char* vbuf = lds + ATT_V + cur * VT;
        f32x16 p[2][2];
        { bf16x8 kf[2][4];
#pragma unroll
          for (int kb = 0; kb < 2; ++kb)
#pragma unroll
            for (int s = 0; s < 4; ++s) kf[kb][s] = *(const LAS bf16x8*)(kbuf + koff[kb][s]);
          __builtin_amdgcn_sched_barrier(0);
#pragma unroll
          for (int kb = 0; kb < 2; ++kb)
#pragma unroll
            for (int j = 0; j < 2; ++j) { f32x16 acc;
#pragma unroll
              for (int r = 0; r < 16; ++r) acc[r] = 0.f;
#pragma unroll
              for (int s = 0; s < 4; ++s) acc = __builtin_amdgcn_mfma_f32_32x32x16_bf16(kf[kb][s], qf[j][s], acc, 0, 0, 0);
              p[j][kb] = acc; } }
        s16x4 vlo[2][4], vhi[2][4];
#define GQ_VREAD(buf_, db_) do { const int cofs_ = (((db_) ^ vsw) << 6); _Pragma("unroll") for (int kb = 0; kb < 2; ++kb) _Pragma("unroll") for (int ss = 0; ss < 2; ++ss) { \
            const LAS unsigned char* vp_ = vbuf + vbase + (32 * kb + 16 * ss) * VROW + cofs_; vlo[buf_][2 * kb + ss] = vtr(vp_); vhi[buf_][2 * kb + ss] = vtr(vp_ + 8 * VROW); } } while (0)
        bf16x8 pk[2][2][2];
#pragma unroll
        for (int j = 0; j < 2; ++j) { float ls0 = 0.f, ls1 = 0.f;
#pragma unroll
            for (int kb = 0; kb < 2; ++kb) {
#pragma unroll
                for (int r = 0; r < 16; r += 2) { const float e0 = __builtin_amdgcn_exp2f(p[j][kb][r]), e1 = __builtin_amdgcn_exp2f(p[j][kb][r + 1]); ls0 += e0; ls1 += e1; p[j][kb][r] = e0; p[j][kb][r + 1] = e1; }
#pragma unroll
                for (int ss = 0; ss < 2; ++ss) { u32x4 w; w.x = cvtpk(p[j][kb][8 * ss + 0], p[j][kb][8 * ss + 1]); w.y = cvtpk(p[j][kb][8 * ss + 2], p[j][kb][8 * ss + 3]); w.z = cvtpk(p[j][kb][8 * ss + 4], p[j][kb][8 * ss + 5]); w.w = cvtpk(p[j][kb][8 * ss + 6], p[j][kb][8 * ss + 7]);
                    pk[j][kb][ss] = __builtin_bit_cast(bf16x8, w); } }
            lrun[j] += ls0 + ls1; }
        __builtin_amdgcn_sched_barrier(0);
        GQ_VREAD(0, 0); GQ_VREAD(1, 1);
#pragma unroll
        for (int db = 0; db < 2; ++db) {
#pragma unroll
            for (int kb = 0; kb < 2; ++kb)
#pragma unroll
                for (int ss = 0; ss < 2; ++ss) { const bf16x8 vf = db ? __builtin_shufflevector(vlo[1][2 * kb + ss], vhi[1][2 * kb + ss], 0, 1, 2, 3, 4, 5, 6, 7) : __builtin_shufflevector(vlo[0][2 * kb + ss], vhi[0][2 * kb + ss], 0, 1, 2, 3, 4, 5, 6, 7);
#pragma unroll
                    for (int j = 0; j < 2; ++j) o[j][db] = __builtin_amdgcn_mfma_f32_32x32x16_bf16(vf, pk[j][kb][ss], o[j][db], 0, 0, 0); }
            __builtin_amdgcn_sched_barrier(0); }
#undef GQ_VREAD
        if (((t + 1) & (G - 1)) == 0) { asm volatile("s_waitcnt vmcnt(0)" ::: "memory"); GQ_BAR(); const int g2 = (t + 1) / G + 1; if (g2 < ng) GQ_DMAGROUP(g2); }
    }
#undef GQ_DMA
#undef GQ_DMAGROUP
#undef GQ_BAR
#pragma unroll
    for (int j = 0; j < 2; ++j) { const float l = lrun[j] + __shfl_xor(lrun[j], 32); const float inv = 1.0f / l; const size_t row = (size_t)(seqrow0 + qw0 + 32 * j + r32);
#pragma unroll
        for (int db = 0; db < 2; ++db)
#pragma unroll
            for (int g = 0; g < 4; ++g) { const int d = 32 * db + 8 * g + 4 * hi; const u32x2 gw = *(const u32x2*)(U + row * UP + C_GG + 64 * h + d);
                const float y0 = o[j][db][4 * g] * inv * silu(bflo(gw.x)), y1 = o[j][db][4 * g + 1] * inv * silu(bfhi(gw.x)), y2 = o[j][db][4 * g + 2] * inv * silu(bflo(gw.y)), y3 = o[j][db][4 * g + 3] * inv * silu(bfhi(gw.y));
                u32x2 w; w.x = cvtpk(y0, y1); w.y = cvtpk(y2, y3); *(u32x2*)(Y + row * 512 + 64 * h + d) = w; } }
}
__device__ __forceinline__ void diff_unit(const AV& a, LAS unsigned char* lds, int seqrow0, int L, int h, int qb, int layer) {
    const int tid = ltid(), lane = tid & 63, wave = tid >> 6, r32 = lane & 31, hi = lane >> 5;
    const bf16* U = (const bf16*)(AWS + WS_U); bf16* Y = (bf16*)(AWS + WS_Y) + (size_t)2 * CH * 512; float* DT = (float*)(AWS + WS_DT);
    const float* relb = AIN(I_RELB);
    LAS float* tb = (LAS float*)(lds + ATT_TB_DIFF);
    for (int i = tid; i < 257; i += NT) { const int rel = i - 128, n = rel < 0 ? -rel : rel; int b = rel > 0 ? 16 : 0;
        if (n < 8) b += n; else { const int v = 8 + (31 - __builtin_clz((unsigned)(n * n))) - 6; b += v < 15 ? v : 15; }
        tb[i] = relb[b * 4 + h] * LOG2E; }
    const float bl = relb[15 * 4 + h] * LOG2E, br = relb[31 * 4 + h] * LOG2E;
    const float li = 0.8f - 0.6f * __expf(-0.3f * (float)layer);
    float d1, d2; { const float q1 = AIN(I_LQ1)[layer * 64 + lane], k1 = AIN(I_LK1)[layer * 64 + lane], q2 = AIN(I_LQ2)[layer * 64 + lane], k2 = AIN(I_LK2)[layer * 64 + lane]; d1 = wave_sum(q1 * k1); d2 = wave_sum(q2 * k2); }
    const float lam = __expf(d1) - __expf(d2) + li;
    const int qw0 = qb * 256 + wave * 32, qpos = qw0 + r32; const size_t row = (size_t)(seqrow0 + qpos);
    __syncthreads();
    f32x16 o[4]; float l; float ss = 0.f;
#pragma unroll 1
    for (int c = 0; c < 2; ++c) {
#pragma unroll
        for (int db = 0; db < 4; ++db)
#pragma unroll
            for (int r = 0; r < 16; ++r) o[db][r] = 0.f;
        flash_pass<128, true, true, 2>(lds, U + row * UP + C_DQ + 128 * h + 64 * c, U + (size_t)seqrow0 * UP + C_DK + 128 * h + 64 * c, U + (size_t)seqrow0 * UP + C_DV + 128 * h, L, qpos, qw0, bl, br, o, l);
        if (c == 0) { const float inv = 1.0f / l;
#pragma unroll
            for (int db = 0; db < 4; ++db)
#pragma unroll
                for (int g = 0; g < 4; ++g) { const int d = 32 * db + 8 * g + 4 * hi; *(f32x4*)(DT + row * 512 + 128 * h + d) = (f32x4){o[db][4 * g] * inv, o[db][4 * g + 1] * inv, o[db][4 * g + 2] * inv, o[db][4 * g + 3] * inv}; }
        } else { const float inv = lam / l;
#pragma unroll
            for (int db = 0; db < 4; ++db)
#pragma unroll
                for (int g = 0; g < 4; ++g) { const int d = 32 * db + 8 * g + 4 * hi; const f32x4 o0 = *(const f32x4*)(DT + row * 512 + 128 * h + d);
#pragma unroll
                    for (int e = 0; e < 4; ++e) { const float v = o0[e] - o[db][4 * g + e] * inv; o[db][4 * g + e] = v; ss += v * v; } }
        }
    }
    ss += __shfl_xor(ss, 32);
    const float rs = (1.0f / sqrtf(ss * (1.0f / 128.0f) + EPS)) * (1.0f - li);
    const float* sg = AIN(I_SUBLN) + layer * 128;
#pragma unroll
    for (int db = 0; db < 4; ++db)
#pragma unroll
        for (int g = 0; g < 4; ++g) { const int d = 32 * db + 8 * g + 4 * hi; const u32x2 gw = *(const u32x2*)(U + row * UP + C_DG + 128 * h + d); const f32x4 gn = *(const f32x4*)(sg + d);
            const float y0 = o[db][4 * g] * rs * gn.x * silu(bflo(gw.x)), y1 = o[db][4 * g + 1] * rs * gn.y * silu(bfhi(gw.x)), y2 = o[db][4 * g + 2] * rs * gn.z * silu(bflo(gw.y)), y3 = o[db][4 * g + 3] * rs * gn.w * silu(bfhi(gw.y));
            u32x2 w; w.x = cvtpk(y0, y1); w.y = cvtpk(y2, y3); *(u32x2*)(Y + row * 512 + 128 * h + d) = w; }
}
template <int LOG4, int BATCH> __device__ __forceinline__ void hyena_unit(const AV& a, LAS unsigned char* lds, int seqrow0, int pr0, int layer) {
    constexpr int N = 1 << (2 * LOG4), L = N / 2, NPAD = N + N / 16;
    const int tid = ltid(); LAS f32x2* buf = (LAS f32x2*)lds;
    bf16* Y = (bf16*)(AWS + WS_Y) + (size_t)seqrow0 * 512;
    const unsigned char* sp = AWS + WS_SPEC + layer * SPEC_LAYER;
    constexpr int SPS = (LOG4 == 7) ? SPS_P : SPS_S;
    const f32x2* Pg = ((LOG4 == 7) ? (const f32x2*)sp : (const f32x2*)(sp + 2 * SPEC_P_BYTES)) + (size_t)pr0 * SPS;
    const f32x2* Mg = ((LOG4 == 7) ? (const f32x2*)(sp + SPEC_P_BYTES) : (const f32x2*)(sp + 2 * SPEC_P_BYTES + SPEC_S_BYTES)) + (size_t)pr0 * SPS;
    const f32x2* hvp = (const f32x2*)(AWS + WS_HVP) + (size_t)pr0 * CH + seqrow0; const f32x2* pmp = (const f32x2*)(AWS + WS_PMP) + (size_t)pr0 * CH + seqrow0;
#pragma unroll
    for (int b = 0; b < BATCH; ++b)
        for (int t = tid; t < L; t += NT) { buf[b * NPAD + PADI(t)] = hvp[(size_t)b * CH + t]; buf[b * NPAD + PADI(t + L)] = (f32x2){0.f, 0.f}; }
    __syncthreads();
    const f32x2* tw = (const f32x2*)(AWS + WS_TW);
    fft_fwd<LOG4, BATCH>(buf, tw, tid);
#pragma unroll
    for (int b = 0; b < BATCH; ++b)
        for (int k = tid; k <= L; k += NT) { const int p1 = b * NPAD + PADI(digitrev<LOG4>(k)), p2 = b * NPAD + PADI(digitrev<LOG4>((N - k) & (N - 1))); const f32x2 z1 = buf[p1], z2 = buf[p2], P = Pg[(size_t)b * SPS + k], M = Mg[(size_t)b * SPS + k];
            const f32x2 y1 = cmul(z1, P) + cmul(cconj(z2), M), y2 = cmulc(z2, P) + cmulc(cconj(z1), M);
            buf[p1] = y1; if (p2 != p1) buf[p2] = y2; }
    __syncthreads();
    fft_inv<LOG4, BATCH>(buf, tw, tid);
    for (int t = tid; t < L; t += NT) { unsigned w[BATCH];
#pragma unroll
        for (int b = 0; b < BATCH; ++b) { const f32x2 y = buf[b * NPAD + PADI(t)], m = pmp[(size_t)b * CH + t]; w[b] = cvtpk(y.x * m.x, y.y * m.y); }
        if (BATCH == 4) *(u32x4*)(Y + (size_t)t * 512 + 2 * pr0) = (u32x4){w[0], w[BATCH > 1 ? 1 : 0], w[BATCH > 2 ? 2 : 0], w[BATCH > 3 ? 3 : 0]};
        else *(unsigned*)(Y + (size_t)t * 512 + 2 * pr0) = w[0]; }
    __syncthreads();
}
#define XB_TMO      128
#define XB_XCNT(j)  (256  + 64 * (j))
#define XB_XSUB(j)  (1280 + 64 * (j))
#define XB_XGEN(j)  (2304 + 64 * (j))
#define XB_TOP      3328
#define XB_TOPGEN   3392
#define XCD_BAR_WORDS 3456
#define XB_SPIN_CAP (1u << 18)

__device__ __forceinline__ unsigned xb_ld(unsigned* p)              { return __hip_atomic_load(p, __ATOMIC_RELAXED, __HIP_MEMORY_SCOPE_AGENT); }
__device__ __forceinline__ unsigned xb_add(unsigned* p, unsigned v) { return __hip_atomic_fetch_add(p, v, __ATOMIC_RELAXED, __HIP_MEMORY_SCOPE_AGENT); }
__device__ __forceinline__ unsigned xb_xcc_id() { return (unsigned)__builtin_amdgcn_s_getreg((3 << 11) | 20) & 0xFu; }
#define XB_SPIN(cond, bar) do { unsigned _sp = 0; while (cond) { __builtin_amdgcn_s_sleep(1); \
    if ((++_sp & 255u) == 0u) { if (xb_ld(&(bar)[XB_TMO])) break; if (_sp > XB_SPIN_CAP) { atomicAdd(&(bar)[XB_TMO], 1u); break; } } } } while (0)

struct XcdBarrier {
    unsigned* bar; unsigned x;
    volatile LAS unsigned* st;
};

__device__ __forceinline__ XcdBarrier xcd_barrier_post(unsigned* bar, volatile LAS unsigned* st) {
    XcdBarrier b; b.bar = bar; b.x = xb_xcc_id(); b.st = st;
    if (threadIdx.x == 0) (void)xb_add(&bar[XB_XCNT(b.x)], 1u);
    return b;
}
__device__ __forceinline__ void xcd_barrier_complete(unsigned* bar, unsigned x, unsigned& nloc, unsigned& nx) {
    const unsigned G = gridDim.x * gridDim.y * gridDim.z;
    unsigned sum, cnt, mine, sp = 0u;
    for (;;) {
        sum = 0u; cnt = 0u; mine = 0u;
#pragma unroll
        for (unsigned j = 0; j < 16; ++j) { const unsigned c = xb_ld(&bar[XB_XCNT(j)]); sum += c; cnt += (c > 0u) ? 1u : 0u; mine = (j == x) ? c : mine; }
        if (sum == G) break;
        __builtin_amdgcn_s_sleep(1);
        if ((++sp & 255u) == 0u) { if (xb_ld(&bar[XB_TMO])) break; if (sp > XB_SPIN_CAP) { atomicAdd(&bar[XB_TMO], 1u); break; } }
    }
    nloc = mine > 0u ? mine : 1u; nx = cnt > 0u ? cnt : 1u;
}

__device__ __forceinline__ void xcd_barrier(const XcdBarrier& b) {
    asm volatile("s_waitcnt vmcnt(0)" ::: "memory");
    __syncthreads();
    if (threadIdx.x == 0) {
        unsigned* bar = b.bar;
        __builtin_amdgcn_s_waitcnt(0);
        unsigned nloc = b.st[0], nx = b.st[1];
        if (nloc == 0u) { xcd_barrier_complete(bar, b.x, nloc, nx); b.st[0] = nloc; b.st[1] = nx; }
        const unsigned old = xb_add(&bar[XB_XSUB(b.x)], 1u);
        const unsigned gen = old / nloc;
        if (old + 1u == (gen + 1u) * nloc) {
            __builtin_amdgcn_fence(__ATOMIC_RELEASE, "agent");
            asm volatile("s_waitcnt vmcnt(0)" ::: "memory");
            const unsigned og = xb_add(&bar[XB_TOP], 1u);
            const unsigned tg = og / nx;
            if (og + 1u == (tg + 1u) * nx) xb_add(&bar[XB_TOPGEN], 1u);
            else XB_SPIN(xb_ld(&bar[XB_TOPGEN]) == tg, bar);
            __builtin_amdgcn_fence(__ATOMIC_ACQUIRE, "agent");
            xb_add(&bar[XB_XGEN(b.x)], 1u);
            asm volatile("s_waitcnt vmcnt(0)" ::: "memory");
        } else {
            XB_SPIN(xb_ld(&bar[XB_XGEN(b.x)]) == gen, bar);
            __builtin_amdgcn_fence(__ATOMIC_ACQUIRE, "agent");
            asm volatile("s_waitcnt vmcnt(0)" ::: "memory");
        }
    }
    __syncthreads();
}

__device__ __forceinline__ void step_mix(const AV& a, LAS unsigned char* lds, int c, int layer, unsigned* ctr, int tmask) {
    const Chunk ck = chunk_of(c); const int nqb = ck.L / 256, nqg = ck.L / 512, nD = ck.nseq * 4 * nqb, nG = ck.nseq * 8 * nqg, nF = (ck.L == LP) ? ck.nseq * 256 : ck.nseq * 64, total = nD + nG + nF;
    volatile LAS unsigned* wq = (volatile LAS unsigned*)(lds + LDS_MAIN);
    for (;;) {
        if (ltid() == 0) wq[0] = atomicAdd(ctr, 1u);
        __syncthreads();
        const int u = (int)wq[0];
        __syncthreads();
        if (u >= total) break;
        if (u < nD) { if (tmask & 1) { const int qb = u % nqb, sh = u / nqb, h = sh & 3, s = sh >> 2; diff_unit(a, lds, s * ck.L, ck.L, h, qb, layer); } }
        else if (u < nD + nG) { if (tmask & 2) { const int v = u - nD, qb = v % nqg, sh = v / nqg, h = sh & 7, s = sh >> 3; gqa_unit(a, lds, s * ck.L, ck.L, h, qb); } }
        else { if (tmask & 4) { const int v = u - nD - nG; if (ck.L == LP) hyena_unit<7, 1>(a, lds, (v >> 8) * LP, v & 255, layer); else hyena_unit<6, 4>(a, lds, (v >> 6) * LS, (v & 63) * 4, layer); } }
    }
}
constexpr int STEPS_PER = 6, NPRO = 3, NSTEPS = NPRO + NCHUNK * 2 * STEPS_PER + 1;
__global__ void __launch_bounds__(NT, 2) mega_fwd(Args kargs) {
    extern __shared__ __attribute__((aligned(16))) unsigned char lds_raw[];
    LAS unsigned char* lds = (LAS unsigned char*)lds_raw;
    cg::grid_group grid = cg::this_grid();
    kargp_t kp = (kargp_t)__builtin_amdgcn_kernarg_segment_ptr();
    { volatile LAS unsigned* misc = (volatile LAS unsigned*)(lds + LDS_MAIN + 64); if (ltid() < 16) misc[ltid()] = 0u; }
    __syncthreads();
    XcdBarrier xbar = xcd_barrier_post((unsigned*)(kargs.ws + WS_CTL) + CW_BAR, (volatile LAS unsigned*)(lds + LDS_MAIN + 64 + 32));
    const int step_lo = kargs.lo, step_hi = kargs.hi;
#pragma unroll 1
    for (int step = step_lo; step < step_hi; ++step) {
        asm volatile("" : "+s"(kp));
        AV a; a.p = kp; unsigned char* ws = AWS;
        if (step == 0) { if (EN(0)) step_pro_a(a, lds); }
        else if (step == 1) { if (EN(11)) { step_pro_a2(a, lds); if (DUP_MASK & 32) { xcd_barrier(xbar); step_pro_a2(a, lds); } } }
        else if (step == 2) { if (EN(1)) { step_pro_b(a, lds); if (DUP_MASK & 64) { xcd_barrier(xbar); step_pro_b(a, lds); } } }
        else if (step == NSTEPS - 1) { if (DUP_MASK & 256) { for (int q = 0; q < 100; ++q) xcd_barrier(xbar); } if (EN(2)) step_final(a, (NCHUNK - 1) * CH, NTOK); }
        else {
            const int s2 = step - NPRO, cl = s2 / STEPS_PER, k = s2 - cl * STEPS_PER, c = cl >> 1, layer = cl & 1;
            const Chunk ck = chunk_of(c);
            if (k == 0) { if (layer == 0) { if (c > 0 && EN(2)) step_final(a, (c - 1) * CH, c * CH); continue; }
                if (EN(3)) { step_norm(a, c, layer); if (DUP_MASK & 128) { xcd_barrier(xbar); step_norm(a, c, layer); } } }
            else if (k == 2) { if (EN(5)) { step_prep(a, c, layer); step_prep_hy(a, lds, c, layer); } }
            else if (k == 3) {
#pragma unroll 1
                for (int rep = 0; rep < ((DUP_MASK & 7) ? 2 : 1); ++rep) { if (rep) xcd_barrier(xbar); step_mix(a, lds, c, layer, (unsigned*)(ws + WS_CTL) + step * 16 + 4 * rep, rep ? (DUP_MASK & 7) : 7); } }
            else { if (EN(4)) {
                pg8::Gemm g; pg8::OrderAll S; pg8::EpiAll E; const int G = (int)gridDim.x, bid = lbid();
                S.so.init(CH, k == 1 ? NCAT : 1024, G, bid); S.o2 = pg8::OrderG2{CH / 256, G, bid}; S.mode = (k == 4) ? 2 : 1;
                float* O = AOUT + (size_t)ck.tok0 * DM; const float* X = layer == 0 ? xin_rows(a, ck.tok0) : O;
                E.mode = (k == 1) ? 1 : (k == 4) ? 2 : 3;
                E.e1 = pg8::EpiG1{(pg8::bf16_t*)(ws + WS_U), (pg8::bf16_t*)(ws + WS_G), AIN(I_BMERGE) + layer * GP};
                E.e2 = pg8::EpiG2{(const pg8::bf16_t*)(ws + WS_G), (float*)(ws + WS_TMP), (pg8::bf16_t*)(ws + WS_MG), CH / 256};
                E.e3 = pg8::EpiG3{X, O};
                if (k == 1) g = pg8::Gemm{layer == 0 ? (const pg8::bf16_t*)(ws + WS_HN0) + (size_t)ck.tok0 * DM : (const pg8::bf16_t*)(ws + WS_HN), (const pg8::bf16_t*)(ws + WS_WCAT + layer * WCAT_BYTES), CH, NCAT, 1024};
                else if (k == 4) g = pg8::Gemm{(const pg8::bf16_t*)(ws + WS_Y), (const pg8::bf16_t*)(ws + WS_WBT + layer * WBT_BYTES), 3 * CH, 3072, 512};
                else g = pg8::Gemm{(const pg8::bf16_t*)(ws + WS_MG), (const pg8::bf16_t*)(ws + WS_WOT + layer * WOT_BYTES), CH, 1024, 1024};
                const int nrep = (((DUP_MASK & 8) && k == 1) || ((DUP_MASK & 16) && k == 4)) ? 2 : 1;
#pragma unroll 1
                for (int rep = 0; rep < nrep; ++rep) { if (rep) xcd_barrier(xbar); pg8::gemm_phase<pg8::EpiAll, pg8::OrderAll, true, true>(lds, g, S, E); }
            } }
        }
        if (step + 1 < step_hi) { if (step == 0) grid.sync(); else xcd_barrier(xbar); }
    }
}
#ifndef MK_MULTI
#define MK_MULTI 0
#endif
extern "C" void kernel_launch(void* const* d_in, const int* in_sizes, int n_in, void* d_out, int out_size, void* d_ws, size_t ws_size, hipStream_t stream) {
    static int grid = 0;
    if (grid == 0) {
        if (n_in != N_IN || out_size != NTOK * DM || ws_size < WS_END) { fprintf(stderr, "kernel_launch: unexpected shapes (n_in %d, out %d, ws %zu)\n", n_in, out_size, ws_size); grid = -1; return; }
        int dev = 0, cus = 0, per_cu = 0;
        hipGetDevice(&dev); hipDeviceGetAttribute(&cus, hipDeviceAttributeMultiprocessorCount, dev);
        if (hipFuncSetAttribute((const void*)mega_fwd, hipFuncAttributeMaxDynamicSharedMemorySize, LDS_BYTES) != hipSuccess) { fprintf(stderr, "kernel_launch: hipFuncSetAttribute failed\n"); grid = -1; return; }
        hipOccupancyMaxActiveBlocksPerMultiprocessor(&per_cu, (const void*)mega_fwd, NT, LDS_BYTES);
        (void)hipGetLastError();
        if (per_cu < 1) per_cu = 1;
        grid = cus * 1;
        fprintf(stderr, "kernel_launch: cus %d per_cu %d grid %d\n", cus, per_cu, grid);
    }
    if (grid < 0) return;
    hipMemsetAsync((char*)d_ws + WS_CTL, 0, CTL_BYTES, stream);
    Args a{};
    for (int i = 0; i < N_IN; ++i) a.in[i] = (const float*)d_in[i];
    a.out = (float*)d_out; a.ws = (unsigned char*)d_ws;
#if MK_MULTI
    for (int s = 0; s < NSTEPS; ++s) { a.lo = s; a.hi = s + 1; hipLaunchKernelGGL(mega_fwd, dim3(grid), dim3(NT), LDS_BYTES, stream, a); }
#else
    a.lo = 0; a.hi = NSTEPS;
    void* args[] = {&a};
    hipError_t e = hipLaunchCooperativeKernel((const void*)mega_fwd, dim3(grid), dim3(NT), args, LDS_BYTES, stream);
    if (e != hipSuccess) fprintf(stderr, "cooperative launch failed: %s (grid %d)\n", hipGetErrorString(e), grid);
#endif
}
```

```cpp
#include <hip/hip_runtime.h>
#include <hip/hip_cooperative_groups.h>
#include <cstdio>
#include <cstdint>
namespace cg = cooperative_groups;
__device__ __forceinline__ int ltid() { int t = (int)threadIdx.x; asm volatile("" : "+v"(t)); return t; }
__device__ __forceinline__ float shx(float v, int o) { const int l = ltid() & 63; return __int_as_float(__builtin_amdgcn_ds_bpermute((l ^ o) << 2, __float_as_int(v))); }
__device__ __forceinline__ int lbid() { int b = (int)blockIdx.x; asm volatile("" : "+s"(b)); return b; }
namespace pg8 {
#define PG8_LAS __attribute__((address_space(3)))
typedef unsigned short bf16_t;
typedef short bf16x8 __attribute__((ext_vector_type(8)));
typedef float f32x4 __attribute__((ext_vector_type(4)));
typedef unsigned u32x4 __attribute__((ext_vector_type(4)));
constexpr int BM = 256, BK = 64, HALF = 128, HTB = HALF * BK * 2  , STAGE_BYTES = 8 * HTB, NXCD = 8, WGM = 8;

__host__ __device__ __forceinline__ int lds_byte(int r, int c) { const int st = (r >> 4) * 2 + (c >> 5), rr = r & 15, cc = c & 31, ob = rr * 64 + cc * 2; return st * 1024 + (ob ^ (((ob >> 9) & 1) << 5)); }
__host__ __device__ __forceinline__ void stage_rc(int b, int& R, int& C) { const int st = b / 1024, sb = b % 1024, swz = sb ^ (((sb >> 9) & 1) << 5); R = (st >> 1) * 16 + swz / 64; C = (st & 1) * 32 + (swz % 64) / 2; }
__host__ __device__ __forceinline__ int perm32(int rho) { const int n = rho >> 4, i = rho & 15; return 8 * (i >> 2) + 4 * n + (i & 3); }

struct Unit { int pm, pn; };
struct Gemm { const bf16_t* A; const bf16_t* Bt; int M, N, K; };

struct StaticOrder {
    int nM, nN, nwg, G, c;
    __host__ __device__ void init(int M, int N, int G_, int c_) { nM = M / BM; nN = N / BM; nwg = nM * nN; G = G_; c = c_; }
    __host__ __device__ bool next(int i, Unit& u) const {
        const long L = (long)i * G + c; if (L >= nwg) return false;
        int wgid = (int)L; { const int q = nwg / NXCD, r = nwg % NXCD, xcd = wgid % NXCD, off = wgid / NXCD; wgid = (xcd < r ? xcd * (q + 1) : r * (q + 1) + (xcd - r) * q) + off; }
        const int nig = WGM * nN, gid = wgid / nig, fm = gid * WGM, gsz = (nM - fm) < WGM ? (nM - fm) : WGM;
        u.pm = fm + ((wgid % nig) % gsz); u.pn = (wgid % nig) / gsz; return true;
    }
    __device__ __forceinline__ void a_ready(const Unit&) const {}
    __device__ __forceinline__ void done(const Unit&) const {}
};

__device__ __forceinline__ unsigned cvt_pk_bf16(float lo, float hi) { unsigned r; asm volatile("v_cvt_pk_bf16_f32 %0, %1, %2" : "=v"(r) : "v"(lo), "v"(hi)); return r; }
template <class Epi, class Sched, bool ALIGN_EPI = false, bool SP2 = false>
__device__ __forceinline__ void gemm_phase(PG8_LAS unsigned char* lds, const Gemm g, const Sched& S, const Epi& E) {
    const int tid = ltid(), wid = __builtin_amdgcn_readfirstlane(tid >> 6), lane = tid & 63, wr = wid >> 2, wc = wid & 3, fr = lane & 15, fq = lane >> 4;
    const int K = g.K, nt = K / BK;
    unsigned voffA[2], voffB[2];
#pragma unroll
    for (int i = 0; i < 2; ++i) { int R, C; stage_rc(tid * 16 + i * 8192, R, C); const int Rb = Epi::PERM ? ((R & ~31) + perm32(R & 31)) : R;
        voffA[i] = (unsigned)(R * K + C) * 2u; voffB[i] = (unsigned)(Rb * K + C) * 2u; }
    const size_t kstep = (size_t)(BK * 2);
    const size_t hstep = (size_t)HALF * K * 2;
    const size_t tstep = 2 * hstep;
    const unsigned ldsw = (unsigned)wid * 1024u;
    const int aoff = lds_byte(wr * 64 + fr, fq * 8), boff = lds_byte(wc * 32 + fr, fq * 8);
#define PG8_SA(b, h) (((b) * 2 + (h)) * HTB)
#define PG8_SB(b, h) ((4 + (b) * 2 + (h)) * HTB)
#define PG8_STAGE(bufoff, gbase, voff) do { _Pragma("unroll") for (int _i = 0; _i < 2; ++_i) \
        __builtin_amdgcn_global_load_lds((const unsigned*)((const char*)(gbase) + (voff)[_i]), (PG8_LAS unsigned*)(lds + (bufoff) + ldsw + _i * 8192), 16, 0, 0); } while (0)
#define PG8_LDA(dst, b, h) do { _Pragma("unroll") for (int m = 0; m < 4; ++m) _Pragma("unroll") for (int k = 0; k < 2; ++k) dst[m][k] = *(const PG8_LAS bf16x8*)(lds + PG8_SA(b, h) + aoff + m * 2048 + k * 1024); } while (0)
#define PG8_LDB(dst, b, h) do { _Pragma("unroll") for (int n = 0; n < 2; ++n) _Pragma("unroll") for (int k = 0; k < 2; ++k) dst[n][k] = *(const PG8_LAS bf16x8*)(lds + PG8_SB(b, h) + boff + n * 2048 + k * 1024); } while (0)
#define PG8_MMA(ai, bj, At, Bt) do { __builtin_amdgcn_s_setprio(1); _Pragma("unroll") for (int m = 0; m < 4; ++m) _Pragma("unroll") for (int n = 0; n < 2; ++n) _Pragma("unroll") for (int k = 0; k < 2; ++k) \
        acc[ai][bj][m][n] = __builtin_amdgcn_mfma_f32_16x16x32_bf16(Bt[n][k], At[m][k], acc[ai][bj][m][n], 0, 0, 0); __builtin_amdgcn_s_setprio(0); } while (0)
#define PG8_WAIT_V(n) asm volatile("s_waitcnt vmcnt(" #n ")" ::: "memory")
#define PG8_WAIT_L(n) asm volatile("s_waitcnt lgkmcnt(" #n ")" ::: "memory")
#define PG8_BAR __builtin_amdgcn_s_barrier()
#define PG8_SCHED __builtin_amdgcn_sched_barrier(0)
    Unit cur, nxt; int ui = 0;
    if (!S.next(0, cur)) return;
    f32x4 acc[2][2][4][2];
#pragma unroll
    for (int a = 0; a < 2; ++a)
#pragma unroll
        for (int b = 0; b < 2; ++b)
#pragma unroll
            for (int m = 0; m < 4; ++m)
#pragma unroll
                for (int n = 0; n < 2; ++n) acc[a][b][m][n] = (f32x4){0.f, 0.f, 0.f, 0.f};
    bf16x8 At[4][2], B0[2][2], B1[2][2];
    const char* cA = (const char*)g.A + (size_t)cur.pm * tstep; const char* cB = (const char*)g.Bt + (size_t)cur.pn * tstep;
    S.a_ready(cur);
    if constexpr (SP2) {
        PG8_STAGE(PG8_SB(0, 0), cB, voffB); PG8_STAGE(PG8_SB(0, 1), cB + hstep, voffB); PG8_STAGE(PG8_SA(0, 0), cA, voffA); PG8_STAGE(PG8_SA(0, 1), cA + hstep, voffA);
        if (wr == 1) PG8_BAR;
        PG8_WAIT_V(2); PG8_BAR;
        PG8_STAGE(PG8_SB(1, 0), cB + kstep, voffB); PG8_STAGE(PG8_SA(1, 0), cA + kstep, voffA); PG8_STAGE(PG8_SB(1, 1), cB + hstep + kstep, voffB);
        PG8_WAIT_V(6); PG8_BAR;
    } else {
        PG8_STAGE(PG8_SB(0, 0), cB, voffB); PG8_STAGE(PG8_SA(0, 0), cA, voffA); PG8_STAGE(PG8_SB(0, 1), cB + hstep, voffB); PG8_STAGE(PG8_SA(0, 1), cA + hstep, voffA);
        if (wr == 1) PG8_BAR;
        PG8_WAIT_V(4); PG8_BAR;
        PG8_STAGE(PG8_SB(1, 0), cB + kstep, voffB); PG8_STAGE(PG8_SA(1, 0), cA + kstep, voffA); PG8_STAGE(PG8_SB(1, 1), cB + hstep + kstep, voffB);
        PG8_WAIT_V(6); PG8_BAR;
    }
    for (;;) {
        const bool has_next = S.next(ui + 1, nxt);
        const char* nA = has_next ? (const char*)g.A + (size_t)nxt.pm * tstep : cA; const char* nB = has_next ? (const char*)g.Bt + (size_t)nxt.pn * tstep : cB;
        for (int t = 0; t < nt; t += 2) {
            const bool last = (t == nt - 2);
            const char* a1 = cA + (size_t)(t + 1) * kstep;
            const char* a2 = last ? nA : cA + (size_t)(t + 2) * kstep; const char* b2 = last ? nB : cB + (size_t)(t + 2) * kstep;
            const char* a3 = a2 + kstep; const char* b3 = b2 + kstep;
            if (last && has_next) S.a_ready(nxt);
            if constexpr (SP2) {
            PG8_LDB(B0, 0, 0); PG8_LDB(B1, 0, 1); PG8_SCHED; PG8_LDA(At, 0, 0); PG8_STAGE(PG8_SA(1, 1), a1 + hstep, voffA);
            PG8_WAIT_V(8); PG8_WAIT_L(0); PG8_BAR; PG8_MMA(0, 0, At, B0); PG8_MMA(0, 1, At, B1); PG8_BAR; PG8_SCHED;
            PG8_LDA(At, 0, 1); PG8_STAGE(PG8_SB(0, 0), b2, voffB); PG8_STAGE(PG8_SB(0, 1), b2 + hstep, voffB); PG8_STAGE(PG8_SA(0, 0), a2, voffA);
            PG8_WAIT_V(8); PG8_WAIT_L(0); PG8_BAR; PG8_MMA(1, 0, At, B0); PG8_MMA(1, 1, At, B1); PG8_BAR; PG8_SCHED;
            PG8_LDB(B0, 1, 0); PG8_LDB(B1, 1, 1); PG8_SCHED; PG8_LDA(At, 1, 0); PG8_STAGE(PG8_SA(0, 1), a2 + hstep, voffA);
            PG8_WAIT_V(8); PG8_WAIT_L(0); PG8_BAR; PG8_MMA(0, 0, At, B0); PG8_MMA(0, 1, At, B1); PG8_BAR; PG8_SCHED;
            PG8_LDA(At, 1, 1); PG8_STAGE(PG8_SB(1, 0), b3, voffB); PG8_STAGE(PG8_SB(1, 1), b3 + hstep, voffB); PG8_STAGE(PG8_SA(1, 0), a3, voffA);
            PG8_WAIT_V(8); PG8_WAIT_L(0); PG8_BAR; PG8_MMA(1, 0, At, B0); PG8_MMA(1, 1, At, B1); PG8_BAR; PG8_SCHED;
            } else {
            PG8_LDB(B0, 0, 0); PG8_SCHED; PG8_LDA(At, 0, 0); PG8_STAGE(PG8_SA(1, 1), a1 + hstep, voffA);
            PG8_WAIT_L(8); PG8_BAR; PG8_WAIT_L(0); PG8_MMA(0, 0, At, B0); PG8_BAR; PG8_SCHED;
            PG8_LDB(B1, 0, 1); PG8_STAGE(PG8_SB(0, 0), b2, voffB);
            PG8_BAR; PG8_WAIT_L(0); PG8_MMA(0, 1, At, B1); PG8_BAR;
            PG8_LDA(At, 0, 1); PG8_STAGE(PG8_SA(0, 0), a2, voffA);
            PG8_BAR; PG8_WAIT_L(0); PG8_MMA(1, 0, At, B0); PG8_BAR; PG8_SCHED;
            PG8_STAGE(PG8_SB(0, 1), b2 + hstep, voffB);
            PG8_WAIT_V(6); PG8_BAR; PG8_MMA(1, 1, At, B1); PG8_BAR;
            PG8_LDB(B0, 1, 0); PG8_SCHED; PG8_LDA(At, 1, 0); PG8_STAGE(PG8_SA(0, 1), a2 + hstep, voffA);
            PG8_WAIT_L(8); PG8_BAR; PG8_WAIT_L(0); PG8_MMA(0, 0, At, B0); PG8_BAR; PG8_SCHED;
            PG8_LDB(B1, 1, 1); PG8_STAGE(PG8_SB(1, 0), b3, voffB);
            PG8_BAR; PG8_WAIT_L(0); PG8_MMA(0, 1, At, B1); PG8_BAR;
            PG8_LDA(At, 1, 1); PG8_STAGE(PG8_SA(1, 0), a3, voffA);
            PG8_BAR; PG8_WAIT_L(0); PG8_MMA(1, 0, At, B0); PG8_BAR; PG8_SCHED;
            PG8_STAGE(PG8_SB(1, 1), b3 + hstep, voffB);
            PG8_WAIT_V(6); PG8_BAR; PG8_MMA(1, 1, At, B1); PG8_BAR;
            }
        }
        if constexpr (ALIGN_EPI) { if (wr == 0) PG8_BAR; }
        if constexpr (!Epi::AFTER_DRAIN) { E(acc, cur, wr, wc, fr, fq); S.done(cur); }
        if (!has_next) break;
#pragma unroll
        for (int a = 0; a < 2; ++a)
#pragma unroll
            for (int b = 0; b < 2; ++b)
#pragma unroll
                for (int m = 0; m < 4; ++m)
#pragma unroll
                    for (int n = 0; n < 2; ++n) acc[a][b][m][n] = (f32x4){0.f, 0.f, 0.f, 0.f};
        cur = nxt; cA = nA; cB = nB; ++ui;
        if constexpr (ALIGN_EPI) { if (wr == 1) PG8_BAR; }
    }
    PG8_WAIT_V(0);
    if constexpr (!ALIGN_EPI) { if (wr == 0) PG8_BAR; }
    PG8_BAR;
    if constexpr (Epi::AFTER_DRAIN) { E.fused(acc, cur, wr, wc, fr, fq, lds, wid, lane); S.done(cur); }
#undef PG8_SA
#undef PG8_SB
#undef PG8_STAGE
#undef PG8_LDA
#undef PG8_LDB
#undef PG8_MMA
#undef PG8_WAIT_V
#undef PG8_WAIT_L
#undef PG8_BAR
#undef PG8_SCHED
}
__device__ __forceinline__ float bf2f(unsigned short h) { return __uint_as_float(((unsigned)h) << 16); }
__device__ __forceinline__ float fast_sigmoid(float x) { return __builtin_amdgcn_rcpf(1.0f + __builtin_amdgcn_exp2f(-1.4426950408889634f * x)); }
struct EpiG1 {
    static constexpr bool PERM = true, AFTER_DRAIN = false;
    bf16_t* U; bf16_t* G; const float* bias; const float* ssq;
    __device__ __forceinline__ void operator()(const f32x4 (&acc)[2][2][4][2], const Unit& u, int wr, int wc, int fr, int fq) const {
        const int row0 = u.pm * BM + wr * 64 + fr; int colt = u.pn * BM; const bool isg = colt >= 5376;
        bf16_t* base = U; int ldc = 5376; if (isg) { colt -= 5376; base = G; ldc = 3072; }
        const int col0 = colt + wc * 32 + 8 * fq;
        f32x4 bv[2][2];
#pragma unroll
        for (int bj = 0; bj < 2; ++bj)
#pragma unroll
            for (int n = 0; n < 2; ++n) bv[bj][n] = isg ? *(const f32x4*)(bias + col0 + bj * HALF + 4 * n) : (f32x4){0.f, 0.f, 0.f, 0.f};
#pragma unroll
        for (int ai = 0; ai < 2; ++ai)
#pragma unroll
            for (int m = 0; m < 4; ++m) { bf16_t* rowp = base + (size_t)(row0 + ai * HALF + m * 16) * ldc + col0;
                const float rs = ssq ? __builtin_amdgcn_rsqf(ssq[row0 + ai * HALF + m * 16] * (1.0f / 1024.0f) + 1e-6f) : 1.0f;
#pragma unroll
                for (int bj = 0; bj < 2; ++bj) { f32x4 v0 = acc[ai][bj][m][0] * rs + bv[bj][0], v1 = acc[ai][bj][m][1] * rs + bv[bj][1];
                    if (isg) {
#pragma unroll
                        for (int e = 0; e < 4; ++e) { v0[e] = fast_sigmoid(v0[e]); v1[e] = fast_sigmoid(v1[e]); } }
                    u32x4 w; w.x = cvt_pk_bf16(v0[0], v0[1]); w.y = cvt_pk_bf16(v0[2], v0[3]); w.z = cvt_pk_bf16(v1[0], v1[1]); w.w = cvt_pk_bf16(v1[2], v1[3]);
                    *(u32x4*)(rowp + bj * HALF) = w; } }
    }
};
struct EpiG2 {
    static constexpr bool PERM = true, AFTER_DRAIN = false;
    const bf16_t* G; float* T; bf16_t* Mg; int npan;
    __device__ __forceinline__ void operator()(const f32x4 (&acc)[2][2][4][2], const Unit& u, int wr, int wc, int fr, int fq) const {
        const int b = u.pm / npan, pm = u.pm - b * npan, pn = u.pn & 3;
        const int row0 = pm * BM + wr * 64 + fr, col0 = pn * BM + wc * 32 + 8 * fq;
#pragma unroll
        for (int ai = 0; ai < 2; ++ai)
#pragma unroll
            for (int m = 0; m < 4; ++m) { const size_t row = (size_t)(row0 + ai * HALF + m * 16);
#pragma unroll
                for (int bj = 0; bj < 2; ++bj) { const int col = col0 + bj * HALF;
                    const u32x4 g = *(const u32x4*)(G + row * 3072 + b * 1024 + col);
                    f32x4 v0 = acc[ai][bj][m][0], v1 = acc[ai][bj][m][1];
                    v0[0] *= __uint_as_float(g.x << 16); v0[1] *= __uint_as_float(g.x & 0xffff0000u); v0[2] *= __uint_as_float(g.y << 16); v0[3] *= __uint_as_float(g.y & 0xffff0000u);
                    v1[0] *= __uint_as_float(g.z << 16); v1[1] *= __uint_as_float(g.z & 0xffff0000u); v1[2] *= __uint_as_float(g.w << 16); v1[3] *= __uint_as_float(g.w & 0xffff0000u);
                    bf16_t* mp = Mg + row * 1024 + col;
                    if (b > 0) { const u32x4 t = *(const u32x4*)mp;
                        v0[0] += __uint_as_float(t.x << 16); v0[1] += __uint_as_float(t.x & 0xffff0000u); v0[2] += __uint_as_float(t.y << 16); v0[3] += __uint_as_float(t.y & 0xffff0000u);
                        v1[0] += __uint_as_float(t.z << 16); v1[1] += __uint_as_float(t.z & 0xffff0000u); v1[2] += __uint_as_float(t.w << 16); v1[3] += __uint_as_float(t.w & 0xffff0000u); }
                    u32x4 w; w.x = cvt_pk_bf16(v0[0], v0[1]); w.y = cvt_pk_bf16(v0[2], v0[3]); w.z = cvt_pk_bf16(v1[0], v1[1]); w.w = cvt_pk_bf16(v1[2], v1[3]);
                    *(u32x4*)mp = w; } }
    }
};
struct OrderG2 {
    int npan, G, c;
    __device__ bool next(int i, Unit& u) const { const int ti = i / 3, b = i - 3 * ti, t = ti * G + c; if (t >= npan * 4) return false;
        const int pm = t >> 2, pn = t & 3; u.pm = b * npan + pm; u.pn = b * 4 + pn; return true; }
    __device__ __forceinline__ void a_ready(const Unit&) const {}
    __device__ __forceinline__ void done(const Unit&) const {}
};
struct EpiG3 {
    static constexpr bool PERM = true, AFTER_DRAIN = false;
    const float* X; float* O; const float* gn; bf16_t* HN; float* ssq; int fuse;
    __device__ __forceinline__ void operator()(const f32x4 (&acc)[2][2][4][2], const Unit& u, int wr, int wc, int fr, int fq) const {
        const int row0 = u.pm * BM + wr * 64 + fr, col0 = u.pn * BM + wc * 32 + 8 * fq;
        f32x4 gv[2][2];
#pragma unroll
        for (int bj = 0; bj < 2; ++bj)
#pragma unroll
            for (int n = 0; n < 2; ++n) gv[bj][n] = fuse ? *(const f32x4*)(gn + col0 + bj * HALF + 4 * n) : (f32x4){0.f, 0.f, 0.f, 0.f};
#pragma unroll
        for (int ai = 0; ai < 2; ++ai)
#pragma unroll
            for (int m = 0; m < 4; ++m) { const size_t row = (size_t)(row0 + ai * HALF + m * 16); float sq = 0.f;
#pragma unroll
                for (int bj = 0; bj < 2; ++bj) { const size_t p = row * 1024 + col0 + bj * HALF;
                    const f32x4 x0 = *(const f32x4*)(X + p), x1 = *(const f32x4*)(X + p + 4);
                    const f32x4 o0 = x0 + acc[ai][bj][m][0], o1 = x1 + acc[ai][bj][m][1];
                    *(f32x4*)(O + p) = o0; *(f32x4*)(O + p + 4) = o1;
                    if (fuse) { const f32x4 h0 = o0 * gv[bj][0], h1 = o1 * gv[bj][1];
                        u32x4 w; w.x = cvt_pk_bf16(h0[0], h0[1]); w.y = cvt_pk_bf16(h0[2], h0[3]); w.z = cvt_pk_bf16(h1[0], h1[1]); w.w = cvt_pk_bf16(h1[2], h1[3]);
                        *(u32x4*)(HN + p) = w;
                        sq += (o0[0] * o0[0] + o0[1] * o0[1]) + (o0[2] * o0[2] + o0[3] * o0[3]) + (o1[0] * o1[0] + o1[1] * o1[1]) + (o1[2] * o1[2] + o1[3] * o1[3]); } }
                if (fuse) { sq += shx(sq, 16); sq += shx(sq, 32); if (fq == 0) atomicAdd(ssq + row, sq); } }
    }
};
struct EpiAll {
    static constexpr bool PERM = true, AFTER_DRAIN = false;
    int mode; EpiG1 e1; EpiG2 e2; EpiG3 e3;
    __device__ __forceinline__ void operator()(const f32x4 (&acc)[2][2][4][2], const Unit& u, int wr, int wc, int fr, int fq) const {
        if (mode == 1) e1(acc, u, wr, wc, fr, fq); else if (mode == 2) e2(acc, u, wr, wc, fr, fq); else e3(acc, u, wr, wc, fr, fq); }
};
struct OrderAll {
    int mode; StaticOrder so; OrderG2 o2;
    __device__ __forceinline__ bool next(int i, Unit& u) const { return mode == 2 ? o2.next(i, u) : so.next(i, u); }
    __device__ __forceinline__ void a_ready(const Unit&) const {}
    __device__ __forceinline__ void done(const Unit&) const {}
};
}
#ifndef DUP_MASK
#define DUP_MASK 0
#endif
#ifndef EN_MASK
#define EN_MASK 0xffff
#endif
#define EN(i) ((EN_MASK >> (i)) & 1)
#define LAS __attribute__((address_space(3)))
typedef unsigned short bf16;
typedef float f32x4 __attribute__((ext_vector_type(4)));
typedef float f32x2 __attribute__((ext_vector_type(2)));
typedef unsigned u32x4 __attribute__((ext_vector_type(4)));
typedef unsigned u32x2 __attribute__((ext_vector_type(2)));
constexpr int DM = 1024, NTOK_P = 65536, NTOK_S = 32768, NTOK = NTOK_P + NTOK_S, LP = 8192, LS = 2048;
constexpr int CH = 16384, NCHUNK = NTOK / CH, NCH_P = NTOK_P / CH;
constexpr int UP = 5376, NCAT = 8448, GP = 3072;
constexpr int C_X0 = 0, C_X1 = 512, C_HV = 1024, C_HG = 1536, C_GQ = 2048, C_GK = 2560, C_GV = 2688, C_GG = 2816, C_DQ = 3328, C_DK = 3840, C_DV = 4352, C_DG = 4864;
constexpr float EPS = 1e-6f, LOG2E = 1.4426950408889634f;
constexpr int NT = 512, NWAVES = 8;
enum { I_XP = 0, I_XS, I_RELB, I_NORMG, I_WIN, I_CONVW, I_CONVB, I_FW1, I_FB1, I_FW2, I_FB2, I_FWOUT, I_FFREQ, I_HYBIAS, I_QNG, I_KNG, I_LQ1, I_LK1, I_LQ2, I_LK2, I_SUBLN, I_WBHY, I_WBGQ, I_WBDF, I_WMERGE, I_BMERGE, I_WOUT, I_FINALG, N_IN };
constexpr size_t MiB = 1u << 20;
constexpr size_t WS_CTL = 0, CTL_BYTES = 64 * 1024;
constexpr size_t WS_TW = 1 * MiB;
constexpr size_t WS_WCAT = 2 * MiB, WCAT_BYTES = (size_t)NCAT * 1024 * 2;
constexpr size_t WS_WBT = 40 * MiB, WBT_BYTES = (size_t)3 * 1024 * 512 * 2;
constexpr size_t WS_WOT = 46 * MiB, WOT_BYTES = (size_t)1024 * 1024 * 2;
constexpr int SPS_P = LP + 16, SPS_S = LS + 16;
constexpr size_t SPEC_P_BYTES = (size_t)256 * SPS_P * 8, SPEC_S_BYTES = (size_t)256 * SPS_S * 8;
constexpr size_t SPEC_LAYER = 2 * SPEC_P_BYTES + 2 * SPEC_S_BYTES;
constexpr size_t WS_SPEC = 52 * MiB;
constexpr size_t WS_HN = 140 * MiB, WS_U = 172 * MiB, WS_G = 340 * MiB, WS_Y = 436 * MiB, WS_MG = 484 * MiB, WS_TMP = 516 * MiB, WS_DT = 580 * MiB, WS_HVP = 612 * MiB, WS_PMP = 644 * MiB, WS_ROPE = 676 * MiB, WS_HN0 = 680 * MiB, WS_END = 872 * MiB;
constexpr size_t HF_P_BYTES = (size_t)LP * 1024 * 4, HF_S_BYTES = (size_t)LS * 1024 * 4;
static_assert(WS_WCAT + 2 * WCAT_BYTES <= WS_WBT && WS_WBT + 2 * WBT_BYTES <= WS_WOT && WS_WOT + 2 * WOT_BYTES <= WS_SPEC && WS_SPEC + 2 * SPEC_LAYER <= WS_HN, "ws map");
static_assert(WS_HN + (size_t)CH * 1024 * 2 <= WS_U && WS_U + (size_t)CH * UP * 2 <= WS_G && WS_G + (size_t)CH * GP * 2 <= WS_Y && WS_Y + (size_t)3 * CH * 512 * 2 <= WS_MG && WS_MG + (size_t)CH * 1024 * 2 <= WS_TMP && WS_TMP + (size_t)CH * 1024 * 4 <= WS_DT && WS_DT + (size_t)CH * 512 * 4 <= WS_END, "ws map 2");
static_assert(2 * (HF_P_BYTES + HF_S_BYTES) <= (size_t)CH * UP * 2, "hf overlay");
constexpr size_t WS_SSQ = WS_TMP;
constexpr int LDS_MAIN = 139264, LDS_BYTES = LDS_MAIN + 1024;
constexpr int CW_BAR = 4096;

struct Args { const float* in[N_IN]; float* out; unsigned char* ws; int lo, hi; };
typedef const __attribute__((address_space(4))) unsigned long long* kargp_t;
struct AV { kargp_t p; };
#define AIN(i) ((const float*)(a.p[(i)]))
#define AOUT ((float*)(a.p[N_IN]))
#define AWS ((unsigned char*)(a.p[N_IN + 1]))


__device__ __forceinline__ float bf2f(unsigned short h) { return __uint_as_float(((unsigned)h) << 16); }
__device__ __forceinline__ float bflo(unsigned w) { return __uint_as_float(w << 16); }
__device__ __forceinline__ float bfhi(unsigned w) { return __uint_as_float(w & 0xffff0000u); }
__device__ __forceinline__ unsigned f2bf(float f) { unsigned u = __builtin_bit_cast(unsigned, f); return (u + 0x7fffu + ((u >> 16) & 1u)) >> 16; }
__device__ __forceinline__ unsigned pk2(float lo, float hi) { return f2bf(lo) | (f2bf(hi) << 16); }
__device__ __forceinline__ float silu(float x) { return x * __builtin_amdgcn_rcpf(1.0f + __builtin_amdgcn_exp2f(-LOG2E * x)); }
__device__ __forceinline__ float wave_sum(float v) {
#pragma unroll
    for (int o = 1; o < 64; o <<= 1) v += shx(v, o);
    return v;
}
__device__ __forceinline__ double kd(double v) { asm volatile("" : "+s"(v)); return v; }
__device__ __forceinline__ void sincos_rev(double r, float& s, float& c) {
    r -= __builtin_rint(r);
    const double k = __builtin_rint(r * 4.0);
    const double x = (r - k * 0.25) * kd(6.283185307179586476925);
    const double x2 = x * x;
    double sp = kd(1.0 / 6227020800.0); sp = sp * x2 + kd(-1.0 / 39916800); sp = sp * x2 + kd(1.0 / 362880); sp = sp * x2 + kd(-1.0 / 5040); sp = sp * x2 + kd(1.0 / 120); sp = sp * x2 + kd(-1.0 / 6); sp = sp * x2 + 1.0; sp *= x;
    double cp = kd(-1.0 / 87178291200.0); cp = cp * x2 + kd(1.0 / 479001600.0); cp = cp * x2 + kd(-1.0 / 3628800); cp = cp * x2 + kd(1.0 / 40320); cp = cp * x2 + kd(-1.0 / 720); cp = cp * x2 + kd(1.0 / 24); cp = cp * x2 + (-0.5); cp = cp * x2 + 1.0;
    const int q = ((int)k) & 3;
    const float sf = (float)sp, cf = (float)cp;
    s = (q == 0) ? sf : (q == 1) ? cf : (q == 2) ? -sf : -cf;
    c = (q == 0) ? cf : (q == 1) ? -sf : (q == 2) ? -cf : sf;
}
__device__ __forceinline__ float sin_acc(float x) { float s, c; sincos_rev((double)x * 0.15915494309189533577, s, c); return s; }

__device__ __forceinline__ void transpose_item(const float* W, int K, int N, bf16* WT, int row_off, LAS float* scr, int item, int lane) {
    const int nblk = N / 32, kb = item / nblk, nb = item % nblk, k0 = 64 * kb, n0 = 32 * nb;
#pragma unroll 8
    for (int i = 0; i < 32; ++i) { const int kk = 2 * i + (lane >> 5); scr[kk * 33 + (lane & 31)] = W[(size_t)(k0 + kk) * N + n0 + (lane & 31)]; }
    asm volatile("s_waitcnt lgkmcnt(0)" ::: "memory");
    const int c = lane & 7;
#pragma unroll
    for (int j = 0; j < 4; ++j) { const int n = (lane >> 3) + 8 * j; const LAS float* s = scr + (8 * c) * 33 + n;
        u32x4 o; o.x = pk2(s[0 * 33], s[1 * 33]); o.y = pk2(s[2 * 33], s[3 * 33]); o.z = pk2(s[4 * 33], s[5 * 33]); o.w = pk2(s[6 * 33], s[7 * 33]);
        *(u32x4*)(WT + (size_t)(row_off + n0 + n) * K + k0 + 8 * c) = o; }
    asm volatile("s_waitcnt lgkmcnt(0)" ::: "memory");
}

__device__ __forceinline__ f32x2 cmul(f32x2 a, f32x2 b) { return (f32x2){a.x * b.x - a.y * b.y, a.x * b.y + a.y * b.x}; }
__device__ __forceinline__ f32x2 cmulc(f32x2 a, f32x2 b) { return (f32x2){a.x * b.x + a.y * b.y, a.y * b.x - a.x * b.y}; }
__device__ __forceinline__ f32x2 cconj(f32x2 a) { return (f32x2){a.x, -a.y}; }
template <int LOG4> __device__ __forceinline__ int digitrev(int k) { unsigned x = __builtin_bitreverse32((unsigned)k) >> (32 - 2 * LOG4); return (int)(((x & 0x55555555u) << 1) | ((x >> 1) & 0x55555555u)); }
#define PADI(i) ((i) + ((i) >> 4))
#define W16C 0.92387953251128674f
#define W16S 0.38268343236508977f
#define W16H 0.70710678118654752f
__device__ __forceinline__ f32x2 w16(int m) { return m == 0 ? (f32x2){1.f, 0.f} : m == 1 ? (f32x2){W16C, -W16S} : m == 2 ? (f32x2){W16H, -W16H} : m == 3 ? (f32x2){W16S, -W16C} : m == 4 ? (f32x2){0.f, -1.f} : m == 6 ? (f32x2){-W16H, -W16H} : (f32x2){-W16C, W16S}; }
__device__ __forceinline__ void bfly_fwd(f32x2& a0, f32x2& a1, f32x2& a2, f32x2& a3) {
    const f32x2 t0 = a0 + a2, t1 = a0 - a2, t2 = a1 + a3, t3 = a1 - a3;
    a0 = t0 + t2; a2 = t0 - t2; a1 = (f32x2){t1.x + t3.y, t1.y - t3.x}; a3 = (f32x2){t1.x - t3.y, t1.y + t3.x};
}
__device__ __forceinline__ void bfly_inv(f32x2& b0, f32x2& b1, f32x2& b2, f32x2& b3) {
    const f32x2 t0 = b0 + b2, t1 = b0 - b2, t2 = b1 + b3, t3 = b1 - b3;
    b0 = t0 + t2; b2 = t0 - t2; b1 = (f32x2){t1.x - t3.y, t1.y + t3.x}; b3 = (f32x2){t1.x + t3.y, t1.y - t3.x};
}
template <int LOG4, int BATCH = 1> __device__ __forceinline__ void fft_fwd(LAS f32x2* buf, const f32x2* __restrict__ tw, int tid) {
    constexpr int N = 1 << (2 * LOG4), TWS = 16384 / N;
#pragma unroll 1
    for (int pass = 0; pass < LOG4 - 2; ++pass) {
        const int lq = 2 * (LOG4 - pass) - 2, q4 = 1 << lq, n = q4 << 2, tstep = TWS << (2 * pass);
        constexpr int IT = BATCH * N / 4 / NT, NPAD = N + N / 16;
        f32x2 wl[IT];
#pragma unroll
        for (int i = 0; i < IT; ++i) wl[i] = tw[((tid + i * NT) & (q4 - 1)) * tstep];
#pragma unroll
        for (int i = 0; i < IT; ++i) { const int jg = tid + i * NT, bo = (jg >> (2 * LOG4 - 2)) * NPAD, j = jg & (N / 4 - 1);
            const int blk = j >> lq, jj = j & (q4 - 1), base = blk * n + jj;
            const int i0 = bo + PADI(base), i1 = bo + PADI(base + q4), i2 = bo + PADI(base + 2 * q4), i3 = bo + PADI(base + 3 * q4);
            const f32x2 w1 = wl[i];
            f32x2 a0 = buf[i0], a1 = buf[i1], a2 = buf[i2], a3 = buf[i3];
            bfly_fwd(a0, a1, a2, a3);
            const f32x2 w2 = cmul(w1, w1), w3 = cmul(w2, w1);
            buf[i0] = a0; buf[i1] = cmul(a1, w1); buf[i2] = cmul(a2, w2); buf[i3] = cmul(a3, w3);
        }
        __syncthreads();
    }
#pragma unroll 1
    for (int b = tid; b < BATCH * N / 16; b += NT) {
        LAS f32x2* xb = buf + 17 * b; f32x2 x[16];
#pragma unroll
        for (int e = 0; e < 16; ++e) x[e] = xb[e];
#pragma unroll
        for (int jj = 0; jj < 4; ++jj) { bfly_fwd(x[jj], x[jj + 4], x[jj + 8], x[jj + 12]); if (jj) { x[jj + 4] = cmul(x[jj + 4], w16(jj)); x[jj + 8] = cmul(x[jj + 8], w16(2 * jj)); x[jj + 12] = cmul(x[jj + 12], w16(3 * jj)); } }
#pragma unroll
        for (int q = 0; q < 4; ++q) bfly_fwd(x[4 * q], x[4 * q + 1], x[4 * q + 2], x[4 * q + 3]);
#pragma unroll
        for (int e = 0; e < 16; ++e) xb[e] = x[e];
    }
    __syncthreads();
}
template <int LOG4, int BATCH = 1> __device__ __forceinline__ void fft_inv(LAS f32x2* buf, const f32x2* __restrict__ tw, int tid) {
    constexpr int N = 1 << (2 * LOG4), TWS = 16384 / N;
#pragma unroll 1
    for (int b = tid; b < BATCH * N / 16; b += NT) {
        LAS f32x2* xb = buf + 17 * b; f32x2 x[16];
#pragma unroll
        for (int e = 0; e < 16; ++e) x[e] = xb[e];
#pragma unroll
        for (int q = 0; q < 4; ++q) bfly_inv(x[4 * q], x[4 * q + 1], x[4 * q + 2], x[4 * q + 3]);
#pragma unroll
        for (int jj = 0; jj < 4; ++jj) { if (jj) { x[jj + 4] = cmulc(x[jj + 4], w16(jj)); x[jj + 8] = cmulc(x[jj + 8], w16(2 * jj)); x[jj + 12] = cmulc(x[jj + 12], w16(3 * jj)); } bfly_inv(x[jj], x[jj + 4], x[jj + 8], x[jj + 12]); }
#pragma unroll
        for (int e = 0; e < 16; ++e) xb[e] = x[e];
    }
    __syncthreads();
#pragma unroll 1
    for (int pass = LOG4 - 3; pass >= 0; --pass) {
        const int lq = 2 * (LOG4 - pass) - 2, q4 = 1 << lq, n = q4 << 2, tstep = TWS << (2 * pass);
        constexpr int IT = BATCH * N / 4 / NT, NPAD = N + N / 16;
        f32x2 wl[IT];
#pragma unroll
        for (int i = 0; i < IT; ++i) wl[i] = tw[((tid + i * NT) & (q4 - 1)) * tstep];
#pragma unroll
        for (int i = 0; i < IT; ++i) { const int jg = tid + i * NT, bo = (jg >> (2 * LOG4 - 2)) * NPAD, j = jg & (N / 4 - 1);
            const int blk = j >> lq, jj = j & (q4 - 1), base = blk * n + jj;
            const int i0 = bo + PADI(base), i1 = bo + PADI(base + q4), i2 = bo + PADI(base + 2 * q4), i3 = bo + PADI(base + 3 * q4);
            const f32x2 w1 = wl[i];
            const f32x2 w2 = cmul(w1, w1), w3 = cmul(w2, w1);
            f32x2 b0 = buf[i0], b1 = cmulc(buf[i1], w1), b2 = cmulc(buf[i2], w2), b3 = cmulc(buf[i3], w3);
            bfly_inv(b0, b1, b2, b3);
            buf[i0] = b0; buf[i1] = b1; buf[i2] = b2; buf[i3] = b3;
        }
        __syncthreads();
    }
}
__device__ const double ROPE_IF[16] = {1.0, 0.5623413251903491, 0.31622776601683794, 0.1778279410038923, 0.1, 0.05623413251903491, 0.03162277660168379, 0.01778279410038923,
    0.01, 0.005623413251903491, 0.0031622776601683794, 0.0017782794100389228, 0.001, 0.0005623413251903491, 0.00031622776601683794, 0.00017782794100389227};
struct Chunk { int tok0, L, nseq; };
__device__ __forceinline__ Chunk chunk_of(int c) { Chunk k; k.tok0 = c * CH; if (c < NCH_P) { k.L = LP; k.nseq = CH / LP; } else { k.L = LS; k.nseq = CH / LS; } return k; }
__device__ __forceinline__ const float* xin_rows(const AV& a, int tok0) { return tok0 < NTOK_P ? AIN(I_XP) + (size_t)tok0 * DM : AIN(I_XS) + (size_t)(tok0 - NTOK_P) * DM; }
__device__ __forceinline__ void hf_group(LAS float* sm, const AV& a, int layer, int L, int t0, float* hf, int tid) {
    LAS float* zs = sm; LAS float* A = sm + 512; LAS float* B = sm + 1024;
    const float* w1 = AIN(I_FW1) + layer * 33 * 64; const float* b1 = AIN(I_FB1) + layer * 64;
    const float* w2 = AIN(I_FW2) + layer * 2 * 64 * 64; const float* b2 = AIN(I_FB2) + layer * 2 * 64;
    const float* wo = AIN(I_FWOUT) + layer * 64 * 1024; const float* fr = AIN(I_FFREQ) + layer * 64;
    const int tt = tid >> 6, j = tid & 63, t = t0 + tt;
    const float t01 = (float)t / (float)(L - 1);
    if (j < 33) {
        float v;
        if (j == 0) v = t01;
        else { const int k = (j - 1) & 15; const double f = kd(1e-4) + (double)k * kd((15.0 - 1e-4) / 15.0); float s, c; sincos_rev(f * (double)t / (double)L, s, c); v = (j <= 16) ? c : -s; }
        zs[tt * 40 + j] = v;
    }
    __syncthreads();
    const float fq = fr[j];
    { float acc = b1[j]; for (int i = 0; i < 33; ++i) acc += zs[tt * 40 + i] * w1[i * 64 + j]; A[tt * 64 + j] = sin_acc(fq * acc); }
    __syncthreads();
    { float acc = b2[j]; for (int i = 0; i < 64; ++i) acc += A[tt * 64 + i] * w2[i * 64 + j]; B[tt * 64 + j] = sin_acc(fq * acc); }
    __syncthreads();
    { float acc = b2[64 + j]; for (int i = 0; i < 64; ++i) acc += B[tt * 64 + i] * w2[4096 + i * 64 + j]; A[tt * 64 + j] = sin_acc(fq * acc); }
    __syncthreads();
    { float acc0[8], acc1[8];
#pragma unroll
      for (int q = 0; q < 8; ++q) { acc0[q] = 0.f; acc1[q] = 0.f; }
#pragma unroll 8
      for (int i = 0; i < 64; ++i) { const float wa = wo[i * 1024 + tid], wb = wo[i * 1024 + 512 + tid];
#pragma unroll
          for (int q = 0; q < 8; ++q) { const float av = A[q * 64 + i]; acc0[q] += av * wa; acc1[q] += av * wb; } }
      const float ad = 3.070113457325394f + (float)tid * ((15.350567286626973f - 3.070113457325394f) / 511.0f);
#pragma unroll
      for (int q = 0; q < 8; ++q) { const float tq = (float)(t0 + q) / (float)(L - 1); const float win = __expf(-tq * ad);
          hf[(size_t)(t0 + q) * 1024 + tid] = acc0[q] * win; hf[(size_t)(t0 + q) * 1024 + 512 + tid] = acc1[q] * win; } }
    __syncthreads();
}
__device__ __forceinline__ void step_pro_a(const AV& a, LAS unsigned char* lds) {
    const int tid = ltid(), lane = tid & 63, wave = tid >> 6, G = gridDim.x;
    unsigned char* ws = AWS;
    { f32x2* tw = (f32x2*)(ws + WS_TW); for (int m = lbid() * NT + tid; m < 16384; m += G * NT) { float s, c; sincos_rev((double)m / 16384.0, s, c); tw[m] = (f32x2){c, -s}; } }
    { f32x2* rt = (f32x2*)(ws + WS_ROPE);
      for (int e = lbid() * NT + tid; e < 8192 * 32; e += G * NT) { const int pos = e >> 5, i = e & 31; const int pp = (i < 16) ? (pos >> 6) : (pos & 63);
          const double inv = ROPE_IF[i & 15]; float sn, cs; sincos_rev((double)pp * inv * 0.15915494309189533577, sn, cs); rt[e] = (f32x2){cs, sn}; } }
    { const float* g = AIN(I_NORMG); bf16* HN0 = (bf16*)(ws + WS_HN0); f32x4 gv[4];
#pragma unroll
      for (int j = 0; j < 4; ++j) gv[j] = *((const f32x4*)g + lane + 64 * j);
      for (int m = lbid() * NWAVES + wave; m < NTOK; m += G * NWAVES) {
          const f32x4* xr = (const f32x4*)(xin_rows(a, m)) + lane; f32x4 v[4]; float ssum = 0.f;
#pragma unroll
          for (int j = 0; j < 4; ++j) { v[j] = xr[64 * j]; ssum += (v[j].x * v[j].x + v[j].y * v[j].y) + (v[j].z * v[j].z + v[j].w * v[j].w); }
          const float rs = 1.0f / sqrtf(wave_sum(ssum) * (1.0f / DM) + EPS);
          u32x2* o8 = (u32x2*)(HN0 + (size_t)m * DM) + lane;
#pragma unroll
          for (int j = 0; j < 4; ++j) { u32x2 w; w.x = pk2(v[j].x * rs * gv[j].x, v[j].y * rs * gv[j].y); w.y = pk2(v[j].z * rs * gv[j].z, v[j].w * rs * gv[j].w); o8[64 * j] = w; } } }
    { LAS float* scr = (LAS float*)(lds + wave * 16384);
      constexpr int I_IN = 16 * (UP / 32), I_MG = 16 * (GP / 32), I_BR = 8 * 32, I_OU = 16 * 32, PER = I_IN + I_MG + 3 * I_BR + I_OU;
      for (int it = lbid() * NWAVES + wave; it < 2 * PER; it += G * NWAVES) {
          const int l = it / PER; int r = it - l * PER;
          bf16* wcat = (bf16*)(ws + WS_WCAT + l * WCAT_BYTES); bf16* wbt = (bf16*)(ws + WS_WBT + l * WBT_BYTES); bf16* wot = (bf16*)(ws + WS_WOT + l * WOT_BYTES);
          if (r < I_IN) { transpose_item(AIN(I_WIN) + (size_t)l * 1024 * UP, 1024, UP, wcat, 0, scr, r, lane); continue; } r -= I_IN;
          if (r < I_MG) { transpose_item(AIN(I_WMERGE) + (size_t)l * 1024 * GP, 1024, GP, wcat, UP, scr, r, lane); continue; } r -= I_MG;
          if (r < I_BR) { transpose_item(AIN(I_WBHY) + (size_t)l * 512 * 1024, 512, 1024, wbt, 0, scr, r, lane); continue; } r -= I_BR;
          if (r < I_BR) { transpose_item(AIN(I_WBGQ) + (size_t)l * 512 * 1024, 512, 1024, wbt, 1024, scr, r, lane); continue; } r -= I_BR;
          if (r < I_BR) { transpose_item(AIN(I_WBDF) + (size_t)l * 512 * 1024, 512, 1024, wbt, 2048, scr, r, lane); continue; } r -= I_BR;
          transpose_item(AIN(I_WOUT) + (size_t)l * 1024 * 1024, 1024, 1024, wot, 0, scr, r, lane);
      } }
}
__device__ __forceinline__ void step_pro_a2(const AV& a, LAS unsigned char* lds) {
    const int tid = ltid(), G = gridDim.x; unsigned char* ws = AWS;
    { constexpr int GPL = LP / 8 + LS / 8;
      for (int g = lbid(); g < 2 * GPL; g += G) { const int l = g / GPL; int r = g - l * GPL;
          float* hfp = (float*)(ws + WS_U + l * (HF_P_BYTES + HF_S_BYTES));
          if (r < LP / 8) hf_group((LAS float*)lds, a, l, LP, r * 8, hfp, tid);
          else hf_group((LAS float*)lds, a, l, LS, (r - LP / 8) * 8, (float*)((unsigned char*)hfp + HF_P_BYTES), tid); } }
}
template <int LOG4> __device__ __forceinline__ void filt_unit(const AV& a, LAS unsigned char* lds, int layer, int pr, const float* hf, f32x2* Pg, f32x2* Mg) {
    constexpr int N = 1 << (2 * LOG4), L = N / 2;
    const int tid = ltid(); LAS f32x2* buf = (LAS f32x2*)lds; const int c0 = 2 * pr;
    for (int n = tid; n < N; n += NT) { f32x2 v = (f32x2){0.f, 0.f};
        if (n < L) v = *(const f32x2*)(hf + (size_t)n * 1024 + c0); else if (n > L) v = *(const f32x2*)(hf + (size_t)(N - n) * 1024 + 512 + c0);
        buf[PADI(n)] = v; }
    __syncthreads();
    fft_fwd<LOG4>(buf, (const f32x2*)(AWS + WS_TW), tid);
    const float ba = AIN(I_HYBIAS)[layer * 512 + c0], bb = AIN(I_HYBIAS)[layer * 512 + c0 + 1]; const float sc = 1.0f / (float)N;
    for (int k = tid; k <= L; k += NT) { const int q1 = digitrev<LOG4>(k), q2 = digitrev<LOG4>((N - k) & (N - 1)); const f32x2 z1 = buf[PADI(q1)], z2 = buf[PADI(q2)];
        f32x2 ca = (f32x2){0.5f * (z1.x + z2.x), 0.5f * (z1.y - z2.y)}; const float dx = z1.x - z2.x, dy = z1.y + z2.y; f32x2 cb = (f32x2){0.5f * dy, -0.5f * dx};
        ca.x += ba; cb.x += bb;
        Pg[k] = (f32x2){0.5f * sc * (ca.x + cb.x), 0.5f * sc * (ca.y + cb.y)}; Mg[k] = (f32x2){0.5f * sc * (ca.x - cb.x), 0.5f * sc * (ca.y - cb.y)}; }
    __syncthreads();
}
__device__ __forceinline__ void step_pro_b(const AV& a, LAS unsigned char* lds) {
    for (int u = lbid(); u < 1024; u += gridDim.x) { const int l = u >> 9, r = u & 511; unsigned char* sp = AWS + WS_SPEC + l * SPEC_LAYER; const float* hfp = (const float*)(AWS + WS_U + l * (HF_P_BYTES + HF_S_BYTES));
        if (r < 256) filt_unit<7>(a, lds, l, r, hfp, (f32x2*)sp + (size_t)r * SPS_P, (f32x2*)(sp + SPEC_P_BYTES) + (size_t)r * SPS_P);
        else { const int pr = r - 256; filt_unit<6>(a, lds, l, pr, (const float*)((const unsigned char*)hfp + HF_P_BYTES), (f32x2*)(sp + 2 * SPEC_P_BYTES) + (size_t)pr * SPS_S, (f32x2*)(sp + 2 * SPEC_P_BYTES + SPEC_S_BYTES) + (size_t)pr * SPS_S); } }
}
__device__ __forceinline__ void step_norm(const AV& a, int c, int layer) {
    const int tid = ltid(), lane = tid & 63, wave = tid >> 6; const Chunk ck = chunk_of(c);
    const float* X = layer == 0 ? xin_rows(a, ck.tok0) : AOUT + (size_t)ck.tok0 * DM; bf16* HN = (bf16*)(AWS + WS_HN); const float* g = AIN(I_NORMG) + layer * DM;
    f32x4 gv[4];
#pragma unroll
    for (int j = 0; j < 4; ++j) gv[j] = *((const f32x4*)g + lane + 64 * j);
    for (int m = lbid() * NWAVES + wave; m < CH; m += gridDim.x * NWAVES) {
        const f32x4* xr = (const f32x4*)(X + (size_t)m * DM) + lane; f32x4 v[4]; float s = 0.f;
#pragma unroll
        for (int j = 0; j < 4; ++j) { v[j] = xr[64 * j]; s += (v[j].x * v[j].x + v[j].y * v[j].y) + (v[j].z * v[j].z + v[j].w * v[j].w); }
        const float rs = 1.0f / sqrtf(wave_sum(s) * (1.0f / DM) + EPS);
        u32x2* o8 = (u32x2*)(HN + (size_t)m * DM) + lane;
#pragma unroll
        for (int j = 0; j < 4; ++j) { u32x2 w; w.x = pk2(v[j].x * rs * gv[j].x, v[j].y * rs * gv[j].y); w.y = pk2(v[j].z * rs * gv[j].z, v[j].w * rs * gv[j].w); o8[64 * j] = w; }
    }
}
__device__ __forceinline__ void step_final(const AV& a, int row0, int row1) {
    const int tid = ltid(), lane = tid & 63, wave = tid >> 6; const float* g = AIN(I_FINALG);
    f32x4 gv[4];
#pragma unroll
    for (int j = 0; j < 4; ++j) gv[j] = *((const f32x4*)g + lane + 64 * j);
    for (int m = row0 + lbid() * NWAVES + wave; m < row1; m += gridDim.x * NWAVES) {
        f32x4* xr = (f32x4*)(AOUT + (size_t)m * DM) + lane; f32x4 v[4]; float s = 0.f;
#pragma unroll
        for (int j = 0; j < 4; ++j) { v[j] = xr[64 * j]; s += (v[j].x * v[j].x + v[j].y * v[j].y) + (v[j].z * v[j].z + v[j].w * v[j].w); }
        const float rs = 1.0f / sqrtf(wave_sum(s) * (1.0f / DM) + EPS);
#pragma unroll
        for (int j = 0; j < 4; ++j) xr[64 * j] = v[j] * rs * gv[j];
    }
}
__device__ __forceinline__ void step_prep(const AV& a, int c, int layer) {
    const Chunk ck = chunk_of(c); bf16* U = (bf16*)(AWS + WS_U);
    for (int it = lbid() * NT + ltid(); it < CH * 10; it += gridDim.x * NT) {
        const int tok = it / 10, hd = it - tok * 10; const int pos = tok & (ck.L - 1);
        bf16* p = U + (size_t)tok * UP + (hd < 8 ? C_GQ + 64 * hd : C_GK + 64 * (hd - 8));
        const float* g = (hd < 8 ? AIN(I_QNG) : AIN(I_KNG)) + layer * 64;
        float x[64];
#pragma unroll
        for (int i = 0; i < 8; ++i) { const u32x4 w = *((const u32x4*)p + i);
            x[8 * i + 0] = bflo(w.x); x[8 * i + 1] = bfhi(w.x); x[8 * i + 2] = bflo(w.y); x[8 * i + 3] = bfhi(w.y); x[8 * i + 4] = bflo(w.z); x[8 * i + 5] = bfhi(w.z); x[8 * i + 6] = bflo(w.w); x[8 * i + 7] = bfhi(w.w); }
        float ss = 0.f;
#pragma unroll
        for (int i = 0; i < 64; ++i) ss += x[i] * x[i];
        const float rs = (1.0f / sqrtf(ss * (1.0f / 64.0f) + EPS)) * (hd < 8 ? 0.125f * LOG2E : 1.0f);
#pragma unroll
        for (int i = 0; i < 64; ++i) x[i] = x[i] * rs * g[i];
        const f32x4* rt = (const f32x4*)(AWS + WS_ROPE) + (size_t)pos * 16;
#pragma unroll
        for (int i2 = 0; i2 < 16; ++i2) { const f32x4 cs2 = rt[i2];
#pragma unroll
            for (int e = 0; e < 2; ++e) { const int i = 2 * i2 + e; const float cs = e ? cs2.z : cs2.x, sn = e ? cs2.w : cs2.y; const float x1 = x[i], x2 = x[i + 32]; x[i] = x1 * cs - x2 * sn; x[i + 32] = x2 * cs + x1 * sn; } }
#pragma unroll
        for (int i = 0; i < 8; ++i) { u32x4 w; w.x = pk2(x[8 * i], x[8 * i + 1]); w.y = pk2(x[8 * i + 2], x[8 * i + 3]); w.z = pk2(x[8 * i + 4], x[8 * i + 5]); w.w = pk2(x[8 * i + 6], x[8 * i + 7]); *((u32x4*)p + i) = w; }
    }
}
__device__ __forceinline__ void step_prep_hy(const AV& a, LAS unsigned char* lds, int c, int layer) {
    const Chunk ck = chunk_of(c); const bf16* U = (const bf16*)(AWS + WS_U);
    f32x2* HVP = (f32x2*)(AWS + WS_HVP); f32x2* PMP = (f32x2*)(AWS + WS_PMP);
    const int tid = ltid(), lane = tid & 63, wave = tid >> 6;
    LAS f32x2* th = (LAS f32x2*)(lds + wave * 17408); LAS f32x2* tp = th + 64 * 17;
    const float* cw = AIN(I_CONVW) + layer * 3 * 1536; const float* cb = AIN(I_CONVB) + layer * 1536;
    for (int it = lbid() * NWAVES + wave; it < (CH / 16) * 4; it += gridDim.x * NWAVES) {
        const int cbk = it & 3, tg = it >> 2, t0 = tg * 16, ch = cbk * 128 + 2 * lane;
        const int pos0 = t0 & (ck.L - 1);
        float w[3][3][2], bb[3][2];
#pragma unroll
        for (int ar = 0; ar < 3; ++ar) {
#pragma unroll
            for (int j = 0; j < 3; ++j) { const f32x2 v = *(const f32x2*)(cw + j * 1536 + ar * 512 + ch); w[ar][j][0] = v.x; w[ar][j][1] = v.y; }
            const f32x2 v = *(const f32x2*)(cb + ar * 512 + ch); bb[ar][0] = v.x; bb[ar][1] = v.y; }
        const bf16* r0 = U + (size_t)t0 * UP + ch;
        unsigned pv[3], cv[3], nv[3];
#pragma unroll
        for (int ar = 0; ar < 3; ++ar) { pv[ar] = pos0 > 0 ? *(const unsigned*)(r0 - UP + ar * 512) : 0u; cv[ar] = *(const unsigned*)(r0 + ar * 512); }
#pragma unroll 4
        for (int t = 0; t < 16; ++t) {
            const bf16* rt = r0 + (size_t)t * UP; const bool last = (pos0 + t + 1 >= ck.L);
#pragma unroll
            for (int ar = 0; ar < 3; ++ar) nv[ar] = last ? 0u : *(const unsigned*)(rt + UP + ar * 512);
            const unsigned gw = *(const unsigned*)(rt + C_HG);
            float o[3][2];
#pragma unroll
            for (int ar = 0; ar < 3; ++ar) { o[ar][0] = w[ar][0][0] * bflo(pv[ar]) + w[ar][1][0] * bflo(cv[ar]) + w[ar][2][0] * bflo(nv[ar]) + bb[ar][0];
                o[ar][1] = w[ar][0][1] * bfhi(pv[ar]) + w[ar][1][1] * bfhi(cv[ar]) + w[ar][2][1] * bfhi(nv[ar]) + bb[ar][1]; pv[ar] = cv[ar]; cv[ar] = nv[ar]; }
            th[lane * 17 + t] = (f32x2){o[2][0] * o[1][0], o[2][1] * o[1][1]};
            tp[lane * 17 + t] = (f32x2){o[0][0] * silu(bflo(gw)), o[0][1] * silu(bfhi(gw))};
        }
        asm volatile("s_waitcnt lgkmcnt(0)" ::: "memory");
#pragma unroll 4
        for (int i = 0; i < 16; ++i) { const int pl = 4 * i + (lane >> 4), tt = lane & 15; const size_t o = (size_t)(cbk * 64 + pl) * CH + t0 + tt;
            HVP[o] = th[pl * 17 + tt]; PMP[o] = tp[pl * 17 + tt]; }
        asm volatile("s_waitcnt lgkmcnt(0)" ::: "memory");
    }
}
typedef short bf16x8 __attribute__((ext_vector_type(8)));
typedef short s16x4 __attribute__((ext_vector_type(4)));
typedef float f32x16 __attribute__((ext_vector_type(16)));
typedef float f32x2_t __attribute__((ext_vector_type(2)));
typedef __bf16 bf16x2_t __attribute__((ext_vector_type(2)));
__device__ __forceinline__ unsigned cvtpk(float lo, float hi) { f32x2_t v = {lo, hi}; bf16x2_t b = __builtin_convertvector(v, bf16x2_t); return __builtin_bit_cast(unsigned, b); }
__device__ __forceinline__ int crow(int r, int hi) { return (r & 3) + 8 * (r >> 2) + 4 * hi; }
__device__ __forceinline__ s16x4 vtr(const LAS unsigned char* p) { return __builtin_bit_cast(s16x4, __builtin_amdgcn_ds_read_tr16_b64_v4i16((LAS s16x4*)p)); }
constexpr int ATT_K = 0;
constexpr int ATT_TB_DIFF = 4 * 8192 + 4 * 16384;
constexpr float C1 = 0.125f * LOG2E;
__device__ __forceinline__ void glds16(const void* gsrc, unsigned lds_dst) { unsigned keep;
    asm volatile("s_mov_b32 %0, m0\n\ts_mov_b32 m0, %2\n\ts_nop 0\n\tglobal_load_lds_dwordx4 %1, off\n\ts_mov_b32 m0, %0" : "=&s"(keep) : "v"(gsrc), "s"(lds_dst) : "memory"); }

template <int VD, bool BIAS, bool OMAX, int G>
__device__ __forceinline__ void flash_pass(LAS unsigned char* lds, const bf16* Qrow, const bf16* Kg, const bf16* Vg, int L, int qpos, int qw0, float bl, float br, f32x16 (&o)[VD / 32], float& l_out) {
    const int tid = ltid(), lane = tid & 63, r32 = lane & 31, hi = lane >> 5;
    constexpr int VROW = VD * 2, VT = 64 * VROW, NVL = VD / 64, NSL = 2 * G, ATT_V = NSL * 8192, ATT_TB = ATT_V + NSL * VT;
    const LAS float* tb = (const LAS float*)(lds + ATT_TB);
    typedef const __attribute__((address_space(1))) u32x4* g4p;
    const int wv = __builtin_amdgcn_readfirstlane(tid >> 6); const int ldsa = (int)(unsigned)(uintptr_t)lds;
    const bf16* ksrc; { const int X = wv * 1024 + lane * 16, line = X >> 8, c16 = ((X >> 4) & 15) ^ (line & 15), key = 2 * line + (c16 >> 3), ch = c16 & 7; ksrc = Kg + (size_t)key * UP + ch * 8; }
    const bf16* vsrc[NVL];
#pragma unroll
    for (int i = 0; i < NVL; ++i) { const int X = i * 8192 + wv * 1024 + lane * 16; const int key = (VD == 64) ? (X >> 7) : (X >> 8), posb = (VD == 64) ? (X & 127) : (X & 255);
        const int swz = (VD == 64) ? (((key >> 1) & 1) << 6) : ((key & 3) << 6); vsrc[i] = Vg + (size_t)key * UP + ((posb ^ swz) >> 1); }
#define ATT_DMA(tt_, sl_) do { const size_t go_ = (size_t)(tt_) * 64 * UP; \
        glds16(ksrc + go_, (unsigned)__builtin_amdgcn_readfirstlane(ldsa + ATT_K + (sl_) * 8192 + wv * 1024)); \
        _Pragma("unroll") for (int i_ = 0; i_ < NVL; ++i_) glds16(vsrc[i_] + go_, (unsigned)__builtin_amdgcn_readfirstlane(ldsa + ATT_V + (sl_) * VT + i_ * 8192 + wv * 1024)); } while (0)
#define ATT_DMAGROUP(g_) do { _Pragma("unroll") for (int j_ = 0; j_ < G; ++j_) { const int tt_ = (g_) * G + j_; ATT_DMA(tt_, tt_ & (NSL - 1)); } } while (0)
#define ATT_BAR() do { __builtin_amdgcn_s_barrier(); asm volatile("" ::: "memory"); } while (0)
    int koff[2][4];
#pragma unroll
    for (int kb = 0; kb < 2; ++kb)
#pragma unroll
        for (int s = 0; s < 4; ++s) { const int key = 32 * kb + r32, line = key >> 1, c16 = ((key & 1) << 3) | (2 * s + hi); koff[kb][s] = line * 256 + ((c16 ^ (line & 15)) << 4); }
    const int q4 = (lane & 15) >> 2, p4 = lane & 3, g1 = (lane >> 4) & 1;
    const int vsw = (VD == 64) ? ((q4 >> 1) & 1) : q4;
    const int vbase = (4 * hi + q4) * VROW + 32 * g1 + 8 * p4;
    bf16x8 qf[4];
#pragma unroll
    for (int s = 0; s < 4; ++s) qf[s] = __builtin_bit_cast(bf16x8, *(g4p)(Qrow + 16 * s + 8 * hi));
    float m_run = OMAX ? -1e30f : 0.f, l_run = 0.f;
    const int nt = L >> 6;
    asm volatile("" :: "v"(qf[0]), "v"(qf[1]), "v"(qf[2]), "v"(qf[3]) : "memory");
    asm volatile("s_waitcnt vmcnt(0)" ::: "memory");
    const int ng = nt / G;
    ATT_DMAGROUP(0); if (ng > 1) ATT_DMAGROUP(1);
    if (ng > 1) { if (G * (1 + NVL) == 8) asm volatile("s_waitcnt vmcnt(8)" ::: "memory"); else asm volatile("s_waitcnt vmcnt(6)" ::: "memory"); } else asm volatile("s_waitcnt vmcnt(0)" ::: "memory");
    static_assert(G * (1 + NVL) == 8 || G * (1 + NVL) == 6, "vmcnt immediates above");
    ATT_BAR();
#pragma unroll 1
    for (int t = 0; t < nt; ++t) {
        const int cur = t & (NSL - 1);
        const LAS unsigned char* kbuf = lds + ATT_K + cur * 8192; const LAS unsigned char* vbuf = lds + ATT_V + cur * VT;
        f32x16 p[2];
        { bf16x8 kf[2][4];
#pragma unroll
          for (int kb = 0; kb < 2; ++kb)
#pragma unroll
            for (int s = 0; s < 4; ++s) kf[kb][s] = *(const LAS bf16x8*)(kbuf + koff[kb][s]);
          __builtin_amdgcn_sched_barrier(0);
#pragma unroll
          for (int kb = 0; kb < 2; ++kb) { f32x16 acc;
#pragma unroll
            for (int r = 0; r < 16; ++r) acc[r] = 0.f;
#pragma unroll
            for (int s = 0; s < 4; ++s) acc = __builtin_amdgcn_mfma_f32_32x32x16_bf16(kf[kb][s], qf[s], acc, 0, 0, 0);
            p[kb] = acc; } }
        s16x4 vlo[2][4], vhi[2][4];
#define VREAD(buf_, db_) do { const int cofs_ = (((db_) ^ vsw) << 6); _Pragma("unroll") for (int kb = 0; kb < 2; ++kb) _Pragma("unroll") for (int ss = 0; ss < 2; ++ss) { \
            const LAS unsigned char* vp_ = vbuf + vbase + (32 * kb + 16 * ss) * VROW + cofs_; vlo[buf_][2 * kb + ss] = vtr(vp_); vhi[buf_][2 * kb + ss] = vtr(vp_ + 8 * VROW); } } while (0)
        VREAD(0, 0);
        __builtin_amdgcn_sched_barrier(0);
        const int k0 = t * 64; float mulc, bconst, mx = -3e38f; bool nearT = false;
        const bool domax = (t & 7) == 0;
        if (BIAS) { const int rlo = k0 - qw0 - 31, rhi = k0 + 63 - qw0; nearT = !(rhi <= -128 || rlo >= 128); }
        if (BIAS && nearT) {
#pragma unroll
            for (int kb = 0; kb < 2; ++kb)
#pragma unroll
                for (int r4 = 0; r4 < 4; ++r4) {
#pragma unroll
                    for (int e = 0; e < 4; ++e) { const int r = 4 * r4 + e; int rel = k0 + 32 * kb + crow(r, hi) - qpos; rel = rel < -128 ? -128 : (rel > 128 ? 128 : rel); const float v = p[kb][r] * C1 + tb[rel + 128]; p[kb][r] = v; mx = fmaxf(mx, v); }
                    __builtin_amdgcn_sched_barrier(0); }
            mulc = 1.0f; bconst = 0.f;
        } else {
            if (OMAX && domax) {
#pragma unroll
                for (int kb = 0; kb < 2; ++kb)
#pragma unroll
                    for (int r = 0; r < 16; ++r) mx = fmaxf(mx, p[kb][r]); }
            bconst = BIAS ? (k0 < qw0 ? bl : br) : 0.f; mx = mx * C1 + bconst; mulc = C1;
        }
        if (OMAX && (domax || (BIAS && nearT))) {
            mx = fmaxf(mx, shx(mx, 32));
            if (__any(mx > m_run)) { const float mn = fmaxf(m_run, mx), al = __builtin_amdgcn_exp2f(m_run - mn); l_run *= al;
#pragma unroll
                for (int db = 0; db < VD / 32; ++db) o[db] *= al;
                m_run = mn; }
        }
        const f32x2 mul2 = (f32x2){mulc, mulc}, add2 = (f32x2){bconst - m_run, bconst - m_run}; f32x2 ls2 = (f32x2){0.f, 0.f};
#pragma unroll
        for (int kb = 0; kb < 2; ++kb)
#pragma unroll
            for (int r = 0; r < 16; r += 2) { f32x2 v = (f32x2){p[kb][r], p[kb][r + 1]}; v = v * mul2 + add2; f32x2 e; e.x = __builtin_amdgcn_exp2f(v.x); e.y = __builtin_amdgcn_exp2f(v.y); ls2 += e; p[kb][r] = e.x; p[kb][r + 1] = e.y; }
        l_run += ls2.x + ls2.y;
        bf16x8 pk[2][2];
#pragma unroll
        for (int kb = 0; kb < 2; ++kb)
#pragma unroll
            for (int ss = 0; ss < 2; ++ss) { u32x4 w; w.x = cvtpk(p[kb][8 * ss + 0], p[kb][8 * ss + 1]); w.y = cvtpk(p[kb][8 * ss + 2], p[kb][8 * ss + 3]); w.z = cvtpk(p[kb][8 * ss + 4], p[kb][8 * ss + 5]); w.w = cvtpk(p[kb][8 * ss + 6], p[kb][8 * ss + 7]);
                pk[kb][ss] = __builtin_bit_cast(bf16x8, w); }
        __builtin_amdgcn_sched_barrier(0);
#pragma unroll
        for (int db = 0; db < VD / 32; ++db) {
            if (db + 1 < VD / 32) { if ((db + 1) & 1) VREAD(1, db + 1); else VREAD(0, db + 1); }
#pragma unroll
            for (int kb = 0; kb < 2; ++kb)
#pragma unroll
                for (int ss = 0; ss < 2; ++ss) { const bf16x8 vf = (db & 1) ? __builtin_shufflevector(vlo[1][2 * kb + ss], vhi[1][2 * kb + ss], 0, 1, 2, 3, 4, 5, 6, 7) : __builtin_shufflevector(vlo[0][2 * kb + ss], vhi[0][2 * kb + ss], 0, 1, 2, 3, 4, 5, 6, 7);
                    o[db] = __builtin_amdgcn_mfma_f32_32x32x16_bf16(vf, pk[kb][ss], o[db], 0, 0, 0); }
            __builtin_amdgcn_sched_barrier(0); }
#undef VREAD
        if (((t + 1) & (G - 1)) == 0) {
            asm volatile("s_waitcnt vmcnt(0)" ::: "memory"); ATT_BAR();
            const int g2 = (t + 1) / G + 1; if (g2 < ng) ATT_DMAGROUP(g2); }
    }
#undef ATT_DMA
#undef ATT_DMAGROUP
#undef ATT_BAR
    l_out = l_run + shx(l_run, 32);
}
__device__ __forceinline__ void gqa_unit(const AV& a, LAS unsigned char* lds, int seqrow0, int L, int h, int qb) {
    const int tid = ltid(), lane = tid & 63, r32 = lane & 31, hi = lane >> 5;
    const bf16* U = (const bf16*)(AWS + WS_U); bf16* Y = (bf16*)(AWS + WS_Y) + (size_t)1 * CH * 512;
    constexpr int G = 4, NSL = 2 * G, VROW = 128, VT = 8192, ATT_V = NSL * 8192;
    typedef const __attribute__((address_space(1))) u32x4* g4p;
    const int wv = __builtin_amdgcn_readfirstlane(tid >> 6); const int ldsa = (int)(unsigned)(uintptr_t)lds;
    const int qw0 = qb * 512 + wv * 64;
    const bf16* Kg = U + (size_t)seqrow0 * UP + C_GK + 64 * (h >> 2); const bf16* Vg = U + (size_t)seqrow0 * UP + C_GV + 64 * (h >> 2);
    const bf16* ksrc; { const int X = wv * 1024 + lane * 16, line = X >> 8, c16 = ((X >> 4) & 15) ^ (line & 15), key = 2 * line + (c16 >> 3), ch = c16 & 7; ksrc = Kg + (size_t)key * UP + ch * 8; }
    const bf16* vsrc; { const int X = wv * 1024 + lane * 16, key = X >> 7, posb = X & 127, swz = ((key >> 1) & 1) << 6; vsrc = Vg + (size_t)key * UP + ((posb ^ swz) >> 1); }
#define GQ_DMA(tt_, sl_) do { const size_t go_ = (size_t)(tt_) * 64 * UP; \
        glds16(ksrc + go_, (unsigned)__builtin_amdgcn_readfirstlane(ldsa + ATT_K + (sl_) * 8192 + wv * 1024)); \
        glds16(vsrc + go_, (unsigned)__builtin_amdgcn_readfirstlane(ldsa + ATT_V + (sl_) * VT + wv * 1024)); } while (0)
#define GQ_DMAGROUP(g_) do { _Pragma("unroll") for (int j_ = 0; j_ < G; ++j_) { const int tt_ = (g_) * G + j_; GQ_DMA(tt_, tt_ & (NSL - 1)); } } while (0)
#define GQ_BAR() do { __builtin_amdgcn_s_barrier(); asm volatile("" ::: "memory"); } while (0)
    int koff[2][4];
#pragma unroll
    for (int kb = 0; kb < 2; ++kb)
#pragma unroll
        for (int s = 0; s < 4; ++s) { const int key = 32 * kb + r32, line = key >> 1, c16 = ((key & 1) << 3) | (2 * s + hi); koff[kb][s] = line * 256 + ((c16 ^ (line & 15)) << 4); }
    const int q4 = (lane & 15) >> 2, p4 = lane & 3, g1 = (lane >> 4) & 1;
    const int vsw = (q4 >> 1) & 1;
    const int vbase = (4 * hi + q4) * VROW + 32 * g1 + 8 * p4;
    bf16x8 qf[2][4];
#pragma unroll
    for (int j = 0; j < 2; ++j)
#pragma unroll
        for (int s = 0; s < 4; ++s) qf[j][s] = __builtin_bit_cast(bf16x8, *(g4p)(U + (size_t)(seqrow0 + qw0 + 32 * j + r32) * UP + C_GQ + 64 * h + 16 * s + 8 * hi));
    f32x16 o[2][2];
#pragma unroll
    for (int j = 0; j < 2; ++j)
#pragma unroll
        for (int db = 0; db < 2; ++db)
#pragma unroll
            for (int r = 0; r < 16; ++r) o[j][db][r] = 0.f;
    float lrun[2] = {0.f, 0.f};
    const int nt = L >> 6, ng = nt / G;
    asm volatile("" :: "v"(qf[0][0]), "v"(qf[0][1]), "v"(qf[0][2]), "v"(qf[0][3]), "v"(qf[1][0]), "v"(qf[1][1]), "v"(qf[1][2]), "v"(qf[1][3]) : "memory");
    asm volatile("s_waitcnt vmcnt(0)" ::: "memory");
    GQ_DMAGROUP(0); if (ng > 1) GQ_DMAGROUP(1);
    if (ng > 1) asm volatile("s_waitcnt vmcnt(8)" ::: "memory"); else asm volatile("s_waitcnt vmcnt(0)" ::: "memory");
    GQ_BAR();
#pragma unroll 1
    for (int t = 0; t < nt; ++t) {
        const int cur = t & (NSL - 1);
        const LAS unsigned char* kbuf = lds + ATT_K + cur * 8192; const LAS unsigned char* vbuf = lds + ATT_V + cur * VT;
        f32x16 p[2][2];
        { bf16x8 kf[2][4];
#pragma unroll
          for (int kb = 0; kb < 2; ++kb)
#pragma unroll
            for (int s = 0; s < 4; ++s) kf[kb][s] = *(const LAS bf16x8*)(kbuf + koff[kb][s]);
          __builtin_amdgcn_sched_barrier(0);
#pragma unroll
          for (int kb = 0; kb < 2; ++kb)
#pragma unroll
            for (int j = 0; j < 2; ++j) { f32x16 acc;
#pragma unroll
              for (int r = 0; r < 16; ++r) acc[r] = 0.f;
#pragma unroll
              for (int s = 0; s < 4; ++s) acc = __builtin_amdgcn_mfma_f32_32x32x16_bf16(kf[kb][s], qf[j][s], acc, 0, 0, 0);
              p[j][kb] = acc; } }
        s16x4 vlo[2][4], vhi[2][4];
#define GQ_VREAD(buf_, db_) do { const int cofs_ = (((db_) ^ vsw) << 6); _Pragma("unroll") for (int kb = 0; kb < 2; ++kb) _Pragma("unroll") for (int ss = 0; ss < 2; ++ss) { \
            const LAS unsigned char* vp_ = vbuf + vbase + (32 * kb + 16 * ss) * VROW + cofs_; vlo[buf_][2 * kb + ss] = vtr(vp_); vhi[buf_][2 * kb + ss] = vtr(vp_ + 8 * VROW); } } while (0)
        bf16x8 pk[2][2][2];
#pragma unroll
        for (int j = 0; j < 2; ++j) { float ls0 = 0.f, ls1 = 0.f;
#pragma unroll
            for (int kb = 0; kb < 2; ++kb) {
#pragma unroll
                for (int r = 0; r < 16; r += 2) { const float e0 = __builtin_amdgcn_exp2f(p[j][kb][r]), e1 = __builtin_amdgcn_exp2f(p[j][kb][r + 1]); ls0 += e0; ls1 += e1; p[j][kb][r] = e0; p[j][kb][r + 1] = e1; }
#pragma unroll
                for (int ss = 0; ss < 2; ++ss) { u32x4 w; w.x = cvtpk(p[j][kb][8 * ss + 0], p[j][kb][8 * ss + 1]); w.y = cvtpk(p[j][kb][8 * ss + 2], p[j][kb][8 * ss + 3]); w.z = cvtpk(p[j][kb][8 * ss + 4], p[j][kb][8 * ss + 5]); w.w = cvtpk(p[j][kb][8 * ss + 6], p[j][kb][8 * ss + 7]);
                    pk[j][kb][ss] = __builtin_bit_cast(bf16x8, w); } }
            lrun[j] += ls0 + ls1; }
        __builtin_amdgcn_sched_barrier(0);
        GQ_VREAD(0, 0); GQ_VREAD(1, 1);
#pragma unroll
        for (int db = 0; db < 2; ++db) {
#pragma unroll
            for (int kb = 0; kb < 2; ++kb)
#pragma unroll
                for (int ss = 0; ss < 2; ++ss) { const bf16x8 vf = db ? __builtin_shufflevector(vlo[1][2 * kb + ss], vhi[1][2 * kb + ss], 0, 1, 2, 3, 4, 5, 6, 7) : __builtin_shufflevector(vlo[0][2 * kb + ss], vhi[0][2 * kb + ss], 0, 1, 2, 3, 4, 5, 6, 7);
#pragma unroll
                    for (int j = 0; j < 2; ++j) o[j][db] = __builtin_amdgcn_mfma_f32_32x32x16_bf16(vf, pk[j][kb][ss], o[j][db], 0, 0, 0); }
            __builtin_amdgcn_sched_barrier(0); }
#undef GQ_VREAD
        if (((t + 1) & (G - 1)) == 0) { asm volatile("s_waitcnt vmcnt(0)" ::: "memory"); GQ_BAR(); const int g2 = (t + 1) / G + 1; if (g2 < ng) GQ_DMAGROUP(g2); }
    }
#undef GQ_DMA
#undef GQ_DMAGROUP
#undef GQ_BAR
#pragma unroll
    for (int j = 0; j < 2; ++j) { const int lane2 = ltid() & 63, r32b = lane2 & 31, hib = lane2 >> 5;
        const float l = lrun[j] + shx(lrun[j], 32); const float inv = 1.0f / l; const size_t row = (size_t)(seqrow0 + qw0 + 32 * j + r32b);
#pragma unroll
        for (int db = 0; db < 2; ++db)
#pragma unroll
            for (int g = 0; g < 4; ++g) { const int d = 32 * db + 8 * g + 4 * hib; const u32x2 gw = *(const u32x2*)(U + row * UP + C_GG + 64 * h + d);
                const float y0 = o[j][db][4 * g] * inv * silu(bflo(gw.x)), y1 = o[j][db][4 * g + 1] * inv * silu(bfhi(gw.x)), y2 = o[j][db][4 * g + 2] * inv * silu(bflo(gw.y)), y3 = o[j][db][4 * g + 3] * inv * silu(bfhi(gw.y));
                u32x2 w; w.x = cvtpk(y0, y1); w.y = cvtpk(y2, y3); *(u32x2*)(Y + row * 512 + 64 * h + d) = w; } }
}
__device__ __forceinline__ void diff_unit(const AV& a, LAS unsigned char* lds, int seqrow0, int L, int h, int qb, int layer) {
    const int tid = ltid(), lane = tid & 63, wave = tid >> 6, r32 = lane & 31, hi = lane >> 5;
    const bf16* U = (const bf16*)(AWS + WS_U); bf16* Y = (bf16*)(AWS + WS_Y) + (size_t)2 * CH * 512; float* DT = (float*)(AWS + WS_DT);
    const float* relb = AIN(I_RELB);
    LAS float* tb = (LAS float*)(lds + ATT_TB_DIFF);
    for (int i = tid; i < 257; i += NT) { const int rel = i - 128, n = rel < 0 ? -rel : rel; int b = rel > 0 ? 16 : 0;
        if (n < 8) b += n; else { const int v = 8 + (31 - __builtin_clz((unsigned)(n * n))) - 6; b += v < 15 ? v : 15; }
        tb[i] = relb[b * 4 + h] * LOG2E; }
    const float bl = relb[15 * 4 + h] * LOG2E, br = relb[31 * 4 + h] * LOG2E;
    float lyf = (float)layer; asm volatile("" : "+v"(lyf));
    const float li = 0.8f - 0.6f * __expf(-0.3f * lyf);
    float d1, d2; { const float q1 = AIN(I_LQ1)[layer * 64 + lane], k1 = AIN(I_LK1)[layer * 64 + lane], q2 = AIN(I_LQ2)[layer * 64 + lane], k2 = AIN(I_LK2)[layer * 64 + lane]; d1 = wave_sum(q1 * k1); d2 = wave_sum(q2 * k2); }
    const float lam = __expf(d1) - __expf(d2) + li;
    const int qw0 = qb * 256 + wave * 32, qpos = qw0 + r32; const size_t row = (size_t)(seqrow0 + qpos);
    __syncthreads();
    f32x16 o[4]; float l; float ss = 0.f;
#pragma unroll 1
    for (int c = 0; c < 2; ++c) {
#pragma unroll
        for (int db = 0; db < 4; ++db)
#pragma unroll
            for (int r = 0; r < 16; ++r) o[db][r] = 0.f;
        flash_pass<128, true, true, 2>(lds, U + row * UP + C_DQ + 128 * h + 64 * c, U + (size_t)seqrow0 * UP + C_DK + 128 * h + 64 * c, U + (size_t)seqrow0 * UP + C_DV + 128 * h, L, qpos, qw0, bl, br, o, l);
        if (c == 0) { const float inv = 1.0f / l;
#pragma unroll
            for (int db = 0; db < 4; ++db)
#pragma unroll
                for (int g = 0; g < 4; ++g) { const int d = 32 * db + 8 * g + 4 * hi; *(f32x4*)(DT + row * 512 + 128 * h + d) = (f32x4){o[db][4 * g] * inv, o[db][4 * g + 1] * inv, o[db][4 * g + 2] * inv, o[db][4 * g + 3] * inv}; }
        } else { const float inv = lam / l;
#pragma unroll
            for (int db = 0; db < 4; ++db)
#pragma unroll
                for (int g = 0; g < 4; ++g) { const int d = 32 * db + 8 * g + 4 * hi; const f32x4 o0 = *(const f32x4*)(DT + row * 512 + 128 * h + d);
#pragma unroll
                    for (int e = 0; e < 4; ++e) { const float v = o0[e] - o[db][4 * g + e] * inv; o[db][4 * g + e] = v; ss += v * v; } }
        }
    }
    ss += shx(ss, 32);
    const float rs = (1.0f / sqrtf(ss * (1.0f / 128.0f) + EPS)) * (1.0f - li);
    const float* sg = AIN(I_SUBLN) + layer * 128;
#pragma unroll
    for (int db = 0; db < 4; ++db)
#pragma unroll
        for (int g = 0; g < 4; ++g) { const int d = 32 * db + 8 * g + 4 * hi; const u32x2 gw = *(const u32x2*)(U + row * UP + C_DG + 128 * h + d); const f32x4 gn = *(const f32x4*)(sg + d);
            const float y0 = o[db][4 * g] * rs * gn.x * silu(bflo(gw.x)), y1 = o[db][4 * g + 1] * rs * gn.y * silu(bfhi(gw.x)), y2 = o[db][4 * g + 2] * rs * gn.z * silu(bflo(gw.y)), y3 = o[db][4 * g + 3] * rs * gn.w * silu(bfhi(gw.y));
            u32x2 w; w.x = cvtpk(y0, y1); w.y = cvtpk(y2, y3); *(u32x2*)(Y + row * 512 + 128 * h + d) = w; }
}
template <int LOG4, int BATCH> __device__ __forceinline__ void hyena_unit(const AV& a, LAS unsigned char* lds, int seqrow0, int pr0, int layer) {
    constexpr int N = 1 << (2 * LOG4), L = N / 2, NPAD = N + N / 16;
    const int tid = ltid(); LAS f32x2* buf = (LAS f32x2*)lds;
    bf16* Y = (bf16*)(AWS + WS_Y) + (size_t)seqrow0 * 512;
    const unsigned char* sp = AWS + WS_SPEC + layer * SPEC_LAYER;
    constexpr int SPS = (LOG4 == 7) ? SPS_P : SPS_S;
    const f32x2* Pg = ((LOG4 == 7) ? (const f32x2*)sp : (const f32x2*)(sp + 2 * SPEC_P_BYTES)) + (size_t)pr0 * SPS;
    const f32x2* Mg = ((LOG4 == 7) ? (const f32x2*)(sp + SPEC_P_BYTES) : (const f32x2*)(sp + 2 * SPEC_P_BYTES + SPEC_S_BYTES)) + (size_t)pr0 * SPS;
    const f32x2* hvp = (const f32x2*)(AWS + WS_HVP) + (size_t)pr0 * CH + seqrow0; const f32x2* pmp = (const f32x2*)(AWS + WS_PMP) + (size_t)pr0 * CH + seqrow0;
#pragma unroll
    for (int b = 0; b < BATCH; ++b)
        for (int t = tid; t < L; t += NT) { buf[b * NPAD + PADI(t)] = hvp[(size_t)b * CH + t]; buf[b * NPAD + PADI(t + L)] = (f32x2){0.f, 0.f}; }
    __syncthreads();
    const f32x2* tw = (const f32x2*)(AWS + WS_TW);
    fft_fwd<LOG4, BATCH>(buf, tw, tid);
#pragma unroll
    for (int b = 0; b < BATCH; ++b)
        for (int k = tid; k <= L; k += NT) { const int p1 = b * NPAD + PADI(digitrev<LOG4>(k)), p2 = b * NPAD + PADI(digitrev<LOG4>((N - k) & (N - 1))); const f32x2 z1 = buf[p1], z2 = buf[p2], P = Pg[(size_t)b * SPS + k], M = Mg[(size_t)b * SPS + k];
            const f32x2 y1 = cmul(z1, P) + cmul(cconj(z2), M), y2 = cmulc(z2, P) + cmulc(cconj(z1), M);
            buf[p1] = y1; if (p2 != p1) buf[p2] = y2; }
    __syncthreads();
    fft_inv<LOG4, BATCH>(buf, tw, tid);
    for (int t = tid; t < L; t += NT) { unsigned w[BATCH];
#pragma unroll
        for (int b = 0; b < BATCH; ++b) { const f32x2 y = buf[b * NPAD + PADI(t)], m = pmp[(size_t)b * CH + t]; w[b] = cvtpk(y.x * m.x, y.y * m.y); }
        if (BATCH == 4) *(u32x4*)(Y + (size_t)t * 512 + 2 * pr0) = (u32x4){w[0], w[BATCH > 1 ? 1 : 0], w[BATCH > 2 ? 2 : 0], w[BATCH > 3 ? 3 : 0]};
        else *(unsigned*)(Y + (size_t)t * 512 + 2 * pr0) = w[0]; }
    __syncthreads();
}
#define XB_TMO      128
#define XB_XCNT(j)  (256  + 64 * (j))
#define XB_XSUB(j)  (1280 + 64 * (j))
#define XB_XGEN(j)  (2304 + 64 * (j))
#define XB_TOP      3328
#define XB_TOPGEN   3392
#define XCD_BAR_WORDS 3456
#define XB_SPIN_CAP (1u << 18)

__device__ __forceinline__ unsigned xb_ld(unsigned* p)              { return __hip_atomic_load(p, __ATOMIC_RELAXED, __HIP_MEMORY_SCOPE_AGENT); }
__device__ __forceinline__ unsigned xb_add(unsigned* p, unsigned v) { return __hip_atomic_fetch_add(p, v, __ATOMIC_RELAXED, __HIP_MEMORY_SCOPE_AGENT); }
__device__ __forceinline__ unsigned xb_xcc_id() { return (unsigned)__builtin_amdgcn_s_getreg((3 << 11) | 20) & 0xFu; }
#define XB_SPIN(cond, bar) do { unsigned _sp = 0; while (cond) { __builtin_amdgcn_s_sleep(1); \
    if ((++_sp & 255u) == 0u) { if (xb_ld(&(bar)[XB_TMO])) break; if (_sp > XB_SPIN_CAP) { atomicAdd(&(bar)[XB_TMO], 1u); break; } } } } while (0)

struct XcdBarrier {
    unsigned* bar; unsigned x;
    volatile LAS unsigned* st;
};

__device__ __forceinline__ XcdBarrier xcd_barrier_post(unsigned* bar, volatile LAS unsigned* st) {
    XcdBarrier b; b.bar = bar; b.x = xb_xcc_id(); b.st = st;
    if (threadIdx.x == 0) (void)xb_add(&bar[XB_XCNT(b.x)], 1u);
    return b;
}
__device__ __forceinline__ void xcd_barrier_complete(unsigned* bar, unsigned x, unsigned& nloc, unsigned& nx) {
    const unsigned G = gridDim.x * gridDim.y * gridDim.z;
    unsigned sum, cnt, mine, sp = 0u;
    for (;;) {
        sum = 0u; cnt = 0u; mine = 0u;
#pragma unroll
        for (unsigned j = 0; j < 16; ++j) { const unsigned c = xb_ld(&bar[XB_XCNT(j)]); sum += c; cnt += (c > 0u) ? 1u : 0u; mine = (j == x) ? c : mine; }
        if (sum == G) break;
        __builtin_amdgcn_s_sleep(1);
        if ((++sp & 255u) == 0u) { if (xb_ld(&bar[XB_TMO])) break; if (sp > XB_SPIN_CAP) { atomicAdd(&bar[XB_TMO], 1u); break; } }
    }
    nloc = mine > 0u ? mine : 1u; nx = cnt > 0u ? cnt : 1u;
}

__device__ __forceinline__ void xcd_barrier(const XcdBarrier& b) {
    asm volatile("s_waitcnt vmcnt(0)" ::: "memory");
    __syncthreads();
    if (threadIdx.x == 0) {
        unsigned* bar = b.bar;
        __builtin_amdgcn_s_waitcnt(0);
        unsigned nloc = b.st[0], nx = b.st[1];
        if (nloc == 0u) { xcd_barrier_complete(bar, b.x, nloc, nx); b.st[0] = nloc; b.st[1] = nx; }
        const unsigned old = xb_add(&bar[XB_XSUB(b.x)], 1u);
        const unsigned gen = old / nloc;
        if (old + 1u == (gen + 1u) * nloc) {
            __builtin_amdgcn_fence(__ATOMIC_RELEASE, "agent");
            asm volatile("s_waitcnt vmcnt(0)" ::: "memory");
            const unsigned og = xb_add(&bar[XB_TOP], 1u);
            const unsigned tg = og / nx;
            if (og + 1u == (tg + 1u) * nx) xb_add(&bar[XB_TOPGEN], 1u);
            else XB_SPIN(xb_ld(&bar[XB_TOPGEN]) == tg, bar);
            __builtin_amdgcn_fence(__ATOMIC_ACQUIRE, "agent");
            xb_add(&bar[XB_XGEN(b.x)], 1u);
            asm volatile("s_waitcnt vmcnt(0)" ::: "memory");
        } else {
            XB_SPIN(xb_ld(&bar[XB_XGEN(b.x)]) == gen, bar);
            __builtin_amdgcn_fence(__ATOMIC_ACQUIRE, "agent");
            asm volatile("s_waitcnt vmcnt(0)" ::: "memory");
        }
    }
    __syncthreads();
}

__device__ __forceinline__ void step_mix(const AV& a, LAS unsigned char* lds, int c, int layer, unsigned* ctr, int tmask) {
    const Chunk ck = chunk_of(c); const int nqb = ck.L / 256, nqg = ck.L / 512, nD = ck.nseq * 4 * nqb, nG = ck.nseq * 8 * nqg, nF = (ck.L == LP) ? ck.nseq * 256 : ck.nseq * 64, total = nD + nG + nF;
    volatile LAS unsigned* wq = (volatile LAS unsigned*)(lds + LDS_MAIN);
    for (;;) {
        if (ltid() == 0) wq[0] = atomicAdd(ctr, 1u);
        __syncthreads();
        const int u = (int)wq[0];
        __syncthreads();
        if (u >= total) break;
        if (u < nD) { if (tmask & 1) { const int qb = u % nqb, sh = u / nqb, h = sh & 3, s = sh >> 2; diff_unit(a, lds, s * ck.L, ck.L, h, qb, layer); } }
        else if (u < nD + nG) { if (tmask & 2) { const int v = u - nD, qb = v % nqg, sh = v / nqg, h = sh & 7, s = sh >> 3; gqa_unit(a, lds, s * ck.L, ck.L, h, qb); } }
        else { if (tmask & 4) { const int v = u - nD - nG; if (ck.L == LP) hyena_unit<7, 1>(a, lds, (v >> 8) * LP, v & 255, layer); else hyena_unit<6, 4>(a, lds, (v >> 6) * LS, (v & 63) * 4, layer); } }
    }
}
constexpr int STEPS_PER = 6, NPRO = 3, NSTEPS = NPRO + NCHUNK * 2 * STEPS_PER + 1;
__global__ void __launch_bounds__(NT, 2) mega_fwd(Args kargs) {
    extern __shared__ __attribute__((aligned(16))) unsigned char lds_raw[];
    LAS unsigned char* lds = (LAS unsigned char*)lds_raw;
    kargp_t kp = (kargp_t)__builtin_amdgcn_kernarg_segment_ptr();
    { volatile LAS unsigned* misc = (volatile LAS unsigned*)(lds + LDS_MAIN + 64); if (ltid() < 16) misc[ltid()] = 0u; }
    __syncthreads();
    XcdBarrier xbar = xcd_barrier_post((unsigned*)(kargs.ws + WS_CTL) + CW_BAR, (volatile LAS unsigned*)(lds + LDS_MAIN + 64 + 32));
    const int step_lo = kargs.lo, step_hi = kargs.hi;
#pragma unroll 1
    for (int step = step_lo; step < step_hi; ++step) {
        asm volatile("" : "+s"(kp));
        AV a; a.p = kp; unsigned char* ws = AWS;
        if (step == 0) { if (EN(0)) step_pro_a(a, lds); }
        else if (step == 1) { if (EN(11)) { step_pro_a2(a, lds); if (DUP_MASK & 32) { xcd_barrier(xbar); step_pro_a2(a, lds); } } }
        else if (step == 2) { if (EN(1)) { step_pro_b(a, lds); if (DUP_MASK & 64) { xcd_barrier(xbar); step_pro_b(a, lds); } } }
        else if (step == NSTEPS - 1) { if (DUP_MASK & 256) { for (int q = 0; q < 100; ++q) xcd_barrier(xbar); } if (EN(2)) step_final(a, (NCHUNK - 1) * CH, NTOK); }
        else {
            const int s2 = step - NPRO, cl = s2 / STEPS_PER, k = s2 - cl * STEPS_PER, c = cl >> 1, layer = cl & 1;
            const Chunk ck = chunk_of(c);
            if (k == 0) { if (layer == 0) { if (c > 0 && EN(2)) step_final(a, (c - 1) * CH, c * CH); } continue;     }
            else if (k == 2) { if (EN(5)) { step_prep(a, c, layer); step_prep_hy(a, lds, c, layer); if (layer == 0) { float* q = (float*)(ws + WS_SSQ); for (int i = lbid() * NT + ltid(); i < CH; i += (int)gridDim.x * NT) q[i] = 0.f; } } }
            else if (k == 3) {
#pragma unroll 1
                for (int rep = 0; rep < ((DUP_MASK & 7) ? 2 : 1); ++rep) { if (rep) xcd_barrier(xbar); step_mix(a, lds, c, layer, (unsigned*)(ws + WS_CTL) + step * 16 + 4 * rep, rep ? (DUP_MASK & 7) : 7); } }
            else { if (EN(4)) {
                pg8::Gemm g; pg8::OrderAll S; pg8::EpiAll E; const int G = (int)gridDim.x, bid = lbid();
                S.so.init(CH, k == 1 ? NCAT : 1024, G, bid); S.o2 = pg8::OrderG2{CH / 256, G, bid}; S.mode = (k == 4) ? 2 : 1;
                float* O = AOUT + (size_t)ck.tok0 * DM; const float* X = layer == 0 ? xin_rows(a, ck.tok0) : O;
                E.mode = (k == 1) ? 1 : (k == 4) ? 2 : 3;
                E.e1 = pg8::EpiG1{(pg8::bf16_t*)(ws + WS_U), (pg8::bf16_t*)(ws + WS_G), AIN(I_BMERGE) + layer * GP, layer == 1 ? (const float*)(ws + WS_SSQ) : (const float*)nullptr};
                E.e2 = pg8::EpiG2{(const pg8::bf16_t*)(ws + WS_G), (float*)(ws + WS_TMP), (pg8::bf16_t*)(ws + WS_MG), CH / 256};
                E.e3 = pg8::EpiG3{X, O, AIN(I_NORMG) + DM, (pg8::bf16_t*)(ws + WS_HN), (float*)(ws + WS_SSQ), layer == 0 ? 1 : 0};
                if (k == 1) g = pg8::Gemm{layer == 0 ? (const pg8::bf16_t*)(ws + WS_HN0) + (size_t)ck.tok0 * DM : (const pg8::bf16_t*)(ws + WS_HN), (const pg8::bf16_t*)(ws + WS_WCAT + layer * WCAT_BYTES), CH, NCAT, 1024};
                else if (k == 4) g = pg8::Gemm{(const pg8::bf16_t*)(ws + WS_Y), (const pg8::bf16_t*)(ws + WS_WBT + layer * WBT_BYTES), 3 * CH, 3072, 512};
                else g = pg8::Gemm{(const pg8::bf16_t*)(ws + WS_MG), (const pg8::bf16_t*)(ws + WS_WOT + layer * WOT_BYTES), CH, 1024, 1024};
                const int nrep = (((DUP_MASK & 8) && k == 1) || ((DUP_MASK & 16) && k == 4)) ? 2 : 1;
#pragma unroll 1
                for (int rep = 0; rep < nrep; ++rep) { if (rep) xcd_barrier(xbar); pg8::gemm_phase<pg8::EpiAll, pg8::OrderAll, true, true>(lds, g, S, E); }
            } }
        }
        if (step + 1 < step_hi) { if (step == 0) cg::this_grid().sync(); else xcd_barrier(xbar); }
    }
}
#ifndef MK_MULTI
#define MK_MULTI 0
#endif
extern "C" void kernel_launch(void* const* d_in, const int* in_sizes, int n_in, void* d_out, int out_size, void* d_ws, size_t ws_size, hipStream_t stream) {
    static int grid = 0;
    if (grid == 0) {
        if (n_in != N_IN || out_size != NTOK * DM || ws_size < WS_END) { fprintf(stderr, "kernel_launch: unexpected shapes (n_in %d, out %d, ws %zu)\n", n_in, out_size, ws_size); grid = -1; return; }
        int dev = 0, cus = 0, per_cu = 0;
        hipGetDevice(&dev); hipDeviceGetAttribute(&cus, hipDeviceAttributeMultiprocessorCount, dev);
        if (hipFuncSetAttribute((const void*)mega_fwd, hipFuncAttributeMaxDynamicSharedMemorySize, LDS_BYTES) != hipSuccess) { fprintf(stderr, "kernel_launch: hipFuncSetAttribute failed\n"); grid = -1; return; }
        hipOccupancyMaxActiveBlocksPerMultiprocessor(&per_cu, (const void*)mega_fwd, NT, LDS_BYTES);
        (void)hipGetLastError();
        if (per_cu < 1) per_cu = 1;
        grid = cus * 1;
        fprintf(stderr, "kernel_launch: cus %d per_cu %d grid %d\n", cus, per_cu, grid);
    }
    if (grid < 0) return;
    hipMemsetAsync((char*)d_ws + WS_CTL, 0, CTL_BYTES, stream);
    Args a{};
    for (int i = 0; i < N_IN; ++i) a.in[i] = (const float*)d_in[i];
    a.out = (float*)d_out; a.ws = (unsigned char*)d_ws;
#if MK_MULTI
    for (int s = 0; s < NSTEPS; ++s) { a.lo = s; a.hi = s + 1; hipLaunchKernelGGL(mega_fwd, dim3(grid), dim3(NT), LDS_BYTES, stream, a); }
#else
    a.lo = 0; a.hi = NSTEPS;
    void* args[] = {&a};
    hipError_t e = hipLaunchCooperativeKernel((const void*)mega_fwd, dim3(grid), dim3(NT), args, LDS_BYTES, stream);
    if (e != hipSuccess) fprintf(stderr, "cooperative launch failed: %s (grid %d)\n", hipGetErrorString(e), grid);
#endif
}
```

```cpp
#include <hip/hip_runtime.h>
#include <hip/hip_cooperative_groups.h>
#include <cstdio>
#include <cstdint>
namespace cg = cooperative_groups;
__device__ __forceinline__ int ltid() { int t = (int)threadIdx.x; asm volatile("" : "+v"(t)); return t; }
__device__ __forceinline__ float shx(float v, int o) { const int l = ltid() & 63; return __int_as_float(__builtin_amdgcn_ds_bpermute((l ^ o) << 2, __float_as_int(v))); }
__device__ __forceinline__ int lbid() { int b = (int)blockIdx.x; asm volatile("" : "+s"(b)); return b; }
namespace pg8 {
#define PG8_LAS __attribute__((address_space(3)))
typedef unsigned short bf16_t;
typedef short bf16x8 __attribute__((ext_vector_type(8)));
typedef float f32x4 __attribute__((ext_vector_type(4)));
typedef unsigned u32x4 __attribute__((ext_vector_type(4)));
constexpr int BM = 256, BK = 64, HALF = 128, HTB = HALF * BK * 2  , STAGE_BYTES = 8 * HTB, NXCD = 8, WGM = 8;

__host__ __device__ __forceinline__ int lds_byte(int r, int c) { const int st = (r >> 4) * 2 + (c >> 5), rr = r & 15, cc = c & 31, ob = rr * 64 + cc * 2; return st * 1024 + (ob ^ (((ob >> 9) & 1) << 5)); }
__host__ __device__ __forceinline__ void stage_rc(int b, int& R, int& C) { const int st = b / 1024, sb = b % 1024, swz = sb ^ (((sb >> 9) & 1) << 5); R = (st >> 1) * 16 + swz / 64; C = (st & 1) * 32 + (swz % 64) / 2; }
__host__ __device__ __forceinline__ int perm32(int rho) { const int n = rho >> 4, i = rho & 15; return 8 * (i >> 2) + 4 * n + (i & 3); }

struct Unit { int pm, pn; };
struct Gemm { const bf16_t* A; const bf16_t* Bt; int M, N, K; };

struct StaticOrder {
    int nM, nN, nwg, G, c;
    __host__ __device__ void init(int M, int N, int G_, int c_) { nM = M / BM; nN = N / BM; nwg = nM * nN; G = G_; c = c_; }
    __host__ __device__ bool next(int i, Unit& u) const {
        const long L = (long)i * G + c; if (L >= nwg) return false;
        int wgid = (int)L; { const int q = nwg / NXCD, r = nwg % NXCD, xcd = wgid % NXCD, off = wgid / NXCD; wgid = (xcd < r ? xcd * (q + 1) : r * (q + 1) + (xcd - r) * q) + off; }
        const int nig = WGM * nN, gid = wgid / nig, fm = gid * WGM, gsz = (nM - fm) < WGM ? (nM - fm) : WGM;
        u.pm = fm + ((wgid % nig) % gsz); u.pn = (wgid % nig) / gsz; return true;
    }
    __device__ __forceinline__ void a_ready(const Unit&) const {}
    __device__ __forceinline__ void done(const Unit&) const {}
};

__device__ __forceinline__ unsigned cvt_pk_bf16(float lo, float hi) { unsigned r; asm volatile("v_cvt_pk_bf16_f32 %0, %1, %2" : "=v"(r) : "v"(lo), "v"(hi)); return r; }
template <class Epi, class Sched, bool ALIGN_EPI = false, bool SP2 = false>
__device__ __forceinline__ void gemm_phase(PG8_LAS unsigned char* lds, const Gemm g, const Sched& S, const Epi& E) {
    const int tid = ltid(), wid = __builtin_amdgcn_readfirstlane(tid >> 6), lane = tid & 63, wr = wid >> 2, wc = wid & 3, fr = lane & 15, fq = lane >> 4;
    const int K = g.K, nt = K / BK;
    unsigned voffA[2], voffB[2];
#pragma unroll
    for (int i = 0; i < 2; ++i) { int R, C; stage_rc(tid * 16 + i * 8192, R, C); const int Rb = Epi::PERM ? ((R & ~31) + perm32(R & 31)) : R;
        voffA[i] = (unsigned)(R * K + C) * 2u; voffB[i] = (unsigned)(Rb * K + C) * 2u; }
    const size_t kstep = (size_t)(BK * 2);
    const size_t hstep = (size_t)HALF * K * 2;
    const size_t tstep = 2 * hstep;
    const unsigned ldsw = (unsigned)wid * 1024u;
    const int aoff = lds_byte(wr * 64 + fr, fq * 8), boff = lds_byte(wc * 32 + fr, fq * 8);
#define PG8_SA(b, h) (((b) * 2 + (h)) * HTB)
#define PG8_SB(b, h) ((4 + (b) * 2 + (h)) * HTB)
#define PG8_STAGE(bufoff, gbase, voff) do { _Pragma("unroll") for (int _i = 0; _i < 2; ++_i) \
        __builtin_amdgcn_global_load_lds((const unsigned*)((const char*)(gbase) + (voff)[_i]), (PG8_LAS unsigned*)(lds + (bufoff) + ldsw + _i * 8192), 16, 0, 0); } while (0)
#define PG8_LDA(dst, b, h) do { _Pragma("unroll") for (int m = 0; m < 4; ++m) _Pragma("unroll") for (int k = 0; k < 2; ++k) dst[m][k] = *(const PG8_LAS bf16x8*)(lds + PG8_SA(b, h) + aoff + m * 2048 + k * 1024); } while (0)
#define PG8_LDB(dst, b, h) do { _Pragma("unroll") for (int n = 0; n < 2; ++n) _Pragma("unroll") for (int k = 0; k < 2; ++k) dst[n][k] = *(const PG8_LAS bf16x8*)(lds + PG8_SB(b, h) + boff + n * 2048 + k * 1024); } while (0)
#define PG8_MMA(ai, bj, At, Bt) do { __builtin_amdgcn_s_setprio(1); _Pragma("unroll") for (int m = 0; m < 4; ++m) _Pragma("unroll") for (int n = 0; n < 2; ++n) _Pragma("unroll") for (int k = 0; k < 2; ++k) \
        acc[ai][bj][m][n] = __builtin_amdgcn_mfma_f32_16x16x32_bf16(Bt[n][k], At[m][k], acc[ai][bj][m][n], 0, 0, 0); __builtin_amdgcn_s_setprio(0); } while (0)
#define PG8_WAIT_V(n) asm volatile("s_waitcnt vmcnt(" #n ")" ::: "memory")
#define PG8_WAIT_L(n) asm volatile("s_waitcnt lgkmcnt(" #n ")" ::: "memory")
#define PG8_BAR __builtin_amdgcn_s_barrier()
#define PG8_SCHED __builtin_amdgcn_sched_barrier(0)
    Unit cur, nxt; int ui = 0;
    if (!S.next(0, cur)) return;
    f32x4 acc[2][2][4][2];
#pragma unroll
    for (int a = 0; a < 2; ++a)
#pragma unroll
        for (int b = 0; b < 2; ++b)
#pragma unroll
            for (int m = 0; m < 4; ++m)
#pragma unroll
                for (int n = 0; n < 2; ++n) acc[a][b][m][n] = (f32x4){0.f, 0.f, 0.f, 0.f};
    bf16x8 At[4][2], B0[2][2], B1[2][2];
    const char* cA = (const char*)g.A + (size_t)cur.pm * tstep; const char* cB = (const char*)g.Bt + (size_t)cur.pn * tstep;
    S.a_ready(cur);
    if constexpr (SP2) {
        PG8_STAGE(PG8_SB(0, 0), cB, voffB); PG8_STAGE(PG8_SB(0, 1), cB + hstep, voffB); PG8_STAGE(PG8_SA(0, 0), cA, voffA); PG8_STAGE(PG8_SA(0, 1), cA + hstep, voffA);
        if (wr == 1) PG8_BAR;
        PG8_WAIT_V(2); PG8_BAR;
        PG8_STAGE(PG8_SB(1, 0), cB + kstep, voffB); PG8_STAGE(PG8_SA(1, 0), cA + kstep, voffA); PG8_STAGE(PG8_SB(1, 1), cB + hstep + kstep, voffB);
        PG8_WAIT_V(6); PG8_BAR;
    } else {
        PG8_STAGE(PG8_SB(0, 0), cB, voffB); PG8_STAGE(PG8_SA(0, 0), cA, voffA); PG8_STAGE(PG8_SB(0, 1), cB + hstep, voffB); PG8_STAGE(PG8_SA(0, 1), cA + hstep, voffA);
        if (wr == 1) PG8_BAR;
        PG8_WAIT_V(4); PG8_BAR;
        PG8_STAGE(PG8_SB(1, 0), cB + kstep, voffB); PG8_STAGE(PG8_SA(1, 0), cA + kstep, voffA); PG8_STAGE(PG8_SB(1, 1), cB + hstep + kstep, voffB);
        PG8_WAIT_V(6); PG8_BAR;
    }
    for (;;) {
        const bool has_next = S.next(ui + 1, nxt);
        const char* nA = has_next ? (const char*)g.A + (size_t)nxt.pm * tstep : cA; const char* nB = has_next ? (const char*)g.Bt + (size_t)nxt.pn * tstep : cB;
        for (int t = 0; t < nt; t += 2) {
            const bool last = (t == nt - 2);
            const char* a1 = cA + (size_t)(t + 1) * kstep;
            const char* a2 = last ? nA : cA + (size_t)(t + 2) * kstep; const char* b2 = last ? nB : cB + (size_t)(t + 2) * kstep;
            const char* a3 = a2 + kstep; const char* b3 = b2 + kstep;
            if (last && has_next) S.a_ready(nxt);
            if constexpr (SP2) {
            PG8_LDB(B0, 0, 0); PG8_LDB(B1, 0, 1); PG8_SCHED; PG8_LDA(At, 0, 0); PG8_STAGE(PG8_SA(1, 1), a1 + hstep, voffA);
            PG8_WAIT_V(8); PG8_WAIT_L(0); PG8_BAR; PG8_MMA(0, 0, At, B0); PG8_MMA(0, 1, At, B1); PG8_BAR; PG8_SCHED;
            PG8_LDA(At, 0, 1); PG8_STAGE(PG8_SB(0, 0), b2, voffB); PG8_STAGE(PG8_SB(0, 1), b2 + hstep, voffB); PG8_STAGE(PG8_SA(0, 0), a2, voffA);
            PG8_WAIT_V(8); PG8_WAIT_L(0); PG8_BAR; PG8_MMA(1, 0, At, B0); PG8_MMA(1, 1, At, B1); PG8_BAR; PG8_SCHED;
            PG8_LDB(B0, 1, 0); PG8_LDB(B1, 1, 1); PG8_SCHED; PG8_LDA(At, 1, 0); PG8_STAGE(PG8_SA(0, 1), a2 + hstep, voffA);
            PG8_WAIT_V(8); PG8_WAIT_L(0); PG8_BAR; PG8_MMA(0, 0, At, B0); PG8_MMA(0, 1, At, B1); PG8_BAR; PG8_SCHED;
            PG8_LDA(At, 1, 1); PG8_STAGE(PG8_SB(1, 0), b3, voffB); PG8_STAGE(PG8_SB(1, 1), b3 + hstep, voffB); PG8_STAGE(PG8_SA(1, 0), a3, voffA);
            PG8_WAIT_V(8); PG8_WAIT_L(0); PG8_BAR; PG8_MMA(1, 0, At, B0); PG8_MMA(1, 1, At, B1); PG8_BAR; PG8_SCHED;
            } else {
            PG8_LDB(B0, 0, 0); PG8_SCHED; PG8_LDA(At, 0, 0); PG8_STAGE(PG8_SA(1, 1), a1 + hstep, voffA);
            PG8_WAIT_L(8); PG8_BAR; PG8_WAIT_L(0); PG8_MMA(0, 0, At, B0); PG8_BAR; PG8_SCHED;
            PG8_LDB(B1, 0, 1); PG8_STAGE(PG8_SB(0, 0), b2, voffB);
            PG8_BAR; PG8_WAIT_L(0); PG8_MMA(0, 1, At, B1); PG8_BAR;
            PG8_LDA(At, 0, 1); PG8_STAGE(PG8_SA(0, 0), a2, voffA);
            PG8_BAR; PG8_WAIT_L(0); PG8_MMA(1, 0, At, B0); PG8_BAR; PG8_SCHED;
            PG8_STAGE(PG8_SB(0, 1), b2 + hstep, voffB);
            PG8_WAIT_V(6); PG8_BAR; PG8_MMA(1, 1, At, B1); PG8_BAR;
            PG8_LDB(B0, 1, 0); PG8_SCHED; PG8_LDA(At, 1, 0); PG8_STAGE(PG8_SA(0, 1), a2 + hstep, voffA);
            PG8_WAIT_L(8); PG8_BAR; PG8_WAIT_L(0); PG8_MMA(0, 0, At, B0); PG8_BAR; PG8_SCHED;
            PG8_LDB(B1, 1, 1); PG8_STAGE(PG8_SB(1, 0), b3, voffB);
            PG8_BAR; PG8_WAIT_L(0); PG8_MMA(0, 1, At, B1); PG8_BAR;
            PG8_LDA(At, 1, 1); PG8_STAGE(PG8_SA(1, 0), a3, voffA);
            PG8_BAR; PG8_WAIT_L(0); PG8_MMA(1, 0, At, B0); PG8_BAR; PG8_SCHED;
            PG8_STAGE(PG8_SB(1, 1), b3 + hstep, voffB);
            PG8_WAIT_V(6); PG8_BAR; PG8_MMA(1, 1, At, B1); PG8_BAR;
            }
        }
        if constexpr (ALIGN_EPI) { if (wr == 0) PG8_BAR; }
        if constexpr (!Epi::AFTER_DRAIN) { E(acc, cur, wr, wc, fr, fq); S.done(cur); }
        if (!has_next) break;
#pragma unroll
        for (int a = 0; a < 2; ++a)
#pragma unroll
            for (int b = 0; b < 2; ++b)
#pragma unroll
                for (int m = 0; m < 4; ++m)
#pragma unroll
                    for (int n = 0; n < 2; ++n) acc[a][b][m][n] = (f32x4){0.f, 0.f, 0.f, 0.f};
        cur = nxt; cA = nA; cB = nB; ++ui;
        if constexpr (ALIGN_EPI) { if (wr == 1) PG8_BAR; }
    }
    PG8_WAIT_V(0);
    if constexpr (!ALIGN_EPI) { if (wr == 0) PG8_BAR; }
    PG8_BAR;
    if constexpr (Epi::AFTER_DRAIN) { E.fused(acc, cur, wr, wc, fr, fq, lds, wid, lane); S.done(cur); }
#undef PG8_SA
#undef PG8_SB
#undef PG8_STAGE
#undef PG8_LDA
#undef PG8_LDB
#undef PG8_MMA
#undef PG8_WAIT_V
#undef PG8_WAIT_L
#undef PG8_BAR
#undef PG8_SCHED
}
__device__ __forceinline__ float bf2f(unsigned short h) { return __uint_as_float(((unsigned)h) << 16); }
__device__ __forceinline__ float fast_sigmoid(float x) { return __builtin_amdgcn_rcpf(1.0f + __builtin_amdgcn_exp2f(-1.4426950408889634f * x)); }
struct EpiG1 {
    static constexpr bool PERM = true, AFTER_DRAIN = false;
    bf16_t* U; bf16_t* G; const float* bias; const float* ssq;
    __device__ __forceinline__ void operator()(const f32x4 (&acc)[2][2][4][2], const Unit& u, int wr, int wc, int fr, int fq) const {
        const int row0 = u.pm * BM + wr * 64 + fr; int colt = u.pn * BM; const bool isg = colt >= 5376;
        bf16_t* base = U; int ldc = 5376; if (isg) { colt -= 5376; base = G; ldc = 3072; }
        const int col0 = colt + wc * 32 + 8 * fq;
        f32x4 bv[2][2];
#pragma unroll
        for (int bj = 0; bj < 2; ++bj)
#pragma unroll
            for (int n = 0; n < 2; ++n) bv[bj][n] = isg ? *(const f32x4*)(bias + col0 + bj * HALF + 4 * n) : (f32x4){0.f, 0.f, 0.f, 0.f};
#pragma unroll
        for (int ai = 0; ai < 2; ++ai)
#pragma unroll
            for (int m = 0; m < 4; ++m) { bf16_t* rowp = base + (size_t)(row0 + ai * HALF + m * 16) * ldc + col0;
                const float rs = ssq ? __builtin_amdgcn_rsqf(ssq[row0 + ai * HALF + m * 16] * (1.0f / 1024.0f) + 1e-6f) : 1.0f;
#pragma unroll
                for (int bj = 0; bj < 2; ++bj) { f32x4 v0 = acc[ai][bj][m][0] * rs + bv[bj][0], v1 = acc[ai][bj][m][1] * rs + bv[bj][1];
                    if (isg) {
#pragma unroll
                        for (int e = 0; e < 4; ++e) { v0[e] = fast_sigmoid(v0[e]); v1[e] = fast_sigmoid(v1[e]); } }
                    u32x4 w; w.x = cvt_pk_bf16(v0[0], v0[1]); w.y = cvt_pk_bf16(v0[2], v0[3]); w.z = cvt_pk_bf16(v1[0], v1[1]); w.w = cvt_pk_bf16(v1[2], v1[3]);
                    *(u32x4*)(rowp + bj * HALF) = w; } }
    }
};
struct EpiG2 {
    static constexpr bool PERM = true, AFTER_DRAIN = false;
    const bf16_t* G; float* T; bf16_t* Mg; int npan;
    __device__ __forceinline__ void operator()(const f32x4 (&acc)[2][2][4][2], const Unit& u, int wr, int wc, int fr, int fq) const {
        const int b = u.pm / npan, pm = u.pm - b * npan, pn = u.pn & 3;
        const int row0 = pm * BM + wr * 64 + fr, col0 = pn * BM + wc * 32 + 8 * fq;
#pragma unroll
        for (int ai = 0; ai < 2; ++ai)
#pragma unroll
            for (int m = 0; m < 4; ++m) { const size_t row = (size_t)(row0 + ai * HALF + m * 16);
#pragma unroll
                for (int bj = 0; bj < 2; ++bj) { const int col = col0 + bj * HALF;
                    const u32x4 g = *(const u32x4*)(G + row * 3072 + b * 1024 + col);
                    f32x4 v0 = acc[ai][bj][m][0], v1 = acc[ai][bj][m][1];
                    v0[0] *= __uint_as_float(g.x << 16); v0[1] *= __uint_as_float(g.x & 0xffff0000u); v0[2] *= __uint_as_float(g.y << 16); v0[3] *= __uint_as_float(g.y & 0xffff0000u);
                    v1[0] *= __uint_as_float(g.z << 16); v1[1] *= __uint_as_float(g.z & 0xffff0000u); v1[2] *= __uint_as_float(g.w << 16); v1[3] *= __uint_as_float(g.w & 0xffff0000u);
                    bf16_t* mp = Mg + row * 1024 + col;
                    if (b > 0) { const u32x4 t = *(const u32x4*)mp;
                        v0[0] += __uint_as_float(t.x << 16); v0[1] += __uint_as_float(t.x & 0xffff0000u); v0[2] += __uint_as_float(t.y << 16); v0[3] += __uint_as_float(t.y & 0xffff0000u);
                        v1[0] += __uint_as_float(t.z << 16); v1[1] += __uint_as_float(t.z & 0xffff0000u); v1[2] += __uint_as_float(t.w << 16); v1[3] += __uint_as_float(t.w & 0xffff0000u); }
                    u32x4 w; w.x = cvt_pk_bf16(v0[0], v0[1]); w.y = cvt_pk_bf16(v0[2], v0[3]); w.z = cvt_pk_bf16(v1[0], v1[1]); w.w = cvt_pk_bf16(v1[2], v1[3]);
                    *(u32x4*)mp = w; } }
    }
};
struct OrderG2 {
    int npan, G, c;
    __device__ bool next(int i, Unit& u) const { const int ti = i / 3, b = i - 3 * ti, t = ti * G + c; if (t >= npan * 4) return false;
        const int pm = t >> 2, pn = t & 3; u.pm = b * npan + pm; u.pn = b * 4 + pn; return true; }
    __device__ __forceinline__ void a_ready(const Unit&) const {}
    __device__ __forceinline__ void done(const Unit&) const {}
};
struct EpiG3 {
    static constexpr bool PERM = true, AFTER_DRAIN = false;
    const float* X; float* O; const float* gn; bf16_t* HN; float* ssq; int fuse;
    __device__ __forceinline__ void operator()(const f32x4 (&acc)[2][2][4][2], const Unit& u, int wr, int wc, int fr, int fq) const {
        const int row0 = u.pm * BM + wr * 64 + fr, col0 = u.pn * BM + wc * 32 + 8 * fq;
        f32x4 gv[2][2];
#pragma unroll
        for (int bj = 0; bj < 2; ++bj)
#pragma unroll
            for (int n = 0; n < 2; ++n) gv[bj][n] = fuse ? *(const f32x4*)(gn + col0 + bj * HALF + 4 * n) : (f32x4){0.f, 0.f, 0.f, 0.f};
#pragma unroll
        for (int ai = 0; ai < 2; ++ai)
#pragma unroll
            for (int m = 0; m < 4; ++m) { const size_t row = (size_t)(row0 + ai * HALF + m * 16); float sq = 0.f;
#pragma unroll
                for (int bj = 0; bj < 2; ++bj) { const size_t p = row * 1024 + col0 + bj * HALF;
                    const f32x4 x0 = *(const f32x4*)(X + p), x1 = *(const f32x4*)(X + p + 4);
                    const f32x4 o0 = x0 + acc[ai][bj][m][0], o1 = x1 + acc[ai][bj][m][1];
                    *(f32x4*)(O + p) = o0; *(f32x4*)(O + p + 4) = o1;
                    if (fuse) { const f32x4 h0 = o0 * gv[bj][0], h1 = o1 * gv[bj][1];
                        u32x4 w; w.x = cvt_pk_bf16(h0[0], h0[1]); w.y = cvt_pk_bf16(h0[2], h0[3]); w.z = cvt_pk_bf16(h1[0], h1[1]); w.w = cvt_pk_bf16(h1[2], h1[3]);
                        *(u32x4*)(HN + p) = w;
                        sq += (o0[0] * o0[0] + o0[1] * o0[1]) + (o0[2] * o0[2] + o0[3] * o0[3]) + (o1[0] * o1[0] + o1[1] * o1[1]) + (o1[2] * o1[2] + o1[3] * o1[3]); } }
                if (fuse) { sq += shx(sq, 16); sq += shx(sq, 32); if (fq == 0) atomicAdd(ssq + row, sq); } }
    }
};
struct EpiAll {
    static constexpr bool PERM = true, AFTER_DRAIN = false;
    int mode; EpiG1 e1; EpiG2 e2; EpiG3 e3;
    __device__ __forceinline__ void operator()(const f32x4 (&acc)[2][2][4][2], const Unit& u, int wr, int wc, int fr, int fq) const {
        if (mode == 1) e1(acc, u, wr, wc, fr, fq); else if (mode == 2) e2(acc, u, wr, wc, fr, fq); else e3(acc, u, wr, wc, fr, fq); }
};
struct OrderAll {
    int mode; StaticOrder so; OrderG2 o2;
    __device__ __forceinline__ bool next(int i, Unit& u) const { return mode == 2 ? o2.next(i, u) : so.next(i, u); }
    __device__ __forceinline__ void a_ready(const Unit&) const {}
    __device__ __forceinline__ void done(const Unit&) const {}
};
}
#ifndef DUP_MASK
#define DUP_MASK 0
#endif
#ifndef EN_MASK
#define EN_MASK 0xffff
#endif
#define EN(i) ((EN_MASK >> (i)) & 1)
#define LAS __attribute__((address_space(3)))
typedef unsigned short bf16;
typedef float f32x4 __attribute__((ext_vector_type(4)));
typedef float f32x2 __attribute__((ext_vector_type(2)));
typedef unsigned u32x4 __attribute__((ext_vector_type(4)));
typedef unsigned u32x2 __attribute__((ext_vector_type(2)));
constexpr int DM = 1024, NTOK_P = 65536, NTOK_S = 32768, NTOK = NTOK_P + NTOK_S, LP = 8192, LS = 2048;
constexpr int CH = 16384, NCHUNK = NTOK / CH, NCH_P = NTOK_P / CH;
constexpr int UP = 5376, NCAT = 8448, GP = 3072;
constexpr int C_X0 = 0, C_X1 = 512, C_HV = 1024, C_HG = 1536, C_GQ = 2048, C_GK = 2560, C_GV = 2688, C_GG = 2816, C_DQ = 3328, C_DK = 3840, C_DV = 4352, C_DG = 4864;
constexpr float EPS = 1e-6f, LOG2E = 1.4426950408889634f;
constexpr int NT = 512, NWAVES = 8;
enum { I_XP = 0, I_XS, I_RELB, I_NORMG, I_WIN, I_CONVW, I_CONVB, I_FW1, I_FB1, I_FW2, I_FB2, I_FWOUT, I_FFREQ, I_HYBIAS, I_QNG, I_KNG, I_LQ1, I_LK1, I_LQ2, I_LK2, I_SUBLN, I_WBHY, I_WBGQ, I_WBDF, I_WMERGE, I_BMERGE, I_WOUT, I_FINALG, N_IN };
constexpr size_t MiB = 1u << 20;
constexpr size_t WS_CTL = 0, CTL_BYTES = 64 * 1024;
constexpr size_t WS_TW = 1 * MiB;
constexpr size_t WS_WCAT = 2 * MiB, WCAT_BYTES = (size_t)NCAT * 1024 * 2;
constexpr size_t WS_WBT = 40 * MiB, WBT_BYTES = (size_t)3 * 1024 * 512 * 2;
constexpr size_t WS_WOT = 46 * MiB, WOT_BYTES = (size_t)1024 * 1024 * 2;
constexpr int SPS_P = LP + 16, SPS_S = LS + 16;
constexpr size_t SPEC_P_BYTES = (size_t)256 * SPS_P * 8, SPEC_S_BYTES = (size_t)256 * SPS_S * 8;
constexpr size_t SPEC_LAYER = 2 * SPEC_P_BYTES + 2 * SPEC_S_BYTES;
constexpr size_t WS_SPEC = 52 * MiB;
constexpr size_t WS_HN = 140 * MiB, WS_U = 172 * MiB, WS_G = 340 * MiB, WS_Y = 436 * MiB, WS_MG = 484 * MiB, WS_TMP = 516 * MiB, WS_DT = 580 * MiB, WS_HVP = 612 * MiB, WS_PMP = 644 * MiB, WS_ROPE = 676 * MiB, WS_HN0 = 680 * MiB, WS_END = 872 * MiB;
constexpr size_t HF_P_BYTES = (size_t)LP * 1024 * 4, HF_S_BYTES = (size_t)LS * 1024 * 4;
static_assert(WS_WCAT + 2 * WCAT_BYTES <= WS_WBT && WS_WBT + 2 * WBT_BYTES <= WS_WOT && WS_WOT + 2 * WOT_BYTES <= WS_SPEC && WS_SPEC + 2 * SPEC_LAYER <= WS_HN, "ws map");
static_assert(WS_HN + (size_t)CH * 1024 * 2 <= WS_U && WS_U + (size_t)CH * UP * 2 <= WS_G && WS_G + (size_t)CH * GP * 2 <= WS_Y && WS_Y + (size_t)3 * CH * 512 * 2 <= WS_MG && WS_MG + (size_t)CH * 1024 * 2 <= WS_TMP && WS_TMP + (size_t)CH * 1024 * 4 <= WS_DT && WS_DT + (size_t)CH * 512 * 4 <= WS_END, "ws map 2");
static_assert(2 * (HF_P_BYTES + HF_S_BYTES) <= (size_t)CH * UP * 2, "hf overlay");
constexpr size_t WS_SSQ = WS_TMP;
constexpr int LDS_MAIN = 139264, LDS_BYTES = LDS_MAIN + 1024;
constexpr int CW_BAR = 4096;

struct Args { const float* in[N_IN]; float* out; unsigned char* ws; int lo, hi; };
typedef const __attribute__((address_space(4))) unsigned long long* kargp_t;
struct AV { kargp_t p; };
#define AIN(i) ((const float*)(a.p[(i)]))
#define AOUT ((float*)(a.p[N_IN]))
#define AWS ((unsigned char*)(a.p[N_IN + 1]))


__device__ __forceinline__ float bf2f(unsigned short h) { return __uint_as_float(((unsigned)h) << 16); }
__device__ __forceinline__ float bflo(unsigned w) { return __uint_as_float(w << 16); }
__device__ __forceinline__ float bfhi(unsigned w) { return __uint_as_float(w & 0xffff0000u); }
__device__ __forceinline__ unsigned f2bf(float f) { unsigned u = __builtin_bit_cast(unsigned, f); return (u + 0x7fffu + ((u >> 16) & 1u)) >> 16; }
__device__ __forceinline__ unsigned pk2(float lo, float hi) { return f2bf(lo) | (f2bf(hi) << 16); }
__device__ __forceinline__ float silu(float x) { return x * __builtin_amdgcn_rcpf(1.0f + __builtin_amdgcn_exp2f(-LOG2E * x)); }
__device__ __forceinline__ float wave_sum(float v) {
#pragma unroll
    for (int o = 1; o < 64; o <<= 1) v += shx(v, o);
    return v;
}
__device__ __forceinline__ double kd(double v) { asm volatile("" : "+s"(v)); return v; }
__device__ __forceinline__ void sincos_rev(double r, float& s, float& c) {
    r -= __builtin_rint(r);
    const double k = __builtin_rint(r * 4.0);
    const double x = (r - k * 0.25) * kd(6.283185307179586476925);
    const double x2 = x * x;
    double sp = kd(1.0 / 6227020800.0); sp = sp * x2 + kd(-1.0 / 39916800); sp = sp * x2 + kd(1.0 / 362880); sp = sp * x2 + kd(-1.0 / 5040); sp = sp * x2 + kd(1.0 / 120); sp = sp * x2 + kd(-1.0 / 6); sp = sp * x2 + 1.0; sp *= x;
    double cp = kd(-1.0 / 87178291200.0); cp = cp * x2 + kd(1.0 / 479001600.0); cp = cp * x2 + kd(-1.0 / 3628800); cp = cp * x2 + kd(1.0 / 40320); cp = cp * x2 + kd(-1.0 / 720); cp = cp * x2 + kd(1.0 / 24); cp = cp * x2 + (-0.5); cp = cp * x2 + 1.0;
    const int q = ((int)k) & 3;
    const float sf = (float)sp, cf = (float)cp;
    s = (q == 0) ? sf : (q == 1) ? cf : (q == 2) ? -sf : -cf;
    c = (q == 0) ? cf : (q == 1) ? -sf : (q == 2) ? -cf : sf;
}
__device__ __forceinline__ float sin_acc(float x) { float s, c; sincos_rev((double)x * 0.15915494309189533577, s, c); return s; }

__device__ __forceinline__ void transpose_item(const float* W, int K, int N, bf16* WT, int row_off, LAS float* scr, int item, int lane) {
    const int nblk = N / 32, kb = item / nblk, nb = item % nblk, k0 = 64 * kb, n0 = 32 * nb;
#pragma unroll 8
    for (int i = 0; i < 32; ++i) { const int kk = 2 * i + (lane >> 5); scr[kk * 33 + (lane & 31)] = W[(size_t)(k0 + kk) * N + n0 + (lane & 31)]; }
    asm volatile("s_waitcnt lgkmcnt(0)" ::: "memory");
    const int c = lane & 7;
#pragma unroll
    for (int j = 0; j < 4; ++j) { const int n = (lane >> 3) + 8 * j; const LAS float* s = scr + (8 * c) * 33 + n;
        u32x4 o; o.x = pk2(s[0 * 33], s[1 * 33]); o.y = pk2(s[2 * 33], s[3 * 33]); o.z = pk2(s[4 * 33], s[5 * 33]); o.w = pk2(s[6 * 33], s[7 * 33]);
        *(u32x4*)(WT + (size_t)(row_off + n0 + n) * K + k0 + 8 * c) = o; }
    asm volatile("s_waitcnt lgkmcnt(0)" ::: "memory");
}

__device__ __forceinline__ f32x2 cmul(f32x2 a, f32x2 b) { return (f32x2){a.x * b.x - a.y * b.y, a.x * b.y + a.y * b.x}; }
__device__ __forceinline__ f32x2 cmulc(f32x2 a, f32x2 b) { return (f32x2){a.x * b.x + a.y * b.y, a.y * b.x - a.x * b.y}; }
__device__ __forceinline__ f32x2 cconj(f32x2 a) { return (f32x2){a.x, -a.y}; }
template <int LOG4> __device__ __forceinline__ int digitrev(int k) { unsigned x = __builtin_bitreverse32((unsigned)k) >> (32 - 2 * LOG4); return (int)(((x & 0x55555555u) << 1) | ((x >> 1) & 0x55555555u)); }
#define PADI(i) ((i) + ((i) >> 4))
#define W16C 0.92387953251128674f
#define W16S 0.38268343236508977f
#define W16H 0.70710678118654752f
__device__ __forceinline__ f32x2 w16(int m) { return m == 0 ? (f32x2){1.f, 0.f} : m == 1 ? (f32x2){W16C, -W16S} : m == 2 ? (f32x2){W16H, -W16H} : m == 3 ? (f32x2){W16S, -W16C} : m == 4 ? (f32x2){0.f, -1.f} : m == 6 ? (f32x2){-W16H, -W16H} : (f32x2){-W16C, W16S}; }
__device__ __forceinline__ void bfly_fwd(f32x2& a0, f32x2& a1, f32x2& a2, f32x2& a3) {
    const f32x2 t0 = a0 + a2, t1 = a0 - a2, t2 = a1 + a3, t3 = a1 - a3;
    a0 = t0 + t2; a2 = t0 - t2; a1 = (f32x2){t1.x + t3.y, t1.y - t3.x}; a3 = (f32x2){t1.x - t3.y, t1.y + t3.x};
}
__device__ __forceinline__ void bfly_inv(f32x2& b0, f32x2& b1, f32x2& b2, f32x2& b3) {
    const f32x2 t0 = b0 + b2, t1 = b0 - b2, t2 = b1 + b3, t3 = b1 - b3;
    b0 = t0 + t2; b2 = t0 - t2; b1 = (f32x2){t1.x - t3.y, t1.y + t3.x}; b3 = (f32x2){t1.x + t3.y, t1.y - t3.x};
}
template <int LOG4, int BATCH = 1> __device__ __forceinline__ void fft_fwd(LAS f32x2* buf, const f32x2* __restrict__ tw, int tid) {
    constexpr int N = 1 << (2 * LOG4), TWS = 16384 / N;
    constexpr int NPAD = N + N / 16, NLEV = LOG4 - 2, NP16 = NLEV / 2;
#pragma unroll 1
    for (int ps = 0; ps < NP16; ++ps) {
        const int lq4 = 2 * (LOG4 - 2 * ps) - 2, lq16 = lq4 - 2, q4 = 1 << lq4, q16 = 1 << lq16, tsA = TWS << (4 * ps), tsB = tsA << 2;
        constexpr int TOT = BATCH * N / 16, IT = (TOT + NT - 1) / NT;
#pragma unroll
        for (int i = 0; i < IT; ++i) { const int jg = tid + i * NT; if (TOT % NT != 0 && jg >= TOT) break; const int bo = (jg >> (2 * LOG4 - 4)) * NPAD, j = jg & (N / 16 - 1);
            const int blk = j >> lq16, jj = j & (q16 - 1), base = (blk << (lq4 + 2)) + jj;
            f32x2 wa[4], wb = tw[jj * tsB];
#pragma unroll
            for (int b = 0; b < 4; ++b) wa[b] = tw[(jj + b * q16) * tsA];
            f32x2 e[4][4];
#pragma unroll
            for (int a = 0; a < 4; ++a)
#pragma unroll
                for (int b = 0; b < 4; ++b) e[a][b] = buf[bo + PADI(base + b * q16 + a * q4)];
#pragma unroll
            for (int b = 0; b < 4; ++b) { bfly_fwd(e[0][b], e[1][b], e[2][b], e[3][b]); const f32x2 w2 = cmul(wa[b], wa[b]), w3 = cmul(w2, wa[b]); e[1][b] = cmul(e[1][b], wa[b]); e[2][b] = cmul(e[2][b], w2); e[3][b] = cmul(e[3][b], w3); }
            { const f32x2 w2 = cmul(wb, wb), w3 = cmul(w2, wb);
#pragma unroll
              for (int a = 0; a < 4; ++a) { bfly_fwd(e[a][0], e[a][1], e[a][2], e[a][3]); e[a][1] = cmul(e[a][1], wb); e[a][2] = cmul(e[a][2], w2); e[a][3] = cmul(e[a][3], w3); } }
#pragma unroll
            for (int a = 0; a < 4; ++a)
#pragma unroll
                for (int b = 0; b < 4; ++b) buf[bo + PADI(base + b * q16 + a * q4)] = e[a][b];
        }
        __syncthreads();
    }
#pragma unroll 1
    for (int pass = 2 * NP16; pass < NLEV; ++pass) {
        const int lq = 2 * (LOG4 - pass) - 2, q4 = 1 << lq, n = q4 << 2, tstep = TWS << (2 * pass);
        constexpr int IT = BATCH * N / 4 / NT;
        f32x2 wl[IT];
#pragma unroll
        for (int i = 0; i < IT; ++i) wl[i] = tw[((tid + i * NT) & (q4 - 1)) * tstep];
#pragma unroll
        for (int i = 0; i < IT; ++i) { const int jg = tid + i * NT, bo = (jg >> (2 * LOG4 - 2)) * NPAD, j = jg & (N / 4 - 1);
            const int blk = j >> lq, jj = j & (q4 - 1), base = blk * n + jj;
            const int i0 = bo + PADI(base), i1 = bo + PADI(base + q4), i2 = bo + PADI(base + 2 * q4), i3 = bo + PADI(base + 3 * q4);
            const f32x2 w1 = wl[i];
            f32x2 a0 = buf[i0], a1 = buf[i1], a2 = buf[i2], a3 = buf[i3];
            bfly_fwd(a0, a1, a2, a3);
            const f32x2 w2 = cmul(w1, w1), w3 = cmul(w2, w1);
            buf[i0] = a0; buf[i1] = cmul(a1, w1); buf[i2] = cmul(a2, w2); buf[i3] = cmul(a3, w3);
        }
        __syncthreads();
    }
#pragma unroll 1
    for (int b = tid; b < BATCH * N / 16; b += NT) {
        LAS f32x2* xb = buf + 17 * b; f32x2 x[16];
#pragma unroll
        for (int e = 0; e < 16; ++e) x[e] = xb[e];
#pragma unroll
        for (int jj = 0; jj < 4; ++jj) { bfly_fwd(x[jj], x[jj + 4], x[jj + 8], x[jj + 12]); if (jj) { x[jj + 4] = cmul(x[jj + 4], w16(jj)); x[jj + 8] = cmul(x[jj + 8], w16(2 * jj)); x[jj + 12] = cmul(x[jj + 12], w16(3 * jj)); } }
#pragma unroll
        for (int q = 0; q < 4; ++q) bfly_fwd(x[4 * q], x[4 * q + 1], x[4 * q + 2], x[4 * q + 3]);
#pragma unroll
        for (int e = 0; e < 16; ++e) xb[e] = x[e];
    }
    __syncthreads();
}
template <int LOG4, int BATCH = 1> __device__ __forceinline__ void fft_inv(LAS f32x2* buf, const f32x2* __restrict__ tw, int tid) {
    constexpr int N = 1 << (2 * LOG4), TWS = 16384 / N;
#pragma unroll 1
    for (int b = tid; b < BATCH * N / 16; b += NT) {
        LAS f32x2* xb = buf + 17 * b; f32x2 x[16];
#pragma unroll
        for (int e = 0; e < 16; ++e) x[e] = xb[e];
#pragma unroll
        for (int q = 0; q < 4; ++q) bfly_inv(x[4 * q], x[4 * q + 1], x[4 * q + 2], x[4 * q + 3]);
#pragma unroll
        for (int jj = 0; jj < 4; ++jj) { if (jj) { x[jj + 4] = cmulc(x[jj + 4], w16(jj)); x[jj + 8] = cmulc(x[jj + 8], w16(2 * jj)); x[jj + 12] = cmulc(x[jj + 12], w16(3 * jj)); } bfly_inv(x[jj], x[jj + 4], x[jj + 8], x[jj + 12]); }
#pragma unroll
        for (int e = 0; e < 16; ++e) xb[e] = x[e];
    }
    __syncthreads();
    constexpr int NPAD = N + N / 16, NLEV = LOG4 - 2, NP16 = NLEV / 2;
#pragma unroll 1
    for (int pass = NLEV - 1; pass >= 2 * NP16; --pass) {
        const int lq = 2 * (LOG4 - pass) - 2, q4 = 1 << lq, n = q4 << 2, tstep = TWS << (2 * pass);
        constexpr int IT = BATCH * N / 4 / NT;
        f32x2 wl[IT];
#pragma unroll
        for (int i = 0; i < IT; ++i) wl[i] = tw[((tid + i * NT) & (q4 - 1)) * tstep];
#pragma unroll
        for (int i = 0; i < IT; ++i) { const int jg = tid + i * NT, bo = (jg >> (2 * LOG4 - 2)) * NPAD, j = jg & (N / 4 - 1);
            const int blk = j >> lq, jj = j & (q4 - 1), base = blk * n + jj;
            const int i0 = bo + PADI(base), i1 = bo + PADI(base + q4), i2 = bo + PADI(base + 2 * q4), i3 = bo + PADI(base + 3 * q4);
            const f32x2 w1 = wl[i];
            const f32x2 w2 = cmul(w1, w1), w3 = cmul(w2, w1);
            f32x2 b0 = buf[i0], b1 = cmulc(buf[i1], w1), b2 = cmulc(buf[i2], w2), b3 = cmulc(buf[i3], w3);
            bfly_inv(b0, b1, b2, b3);
            buf[i0] = b0; buf[i1] = b1; buf[i2] = b2; buf[i3] = b3;
        }
        __syncthreads();
    }
#pragma unroll 1
    for (int ps = NP16 - 1; ps >= 0; --ps) {
        const int lq4 = 2 * (LOG4 - 2 * ps) - 2, lq16 = lq4 - 2, q4 = 1 << lq4, q16 = 1 << lq16, tsA = TWS << (4 * ps), tsB = tsA << 2;
        constexpr int TOT = BATCH * N / 16, IT = (TOT + NT - 1) / NT;
#pragma unroll
        for (int i = 0; i < IT; ++i) { const int jg = tid + i * NT; if (TOT % NT != 0 && jg >= TOT) break; const int bo = (jg >> (2 * LOG4 - 4)) * NPAD, j = jg & (N / 16 - 1);
            const int blk = j >> lq16, jj = j & (q16 - 1), base = (blk << (lq4 + 2)) + jj;
            f32x2 wa[4], wb = tw[jj * tsB];
#pragma unroll
            for (int b = 0; b < 4; ++b) wa[b] = tw[(jj + b * q16) * tsA];
            f32x2 e[4][4];
#pragma unroll
            for (int a = 0; a < 4; ++a)
#pragma unroll
                for (int b = 0; b < 4; ++b) e[a][b] = buf[bo + PADI(base + b * q16 + a * q4)];
            { const f32x2 w2 = cmul(wb, wb), w3 = cmul(w2, wb);
#pragma unroll
              for (int a = 0; a < 4; ++a) { e[a][1] = cmulc(e[a][1], wb); e[a][2] = cmulc(e[a][2], w2); e[a][3] = cmulc(e[a][3], w3); bfly_inv(e[a][0], e[a][1], e[a][2], e[a][3]); } }
#pragma unroll
            for (int b = 0; b < 4; ++b) { const f32x2 w2 = cmul(wa[b], wa[b]), w3 = cmul(w2, wa[b]); e[1][b] = cmulc(e[1][b], wa[b]); e[2][b] = cmulc(e[2][b], w2); e[3][b] = cmulc(e[3][b], w3); bfly_inv(e[0][b], e[1][b], e[2][b], e[3][b]); }
#pragma unroll
            for (int a = 0; a < 4; ++a)
#pragma unroll
                for (int b = 0; b < 4; ++b) buf[bo + PADI(base + b * q16 + a * q4)] = e[a][b];
        }
        __syncthreads();
    }
}
__device__ const double ROPE_IF[16] = {1.0, 0.5623413251903491, 0.31622776601683794, 0.1778279410038923, 0.1, 0.05623413251903491, 0.03162277660168379, 0.01778279410038923,
    0.01, 0.005623413251903491, 0.0031622776601683794, 0.0017782794100389228, 0.001, 0.0005623413251903491, 0.00031622776601683794, 0.00017782794100389227};
struct Chunk { int tok0, L, nseq; };
__device__ __forceinline__ Chunk chunk_of(int c) { Chunk k; k.tok0 = c * CH; if (c < NCH_P) { k.L = LP; k.nseq = CH / LP; } else { k.L = LS; k.nseq = CH / LS; } return k; }
__device__ __forceinline__ const float* xin_rows(const AV& a, int tok0) { return tok0 < NTOK_P ? AIN(I_XP) + (size_t)tok0 * DM : AIN(I_XS) + (size_t)(tok0 - NTOK_P) * DM; }
__device__ __forceinline__ void hf_group(LAS float* sm, const AV& a, int layer, int L, int t0, float* hf, int tid) {
    LAS float* zs = sm; LAS float* A = sm + 512; LAS float* B = sm + 1024;
    const float* w1 = AIN(I_FW1) + layer * 33 * 64; const float* b1 = AIN(I_FB1) + layer * 64;
    const float* w2 = AIN(I_FW2) + layer * 2 * 64 * 64; const float* b2 = AIN(I_FB2) + layer * 2 * 64;
    const float* wo = AIN(I_FWOUT) + layer * 64 * 1024; const float* fr = AIN(I_FFREQ) + layer * 64;
    const int tt = tid >> 6, j = tid & 63, t = t0 + tt;
    const float t01 = (float)t / (float)(L - 1);
    if (j < 33) {
        float v;
        if (j == 0) v = t01;
        else { const int k = (j - 1) & 15; const double f = kd(1e-4) + (double)k * kd((15.0 - 1e-4) / 15.0); float s, c; sincos_rev(f * (double)t / (double)L, s, c); v = (j <= 16) ? c : -s; }
        zs[tt * 40 + j] = v;
    }
    __syncthreads();
    const float fq = fr[j];
    { float acc = b1[j]; for (int i = 0; i < 33; ++i) acc += zs[tt * 40 + i] * w1[i * 64 + j]; A[tt * 64 + j] = sin_acc(fq * acc); }
    __syncthreads();
    { float acc = b2[j]; for (int i = 0; i < 64; ++i) acc += A[tt * 64 + i] * w2[i * 64 + j]; B[tt * 64 + j] = sin_acc(fq * acc); }
    __syncthreads();
    { float acc = b2[64 + j]; for (int i = 0; i < 64; ++i) acc += B[tt * 64 + i] * w2[4096 + i * 64 + j]; A[tt * 64 + j] = sin_acc(fq * acc); }
    __syncthreads();
    { float acc0[8], acc1[8];
#pragma unroll
      for (int q = 0; q < 8; ++q) { acc0[q] = 0.f; acc1[q] = 0.f; }
#pragma unroll 8
      for (int i = 0; i < 64; ++i) { const float wa = wo[i * 1024 + tid], wb = wo[i * 1024 + 512 + tid];
#pragma unroll
          for (int q = 0; q < 8; ++q) { const float av = A[q * 64 + i]; acc0[q] += av * wa; acc1[q] += av * wb; } }
      const float ad = 3.070113457325394f + (float)tid * ((15.350567286626973f - 3.070113457325394f) / 511.0f);
#pragma unroll
      for (int q = 0; q < 8; ++q) { const float tq = (float)(t0 + q) / (float)(L - 1); const float win = __expf(-tq * ad);
          hf[(size_t)(t0 + q) * 1024 + tid] = acc0[q] * win; hf[(size_t)(t0 + q) * 1024 + 512 + tid] = acc1[q] * win; } }
    __syncthreads();
}
__device__ __forceinline__ void step_pro_a(const AV& a, LAS unsigned char* lds) {
    const int tid = ltid(), lane = tid & 63, wave = tid >> 6, G = gridDim.x;
    unsigned char* ws = AWS;
    { f32x2* tw = (f32x2*)(ws + WS_TW); for (int m = lbid() * NT + tid; m < 16384; m += G * NT) { float s, c; sincos_rev((double)m / 16384.0, s, c); tw[m] = (f32x2){c, -s}; } }
    { f32x2* rt = (f32x2*)(ws + WS_ROPE);
      for (int e = lbid() * NT + tid; e < 8192 * 32; e += G * NT) { const int pos = e >> 5, i = e & 31; const int pp = (i < 16) ? (pos >> 6) : (pos & 63);
          const double inv = ROPE_IF[i & 15]; float sn, cs; sincos_rev((double)pp * inv * 0.15915494309189533577, sn, cs); rt[e] = (f32x2){cs, sn}; } }
    { const float* g = AIN(I_NORMG); bf16* HN0 = (bf16*)(ws + WS_HN0); f32x4 gv[4];
#pragma unroll
      for (int j = 0; j < 4; ++j) gv[j] = *((const f32x4*)g + lane + 64 * j);
      for (int m = lbid() * NWAVES + wave; m < NTOK; m += G * NWAVES) {
          const f32x4* xr = (const f32x4*)(xin_rows(a, m)) + lane; f32x4 v[4]; float ssum = 0.f;
#pragma unroll
          for (int j = 0; j < 4; ++j) { v[j] = xr[64 * j]; ssum += (v[j].x * v[j].x + v[j].y * v[j].y) + (v[j].z * v[j].z + v[j].w * v[j].w); }
          const float rs = 1.0f / sqrtf(wave_sum(ssum) * (1.0f / DM) + EPS);
          u32x2* o8 = (u32x2*)(HN0 + (size_t)m * DM) + lane;
#pragma unroll
          for (int j = 0; j < 4; ++j) { u32x2 w; w.x = pk2(v[j].x * rs * gv[j].x, v[j].y * rs * gv[j].y); w.y = pk2(v[j].z * rs * gv[j].z, v[j].w * rs * gv[j].w); o8[64 * j] = w; } } }
    { LAS float* scr = (LAS float*)(lds + wave * 16384);
      constexpr int I_IN = 16 * (UP / 32), I_MG = 16 * (GP / 32), I_BR = 8 * 32, I_OU = 16 * 32, PER = I_IN + I_MG + 3 * I_BR + I_OU;
      for (int it = lbid() * NWAVES + wave; it < 2 * PER; it += G * NWAVES) {
          const int l = it / PER; int r = it - l * PER;
          bf16* wcat = (bf16*)(ws + WS_WCAT + l * WCAT_BYTES); bf16* wbt = (bf16*)(ws + WS_WBT + l * WBT_BYTES); bf16* wot = (bf16*)(ws + WS_WOT + l * WOT_BYTES);
          if (r < I_IN) { transpose_item(AIN(I_WIN) + (size_t)l * 1024 * UP, 1024, UP, wcat, 0, scr, r, lane); continue; } r -= I_IN;
          if (r < I_MG) { transpose_item(AIN(I_WMERGE) + (size_t)l * 1024 * GP, 1024, GP, wcat, UP, scr, r, lane); continue; } r -= I_MG;
          if (r < I_BR) { transpose_item(AIN(I_WBHY) + (size_t)l * 512 * 1024, 512, 1024, wbt, 0, scr, r, lane); continue; } r -= I_BR;
          if (r < I_BR) { transpose_item(AIN(I_WBGQ) + (size_t)l * 512 * 1024, 512, 1024, wbt, 1024, scr, r, lane); continue; } r -= I_BR;
          if (r < I_BR) { transpose_item(AIN(I_WBDF) + (size_t)l * 512 * 1024, 512, 1024, wbt, 2048, scr, r, lane); continue; } r -= I_BR;
          transpose_item(AIN(I_WOUT) + (size_t)l * 1024 * 1024, 1024, 1024, wot, 0, scr, r, lane);
      } }
}
__device__ __forceinline__ void step_pro_a2(const AV& a, LAS unsigned char* lds) {
    const int tid = ltid(), G = gridDim.x; unsigned char* ws = AWS;
    { constexpr int GPL = LP / 8 + LS / 8;
      for (int g = lbid(); g < 2 * GPL; g += G) { const int l = g / GPL; int r = g - l * GPL;
          float* hfp = (float*)(ws + WS_U + l * (HF_P_BYTES + HF_S_BYTES));
          if (r < LP / 8) hf_group((LAS float*)lds, a, l, LP, r * 8, hfp, tid);
          else hf_group((LAS float*)lds, a, l, LS, (r - LP / 8) * 8, (float*)((unsigned char*)hfp + HF_P_BYTES), tid); } }
}
template <int LOG4> __device__ __forceinline__ void filt_unit(const AV& a, LAS unsigned char* lds, int layer, int pr, const float* hf, f32x2* Pg, f32x2* Mg) {
    constexpr int N = 1 << (2 * LOG4), L = N / 2;
    const int tid = ltid(); LAS f32x2* buf = (LAS f32x2*)lds; const int c0 = 2 * pr;
    for (int n = tid; n < N; n += NT) { f32x2 v = (f32x2){0.f, 0.f};
        if (n < L) v = *(const f32x2*)(hf + (size_t)n * 1024 + c0); else if (n > L) v = *(const f32x2*)(hf + (size_t)(N - n) * 1024 + 512 + c0);
        buf[PADI(n)] = v; }
    __syncthreads();
    fft_fwd<LOG4>(buf, (const f32x2*)(AWS + WS_TW), tid);
    const float ba = AIN(I_HYBIAS)[layer * 512 + c0], bb = AIN(I_HYBIAS)[layer * 512 + c0 + 1]; const float sc = 1.0f / (float)N;
    for (int k = tid; k <= L; k += NT) { const int q1 = digitrev<LOG4>(k), q2 = digitrev<LOG4>((N - k) & (N - 1)); const f32x2 z1 = buf[PADI(q1)], z2 = buf[PADI(q2)];
        f32x2 ca = (f32x2){0.5f * (z1.x + z2.x), 0.5f * (z1.y - z2.y)}; const float dx = z1.x - z2.x, dy = z1.y + z2.y; f32x2 cb = (f32x2){0.5f * dy, -0.5f * dx};
        ca.x += ba; cb.x += bb;
        Pg[k] = (f32x2){0.5f * sc * (ca.x + cb.x), 0.5f * sc * (ca.y + cb.y)}; Mg[k] = (f32x2){0.5f * sc * (ca.x - cb.x), 0.5f * sc * (ca.y - cb.y)}; }
    __syncthreads();
}
__device__ __forceinline__ void step_pro_b(const AV& a, LAS unsigned char* lds) {
    for (int u = lbid(); u < 1024; u += gridDim.x) { const int l = u >> 9, r = u & 511; unsigned char* sp = AWS + WS_SPEC + l * SPEC_LAYER; const float* hfp = (const float*)(AWS + WS_U + l * (HF_P_BYTES + HF_S_BYTES));
        if (r < 256) filt_unit<7>(a, lds, l, r, hfp, (f32x2*)sp + (size_t)r * SPS_P, (f32x2*)(sp + SPEC_P_BYTES) + (size_t)r * SPS_P);
        else { const int pr = r - 256; filt_unit<6>(a, lds, l, pr, (const float*)((const unsigned char*)hfp + HF_P_BYTES), (f32x2*)(sp + 2 * SPEC_P_BYTES) + (size_t)pr * SPS_S, (f32x2*)(sp + 2 * SPEC_P_BYTES + SPEC_S_BYTES) + (size_t)pr * SPS_S); } }
}
__device__ __forceinline__ void step_norm(const AV& a, int c, int layer) {
    const int tid = ltid(), lane = tid & 63, wave = tid >> 6; const Chunk ck = chunk_of(c);
    const float* X = layer == 0 ? xin_rows(a, ck.tok0) : AOUT + (size_t)ck.tok0 * DM; bf16* HN = (bf16*)(AWS + WS_HN); const float* g = AIN(I_NORMG) + layer * DM;
    f32x4 gv[4];
#pragma unroll
    for (int j = 0; j < 4; ++j) gv[j] = *((const f32x4*)g + lane + 64 * j);
    for (int m = lbid() * NWAVES + wave; m < CH; m += gridDim.x * NWAVES) {
        const f32x4* xr = (const f32x4*)(X + (size_t)m * DM) + lane; f32x4 v[4]; float s = 0.f;
#pragma unroll
        for (int j = 0; j < 4; ++j) { v[j] = xr[64 * j]; s += (v[j].x * v[j].x + v[j].y * v[j].y) + (v[j].z * v[j].z + v[j].w * v[j].w); }
        const float rs = 1.0f / sqrtf(wave_sum(s) * (1.0f / DM) + EPS);
        u32x2* o8 = (u32x2*)(HN + (size_t)m * DM) + lane;
#pragma unroll
        for (int j = 0; j < 4; ++j) { u32x2 w; w.x = pk2(v[j].x * rs * gv[j].x, v[j].y * rs * gv[j].y); w.y = pk2(v[j].z * rs * gv[j].z, v[j].w * rs * gv[j].w); o8[64 * j] = w; }
    }
}
__device__ __forceinline__ void step_final(const AV& a, int row0, int row1) {
    const int tid = ltid(), lane = tid & 63, wave = tid >> 6; const float* g = AIN(I_FINALG);
    f32x4 gv[4];
#pragma unroll
    for (int j = 0; j < 4; ++j) gv[j] = *((const f32x4*)g + lane + 64 * j);
    for (int m = row0 + lbid() * NWAVES + wave; m < row1; m += gridDim.x * NWAVES) {
        f32x4* xr = (f32x4*)(AOUT + (size_t)m * DM) + lane; f32x4 v[4]; float s = 0.f;
#pragma unroll
        for (int j = 0; j < 4; ++j) { v[j] = xr[64 * j]; s += (v[j].x * v[j].x + v[j].y * v[j].y) + (v[j].z * v[j].z + v[j].w * v[j].w); }
        const float rs = 1.0f / sqrtf(wave_sum(s) * (1.0f / DM) + EPS);
#pragma unroll
        for (int j = 0; j < 4; ++j) xr[64 * j] = v[j] * rs * gv[j];
    }
}
__device__ __forceinline__ void step_prep(const AV& a, int c, int layer) {
    const Chunk ck = chunk_of(c); bf16* U = (bf16*)(AWS + WS_U);
    for (int it = lbid() * NT + ltid(); it < CH * 10; it += gridDim.x * NT) {
        const int tok = it / 10, hd = it - tok * 10; const int pos = tok & (ck.L - 1);
        bf16* p = U + (size_t)tok * UP + (hd < 8 ? C_GQ + 64 * hd : C_GK + 64 * (hd - 8));
        const float* g = (hd < 8 ? AIN(I_QNG) : AIN(I_KNG)) + layer * 64;
        float x[64];
#pragma unroll
        for (int i = 0; i < 8; ++i) { const u32x4 w = *((const u32x4*)p + i);
            x[8 * i + 0] = bflo(w.x); x[8 * i + 1] = bfhi(w.x); x[8 * i + 2] = bflo(w.y); x[8 * i + 3] = bfhi(w.y); x[8 * i + 4] = bflo(w.z); x[8 * i + 5] = bfhi(w.z); x[8 * i + 6] = bflo(w.w); x[8 * i + 7] = bfhi(w.w); }
        float ss = 0.f;
#pragma unroll
        for (int i = 0; i < 64; ++i) ss += x[i] * x[i];
        const float rs = (1.0f / sqrtf(ss * (1.0f / 64.0f) + EPS)) * (hd < 8 ? 0.125f * LOG2E : 1.0f);
#pragma unroll
        for (int i = 0; i < 64; ++i) x[i] = x[i] * rs * g[i];
        const f32x4* rt = (const f32x4*)(AWS + WS_ROPE) + (size_t)pos * 16;
#pragma unroll
        for (int i2 = 0; i2 < 16; ++i2) { const f32x4 cs2 = rt[i2];
#pragma unroll
            for (int e = 0; e < 2; ++e) { const int i = 2 * i2 + e; const float cs = e ? cs2.z : cs2.x, sn = e ? cs2.w : cs2.y; const float x1 = x[i], x2 = x[i + 32]; x[i] = x1 * cs - x2 * sn; x[i + 32] = x2 * cs + x1 * sn; } }
#pragma unroll
        for (int i = 0; i < 8; ++i) { u32x4 w; w.x = pk2(x[8 * i], x[8 * i + 1]); w.y = pk2(x[8 * i + 2], x[8 * i + 3]); w.z = pk2(x[8 * i + 4], x[8 * i + 5]); w.w = pk2(x[8 * i + 6], x[8 * i + 7]); *((u32x4*)p + i) = w; }
    }
}
__device__ __forceinline__ void step_prep_hy(const AV& a, LAS unsigned char* lds, int c, int layer) {
    const Chunk ck = chunk_of(c); const bf16* U = (const bf16*)(AWS + WS_U);
    f32x2* HVP = (f32x2*)(AWS + WS_HVP); f32x2* PMP = (f32x2*)(AWS + WS_PMP);
    const int tid = ltid(), lane = tid & 63, wave = tid >> 6;
    LAS f32x2* th = (LAS f32x2*)(lds + wave * 17408); LAS f32x2* tp = th + 64 * 17;
    const float* cw = AIN(I_CONVW) + layer * 3 * 1536; const float* cb = AIN(I_CONVB) + layer * 1536;
    for (int it = lbid() * NWAVES + wave; it < (CH / 16) * 4; it += gridDim.x * NWAVES) {
        const int cbk = it & 3, tg = it >> 2, t0 = tg * 16, ch = cbk * 128 + 2 * lane;
        const int pos0 = t0 & (ck.L - 1);
        float w[3][3][2], bb[3][2];
#pragma unroll
        for (int ar = 0; ar < 3; ++ar) {
#pragma unroll
            for (int j = 0; j < 3; ++j) { const f32x2 v = *(const f32x2*)(cw + j * 1536 + ar * 512 + ch); w[ar][j][0] = v.x; w[ar][j][1] = v.y; }
            const f32x2 v = *(const f32x2*)(cb + ar * 512 + ch); bb[ar][0] = v.x; bb[ar][1] = v.y; }
        const bf16* r0 = U + (size_t)t0 * UP + ch;
        unsigned pv[3], cv[3], nv[3];
#pragma unroll
        for (int ar = 0; ar < 3; ++ar) { pv[ar] = pos0 > 0 ? *(const unsigned*)(r0 - UP + ar * 512) : 0u; cv[ar] = *(const unsigned*)(r0 + ar * 512); }
#pragma unroll 4
        for (int t = 0; t < 16; ++t) {
            const bf16* rt = r0 + (size_t)t * UP; const bool last = (pos0 + t + 1 >= ck.L);
#pragma unroll
            for (int ar = 0; ar < 3; ++ar) nv[ar] = last ? 0u : *(const unsigned*)(rt + UP + ar * 512);
            const unsigned gw = *(const unsigned*)(rt + C_HG);
            float o[3][2];
#pragma unroll
            for (int ar = 0; ar < 3; ++ar) { o[ar][0] = w[ar][0][0] * bflo(pv[ar]) + w[ar][1][0] * bflo(cv[ar]) + w[ar][2][0] * bflo(nv[ar]) + bb[ar][0];
                o[ar][1] = w[ar][0][1] * bfhi(pv[ar]) + w[ar][1][1] * bfhi(cv[ar]) + w[ar][2][1] * bfhi(nv[ar]) + bb[ar][1]; pv[ar] = cv[ar]; cv[ar] = nv[ar]; }
            th[lane * 17 + t] = (f32x2){o[2][0] * o[1][0], o[2][1] * o[1][1]};
            tp[lane * 17 + t] = (f32x2){o[0][0] * silu(bflo(gw)), o[0][1] * silu(bfhi(gw))};
        }
        asm volatile("s_waitcnt lgkmcnt(0)" ::: "memory");
#pragma unroll 4
        for (int i = 0; i < 16; ++i) { const int pl = 4 * i + (lane >> 4), tt = lane & 15; const size_t o = (size_t)(cbk * 64 + pl) * CH + t0 + tt;
            HVP[o] = th[pl * 17 + tt]; PMP[o] = tp[pl * 17 + tt]; }
        asm volatile("s_waitcnt lgkmcnt(0)" ::: "memory");
    }
}
typedef short bf16x8 __attribute__((ext_vector_type(8)));
typedef short s16x4 __attribute__((ext_vector_type(4)));
typedef float f32x16 __attribute__((ext_vector_type(16)));
typedef float f32x2_t __attribute__((ext_vector_type(2)));
typedef __bf16 bf16x2_t __attribute__((ext_vector_type(2)));
__device__ __forceinline__ unsigned cvtpk(float lo, float hi) { f32x2_t v = {lo, hi}; bf16x2_t b = __builtin_convertvector(v, bf16x2_t); return __builtin_bit_cast(unsigned, b); }
__device__ __forceinline__ int crow(int r, int hi) { return (r & 3) + 8 * (r >> 2) + 4 * hi; }
__device__ __forceinline__ s16x4 vtr(const LAS unsigned char* p) { return __builtin_bit_cast(s16x4, __builtin_amdgcn_ds_read_tr16_b64_v4i16((LAS s16x4*)p)); }
constexpr int ATT_K = 0;
constexpr int ATT_TB_DIFF = 4 * 8192 + 4 * 16384;
constexpr float C1 = 0.125f * LOG2E;
__device__ __forceinline__ void glds16(const void* gsrc, unsigned lds_dst) { unsigned keep;
    asm volatile("s_mov_b32 %0, m0\n\ts_mov_b32 m0, %2\n\ts_nop 0\n\tglobal_load_lds_dwordx4 %1, off\n\ts_mov_b32 m0, %0" : "=&s"(keep) : "v"(gsrc), "s"(lds_dst) : "memory"); }

template <int VD, bool BIAS, bool OMAX, int G>
__device__ __forceinline__ void flash_pass(LAS unsigned char* lds, const bf16* Qrow, const bf16* Kg, const bf16* Vg, int L, int qpos, int qw0, float bl, float br, f32x16 (&o)[VD / 32], float& l_out) {
    const int tid = ltid(), lane = tid & 63, r32 = lane & 31, hi = lane >> 5;
    constexpr int VROW = VD * 2, VT = 64 * VROW, NVL = VD / 64, NSL = 2 * G, ATT_V = NSL * 8192, ATT_TB = ATT_V + NSL * VT;
    const LAS float* tb = (const LAS float*)(lds + ATT_TB);
    typedef const __attribute__((address_space(1))) u32x4* g4p;
    const int wv = __builtin_amdgcn_readfirstlane(tid >> 6); const int ldsa = (int)(unsigned)(uintptr_t)lds;
    const bf16* ksrc; { const int X = wv * 1024 + lane * 16, line = X >> 8, c16 = ((X >> 4) & 15) ^ (line & 15), key = 2 * line + (c16 >> 3), ch = c16 & 7; ksrc = Kg + (size_t)key * UP + ch * 8; }
    const bf16* vsrc[NVL];
#pragma unroll
    for (int i = 0; i < NVL; ++i) { const int X = i * 8192 + wv * 1024 + lane * 16; const int key = (VD == 64) ? (X >> 7) : (X >> 8), posb = (VD == 64) ? (X & 127) : (X & 255);
        const int swz = (VD == 64) ? (((key >> 1) & 1) << 6) : ((key & 3) << 6); vsrc[i] = Vg + (size_t)key * UP + ((posb ^ swz) >> 1); }
#define ATT_DMA(tt_, sl_) do { const size_t go_ = (size_t)(tt_) * 64 * UP; \
        glds16(ksrc + go_, (unsigned)__builtin_amdgcn_readfirstlane(ldsa + ATT_K + (sl_) * 8192 + wv * 1024)); \
        _Pragma("unroll") for (int i_ = 0; i_ < NVL; ++i_) glds16(vsrc[i_] + go_, (unsigned)__builtin_amdgcn_readfirstlane(ldsa + ATT_V + (sl_) * VT + i_ * 8192 + wv * 1024)); } while (0)
#define ATT_DMAGROUP(g_) do { _Pragma("unroll") for (int j_ = 0; j_ < G; ++j_) { const int tt_ = (g_) * G + j_; ATT_DMA(tt_, tt_ & (NSL - 1)); } } while (0)
#define ATT_BAR() do { __builtin_amdgcn_s_barrier(); asm volatile("" ::: "memory"); } while (0)
    int koff[2][4];
#pragma unroll
    for (int kb = 0; kb < 2; ++kb)
#pragma unroll
        for (int s = 0; s < 4; ++s) { const int key = 32 * kb + r32, line = key >> 1, c16 = ((key & 1) << 3) | (2 * s + hi); koff[kb][s] = line * 256 + ((c16 ^ (line & 15)) << 4); }
    const int q4 = (lane & 15) >> 2, p4 = lane & 3, g1 = (lane >> 4) & 1;
    const int vsw = (VD == 64) ? ((q4 >> 1) & 1) : q4;
    const int vbase = (4 * hi + q4) * VROW + 32 * g1 + 8 * p4;
    bf16x8 qf[4];
#pragma unroll
    for (int s = 0; s < 4; ++s) qf[s] = __builtin_bit_cast(bf16x8, *(g4p)(Qrow + 16 * s + 8 * hi));
    float m_run = OMAX ? -1e30f : 0.f, l_run = 0.f;
    const int nt = L >> 6;
    asm volatile("" :: "v"(qf[0]), "v"(qf[1]), "v"(qf[2]), "v"(qf[3]) : "memory");
    asm volatile("s_waitcnt vmcnt(0)" ::: "memory");
    const int ng = nt / G;
    ATT_DMAGROUP(0); if (ng > 1) ATT_DMAGROUP(1);
    if (ng > 1) { if (G * (1 + NVL) == 8) asm volatile("s_waitcnt vmcnt(8)" ::: "memory"); else asm volatile("s_waitcnt vmcnt(6)" ::: "memory"); } else asm volatile("s_waitcnt vmcnt(0)" ::: "memory");
    static_assert(G * (1 + NVL) == 8 || G * (1 + NVL) == 6, "vmcnt immediates above");
    ATT_BAR();
#pragma unroll 1
    for (int t = 0; t < nt; ++t) {
        const int cur = t & (NSL - 1);
        const LAS unsigned char* kbuf = lds + ATT_K + cur * 8192; const LAS unsigned char* vbuf = lds + ATT_V + cur * VT;
        f32x16 p[2];
        { bf16x8 kf[2][4];
#pragma unroll
          for (int kb = 0; kb < 2; ++kb)
#pragma unroll
            for (int s = 0; s < 4; ++s) kf[kb][s] = *(const LAS bf16x8*)(kbuf + koff[kb][s]);
          __builtin_amdgcn_sched_barrier(0);
#pragma unroll
          for (int kb = 0; kb < 2; ++kb) { f32x16 acc;
#pragma unroll
            for (int r = 0; r < 16; ++r) acc[r] = 0.f;
#pragma unroll
            for (int s = 0; s < 4; ++s) acc = __builtin_amdgcn_mfma_f32_32x32x16_bf16(kf[kb][s], qf[s], acc, 0, 0, 0);
            p[kb] = acc; } }
        s16x4 vlo[2][4], vhi[2][4];
#define VREAD(buf_, db_) do { const int cofs_ = (((db_) ^ vsw) << 6); _Pragma("unroll") for (int kb = 0; kb < 2; ++kb) _Pragma("unroll") for (int ss = 0; ss < 2; ++ss) { \
            const LAS unsigned char* vp_ = vbuf + vbase + (32 * kb + 16 * ss) * VROW + cofs_; vlo[buf_][2 * kb + ss] = vtr(vp_); vhi[buf_][2 * kb + ss] = vtr(vp_ + 8 * VROW); } } while (0)
        VREAD(0, 0);
        __builtin_amdgcn_sched_barrier(0);
        const int k0 = t * 64; float mulc, bconst, mx = -3e38f; bool nearT = false;
        const bool domax = (t & 7) == 0;
        if (BIAS) { const int rlo = k0 - qw0 - 31, rhi = k0 + 63 - qw0; nearT = !(rhi <= -128 || rlo >= 128); }
        if (BIAS && nearT) {
#pragma unroll
            for (int kb = 0; kb < 2; ++kb)
#pragma unroll
                for (int r4 = 0; r4 < 4; ++r4) {
#pragma unroll
                    for (int e = 0; e < 4; ++e) { const int r = 4 * r4 + e; int rel = k0 + 32 * kb + crow(r, hi) - qpos; rel = rel < -128 ? -128 : (rel > 128 ? 128 : rel); const float v = p[kb][r] * C1 + tb[rel + 128]; p[kb][r] = v; mx = fmaxf(mx, v); }
                    __builtin_amdgcn_sched_barrier(0); }
            mulc = 1.0f; bconst = 0.f;
        } else {
            if (OMAX && domax) {
#pragma unroll
                for (int kb = 0; kb < 2; ++kb)
#pragma unroll
                    for (int r = 0; r < 16; ++r) mx = fmaxf(mx, p[kb][r]); }
            bconst = BIAS ? (k0 < qw0 ? bl : br) : 0.f; mx = mx * C1 + bconst; mulc = C1;
        }
        if (OMAX && (domax || (BIAS && nearT))) {
            mx = fmaxf(mx, shx(mx, 32));
            if (__any(mx > m_run)) { const float mn = fmaxf(m_run, mx), al = __builtin_amdgcn_exp2f(m_run - mn); l_run *= al;
#pragma unroll
                for (int db = 0; db < VD / 32; ++db) o[db] *= al;
                m_run = mn; }
        }
        const f32x2 mul2 = (f32x2){mulc, mulc}, add2 = (f32x2){bconst - m_run, bconst - m_run}; f32x2 ls2 = (f32x2){0.f, 0.f};
#pragma unroll
        for (int kb = 0; kb < 2; ++kb)
#pragma unroll
            for (int r = 0; r < 16; r += 2) { f32x2 v = (f32x2){p[kb][r], p[kb][r + 1]}; v = v * mul2 + add2; f32x2 e; e.x = __builtin_amdgcn_exp2f(v.x); e.y = __builtin_amdgcn_exp2f(v.y); ls2 += e; p[kb][r] = e.x; p[kb][r + 1] = e.y; }
        l_run += ls2.x + ls2.y;
        bf16x8 pk[2][2];
#pragma unroll
        for (int kb = 0; kb < 2; ++kb)
#pragma unroll
            for (int ss = 0; ss < 2; ++ss) { u32x4 w; w.x = cvtpk(p[kb][8 * ss + 0], p[kb][8 * ss + 1]); w.y = cvtpk(p[kb][8 * ss + 2], p[kb][8 * ss + 3]); w.z = cvtpk(p[kb][8 * ss + 4], p[kb][8 * ss + 5]); w.w = cvtpk(p[kb][8 * ss + 6], p[kb][8 * ss + 7]);
                pk[kb][ss] = __builtin_bit_cast(bf16x8, w); }
        __builtin_amdgcn_sched_barrier(0);
#pragma unroll
        for (int db = 0; db < VD / 32; ++db) {
            if (db + 1 < VD / 32) { if ((db + 1) & 1) VREAD(1, db + 1); else VREAD(0, db + 1); }
#pragma unroll
            for (int kb = 0; kb < 2; ++kb)
#pragma unroll
                for (int ss = 0; ss < 2; ++ss) { const bf16x8 vf = (db & 1) ? __builtin_shufflevector(vlo[1][2 * kb + ss], vhi[1][2 * kb + ss], 0, 1, 2, 3, 4, 5, 6, 7) : __builtin_shufflevector(vlo[0][2 * kb + ss], vhi[0][2 * kb + ss], 0, 1, 2, 3, 4, 5, 6, 7);
                    o[db] = __builtin_amdgcn_mfma_f32_32x32x16_bf16(vf, pk[kb][ss], o[db], 0, 0, 0); }
            __builtin_amdgcn_sched_barrier(0); }
#undef VREAD
        if (((t + 1) & (G - 1)) == 0) {
            asm volatile("s_waitcnt vmcnt(0)" ::: "memory"); ATT_BAR();
            const int g2 = (t + 1) / G + 1; if (g2 < ng) ATT_DMAGROUP(g2); }
    }
#undef ATT_DMA
#undef ATT_DMAGROUP
#undef ATT_BAR
    l_out = l_run + shx(l_run, 32);
}
__device__ __forceinline__ void gqa_unit(const AV& a, LAS unsigned char* lds, int seqrow0, int L, int h, int qb) {
    const int tid = ltid(), lane = tid & 63, r32 = lane & 31, hi = lane >> 5;
    const bf16* U = (const bf16*)(AWS + WS_U); bf16* Y = (bf16*)(AWS + WS_Y) + (size_t)1 * CH * 512;
    constexpr int G = 4, NSL = 2 * G, VROW = 128, VT = 8192, ATT_V = NSL * 8192;
    typedef const __attribute__((address_space(1))) u32x4* g4p;
    const int wv = __builtin_amdgcn_readfirstlane(tid >> 6); const int ldsa = (int)(unsigned)(uintptr_t)lds;
    const int qw0 = qb * 512 + wv * 64;
    const bf16* Kg = U + (size_t)seqrow0 * UP + C_GK + 64 * (h >> 2); const bf16* Vg = U + (size_t)seqrow0 * UP + C_GV + 64 * (h >> 2);
    const bf16* ksrc; { const int X = wv * 1024 + lane * 16, line = X >> 8, c16 = ((X >> 4) & 15) ^ (line & 15), key = 2 * line + (c16 >> 3), ch = c16 & 7; ksrc = Kg + (size_t)key * UP + ch * 8; }
    const bf16* vsrc; { const int X = wv * 1024 + lane * 16, key = X >> 7, posb = X & 127, swz = ((key >> 1) & 1) << 6; vsrc = Vg + (size_t)key * UP + ((posb ^ swz) >> 1); }
#define GQ_DMA(tt_, sl_) do { const size_t go_ = (size_t)(tt_) * 64 * UP; \
        glds16(ksrc + go_, (unsigned)__builtin_amdgcn_readfirstlane(ldsa + ATT_K + (sl_) * 8192 + wv * 1024)); \
        glds16(vsrc + go_, (unsigned)__builtin_amdgcn_readfirstlane(ldsa + ATT_V + (sl_) * VT + wv * 1024)); } while (0)
#define GQ_DMAGROUP(g_) do { _Pragma("unroll") for (int j_ = 0; j_ < G; ++j_) { const int tt_ = (g_) * G + j_; GQ_DMA(tt_, tt_ & (NSL - 1)); } } while (0)
#define GQ_BAR() do { __builtin_amdgcn_s_barrier(); asm volatile("" ::: "memory"); } while (0)
    int koff[2][4];
#pragma unroll
    for (int kb = 0; kb < 2; ++kb)
#pragma unroll
        for (int s = 0; s < 4; ++s) { const int key = 32 * kb + r32, line = key >> 1, c16 = ((key & 1) << 3) | (2 * s + hi); koff[kb][s] = line * 256 + ((c16 ^ (line & 15)) << 4); }
    const int q4 = (lane & 15) >> 2, p4 = lane & 3, g1 = (lane >> 4) & 1;
    const int vsw = (q4 >> 1) & 1;
    const int vbase = (4 * hi + q4) * VROW + 32 * g1 + 8 * p4;
    bf16x8 qf[2][4];
#pragma unroll
    for (int j = 0; j < 2; ++j)
#pragma unroll
        for (int s = 0; s < 4; ++s) qf[j][s] = __builtin_bit_cast(bf16x8, *(g4p)(U + (size_t)(seqrow0 + qw0 + 32 * j + r32) * UP + C_GQ + 64 * h + 16 * s + 8 * hi));
    f32x16 o[2][2];
#pragma unroll
    for (int j = 0; j < 2; ++j)
#pragma unroll
        for (int db = 0; db < 2; ++db)
#pragma unroll
            for (int r = 0; r < 16; ++r) o[j][db][r] = 0.f;
    float lrun[2] = {0.f, 0.f};
    const int nt = L >> 6, ng = nt / G;
    asm volatile("" :: "v"(qf[0][0]), "v"(qf[0][1]), "v"(qf[0][2]), "v"(qf[0][3]), "v"(qf[1][0]), "v"(qf[1][1]), "v"(qf[1][2]), "v"(qf[1][3]) : "memory");
    asm volatile("s_waitcnt vmcnt(0)" ::: "memory");
    GQ_DMAGROUP(0); if (ng > 1) GQ_DMAGROUP(1);
    if (ng > 1) asm volatile("s_waitcnt vmcnt(8)" ::: "memory"); else asm volatile("s_waitcnt vmcnt(0)" ::: "memory");
    GQ_BAR();
#pragma unroll 1
    for (int t = 0; t < nt; ++t) {
        const int cur = t & (NSL - 1);
        const LAS unsigned char* kbuf = lds + ATT_K + cur * 8192; const LAS unsigned char* vbuf = lds + ATT_V + cur * VT;
        f32x16 p[2][2];
        { bf16x8 kf[2][4];
#pragma unroll
          for (int kb = 0; kb < 2; ++kb)
#pragma unroll
            for (int s = 0; s < 4; ++s) kf[kb][s] = *(const LAS bf16x8*)(kbuf + koff[kb][s]);
          __builtin_amdgcn_sched_barrier(0);
#pragma unroll
          for (int kb = 0; kb < 2; ++kb)
#pragma unroll
            for (int j = 0; j < 2; ++j) { f32x16 acc;
#pragma unroll
              for (int r = 0; r < 16; ++r) acc[r] = 0.f;
#pragma unroll
              for (int s = 0; s < 4; ++s) acc = __builtin_amdgcn_mfma_f32_32x32x16_bf16(kf[kb][s], qf[j][s], acc, 0, 0, 0);
              p[j][kb] = acc; } }
        s16x4 vlo[2][4], vhi[2][4];
#define GQ_VREAD(buf_, db_) do { const int cofs_ = (((db_) ^ vsw) << 6); _Pragma("unroll") for (int kb = 0; kb < 2; ++kb) _Pragma("unroll") for (int ss = 0; ss < 2; ++ss) { \
            const LAS unsigned char* vp_ = vbuf + vbase + (32 * kb + 16 * ss) * VROW + cofs_; vlo[buf_][2 * kb + ss] = vtr(vp_); vhi[buf_][2 * kb + ss] = vtr(vp_ + 8 * VROW); } } while (0)
        bf16x8 pk[2][2][2];
#pragma unroll
        for (int j = 0; j < 2; ++j) { float ls0 = 0.f, ls1 = 0.f;
#pragma unroll
            for (int kb = 0; kb < 2; ++kb) {
#pragma unroll
                for (int r = 0; r < 16; r += 2) { const float e0 = __builtin_amdgcn_exp2f(p[j][kb][r]), e1 = __builtin_amdgcn_exp2f(p[j][kb][r + 1]); ls0 += e0; ls1 += e1; p[j][kb][r] = e0; p[j][kb][r + 1] = e1; }
#pragma unroll
                for (int ss = 0; ss < 2; ++ss) { u32x4 w; w.x = cvtpk(p[j][kb][8 * ss + 0], p[j][kb][8 * ss + 1]); w.y = cvtpk(p[j][kb][8 * ss + 2], p[j][kb][8 * ss + 3]); w.z = cvtpk(p[j][kb][8 * ss + 4], p[j][kb][8 * ss + 5]); w.w = cvtpk(p[j][kb][8 * ss + 6], p[j][kb][8 * ss + 7]);
                    pk[j][kb][ss] = __builtin_bit_cast(bf16x8, w); } }
            lrun[j] += ls0 + ls1; }
        __builtin_amdgcn_sched_barrier(0);
        GQ_VREAD(0, 0); GQ_VREAD(1, 1);
#pragma unroll
        for (int db = 0; db < 2; ++db) {
#pragma unroll
            for (int kb = 0; kb < 2; ++kb)
#pragma unroll
                for (int ss = 0; ss < 2; ++ss) { const bf16x8 vf = db ? __builtin_shufflevector(vlo[1][2 * kb + ss], vhi[1][2 * kb + ss], 0, 1, 2, 3, 4, 5, 6, 7) : __builtin_shufflevector(vlo[0][2 * kb + ss], vhi[0][2 * kb + ss], 0, 1, 2, 3, 4, 5, 6, 7);
#pragma unroll
                    for (int j = 0; j < 2; ++j) o[j][db] = __builtin_amdgcn_mfma_f32_32x32x16_bf16(vf, pk[j][kb][ss], o[j][db], 0, 0, 0); }
            __builtin_amdgcn_sched_barrier(0); }
#undef GQ_VREAD
        if (((t + 1) & (G - 1)) == 0) { asm volatile("s_waitcnt vmcnt(0)" ::: "memory"); GQ_BAR(); const int g2 = (t + 1) / G + 1; if (g2 < ng) GQ_DMAGROUP(g2); }
    }
#undef GQ_DMA
#undef GQ_DMAGROUP
#undef GQ_BAR
#pragma unroll
    for (int j = 0; j < 2; ++j) { const int lane2 = ltid() & 63, r32b = lane2 & 31, hib = lane2 >> 5;
        const float l = lrun[j] + shx(lrun[j], 32); const float inv = 1.0f / l; const size_t row = (size_t)(seqrow0 + qw0 + 32 * j + r32b);
#pragma unroll
        for (int db = 0; db < 2; ++db)
#pragma unroll
            for (int g = 0; g < 4; ++g) { const int d = 32 * db + 8 * g + 4 * hib; const u32x2 gw = *(const u32x2*)(U + row * UP + C_GG + 64 * h + d);
                const float y0 = o[j][db][4 * g] * inv * silu(bflo(gw.x)), y1 = o[j][db][4 * g + 1] * inv * silu(bfhi(gw.x)), y2 = o[j][db][4 * g + 2] * inv * silu(bflo(gw.y)), y3 = o[j][db][4 * g + 3] * inv * silu(bfhi(gw.y));
                u32x2 w; w.x = cvtpk(y0, y1); w.y = cvtpk(y2, y3); *(u32x2*)(Y + row * 512 + 64 * h + d) = w; } }
}
__device__ __forceinline__ void diff_unit(const AV& a, LAS unsigned char* lds, int seqrow0, int L, int h, int qb, int layer) {
    const int tid = ltid(), lane = tid & 63, wave = tid >> 6, r32 = lane & 31, hi = lane >> 5;
    const bf16* U = (const bf16*)(AWS + WS_U); bf16* Y = (bf16*)(AWS + WS_Y) + (size_t)2 * CH * 512; float* DT = (float*)(AWS + WS_DT);
    const float* relb = AIN(I_RELB);
    LAS float* tb = (LAS float*)(lds + ATT_TB_DIFF);
    for (int i = tid; i < 257; i += NT) { const int rel = i - 128, n = rel < 0 ? -rel : rel; int b = rel > 0 ? 16 : 0;
        if (n < 8) b += n; else { const int v = 8 + (31 - __builtin_clz((unsigned)(n * n))) - 6; b += v < 15 ? v : 15; }
        tb[i] = relb[b * 4 + h] * LOG2E; }
    const float bl = relb[15 * 4 + h] * LOG2E, br = relb[31 * 4 + h] * LOG2E;
    float lyf = (float)layer; asm volatile("" : "+v"(lyf));
    const float li = 0.8f - 0.6f * __expf(-0.3f * lyf);
    float d1, d2; { const float q1 = AIN(I_LQ1)[layer * 64 + lane], k1 = AIN(I_LK1)[layer * 64 + lane], q2 = AIN(I_LQ2)[layer * 64 + lane], k2 = AIN(I_LK2)[layer * 64 + lane]; d1 = wave_sum(q1 * k1); d2 = wave_sum(q2 * k2); }
    const float lam = __expf(d1) - __expf(d2) + li;
    const int qw0 = qb * 256 + wave * 32, qpos = qw0 + r32; const size_t row = (size_t)(seqrow0 + qpos);
    __syncthreads();
    f32x16 o[4]; float l; float ss = 0.f;
#pragma unroll 1
    for (int c = 0; c < 2; ++c) {
#pragma unroll
        for (int db = 0; db < 4; ++db)
#pragma unroll
            for (int r = 0; r < 16; ++r) o[db][r] = 0.f;
        flash_pass<128, true, true, 2>(lds, U + row * UP + C_DQ + 128 * h + 64 * c, U + (size_t)seqrow0 * UP + C_DK + 128 * h + 64 * c, U + (size_t)seqrow0 * UP + C_DV + 128 * h, L, qpos, qw0, bl, br, o, l);
        if (c == 0) { const float inv = 1.0f / l;
#pragma unroll
            for (int db = 0; db < 4; ++db)
#pragma unroll
                for (int g = 0; g < 4; ++g) { const int d = 32 * db + 8 * g + 4 * hi; *(f32x4*)(DT + row * 512 + 128 * h + d) = (f32x4){o[db][4 * g] * inv, o[db][4 * g + 1] * inv, o[db][4 * g + 2] * inv, o[db][4 * g + 3] * inv}; }
        } else { const float inv = lam / l;
#pragma unroll
            for (int db = 0; db < 4; ++db)
#pragma unroll
                for (int g = 0; g < 4; ++g) { const int d = 32 * db + 8 * g + 4 * hi; const f32x4 o0 = *(const f32x4*)(DT + row * 512 + 128 * h + d);
#pragma unroll
                    for (int e = 0; e < 4; ++e) { const float v = o0[e] - o[db][4 * g + e] * inv; o[db][4 * g + e] = v; ss += v * v; } }
        }
    }
    ss += shx(ss, 32);
    const float rs = (1.0f / sqrtf(ss * (1.0f / 128.0f) + EPS)) * (1.0f - li);
    const float* sg = AIN(I_SUBLN) + layer * 128;
#pragma unroll
    for (int db = 0; db < 4; ++db)
#pragma unroll
        for (int g = 0; g < 4; ++g) { const int d = 32 * db + 8 * g + 4 * hi; const u32x2 gw = *(const u32x2*)(U + row * UP + C_DG + 128 * h + d); const f32x4 gn = *(const f32x4*)(sg + d);
            const float y0 = o[db][4 * g] * rs * gn.x * silu(bflo(gw.x)), y1 = o[db][4 * g + 1] * rs * gn.y * silu(bfhi(gw.x)), y2 = o[db][4 * g + 2] * rs * gn.z * silu(bflo(gw.y)), y3 = o[db][4 * g + 3] * rs * gn.w * silu(bfhi(gw.y));
            u32x2 w; w.x = cvtpk(y0, y1); w.y = cvtpk(y2, y3); *(u32x2*)(Y + row * 512 + 128 * h + d) = w; }
}
template <int LOG4, int BATCH> __device__ __forceinline__ void hyena_unit(const AV& a, LAS unsigned char* lds, int seqrow0, int pr0, int layer) {
    constexpr int N = 1 << (2 * LOG4), L = N / 2, NPAD = N + N / 16;
    const int tid = ltid(); LAS f32x2* buf = (LAS f32x2*)lds;
    bf16* Y = (bf16*)(AWS + WS_Y) + (size_t)seqrow0 * 512;
    const unsigned char* sp = AWS + WS_SPEC + layer * SPEC_LAYER;
    constexpr int SPS = (LOG4 == 7) ? SPS_P : SPS_S;
    const f32x2* Pg = ((LOG4 == 7) ? (const f32x2*)sp : (const f32x2*)(sp + 2 * SPEC_P_BYTES)) + (size_t)pr0 * SPS;
    const f32x2* Mg = ((LOG4 == 7) ? (const f32x2*)(sp + SPEC_P_BYTES) : (const f32x2*)(sp + 2 * SPEC_P_BYTES + SPEC_S_BYTES)) + (size_t)pr0 * SPS;
    const f32x2* hvp = (const f32x2*)(AWS + WS_HVP) + (size_t)pr0 * CH + seqrow0; const f32x2* pmp = (const f32x2*)(AWS + WS_PMP) + (size_t)pr0 * CH + seqrow0;
#pragma unroll
    for (int b = 0; b < BATCH; ++b)
        for (int t = tid; t < L; t += NT) { buf[b * NPAD + PADI(t)] = hvp[(size_t)b * CH + t]; buf[b * NPAD + PADI(t + L)] = (f32x2){0.f, 0.f}; }
    __syncthreads();
    const f32x2* tw = (const f32x2*)(AWS + WS_TW);
    fft_fwd<LOG4, BATCH>(buf, tw, tid);
#pragma unroll
    for (int b = 0; b < BATCH; ++b)
        for (int k = tid; k <= L; k += NT) { const int p1 = b * NPAD + PADI(digitrev<LOG4>(k)), p2 = b * NPAD + PADI(digitrev<LOG4>((N - k) & (N - 1))); const f32x2 z1 = buf[p1], z2 = buf[p2], P = Pg[(size_t)b * SPS + k], M = Mg[(size_t)b * SPS + k];
            const f32x2 y1 = cmul(z1, P) + cmul(cconj(z2), M), y2 = cmulc(z2, P) + cmulc(cconj(z1), M);
            buf[p1] = y1; if (p2 != p1) buf[p2] = y2; }
    __syncthreads();
    fft_inv<LOG4, BATCH>(buf, tw, tid);
    for (int t = tid; t < L; t += NT) { unsigned w[BATCH];
#pragma unroll
        for (int b = 0; b < BATCH; ++b) { const f32x2 y = buf[b * NPAD + PADI(t)], m = pmp[(size_t)b * CH + t]; w[b] = cvtpk(y.x * m.x, y.y * m.y); }
        if (BATCH == 4) *(u32x4*)(Y + (size_t)t * 512 + 2 * pr0) = (u32x4){w[0], w[BATCH > 1 ? 1 : 0], w[BATCH > 2 ? 2 : 0], w[BATCH > 3 ? 3 : 0]};
        else *(unsigned*)(Y + (size_t)t * 512 + 2 * pr0) = w[0]; }
    __syncthreads();
}
#define XB_TMO      128
#define XB_XCNT(j)  (256  + 64 * (j))
#define XB_XSUB(j)  (1280 + 64 * (j))
#define XB_XGEN(j)  (2304 + 64 * (j))
#define XB_TOP      3328
#define XB_TOPGEN   3392
#define XCD_BAR_WORDS 3456
#define XB_SPIN_CAP (1u << 18)

__device__ __forceinline__ unsigned xb_ld(unsigned* p)              { return __hip_atomic_load(p, __ATOMIC_RELAXED, __HIP_MEMORY_SCOPE_AGENT); }
__device__ __forceinline__ unsigned xb_add(unsigned* p, unsigned v) { return __hip_atomic_fetch_add(p, v, __ATOMIC_RELAXED, __HIP_MEMORY_SCOPE_AGENT); }
__device__ __forceinline__ unsigned xb_xcc_id() { return (unsigned)__builtin_amdgcn_s_getreg((3 << 11) | 20) & 0xFu; }
#define XB_SPIN(cond, bar) do { unsigned _sp = 0; while (cond) { __builtin_amdgcn_s_sleep(1); \
    if ((++_sp & 255u) == 0u) { if (xb_ld(&(bar)[XB_TMO])) break; if (_sp > XB_SPIN_CAP) { atomicAdd(&(bar)[XB_TMO], 1u); break; } } } } while (0)

struct XcdBarrier {
    unsigned* bar; unsigned x;
    volatile LAS unsigned* st;
};

__device__ __forceinline__ XcdBarrier xcd_barrier_post(unsigned* bar, volatile LAS unsigned* st) {
    XcdBarrier b; b.bar = bar; b.x = xb_xcc_id(); b.st = st;
    if (threadIdx.x == 0) (void)xb_add(&bar[XB_XCNT(b.x)], 1u);
    return b;
}
__device__ __forceinline__ void xcd_barrier_complete(unsigned* bar, unsigned x, unsigned& nloc, unsigned& nx) {
    const unsigned G = gridDim.x * gridDim.y * gridDim.z;
    unsigned sum, cnt, mine, sp = 0u;
    for (;;) {
        sum = 0u; cnt = 0u; mine = 0u;
#pragma unroll
        for (unsigned j = 0; j < 16; ++j) { const unsigned c = xb_ld(&bar[XB_XCNT(j)]); sum += c; cnt += (c > 0u) ? 1u : 0u; mine = (j == x) ? c : mine; }
        if (sum == G) break;
        __builtin_amdgcn_s_sleep(1);
        if ((++sp & 255u) == 0u) { if (xb_ld(&bar[XB_TMO])) break; if (sp > XB_SPIN_CAP) { atomicAdd(&bar[XB_TMO], 1u); break; } }
    }
    nloc = mine > 0u ? mine : 1u; nx = cnt > 0u ? cnt : 1u;
}

__device__ __forceinline__ void xcd_barrier(const XcdBarrier& b) {
    asm volatile("s_waitcnt vmcnt(0)" ::: "memory");
    __syncthreads();
    if (threadIdx.x == 0) {
        unsigned* bar = b.bar;
        __builtin_amdgcn_s_waitcnt(0);
        unsigned nloc = b.st[0], nx = b.st[1];
        if (nloc == 0u) { xcd_barrier_complete(bar, b.x, nloc, nx); b.st[0] = nloc; b.st[1] = nx; }
        const unsigned old = xb_add(&bar[XB_XSUB(b.x)], 1u);
        const unsigned gen = old / nloc;
        if (old + 1u == (gen + 1u) * nloc) {
            __builtin_amdgcn_fence(__ATOMIC_RELEASE, "agent");
            asm volatile("s_waitcnt vmcnt(0)" ::: "memory");
            const unsigned og = xb_add(&bar[XB_TOP], 1u);
            const unsigned tg = og / nx;
            if (og + 1u == (tg + 1u) * nx) xb_add(&bar[XB_TOPGEN], 1u);
            else XB_SPIN(xb_ld(&bar[XB_TOPGEN]) == tg, bar);
            __builtin_amdgcn_fence(__ATOMIC_ACQUIRE, "agent");
            xb_add(&bar[XB_XGEN(b.x)], 1u);
            asm volatile("s_waitcnt vmcnt(0)" ::: "memory");
        } else {
            XB_SPIN(xb_ld(&bar[XB_XGEN(b.x)]) == gen, bar);
            __builtin_amdgcn_fence(__ATOMIC_ACQUIRE, "agent");
            asm volatile("s_waitcnt vmcnt(0)" ::: "memory");
        }
    }
    __syncthreads();
}

__device__ __forceinline__ void step_mix(const AV& a, LAS unsigned char* lds, int c, int layer, unsigned* ctr, int tmask) {
    const Chunk ck = chunk_of(c); const int nqb = ck.L / 256, nqg = ck.L / 512, nD = ck.nseq * 4 * nqb, nG = ck.nseq * 8 * nqg, nF = (ck.L == LP) ? ck.nseq * 256 : ck.nseq * 64, total = nD + nG + nF;
    volatile LAS unsigned* wq = (volatile LAS unsigned*)(lds + LDS_MAIN);
    for (;;) {
        if (ltid() == 0) wq[0] = atomicAdd(ctr, 1u);
        __syncthreads();
        const int u = (int)wq[0];
        __syncthreads();
        if (u >= total) break;
        if (u < nD) { if (tmask & 1) { const int qb = u % nqb, sh = u / nqb, h = sh & 3, s = sh >> 2; diff_unit(a, lds, s * ck.L, ck.L, h, qb, layer); } }
        else if (u < nD + nG) { if (tmask & 2) { const int v = u - nD, qb = v % nqg, sh = v / nqg, h = sh & 7, s = sh >> 3; gqa_unit(a, lds, s * ck.L, ck.L, h, qb); } }
        else { if (tmask & 4) { const int v = u - nD - nG; if (ck.L == LP) hyena_unit<7, 1>(a, lds, (v >> 8) * LP, v & 255, layer); else hyena_unit<6, 4>(a, lds, (v >> 6) * LS, (v & 63) * 4, layer); } }
    }
}
constexpr int STEPS_PER = 6, NPRO = 3, NSTEPS = NPRO + NCHUNK * 2 * STEPS_PER + 1;
__global__ void __launch_bounds__(NT, 2) mega_fwd(Args kargs) {
    extern __shared__ __attribute__((aligned(16))) unsigned char lds_raw[];
    LAS unsigned char* lds = (LAS unsigned char*)lds_raw;
    kargp_t kp = (kargp_t)__builtin_amdgcn_kernarg_segment_ptr();
    { volatile LAS unsigned* misc = (volatile LAS unsigned*)(lds + LDS_MAIN + 64); if (ltid() < 16) misc[ltid()] = 0u; }
    __syncthreads();
    XcdBarrier xbar = xcd_barrier_post((unsigned*)(kargs.ws + WS_CTL) + CW_BAR, (volatile LAS unsigned*)(lds + LDS_MAIN + 64 + 32));
    const int step_lo = kargs.lo, step_hi = kargs.hi;
#pragma unroll 1
    for (int step = step_lo; step < step_hi; ++step) {
        asm volatile("" : "+s"(kp));
        AV a; a.p = kp; unsigned char* ws = AWS;
        if (step == 0) { if (EN(0)) step_pro_a(a, lds); }
        else if (step == 1) { if (EN(11)) { step_pro_a2(a, lds); if (DUP_MASK & 32) { xcd_barrier(xbar); step_pro_a2(a, lds); } } }
        else if (step == 2) { if (EN(1)) { step_pro_b(a, lds); if (DUP_MASK & 64) { xcd_barrier(xbar); step_pro_b(a, lds); } } }
        else if (step == NSTEPS - 1) { if (DUP_MASK & 256) { for (int q = 0; q < 100; ++q) xcd_barrier(xbar); } if (EN(2)) step_final(a, (NCHUNK - 1) * CH, NTOK); }
        else {
            const int s2 = step - NPRO, cl = s2 / STEPS_PER, k = s2 - cl * STEPS_PER, c = cl >> 1, layer = cl & 1;
            const Chunk ck = chunk_of(c);
            if (k == 0) { if (layer == 0) { if (c > 0 && EN(2)) step_final(a, (c - 1) * CH, c * CH); } continue;     }
            else if (k == 2) { if (EN(5)) { step_prep(a, c, layer); step_prep_hy(a, lds, c, layer); if (layer == 0) { float* q = (float*)(ws + WS_SSQ); for (int i = lbid() * NT + ltid(); i < CH; i += (int)gridDim.x * NT) q[i] = 0.f; } } }
            else if (k == 3) {
#pragma unroll 1
                for (int rep = 0; rep < ((DUP_MASK & 7) ? 2 : 1); ++rep) { if (rep) xcd_barrier(xbar); step_mix(a, lds, c, layer, (unsigned*)(ws + WS_CTL) + step * 16 + 4 * rep, rep ? (DUP_MASK & 7) : 7); } }
            else { if (EN(4)) {
                pg8::Gemm g; pg8::OrderAll S; pg8::EpiAll E; const int G = (int)gridDim.x, bid = lbid();
                S.so.init(CH, k == 1 ? NCAT : 1024, G, bid); S.o2 = pg8::OrderG2{CH / 256, G, bid}; S.mode = (k == 4) ? 2 : 1;
                float* O = AOUT + (size_t)ck.tok0 * DM; const float* X = layer == 0 ? xin_rows(a, ck.tok0) : O;
                E.mode = (k == 1) ? 1 : (k == 4) ? 2 : 3;
                E.e1 = pg8::EpiG1{(pg8::bf16_t*)(ws + WS_U), (pg8::bf16_t*)(ws + WS_G), AIN(I_BMERGE) + layer * GP, layer == 1 ? (const float*)(ws + WS_SSQ) : (const float*)nullptr};
                E.e2 = pg8::EpiG2{(const pg8::bf16_t*)(ws + WS_G), (float*)(ws + WS_TMP), (pg8::bf16_t*)(ws + WS_MG), CH / 256};
                E.e3 = pg8::EpiG3{X, O, AIN(I_NORMG) + DM, (pg8::bf16_t*)(ws + WS_HN), (float*)(ws + WS_SSQ), layer == 0 ? 1 : 0};
                if (k == 1) g = pg8::Gemm{layer == 0 ? (const pg8::bf16_t*)(ws + WS_HN0) + (size_t)ck.tok0 * DM : (const pg8::bf16_t*)(ws + WS_HN), (const pg8::bf16_t*)(ws + WS_WCAT + layer * WCAT_BYTES), CH, NCAT, 1024};
                else if (k == 4) g = pg8::Gemm{(const pg8::bf16_t*)(ws + WS_Y), (const pg8::bf16_t*)(ws + WS_WBT + layer * WBT_BYTES), 3 * CH, 3072, 512};
                else g = pg8::Gemm{(const pg8::bf16_t*)(ws + WS_MG), (const pg8::bf16_t*)(ws + WS_WOT + layer * WOT_BYTES), CH, 1024, 1024};
                const int nrep = (((DUP_MASK & 8) && k == 1) || ((DUP_MASK & 16) && k == 4)) ? 2 : 1;
#pragma unroll 1
                for (int rep = 0; rep < nrep; ++rep) { if (rep) xcd_barrier(xbar); pg8::gemm_phase<pg8::EpiAll, pg8::OrderAll, true, true>(lds, g, S, E); }
            } }
        }
        if (step + 1 < step_hi) { if (step == 0) cg::this_grid().sync(); else xcd_barrier(xbar); }
    }
}
#ifndef MK_MULTI
#define MK_MULTI 0
#endif
extern "C" void kernel_launch(void* const* d_in, const int* in_sizes, int n_in, void* d_out, int out_size, void* d_ws, size_t ws_size, hipStream_t stream) {
    static int grid = 0;
    if (grid == 0) {
        if (n_in != N_IN || out_size != NTOK * DM || ws_size < WS_END) { fprintf(stderr, "kernel_launch: unexpected shapes (n_in %d, out %d, ws %zu)\n", n_in, out_size, ws_size); grid = -1; return; }
        int dev = 0, cus = 0, per_cu = 0;
        hipGetDevice(&dev); hipDeviceGetAttribute(&cus, hipDeviceAttributeMultiprocessorCount, dev);
        if (hipFuncSetAttribute((const void*)mega_fwd, hipFuncAttributeMaxDynamicSharedMemorySize, LDS_BYTES) != hipSuccess) { fprintf(stderr, "kernel_launch: hipFuncSetAttribute failed\n"); grid = -1; return; }
        hipOccupancyMaxActiveBlocksPerMultiprocessor(&per_cu, (const void*)mega_fwd, NT, LDS_BYTES);
        (void)hipGetLastError();
        if (per_cu < 1) per_cu = 1;
        grid = cus * 1;
        fprintf(stderr, "kernel_launch: cus %d per_cu %d grid %d\n", cus, per_cu, grid);
    }
    if (grid < 0) return;
    hipMemsetAsync((char*)d_ws + WS_CTL, 0, CTL_BYTES, stream);
    Args a{};
    for (int i = 0; i < N_IN; ++i) a.in[i] = (const float*)d_in[i];
    a.out = (float*)d_out; a.ws = (unsigned char*)d_ws;
#if MK_MULTI
    for (int s = 0; s < NSTEPS; ++s) { a.lo = s; a.hi = s + 1; hipLaunchKernelGGL(mega_fwd, dim3(grid), dim3(NT), LDS_BYTES, stream, a); }
#else
    a.lo = 0; a.hi = NSTEPS;
    void* args[] = {&a};
    hipError_t e = hipLaunchCooperativeKernel((const void*)mega_fwd, dim3(grid), dim3(NT), args, LDS_BYTES, stream);
    if (e != hipSuccess) fprintf(stderr, "cooperative launch failed: %s (grid %d)\n", hipGetErrorString(e), grid);
#endif
}
```

```cpp
#include <hip/hip_runtime.h>
#include <hip/hip_cooperative_groups.h>
#include <cstdio>
#include <cstdint>
namespace cg = cooperative_groups;
__device__ __forceinline__ int ltid() { int t = (int)threadIdx.x; asm volatile("" : "+v"(t)); return t; }
__device__ __forceinline__ float shx(float v, int o) { const int l = ltid() & 63; return __int_as_float(__builtin_amdgcn_ds_bpermute((l ^ o) << 2, __float_as_int(v))); }
__device__ __forceinline__ int lbid() { int b = (int)blockIdx.x; asm volatile("" : "+s"(b)); return b; }
namespace pg8 {
#define PG8_LAS __attribute__((address_space(3)))
typedef unsigned short bf16_t;
typedef short bf16x8 __attribute__((ext_vector_type(8)));
typedef float f32x4 __attribute__((ext_vector_type(4)));
typedef unsigned u32x4 __attribute__((ext_vector_type(4)));
constexpr int BM = 256, BK = 64, HALF = 128, HTB = HALF * BK * 2  , STAGE_BYTES = 8 * HTB, NXCD = 8, WGM = 8;

__host__ __device__ __forceinline__ int lds_byte(int r, int c) { const int st = (r >> 4) * 2 + (c >> 5), rr = r & 15, cc = c & 31, ob = rr * 64 + cc * 2; return st * 1024 + (ob ^ (((ob >> 9) & 1) << 5)); }
__host__ __device__ __forceinline__ void stage_rc(int b, int& R, int& C) { const int st = b / 1024, sb = b % 1024, swz = sb ^ (((sb >> 9) & 1) << 5); R = (st >> 1) * 16 + swz / 64; C = (st & 1) * 32 + (swz % 64) / 2; }
__host__ __device__ __forceinline__ int perm32(int rho) { const int n = rho >> 4, i = rho & 15; return 8 * (i >> 2) + 4 * n + (i & 3); }

struct Unit { int pm, pn; };
struct Gemm { const bf16_t* A; const bf16_t* Bt; int M, N, K; };

struct StaticOrder {
    int nM, nN, nwg, G, c;
    __host__ __device__ void init(int M, int N, int G_, int c_) { nM = M / BM; nN = N / BM; nwg = nM * nN; G = G_; c = c_; }
    __host__ __device__ bool next(int i, Unit& u) const {
        const long L = (long)i * G + c; if (L >= nwg) return false;
        int wgid = (int)L; { const int q = nwg / NXCD, r = nwg % NXCD, xcd = wgid % NXCD, off = wgid / NXCD; wgid = (xcd < r ? xcd * (q + 1) : r * (q + 1) + (xcd - r) * q) + off; }
        const int nig = WGM * nN, gid = wgid / nig, fm = gid * WGM, gsz = (nM - fm) < WGM ? (nM - fm) : WGM;
        u.pm = fm + ((wgid % nig) % gsz); u.pn = (wgid % nig) / gsz; return true;
    }
    __device__ __forceinline__ void a_ready(const Unit&) const {}
    __device__ __forceinline__ void done(const Unit&) const {}
};

__device__ __forceinline__ unsigned cvt_pk_bf16(float lo, float hi) { unsigned r; asm volatile("v_cvt_pk_bf16_f32 %0, %1, %2" : "=v"(r) : "v"(lo), "v"(hi)); return r; }
template <class Epi, class Sched, bool ALIGN_EPI = false, bool SP2 = false>
__device__ __forceinline__ void gemm_phase(PG8_LAS unsigned char* lds, const Gemm g, const Sched& S, const Epi& E) {
    const int tid = ltid(), wid = __builtin_amdgcn_readfirstlane(tid >> 6), lane = tid & 63, wr = wid >> 2, wc = wid & 3, fr = lane & 15, fq = lane >> 4;
    const int K = g.K, nt = K / BK;
    unsigned voffA[2], voffB[2];
#pragma unroll
    for (int i = 0; i < 2; ++i) { int R, C; stage_rc(tid * 16 + i * 8192, R, C); const int Rb = Epi::PERM ? ((R & ~31) + perm32(R & 31)) : R;
        voffA[i] = (unsigned)(R * K + C) * 2u; voffB[i] = (unsigned)(Rb * K + C) * 2u; }
    const size_t kstep = (size_t)(BK * 2);
    const size_t hstep = (size_t)HALF * K * 2;
    const size_t tstep = 2 * hstep;
    const unsigned ldsw = (unsigned)wid * 1024u;
    const int aoff = lds_byte(wr * 64 + fr, fq * 8), boff = lds_byte(wc * 32 + fr, fq * 8);
#define PG8_SA(b, h) (((b) * 2 + (h)) * HTB)
#define PG8_SB(b, h) ((4 + (b) * 2 + (h)) * HTB)
#define PG8_STAGE(bufoff, gbase, voff) do { _Pragma("unroll") for (int _i = 0; _i < 2; ++_i) \
        __builtin_amdgcn_global_load_lds((const unsigned*)((const char*)(gbase) + (voff)[_i]), (PG8_LAS unsigned*)(lds + (bufoff) + ldsw + _i * 8192), 16, 0, 0); } while (0)
#define PG8_LDA(dst, b, h) do { _Pragma("unroll") for (int m = 0; m < 4; ++m) _Pragma("unroll") for (int k = 0; k < 2; ++k) dst[m][k] = *(const PG8_LAS bf16x8*)(lds + PG8_SA(b, h) + aoff + m * 2048 + k * 1024); } while (0)
#define PG8_LDB(dst, b, h) do { _Pragma("unroll") for (int n = 0; n < 2; ++n) _Pragma("unroll") for (int k = 0; k < 2; ++k) dst[n][k] = *(const PG8_LAS bf16x8*)(lds + PG8_SB(b, h) + boff + n * 2048 + k * 1024); } while (0)
#define PG8_MMA(ai, bj, At, Bt) do { __builtin_amdgcn_s_setprio(1); _Pragma("unroll") for (int m = 0; m < 4; ++m) _Pragma("unroll") for (int n = 0; n < 2; ++n) _Pragma("unroll") for (int k = 0; k < 2; ++k) \
        acc[ai][bj][m][n] = __builtin_amdgcn_mfma_f32_16x16x32_bf16(Bt[n][k], At[m][k], acc[ai][bj][m][n], 0, 0, 0); __builtin_amdgcn_s_setprio(0); } while (0)
#define PG8_WAIT_V(n) asm volatile("s_waitcnt vmcnt(" #n ")" ::: "memory")
#define PG8_WAIT_L(n) asm volatile("s_waitcnt lgkmcnt(" #n ")" ::: "memory")
#define PG8_BAR __builtin_amdgcn_s_barrier()
#define PG8_SCHED __builtin_amdgcn_sched_barrier(0)
    Unit cur, nxt; int ui = 0;
    if (!S.next(0, cur)) return;
    f32x4 acc[2][2][4][2];
#pragma unroll
    for (int a = 0; a < 2; ++a)
#pragma unroll
        for (int b = 0; b < 2; ++b)
#pragma unroll
            for (int m = 0; m < 4; ++m)
#pragma unroll
                for (int n = 0; n < 2; ++n) acc[a][b][m][n] = (f32x4){0.f, 0.f, 0.f, 0.f};
    bf16x8 At[4][2], B0[2][2], B1[2][2];
    const char* cA = (const char*)g.A + (size_t)cur.pm * tstep; const char* cB = (const char*)g.Bt + (size_t)cur.pn * tstep;
    S.a_ready(cur);
    if constexpr (SP2) {
        PG8_STAGE(PG8_SB(0, 0), cB, voffB); PG8_STAGE(PG8_SB(0, 1), cB + hstep, voffB); PG8_STAGE(PG8_SA(0, 0), cA, voffA); PG8_STAGE(PG8_SA(0, 1), cA + hstep, voffA);
        if (wr == 1) PG8_BAR;
        PG8_WAIT_V(2); PG8_BAR;
        PG8_STAGE(PG8_SB(1, 0), cB + kstep, voffB); PG8_STAGE(PG8_SA(1, 0), cA + kstep, voffA); PG8_STAGE(PG8_SB(1, 1), cB + hstep + kstep, voffB);
        PG8_WAIT_V(6); PG8_BAR;
    } else {
        PG8_STAGE(PG8_SB(0, 0), cB, voffB); PG8_STAGE(PG8_SA(0, 0), cA, voffA); PG8_STAGE(PG8_SB(0, 1), cB + hstep, voffB); PG8_STAGE(PG8_SA(0, 1), cA + hstep, voffA);
        if (wr == 1) PG8_BAR;
        PG8_WAIT_V(4); PG8_BAR;
        PG8_STAGE(PG8_SB(1, 0), cB + kstep, voffB); PG8_STAGE(PG8_SA(1, 0), cA + kstep, voffA); PG8_STAGE(PG8_SB(1, 1), cB + hstep + kstep, voffB);
        PG8_WAIT_V(6); PG8_BAR;
    }
    for (;;) {
        const bool has_next = S.next(ui + 1, nxt);
        const char* nA = has_next ? (const char*)g.A + (size_t)nxt.pm * tstep : cA; const char* nB = has_next ? (const char*)g.Bt + (size_t)nxt.pn * tstep : cB;
        for (int t = 0; t < nt; t += 2) {
            const bool last = (t == nt - 2);
            const char* a1 = cA + (size_t)(t + 1) * kstep;
            const char* a2 = last ? nA : cA + (size_t)(t + 2) * kstep; const char* b2 = last ? nB : cB + (size_t)(t + 2) * kstep;
            const char* a3 = a2 + kstep; const char* b3 = b2 + kstep;
            if (last && has_next) S.a_ready(nxt);
            if constexpr (SP2) {
            PG8_LDB(B0, 0, 0); PG8_LDB(B1, 0, 1); PG8_SCHED; PG8_LDA(At, 0, 0); PG8_STAGE(PG8_SA(1, 1), a1 + hstep, voffA);
            PG8_WAIT_V(8); PG8_WAIT_L(0); PG8_BAR; PG8_MMA(0, 0, At, B0); PG8_MMA(0, 1, At, B1); PG8_BAR; PG8_SCHED;
            PG8_LDA(At, 0, 1); PG8_STAGE(PG8_SB(0, 0), b2, voffB); PG8_STAGE(PG8_SB(0, 1), b2 + hstep, voffB); PG8_STAGE(PG8_SA(0, 0), a2, voffA);
            PG8_WAIT_V(8); PG8_WAIT_L(0); PG8_BAR; PG8_MMA(1, 0, At, B0); PG8_MMA(1, 1, At, B1); PG8_BAR; PG8_SCHED;
            PG8_LDB(B0, 1, 0); PG8_LDB(B1, 1, 1); PG8_SCHED; PG8_LDA(At, 1, 0); PG8_STAGE(PG8_SA(0, 1), a2 + hstep, voffA);
            PG8_WAIT_V(8); PG8_WAIT_L(0); PG8_BAR; PG8_MMA(0, 0, At, B0); PG8_MMA(0, 1, At, B1); PG8_BAR; PG8_SCHED;
            PG8_LDA(At, 1, 1); PG8_STAGE(PG8_SB(1, 0), b3, voffB); PG8_STAGE(PG8_SB(1, 1), b3 + hstep, voffB); PG8_STAGE(PG8_SA(1, 0), a3, voffA);
            PG8_WAIT_V(8); PG8_WAIT_L(0); PG8_BAR; PG8_MMA(1, 0, At, B0); PG8_MMA(1, 1, At, B1); PG8_BAR; PG8_SCHED;
            } else {
            PG8_LDB(B0, 0, 0); PG8_SCHED; PG8_LDA(At, 0, 0); PG8_STAGE(PG8_SA(1, 1), a1 + hstep, voffA);
            PG8_WAIT_L(8); PG8_BAR; PG8_WAIT_L(0); PG8_MMA(0, 0, At, B0); PG8_BAR; PG8_SCHED;
            PG8_LDB(B1, 0, 1); PG8_STAGE(PG8_SB(0, 0), b2, voffB);
            PG8_BAR; PG8_WAIT_L(0); PG8_MMA(0, 1, At, B1); PG8_BAR;
            PG8_LDA(At, 0, 1); PG8_STAGE(PG8_SA(0, 0), a2, voffA);
            PG8_BAR; PG8_WAIT_L(0); PG8_MMA(1, 0, At, B0); PG8_BAR; PG8_SCHED;
            PG8_STAGE(PG8_SB(0, 1), b2 + hstep, voffB);
            PG8_WAIT_V(6); PG8_BAR; PG8_MMA(1, 1, At, B1); PG8_BAR;
            PG8_LDB(B0, 1, 0); PG8_SCHED; PG8_LDA(At, 1, 0); PG8_STAGE(PG8_SA(0, 1), a2 + hstep, voffA);
            PG8_WAIT_L(8); PG8_BAR; PG8_WAIT_L(0); PG8_MMA(0, 0, At, B0); PG8_BAR; PG8_SCHED;
            PG8_LDB(B1, 1, 1); PG8_STAGE(PG8_SB(1, 0), b3, voffB);
            PG8_BAR; PG8_WAIT_L(0); PG8_MMA(0, 1, At, B1); PG8_BAR;
            PG8_LDA(At, 1, 1); PG8_STAGE(PG8_SA(1, 0), a3, voffA);
            PG8_BAR; PG8_WAIT_L(0); PG8_MMA(1, 0, At, B0); PG8_BAR; PG8_SCHED;
            PG8_STAGE(PG8_SB(1, 1), b3 + hstep, voffB);
            PG8_WAIT_V(6); PG8_BAR; PG8_MMA(1, 1, At, B1); PG8_BAR;
            }
        }
        if constexpr (ALIGN_EPI) { if (wr == 0) PG8_BAR; }
        if constexpr (!Epi::AFTER_DRAIN) { E(acc, cur, wr, wc, fr, fq); S.done(cur); }
        if (!has_next) break;
#pragma unroll
        for (int a = 0; a < 2; ++a)
#pragma unroll
            for (int b = 0; b < 2; ++b)
#pragma unroll
                for (int m = 0; m < 4; ++m)
#pragma unroll
                    for (int n = 0; n < 2; ++n) acc[a][b][m][n] = (f32x4){0.f, 0.f, 0.f, 0.f};
        cur = nxt; cA = nA; cB = nB; ++ui;
        if constexpr (ALIGN_EPI) { if (wr == 1) PG8_BAR; }
    }
    PG8_WAIT_V(0);
    if constexpr (!ALIGN_EPI) { if (wr == 0) PG8_BAR; }
    PG8_BAR;
    if constexpr (Epi::AFTER_DRAIN) { E.fused(acc, cur, wr, wc, fr, fq, lds, wid, lane); S.done(cur); }
#undef PG8_SA
#undef PG8_SB
#undef PG8_STAGE
#undef PG8_LDA
#undef PG8_LDB
#undef PG8_MMA
#undef PG8_WAIT_V
#undef PG8_WAIT_L
#undef PG8_BAR
#undef PG8_SCHED
}
__device__ __forceinline__ float bf2f(unsigned short h) { return __uint_as_float(((unsigned)h) << 16); }
__device__ __forceinline__ float fast_sigmoid(float x) { return __builtin_amdgcn_rcpf(1.0f + __builtin_amdgcn_exp2f(-1.4426950408889634f * x)); }
struct EpiG1 {
    static constexpr bool PERM = true, AFTER_DRAIN = false;
    bf16_t* U; bf16_t* G; const float* bias; const float* ssq;
    __device__ __forceinline__ void operator()(const f32x4 (&acc)[2][2][4][2], const Unit& u, int wr, int wc, int fr, int fq) const {
        const int row0 = u.pm * BM + wr * 64 + fr; int colt = u.pn * BM; const bool isg = colt >= 5376;
        bf16_t* base = U; int ldc = 5376; if (isg) { colt -= 5376; base = G; ldc = 3072; }
        const int col0 = colt + wc * 32 + 8 * fq;
        f32x4 bv[2][2];
#pragma unroll
        for (int bj = 0; bj < 2; ++bj)
#pragma unroll
            for (int n = 0; n < 2; ++n) bv[bj][n] = isg ? *(const f32x4*)(bias + col0 + bj * HALF + 4 * n) : (f32x4){0.f, 0.f, 0.f, 0.f};
        float rsq[2][4];
#pragma unroll
        for (int ai = 0; ai < 2; ++ai)
#pragma unroll
            for (int m = 0; m < 4; ++m) rsq[ai][m] = ssq ? __builtin_amdgcn_rsqf(ssq[row0 + ai * HALF + m * 16] * (1.0f / 1024.0f) + 1e-6f) : 1.0f;
#pragma unroll
        for (int ai = 0; ai < 2; ++ai)
#pragma unroll
            for (int m = 0; m < 4; ++m) { bf16_t* rowp = base + (size_t)(row0 + ai * HALF + m * 16) * ldc + col0;
                const float rs = rsq[ai][m];
#pragma unroll
                for (int bj = 0; bj < 2; ++bj) { f32x4 v0 = acc[ai][bj][m][0] * rs + bv[bj][0], v1 = acc[ai][bj][m][1] * rs + bv[bj][1];
                    if (isg) {
#pragma unroll
                        for (int e = 0; e < 4; ++e) { v0[e] = fast_sigmoid(v0[e]); v1[e] = fast_sigmoid(v1[e]); } }
                    u32x4 w; w.x = cvt_pk_bf16(v0[0], v0[1]); w.y = cvt_pk_bf16(v0[2], v0[3]); w.z = cvt_pk_bf16(v1[0], v1[1]); w.w = cvt_pk_bf16(v1[2], v1[3]);
                    *(u32x4*)(rowp + bj * HALF) = w; } }
    }
};
struct EpiG2 {
    static constexpr bool PERM = true, AFTER_DRAIN = false;
    const bf16_t* G; float* T; bf16_t* Mg; int npan;
    __device__ __forceinline__ void operator()(const f32x4 (&acc)[2][2][4][2], const Unit& u, int wr, int wc, int fr, int fq) const {
        const int b = u.pm / npan, pm = u.pm - b * npan, pn = u.pn & 3;
        const int row0 = pm * BM + wr * 64 + fr, col0 = pn * BM + wc * 32 + 8 * fq;
#pragma unroll
        for (int ai = 0; ai < 2; ++ai)
#pragma unroll
          for (int mh = 0; mh < 2; ++mh) {
            u32x4 gq[4][2], tq[4][2];
#pragma unroll
            for (int m = 2 * mh; m < 2 * mh + 2; ++m)
#pragma unroll
                for (int bj = 0; bj < 2; ++bj) { const size_t row = (size_t)(row0 + ai * HALF + m * 16); const int col = col0 + bj * HALF;
                    gq[m][bj] = *(const u32x4*)(G + row * 3072 + b * 1024 + col);
                    tq[m][bj] = (b > 0) ? *(const u32x4*)(Mg + row * 1024 + col) : (u32x4){0u, 0u, 0u, 0u}; }
            __builtin_amdgcn_sched_barrier(0);
#pragma unroll
            for (int m = 2 * mh; m < 2 * mh + 2; ++m)
#pragma unroll
                for (int bj = 0; bj < 2; ++bj) { const size_t row = (size_t)(row0 + ai * HALF + m * 16); const int col = col0 + bj * HALF; const u32x4 g = gq[m][bj], t = tq[m][bj];
                    f32x4 v0 = acc[ai][bj][m][0], v1 = acc[ai][bj][m][1];
                    v0[0] = v0[0] * __uint_as_float(g.x << 16) + __uint_as_float(t.x << 16); v0[1] = v0[1] * __uint_as_float(g.x & 0xffff0000u) + __uint_as_float(t.x & 0xffff0000u);
                    v0[2] = v0[2] * __uint_as_float(g.y << 16) + __uint_as_float(t.y << 16); v0[3] = v0[3] * __uint_as_float(g.y & 0xffff0000u) + __uint_as_float(t.y & 0xffff0000u);
                    v1[0] = v1[0] * __uint_as_float(g.z << 16) + __uint_as_float(t.z << 16); v1[1] = v1[1] * __uint_as_float(g.z & 0xffff0000u) + __uint_as_float(t.z & 0xffff0000u);
                    v1[2] = v1[2] * __uint_as_float(g.w << 16) + __uint_as_float(t.w << 16); v1[3] = v1[3] * __uint_as_float(g.w & 0xffff0000u) + __uint_as_float(t.w & 0xffff0000u);
                    u32x4 w; w.x = cvt_pk_bf16(v0[0], v0[1]); w.y = cvt_pk_bf16(v0[2], v0[3]); w.z = cvt_pk_bf16(v1[0], v1[1]); w.w = cvt_pk_bf16(v1[2], v1[3]);
                    *(u32x4*)(Mg + row * 1024 + col) = w; }
            __builtin_amdgcn_sched_barrier(0); }
    }
};
struct OrderG2 {
    int npan, G, c;
    __device__ bool next(int i, Unit& u) const { const int ti = i / 3, b = i - 3 * ti, t = ti * G + c; if (t >= npan * 4) return false;
        const int pm = t >> 2, pn = t & 3; u.pm = b * npan + pm; u.pn = b * 4 + pn; return true; }
    __device__ __forceinline__ void a_ready(const Unit&) const {}
    __device__ __forceinline__ void done(const Unit&) const {}
};
struct EpiG3 {
    static constexpr bool PERM = true, AFTER_DRAIN = false;
    const float* X; float* O; const float* gn; bf16_t* HN; float* ssq; int fuse;
    __device__ __forceinline__ void operator()(const f32x4 (&acc)[2][2][4][2], const Unit& u, int wr, int wc, int fr, int fq) const {
        const int row0 = u.pm * BM + wr * 64 + fr, col0 = u.pn * BM + wc * 32 + 8 * fq;
        f32x4 gv[2][2];
#pragma unroll
        for (int bj = 0; bj < 2; ++bj)
#pragma unroll
            for (int n = 0; n < 2; ++n) gv[bj][n] = fuse ? *(const f32x4*)(gn + col0 + bj * HALF + 4 * n) : (f32x4){0.f, 0.f, 0.f, 0.f};
#pragma unroll
        for (int ai = 0; ai < 2; ++ai)
#pragma unroll
         for (int mh = 0; mh < 2; ++mh) {
          f32x4 xq[4][2][2];
#pragma unroll
          for (int m = 2 * mh; m < 2 * mh + 2; ++m)
#pragma unroll
              for (int bj = 0; bj < 2; ++bj) { const size_t p = (size_t)(row0 + ai * HALF + m * 16) * 1024 + col0 + bj * HALF; xq[m][bj][0] = *(const f32x4*)(X + p); xq[m][bj][1] = *(const f32x4*)(X + p + 4); }
          __builtin_amdgcn_sched_barrier(0);
#pragma unroll
            for (int m = 2 * mh; m < 2 * mh + 2; ++m) { const size_t row = (size_t)(row0 + ai * HALF + m * 16); float sq = 0.f;
#pragma unroll
                for (int bj = 0; bj < 2; ++bj) { const size_t p = row * 1024 + col0 + bj * HALF;
                    const f32x4 x0 = xq[m][bj][0], x1 = xq[m][bj][1];
                    const f32x4 o0 = x0 + acc[ai][bj][m][0], o1 = x1 + acc[ai][bj][m][1];
                    *(f32x4*)(O + p) = o0; *(f32x4*)(O + p + 4) = o1;
                    if (fuse) { const f32x4 h0 = o0 * gv[bj][0], h1 = o1 * gv[bj][1];
                        u32x4 w; w.x = cvt_pk_bf16(h0[0], h0[1]); w.y = cvt_pk_bf16(h0[2], h0[3]); w.z = cvt_pk_bf16(h1[0], h1[1]); w.w = cvt_pk_bf16(h1[2], h1[3]);
                        *(u32x4*)(HN + p) = w;
                        sq += (o0[0] * o0[0] + o0[1] * o0[1]) + (o0[2] * o0[2] + o0[3] * o0[3]) + (o1[0] * o1[0] + o1[1] * o1[1]) + (o1[2] * o1[2] + o1[3] * o1[3]); } }
                if (fuse) { sq += shx(sq, 16); sq += shx(sq, 32); if (fq == 0) atomicAdd(ssq + row, sq); } }
          __builtin_amdgcn_sched_barrier(0); }
    }
};
struct EpiAll {
    static constexpr bool PERM = true, AFTER_DRAIN = false;
    int mode; EpiG1 e1; EpiG2 e2; EpiG3 e3;
    __device__ __forceinline__ void operator()(const f32x4 (&acc)[2][2][4][2], const Unit& u, int wr, int wc, int fr, int fq) const {
        if (mode == 1) e1(acc, u, wr, wc, fr, fq); else if (mode == 2) e2(acc, u, wr, wc, fr, fq); else e3(acc, u, wr, wc, fr, fq); }
};
struct OrderAll {
    int mode; StaticOrder so; OrderG2 o2;
    __device__ __forceinline__ bool next(int i, Unit& u) const { return mode == 2 ? o2.next(i, u) : so.next(i, u); }
    __device__ __forceinline__ void a_ready(const Unit&) const {}
    __device__ __forceinline__ void done(const Unit&) const {}
};
}
#ifndef DUP_MASK
#define DUP_MASK 0
#endif
#ifndef EN_MASK
#define EN_MASK 0xffff
#endif
#define EN(i) ((EN_MASK >> (i)) & 1)
#define LAS __attribute__((address_space(3)))
typedef unsigned short bf16;
typedef float f32x4 __attribute__((ext_vector_type(4)));
typedef float f32x2 __attribute__((ext_vector_type(2)));
typedef unsigned u32x4 __attribute__((ext_vector_type(4)));
typedef unsigned u32x2 __attribute__((ext_vector_type(2)));
constexpr int DM = 1024, NTOK_P = 65536, NTOK_S = 32768, NTOK = NTOK_P + NTOK_S, LP = 8192, LS = 2048;
constexpr int CH = 16384, NCHUNK = NTOK / CH, NCH_P = NTOK_P / CH;
constexpr int UP = 5376, NCAT = 8448, GP = 3072;
constexpr int C_X0 = 0, C_X1 = 512, C_HV = 1024, C_HG = 1536, C_GQ = 2048, C_GK = 2560, C_GV = 2688, C_GG = 2816, C_DQ = 3328, C_DK = 3840, C_DV = 4352, C_DG = 4864;
constexpr float EPS = 1e-6f, LOG2E = 1.4426950408889634f;
constexpr int NT = 512, NWAVES = 8;
enum { I_XP = 0, I_XS, I_RELB, I_NORMG, I_WIN, I_CONVW, I_CONVB, I_FW1, I_FB1, I_FW2, I_FB2, I_FWOUT, I_FFREQ, I_HYBIAS, I_QNG, I_KNG, I_LQ1, I_LK1, I_LQ2, I_LK2, I_SUBLN, I_WBHY, I_WBGQ, I_WBDF, I_WMERGE, I_BMERGE, I_WOUT, I_FINALG, N_IN };
constexpr size_t MiB = 1u << 20;
constexpr size_t WS_CTL = 0, CTL_BYTES = 64 * 1024;
constexpr size_t WS_TW = 1 * MiB;
constexpr size_t WS_WCAT = 2 * MiB, WCAT_BYTES = (size_t)NCAT * 1024 * 2;
constexpr size_t WS_WBT = 40 * MiB, WBT_BYTES = (size_t)3 * 1024 * 512 * 2;
constexpr size_t WS_WOT = 46 * MiB, WOT_BYTES = (size_t)1024 * 1024 * 2;
constexpr int SPS_P = LP + 16, SPS_S = LS + 16;
constexpr size_t SPEC_P_BYTES = (size_t)256 * SPS_P * 8, SPEC_S_BYTES = (size_t)256 * SPS_S * 8;
constexpr size_t SPEC_LAYER = 2 * SPEC_P_BYTES + 2 * SPEC_S_BYTES;
constexpr size_t WS_SPEC = 52 * MiB;
constexpr size_t WS_HN = 140 * MiB, WS_U = 172 * MiB, WS_G = 340 * MiB, WS_Y = 436 * MiB, WS_MG = 484 * MiB, WS_TMP = 516 * MiB, WS_DT = 580 * MiB, WS_HVP = 612 * MiB, WS_PMP = 644 * MiB, WS_ROPE = 676 * MiB, WS_HN0 = 680 * MiB, WS_END = 872 * MiB;
constexpr size_t HF_P_BYTES = (size_t)LP * 1024 * 4, HF_S_BYTES = (size_t)LS * 1024 * 4;
static_assert(WS_WCAT + 2 * WCAT_BYTES <= WS_WBT && WS_WBT + 2 * WBT_BYTES <= WS_WOT && WS_WOT + 2 * WOT_BYTES <= WS_SPEC && WS_SPEC + 2 * SPEC_LAYER <= WS_HN, "ws map");
static_assert(WS_HN + (size_t)CH * 1024 * 2 <= WS_U && WS_U + (size_t)CH * UP * 2 <= WS_G && WS_G + (size_t)CH * GP * 2 <= WS_Y && WS_Y + (size_t)3 * CH * 512 * 2 <= WS_MG && WS_MG + (size_t)CH * 1024 * 2 <= WS_TMP && WS_TMP + (size_t)CH * 1024 * 4 <= WS_DT && WS_DT + (size_t)CH * 512 * 4 <= WS_END, "ws map 2");
static_assert(2 * (HF_P_BYTES + HF_S_BYTES) <= (size_t)CH * UP * 2, "hf overlay");
constexpr size_t WS_SSQ = WS_TMP;
constexpr int LDS_MAIN = 139264, LDS_BYTES = LDS_MAIN + 1024;
constexpr int CW_BAR = 4096;

struct Args { const float* in[N_IN]; float* out; unsigned char* ws; int lo, hi; };
typedef const __attribute__((address_space(4))) unsigned long long* kargp_t;
struct AV { kargp_t p; };
#define AIN(i) ((const float*)(a.p[(i)]))
#define AOUT ((float*)(a.p[N_IN]))
#define AWS ((unsigned char*)(a.p[N_IN + 1]))


__device__ __forceinline__ float bf2f(unsigned short h) { return __uint_as_float(((unsigned)h) << 16); }
__device__ __forceinline__ float bflo(unsigned w) { return __uint_as_float(w << 16); }
__device__ __forceinline__ float bfhi(unsigned w) { return __uint_as_float(w & 0xffff0000u); }
__device__ __forceinline__ unsigned f2bf(float f) { unsigned u = __builtin_bit_cast(unsigned, f); return (u + 0x7fffu + ((u >> 16) & 1u)) >> 16; }
__device__ __forceinline__ unsigned pk2(float lo, float hi) { return f2bf(lo) | (f2bf(hi) << 16); }
__device__ __forceinline__ float silu(float x) { return x * __builtin_amdgcn_rcpf(1.0f + __builtin_amdgcn_exp2f(-LOG2E * x)); }
__device__ __forceinline__ float wave_sum(float v) {
#pragma unroll
    for (int o = 1; o < 64; o <<= 1) v += shx(v, o);
    return v;
}
__device__ __forceinline__ double kd(double v) { asm volatile("" : "+s"(v)); return v; }
__device__ __forceinline__ void sincos_rev(double r, float& s, float& c) {
    r -= __builtin_rint(r);
    const double k = __builtin_rint(r * 4.0);
    const double x = (r - k * 0.25) * kd(6.283185307179586476925);
    const double x2 = x * x;
    double sp = kd(1.0 / 6227020800.0); sp = sp * x2 + kd(-1.0 / 39916800); sp = sp * x2 + kd(1.0 / 362880); sp = sp * x2 + kd(-1.0 / 5040); sp = sp * x2 + kd(1.0 / 120); sp = sp * x2 + kd(-1.0 / 6); sp = sp * x2 + 1.0; sp *= x;
    double cp = kd(-1.0 / 87178291200.0); cp = cp * x2 + kd(1.0 / 479001600.0); cp = cp * x2 + kd(-1.0 / 3628800); cp = cp * x2 + kd(1.0 / 40320); cp = cp * x2 + kd(-1.0 / 720); cp = cp * x2 + kd(1.0 / 24); cp = cp * x2 + (-0.5); cp = cp * x2 + 1.0;
    const int q = ((int)k) & 3;
    const float sf = (float)sp, cf = (float)cp;
    s = (q == 0) ? sf : (q == 1) ? cf : (q == 2) ? -sf : -cf;
    c = (q == 0) ? cf : (q == 1) ? -sf : (q == 2) ? -cf : sf;
}
__device__ __forceinline__ float sin_acc(float x) { float s, c; sincos_rev((double)x * 0.15915494309189533577, s, c); return s; }

__device__ __forceinline__ void transpose_item(const float* W, int K, int N, bf16* WT, int row_off, LAS float* scr, int item, int lane) {
    const int nblk = N / 32, kb = item / nblk, nb = item % nblk, k0 = 64 * kb, n0 = 32 * nb;
#pragma unroll 8
    for (int i = 0; i < 32; ++i) { const int kk = 2 * i + (lane >> 5); scr[kk * 33 + (lane & 31)] = W[(size_t)(k0 + kk) * N + n0 + (lane & 31)]; }
    asm volatile("s_waitcnt lgkmcnt(0)" ::: "memory");
    const int c = lane & 7;
#pragma unroll
    for (int j = 0; j < 4; ++j) { const int n = (lane >> 3) + 8 * j; const LAS float* s = scr + (8 * c) * 33 + n;
        u32x4 o; o.x = pk2(s[0 * 33], s[1 * 33]); o.y = pk2(s[2 * 33], s[3 * 33]); o.z = pk2(s[4 * 33], s[5 * 33]); o.w = pk2(s[6 * 33], s[7 * 33]);
        *(u32x4*)(WT + (size_t)(row_off + n0 + n) * K + k0 + 8 * c) = o; }
    asm volatile("s_waitcnt lgkmcnt(0)" ::: "memory");
}

__device__ __forceinline__ f32x2 cmul(f32x2 a, f32x2 b) { return (f32x2){a.x * b.x - a.y * b.y, a.x * b.y + a.y * b.x}; }
__device__ __forceinline__ f32x2 cmulc(f32x2 a, f32x2 b) { return (f32x2){a.x * b.x + a.y * b.y, a.y * b.x - a.x * b.y}; }
__device__ __forceinline__ f32x2 cconj(f32x2 a) { return (f32x2){a.x, -a.y}; }
template <int LOG4> __device__ __forceinline__ int digitrev(int k) { unsigned x = __builtin_bitreverse32((unsigned)k) >> (32 - 2 * LOG4); return (int)(((x & 0x55555555u) << 1) | ((x >> 1) & 0x55555555u)); }
#define PADI(i) ((i) + ((i) >> 4))
#define W16C 0.92387953251128674f
#define W16S 0.38268343236508977f
#define W16H 0.70710678118654752f
__device__ __forceinline__ f32x2 w16(int m) { return m == 0 ? (f32x2){1.f, 0.f} : m == 1 ? (f32x2){W16C, -W16S} : m == 2 ? (f32x2){W16H, -W16H} : m == 3 ? (f32x2){W16S, -W16C} : m == 4 ? (f32x2){0.f, -1.f} : m == 6 ? (f32x2){-W16H, -W16H} : (f32x2){-W16C, W16S}; }
__device__ __forceinline__ void bfly_fwd(f32x2& a0, f32x2& a1, f32x2& a2, f32x2& a3) {
    const f32x2 t0 = a0 + a2, t1 = a0 - a2, t2 = a1 + a3, t3 = a1 - a3;
    a0 = t0 + t2; a2 = t0 - t2; a1 = (f32x2){t1.x + t3.y, t1.y - t3.x}; a3 = (f32x2){t1.x - t3.y, t1.y + t3.x};
}
__device__ __forceinline__ void bfly_inv(f32x2& b0, f32x2& b1, f32x2& b2, f32x2& b3) {
    const f32x2 t0 = b0 + b2, t1 = b0 - b2, t2 = b1 + b3, t3 = b1 - b3;
    b0 = t0 + t2; b2 = t0 - t2; b1 = (f32x2){t1.x - t3.y, t1.y + t3.x}; b3 = (f32x2){t1.x + t3.y, t1.y - t3.x};
}
template <int LOG4, int BATCH = 1> __device__ __forceinline__ void fft_fwd(LAS f32x2* buf, const f32x2* __restrict__ tw, int tid) {
    constexpr int N = 1 << (2 * LOG4), TWS = 16384 / N;
    constexpr int NPAD = N + N / 16, NLEV = LOG4 - 2, NP16 = NLEV / 2;
#pragma unroll 1
    for (int ps = 0; ps < NP16; ++ps) {
        const int lq4 = 2 * (LOG4 - 2 * ps) - 2, lq16 = lq4 - 2, q4 = 1 << lq4, q16 = 1 << lq16, tsA = TWS << (4 * ps), tsB = tsA << 2;
        constexpr int TOT = BATCH * N / 16, IT = (TOT + NT - 1) / NT;
#pragma unroll
        for (int i = 0; i < IT; ++i) { const int jg = tid + i * NT; if (TOT % NT != 0 && jg >= TOT) break; const int bo = (jg >> (2 * LOG4 - 4)) * NPAD, j = jg & (N / 16 - 1);
            const int blk = j >> lq16, jj = j & (q16 - 1), base = (blk << (lq4 + 2)) + jj;
            f32x2 wa[4], wb = tw[jj * tsB];
#pragma unroll
            for (int b = 0; b < 4; ++b) wa[b] = tw[(jj + b * q16) * tsA];
            f32x2 e[4][4];
#pragma unroll
            for (int a = 0; a < 4; ++a)
#pragma unroll
                for (int b = 0; b < 4; ++b) e[a][b] = buf[bo + PADI(base + b * q16 + a * q4)];
#pragma unroll
            for (int b = 0; b < 4; ++b) { bfly_fwd(e[0][b], e[1][b], e[2][b], e[3][b]); const f32x2 w2 = cmul(wa[b], wa[b]), w3 = cmul(w2, wa[b]); e[1][b] = cmul(e[1][b], wa[b]); e[2][b] = cmul(e[2][b], w2); e[3][b] = cmul(e[3][b], w3); }
            { const f32x2 w2 = cmul(wb, wb), w3 = cmul(w2, wb);
#pragma unroll
              for (int a = 0; a < 4; ++a) { bfly_fwd(e[a][0], e[a][1], e[a][2], e[a][3]); e[a][1] = cmul(e[a][1], wb); e[a][2] = cmul(e[a][2], w2); e[a][3] = cmul(e[a][3], w3); } }
#pragma unroll
            for (int a = 0; a < 4; ++a)
#pragma unroll
                for (int b = 0; b < 4; ++b) buf[bo + PADI(base + b * q16 + a * q4)] = e[a][b];
        }
        __syncthreads();
    }
#pragma unroll 1
    for (int pass = 2 * NP16; pass < NLEV; ++pass) {
        const int lq = 2 * (LOG4 - pass) - 2, q4 = 1 << lq, n = q4 << 2, tstep = TWS << (2 * pass);
        constexpr int IT = BATCH * N / 4 / NT;
        f32x2 wl[IT];
#pragma unroll
        for (int i = 0; i < IT; ++i) wl[i] = tw[((tid + i * NT) & (q4 - 1)) * tstep];
#pragma unroll
        for (int i = 0; i < IT; ++i) { const int jg = tid + i * NT, bo = (jg >> (2 * LOG4 - 2)) * NPAD, j = jg & (N / 4 - 1);
            const int blk = j >> lq, jj = j & (q4 - 1), base = blk * n + jj;
            const int i0 = bo + PADI(base), i1 = bo + PADI(base + q4), i2 = bo + PADI(base + 2 * q4), i3 = bo + PADI(base + 3 * q4);
            const f32x2 w1 = wl[i];
            f32x2 a0 = buf[i0], a1 = buf[i1], a2 = buf[i2], a3 = buf[i3];
            bfly_fwd(a0, a1, a2, a3);
            const f32x2 w2 = cmul(w1, w1), w3 = cmul(w2, w1);
            buf[i0] = a0; buf[i1] = cmul(a1, w1); buf[i2] = cmul(a2, w2); buf[i3] = cmul(a3, w3);
        }
        __syncthreads();
    }
#pragma unroll 1
    for (int b = tid; b < BATCH * N / 16; b += NT) {
        LAS f32x2* xb = buf + 17 * b; f32x2 x[16];
#pragma unroll
        for (int e = 0; e < 16; ++e) x[e] = xb[e];
#pragma unroll
        for (int jj = 0; jj < 4; ++jj) { bfly_fwd(x[jj], x[jj + 4], x[jj + 8], x[jj + 12]); if (jj) { x[jj + 4] = cmul(x[jj + 4], w16(jj)); x[jj + 8] = cmul(x[jj + 8], w16(2 * jj)); x[jj + 12] = cmul(x[jj + 12], w16(3 * jj)); } }
#pragma unroll
        for (int q = 0; q < 4; ++q) bfly_fwd(x[4 * q], x[4 * q + 1], x[4 * q + 2], x[4 * q + 3]);
#pragma unroll
        for (int e = 0; e < 16; ++e) xb[e] = x[e];
    }
    __syncthreads();
}
template <int LOG4, int BATCH = 1> __device__ __forceinline__ void fft_inv(LAS f32x2* buf, const f32x2* __restrict__ tw, int tid) {
    constexpr int N = 1 << (2 * LOG4), TWS = 16384 / N;
#pragma unroll 1
    for (int b = tid; b < BATCH * N / 16; b += NT) {
        LAS f32x2* xb = buf + 17 * b; f32x2 x[16];
#pragma unroll
        for (int e = 0; e < 16; ++e) x[e] = xb[e];
#pragma unroll
        for (int q = 0; q < 4; ++q) bfly_inv(x[4 * q], x[4 * q + 1], x[4 * q + 2], x[4 * q + 3]);
#pragma unroll
        for (int jj = 0; jj < 4; ++jj) { if (jj) { x[jj + 4] = cmulc(x[jj + 4], w16(jj)); x[jj + 8] = cmulc(x[jj + 8], w16(2 * jj)); x[jj + 12] = cmulc(x[jj + 12], w16(3 * jj)); } bfly_inv(x[jj], x[jj + 4], x[jj + 8], x[jj + 12]); }
#pragma unroll
        for (int e = 0; e < 16; ++e) xb[e] = x[e];
    }
    __syncthreads();
    constexpr int NPAD = N + N / 16, NLEV = LOG4 - 2, NP16 = NLEV / 2;
#pragma unroll 1
    for (int pass = NLEV - 1; pass >= 2 * NP16; --pass) {
        const int lq = 2 * (LOG4 - pass) - 2, q4 = 1 << lq, n = q4 << 2, tstep = TWS << (2 * pass);
        constexpr int IT = BATCH * N / 4 / NT;
        f32x2 wl[IT];
#pragma unroll
        for (int i = 0; i < IT; ++i) wl[i] = tw[((tid + i * NT) & (q4 - 1)) * tstep];
#pragma unroll
        for (int i = 0; i < IT; ++i) { const int jg = tid + i * NT, bo = (jg >> (2 * LOG4 - 2)) * NPAD, j = jg & (N / 4 - 1);
            const int blk = j >> lq, jj = j & (q4 - 1), base = blk * n + jj;
            const int i0 = bo + PADI(base), i1 = bo + PADI(base + q4), i2 = bo + PADI(base + 2 * q4), i3 = bo + PADI(base + 3 * q4);
            const f32x2 w1 = wl[i];
            const f32x2 w2 = cmul(w1, w1), w3 = cmul(w2, w1);
            f32x2 b0 = buf[i0], b1 = cmulc(buf[i1], w1), b2 = cmulc(buf[i2], w2), b3 = cmulc(buf[i3], w3);
            bfly_inv(b0, b1, b2, b3);
            buf[i0] = b0; buf[i1] = b1; buf[i2] = b2; buf[i3] = b3;
        }
        __syncthreads();
    }
#pragma unroll 1
    for (int ps = NP16 - 1; ps >= 0; --ps) {
        const int lq4 = 2 * (LOG4 - 2 * ps) - 2, lq16 = lq4 - 2, q4 = 1 << lq4, q16 = 1 << lq16, tsA = TWS << (4 * ps), tsB = tsA << 2;
        constexpr int TOT = BATCH * N / 16, IT = (TOT + NT - 1) / NT;
#pragma unroll
        for (int i = 0; i < IT; ++i) { const int jg = tid + i * NT; if (TOT % NT != 0 && jg >= TOT) break; const int bo = (jg >> (2 * LOG4 - 4)) * NPAD, j = jg & (N / 16 - 1);
            const int blk = j >> lq16, jj = j & (q16 - 1), base = (blk << (lq4 + 2)) + jj;
            f32x2 wa[4], wb = tw[jj * tsB];
#pragma unroll
            for (int b = 0; b < 4; ++b) wa[b] = tw[(jj + b * q16) * tsA];
            f32x2 e[4][4];
#pragma unroll
            for (int a = 0; a < 4; ++a)
#pragma unroll
                for (int b = 0; b < 4; ++b) e[a][b] = buf[bo + PADI(base + b * q16 + a * q4)];
            { const f32x2 w2 = cmul(wb, wb), w3 = cmul(w2, wb);
#pragma unroll
              for (int a = 0; a < 4; ++a) { e[a][1] = cmulc(e[a][1], wb); e[a][2] = cmulc(e[a][2], w2); e[a][3] = cmulc(e[a][3], w3); bfly_inv(e[a][0], e[a][1], e[a][2], e[a][3]); } }
#pragma unroll
            for (int b = 0; b < 4; ++b) { const f32x2 w2 = cmul(wa[b], wa[b]), w3 = cmul(w2, wa[b]); e[1][b] = cmulc(e[1][b], wa[b]); e[2][b] = cmulc(e[2][b], w2); e[3][b] = cmulc(e[3][b], w3); bfly_inv(e[0][b], e[1][b], e[2][b], e[3][b]); }
#pragma unroll
            for (int a = 0; a < 4; ++a)
#pragma unroll
                for (int b = 0; b < 4; ++b) buf[bo + PADI(base + b * q16 + a * q4)] = e[a][b];
        }
        __syncthreads();
    }
}
__device__ const double ROPE_IF[16] = {1.0, 0.5623413251903491, 0.31622776601683794, 0.1778279410038923, 0.1, 0.05623413251903491, 0.03162277660168379, 0.01778279410038923,
    0.01, 0.005623413251903491, 0.0031622776601683794, 0.0017782794100389228, 0.001, 0.0005623413251903491, 0.00031622776601683794, 0.00017782794100389227};
struct Chunk { int tok0, L, nseq; };
__device__ __forceinline__ Chunk chunk_of(int c) { Chunk k; k.tok0 = c * CH; if (c < NCH_P) { k.L = LP; k.nseq = CH / LP; } else { k.L = LS; k.nseq = CH / LS; } return k; }
__device__ __forceinline__ const float* xin_rows(const AV& a, int tok0) { return tok0 < NTOK_P ? AIN(I_XP) + (size_t)tok0 * DM : AIN(I_XS) + (size_t)(tok0 - NTOK_P) * DM; }
__device__ __forceinline__ void hf_group(LAS float* sm, const AV& a, int layer, int L, int t0, float* hf, int tid) {
    LAS float* zs = sm; LAS float* A = sm + 512; LAS float* B = sm + 1024;
    const float* w1 = AIN(I_FW1) + layer * 33 * 64; const float* b1 = AIN(I_FB1) + layer * 64;
    const float* w2 = AIN(I_FW2) + layer * 2 * 64 * 64; const float* b2 = AIN(I_FB2) + layer * 2 * 64;
    const float* wo = AIN(I_FWOUT) + layer * 64 * 1024; const float* fr = AIN(I_FFREQ) + layer * 64;
    const int tt = tid >> 6, j = tid & 63, t = t0 + tt;
    const float t01 = (float)t / (float)(L - 1);
    if (j < 33) {
        float v;
        if (j == 0) v = t01;
        else { const int k = (j - 1) & 15; const double f = kd(1e-4) + (double)k * kd((15.0 - 1e-4) / 15.0); float s, c; sincos_rev(f * (double)t / (double)L, s, c); v = (j <= 16) ? c : -s; }
        zs[tt * 40 + j] = v;
    }
    __syncthreads();
    const float fq = fr[j];
    { float acc = b1[j]; for (int i = 0; i < 33; ++i) acc += zs[tt * 40 + i] * w1[i * 64 + j]; A[tt * 64 + j] = sin_acc(fq * acc); }
    __syncthreads();
    { float acc = b2[j]; for (int i = 0; i < 64; ++i) acc += A[tt * 64 + i] * w2[i * 64 + j]; B[tt * 64 + j] = sin_acc(fq * acc); }
    __syncthreads();
    { float acc = b2[64 + j]; for (int i = 0; i < 64; ++i) acc += B[tt * 64 + i] * w2[4096 + i * 64 + j]; A[tt * 64 + j] = sin_acc(fq * acc); }
    __syncthreads();
    { float acc0[8], acc1[8];
#pragma unroll
      for (int q = 0; q < 8; ++q) { acc0[q] = 0.f; acc1[q] = 0.f; }
#pragma unroll 8
      for (int i = 0; i < 64; ++i) { const float wa = wo[i * 1024 + tid], wb = wo[i * 1024 + 512 + tid];
#pragma unroll
          for (int q = 0; q < 8; ++q) { const float av = A[q * 64 + i]; acc0[q] += av * wa; acc1[q] += av * wb; } }
      const float ad = 3.070113457325394f + (float)tid * ((15.350567286626973f - 3.070113457325394f) / 511.0f);
#pragma unroll
      for (int q = 0; q < 8; ++q) { const float tq = (float)(t0 + q) / (float)(L - 1); const float win = __expf(-tq * ad);
          hf[(size_t)(t0 + q) * 1024 + tid] = acc0[q] * win; hf[(size_t)(t0 + q) * 1024 + 512 + tid] = acc1[q] * win; } }
    __syncthreads();
}
__device__ __forceinline__ void step_pro_a(const AV& a, LAS unsigned char* lds) {
    const int tid = ltid(), lane = tid & 63, wave = tid >> 6, G = gridDim.x;
    unsigned char* ws = AWS;
    { f32x2* tw = (f32x2*)(ws + WS_TW); for (int m = lbid() * NT + tid; m < 16384; m += G * NT) { float s, c; sincos_rev((double)m / 16384.0, s, c); tw[m] = (f32x2){c, -s}; } }
    { f32x2* rt = (f32x2*)(ws + WS_ROPE);
      for (int e = lbid() * NT + tid; e < 8192 * 32; e += G * NT) { const int pos = e >> 5, i = e & 31; const int pp = (i < 16) ? (pos >> 6) : (pos & 63);
          const double inv = ROPE_IF[i & 15]; float sn, cs; sincos_rev((double)pp * inv * 0.15915494309189533577, sn, cs); rt[e] = (f32x2){cs, sn}; } }
    { const float* g = AIN(I_NORMG); bf16* HN0 = (bf16*)(ws + WS_HN0); f32x4 gv[4];
#pragma unroll
      for (int j = 0; j < 4; ++j) gv[j] = *((const f32x4*)g + lane + 64 * j);
      for (int m = lbid() * NWAVES + wave; m < NTOK; m += G * NWAVES) {
          const f32x4* xr = (const f32x4*)(xin_rows(a, m)) + lane; f32x4 v[4]; float ssum = 0.f;
#pragma unroll
          for (int j = 0; j < 4; ++j) { v[j] = xr[64 * j]; ssum += (v[j].x * v[j].x + v[j].y * v[j].y) + (v[j].z * v[j].z + v[j].w * v[j].w); }
          const float rs = 1.0f / sqrtf(wave_sum(ssum) * (1.0f / DM) + EPS);
          u32x2* o8 = (u32x2*)(HN0 + (size_t)m * DM) + lane;
#pragma unroll
          for (int j = 0; j < 4; ++j) { u32x2 w; w.x = pk2(v[j].x * rs * gv[j].x, v[j].y * rs * gv[j].y); w.y = pk2(v[j].z * rs * gv[j].z, v[j].w * rs * gv[j].w); o8[64 * j] = w; } } }
    { LAS float* scr = (LAS float*)(lds + wave * 16384);
      constexpr int I_IN = 16 * (UP / 32), I_MG = 16 * (GP / 32), I_BR = 8 * 32, I_OU = 16 * 32, PER = I_IN + I_MG + 3 * I_BR + I_OU;
      for (int it = lbid() * NWAVES + wave; it < 2 * PER; it += G * NWAVES) {
          const int l = it / PER; int r = it - l * PER;
          bf16* wcat = (bf16*)(ws + WS_WCAT + l * WCAT_BYTES); bf16* wbt = (bf16*)(ws + WS_WBT + l * WBT_BYTES); bf16* wot = (bf16*)(ws + WS_WOT + l * WOT_BYTES);
          if (r < I_IN) { transpose_item(AIN(I_WIN) + (size_t)l * 1024 * UP, 1024, UP, wcat, 0, scr, r, lane); continue; } r -= I_IN;
          if (r < I_MG) { transpose_item(AIN(I_WMERGE) + (size_t)l * 1024 * GP, 1024, GP, wcat, UP, scr, r, lane); continue; } r -= I_MG;
          if (r < I_BR) { transpose_item(AIN(I_WBHY) + (size_t)l * 512 * 1024, 512, 1024, wbt, 0, scr, r, lane); continue; } r -= I_BR;
          if (r < I_BR) { transpose_item(AIN(I_WBGQ) + (size_t)l * 512 * 1024, 512, 1024, wbt, 1024, scr, r, lane); continue; } r -= I_BR;
          if (r < I_BR) { transpose_item(AIN(I_WBDF) + (size_t)l * 512 * 1024, 512, 1024, wbt, 2048, scr, r, lane); continue; } r -= I_BR;
          transpose_item(AIN(I_WOUT) + (size_t)l * 1024 * 1024, 1024, 1024, wot, 0, scr, r, lane);
      } }
}
__device__ __forceinline__ void step_pro_a2(const AV& a, LAS unsigned char* lds) {
    const int tid = ltid(), G = gridDim.x; unsigned char* ws = AWS;
    { constexpr int GPL = LP / 8 + LS / 8;
      for (int g = lbid(); g < 2 * GPL; g += G) { const int l = g / GPL; int r = g - l * GPL;
          float* hfp = (float*)(ws + WS_U + l * (HF_P_BYTES + HF_S_BYTES));
          if (r < LP / 8) hf_group((LAS float*)lds, a, l, LP, r * 8, hfp, tid);
          else hf_group((LAS float*)lds, a, l, LS, (r - LP / 8) * 8, (float*)((unsigned char*)hfp + HF_P_BYTES), tid); } }
}
template <int LOG4> __device__ __forceinline__ void filt_unit(const AV& a, LAS unsigned char* lds, int layer, int pr, const float* hf, f32x2* Pg, f32x2* Mg) {
    constexpr int N = 1 << (2 * LOG4), L = N / 2;
    const int tid = ltid(); LAS f32x2* buf = (LAS f32x2*)lds; const int c0 = 2 * pr;
    for (int n = tid; n < N; n += NT) { f32x2 v = (f32x2){0.f, 0.f};
        if (n < L) v = *(const f32x2*)(hf + (size_t)n * 1024 + c0); else if (n > L) v = *(const f32x2*)(hf + (size_t)(N - n) * 1024 + 512 + c0);
        buf[PADI(n)] = v; }
    __syncthreads();
    fft_fwd<LOG4>(buf, (const f32x2*)(AWS + WS_TW), tid);
    const float ba = AIN(I_HYBIAS)[layer * 512 + c0], bb = AIN(I_HYBIAS)[layer * 512 + c0 + 1]; const float sc = 1.0f / (float)N;
    for (int k = tid; k <= L; k += NT) { const int q1 = digitrev<LOG4>(k), q2 = digitrev<LOG4>((N - k) & (N - 1)); const f32x2 z1 = buf[PADI(q1)], z2 = buf[PADI(q2)];
        f32x2 ca = (f32x2){0.5f * (z1.x + z2.x), 0.5f * (z1.y - z2.y)}; const float dx = z1.x - z2.x, dy = z1.y + z2.y; f32x2 cb = (f32x2){0.5f * dy, -0.5f * dx};
        ca.x += ba; cb.x += bb;
        Pg[k] = (f32x2){0.5f * sc * (ca.x + cb.x), 0.5f * sc * (ca.y + cb.y)}; Mg[k] = (f32x2){0.5f * sc * (ca.x - cb.x), 0.5f * sc * (ca.y - cb.y)}; }
    __syncthreads();
}
__device__ __forceinline__ void step_pro_b(const AV& a, LAS unsigned char* lds) {
    for (int u = lbid(); u < 1024; u += gridDim.x) { const int l = u >> 9, r = u & 511; unsigned char* sp = AWS + WS_SPEC + l * SPEC_LAYER; const float* hfp = (const float*)(AWS + WS_U + l * (HF_P_BYTES + HF_S_BYTES));
        if (r < 256) filt_unit<7>(a, lds, l, r, hfp, (f32x2*)sp + (size_t)r * SPS_P, (f32x2*)(sp + SPEC_P_BYTES) + (size_t)r * SPS_P);
        else { const int pr = r - 256; filt_unit<6>(a, lds, l, pr, (const float*)((const unsigned char*)hfp + HF_P_BYTES), (f32x2*)(sp + 2 * SPEC_P_BYTES) + (size_t)pr * SPS_S, (f32x2*)(sp + 2 * SPEC_P_BYTES + SPEC_S_BYTES) + (size_t)pr * SPS_S); } }
}
__device__ __forceinline__ void step_norm(const AV& a, int c, int layer) {
    const int tid = ltid(), lane = tid & 63, wave = tid >> 6; const Chunk ck = chunk_of(c);
    const float* X = layer == 0 ? xin_rows(a, ck.tok0) : AOUT + (size_t)ck.tok0 * DM; bf16* HN = (bf16*)(AWS + WS_HN); const float* g = AIN(I_NORMG) + layer * DM;
    f32x4 gv[4];
#pragma unroll
    for (int j = 0; j < 4; ++j) gv[j] = *((const f32x4*)g + lane + 64 * j);
    for (int m = lbid() * NWAVES + wave; m < CH; m += gridDim.x * NWAVES) {
        const f32x4* xr = (const f32x4*)(X + (size_t)m * DM) + lane; f32x4 v[4]; float s = 0.f;
#pragma unroll
        for (int j = 0; j < 4; ++j) { v[j] = xr[64 * j]; s += (v[j].x * v[j].x + v[j].y * v[j].y) + (v[j].z * v[j].z + v[j].w * v[j].w); }
        const float rs = 1.0f / sqrtf(wave_sum(s) * (1.0f / DM) + EPS);
        u32x2* o8 = (u32x2*)(HN + (size_t)m * DM) + lane;
#pragma unroll
        for (int j = 0; j < 4; ++j) { u32x2 w; w.x = pk2(v[j].x * rs * gv[j].x, v[j].y * rs * gv[j].y); w.y = pk2(v[j].z * rs * gv[j].z, v[j].w * rs * gv[j].w); o8[64 * j] = w; }
    }
}
__device__ __forceinline__ void step_final(const AV& a, int row0, int row1) {
    const int tid = ltid(), lane = tid & 63, wave = tid >> 6; const float* g = AIN(I_FINALG);
    f32x4 gv[4];
#pragma unroll
    for (int j = 0; j < 4; ++j) gv[j] = *((const f32x4*)g + lane + 64 * j);
    for (int m = row0 + lbid() * NWAVES + wave; m < row1; m += gridDim.x * NWAVES) {
        f32x4* xr = (f32x4*)(AOUT + (size_t)m * DM) + lane; f32x4 v[4]; float s = 0.f;
#pragma unroll
        for (int j = 0; j < 4; ++j) { v[j] = xr[64 * j]; s += (v[j].x * v[j].x + v[j].y * v[j].y) + (v[j].z * v[j].z + v[j].w * v[j].w); }
        const float rs = 1.0f / sqrtf(wave_sum(s) * (1.0f / DM) + EPS);
#pragma unroll
        for (int j = 0; j < 4; ++j) xr[64 * j] = v[j] * rs * gv[j];
    }
}
__device__ __forceinline__ void step_prep(const AV& a, int c, int layer) {
    const Chunk ck = chunk_of(c); bf16* U = (bf16*)(AWS + WS_U);
    for (int it = lbid() * NT + ltid(); it < CH * 10; it += gridDim.x * NT) {
        const int tok = it / 10, hd = it - tok * 10; const int pos = tok & (ck.L - 1);
        bf16* p = U + (size_t)tok * UP + (hd < 8 ? C_GQ + 64 * hd : C_GK + 64 * (hd - 8));
        const float* g = (hd < 8 ? AIN(I_QNG) : AIN(I_KNG)) + layer * 64;
        float x[64];
#pragma unroll
        for (int i = 0; i < 8; ++i) { const u32x4 w = *((const u32x4*)p + i);
            x[8 * i + 0] = bflo(w.x); x[8 * i + 1] = bfhi(w.x); x[8 * i + 2] = bflo(w.y); x[8 * i + 3] = bfhi(w.y); x[8 * i + 4] = bflo(w.z); x[8 * i + 5] = bfhi(w.z); x[8 * i + 6] = bflo(w.w); x[8 * i + 7] = bfhi(w.w); }
        float ss = 0.f;
#pragma unroll
        for (int i = 0; i < 64; ++i) ss += x[i] * x[i];
        const float rs = (1.0f / sqrtf(ss * (1.0f / 64.0f) + EPS)) * (hd < 8 ? 0.125f * LOG2E : 1.0f);
#pragma unroll
        for (int i = 0; i < 64; ++i) x[i] = x[i] * rs * g[i];
        const f32x4* rt = (const f32x4*)(AWS + WS_ROPE) + (size_t)pos * 16;
#pragma unroll
        for (int i2 = 0; i2 < 16; ++i2) { const f32x4 cs2 = rt[i2];
#pragma unroll
            for (int e = 0; e < 2; ++e) { const int i = 2 * i2 + e; const float cs = e ? cs2.z : cs2.x, sn = e ? cs2.w : cs2.y; const float x1 = x[i], x2 = x[i + 32]; x[i] = x1 * cs - x2 * sn; x[i + 32] = x2 * cs + x1 * sn; } }
#pragma unroll
        for (int i = 0; i < 8; ++i) { u32x4 w; w.x = pk2(x[8 * i], x[8 * i + 1]); w.y = pk2(x[8 * i + 2], x[8 * i + 3]); w.z = pk2(x[8 * i + 4], x[8 * i + 5]); w.w = pk2(x[8 * i + 6], x[8 * i + 7]); *((u32x4*)p + i) = w; }
    }
}
__device__ __forceinline__ void step_prep_hy(const AV& a, LAS unsigned char* lds, int c, int layer) {
    const Chunk ck = chunk_of(c); const bf16* U = (const bf16*)(AWS + WS_U);
    f32x2* HVP = (f32x2*)(AWS + WS_HVP); f32x2* PMP = (f32x2*)(AWS + WS_PMP);
    const int tid = ltid(), lane = tid & 63, wave = tid >> 6;
    LAS f32x2* th = (LAS f32x2*)(lds + wave * 17408); LAS f32x2* tp = th + 64 * 17;
    const float* cw = AIN(I_CONVW) + layer * 3 * 1536; const float* cb = AIN(I_CONVB) + layer * 1536;
    for (int it = lbid() * NWAVES + wave; it < (CH / 16) * 4; it += gridDim.x * NWAVES) {
        const int cbk = it & 3, tg = it >> 2, t0 = tg * 16, ch = cbk * 128 + 2 * lane;
        const int pos0 = t0 & (ck.L - 1);
        float w[3][3][2], bb[3][2];
#pragma unroll
        for (int ar = 0; ar < 3; ++ar) {
#pragma unroll
            for (int j = 0; j < 3; ++j) { const f32x2 v = *(const f32x2*)(cw + j * 1536 + ar * 512 + ch); w[ar][j][0] = v.x; w[ar][j][1] = v.y; }
            const f32x2 v = *(const f32x2*)(cb + ar * 512 + ch); bb[ar][0] = v.x; bb[ar][1] = v.y; }
        const bf16* r0 = U + (size_t)t0 * UP + ch;
        unsigned pv[3], cv[3], nv[3];
#pragma unroll
        for (int ar = 0; ar < 3; ++ar) { pv[ar] = pos0 > 0 ? *(const unsigned*)(r0 - UP + ar * 512) : 0u; cv[ar] = *(const unsigned*)(r0 + ar * 512); }
#pragma unroll 4
        for (int t = 0; t < 16; ++t) {
            const bf16* rt = r0 + (size_t)t * UP; const bool last = (pos0 + t + 1 >= ck.L);
#pragma unroll
            for (int ar = 0; ar < 3; ++ar) nv[ar] = last ? 0u : *(const unsigned*)(rt + UP + ar * 512);
            const unsigned gw = *(const unsigned*)(rt + C_HG);
            float o[3][2];
#pragma unroll
            for (int ar = 0; ar < 3; ++ar) { o[ar][0] = w[ar][0][0] * bflo(pv[ar]) + w[ar][1][0] * bflo(cv[ar]) + w[ar][2][0] * bflo(nv[ar]) + bb[ar][0];
                o[ar][1] = w[ar][0][1] * bfhi(pv[ar]) + w[ar][1][1] * bfhi(cv[ar]) + w[ar][2][1] * bfhi(nv[ar]) + bb[ar][1]; pv[ar] = cv[ar]; cv[ar] = nv[ar]; }
            th[lane * 17 + t] = (f32x2){o[2][0] * o[1][0], o[2][1] * o[1][1]};
            tp[lane * 17 + t] = (f32x2){o[0][0] * silu(bflo(gw)), o[0][1] * silu(bfhi(gw))};
        }
        asm volatile("s_waitcnt lgkmcnt(0)" ::: "memory");
#pragma unroll 4
        for (int i = 0; i < 16; ++i) { const int pl = 4 * i + (lane >> 4), tt = lane & 15; const size_t o = (size_t)(cbk * 64 + pl) * CH + t0 + tt;
            HVP[o] = th[pl * 17 + tt]; PMP[o] = tp[pl * 17 + tt]; }
        asm volatile("s_waitcnt lgkmcnt(0)" ::: "memory");
    }
}
typedef short bf16x8 __attribute__((ext_vector_type(8)));
typedef short s16x4 __attribute__((ext_vector_type(4)));
typedef float f32x16 __attribute__((ext_vector_type(16)));
typedef float f32x2_t __attribute__((ext_vector_type(2)));
typedef __bf16 bf16x2_t __attribute__((ext_vector_type(2)));
__device__ __forceinline__ unsigned cvtpk(float lo, float hi) { f32x2_t v = {lo, hi}; bf16x2_t b = __builtin_convertvector(v, bf16x2_t); return __builtin_bit_cast(unsigned, b); }
__device__ __forceinline__ int crow(int r, int hi) { return (r & 3) + 8 * (r >> 2) + 4 * hi; }
__device__ __forceinline__ s16x4 vtr(const LAS unsigned char* p) { return __builtin_bit_cast(s16x4, __builtin_amdgcn_ds_read_tr16_b64_v4i16((LAS s16x4*)p)); }
constexpr int ATT_K = 0;
constexpr int ATT_TB_DIFF = 4 * 8192 + 4 * 16384;
constexpr float C1 = 0.125f * LOG2E;
__device__ __forceinline__ void glds16(const void* gsrc, unsigned lds_dst) { unsigned keep;
    asm volatile("s_mov_b32 %0, m0\n\ts_mov_b32 m0, %2\n\ts_nop 0\n\tglobal_load_lds_dwordx4 %1, off\n\ts_mov_b32 m0, %0" : "=&s"(keep) : "v"(gsrc), "s"(lds_dst) : "memory"); }

template <int VD, bool BIAS, bool OMAX, int G>
__device__ __forceinline__ void flash_pass(LAS unsigned char* lds, const bf16* Qrow, const bf16* Kg, const bf16* Vg, int L, int qpos, int qw0, float bl, float br, f32x16 (&o)[VD / 32], float& l_out) {
    const int tid = ltid(), lane = tid & 63, r32 = lane & 31, hi = lane >> 5;
    constexpr int VROW = VD * 2, VT = 64 * VROW, NVL = VD / 64, NSL = 2 * G, ATT_V = NSL * 8192, ATT_TB = ATT_V + NSL * VT;
    const LAS float* tb = (const LAS float*)(lds + ATT_TB);
    typedef const __attribute__((address_space(1))) u32x4* g4p;
    const int wv = __builtin_amdgcn_readfirstlane(tid >> 6); const int ldsa = (int)(unsigned)(uintptr_t)lds;
    const bf16* ksrc; { const int X = wv * 1024 + lane * 16, line = X >> 8, c16 = ((X >> 4) & 15) ^ (line & 15), key = 2 * line + (c16 >> 3), ch = c16 & 7; ksrc = Kg + (size_t)key * UP + ch * 8; }
    const bf16* vsrc[NVL];
#pragma unroll
    for (int i = 0; i < NVL; ++i) { const int X = i * 8192 + wv * 1024 + lane * 16; const int key = (VD == 64) ? (X >> 7) : (X >> 8), posb = (VD == 64) ? (X & 127) : (X & 255);
        const int swz = (VD == 64) ? (((key >> 1) & 1) << 6) : ((key & 3) << 6); vsrc[i] = Vg + (size_t)key * UP + ((posb ^ swz) >> 1); }
#define ATT_DMA(tt_, sl_) do { const size_t go_ = (size_t)(tt_) * 64 * UP; \
        glds16(ksrc + go_, (unsigned)__builtin_amdgcn_readfirstlane(ldsa + ATT_K + (sl_) * 8192 + wv * 1024)); \
        _Pragma("unroll") for (int i_ = 0; i_ < NVL; ++i_) glds16(vsrc[i_] + go_, (unsigned)__builtin_amdgcn_readfirstlane(ldsa + ATT_V + (sl_) * VT + i_ * 8192 + wv * 1024)); } while (0)
#define ATT_DMAGROUP(g_) do { _Pragma("unroll") for (int j_ = 0; j_ < G; ++j_) { const int tt_ = (g_) * G + j_; ATT_DMA(tt_, tt_ & (NSL - 1)); } } while (0)
#define ATT_BAR() do { __builtin_amdgcn_s_barrier(); asm volatile("" ::: "memory"); } while (0)
    int koff[2][4];
#pragma unroll
    for (int kb = 0; kb < 2; ++kb)
#pragma unroll
        for (int s = 0; s < 4; ++s) { const int key = 32 * kb + r32, line = key >> 1, c16 = ((key & 1) << 3) | (2 * s + hi); koff[kb][s] = line * 256 + ((c16 ^ (line & 15)) << 4); }
    const int q4 = (lane & 15) >> 2, p4 = lane & 3, g1 = (lane >> 4) & 1;
    const int vsw = (VD == 64) ? ((q4 >> 1) & 1) : q4;
    const int vbase = (4 * hi + q4) * VROW + 32 * g1 + 8 * p4;
    bf16x8 qf[4];
#pragma unroll
    for (int s = 0; s < 4; ++s) qf[s] = __builtin_bit_cast(bf16x8, *(g4p)(Qrow + 16 * s + 8 * hi));
    float m_run = OMAX ? -1e30f : 0.f, l_run = 0.f;
    const int nt = L >> 6;
    asm volatile("" :: "v"(qf[0]), "v"(qf[1]), "v"(qf[2]), "v"(qf[3]) : "memory");
    asm volatile("s_waitcnt vmcnt(0)" ::: "memory");
    const int ng = nt / G;
    ATT_DMAGROUP(0); if (ng > 1) ATT_DMAGROUP(1);
    if (ng > 1) { if (G * (1 + NVL) == 8) asm volatile("s_waitcnt vmcnt(8)" ::: "memory"); else asm volatile("s_waitcnt vmcnt(6)" ::: "memory"); } else asm volatile("s_waitcnt vmcnt(0)" ::: "memory");
    static_assert(G * (1 + NVL) == 8 || G * (1 + NVL) == 6, "vmcnt immediates above");
    ATT_BAR();
#pragma unroll 1
    for (int t = 0; t < nt; ++t) {
        const int cur = t & (NSL - 1);
        const LAS unsigned char* kbuf = lds + ATT_K + cur * 8192; const LAS unsigned char* vbuf = lds + ATT_V + cur * VT;
        f32x16 p[2];
        { bf16x8 kf[2][4];
#pragma unroll
          for (int kb = 0; kb < 2; ++kb)
#pragma unroll
            for (int s = 0; s < 4; ++s) kf[kb][s] = *(const LAS bf16x8*)(kbuf + koff[kb][s]);
          __builtin_amdgcn_sched_barrier(0);
#pragma unroll
          for (int kb = 0; kb < 2; ++kb) { f32x16 acc;
#pragma unroll
            for (int r = 0; r < 16; ++r) acc[r] = 0.f;
#pragma unroll
            for (int s = 0; s < 4; ++s) acc = __builtin_amdgcn_mfma_f32_32x32x16_bf16(kf[kb][s], qf[s], acc, 0, 0, 0);
            p[kb] = acc; } }
        s16x4 vlo[2][4], vhi[2][4];
#define VREAD(buf_, db_) do { const int cofs_ = (((db_) ^ vsw) << 6); _Pragma("unroll") for (int kb = 0; kb < 2; ++kb) _Pragma("unroll") for (int ss = 0; ss < 2; ++ss) { \
            const LAS unsigned char* vp_ = vbuf + vbase + (32 * kb + 16 * ss) * VROW + cofs_; vlo[buf_][2 * kb + ss] = vtr(vp_); vhi[buf_][2 * kb + ss] = vtr(vp_ + 8 * VROW); } } while (0)
        VREAD(0, 0);
        __builtin_amdgcn_sched_barrier(0);
        const int k0 = t * 64; float mulc, bconst, mx = -3e38f; bool nearT = false;
        const bool domax = (t & 7) == 0;
        if (BIAS) { const int rlo = k0 - qw0 - 31, rhi = k0 + 63 - qw0; nearT = !(rhi <= -128 || rlo >= 128); }
        if (BIAS && nearT) {
#pragma unroll
            for (int kb = 0; kb < 2; ++kb)
#pragma unroll
                for (int r4 = 0; r4 < 4; ++r4) {
#pragma unroll
                    for (int e = 0; e < 4; ++e) { const int r = 4 * r4 + e; int rel = k0 + 32 * kb + crow(r, hi) - qpos; rel = rel < -128 ? -128 : (rel > 128 ? 128 : rel); const float v = p[kb][r] * C1 + tb[rel + 128]; p[kb][r] = v; mx = fmaxf(mx, v); }
                    __builtin_amdgcn_sched_barrier(0); }
            mulc = 1.0f; bconst = 0.f;
        } else {
            if (OMAX && domax) {
#pragma unroll
                for (int kb = 0; kb < 2; ++kb)
#pragma unroll
                    for (int r = 0; r < 16; ++r) mx = fmaxf(mx, p[kb][r]); }
            bconst = BIAS ? (k0 < qw0 ? bl : br) : 0.f; mx = mx * C1 + bconst; mulc = C1;
        }
        if (OMAX && (domax || (BIAS && nearT))) {
            mx = fmaxf(mx, shx(mx, 32));
            if (__any(mx > m_run)) { const float mn = fmaxf(m_run, mx), al = __builtin_amdgcn_exp2f(m_run - mn); l_run *= al;
#pragma unroll
                for (int db = 0; db < VD / 32; ++db) o[db] *= al;
                m_run = mn; }
        }
        const f32x2 mul2 = (f32x2){mulc, mulc}, add2 = (f32x2){bconst - m_run, bconst - m_run}; f32x2 ls2 = (f32x2){0.f, 0.f};
#pragma unroll
        for (int kb = 0; kb < 2; ++kb)
#pragma unroll
            for (int r = 0; r < 16; r += 2) { f32x2 v = (f32x2){p[kb][r], p[kb][r + 1]}; v = v * mul2 + add2; f32x2 e; e.x = __builtin_amdgcn_exp2f(v.x); e.y = __builtin_amdgcn_exp2f(v.y); ls2 += e; p[kb][r] = e.x; p[kb][r + 1] = e.y; }
        l_run += ls2.x + ls2.y;
        bf16x8 pk[2][2];
#pragma unroll
        for (int kb = 0; kb < 2; ++kb)
#pragma unroll
            for (int ss = 0; ss < 2; ++ss) { u32x4 w; w.x = cvtpk(p[kb][8 * ss + 0], p[kb][8 * ss + 1]); w.y = cvtpk(p[kb][8 * ss + 2], p[kb][8 * ss + 3]); w.z = cvtpk(p[kb][8 * ss + 4], p[kb][8 * ss + 5]); w.w = cvtpk(p[kb][8 * ss + 6], p[kb][8 * ss + 7]);
                pk[kb][ss] = __builtin_bit_cast(bf16x8, w); }
        __builtin_amdgcn_sched_barrier(0);
#pragma unroll
        for (int db = 0; db < VD / 32; ++db) {
            if (db + 1 < VD / 32) { if ((db + 1) & 1) VREAD(1, db + 1); else VREAD(0, db + 1); }
#pragma unroll
            for (int kb = 0; kb < 2; ++kb)
#pragma unroll
                for (int ss = 0; ss < 2; ++ss) { const bf16x8 vf = (db & 1) ? __builtin_shufflevector(vlo[1][2 * kb + ss], vhi[1][2 * kb + ss], 0, 1, 2, 3, 4, 5, 6, 7) : __builtin_shufflevector(vlo[0][2 * kb + ss], vhi[0][2 * kb + ss], 0, 1, 2, 3, 4, 5, 6, 7);
                    o[db] = __builtin_amdgcn_mfma_f32_32x32x16_bf16(vf, pk[kb][ss], o[db], 0, 0, 0); }
            __builtin_amdgcn_sched_barrier(0); }
#undef VREAD
        if (((t + 1) & (G - 1)) == 0) {
            asm volatile("s_waitcnt vmcnt(0)" ::: "memory"); ATT_BAR();
            const int g2 = (t + 1) / G + 1; if (g2 < ng) ATT_DMAGROUP(g2); }
    }
#undef ATT_DMA
#undef ATT_DMAGROUP
#undef ATT_BAR
    l_out = l_run + shx(l_run, 32);
}
__device__ __forceinline__ void gqa_unit(const AV& a, LAS unsigned char* lds, int seqrow0, int L, int h, int qb) {
    const int tid = ltid(), lane = tid & 63, r32 = lane & 31, hi = lane >> 5;
    const bf16* U = (const bf16*)(AWS + WS_U); bf16* Y = (bf16*)(AWS + WS_Y) + (size_t)1 * CH * 512;
    constexpr int G = 4, NSL = 2 * G, VROW = 128, VT = 8192, ATT_V = NSL * 8192;
    typedef const __attribute__((address_space(1))) u32x4* g4p;
    const int wv = __builtin_amdgcn_readfirstlane(tid >> 6); const int ldsa = (int)(unsigned)(uintptr_t)lds;
    const int qw0 = qb * 512 + wv * 64;
    const bf16* Kg = U + (size_t)seqrow0 * UP + C_GK + 64 * (h >> 2); const bf16* Vg = U + (size_t)seqrow0 * UP + C_GV + 64 * (h >> 2);
    const bf16* ksrc; { const int X = wv * 1024 + lane * 16, line = X >> 8, c16 = ((X >> 4) & 15) ^ (line & 15), key = 2 * line + (c16 >> 3), ch = c16 & 7; ksrc = Kg + (size_t)key * UP + ch * 8; }
    const bf16* vsrc; { const int X = wv * 1024 + lane * 16, key = X >> 7, posb = X & 127, swz = ((key >> 1) & 1) << 6; vsrc = Vg + (size_t)key * UP + ((posb ^ swz) >> 1); }
#define GQ_DMA(tt_, sl_) do { const size_t go_ = (size_t)(tt_) * 64 * UP; \
        glds16(ksrc + go_, (unsigned)__builtin_amdgcn_readfirstlane(ldsa + ATT_K + (sl_) * 8192 + wv * 1024)); \
        glds16(vsrc + go_, (unsigned)__builtin_amdgcn_readfirstlane(ldsa + ATT_V + (sl_) * VT + wv * 1024)); } while (0)
#define GQ_DMAGROUP(g_) do { _Pragma("unroll") for (int j_ = 0; j_ < G; ++j_) { const int tt_ = (g_) * G + j_; GQ_DMA(tt_, tt_ & (NSL - 1)); } } while (0)
#define GQ_BAR() do { __builtin_amdgcn_s_barrier(); asm volatile("" ::: "memory"); } while (0)
    int koff[2][4];
#pragma unroll
    for (int kb = 0; kb < 2; ++kb)
#pragma unroll
        for (int s = 0; s < 4; ++s) { const int key = 32 * kb + r32, line = key >> 1, c16 = ((key & 1) << 3) | (2 * s + hi); koff[kb][s] = line * 256 + ((c16 ^ (line & 15)) << 4); }
    const int q4 = (lane & 15) >> 2, p4 = lane & 3, g1 = (lane >> 4) & 1;
    const int vsw = (q4 >> 1) & 1;
    const int vbase = (4 * hi + q4) * VROW + 32 * g1 + 8 * p4;
    bf16x8 qf[2][4];
#pragma unroll
    for (int j = 0; j < 2; ++j)
#pragma unroll
        for (int s = 0; s < 4; ++s) qf[j][s] = __builtin_bit_cast(bf16x8, *(g4p)(U + (size_t)(seqrow0 + qw0 + 32 * j + r32) * UP + C_GQ + 64 * h + 16 * s + 8 * hi));
    f32x16 o[2][2];
#pragma unroll
    for (int j = 0; j < 2; ++j)
#pragma unroll
        for (int db = 0; db < 2; ++db)
#pragma unroll
            for (int r = 0; r < 16; ++r) o[j][db][r] = 0.f;
    float lrun[2] = {0.f, 0.f};
    const int nt = L >> 6, ng = nt / G;
    asm volatile("" :: "v"(qf[0][0]), "v"(qf[0][1]), "v"(qf[0][2]), "v"(qf[0][3]), "v"(qf[1][0]), "v"(qf[1][1]), "v"(qf[1][2]), "v"(qf[1][3]) : "memory");
    asm volatile("s_waitcnt vmcnt(0)" ::: "memory");
    GQ_DMAGROUP(0); if (ng > 1) GQ_DMAGROUP(1);
    if (ng > 1) asm volatile("s_waitcnt vmcnt(8)" ::: "memory"); else asm volatile("s_waitcnt vmcnt(0)" ::: "memory");
    GQ_BAR();
#pragma unroll 1
    for (int t = 0; t < nt; ++t) {
        const int cur = t & (NSL - 1);
        const LAS unsigned char* kbuf = lds + ATT_K + cur * 8192; const LAS unsigned char* vbuf = lds + ATT_V + cur * VT;
        f32x16 p[2][2];
        { bf16x8 kf[2][4];
#pragma unroll
          for (int kb = 0; kb < 2; ++kb)
#pragma unroll
            for (int s = 0; s < 4; ++s) kf[kb][s] = *(const LAS bf16x8*)(kbuf + koff[kb][s]);
          __builtin_amdgcn_sched_barrier(0);
#pragma unroll
          for (int kb = 0; kb < 2; ++kb)
#pragma unroll
            for (int j = 0; j < 2; ++j) { f32x16 acc;
#pragma unroll
              for (int r = 0; r < 16; ++r) acc[r] = 0.f;
#pragma unroll
              for (int s = 0; s < 4; ++s) acc = __builtin_amdgcn_mfma_f32_32x32x16_bf16(kf[kb][s], qf[j][s], acc, 0, 0, 0);
              p[j][kb] = acc; } }
        s16x4 vlo[2][4], vhi[2][4];
#define GQ_VREAD(buf_, db_) do { const int cofs_ = (((db_) ^ vsw) << 6); _Pragma("unroll") for (int kb = 0; kb < 2; ++kb) _Pragma("unroll") for (int ss = 0; ss < 2; ++ss) { \
            const LAS unsigned char* vp_ = vbuf + vbase + (32 * kb + 16 * ss) * VROW + cofs_; vlo[buf_][2 * kb + ss] = vtr(vp_); vhi[buf_][2 * kb + ss] = vtr(vp_ + 8 * VROW); } } while (0)
        bf16x8 pk[2][2][2];
#pragma unroll
        for (int j = 0; j < 2; ++j) { float ls0 = 0.f, ls1 = 0.f;
#pragma unroll
            for (int kb = 0; kb < 2; ++kb) {
#pragma unroll
                for (int r = 0; r < 16; r += 2) { const float e0 = __builtin_amdgcn_exp2f(p[j][kb][r]), e1 = __builtin_amdgcn_exp2f(p[j][kb][r + 1]); ls0 += e0; ls1 += e1; p[j][kb][r] = e0; p[j][kb][r + 1] = e1; }
#pragma unroll
                for (int ss = 0; ss < 2; ++ss) { u32x4 w; w.x = cvtpk(p[j][kb][8 * ss + 0], p[j][kb][8 * ss + 1]); w.y = cvtpk(p[j][kb][8 * ss + 2], p[j][kb][8 * ss + 3]); w.z = cvtpk(p[j][kb][8 * ss + 4], p[j][kb][8 * ss + 5]); w.w = cvtpk(p[j][kb][8 * ss + 6], p[j][kb][8 * ss + 7]);
                    pk[j][kb][ss] = __builtin_bit_cast(bf16x8, w); } }
            lrun[j] += ls0 + ls1; }
        __builtin_amdgcn_sched_barrier(0);
        GQ_VREAD(0, 0); GQ_VREAD(1, 1);
#pragma unroll
        for (int db = 0; db < 2; ++db) {
#pragma unroll
            for (int kb = 0; kb < 2; ++kb)
#pragma unroll
                for (int ss = 0; ss < 2; ++ss) { const bf16x8 vf = db ? __builtin_shufflevector(vlo[1][2 * kb + ss], vhi[1][2 * kb + ss], 0, 1, 2, 3, 4, 5, 6, 7) : __builtin_shufflevector(vlo[0][2 * kb + ss], vhi[0][2 * kb + ss], 0, 1, 2, 3, 4, 5, 6, 7);
#pragma unroll
                    for (int j = 0; j < 2; ++j) o[j][db] = __builtin_amdgcn_mfma_f32_32x32x16_bf16(vf, pk[j][kb][ss], o[j][db], 0, 0, 0); }
            __builtin_amdgcn_sched_barrier(0); }
#undef GQ_VREAD
        if (((t + 1) & (G - 1)) == 0) { asm volatile("s_waitcnt vmcnt(0)" ::: "memory"); GQ_BAR(); const int g2 = (t + 1) / G + 1; if (g2 < ng) GQ_DMAGROUP(g2); }
    }
#undef GQ_DMA
#undef GQ_DMAGROUP
#undef GQ_BAR
#pragma unroll
    for (int j = 0; j < 2; ++j) { const int lane2 = ltid() & 63, r32b = lane2 & 31, hib = lane2 >> 5;
        const float l = lrun[j] + shx(lrun[j], 32); const float inv = 1.0f / l; const size_t row = (size_t)(seqrow0 + qw0 + 32 * j + r32b);
#pragma unroll
        for (int db = 0; db < 2; ++db)
#pragma unroll
            for (int g = 0; g < 4; ++g) { const int d = 32 * db + 8 * g + 4 * hib; const u32x2 gw = *(const u32x2*)(U + row * UP + C_GG + 64 * h + d);
                const float y0 = o[j][db][4 * g] * inv * silu(bflo(gw.x)), y1 = o[j][db][4 * g + 1] * inv * silu(bfhi(gw.x)), y2 = o[j][db][4 * g + 2] * inv * silu(bflo(gw.y)), y3 = o[j][db][4 * g + 3] * inv * silu(bfhi(gw.y));
                u32x2 w; w.x = cvtpk(y0, y1); w.y = cvtpk(y2, y3); *(u32x2*)(Y + row * 512 + 64 * h + d) = w; } }
}
__device__ __forceinline__ void diff_unit(const AV& a, LAS unsigned char* lds, int seqrow0, int L, int h, int qb, int layer) {
    const int tid = ltid(), lane = tid & 63, wave = tid >> 6, r32 = lane & 31, hi = lane >> 5;
    const bf16* U = (const bf16*)(AWS + WS_U); bf16* Y = (bf16*)(AWS + WS_Y) + (size_t)2 * CH * 512; float* DT = (float*)(AWS + WS_DT);
    const float* relb = AIN(I_RELB);
    LAS float* tb = (LAS float*)(lds + ATT_TB_DIFF);
    for (int i = tid; i < 257; i += NT) { const int rel = i - 128, n = rel < 0 ? -rel : rel; int b = rel > 0 ? 16 : 0;
        if (n < 8) b += n; else { const int v = 8 + (31 - __builtin_clz((unsigned)(n * n))) - 6; b += v < 15 ? v : 15; }
        tb[i] = relb[b * 4 + h] * LOG2E; }
    const float bl = relb[15 * 4 + h] * LOG2E, br = relb[31 * 4 + h] * LOG2E;
    float lyf = (float)layer; asm volatile("" : "+v"(lyf));
    const float li = 0.8f - 0.6f * __expf(-0.3f * lyf);
    float d1, d2; { const float q1 = AIN(I_LQ1)[layer * 64 + lane], k1 = AIN(I_LK1)[layer * 64 + lane], q2 = AIN(I_LQ2)[layer * 64 + lane], k2 = AIN(I_LK2)[layer * 64 + lane]; d1 = wave_sum(q1 * k1); d2 = wave_sum(q2 * k2); }
    const float lam = __expf(d1) - __expf(d2) + li;
    const int qw0 = qb * 256 + wave * 32, qpos = qw0 + r32; const size_t row = (size_t)(seqrow0 + qpos);
    __syncthreads();
    f32x16 o[4]; float l; float ss = 0.f;
#pragma unroll 1
    for (int c = 0; c < 2; ++c) {
#pragma unroll
        for (int db = 0; db < 4; ++db)
#pragma unroll
            for (int r = 0; r < 16; ++r) o[db][r] = 0.f;
        flash_pass<128, true, true, 2>(lds, U + row * UP + C_DQ + 128 * h + 64 * c, U + (size_t)seqrow0 * UP + C_DK + 128 * h + 64 * c, U + (size_t)seqrow0 * UP + C_DV + 128 * h, L, qpos, qw0, bl, br, o, l);
        if (c == 0) { const float inv = 1.0f / l;
#pragma unroll
            for (int db = 0; db < 4; ++db)
#pragma unroll
                for (int g = 0; g < 4; ++g) { const int d = 32 * db + 8 * g + 4 * hi; *(f32x4*)(DT + row * 512 + 128 * h + d) = (f32x4){o[db][4 * g] * inv, o[db][4 * g + 1] * inv, o[db][4 * g + 2] * inv, o[db][4 * g + 3] * inv}; }
        } else { const float inv = lam / l;
#pragma unroll
            for (int db = 0; db < 4; ++db)
#pragma unroll
                for (int g = 0; g < 4; ++g) { const int d = 32 * db + 8 * g + 4 * hi; const f32x4 o0 = *(const f32x4*)(DT + row * 512 + 128 * h + d);
#pragma unroll
                    for (int e = 0; e < 4; ++e) { const float v = o0[e] - o[db][4 * g + e] * inv; o[db][4 * g + e] = v; ss += v * v; } }
        }
    }
    ss += shx(ss, 32);
    const float rs = (1.0f / sqrtf(ss * (1.0f / 128.0f) + EPS)) * (1.0f - li);
    const float* sg = AIN(I_SUBLN) + layer * 128;
#pragma unroll
    for (int db = 0; db < 4; ++db)
#pragma unroll
        for (int g = 0; g < 4; ++g) { const int d = 32 * db + 8 * g + 4 * hi; const u32x2 gw = *(const u32x2*)(U + row * UP + C_DG + 128 * h + d); const f32x4 gn = *(const f32x4*)(sg + d);
            const float y0 = o[db][4 * g] * rs * gn.x * silu(bflo(gw.x)), y1 = o[db][4 * g + 1] * rs * gn.y * silu(bfhi(gw.x)), y2 = o[db][4 * g + 2] * rs * gn.z * silu(bflo(gw.y)), y3 = o[db][4 * g + 3] * rs * gn.w * silu(bfhi(gw.y));
            u32x2 w; w.x = cvtpk(y0, y1); w.y = cvtpk(y2, y3); *(u32x2*)(Y + row * 512 + 128 * h + d) = w; }
}
template <int LOG4, int BATCH> __device__ __forceinline__ void hyena_unit(const AV& a, LAS unsigned char* lds, int seqrow0, int pr0, int layer) {
    constexpr int N = 1 << (2 * LOG4), L = N / 2, NPAD = N + N / 16;
    const int tid = ltid(); LAS f32x2* buf = (LAS f32x2*)lds;
    bf16* Y = (bf16*)(AWS + WS_Y) + (size_t)seqrow0 * 512;
    const unsigned char* sp = AWS + WS_SPEC + layer * SPEC_LAYER;
    constexpr int SPS = (LOG4 == 7) ? SPS_P : SPS_S;
    const f32x2* Pg = ((LOG4 == 7) ? (const f32x2*)sp : (const f32x2*)(sp + 2 * SPEC_P_BYTES)) + (size_t)pr0 * SPS;
    const f32x2* Mg = ((LOG4 == 7) ? (const f32x2*)(sp + SPEC_P_BYTES) : (const f32x2*)(sp + 2 * SPEC_P_BYTES + SPEC_S_BYTES)) + (size_t)pr0 * SPS;
    const f32x2* hvp = (const f32x2*)(AWS + WS_HVP) + (size_t)pr0 * CH + seqrow0; const f32x2* pmp = (const f32x2*)(AWS + WS_PMP) + (size_t)pr0 * CH + seqrow0;
#pragma unroll
    for (int b = 0; b < BATCH; ++b)
        for (int t = tid; t < L; t += NT) { buf[b * NPAD + PADI(t)] = hvp[(size_t)b * CH + t]; buf[b * NPAD + PADI(t + L)] = (f32x2){0.f, 0.f}; }
    __syncthreads();
    const f32x2* tw = (const f32x2*)(AWS + WS_TW);
    fft_fwd<LOG4, BATCH>(buf, tw, tid);
#pragma unroll
    for (int b = 0; b < BATCH; ++b)
        for (int k = tid; k <= L; k += NT) { const int p1 = b * NPAD + PADI(digitrev<LOG4>(k)), p2 = b * NPAD + PADI(digitrev<LOG4>((N - k) & (N - 1))); const f32x2 z1 = buf[p1], z2 = buf[p2], P = Pg[(size_t)b * SPS + k], M = Mg[(size_t)b * SPS + k];
            const f32x2 y1 = cmul(z1, P) + cmul(cconj(z2), M), y2 = cmulc(z2, P) + cmulc(cconj(z1), M);
            buf[p1] = y1; if (p2 != p1) buf[p2] = y2; }
    __syncthreads();
    fft_inv<LOG4, BATCH>(buf, tw, tid);
    for (int t = tid; t < L; t += NT) { unsigned w[BATCH];
#pragma unroll
        for (int b = 0; b < BATCH; ++b) { const f32x2 y = buf[b * NPAD + PADI(t)], m = pmp[(size_t)b * CH + t]; w[b] = cvtpk(y.x * m.x, y.y * m.y); }
        if (BATCH == 4) *(u32x4*)(Y + (size_t)t * 512 + 2 * pr0) = (u32x4){w[0], w[BATCH > 1 ? 1 : 0], w[BATCH > 2 ? 2 : 0], w[BATCH > 3 ? 3 : 0]};
        else *(unsigned*)(Y + (size_t)t * 512 + 2 * pr0) = w[0]; }
    __syncthreads();
}
#define XB_TMO      128
#define XB_XCNT(j)  (256  + 64 * (j))
#define XB_XSUB(j)  (1280 + 64 * (j))
#define XB_XGEN(j)  (2304 + 64 * (j))
#define XB_TOP      3328
#define XB_TOPGEN   3392
#define XCD_BAR_WORDS 3456
#define XB_SPIN_CAP (1u << 18)

__device__ __forceinline__ unsigned xb_ld(unsigned* p)              { return __hip_atomic_load(p, __ATOMIC_RELAXED, __HIP_MEMORY_SCOPE_AGENT); }
__device__ __forceinline__ unsigned xb_add(unsigned* p, unsigned v) { return __hip_atomic_fetch_add(p, v, __ATOMIC_RELAXED, __HIP_MEMORY_SCOPE_AGENT); }
__device__ __forceinline__ unsigned xb_xcc_id() { return (unsigned)__builtin_amdgcn_s_getreg((3 << 11) | 20) & 0xFu; }
#define XB_SPIN(cond, bar) do { unsigned _sp = 0; while (cond) { __builtin_amdgcn_s_sleep(1); \
    if ((++_sp & 255u) == 0u) { if (xb_ld(&(bar)[XB_TMO])) break; if (_sp > XB_SPIN_CAP) { atomicAdd(&(bar)[XB_TMO], 1u); break; } } } } while (0)

struct XcdBarrier {
    unsigned* bar; unsigned x;
    volatile LAS unsigned* st;
};

__device__ __forceinline__ XcdBarrier xcd_barrier_post(unsigned* bar, volatile LAS unsigned* st) {
    XcdBarrier b; b.bar = bar; b.x = xb_xcc_id(); b.st = st;
    if (threadIdx.x == 0) (void)xb_add(&bar[XB_XCNT(b.x)], 1u);
    return b;
}
__device__ __forceinline__ void xcd_barrier_complete(unsigned* bar, unsigned x, unsigned& nloc, unsigned& nx) {
    const unsigned G = gridDim.x * gridDim.y * gridDim.z;
    unsigned sum, cnt, mine, sp = 0u;
    for (;;) {
        sum = 0u; cnt = 0u; mine = 0u;
#pragma unroll
        for (unsigned j = 0; j < 16; ++j) { const unsigned c = xb_ld(&bar[XB_XCNT(j)]); sum += c; cnt += (c > 0u) ? 1u : 0u; mine = (j == x) ? c : mine; }
        if (sum == G) break;
        __builtin_amdgcn_s_sleep(1);
        if ((++sp & 255u) == 0u) { if (xb_ld(&bar[XB_TMO])) break; if (sp > XB_SPIN_CAP) { atomicAdd(&bar[XB_TMO], 1u); break; } }
    }
    nloc = mine > 0u ? mine : 1u; nx = cnt > 0u ? cnt : 1u;
}

__device__ __forceinline__ void xcd_barrier(const XcdBarrier& b) {
    asm volatile("s_waitcnt vmcnt(0)" ::: "memory");
    __syncthreads();
    if (threadIdx.x == 0) {
        unsigned* bar = b.bar;
        __builtin_amdgcn_s_waitcnt(0);
        unsigned nloc = b.st[0], nx = b.st[1];
        if (nloc == 0u) { xcd_barrier_complete(bar, b.x, nloc, nx); b.st[0] = nloc; b.st[1] = nx; }
        const unsigned old = xb_add(&bar[XB_XSUB(b.x)], 1u);
        const unsigned gen = old / nloc;
        if (old + 1u == (gen + 1u) * nloc) {
            __builtin_amdgcn_fence(__ATOMIC_RELEASE, "agent");
            asm volatile("s_waitcnt vmcnt(0)" ::: "memory");
            const unsigned og = xb_add(&bar[XB_TOP], 1u);
            const unsigned tg = og / nx;
            if (og + 1u == (tg + 1u) * nx) xb_add(&bar[XB_TOPGEN], 1u);
            else XB_SPIN(xb_ld(&bar[XB_TOPGEN]) == tg, bar);
            __builtin_amdgcn_fence(__ATOMIC_ACQUIRE, "agent");
            xb_add(&bar[XB_XGEN(b.x)], 1u);
            asm volatile("s_waitcnt vmcnt(0)" ::: "memory");
        } else {
            XB_SPIN(xb_ld(&bar[XB_XGEN(b.x)]) == gen, bar);
            __builtin_amdgcn_fence(__ATOMIC_ACQUIRE, "agent");
            asm volatile("s_waitcnt vmcnt(0)" ::: "memory");
        }
    }
    __syncthreads();
}

__device__ __forceinline__ void step_mix(const AV& a, LAS unsigned char* lds, int c, int layer, unsigned* ctr, int tmask) {
    const Chunk ck = chunk_of(c); const int nqb = ck.L / 256, nqg = ck.L / 512, nD = ck.nseq * 4 * nqb, nG = ck.nseq * 8 * nqg, nF = (ck.L == LP) ? ck.nseq * 256 : ck.nseq * 64, total = nD + nG + nF;
    volatile LAS unsigned* wq = (volatile LAS unsigned*)(lds + LDS_MAIN);
    for (;;) {
        if (ltid() == 0) wq[0] = atomicAdd(ctr, 1u);
        __syncthreads();
        const int u = (int)wq[0];
        __syncthreads();
        if (u >= total) break;
        if (u < nD) { if (tmask & 1) { const int qb = u % nqb, sh = u / nqb, h = sh & 3, s = sh >> 2; diff_unit(a, lds, s * ck.L, ck.L, h, qb, layer); } }
        else if (u < nD + nG) { if (tmask & 2) { const int v = u - nD, qb = v % nqg, sh = v / nqg, h = sh & 7, s = sh >> 3; gqa_unit(a, lds, s * ck.L, ck.L, h, qb); } }
        else { if (tmask & 4) { const int v = u - nD - nG; if (ck.L == LP) hyena_unit<7, 1>(a, lds, (v >> 8) * LP, v & 255, layer); else hyena_unit<6, 4>(a, lds, (v >> 6) * LS, (v & 63) * 4, layer); } }
    }
}
constexpr int STEPS_PER = 6, NPRO = 3, NSTEPS = NPRO + NCHUNK * 2 * STEPS_PER + 1;
__global__ void __launch_bounds__(NT, 2) mega_fwd(Args kargs) {
    extern __shared__ __attribute__((aligned(16))) unsigned char lds_raw[];
    LAS unsigned char* lds = (LAS unsigned char*)lds_raw;
    kargp_t kp = (kargp_t)__builtin_amdgcn_kernarg_segment_ptr();
    { volatile LAS unsigned* misc = (volatile LAS unsigned*)(lds + LDS_MAIN + 64); if (ltid() < 16) misc[ltid()] = 0u; }
    __syncthreads();
    XcdBarrier xbar = xcd_barrier_post((unsigned*)(kargs.ws + WS_CTL) + CW_BAR, (volatile LAS unsigned*)(lds + LDS_MAIN + 64 + 32));
    const int step_lo = kargs.lo, step_hi = kargs.hi;
#pragma unroll 1
    for (int step = step_lo; step < step_hi; ++step) {
        asm volatile("" : "+s"(kp));
        AV a; a.p = kp; unsigned char* ws = AWS;
        if (step == 0) { if (EN(0)) step_pro_a(a, lds); }
        else if (step == 1) { if (EN(11)) { step_pro_a2(a, lds); if (DUP_MASK & 32) { xcd_barrier(xbar); step_pro_a2(a, lds); } } }
        else if (step == 2) { if (EN(1)) { step_pro_b(a, lds); if (DUP_MASK & 64) { xcd_barrier(xbar); step_pro_b(a, lds); } } }
        else if (step == NSTEPS - 1) { if (DUP_MASK & 256) { for (int q = 0; q < 100; ++q) xcd_barrier(xbar); } if (EN(2)) step_final(a, (NCHUNK - 1) * CH, NTOK); }
        else {
            const int s2 = step - NPRO, cl = s2 / STEPS_PER, k = s2 - cl * STEPS_PER, c = cl >> 1, layer = cl & 1;
            const Chunk ck = chunk_of(c);
            if (k == 0) { if (layer == 0) { if (c > 0 && EN(2)) step_final(a, (c - 1) * CH, c * CH); } continue;     }
            else if (k == 2) { if (EN(5)) { step_prep(a, c, layer); step_prep_hy(a, lds, c, layer); if (layer == 0) { float* q = (float*)(ws + WS_SSQ); for (int i = lbid() * NT + ltid(); i < CH; i += (int)gridDim.x * NT) q[i] = 0.f; } } }
            else if (k == 3) {
#pragma unroll 1
                for (int rep = 0; rep < ((DUP_MASK & 7) ? 2 : 1); ++rep) { if (rep) xcd_barrier(xbar); step_mix(a, lds, c, layer, (unsigned*)(ws + WS_CTL) + step * 16 + 4 * rep, rep ? (DUP_MASK & 7) : 7); } }
            else { if (EN(4)) {
                pg8::Gemm g; pg8::OrderAll S; pg8::EpiAll E; const int G = (int)gridDim.x, bid = lbid();
                S.so.init(CH, k == 1 ? NCAT : 1024, G, bid); S.o2 = pg8::OrderG2{CH / 256, G, bid}; S.mode = (k == 4) ? 2 : 1;
                float* O = AOUT + (size_t)ck.tok0 * DM; const float* X = layer == 0 ? xin_rows(a, ck.tok0) : O;
                E.mode = (k == 1) ? 1 : (k == 4) ? 2 : 3;
                E.e1 = pg8::EpiG1{(pg8::bf16_t*)(ws + WS_U), (pg8::bf16_t*)(ws + WS_G), AIN(I_BMERGE) + layer * GP, layer == 1 ? (const float*)(ws + WS_SSQ) : (const float*)nullptr};
                E.e2 = pg8::EpiG2{(const pg8::bf16_t*)(ws + WS_G), (float*)(ws + WS_TMP), (pg8::bf16_t*)(ws + WS_MG), CH / 256};
                E.e3 = pg8::EpiG3{X, O, AIN(I_NORMG) + DM, (pg8::bf16_t*)(ws + WS_HN), (float*)(ws + WS_SSQ), layer == 0 ? 1 : 0};
                if (k == 1) g = pg8::Gemm{layer == 0 ? (const pg8::bf16_t*)(ws + WS_HN0) + (size_t)ck.tok0 * DM : (const pg8::bf16_t*)(ws + WS_HN), (const pg8::bf16_t*)(ws + WS_WCAT + layer * WCAT_BYTES), CH, NCAT, 1024};
                else if (k == 4) g = pg8::Gemm{(const pg8::bf16_t*)(ws + WS_Y), (const pg8::bf16_t*)(ws + WS_WBT + layer * WBT_BYTES), 3 * CH, 3072, 512};
                else g = pg8::Gemm{(const pg8::bf16_t*)(ws + WS_MG), (const pg8::bf16_t*)(ws + WS_WOT + layer * WOT_BYTES), CH, 1024, 1024};
                const int nrep = (((DUP_MASK & 8) && k == 1) || ((DUP_MASK & 16) && k == 4)) ? 2 : 1;
#pragma unroll 1
                for (int rep = 0; rep < nrep; ++rep) { if (rep) xcd_barrier(xbar); pg8::gemm_phase<pg8::EpiAll, pg8::OrderAll, true, true>(lds, g, S, E); }
            } }
        }
        if (step + 1 < step_hi) { if (step == 0) cg::this_grid().sync(); else xcd_barrier(xbar); }
    }
}
#ifndef MK_MULTI
#define MK_MULTI 0
#endif
extern "C" void kernel_launch(void* const* d_in, const int* in_sizes, int n_in, void* d_out, int out_size, void* d_ws, size_t ws_size, hipStream_t stream) {
    static int grid = 0;
    if (grid == 0) {
        if (n_in != N_IN || out_size != NTOK * DM || ws_size < WS_END) { fprintf(stderr, "kernel_launch: unexpected shapes (n_in %d, out %d, ws %zu)\n", n_in, out_size, ws_size); grid = -1; return; }
        int dev = 0, cus = 0, per_cu = 0;
        hipGetDevice(&dev); hipDeviceGetAttribute(&cus, hipDeviceAttributeMultiprocessorCount, dev);
        if (hipFuncSetAttribute((const void*)mega_fwd, hipFuncAttributeMaxDynamicSharedMemorySize, LDS_BYTES) != hipSuccess) { fprintf(stderr, "kernel_launch: hipFuncSetAttribute failed\n"); grid = -1; return; }
        hipOccupancyMaxActiveBlocksPerMultiprocessor(&per_cu, (const void*)mega_fwd, NT, LDS_BYTES);
        (void)hipGetLastError();
        if (per_cu < 1) per_cu = 1;
        grid = cus * 1;
        fprintf(stderr, "kernel_launch: cus %d per_cu %d grid %d\n", cus, per_cu, grid);
    }
    if (grid < 0) return;
    hipMemsetAsync((char*)d_ws + WS_CTL, 0, CTL_BYTES, stream);
    Args a{};
    for (int i = 0; i < N_IN; ++i) a.in[i] = (const float*)d_in[i];
    a.out = (float*)d_out; a.ws = (unsigned char*)d_ws;
#if MK_MULTI
    for (int s = 0; s < NSTEPS; ++s) { a.lo = s; a.hi = s + 1; hipLaunchKernelGGL(mega_fwd, dim3(grid), dim3(NT), LDS_BYTES, stream, a); }
#else
    a.lo = 0; a.hi = NSTEPS;
    void* args[] = {&a};
    hipError_t e = hipLaunchCooperativeKernel((const void*)mega_fwd, dim3(grid), dim3(NT), args, LDS_BYTES, stream);
    if (e != hipSuccess) fprintf(stderr, "cooperative launch failed: %s (grid %d)\n", hipGetErrorString(e), grid);
#endif
}
```

```cpp
#include <hip/hip_runtime.h>
#include <hip/hip_cooperative_groups.h>
#include <cstdio>
#include <cstdint>
namespace cg = cooperative_groups;
__device__ __forceinline__ int ltid() { int t = (int)threadIdx.x; asm volatile("" : "+v"(t)); return t; }
__device__ __forceinline__ float shx(float v, int o) { const int l = ltid() & 63; return __int_as_float(__builtin_amdgcn_ds_bpermute((l ^ o) << 2, __float_as_int(v))); }
__device__ __forceinline__ int lbid() { int b = (int)blockIdx.x; asm volatile("" : "+s"(b)); return b; }
namespace pg8 {
#define PG8_LAS __attribute__((address_space(3)))
typedef unsigned short bf16_t;
typedef short bf16x8 __attribute__((ext_vector_type(8)));
typedef float f32x4 __attribute__((ext_vector_type(4)));
typedef unsigned u32x4 __attribute__((ext_vector_type(4)));
constexpr int BM = 256, BK = 64, HALF = 128, HTB = HALF * BK * 2  , STAGE_BYTES = 8 * HTB, NXCD = 8, WGM = 8;

__host__ __device__ __forceinline__ int lds_byte(int r, int c) { const int st = (r >> 4) * 2 + (c >> 5), rr = r & 15, cc = c & 31, ob = rr * 64 + cc * 2; return st * 1024 + (ob ^ (((ob >> 9) & 1) << 5)); }
__host__ __device__ __forceinline__ void stage_rc(int b, int& R, int& C) { const int st = b / 1024, sb = b % 1024, swz = sb ^ (((sb >> 9) & 1) << 5); R = (st >> 1) * 16 + swz / 64; C = (st & 1) * 32 + (swz % 64) / 2; }
__host__ __device__ __forceinline__ int perm32(int rho) { const int n = rho >> 4, i = rho & 15; return 8 * (i >> 2) + 4 * n + (i & 3); }

struct Unit { int pm, pn; };
struct Gemm { const bf16_t* A; const bf16_t* Bt; int M, N, K; };

struct StaticOrder {
    int nM, nN, nwg, G, c;
    __host__ __device__ void init(int M, int N, int G_, int c_) { nM = M / BM; nN = N / BM; nwg = nM * nN; G = G_; c = c_; }
    __host__ __device__ bool next(int i, Unit& u) const {
        const long L = (long)i * G + c; if (L >= nwg) return false;
        int wgid = (int)L; { const int q = nwg / NXCD, r = nwg % NXCD, xcd = wgid % NXCD, off = wgid / NXCD; wgid = (xcd < r ? xcd * (q + 1) : r * (q + 1) + (xcd - r) * q) + off; }
        const int nig = WGM * nN, gid = wgid / nig, fm = gid * WGM, gsz = (nM - fm) < WGM ? (nM - fm) : WGM;
        u.pm = fm + ((wgid % nig) % gsz); u.pn = (wgid % nig) / gsz; return true;
    }
    __device__ __forceinline__ void a_ready(const Unit&) const {}
    __device__ __forceinline__ void done(const Unit&) const {}
};

__device__ __forceinline__ unsigned cvt_pk_bf16(float lo, float hi) { unsigned r; asm volatile("v_cvt_pk_bf16_f32 %0, %1, %2" : "=v"(r) : "v"(lo), "v"(hi)); return r; }
template <class Epi, class Sched, bool ALIGN_EPI = false, bool SP2 = false>
__device__ __forceinline__ void gemm_phase(PG8_LAS unsigned char* lds, const Gemm g, const Sched& S, const Epi& E) {
    const int tid = ltid(), wid = __builtin_amdgcn_readfirstlane(tid >> 6), lane = tid & 63, wr = wid >> 2, wc = wid & 3, fr = lane & 15, fq = lane >> 4;
    const int K = g.K, nt = K / BK;
    unsigned voffA[2], voffB[2];
#pragma unroll
    for (int i = 0; i < 2; ++i) { int R, C; stage_rc(tid * 16 + i * 8192, R, C); const int Rb = Epi::PERM ? ((R & ~31) + perm32(R & 31)) : R;
        voffA[i] = (unsigned)(R * K + C) * 2u; voffB[i] = (unsigned)(Rb * K + C) * 2u; }
    const size_t kstep = (size_t)(BK * 2);
    const size_t hstep = (size_t)HALF * K * 2;
    const size_t tstep = 2 * hstep;
    const unsigned ldsw = (unsigned)wid * 1024u;
    const int aoff = lds_byte(wr * 64 + fr, fq * 8), boff = lds_byte(wc * 32 + fr, fq * 8);
#define PG8_SA(b, h) (((b) * 2 + (h)) * HTB)
#define PG8_SB(b, h) ((4 + (b) * 2 + (h)) * HTB)
#define PG8_STAGE(bufoff, gbase, voff) do { _Pragma("unroll") for (int _i = 0; _i < 2; ++_i) \
        __builtin_amdgcn_global_load_lds((const unsigned*)((const char*)(gbase) + (voff)[_i]), (PG8_LAS unsigned*)(lds + (bufoff) + ldsw + _i * 8192), 16, 0, 0); } while (0)
#define PG8_LDA(dst, b, h) do { _Pragma("unroll") for (int m = 0; m < 4; ++m) _Pragma("unroll") for (int k = 0; k < 2; ++k) dst[m][k] = *(const PG8_LAS bf16x8*)(lds + PG8_SA(b, h) + aoff + m * 2048 + k * 1024); } while (0)
#define PG8_LDB(dst, b, h) do { _Pragma("unroll") for (int n = 0; n < 2; ++n) _Pragma("unroll") for (int k = 0; k < 2; ++k) dst[n][k] = *(const PG8_LAS bf16x8*)(lds + PG8_SB(b, h) + boff + n * 2048 + k * 1024); } while (0)
#define PG8_MMA(ai, bj, At, Bt) do { __builtin_amdgcn_s_setprio(1); _Pragma("unroll") for (int m = 0; m < 4; ++m) _Pragma("unroll") for (int n = 0; n < 2; ++n) _Pragma("unroll") for (int k = 0; k < 2; ++k) \
        acc[ai][bj][m][n] = __builtin_amdgcn_mfma_f32_16x16x32_bf16(Bt[n][k], At[m][k], acc[ai][bj][m][n], 0, 0, 0); __builtin_amdgcn_s_setprio(0); } while (0)
#define PG8_WAIT_V(n) asm volatile("s_waitcnt vmcnt(" #n ")" ::: "memory")
#define PG8_WAIT_L(n) asm volatile("s_waitcnt lgkmcnt(" #n ")" ::: "memory")
#define PG8_BAR __builtin_amdgcn_s_barrier()
#define PG8_SCHED __builtin_amdgcn_sched_barrier(0)
    Unit cur, nxt; int ui = 0;
    if (!S.next(0, cur)) return;
    f32x4 acc[2][2][4][2];
#pragma unroll
    for (int a = 0; a < 2; ++a)
#pragma unroll
        for (int b = 0; b < 2; ++b)
#pragma unroll
            for (int m = 0; m < 4; ++m)
#pragma unroll
                for (int n = 0; n < 2; ++n) acc[a][b][m][n] = (f32x4){0.f, 0.f, 0.f, 0.f};
    bf16x8 At[4][2], B0[2][2], B1[2][2];
    const char* cA = (const char*)g.A + (size_t)cur.pm * tstep; const char* cB = (const char*)g.Bt + (size_t)cur.pn * tstep;
    S.a_ready(cur);
    if constexpr (SP2) {
        PG8_STAGE(PG8_SB(0, 0), cB, voffB); PG8_STAGE(PG8_SB(0, 1), cB + hstep, voffB); PG8_STAGE(PG8_SA(0, 0), cA, voffA); PG8_STAGE(PG8_SA(0, 1), cA + hstep, voffA);
        if (wr == 1) PG8_BAR;
        PG8_WAIT_V(2); PG8_BAR;
        PG8_STAGE(PG8_SB(1, 0), cB + kstep, voffB); PG8_STAGE(PG8_SA(1, 0), cA + kstep, voffA); PG8_STAGE(PG8_SB(1, 1), cB + hstep + kstep, voffB);
        PG8_WAIT_V(6); PG8_BAR;
    } else {
        PG8_STAGE(PG8_SB(0, 0), cB, voffB); PG8_STAGE(PG8_SA(0, 0), cA, voffA); PG8_STAGE(PG8_SB(0, 1), cB + hstep, voffB); PG8_STAGE(PG8_SA(0, 1), cA + hstep, voffA);
        if (wr == 1) PG8_BAR;
        PG8_WAIT_V(4); PG8_BAR;
        PG8_STAGE(PG8_SB(1, 0), cB + kstep, voffB); PG8_STAGE(PG8_SA(1, 0), cA + kstep, voffA); PG8_STAGE(PG8_SB(1, 1), cB + hstep + kstep, voffB);
        PG8_WAIT_V(6); PG8_BAR;
    }
    for (;;) {
        const bool has_next = S.next(ui + 1, nxt);
        const char* nA = has_next ? (const char*)g.A + (size_t)nxt.pm * tstep : cA; const char* nB = has_next ? (const char*)g.Bt + (size_t)nxt.pn * tstep : cB;
        for (int t = 0; t < nt; t += 2) {
            const bool last = (t == nt - 2);
            const char* a1 = cA + (size_t)(t + 1) * kstep;
            const char* a2 = last ? nA : cA + (size_t)(t + 2) * kstep; const char* b2 = last ? nB : cB + (size_t)(t + 2) * kstep;
            const char* a3 = a2 + kstep; const char* b3 = b2 + kstep;
            if (last && has_next) S.a_ready(nxt);
            if constexpr (SP2) {
            PG8_LDB(B0, 0, 0); PG8_LDB(B1, 0, 1); PG8_SCHED; PG8_LDA(At, 0, 0); PG8_STAGE(PG8_SA(1, 1), a1 + hstep, voffA);
            PG8_WAIT_V(8); PG8_WAIT_L(0); PG8_BAR; PG8_MMA(0, 0, At, B0); PG8_MMA(0, 1, At, B1); PG8_BAR; PG8_SCHED;
            PG8_LDA(At, 0, 1); PG8_STAGE(PG8_SB(0, 0), b2, voffB); PG8_STAGE(PG8_SB(0, 1), b2 + hstep, voffB); PG8_STAGE(PG8_SA(0, 0), a2, voffA);
            PG8_WAIT_V(8); PG8_WAIT_L(0); PG8_BAR; PG8_MMA(1, 0, At, B0); PG8_MMA(1, 1, At, B1); PG8_BAR; PG8_SCHED;
            PG8_LDB(B0, 1, 0); PG8_LDB(B1, 1, 1); PG8_SCHED; PG8_LDA(At, 1, 0); PG8_STAGE(PG8_SA(0, 1), a2 + hstep, voffA);
            PG8_WAIT_V(8); PG8_WAIT_L(0); PG8_BAR; PG8_MMA(0, 0, At, B0); PG8_MMA(0, 1, At, B1); PG8_BAR; PG8_SCHED;
            PG8_LDA(At, 1, 1); PG8_STAGE(PG8_SB(1, 0), b3, voffB); PG8_STAGE(PG8_SB(1, 1), b3 + hstep, voffB); PG8_STAGE(PG8_SA(1, 0), a3, voffA);
            PG8_WAIT_V(8); PG8_WAIT_L(0); PG8_BAR; PG8_MMA(1, 0, At, B0); PG8_MMA(1, 1, At, B1); PG8_BAR; PG8_SCHED;
            } else {
            PG8_LDB(B0, 0, 0); PG8_SCHED; PG8_LDA(At, 0, 0); PG8_STAGE(PG8_SA(1, 1), a1 + hstep, voffA);
            PG8_WAIT_L(8); PG8_BAR; PG8_WAIT_L(0); PG8_MMA(0, 0, At, B0); PG8_BAR; PG8_SCHED;
            PG8_LDB(B1, 0, 1); PG8_STAGE(PG8_SB(0, 0), b2, voffB);
            PG8_BAR; PG8_WAIT_L(0); PG8_MMA(0, 1, At, B1); PG8_BAR;
            PG8_LDA(At, 0, 1); PG8_STAGE(PG8_SA(0, 0), a2, voffA);
            PG8_BAR; PG8_WAIT_L(0); PG8_MMA(1, 0, At, B0); PG8_BAR; PG8_SCHED;
            PG8_STAGE(PG8_SB(0, 1), b2 + hstep, voffB);
            PG8_WAIT_V(6); PG8_BAR; PG8_MMA(1, 1, At, B1); PG8_BAR;
            PG8_LDB(B0, 1, 0); PG8_SCHED; PG8_LDA(At, 1, 0); PG8_STAGE(PG8_SA(0, 1), a2 + hstep, voffA);
            PG8_WAIT_L(8); PG8_BAR; PG8_WAIT_L(0); PG8_MMA(0, 0, At, B0); PG8_BAR; PG8_SCHED;
            PG8_LDB(B1, 1, 1); PG8_STAGE(PG8_SB(1, 0), b3, voffB);
            PG8_BAR; PG8_WAIT_L(0); PG8_MMA(0, 1, At, B1); PG8_BAR;
            PG8_LDA(At, 1, 1); PG8_STAGE(PG8_SA(1, 0), a3, voffA);
            PG8_BAR; PG8_WAIT_L(0); PG8_MMA(1, 0, At, B0); PG8_BAR; PG8_SCHED;
            PG8_STAGE(PG8_SB(1, 1), b3 + hstep, voffB);
            PG8_WAIT_V(6); PG8_BAR; PG8_MMA(1, 1, At, B1); PG8_BAR;
            }
        }
        if constexpr (ALIGN_EPI) { if (wr == 0) PG8_BAR; }
        if constexpr (!Epi::AFTER_DRAIN) { E(acc, cur, wr, wc, fr, fq); S.done(cur); }
        if (!has_next) break;
#pragma unroll
        for (int a = 0; a < 2; ++a)
#pragma unroll
            for (int b = 0; b < 2; ++b)
#pragma unroll
                for (int m = 0; m < 4; ++m)
#pragma unroll
                    for (int n = 0; n < 2; ++n) acc[a][b][m][n] = (f32x4){0.f, 0.f, 0.f, 0.f};
        cur = nxt; cA = nA; cB = nB; ++ui;
        if constexpr (ALIGN_EPI) { if (wr == 1) PG8_BAR; }
    }
    PG8_WAIT_V(0);
    if constexpr (!ALIGN_EPI) { if (wr == 0) PG8_BAR; }
    PG8_BAR;
    if constexpr (Epi::AFTER_DRAIN) { E.fused(acc, cur, wr, wc, fr, fq, lds, wid, lane); S.done(cur); }
#undef PG8_SA
#undef PG8_SB
#undef PG8_STAGE
#undef PG8_LDA
#undef PG8_LDB
#undef PG8_MMA
#undef PG8_WAIT_V
#undef PG8_WAIT_L
#undef PG8_BAR
#undef PG8_SCHED
}
__device__ __forceinline__ float bf2f(unsigned short h) { return __uint_as_float(((unsigned)h) << 16); }
__device__ __forceinline__ float fast_sigmoid(float x) { return __builtin_amdgcn_rcpf(1.0f + __builtin_amdgcn_exp2f(-1.4426950408889634f * x)); }
struct EpiG1 {
    static constexpr bool PERM = true, AFTER_DRAIN = false;
    bf16_t* U; bf16_t* G; const float* bias; const float* ssq;
    __device__ __forceinline__ void operator()(const f32x4 (&acc)[2][2][4][2], const Unit& u, int wr, int wc, int fr, int fq) const {
        const int row0 = u.pm * BM + wr * 64 + fr; int colt = u.pn * BM; const bool isg = colt >= 5376;
        bf16_t* base = U; int ldc = 5376; if (isg) { colt -= 5376; base = G; ldc = 3072; }
        const int col0 = colt + wc * 32 + 8 * fq;
        f32x4 bv[2][2];
#pragma unroll
        for (int bj = 0; bj < 2; ++bj)
#pragma unroll
            for (int n = 0; n < 2; ++n) bv[bj][n] = isg ? *(const f32x4*)(bias + col0 + bj * HALF + 4 * n) : (f32x4){0.f, 0.f, 0.f, 0.f};
        float rsq[2][4];
#pragma unroll
        for (int ai = 0; ai < 2; ++ai)
#pragma unroll
            for (int m = 0; m < 4; ++m) rsq[ai][m] = ssq ? __builtin_amdgcn_rsqf(ssq[row0 + ai * HALF + m * 16] * (1.0f / 1024.0f) + 1e-6f) : 1.0f;
#pragma unroll
        for (int ai = 0; ai < 2; ++ai)
#pragma unroll
            for (int m = 0; m < 4; ++m) { bf16_t* rowp = base + (size_t)(row0 + ai * HALF + m * 16) * ldc + col0;
                const float rs = rsq[ai][m];
#pragma unroll
                for (int bj = 0; bj < 2; ++bj) { f32x4 v0 = acc[ai][bj][m][0] * rs + bv[bj][0], v1 = acc[ai][bj][m][1] * rs + bv[bj][1];
                    if (isg) {
#pragma unroll
                        for (int e = 0; e < 4; ++e) { v0[e] = fast_sigmoid(v0[e]); v1[e] = fast_sigmoid(v1[e]); } }
                    u32x4 w; w.x = cvt_pk_bf16(v0[0], v0[1]); w.y = cvt_pk_bf16(v0[2], v0[3]); w.z = cvt_pk_bf16(v1[0], v1[1]); w.w = cvt_pk_bf16(v1[2], v1[3]);
                    *(u32x4*)(rowp + bj * HALF) = w; } }
    }
};
struct EpiG2 {
    static constexpr bool PERM = true, AFTER_DRAIN = false;
    const bf16_t* G; float* T; bf16_t* Mg; int npan;
    __device__ __forceinline__ void operator()(const f32x4 (&acc)[2][2][4][2], const Unit& u, int wr, int wc, int fr, int fq) const {
        const int b = u.pm / npan, pm = u.pm - b * npan, pn = u.pn & 3;
        const int row0 = pm * BM + wr * 64 + fr, col0 = pn * BM + wc * 32 + 8 * fq;
#pragma unroll
        for (int ai = 0; ai < 2; ++ai)
#pragma unroll
          for (int mh = 0; mh < 2; ++mh) {
            u32x4 gq[4][2], tq[4][2];
#pragma unroll
            for (int m = 2 * mh; m < 2 * mh + 2; ++m)
#pragma unroll
                for (int bj = 0; bj < 2; ++bj) { const size_t row = (size_t)(row0 + ai * HALF + m * 16); const int col = col0 + bj * HALF;
                    gq[m][bj] = *(const u32x4*)(G + row * 3072 + b * 1024 + col);
                    tq[m][bj] = (b > 0) ? *(const u32x4*)(Mg + row * 1024 + col) : (u32x4){0u, 0u, 0u, 0u}; }
            __builtin_amdgcn_sched_barrier(0);
#pragma unroll
            for (int m = 2 * mh; m < 2 * mh + 2; ++m)
#pragma unroll
                for (int bj = 0; bj < 2; ++bj) { const size_t row = (size_t)(row0 + ai * HALF + m * 16); const int col = col0 + bj * HALF; const u32x4 g = gq[m][bj], t = tq[m][bj];
                    f32x4 v0 = acc[ai][bj][m][0], v1 = acc[ai][bj][m][1];
                    v0[0] = v0[0] * __uint_as_float(g.x << 16) + __uint_as_float(t.x << 16); v0[1] = v0[1] * __uint_as_float(g.x & 0xffff0000u) + __uint_as_float(t.x & 0xffff0000u);
                    v0[2] = v0[2] * __uint_as_float(g.y << 16) + __uint_as_float(t.y << 16); v0[3] = v0[3] * __uint_as_float(g.y & 0xffff0000u) + __uint_as_float(t.y & 0xffff0000u);
                    v1[0] = v1[0] * __uint_as_float(g.z << 16) + __uint_as_float(t.z << 16); v1[1] = v1[1] * __uint_as_float(g.z & 0xffff0000u) + __uint_as_float(t.z & 0xffff0000u);
                    v1[2] = v1[2] * __uint_as_float(g.w << 16) + __uint_as_float(t.w << 16); v1[3] = v1[3] * __uint_as_float(g.w & 0xffff0000u) + __uint_as_float(t.w & 0xffff0000u);
                    u32x4 w; w.x = cvt_pk_bf16(v0[0], v0[1]); w.y = cvt_pk_bf16(v0[2], v0[3]); w.z = cvt_pk_bf16(v1[0], v1[1]); w.w = cvt_pk_bf16(v1[2], v1[3]);
                    *(u32x4*)(Mg + row * 1024 + col) = w; }
            __builtin_amdgcn_sched_barrier(0); }
    }
};
struct OrderG2 {
    int npan, G, c;
    __device__ bool next(int i, Unit& u) const { const int ti = i / 3, b = i - 3 * ti, t = ti * G + c; if (t >= npan * 4) return false;
        const int pm = t >> 2, pn = t & 3; u.pm = b * npan + pm; u.pn = b * 4 + pn; return true; }
    __device__ __forceinline__ void a_ready(const Unit&) const {}
    __device__ __forceinline__ void done(const Unit&) const {}
};
struct EpiG3 {
    static constexpr bool PERM = true, AFTER_DRAIN = false;
    const float* X; float* O; const float* gn; bf16_t* HN; float* ssq; int fuse;
    __device__ __forceinline__ void operator()(const f32x4 (&acc)[2][2][4][2], const Unit& u, int wr, int wc, int fr, int fq) const {
        const int row0 = u.pm * BM + wr * 64 + fr, col0 = u.pn * BM + wc * 32 + 8 * fq;
        f32x4 gv[2][2];
#pragma unroll
        for (int bj = 0; bj < 2; ++bj)
#pragma unroll
            for (int n = 0; n < 2; ++n) gv[bj][n] = fuse ? *(const f32x4*)(gn + col0 + bj * HALF + 4 * n) : (f32x4){0.f, 0.f, 0.f, 0.f};
#pragma unroll
        for (int ai = 0; ai < 2; ++ai)
#pragma unroll
         for (int mh = 0; mh < 2; ++mh) {
          f32x4 xq[4][2][2];
#pragma unroll
          for (int m = 2 * mh; m < 2 * mh + 2; ++m)
#pragma unroll
              for (int bj = 0; bj < 2; ++bj) { const size_t p = (size_t)(row0 + ai * HALF + m * 16) * 1024 + col0 + bj * HALF; xq[m][bj][0] = *(const f32x4*)(X + p); xq[m][bj][1] = *(const f32x4*)(X + p + 4); }
          __builtin_amdgcn_sched_barrier(0);
#pragma unroll
            for (int m = 2 * mh; m < 2 * mh + 2; ++m) { const size_t row = (size_t)(row0 + ai * HALF + m * 16); float sq = 0.f;
#pragma unroll
                for (int bj = 0; bj < 2; ++bj) { const size_t p = row * 1024 + col0 + bj * HALF;
                    const f32x4 x0 = xq[m][bj][0], x1 = xq[m][bj][1];
                    const f32x4 o0 = x0 + acc[ai][bj][m][0], o1 = x1 + acc[ai][bj][m][1];
                    *(f32x4*)(O + p) = o0; *(f32x4*)(O + p + 4) = o1;
                    if (fuse) { const f32x4 h0 = o0 * gv[bj][0], h1 = o1 * gv[bj][1];
                        u32x4 w; w.x = cvt_pk_bf16(h0[0], h0[1]); w.y = cvt_pk_bf16(h0[2], h0[3]); w.z = cvt_pk_bf16(h1[0], h1[1]); w.w = cvt_pk_bf16(h1[2], h1[3]);
                        *(u32x4*)(HN + p) = w;
                        sq += (o0[0] * o0[0] + o0[1] * o0[1]) + (o0[2] * o0[2] + o0[3] * o0[3]) + (o1[0] * o1[0] + o1[1] * o1[1]) + (o1[2] * o1[2] + o1[3] * o1[3]); } }
                if (fuse) { sq += shx(sq, 16); sq += shx(sq, 32); if (fq == 0) atomicAdd(ssq + row, sq); } }
          __builtin_amdgcn_sched_barrier(0); }
    }
};
struct EpiAll {
    static constexpr bool PERM = true, AFTER_DRAIN = false;
    int mode; EpiG1 e1; EpiG2 e2; EpiG3 e3;
    __device__ __forceinline__ void operator()(const f32x4 (&acc)[2][2][4][2], const Unit& u, int wr, int wc, int fr, int fq) const {
        if (mode == 1) e1(acc, u, wr, wc, fr, fq); else if (mode == 2) e2(acc, u, wr, wc, fr, fq); else e3(acc, u, wr, wc, fr, fq); }
};
struct OrderAll {
    int mode; StaticOrder so; OrderG2 o2;
    __device__ __forceinline__ bool next(int i, Unit& u) const { return mode == 2 ? o2.next(i, u) : so.next(i, u); }
    __device__ __forceinline__ void a_ready(const Unit&) const {}
    __device__ __forceinline__ void done(const Unit&) const {}
};
}
#ifndef DUP_MASK
#define DUP_MASK 0
#endif
#ifndef EN_MASK
#define EN_MASK 0xffff
#endif
#define EN(i) ((EN_MASK >> (i)) & 1)
#define LAS __attribute__((address_space(3)))
typedef unsigned short bf16;
typedef float f32x4 __attribute__((ext_vector_type(4)));
typedef float f32x2 __attribute__((ext_vector_type(2)));
typedef unsigned u32x4 __attribute__((ext_vector_type(4)));
typedef unsigned u32x2 __attribute__((ext_vector_type(2)));
constexpr int DM = 1024, NTOK_P = 65536, NTOK_S = 32768, NTOK = NTOK_P + NTOK_S, LP = 8192, LS = 2048;
constexpr int CH = 16384, NCHUNK = NTOK / CH, NCH_P = NTOK_P / CH;
constexpr int UP = 5376, NCAT = 8448, GP = 3072;
constexpr int C_X0 = 0, C_X1 = 512, C_HV = 1024, C_HG = 1536, C_GQ = 2048, C_GK = 2560, C_GV = 2688, C_GG = 2816, C_DQ = 3328, C_DK = 3840, C_DV = 4352, C_DG = 4864;
constexpr float EPS = 1e-6f, LOG2E = 1.4426950408889634f;
constexpr int NT = 512, NWAVES = 8;
enum { I_XP = 0, I_XS, I_RELB, I_NORMG, I_WIN, I_CONVW, I_CONVB, I_FW1, I_FB1, I_FW2, I_FB2, I_FWOUT, I_FFREQ, I_HYBIAS, I_QNG, I_KNG, I_LQ1, I_LK1, I_LQ2, I_LK2, I_SUBLN, I_WBHY, I_WBGQ, I_WBDF, I_WMERGE, I_BMERGE, I_WOUT, I_FINALG, N_IN };
constexpr size_t MiB = 1u << 20;
constexpr size_t WS_CTL = 0, CTL_BYTES = 64 * 1024;
constexpr size_t WS_TW = 1 * MiB;
constexpr size_t WS_WCAT = 2 * MiB, WCAT_BYTES = (size_t)NCAT * 1024 * 2;
constexpr size_t WS_WBT = 40 * MiB, WBT_BYTES = (size_t)3 * 1024 * 512 * 2;
constexpr size_t WS_WOT = 46 * MiB, WOT_BYTES = (size_t)1024 * 1024 * 2;
constexpr int SPS_P = LP + 16, SPS_S = LS + 16;
constexpr size_t SPEC_P_BYTES = (size_t)256 * SPS_P * 8, SPEC_S_BYTES = (size_t)256 * SPS_S * 8;
constexpr size_t SPEC_LAYER = 2 * SPEC_P_BYTES + 2 * SPEC_S_BYTES;
constexpr size_t WS_SPEC = 52 * MiB;
constexpr size_t WS_HN = 140 * MiB, WS_U = 172 * MiB, WS_G = 340 * MiB, WS_Y = 436 * MiB, WS_MG = 484 * MiB, WS_TMP = 516 * MiB, WS_DT = 580 * MiB, WS_HVP = 612 * MiB, WS_PMP = 644 * MiB, WS_ROPE = 676 * MiB, WS_HN0 = 680 * MiB, WS_END = 872 * MiB;
constexpr size_t HF_P_BYTES = (size_t)LP * 1024 * 4, HF_S_BYTES = (size_t)LS * 1024 * 4;
static_assert(WS_WCAT + 2 * WCAT_BYTES <= WS_WBT && WS_WBT + 2 * WBT_BYTES <= WS_WOT && WS_WOT + 2 * WOT_BYTES <= WS_SPEC && WS_SPEC + 2 * SPEC_LAYER <= WS_HN, "ws map");
static_assert(WS_HN + (size_t)CH * 1024 * 2 <= WS_U && WS_U + (size_t)CH * UP * 2 <= WS_G && WS_G + (size_t)CH * GP * 2 <= WS_Y && WS_Y + (size_t)3 * CH * 512 * 2 <= WS_MG && WS_MG + (size_t)CH * 1024 * 2 <= WS_TMP && WS_TMP + (size_t)CH * 1024 * 4 <= WS_DT && WS_DT + (size_t)CH * 512 * 4 <= WS_END, "ws map 2");
static_assert(2 * (HF_P_BYTES + HF_S_BYTES) <= (size_t)CH * UP * 2, "hf overlay");
constexpr size_t WS_SSQ = WS_TMP;
constexpr int LDS_MAIN = 139264, LDS_BYTES = LDS_MAIN + 1024;
constexpr int CW_BAR = 4096;

struct Args { const float* in[N_IN]; float* out; unsigned char* ws; int lo, hi; };
typedef const __attribute__((address_space(4))) unsigned long long* kargp_t;
struct AV { kargp_t p; };
#define AIN(i) ((const float*)(a.p[(i)]))
#define AOUT ((float*)(a.p[N_IN]))
#define AWS ((unsigned char*)(a.p[N_IN + 1]))


__device__ __forceinline__ float bf2f(unsigned short h) { return __uint_as_float(((unsigned)h) << 16); }
__device__ __forceinline__ float bflo(unsigned w) { return __uint_as_float(w << 16); }
__device__ __forceinline__ float bfhi(unsigned w) { return __uint_as_float(w & 0xffff0000u); }
__device__ __forceinline__ unsigned f2bf(float f) { unsigned u = __builtin_bit_cast(unsigned, f); return (u + 0x7fffu + ((u >> 16) & 1u)) >> 16; }
__device__ __forceinline__ unsigned pk2(float lo, float hi) { return f2bf(lo) | (f2bf(hi) << 16); }
__device__ __forceinline__ float silu(float x) { return x * __builtin_amdgcn_rcpf(1.0f + __builtin_amdgcn_exp2f(-LOG2E * x)); }
__device__ __forceinline__ float wave_sum(float v) {
#pragma unroll
    for (int o = 1; o < 64; o <<= 1) v += shx(v, o);
    return v;
}
__device__ __forceinline__ double kd(double v) { asm volatile("" : "+s"(v)); return v; }
__device__ __forceinline__ void sincos_rev(double r, float& s, float& c) {
    r -= __builtin_rint(r);
    const double k = __builtin_rint(r * 4.0);
    const double x = (r - k * 0.25) * kd(6.283185307179586476925);
    const double x2 = x * x;
    double sp = kd(1.0 / 6227020800.0); sp = sp * x2 + kd(-1.0 / 39916800); sp = sp * x2 + kd(1.0 / 362880); sp = sp * x2 + kd(-1.0 / 5040); sp = sp * x2 + kd(1.0 / 120); sp = sp * x2 + kd(-1.0 / 6); sp = sp * x2 + 1.0; sp *= x;
    double cp = kd(-1.0 / 87178291200.0); cp = cp * x2 + kd(1.0 / 479001600.0); cp = cp * x2 + kd(-1.0 / 3628800); cp = cp * x2 + kd(1.0 / 40320); cp = cp * x2 + kd(-1.0 / 720); cp = cp * x2 + kd(1.0 / 24); cp = cp * x2 + (-0.5); cp = cp * x2 + 1.0;
    const int q = ((int)k) & 3;
    const float sf = (float)sp, cf = (float)cp;
    s = (q == 0) ? sf : (q == 1) ? cf : (q == 2) ? -sf : -cf;
    c = (q == 0) ? cf : (q == 1) ? -sf : (q == 2) ? -cf : sf;
}
__device__ __forceinline__ float sin_acc(float x) { float s, c; sincos_rev((double)x * 0.15915494309189533577, s, c); return s; }

__device__ __forceinline__ void transpose_item(const float* W, int K, int N, bf16* WT, int row_off, LAS float* scr, int item, int lane) {
    const int nblk = N / 32, kb = item / nblk, nb = item % nblk, k0 = 64 * kb, n0 = 32 * nb;
#pragma unroll 8
    for (int i = 0; i < 32; ++i) { const int kk = 2 * i + (lane >> 5); scr[kk * 33 + (lane & 31)] = W[(size_t)(k0 + kk) * N + n0 + (lane & 31)]; }
    asm volatile("s_waitcnt lgkmcnt(0)" ::: "memory");
    const int c = lane & 7;
#pragma unroll
    for (int j = 0; j < 4; ++j) { const int n = (lane >> 3) + 8 * j; const LAS float* s = scr + (8 * c) * 33 + n;
        u32x4 o; o.x = pk2(s[0 * 33], s[1 * 33]); o.y = pk2(s[2 * 33], s[3 * 33]); o.z = pk2(s[4 * 33], s[5 * 33]); o.w = pk2(s[6 * 33], s[7 * 33]);
        *(u32x4*)(WT + (size_t)(row_off + n0 + n) * K + k0 + 8 * c) = o; }
    asm volatile("s_waitcnt lgkmcnt(0)" ::: "memory");
}

__device__ __forceinline__ f32x2 cmul(f32x2 a, f32x2 b) { return (f32x2){a.x * b.x - a.y * b.y, a.x * b.y + a.y * b.x}; }
__device__ __forceinline__ f32x2 cmulc(f32x2 a, f32x2 b) { return (f32x2){a.x * b.x + a.y * b.y, a.y * b.x - a.x * b.y}; }
__device__ __forceinline__ f32x2 cconj(f32x2 a) { return (f32x2){a.x, -a.y}; }
template <int LOG4> __device__ __forceinline__ int digitrev(int k) { unsigned x = __builtin_bitreverse32((unsigned)k) >> (32 - 2 * LOG4); return (int)(((x & 0x55555555u) << 1) | ((x >> 1) & 0x55555555u)); }
__device__ __forceinline__ unsigned cvtpk(float lo, float hi);
#define PADI(i) ((i) + ((i) >> 4))
#define W16C 0.92387953251128674f
#define W16S 0.38268343236508977f
#define W16H 0.70710678118654752f
__device__ __forceinline__ f32x2 w16(int m) { return m == 0 ? (f32x2){1.f, 0.f} : m == 1 ? (f32x2){W16C, -W16S} : m == 2 ? (f32x2){W16H, -W16H} : m == 3 ? (f32x2){W16S, -W16C} : m == 4 ? (f32x2){0.f, -1.f} : m == 6 ? (f32x2){-W16H, -W16H} : (f32x2){-W16C, W16S}; }
__device__ __forceinline__ void bfly_fwd(f32x2& a0, f32x2& a1, f32x2& a2, f32x2& a3) {
    const f32x2 t0 = a0 + a2, t1 = a0 - a2, t2 = a1 + a3, t3 = a1 - a3;
    a0 = t0 + t2; a2 = t0 - t2; a1 = (f32x2){t1.x + t3.y, t1.y - t3.x}; a3 = (f32x2){t1.x - t3.y, t1.y + t3.x};
}
__device__ __forceinline__ void bfly_inv(f32x2& b0, f32x2& b1, f32x2& b2, f32x2& b3) {
    const f32x2 t0 = b0 + b2, t1 = b0 - b2, t2 = b1 + b3, t3 = b1 - b3;
    b0 = t0 + t2; b2 = t0 - t2; b1 = (f32x2){t1.x - t3.y, t1.y + t3.x}; b3 = (f32x2){t1.x + t3.y, t1.y - t3.x};
}
template <int LOG4, int BATCH = 1, int PS0 = 0> __device__ __forceinline__ void fft_fwd(LAS f32x2* buf, const f32x2* __restrict__ tw, int tid) {
    constexpr int N = 1 << (2 * LOG4), TWS = 16384 / N;
    constexpr int NPAD = N + N / 16, NLEV = LOG4 - 2, NP16 = NLEV / 2;
#pragma unroll 1
    for (int ps = PS0; ps < NP16; ++ps) {
        const int lq4 = 2 * (LOG4 - 2 * ps) - 2, lq16 = lq4 - 2, q4 = 1 << lq4, q16 = 1 << lq16, tsA = TWS << (4 * ps), tsB = tsA << 2;
        constexpr int TOT = BATCH * N / 16, IT = (TOT + NT - 1) / NT;
#pragma unroll
        for (int i = 0; i < IT; ++i) { const int jg = tid + i * NT; if (TOT % NT != 0 && jg >= TOT) break; const int bo = (jg >> (2 * LOG4 - 4)) * NPAD, j = jg & (N / 16 - 1);
            const int blk = j >> lq16, jj = j & (q16 - 1), base = (blk << (lq4 + 2)) + jj;
            f32x2 wa[4], wb = tw[jj * tsB];
#pragma unroll
            for (int b = 0; b < 4; ++b) wa[b] = tw[(jj + b * q16) * tsA];
            f32x2 e[4][4];
#pragma unroll
            for (int a = 0; a < 4; ++a)
#pragma unroll
                for (int b = 0; b < 4; ++b) e[a][b] = buf[bo + PADI(base + b * q16 + a * q4)];
#pragma unroll
            for (int b = 0; b < 4; ++b) { bfly_fwd(e[0][b], e[1][b], e[2][b], e[3][b]); const f32x2 w2 = cmul(wa[b], wa[b]), w3 = cmul(w2, wa[b]); e[1][b] = cmul(e[1][b], wa[b]); e[2][b] = cmul(e[2][b], w2); e[3][b] = cmul(e[3][b], w3); }
            { const f32x2 w2 = cmul(wb, wb), w3 = cmul(w2, wb);
#pragma unroll
              for (int a = 0; a < 4; ++a) { bfly_fwd(e[a][0], e[a][1], e[a][2], e[a][3]); e[a][1] = cmul(e[a][1], wb); e[a][2] = cmul(e[a][2], w2); e[a][3] = cmul(e[a][3], w3); } }
#pragma unroll
            for (int a = 0; a < 4; ++a)
#pragma unroll
                for (int b = 0; b < 4; ++b) buf[bo + PADI(base + b * q16 + a * q4)] = e[a][b];
        }
        __syncthreads();
    }
#pragma unroll 1
    for (int pass = 2 * NP16; pass < NLEV; ++pass) {
        const int lq = 2 * (LOG4 - pass) - 2, q4 = 1 << lq, n = q4 << 2, tstep = TWS << (2 * pass);
        constexpr int IT = BATCH * N / 4 / NT;
        f32x2 wl[IT];
#pragma unroll
        for (int i = 0; i < IT; ++i) wl[i] = tw[((tid + i * NT) & (q4 - 1)) * tstep];
#pragma unroll
        for (int i = 0; i < IT; ++i) { const int jg = tid + i * NT, bo = (jg >> (2 * LOG4 - 2)) * NPAD, j = jg & (N / 4 - 1);
            const int blk = j >> lq, jj = j & (q4 - 1), base = blk * n + jj;
            const int i0 = bo + PADI(base), i1 = bo + PADI(base + q4), i2 = bo + PADI(base + 2 * q4), i3 = bo + PADI(base + 3 * q4);
            const f32x2 w1 = wl[i];
            f32x2 a0 = buf[i0], a1 = buf[i1], a2 = buf[i2], a3 = buf[i3];
            bfly_fwd(a0, a1, a2, a3);
            const f32x2 w2 = cmul(w1, w1), w3 = cmul(w2, w1);
            buf[i0] = a0; buf[i1] = cmul(a1, w1); buf[i2] = cmul(a2, w2); buf[i3] = cmul(a3, w3);
        }
        __syncthreads();
    }
#pragma unroll 1
    for (int b = tid; b < BATCH * N / 16; b += NT) {
        LAS f32x2* xb = buf + 17 * b; f32x2 x[16];
#pragma unroll
        for (int e = 0; e < 16; ++e) x[e] = xb[e];
#pragma unroll
        for (int jj = 0; jj < 4; ++jj) { bfly_fwd(x[jj], x[jj + 4], x[jj + 8], x[jj + 12]); if (jj) { x[jj + 4] = cmul(x[jj + 4], w16(jj)); x[jj + 8] = cmul(x[jj + 8], w16(2 * jj)); x[jj + 12] = cmul(x[jj + 12], w16(3 * jj)); } }
#pragma unroll
        for (int q = 0; q < 4; ++q) bfly_fwd(x[4 * q], x[4 * q + 1], x[4 * q + 2], x[4 * q + 3]);
#pragma unroll
        for (int e = 0; e < 16; ++e) xb[e] = x[e];
    }
    __syncthreads();
}
template <int LOG4, int BATCH = 1, int PS0 = 0> __device__ __forceinline__ void fft_inv(LAS f32x2* buf, const f32x2* __restrict__ tw, int tid) {
    constexpr int N = 1 << (2 * LOG4), TWS = 16384 / N;
#pragma unroll 1
    for (int b = tid; b < BATCH * N / 16; b += NT) {
        LAS f32x2* xb = buf + 17 * b; f32x2 x[16];
#pragma unroll
        for (int e = 0; e < 16; ++e) x[e] = xb[e];
#pragma unroll
        for (int q = 0; q < 4; ++q) bfly_inv(x[4 * q], x[4 * q + 1], x[4 * q + 2], x[4 * q + 3]);
#pragma unroll
        for (int jj = 0; jj < 4; ++jj) { if (jj) { x[jj + 4] = cmulc(x[jj + 4], w16(jj)); x[jj + 8] = cmulc(x[jj + 8], w16(2 * jj)); x[jj + 12] = cmulc(x[jj + 12], w16(3 * jj)); } bfly_inv(x[jj], x[jj + 4], x[jj + 8], x[jj + 12]); }
#pragma unroll
        for (int e = 0; e < 16; ++e) xb[e] = x[e];
    }
    __syncthreads();
    constexpr int NPAD = N + N / 16, NLEV = LOG4 - 2, NP16 = NLEV / 2;
#pragma unroll 1
    for (int pass = NLEV - 1; pass >= 2 * NP16; --pass) {
        const int lq = 2 * (LOG4 - pass) - 2, q4 = 1 << lq, n = q4 << 2, tstep = TWS << (2 * pass);
        constexpr int IT = BATCH * N / 4 / NT;
        f32x2 wl[IT];
#pragma unroll
        for (int i = 0; i < IT; ++i) wl[i] = tw[((tid + i * NT) & (q4 - 1)) * tstep];
#pragma unroll
        for (int i = 0; i < IT; ++i) { const int jg = tid + i * NT, bo = (jg >> (2 * LOG4 - 2)) * NPAD, j = jg & (N / 4 - 1);
            const int blk = j >> lq, jj = j & (q4 - 1), base = blk * n + jj;
            const int i0 = bo + PADI(base), i1 = bo + PADI(base + q4), i2 = bo + PADI(base + 2 * q4), i3 = bo + PADI(base + 3 * q4);
            const f32x2 w1 = wl[i];
            const f32x2 w2 = cmul(w1, w1), w3 = cmul(w2, w1);
            f32x2 b0 = buf[i0], b1 = cmulc(buf[i1], w1), b2 = cmulc(buf[i2], w2), b3 = cmulc(buf[i3], w3);
            bfly_inv(b0, b1, b2, b3);
            buf[i0] = b0; buf[i1] = b1; buf[i2] = b2; buf[i3] = b3;
        }
        __syncthreads();
    }
#pragma unroll 1
    for (int ps = NP16 - 1; ps >= PS0; --ps) {
        const int lq4 = 2 * (LOG4 - 2 * ps) - 2, lq16 = lq4 - 2, q4 = 1 << lq4, q16 = 1 << lq16, tsA = TWS << (4 * ps), tsB = tsA << 2;
        constexpr int TOT = BATCH * N / 16, IT = (TOT + NT - 1) / NT;
#pragma unroll
        for (int i = 0; i < IT; ++i) { const int jg = tid + i * NT; if (TOT % NT != 0 && jg >= TOT) break; const int bo = (jg >> (2 * LOG4 - 4)) * NPAD, j = jg & (N / 16 - 1);
            const int blk = j >> lq16, jj = j & (q16 - 1), base = (blk << (lq4 + 2)) + jj;
            f32x2 wa[4], wb = tw[jj * tsB];
#pragma unroll
            for (int b = 0; b < 4; ++b) wa[b] = tw[(jj + b * q16) * tsA];
            f32x2 e[4][4];
#pragma unroll
            for (int a = 0; a < 4; ++a)
#pragma unroll
                for (int b = 0; b < 4; ++b) e[a][b] = buf[bo + PADI(base + b * q16 + a * q4)];
            { const f32x2 w2 = cmul(wb, wb), w3 = cmul(w2, wb);
#pragma unroll
              for (int a = 0; a < 4; ++a) { e[a][1] = cmulc(e[a][1], wb); e[a][2] = cmulc(e[a][2], w2); e[a][3] = cmulc(e[a][3], w3); bfly_inv(e[a][0], e[a][1], e[a][2], e[a][3]); } }
#pragma unroll
            for (int b = 0; b < 4; ++b) { const f32x2 w2 = cmul(wa[b], wa[b]), w3 = cmul(w2, wa[b]); e[1][b] = cmulc(e[1][b], wa[b]); e[2][b] = cmulc(e[2][b], w2); e[3][b] = cmulc(e[3][b], w3); bfly_inv(e[0][b], e[1][b], e[2][b], e[3][b]); }
#pragma unroll
            for (int a = 0; a < 4; ++a)
#pragma unroll
                for (int b = 0; b < 4; ++b) buf[bo + PADI(base + b * q16 + a * q4)] = e[a][b];
        }
        __syncthreads();
    }
}
template <int LOG4> __device__ __forceinline__ void fft_first_from_global(LAS f32x2* buf, const f32x2* __restrict__ tw, const f32x2* __restrict__ src, int tid) {
    constexpr int N = 1 << (2 * LOG4), TWS = 16384 / N, q4 = N / 4, q16 = N / 16, IT = N / 16 / NT;
    static_assert(N / 16 % NT == 0, "one or more items per thread");
#pragma unroll
    for (int i = 0; i < IT; ++i) { const int jj = tid + i * NT;
        f32x2 wa[4], wb = tw[jj * (TWS << 2)];
#pragma unroll
        for (int b = 0; b < 4; ++b) wa[b] = tw[(jj + b * q16) * TWS];
        f32x2 e[4][4];
#pragma unroll
        for (int b = 0; b < 4; ++b) { e[0][b] = src[jj + b * q16]; e[1][b] = src[jj + b * q16 + q4]; e[2][b] = (f32x2){0.f, 0.f}; e[3][b] = (f32x2){0.f, 0.f}; }
#pragma unroll
        for (int b = 0; b < 4; ++b) { bfly_fwd(e[0][b], e[1][b], e[2][b], e[3][b]); const f32x2 w2 = cmul(wa[b], wa[b]), w3 = cmul(w2, wa[b]); e[1][b] = cmul(e[1][b], wa[b]); e[2][b] = cmul(e[2][b], w2); e[3][b] = cmul(e[3][b], w3); }
        { const f32x2 w2 = cmul(wb, wb), w3 = cmul(w2, wb);
#pragma unroll
          for (int a = 0; a < 4; ++a) { bfly_fwd(e[a][0], e[a][1], e[a][2], e[a][3]); e[a][1] = cmul(e[a][1], wb); e[a][2] = cmul(e[a][2], w2); e[a][3] = cmul(e[a][3], w3); } }
#pragma unroll
        for (int a = 0; a < 4; ++a)
#pragma unroll
            for (int b = 0; b < 4; ++b) buf[PADI(jj + b * q16 + a * q4)] = e[a][b];
    }
    __syncthreads();
}
template <int LOG4> __device__ __forceinline__ void fft_last_to_global(const LAS f32x2* buf, const f32x2* __restrict__ tw, const f32x2* __restrict__ pm, bf16* Yc, int tid) {
    constexpr int N = 1 << (2 * LOG4), TWS = 16384 / N, q4 = N / 4, q16 = N / 16, IT = N / 16 / NT;
#pragma unroll
    for (int i = 0; i < IT; ++i) { const int jj = tid + i * NT;
        f32x2 wa[4], wb = tw[jj * (TWS << 2)];
#pragma unroll
        for (int b = 0; b < 4; ++b) wa[b] = tw[(jj + b * q16) * TWS];
        f32x2 pmv[2][4];
#pragma unroll
        for (int a = 0; a < 2; ++a)
#pragma unroll
            for (int b = 0; b < 4; ++b) pmv[a][b] = pm[jj + b * q16 + a * q4];
        f32x2 e[4][4];
#pragma unroll
        for (int a = 0; a < 4; ++a)
#pragma unroll
            for (int b = 0; b < 4; ++b) e[a][b] = buf[PADI(jj + b * q16 + a * q4)];
        { const f32x2 w2 = cmul(wb, wb), w3 = cmul(w2, wb);
#pragma unroll
          for (int a = 0; a < 4; ++a) { e[a][1] = cmulc(e[a][1], wb); e[a][2] = cmulc(e[a][2], w2); e[a][3] = cmulc(e[a][3], w3); bfly_inv(e[a][0], e[a][1], e[a][2], e[a][3]); } }
#pragma unroll
        for (int b = 0; b < 4; ++b) { const f32x2 w2 = cmul(wa[b], wa[b]), w3 = cmul(w2, wa[b]); e[1][b] = cmulc(e[1][b], wa[b]); e[2][b] = cmulc(e[2][b], w2); e[3][b] = cmulc(e[3][b], w3); bfly_inv(e[0][b], e[1][b], e[2][b], e[3][b]); }
#pragma unroll
        for (int a = 0; a < 2; ++a)
#pragma unroll
            for (int b = 0; b < 4; ++b) { const int t = jj + b * q16 + a * q4; *(unsigned*)(Yc + (size_t)t * 512) = cvtpk(e[a][b].x * pmv[a][b].x, e[a][b].y * pmv[a][b].y); }
    }
}
__device__ const double ROPE_IF[16] = {1.0, 0.5623413251903491, 0.31622776601683794, 0.1778279410038923, 0.1, 0.05623413251903491, 0.03162277660168379, 0.01778279410038923,
    0.01, 0.005623413251903491, 0.0031622776601683794, 0.0017782794100389228, 0.001, 0.0005623413251903491, 0.00031622776601683794, 0.00017782794100389227};
struct Chunk { int tok0, L, nseq; };
__device__ __forceinline__ Chunk chunk_of(int c) { Chunk k; k.tok0 = c * CH; if (c < NCH_P) { k.L = LP; k.nseq = CH / LP; } else { k.L = LS; k.nseq = CH / LS; } return k; }
__device__ __forceinline__ const float* xin_rows(const AV& a, int tok0) { return tok0 < NTOK_P ? AIN(I_XP) + (size_t)tok0 * DM : AIN(I_XS) + (size_t)(tok0 - NTOK_P) * DM; }
__device__ __forceinline__ void hf_group(LAS float* sm, const AV& a, int layer, int L, int t0, float* hf, int tid) {
    LAS float* zs = sm; LAS float* A = sm + 512; LAS float* B = sm + 1024;
    const float* w1 = AIN(I_FW1) + layer * 33 * 64; const float* b1 = AIN(I_FB1) + layer * 64;
    const float* w2 = AIN(I_FW2) + layer * 2 * 64 * 64; const float* b2 = AIN(I_FB2) + layer * 2 * 64;
    const float* wo = AIN(I_FWOUT) + layer * 64 * 1024; const float* fr = AIN(I_FFREQ) + layer * 64;
    const int tt = tid >> 6, j = tid & 63, t = t0 + tt;
    const float t01 = (float)t / (float)(L - 1);
    if (j < 33) {
        float v;
        if (j == 0) v = t01;
        else { const int k = (j - 1) & 15; const double f = kd(1e-4) + (double)k * kd((15.0 - 1e-4) / 15.0); float s, c; sincos_rev(f * (double)t / (double)L, s, c); v = (j <= 16) ? c : -s; }
        zs[tt * 40 + j] = v;
    }
    __syncthreads();
    const float fq = fr[j];
    { float acc = b1[j]; for (int i = 0; i < 33; ++i) acc += zs[tt * 40 + i] * w1[i * 64 + j]; A[tt * 64 + j] = sin_acc(fq * acc); }
    __syncthreads();
    { float acc = b2[j]; for (int i = 0; i < 64; ++i) acc += A[tt * 64 + i] * w2[i * 64 + j]; B[tt * 64 + j] = sin_acc(fq * acc); }
    __syncthreads();
    { float acc = b2[64 + j]; for (int i = 0; i < 64; ++i) acc += B[tt * 64 + i] * w2[4096 + i * 64 + j]; A[tt * 64 + j] = sin_acc(fq * acc); }
    __syncthreads();
    { float acc0[8], acc1[8];
#pragma unroll
      for (int q = 0; q < 8; ++q) { acc0[q] = 0.f; acc1[q] = 0.f; }
#pragma unroll 8
      for (int i = 0; i < 64; ++i) { const float wa = wo[i * 1024 + tid], wb = wo[i * 1024 + 512 + tid];
#pragma unroll
          for (int q = 0; q < 8; ++q) { const float av = A[q * 64 + i]; acc0[q] += av * wa; acc1[q] += av * wb; } }
      const float ad = 3.070113457325394f + (float)tid * ((15.350567286626973f - 3.070113457325394f) / 511.0f);
#pragma unroll
      for (int q = 0; q < 8; ++q) { const float tq = (float)(t0 + q) / (float)(L - 1); const float win = __expf(-tq * ad);
          hf[(size_t)(t0 + q) * 1024 + tid] = acc0[q] * win; hf[(size_t)(t0 + q) * 1024 + 512 + tid] = acc1[q] * win; } }
    __syncthreads();
}
__device__ __forceinline__ void step_pro_a(const AV& a, LAS unsigned char* lds) {
    const int tid = ltid(), lane = tid & 63, wave = tid >> 6, G = gridDim.x;
    unsigned char* ws = AWS;
    { f32x2* tw = (f32x2*)(ws + WS_TW); for (int m = lbid() * NT + tid; m < 16384; m += G * NT) { float s, c; sincos_rev((double)m / 16384.0, s, c); tw[m] = (f32x2){c, -s}; } }
    { f32x2* rt = (f32x2*)(ws + WS_ROPE);
      for (int e = lbid() * NT + tid; e < 8192 * 32; e += G * NT) { const int pos = e >> 5, i = e & 31; const int pp = (i < 16) ? (pos >> 6) : (pos & 63);
          const double inv = ROPE_IF[i & 15]; float sn, cs; sincos_rev((double)pp * inv * 0.15915494309189533577, sn, cs); rt[e] = (f32x2){cs, sn}; } }
    { const float* g = AIN(I_NORMG); bf16* HN0 = (bf16*)(ws + WS_HN0); f32x4 gv[4];
#pragma unroll
      for (int j = 0; j < 4; ++j) gv[j] = *((const f32x4*)g + lane + 64 * j);
      for (int m = lbid() * NWAVES + wave; m < NTOK; m += G * NWAVES) {
          const f32x4* xr = (const f32x4*)(xin_rows(a, m)) + lane; f32x4 v[4]; float ssum = 0.f;
#pragma unroll
          for (int j = 0; j < 4; ++j) { v[j] = xr[64 * j]; ssum += (v[j].x * v[j].x + v[j].y * v[j].y) + (v[j].z * v[j].z + v[j].w * v[j].w); }
          const float rs = 1.0f / sqrtf(wave_sum(ssum) * (1.0f / DM) + EPS);
          u32x2* o8 = (u32x2*)(HN0 + (size_t)m * DM) + lane;
#pragma unroll
          for (int j = 0; j < 4; ++j) { u32x2 w; w.x = pk2(v[j].x * rs * gv[j].x, v[j].y * rs * gv[j].y); w.y = pk2(v[j].z * rs * gv[j].z, v[j].w * rs * gv[j].w); o8[64 * j] = w; } } }
    { LAS float* scr = (LAS float*)(lds + wave * 16384);
      constexpr int I_IN = 16 * (UP / 32), I_MG = 16 * (GP / 32), I_BR = 8 * 32, I_OU = 16 * 32, PER = I_IN + I_MG + 3 * I_BR + I_OU;
      for (int it = lbid() * NWAVES + wave; it < 2 * PER; it += G * NWAVES) {
          const int l = it / PER; int r = it - l * PER;
          bf16* wcat = (bf16*)(ws + WS_WCAT + l * WCAT_BYTES); bf16* wbt = (bf16*)(ws + WS_WBT + l * WBT_BYTES); bf16* wot = (bf16*)(ws + WS_WOT + l * WOT_BYTES);
          if (r < I_IN) { transpose_item(AIN(I_WIN) + (size_t)l * 1024 * UP, 1024, UP, wcat, 0, scr, r, lane); continue; } r -= I_IN;
          if (r < I_MG) { transpose_item(AIN(I_WMERGE) + (size_t)l * 1024 * GP, 1024, GP, wcat, UP, scr, r, lane); continue; } r -= I_MG;
          if (r < I_BR) { transpose_item(AIN(I_WBHY) + (size_t)l * 512 * 1024, 512, 1024, wbt, 0, scr, r, lane); continue; } r -= I_BR;
          if (r < I_BR) { transpose_item(AIN(I_WBGQ) + (size_t)l * 512 * 1024, 512, 1024, wbt, 1024, scr, r, lane); continue; } r -= I_BR;
          if (r < I_BR) { transpose_item(AIN(I_WBDF) + (size_t)l * 512 * 1024, 512, 1024, wbt, 2048, scr, r, lane); continue; } r -= I_BR;
          transpose_item(AIN(I_WOUT) + (size_t)l * 1024 * 1024, 1024, 1024, wot, 0, scr, r, lane);
      } }
}
__device__ __forceinline__ void step_pro_a2(const AV& a, LAS unsigned char* lds) {
    const int tid = ltid(), G = gridDim.x; unsigned char* ws = AWS;
    { constexpr int GPL = LP / 8 + LS / 8;
      for (int g = lbid(); g < 2 * GPL; g += G) { const int l = g / GPL; int r = g - l * GPL;
          float* hfp = (float*)(ws + WS_U + l * (HF_P_BYTES + HF_S_BYTES));
          if (r < LP / 8) hf_group((LAS float*)lds, a, l, LP, r * 8, hfp, tid);
          else hf_group((LAS float*)lds, a, l, LS, (r - LP / 8) * 8, (float*)((unsigned char*)hfp + HF_P_BYTES), tid); } }
}
template <int LOG4> __device__ __forceinline__ void filt_unit(const AV& a, LAS unsigned char* lds, int layer, int pr, const float* hf, f32x2* Pg, f32x2* Mg) {
    constexpr int N = 1 << (2 * LOG4), L = N / 2;
    const int tid = ltid(); LAS f32x2* buf = (LAS f32x2*)lds; const int c0 = 2 * pr;
    for (int n = tid; n < N; n += NT) { f32x2 v = (f32x2){0.f, 0.f};
        if (n < L) v = *(const f32x2*)(hf + (size_t)n * 1024 + c0); else if (n > L) v = *(const f32x2*)(hf + (size_t)(N - n) * 1024 + 512 + c0);
        buf[PADI(n)] = v; }
    __syncthreads();
    fft_fwd<LOG4>(buf, (const f32x2*)(AWS + WS_TW), tid);
    const float ba = AIN(I_HYBIAS)[layer * 512 + c0], bb = AIN(I_HYBIAS)[layer * 512 + c0 + 1]; const float sc = 1.0f / (float)N;
    for (int k = tid; k <= L; k += NT) { const int q1 = digitrev<LOG4>(k), q2 = digitrev<LOG4>((N - k) & (N - 1)); const f32x2 z1 = buf[PADI(q1)], z2 = buf[PADI(q2)];
        f32x2 ca = (f32x2){0.5f * (z1.x + z2.x), 0.5f * (z1.y - z2.y)}; const float dx = z1.x - z2.x, dy = z1.y + z2.y; f32x2 cb = (f32x2){0.5f * dy, -0.5f * dx};
        ca.x += ba; cb.x += bb;
        Pg[k] = (f32x2){0.5f * sc * (ca.x + cb.x), 0.5f * sc * (ca.y + cb.y)}; Mg[k] = (f32x2){0.5f * sc * (ca.x - cb.x), 0.5f * sc * (ca.y - cb.y)}; }
    __syncthreads();
}
__device__ __forceinline__ void step_pro_b(const AV& a, LAS unsigned char* lds) {
    for (int u = lbid(); u < 1024; u += gridDim.x) { const int l = u >> 9, r = u & 511; unsigned char* sp = AWS + WS_SPEC + l * SPEC_LAYER; const float* hfp = (const float*)(AWS + WS_U + l * (HF_P_BYTES + HF_S_BYTES));
        if (r < 256) filt_unit<7>(a, lds, l, r, hfp, (f32x2*)sp + (size_t)r * SPS_P, (f32x2*)(sp + SPEC_P_BYTES) + (size_t)r * SPS_P);
        else { const int pr = r - 256; filt_unit<6>(a, lds, l, pr, (const float*)((const unsigned char*)hfp + HF_P_BYTES), (f32x2*)(sp + 2 * SPEC_P_BYTES) + (size_t)pr * SPS_S, (f32x2*)(sp + 2 * SPEC_P_BYTES + SPEC_S_BYTES) + (size_t)pr * SPS_S); } }
}
__device__ __forceinline__ void step_norm(const AV& a, int c, int layer) {
    const int tid = ltid(), lane = tid & 63, wave = tid >> 6; const Chunk ck = chunk_of(c);
    const float* X = layer == 0 ? xin_rows(a, ck.tok0) : AOUT + (size_t)ck.tok0 * DM; bf16* HN = (bf16*)(AWS + WS_HN); const float* g = AIN(I_NORMG) + layer * DM;
    f32x4 gv[4];
#pragma unroll
    for (int j = 0; j < 4; ++j) gv[j] = *((const f32x4*)g + lane + 64 * j);
    for (int m = lbid() * NWAVES + wave; m < CH; m += gridDim.x * NWAVES) {
        const f32x4* xr = (const f32x4*)(X + (size_t)m * DM) + lane; f32x4 v[4]; float s = 0.f;
#pragma unroll
        for (int j = 0; j < 4; ++j) { v[j] = xr[64 * j]; s += (v[j].x * v[j].x + v[j].y * v[j].y) + (v[j].z * v[j].z + v[j].w * v[j].w); }
        const float rs = 1.0f / sqrtf(wave_sum(s) * (1.0f / DM) + EPS);
        u32x2* o8 = (u32x2*)(HN + (size_t)m * DM) + lane;
#pragma unroll
        for (int j = 0; j < 4; ++j) { u32x2 w; w.x = pk2(v[j].x * rs * gv[j].x, v[j].y * rs * gv[j].y); w.y = pk2(v[j].z * rs * gv[j].z, v[j].w * rs * gv[j].w); o8[64 * j] = w; }
    }
}
__device__ __forceinline__ void step_final(const AV& a, int row0, int row1) {
    const int tid = ltid(), lane = tid & 63, wave = tid >> 6; const float* g = AIN(I_FINALG);
    f32x4 gv[4];
#pragma unroll
    for (int j = 0; j < 4; ++j) gv[j] = *((const f32x4*)g + lane + 64 * j);
    for (int m = row0 + lbid() * NWAVES + wave; m < row1; m += gridDim.x * NWAVES) {
        f32x4* xr = (f32x4*)(AOUT + (size_t)m * DM) + lane; f32x4 v[4]; float s = 0.f;
#pragma unroll
        for (int j = 0; j < 4; ++j) { v[j] = xr[64 * j]; s += (v[j].x * v[j].x + v[j].y * v[j].y) + (v[j].z * v[j].z + v[j].w * v[j].w); }
        const float rs = 1.0f / sqrtf(wave_sum(s) * (1.0f / DM) + EPS);
#pragma unroll
        for (int j = 0; j < 4; ++j) xr[64 * j] = v[j] * rs * gv[j];
    }
}
__device__ __forceinline__ void step_prep(const AV& a, int c, int layer) {
    const Chunk ck = chunk_of(c); bf16* U = (bf16*)(AWS + WS_U);
    for (int it = lbid() * NT + ltid(); it < CH * 10; it += gridDim.x * NT) {
        const int tok = it / 10, hd = it - tok * 10; const int pos = tok & (ck.L - 1);
        bf16* p = U + (size_t)tok * UP + (hd < 8 ? C_GQ + 64 * hd : C_GK + 64 * (hd - 8));
        const float* g = (hd < 8 ? AIN(I_QNG) : AIN(I_KNG)) + layer * 64;
        float x[64];
#pragma unroll
        for (int i = 0; i < 8; ++i) { const u32x4 w = *((const u32x4*)p + i);
            x[8 * i + 0] = bflo(w.x); x[8 * i + 1] = bfhi(w.x); x[8 * i + 2] = bflo(w.y); x[8 * i + 3] = bfhi(w.y); x[8 * i + 4] = bflo(w.z); x[8 * i + 5] = bfhi(w.z); x[8 * i + 6] = bflo(w.w); x[8 * i + 7] = bfhi(w.w); }
        float ss = 0.f;
#pragma unroll
        for (int i = 0; i < 64; ++i) ss += x[i] * x[i];
        const float rs = (1.0f / sqrtf(ss * (1.0f / 64.0f) + EPS)) * (hd < 8 ? 0.125f * LOG2E : 1.0f);
#pragma unroll
        for (int i = 0; i < 64; ++i) x[i] = x[i] * rs * g[i];
        const f32x4* rt = (const f32x4*)(AWS + WS_ROPE) + (size_t)pos * 16;
#pragma unroll
        for (int i2 = 0; i2 < 16; ++i2) { const f32x4 cs2 = rt[i2];
#pragma unroll
            for (int e = 0; e < 2; ++e) { const int i = 2 * i2 + e; const float cs = e ? cs2.z : cs2.x, sn = e ? cs2.w : cs2.y; const float x1 = x[i], x2 = x[i + 32]; x[i] = x1 * cs - x2 * sn; x[i + 32] = x2 * cs + x1 * sn; } }
#pragma unroll
        for (int i = 0; i < 8; ++i) { u32x4 w; w.x = pk2(x[8 * i], x[8 * i + 1]); w.y = pk2(x[8 * i + 2], x[8 * i + 3]); w.z = pk2(x[8 * i + 4], x[8 * i + 5]); w.w = pk2(x[8 * i + 6], x[8 * i + 7]); *((u32x4*)p + i) = w; }
    }
}
__device__ __forceinline__ void step_prep_hy(const AV& a, LAS unsigned char* lds, int c, int layer) {
    const Chunk ck = chunk_of(c); const bf16* U = (const bf16*)(AWS + WS_U);
    f32x2* HVP = (f32x2*)(AWS + WS_HVP); f32x2* PMP = (f32x2*)(AWS + WS_PMP);
    const int tid = ltid(), lane = tid & 63, wave = tid >> 6;
    LAS f32x2* th = (LAS f32x2*)(lds + wave * 17408); LAS f32x2* tp = th + 64 * 17;
    const float* cw = AIN(I_CONVW) + layer * 3 * 1536; const float* cb = AIN(I_CONVB) + layer * 1536;
    for (int it = lbid() * NWAVES + wave; it < (CH / 16) * 4; it += gridDim.x * NWAVES) {
        const int cbk = it & 3, tg = it >> 2, t0 = tg * 16, ch = cbk * 128 + 2 * lane;
        const int pos0 = t0 & (ck.L - 1);
        float w[3][3][2], bb[3][2];
#pragma unroll
        for (int ar = 0; ar < 3; ++ar) {
#pragma unroll
            for (int j = 0; j < 3; ++j) { const f32x2 v = *(const f32x2*)(cw + j * 1536 + ar * 512 + ch); w[ar][j][0] = v.x; w[ar][j][1] = v.y; }
            const f32x2 v = *(const f32x2*)(cb + ar * 512 + ch); bb[ar][0] = v.x; bb[ar][1] = v.y; }
        const bf16* r0 = U + (size_t)t0 * UP + ch;
        unsigned pv[3], cv[3], nv[3];
#pragma unroll
        for (int ar = 0; ar < 3; ++ar) { pv[ar] = pos0 > 0 ? *(const unsigned*)(r0 - UP + ar * 512) : 0u; cv[ar] = *(const unsigned*)(r0 + ar * 512); }
#pragma unroll 4
        for (int t = 0; t < 16; ++t) {
            const bf16* rt = r0 + (size_t)t * UP; const bool last = (pos0 + t + 1 >= ck.L);
#pragma unroll
            for (int ar = 0; ar < 3; ++ar) nv[ar] = last ? 0u : *(const unsigned*)(rt + UP + ar * 512);
            const unsigned gw = *(const unsigned*)(rt + C_HG);
            float o[3][2];
#pragma unroll
            for (int ar = 0; ar < 3; ++ar) { o[ar][0] = w[ar][0][0] * bflo(pv[ar]) + w[ar][1][0] * bflo(cv[ar]) + w[ar][2][0] * bflo(nv[ar]) + bb[ar][0];
                o[ar][1] = w[ar][0][1] * bfhi(pv[ar]) + w[ar][1][1] * bfhi(cv[ar]) + w[ar][2][1] * bfhi(nv[ar]) + bb[ar][1]; pv[ar] = cv[ar]; cv[ar] = nv[ar]; }
            th[lane * 17 + t] = (f32x2){o[2][0] * o[1][0], o[2][1] * o[1][1]};
            tp[lane * 17 + t] = (f32x2){o[0][0] * silu(bflo(gw)), o[0][1] * silu(bfhi(gw))};
        }
        asm volatile("s_waitcnt lgkmcnt(0)" ::: "memory");
#pragma unroll 4
        for (int i = 0; i < 16; ++i) { const int pl = 4 * i + (lane >> 4), tt = lane & 15; const size_t o = (size_t)(cbk * 64 + pl) * CH + t0 + tt;
            HVP[o] = th[pl * 17 + tt]; PMP[o] = tp[pl * 17 + tt]; }
        asm volatile("s_waitcnt lgkmcnt(0)" ::: "memory");
    }
}
typedef short bf16x8 __attribute__((ext_vector_type(8)));
typedef short s16x4 __attribute__((ext_vector_type(4)));
typedef float f32x16 __attribute__((ext_vector_type(16)));
typedef float f32x2_t __attribute__((ext_vector_type(2)));
typedef __bf16 bf16x2_t __attribute__((ext_vector_type(2)));
__device__ __forceinline__ unsigned cvtpk(float lo, float hi) { f32x2_t v = {lo, hi}; bf16x2_t b = __builtin_convertvector(v, bf16x2_t); return __builtin_bit_cast(unsigned, b); }
__device__ __forceinline__ int crow(int r, int hi) { return (r & 3) + 8 * (r >> 2) + 4 * hi; }
__device__ __forceinline__ s16x4 vtr(const LAS unsigned char* p) { return __builtin_bit_cast(s16x4, __builtin_amdgcn_ds_read_tr16_b64_v4i16((LAS s16x4*)p)); }
constexpr int ATT_K = 0;
constexpr int ATT_TB_DIFF = 4 * 8192 + 4 * 16384;
constexpr float C1 = 0.125f * LOG2E;
__device__ __forceinline__ void glds16(const void* gsrc, unsigned lds_dst) { unsigned keep;
    asm volatile("s_mov_b32 %0, m0\n\ts_mov_b32 m0, %2\n\ts_nop 0\n\tglobal_load_lds_dwordx4 %1, off\n\ts_mov_b32 m0, %0" : "=&s"(keep) : "v"(gsrc), "s"(lds_dst) : "memory"); }

template <int VD, bool BIAS, bool OMAX, int G>
__device__ __forceinline__ void flash_pass(LAS unsigned char* lds, const bf16* Qrow, const bf16* Kg, const bf16* Vg, int L, int qpos, int qw0, float bl, float br, f32x16 (&o)[VD / 32], float& l_out) {
    const int tid = ltid(), lane = tid & 63, r32 = lane & 31, hi = lane >> 5;
    constexpr int VROW = VD * 2, VT = 64 * VROW, NVL = VD / 64, NSL = 2 * G, ATT_V = NSL * 8192, ATT_TB = ATT_V + NSL * VT;
    const LAS float* tb = (const LAS float*)(lds + ATT_TB);
    typedef const __attribute__((address_space(1))) u32x4* g4p;
    const int wv = __builtin_amdgcn_readfirstlane(tid >> 6); const int ldsa = (int)(unsigned)(uintptr_t)lds;
    const bf16* ksrc; { const int X = wv * 1024 + lane * 16, line = X >> 8, c16 = ((X >> 4) & 15) ^ (line & 15), key = 2 * line + (c16 >> 3), ch = c16 & 7; ksrc = Kg + (size_t)key * UP + ch * 8; }
    const bf16* vsrc[NVL];
#pragma unroll
    for (int i = 0; i < NVL; ++i) { const int X = i * 8192 + wv * 1024 + lane * 16; const int key = (VD == 64) ? (X >> 7) : (X >> 8), posb = (VD == 64) ? (X & 127) : (X & 255);
        const int swz = (VD == 64) ? (((key >> 1) & 1) << 6) : ((key & 3) << 6); vsrc[i] = Vg + (size_t)key * UP + ((posb ^ swz) >> 1); }
#define ATT_DMA(tt_, sl_) do { const size_t go_ = (size_t)(tt_) * 64 * UP; \
        glds16(ksrc + go_, (unsigned)__builtin_amdgcn_readfirstlane(ldsa + ATT_K + (sl_) * 8192 + wv * 1024)); \
        _Pragma("unroll") for (int i_ = 0; i_ < NVL; ++i_) glds16(vsrc[i_] + go_, (unsigned)__builtin_amdgcn_readfirstlane(ldsa + ATT_V + (sl_) * VT + i_ * 8192 + wv * 1024)); } while (0)
#define ATT_DMAGROUP(g_) do { _Pragma("unroll") for (int j_ = 0; j_ < G; ++j_) { const int tt_ = (g_) * G + j_; ATT_DMA(tt_, tt_ & (NSL - 1)); } } while (0)
#define ATT_BAR() do { __builtin_amdgcn_s_barrier(); asm volatile("" ::: "memory"); } while (0)
    int koff[2][4];
#pragma unroll
    for (int kb = 0; kb < 2; ++kb)
#pragma unroll
        for (int s = 0; s < 4; ++s) { const int key = 32 * kb + r32, line = key >> 1, c16 = ((key & 1) << 3) | (2 * s + hi); koff[kb][s] = line * 256 + ((c16 ^ (line & 15)) << 4); }
    const int q4 = (lane & 15) >> 2, p4 = lane & 3, g1 = (lane >> 4) & 1;
    const int vsw = (VD == 64) ? ((q4 >> 1) & 1) : q4;
    const int vbase = (4 * hi + q4) * VROW + 32 * g1 + 8 * p4;
    bf16x8 qf[4];
#pragma unroll
    for (int s = 0; s < 4; ++s) qf[s] = __builtin_bit_cast(bf16x8, *(g4p)(Qrow + 16 * s + 8 * hi));
    float m_run = OMAX ? -1e30f : 0.f, l_run = 0.f;
    const int nt = L >> 6;
    asm volatile("" :: "v"(qf[0]), "v"(qf[1]), "v"(qf[2]), "v"(qf[3]) : "memory");
    asm volatile("s_waitcnt vmcnt(0)" ::: "memory");
    const int ng = nt / G;
    ATT_DMAGROUP(0); if (ng > 1) ATT_DMAGROUP(1);
    if (ng > 1) { if (G * (1 + NVL) == 8) asm volatile("s_waitcnt vmcnt(8)" ::: "memory"); else asm volatile("s_waitcnt vmcnt(6)" ::: "memory"); } else asm volatile("s_waitcnt vmcnt(0)" ::: "memory");
    static_assert(G * (1 + NVL) == 8 || G * (1 + NVL) == 6, "vmcnt immediates above");
    ATT_BAR();
#pragma unroll 1
    for (int t = 0; t < nt; ++t) {
        const int cur = t & (NSL - 1);
        const LAS unsigned char* kbuf = lds + ATT_K + cur * 8192; const LAS unsigned char* vbuf = lds + ATT_V + cur * VT;
        f32x16 p[2];
        { bf16x8 kf[2][4];
#pragma unroll
          for (int kb = 0; kb < 2; ++kb)
#pragma unroll
            for (int s = 0; s < 4; ++s) kf[kb][s] = *(const LAS bf16x8*)(kbuf + koff[kb][s]);
          __builtin_amdgcn_sched_barrier(0);
#pragma unroll
          for (int kb = 0; kb < 2; ++kb) { f32x16 acc;
#pragma unroll
            for (int r = 0; r < 16; ++r) acc[r] = 0.f;
#pragma unroll
            for (int s = 0; s < 4; ++s) acc = __builtin_amdgcn_mfma_f32_32x32x16_bf16(kf[kb][s], qf[s], acc, 0, 0, 0);
            p[kb] = acc; } }
        s16x4 vlo[2][4], vhi[2][4];
#define VREAD(buf_, db_) do { const int cofs_ = (((db_) ^ vsw) << 6); _Pragma("unroll") for (int kb = 0; kb < 2; ++kb) _Pragma("unroll") for (int ss = 0; ss < 2; ++ss) { \
            const LAS unsigned char* vp_ = vbuf + vbase + (32 * kb + 16 * ss) * VROW + cofs_; vlo[buf_][2 * kb + ss] = vtr(vp_); vhi[buf_][2 * kb + ss] = vtr(vp_ + 8 * VROW); } } while (0)
        VREAD(0, 0);
        __builtin_amdgcn_sched_barrier(0);
        const int k0 = t * 64; float mulc, bconst, mx = -3e38f; bool nearT = false;
        const bool domax = (t & 7) == 0;
        if (BIAS) { const int rlo = k0 - qw0 - 31, rhi = k0 + 63 - qw0; nearT = !(rhi <= -128 || rlo >= 128); }
        if (BIAS && nearT) {
#pragma unroll
            for (int kb = 0; kb < 2; ++kb)
#pragma unroll
                for (int r4 = 0; r4 < 4; ++r4) {
#pragma unroll
                    for (int e = 0; e < 4; ++e) { const int r = 4 * r4 + e; int rel = k0 + 32 * kb + crow(r, hi) - qpos; rel = rel < -128 ? -128 : (rel > 128 ? 128 : rel); const float v = p[kb][r] * C1 + tb[rel + 128]; p[kb][r] = v; mx = fmaxf(mx, v); }
                    __builtin_amdgcn_sched_barrier(0); }
            mulc = 1.0f; bconst = 0.f;
        } else {
            if (OMAX && domax) {
#pragma unroll
                for (int kb = 0; kb < 2; ++kb)
#pragma unroll
                    for (int r = 0; r < 16; ++r) mx = fmaxf(mx, p[kb][r]); }
            bconst = BIAS ? (k0 < qw0 ? bl : br) : 0.f; mx = mx * C1 + bconst; mulc = C1;
        }
        if (OMAX && (domax || (BIAS && nearT))) {
            mx = fmaxf(mx, shx(mx, 32));
            if (__any(mx > m_run)) { const float mn = fmaxf(m_run, mx), al = __builtin_amdgcn_exp2f(m_run - mn); l_run *= al;
#pragma unroll
                for (int db = 0; db < VD / 32; ++db) o[db] *= al;
                m_run = mn; }
        }
        const f32x2 mul2 = (f32x2){mulc, mulc}, add2 = (f32x2){bconst - m_run, bconst - m_run}; f32x2 ls2 = (f32x2){0.f, 0.f};
#pragma unroll
        for (int kb = 0; kb < 2; ++kb)
#pragma unroll
            for (int r = 0; r < 16; r += 2) { f32x2 v = (f32x2){p[kb][r], p[kb][r + 1]}; v = v * mul2 + add2; f32x2 e; e.x = __builtin_amdgcn_exp2f(v.x); e.y = __builtin_amdgcn_exp2f(v.y); ls2 += e; p[kb][r] = e.x; p[kb][r + 1] = e.y; }
        l_run += ls2.x + ls2.y;
        bf16x8 pk[2][2];
#pragma unroll
        for (int kb = 0; kb < 2; ++kb)
#pragma unroll
            for (int ss = 0; ss < 2; ++ss) { u32x4 w; w.x = cvtpk(p[kb][8 * ss + 0], p[kb][8 * ss + 1]); w.y = cvtpk(p[kb][8 * ss + 2], p[kb][8 * ss + 3]); w.z = cvtpk(p[kb][8 * ss + 4], p[kb][8 * ss + 5]); w.w = cvtpk(p[kb][8 * ss + 6], p[kb][8 * ss + 7]);
                pk[kb][ss] = __builtin_bit_cast(bf16x8, w); }
        __builtin_amdgcn_sched_barrier(0);
#pragma unroll
        for (int db = 0; db < VD / 32; ++db) {
            if (db + 1 < VD / 32) { if ((db + 1) & 1) VREAD(1, db + 1); else VREAD(0, db + 1); }
#pragma unroll
            for (int kb = 0; kb < 2; ++kb)
#pragma unroll
                for (int ss = 0; ss < 2; ++ss) { const bf16x8 vf = (db & 1) ? __builtin_shufflevector(vlo[1][2 * kb + ss], vhi[1][2 * kb + ss], 0, 1, 2, 3, 4, 5, 6, 7) : __builtin_shufflevector(vlo[0][2 * kb + ss], vhi[0][2 * kb + ss], 0, 1, 2, 3, 4, 5, 6, 7);
                    o[db] = __builtin_amdgcn_mfma_f32_32x32x16_bf16(vf, pk[kb][ss], o[db], 0, 0, 0); }
            __builtin_amdgcn_sched_barrier(0); }
#undef VREAD
        if (((t + 1) & (G - 1)) == 0) {
            asm volatile("s_waitcnt vmcnt(0)" ::: "memory"); ATT_BAR();
            const int g2 = (t + 1) / G + 1; if (g2 < ng) ATT_DMAGROUP(g2); }
    }
#undef ATT_DMA
#undef ATT_DMAGROUP
#undef ATT_BAR
    l_out = l_run + shx(l_run, 32);
}
__device__ __forceinline__ void gqa_unit(const AV& a, LAS unsigned char* lds, int seqrow0, int L, int h, int qb) {
    const int tid = ltid(), lane = tid & 63, r32 = lane & 31, hi = lane >> 5;
    const bf16* U = (const bf16*)(AWS + WS_U); bf16* Y = (bf16*)(AWS + WS_Y) + (size_t)1 * CH * 512;
    constexpr int G = 4, NSL = 2 * G, VROW = 128, VT = 8192, ATT_V = NSL * 8192;
    typedef const __attribute__((address_space(1))) u32x4* g4p;
    const int wv = __builtin_amdgcn_readfirstlane(tid >> 6); const int ldsa = (int)(unsigned)(uintptr_t)lds;
    const int qw0 = qb * 512 + wv * 64;
    const bf16* Kg = U + (size_t)seqrow0 * UP + C_GK + 64 * (h >> 2); const bf16* Vg = U + (size_t)seqrow0 * UP + C_GV + 64 * (h >> 2);
    const bf16* ksrc; { const int X = wv * 1024 + lane * 16, line = X >> 8, c16 = ((X >> 4) & 15) ^ (line & 15), key = 2 * line + (c16 >> 3), ch = c16 & 7; ksrc = Kg + (size_t)key * UP + ch * 8; }
    const bf16* vsrc; { const int X = wv * 1024 + lane * 16, key = X >> 7, posb = X & 127, swz = ((key >> 1) & 1) << 6; vsrc = Vg + (size_t)key * UP + ((posb ^ swz) >> 1); }
#define GQ_DMA(tt_, sl_) do { const size_t go_ = (size_t)(tt_) * 64 * UP; \
        glds16(ksrc + go_, (unsigned)__builtin_amdgcn_readfirstlane(ldsa + ATT_K + (sl_) * 8192 + wv * 1024)); \
        glds16(vsrc + go_, (unsigned)__builtin_amdgcn_readfirstlane(ldsa + ATT_V + (sl_) * VT + wv * 1024)); } while (0)
#define GQ_DMAGROUP(g_) do { _Pragma("unroll") for (int j_ = 0; j_ < G; ++j_) { const int tt_ = (g_) * G + j_; GQ_DMA(tt_, tt_ & (NSL - 1)); } } while (0)
#define GQ_BAR() do { __builtin_amdgcn_s_barrier(); asm volatile("" ::: "memory"); } while (0)
    int koff[2][4];
#pragma unroll
    for (int kb = 0; kb < 2; ++kb)
#pragma unroll
        for (int s = 0; s < 4; ++s) { const int key = 32 * kb + r32, line = key >> 1, c16 = ((key & 1) << 3) | (2 * s + hi); koff[kb][s] = line * 256 + ((c16 ^ (line & 15)) << 4); }
    const int q4 = (lane & 15) >> 2, p4 = lane & 3, g1 = (lane >> 4) & 1;
    const int vsw = (q4 >> 1) & 1;
    const int vbase = (4 * hi + q4) * VROW + 32 * g1 + 8 * p4;
    bf16x8 qf[2][4];
#pragma unroll
    for (int j = 0; j < 2; ++j)
#pragma unroll
        for (int s = 0; s < 4; ++s) qf[j][s] = __builtin_bit_cast(bf16x8, *(g4p)(U + (size_t)(seqrow0 + qw0 + 32 * j + r32) * UP + C_GQ + 64 * h + 16 * s + 8 * hi));
    f32x16 o[2][2];
#pragma unroll
    for (int j = 0; j < 2; ++j)
#pragma unroll
        for (int db = 0; db < 2; ++db)
#pragma unroll
            for (int r = 0; r < 16; ++r) o[j][db][r] = 0.f;
    float lrun[2] = {0.f, 0.f};
    const int nt = L >> 6, ng = nt / G;
    asm volatile("" :: "v"(qf[0][0]), "v"(qf[0][1]), "v"(qf[0][2]), "v"(qf[0][3]), "v"(qf[1][0]), "v"(qf[1][1]), "v"(qf[1][2]), "v"(qf[1][3]) : "memory");
    asm volatile("s_waitcnt vmcnt(0)" ::: "memory");
    GQ_DMAGROUP(0); if (ng > 1) GQ_DMAGROUP(1);
    if (ng > 1) asm volatile("s_waitcnt vmcnt(8)" ::: "memory"); else asm volatile("s_waitcnt vmcnt(0)" ::: "memory");
    GQ_BAR();
#pragma unroll 1
    for (int t = 0; t < nt; ++t) {
        const int cur = t & (NSL - 1);
        const LAS unsigned char* kbuf = lds + ATT_K + cur * 8192; const LAS unsigned char* vbuf = lds + ATT_V + cur * VT;
        f32x16 p[2][2];
        { bf16x8 kf[2][4];
#pragma unroll
          for (int kb = 0; kb < 2; ++kb)
#pragma unroll
            for (int s = 0; s < 4; ++s) kf[kb][s] = *(const LAS bf16x8*)(kbuf + koff[kb][s]);
          __builtin_amdgcn_sched_barrier(0);
#pragma unroll
          for (int kb = 0; kb < 2; ++kb)
#pragma unroll
            for (int j = 0; j < 2; ++j) { f32x16 acc;
#pragma unroll
              for (int r = 0; r < 16; ++r) acc[r] = 0.f;
#pragma unroll
              for (int s = 0; s < 4; ++s) acc = __builtin_amdgcn_mfma_f32_32x32x16_bf16(kf[kb][s], qf[j][s], acc, 0, 0, 0);
              p[j][kb] = acc; } }
        s16x4 vlo[2][4], vhi[2][4];
#define GQ_VREAD(buf_, db_) do { const int cofs_ = (((db_) ^ vsw) << 6); _Pragma("unroll") for (int kb = 0; kb < 2; ++kb) _Pragma("unroll") for (int ss = 0; ss < 2; ++ss) { \
            const LAS unsigned char* vp_ = vbuf + vbase + (32 * kb + 16 * ss) * VROW + cofs_; vlo[buf_][2 * kb + ss] = vtr(vp_); vhi[buf_][2 * kb + ss] = vtr(vp_ + 8 * VROW); } } while (0)
        bf16x8 pk[2][2][2];
#pragma unroll
        for (int j = 0; j < 2; ++j) { float ls0 = 0.f, ls1 = 0.f;
#pragma unroll
            for (int kb = 0; kb < 2; ++kb) {
#pragma unroll
                for (int r = 0; r < 16; r += 2) { const float e0 = __builtin_amdgcn_exp2f(p[j][kb][r]), e1 = __builtin_amdgcn_exp2f(p[j][kb][r + 1]); ls0 += e0; ls1 += e1; p[j][kb][r] = e0; p[j][kb][r + 1] = e1; }
#pragma unroll
                for (int ss = 0; ss < 2; ++ss) { u32x4 w; w.x = cvtpk(p[j][kb][8 * ss + 0], p[j][kb][8 * ss + 1]); w.y = cvtpk(p[j][kb][8 * ss + 2], p[j][kb][8 * ss + 3]); w.z = cvtpk(p[j][kb][8 * ss + 4], p[j][kb][8 * ss + 5]); w.w = cvtpk(p[j][kb][8 * ss + 6], p[j][kb][8 * ss + 7]);
                    pk[j][kb][ss] = __builtin_bit_cast(bf16x8, w); } }
            lrun[j] += ls0 + ls1; }
        __builtin_amdgcn_sched_barrier(0);
        GQ_VREAD(0, 0); GQ_VREAD(1, 1);
#pragma unroll
        for (int db = 0; db < 2; ++db) {
#pragma unroll
            for (int kb = 0; kb < 2; ++kb)
#pragma unroll
                for (int ss = 0; ss < 2; ++ss) { const bf16x8 vf = db ? __builtin_shufflevector(vlo[1][2 * kb + ss], vhi[1][2 * kb + ss], 0, 1, 2, 3, 4, 5, 6, 7) : __builtin_shufflevector(vlo[0][2 * kb + ss], vhi[0][2 * kb + ss], 0, 1, 2, 3, 4, 5, 6, 7);
#pragma unroll
                    for (int j = 0; j < 2; ++j) o[j][db] = __builtin_amdgcn_mfma_f32_32x32x16_bf16(vf, pk[j][kb][ss], o[j][db], 0, 0, 0); }
            __builtin_amdgcn_sched_barrier(0); }
#undef GQ_VREAD
        if (((t + 1) & (G - 1)) == 0) { asm volatile("s_waitcnt vmcnt(0)" ::: "memory"); GQ_BAR(); const int g2 = (t + 1) / G + 1; if (g2 < ng) GQ_DMAGROUP(g2); }
    }
#undef GQ_DMA
#undef GQ_DMAGROUP
#undef GQ_BAR
#pragma unroll
    for (int j = 0; j < 2; ++j) { const int lane2 = ltid() & 63, r32b = lane2 & 31, hib = lane2 >> 5;
        const float l = lrun[j] + shx(lrun[j], 32); const float inv = 1.0f / l; const size_t row = (size_t)(seqrow0 + qw0 + 32 * j + r32b);
#pragma unroll
        for (int db = 0; db < 2; ++db)
#pragma unroll
            for (int g = 0; g < 4; ++g) { const int d = 32 * db + 8 * g + 4 * hib; const u32x2 gw = *(const u32x2*)(U + row * UP + C_GG + 64 * h + d);
                const float y0 = o[j][db][4 * g] * inv * silu(bflo(gw.x)), y1 = o[j][db][4 * g + 1] * inv * silu(bfhi(gw.x)), y2 = o[j][db][4 * g + 2] * inv * silu(bflo(gw.y)), y3 = o[j][db][4 * g + 3] * inv * silu(bfhi(gw.y));
                u32x2 w; w.x = cvtpk(y0, y1); w.y = cvtpk(y2, y3); *(u32x2*)(Y + row * 512 + 64 * h + d) = w; } }
}
__device__ __forceinline__ void diff_unit(const AV& a, LAS unsigned char* lds, int seqrow0, int L, int h, int qb, int layer) {
    const int tid = ltid(), lane = tid & 63, wave = tid >> 6, r32 = lane & 31, hi = lane >> 5;
    const bf16* U = (const bf16*)(AWS + WS_U); bf16* Y = (bf16*)(AWS + WS_Y) + (size_t)2 * CH * 512; float* DT = (float*)(AWS + WS_DT);
    const float* relb = AIN(I_RELB);
    LAS float* tb = (LAS float*)(lds + ATT_TB_DIFF);
    for (int i = tid; i < 257; i += NT) { const int rel = i - 128, n = rel < 0 ? -rel : rel; int b = rel > 0 ? 16 : 0;
        if (n < 8) b += n; else { const int v = 8 + (31 - __builtin_clz((unsigned)(n * n))) - 6; b += v < 15 ? v : 15; }
        tb[i] = relb[b * 4 + h] * LOG2E; }
    const float bl = relb[15 * 4 + h] * LOG2E, br = relb[31 * 4 + h] * LOG2E;
    float lyf = (float)layer; asm volatile("" : "+v"(lyf));
    const float li = 0.8f - 0.6f * __expf(-0.3f * lyf);
    float d1, d2; { const float q1 = AIN(I_LQ1)[layer * 64 + lane], k1 = AIN(I_LK1)[layer * 64 + lane], q2 = AIN(I_LQ2)[layer * 64 + lane], k2 = AIN(I_LK2)[layer * 64 + lane]; d1 = wave_sum(q1 * k1); d2 = wave_sum(q2 * k2); }
    const float lam = __expf(d1) - __expf(d2) + li;
    const int qw0 = qb * 256 + wave * 32, qpos = qw0 + r32; const size_t row = (size_t)(seqrow0 + qpos);
    __syncthreads();
    f32x16 o[4]; float l; float ss = 0.f;
#pragma unroll 1
    for (int c = 0; c < 2; ++c) {
#pragma unroll
        for (int db = 0; db < 4; ++db)
#pragma unroll
            for (int r = 0; r < 16; ++r) o[db][r] = 0.f;
        flash_pass<128, true, true, 2>(lds, U + row * UP + C_DQ + 128 * h + 64 * c, U + (size_t)seqrow0 * UP + C_DK + 128 * h + 64 * c, U + (size_t)seqrow0 * UP + C_DV + 128 * h, L, qpos, qw0, bl, br, o, l);
        if (c == 0) { const float inv = 1.0f / l;
#pragma unroll
            for (int db = 0; db < 4; ++db)
#pragma unroll
                for (int g = 0; g < 4; ++g) { const int d = 32 * db + 8 * g + 4 * hi; *(f32x4*)(DT + row * 512 + 128 * h + d) = (f32x4){o[db][4 * g] * inv, o[db][4 * g + 1] * inv, o[db][4 * g + 2] * inv, o[db][4 * g + 3] * inv}; }
        } else { const float inv = lam / l;
#pragma unroll
            for (int db = 0; db < 4; ++db)
#pragma unroll
                for (int g = 0; g < 4; ++g) { const int d = 32 * db + 8 * g + 4 * hi; const f32x4 o0 = *(const f32x4*)(DT + row * 512 + 128 * h + d);
#pragma unroll
                    for (int e = 0; e < 4; ++e) { const float v = o0[e] - o[db][4 * g + e] * inv; o[db][4 * g + e] = v; ss += v * v; } }
        }
    }
    ss += shx(ss, 32);
    const float rs = (1.0f / sqrtf(ss * (1.0f / 128.0f) + EPS)) * (1.0f - li);
    const float* sg = AIN(I_SUBLN) + layer * 128;
#pragma unroll
    for (int db = 0; db < 4; ++db)
#pragma unroll
        for (int g = 0; g < 4; ++g) { const int d = 32 * db + 8 * g + 4 * hi; const u32x2 gw = *(const u32x2*)(U + row * UP + C_DG + 128 * h + d); const f32x4 gn = *(const f32x4*)(sg + d);
            const float y0 = o[db][4 * g] * rs * gn.x * silu(bflo(gw.x)), y1 = o[db][4 * g + 1] * rs * gn.y * silu(bfhi(gw.x)), y2 = o[db][4 * g + 2] * rs * gn.z * silu(bflo(gw.y)), y3 = o[db][4 * g + 3] * rs * gn.w * silu(bfhi(gw.y));
            u32x2 w; w.x = cvtpk(y0, y1); w.y = cvtpk(y2, y3); *(u32x2*)(Y + row * 512 + 128 * h + d) = w; }
}
template <int LOG4, int BATCH> __device__ __forceinline__ void hyena_unit(const AV& a, LAS unsigned char* lds, int seqrow0, int pr0, int layer) {
    constexpr int N = 1 << (2 * LOG4), L = N / 2, NPAD = N + N / 16;
    const int tid = ltid(); LAS f32x2* buf = (LAS f32x2*)lds;
    bf16* Y = (bf16*)(AWS + WS_Y) + (size_t)seqrow0 * 512;
    const unsigned char* sp = AWS + WS_SPEC + layer * SPEC_LAYER;
    constexpr int SPS = (LOG4 == 7) ? SPS_P : SPS_S;
    const f32x2* Pg = ((LOG4 == 7) ? (const f32x2*)sp : (const f32x2*)(sp + 2 * SPEC_P_BYTES)) + (size_t)pr0 * SPS;
    const f32x2* Mg = ((LOG4 == 7) ? (const f32x2*)(sp + SPEC_P_BYTES) : (const f32x2*)(sp + 2 * SPEC_P_BYTES + SPEC_S_BYTES)) + (size_t)pr0 * SPS;
    const f32x2* hvp = (const f32x2*)(AWS + WS_HVP) + (size_t)pr0 * CH + seqrow0; const f32x2* pmp = (const f32x2*)(AWS + WS_PMP) + (size_t)pr0 * CH + seqrow0;
    const f32x2* tw = (const f32x2*)(AWS + WS_TW);
    if constexpr (BATCH == 1) { fft_first_from_global<LOG4>(buf, tw, hvp, tid); fft_fwd<LOG4, 1, 1>(buf, tw, tid); }
    else {
#pragma unroll
        for (int b = 0; b < BATCH; ++b)
            for (int t = tid; t < L; t += NT) { buf[b * NPAD + PADI(t)] = hvp[(size_t)b * CH + t]; buf[b * NPAD + PADI(t + L)] = (f32x2){0.f, 0.f}; }
        __syncthreads();
        fft_fwd<LOG4, BATCH>(buf, tw, tid);
    }
#pragma unroll
    for (int b = 0; b < BATCH; ++b)
        for (int k = tid; k <= L; k += NT) { const int p1 = b * NPAD + PADI(digitrev<LOG4>(k)), p2 = b * NPAD + PADI(digitrev<LOG4>((N - k) & (N - 1))); const f32x2 z1 = buf[p1], z2 = buf[p2], P = Pg[(size_t)b * SPS + k], M = Mg[(size_t)b * SPS + k];
            const f32x2 y1 = cmul(z1, P) + cmul(cconj(z2), M), y2 = cmulc(z2, P) + cmulc(cconj(z1), M);
            buf[p1] = y1; if (p2 != p1) buf[p2] = y2; }
    __syncthreads();
    if constexpr (BATCH == 1) { fft_inv<LOG4, 1, 1>(buf, tw, tid); fft_last_to_global<LOG4>(buf, tw, pmp, Y + 2 * pr0, tid); }
    else { fft_inv<LOG4, BATCH>(buf, tw, tid);
    for (int t = tid; t < L; t += NT) { unsigned w[BATCH];
#pragma unroll
        for (int b = 0; b < BATCH; ++b) { const f32x2 y = buf[b * NPAD + PADI(t)], m = pmp[(size_t)b * CH + t]; w[b] = cvtpk(y.x * m.x, y.y * m.y); }
        if (BATCH == 4) *(u32x4*)(Y + (size_t)t * 512 + 2 * pr0) = (u32x4){w[0], w[BATCH > 1 ? 1 : 0], w[BATCH > 2 ? 2 : 0], w[BATCH > 3 ? 3 : 0]};
        else *(unsigned*)(Y + (size_t)t * 512 + 2 * pr0) = w[0]; } }
    __syncthreads();
}
#define XB_TMO      128
#define XB_XCNT(j)  (256  + 64 * (j))
#define XB_XSUB(j)  (1280 + 64 * (j))
#define XB_XGEN(j)  (2304 + 64 * (j))
#define XB_TOP      3328
#define XB_TOPGEN   3392
#define XCD_BAR_WORDS 3456
#define XB_SPIN_CAP (1u << 18)

__device__ __forceinline__ unsigned xb_ld(unsigned* p)              { return __hip_atomic_load(p, __ATOMIC_RELAXED, __HIP_MEMORY_SCOPE_AGENT); }
__device__ __forceinline__ unsigned xb_add(unsigned* p, unsigned v) { return __hip_atomic_fetch_add(p, v, __ATOMIC_RELAXED, __HIP_MEMORY_SCOPE_AGENT); }
__device__ __forceinline__ unsigned xb_xcc_id() { return (unsigned)__builtin_amdgcn_s_getreg((3 << 11) | 20) & 0xFu; }
#define XB_SPIN(cond, bar) do { unsigned _sp = 0; while (cond) { __builtin_amdgcn_s_sleep(1); \
    if ((++_sp & 255u) == 0u) { if (xb_ld(&(bar)[XB_TMO])) break; if (_sp > XB_SPIN_CAP) { atomicAdd(&(bar)[XB_TMO], 1u); break; } } } } while (0)

struct XcdBarrier {
    unsigned* bar; unsigned x;
    volatile LAS unsigned* st;
};

__device__ __forceinline__ XcdBarrier xcd_barrier_post(unsigned* bar, volatile LAS unsigned* st) {
    XcdBarrier b; b.bar = bar; b.x = xb_xcc_id(); b.st = st;
    if (threadIdx.x == 0) (void)xb_add(&bar[XB_XCNT(b.x)], 1u);
    return b;
}
__device__ __forceinline__ void xcd_barrier_complete(unsigned* bar, unsigned x, unsigned& nloc, unsigned& nx) {
    const unsigned G = gridDim.x * gridDim.y * gridDim.z;
    unsigned sum, cnt, mine, sp = 0u;
    for (;;) {
        sum = 0u; cnt = 0u; mine = 0u;
#pragma unroll
        for (unsigned j = 0; j < 16; ++j) { const unsigned c = xb_ld(&bar[XB_XCNT(j)]); sum += c; cnt += (c > 0u) ? 1u : 0u; mine = (j == x) ? c : mine; }
        if (sum == G) break;
        __builtin_amdgcn_s_sleep(1);
        if ((++sp & 255u) == 0u) { if (xb_ld(&bar[XB_TMO])) break; if (sp > XB_SPIN_CAP) { atomicAdd(&bar[XB_TMO], 1u); break; } }
    }
    nloc = mine > 0u ? mine : 1u; nx = cnt > 0u ? cnt : 1u;
}

__device__ __forceinline__ void xcd_barrier(const XcdBarrier& b) {
    asm volatile("s_waitcnt vmcnt(0)" ::: "memory");
    __syncthreads();
    if (threadIdx.x == 0) {
        unsigned* bar = b.bar;
        __builtin_amdgcn_s_waitcnt(0);
        unsigned nloc = b.st[0], nx = b.st[1];
        if (nloc == 0u) { xcd_barrier_complete(bar, b.x, nloc, nx); b.st[0] = nloc; b.st[1] = nx; }
        const unsigned old = xb_add(&bar[XB_XSUB(b.x)], 1u);
        const unsigned gen = old / nloc;
        if (old + 1u == (gen + 1u) * nloc) {
            __builtin_amdgcn_fence(__ATOMIC_RELEASE, "agent");
            asm volatile("s_waitcnt vmcnt(0)" ::: "memory");
            const unsigned og = xb_add(&bar[XB_TOP], 1u);
            const unsigned tg = og / nx;
            if (og + 1u == (tg + 1u) * nx) xb_add(&bar[XB_TOPGEN], 1u);
            else XB_SPIN(xb_ld(&bar[XB_TOPGEN]) == tg, bar);
            __builtin_amdgcn_fence(__ATOMIC_ACQUIRE, "agent");
            xb_add(&bar[XB_XGEN(b.x)], 1u);
            asm volatile("s_waitcnt vmcnt(0)" ::: "memory");
        } else {
            XB_SPIN(xb_ld(&bar[XB_XGEN(b.x)]) == gen, bar);
            __builtin_amdgcn_fence(__ATOMIC_ACQUIRE, "agent");
            asm volatile("s_waitcnt vmcnt(0)" ::: "memory");
        }
    }
    __syncthreads();
}

__device__ __forceinline__ void step_mix(const AV& a, LAS unsigned char* lds, int c, int layer, unsigned* ctr, int tmask) {
    const Chunk ck = chunk_of(c); const int nqb = ck.L / 256, nqg = ck.L / 512, nD = ck.nseq * 4 * nqb, nG = ck.nseq * 8 * nqg, nF = (ck.L == LP) ? ck.nseq * 256 : ck.nseq * 64, total = nD + nG + nF;
    volatile LAS unsigned* wq = (volatile LAS unsigned*)(lds + LDS_MAIN);
    for (;;) {
        if (ltid() == 0) wq[0] = atomicAdd(ctr, 1u);
        __syncthreads();
        const int u = (int)wq[0];
        __syncthreads();
        if (u >= total) break;
        if (u < nD) { if (tmask & 1) { const int qb = u % nqb, sh = u / nqb, h = sh & 3, s = sh >> 2; diff_unit(a, lds, s * ck.L, ck.L, h, qb, layer); } }
        else if (u < nD + nG) { if (tmask & 2) { const int v = u - nD, qb = v % nqg, sh = v / nqg, h = sh & 7, s = sh >> 3; gqa_unit(a, lds, s * ck.L, ck.L, h, qb); } }
        else { if (tmask & 4) { const int v = u - nD - nG; if (ck.L == LP) hyena_unit<7, 1>(a, lds, (v >> 8) * LP, v & 255, layer); else hyena_unit<6, 4>(a, lds, (v >> 6) * LS, (v & 63) * 4, layer); } }
    }
}
constexpr int STEPS_PER = 6, NPRO = 3, NSTEPS = NPRO + NCHUNK * 2 * STEPS_PER + 1;
__global__ void __launch_bounds__(NT, 2) mega_fwd(Args kargs) {
    extern __shared__ __attribute__((aligned(16))) unsigned char lds_raw[];
    LAS unsigned char* lds = (LAS unsigned char*)lds_raw;
    kargp_t kp = (kargp_t)__builtin_amdgcn_kernarg_segment_ptr();
    { volatile LAS unsigned* misc = (volatile LAS unsigned*)(lds + LDS_MAIN + 64); if (ltid() < 16) misc[ltid()] = 0u; }
    __syncthreads();
    XcdBarrier xbar = xcd_barrier_post((unsigned*)(kargs.ws + WS_CTL) + CW_BAR, (volatile LAS unsigned*)(lds + LDS_MAIN + 64 + 32));
    const int step_lo = kargs.lo, step_hi = kargs.hi;
#pragma unroll 1
    for (int step = step_lo; step < step_hi; ++step) {
        asm volatile("" : "+s"(kp));
        AV a; a.p = kp; unsigned char* ws = AWS;
        if (step == 0) { if (EN(0)) step_pro_a(a, lds); }
        else if (step == 1) { if (EN(11)) { step_pro_a2(a, lds); if (DUP_MASK & 32) { xcd_barrier(xbar); step_pro_a2(a, lds); } } }
        else if (step == 2) { if (EN(1)) { step_pro_b(a, lds); if (DUP_MASK & 64) { xcd_barrier(xbar); step_pro_b(a, lds); } } }
        else if (step == NSTEPS - 1) { if (DUP_MASK & 256) { for (int q = 0; q < 100; ++q) xcd_barrier(xbar); } if (EN(2)) step_final(a, (NCHUNK - 1) * CH, NTOK); }
        else {
            const int s2 = step - NPRO, cl = s2 / STEPS_PER, k = s2 - cl * STEPS_PER, c = cl >> 1, layer = cl & 1;
            const Chunk ck = chunk_of(c);
            if (k == 0) { if (layer == 0) { if (c > 0 && EN(2)) step_final(a, (c - 1) * CH, c * CH); } continue;     }
            else if (k == 2) { if (EN(5)) { step_prep(a, c, layer); step_prep_hy(a, lds, c, layer); if (layer == 0) { float* q = (float*)(ws + WS_SSQ); for (int i = lbid() * NT + ltid(); i < CH; i += (int)gridDim.x * NT) q[i] = 0.f; } } }
            else if (k == 3) {
#pragma unroll 1
                for (int rep = 0; rep < ((DUP_MASK & 7) ? 2 : 1); ++rep) { if (rep) xcd_barrier(xbar); step_mix(a, lds, c, layer, (unsigned*)(ws + WS_CTL) + step * 16 + 4 * rep, rep ? (DUP_MASK & 7) : 7); } }
            else { if (EN(4)) {
                pg8::Gemm g; pg8::OrderAll S; pg8::EpiAll E; const int G = (int)gridDim.x, bid = lbid();
                S.so.init(CH, k == 1 ? NCAT : 1024, G, bid); S.o2 = pg8::OrderG2{CH / 256, G, bid}; S.mode = (k == 4) ? 2 : 1;
                float* O = AOUT + (size_t)ck.tok0 * DM; const float* X = layer == 0 ? xin_rows(a, ck.tok0) : O;
                E.mode = (k == 1) ? 1 : (k == 4) ? 2 : 3;
                E.e1 = pg8::EpiG1{(pg8::bf16_t*)(ws + WS_U), (pg8::bf16_t*)(ws + WS_G), AIN(I_BMERGE) + layer * GP, layer == 1 ? (const float*)(ws + WS_SSQ) : (const float*)nullptr};
                E.e2 = pg8::EpiG2{(const pg8::bf16_t*)(ws + WS_G), (float*)(ws + WS_TMP), (pg8::bf16_t*)(ws + WS_MG), CH / 256};
                E.e3 = pg8::EpiG3{X, O, AIN(I_NORMG) + DM, (pg8::bf16_t*)(ws + WS_HN), (float*)(ws + WS_SSQ), layer == 0 ? 1 : 0};
                if (k == 1) g = pg8::Gemm{layer == 0 ? (const pg8::bf16_t*)(ws + WS_HN0) + (size_t)ck.tok0 * DM : (const pg8::bf16_t*)(ws + WS_HN), (const pg8::bf16_t*)(ws + WS_WCAT + layer * WCAT_BYTES), CH, NCAT, 1024};
                else if (k == 4) g = pg8::Gemm{(const pg8::bf16_t*)(ws + WS_Y), (const pg8::bf16_t*)(ws + WS_WBT + layer * WBT_BYTES), 3 * CH, 3072, 512};
                else g = pg8::Gemm{(const pg8::bf16_t*)(ws + WS_MG), (const pg8::bf16_t*)(ws + WS_WOT + layer * WOT_BYTES), CH, 1024, 1024};
                const int nrep = (((DUP_MASK & 8) && k == 1) || ((DUP_MASK & 16) && k == 4)) ? 2 : 1;
#pragma unroll 1
                for (int rep = 0; rep < nrep; ++rep) { if (rep) xcd_barrier(xbar); pg8::gemm_phase<pg8::EpiAll, pg8::OrderAll, true, true>(lds, g, S, E); }
            } }
        }
        if (step + 1 < step_hi) { if (step == 0) cg::this_grid().sync(); else xcd_barrier(xbar); }
    }
}
#ifndef MK_MULTI
#define MK_MULTI 0
#endif
extern "C" void kernel_launch(void* const* d_in, const int* in_sizes, int n_in, void* d_out, int out_size, void* d_ws, size_t ws_size, hipStream_t stream) {
    static int grid = 0;
    if (grid == 0) {
        if (n_in != N_IN || out_size != NTOK * DM || ws_size < WS_END) { fprintf(stderr, "kernel_launch: unexpected shapes (n_in %d, out %d, ws %zu)\n", n_in, out_size, ws_size); grid = -1; return; }
        int dev = 0, cus = 0, per_cu = 0;
        hipGetDevice(&dev); hipDeviceGetAttribute(&cus, hipDeviceAttributeMultiprocessorCount, dev);
        if (hipFuncSetAttribute((const void*)mega_fwd, hipFuncAttributeMaxDynamicSharedMemorySize, LDS_BYTES) != hipSuccess) { fprintf(stderr, "kernel_launch: hipFuncSetAttribute failed\n"); grid = -1; return; }
        hipOccupancyMaxActiveBlocksPerMultiprocessor(&per_cu, (const void*)mega_fwd, NT, LDS_BYTES);
        (void)hipGetLastError();
        if (per_cu < 1) per_cu = 1;
        grid = cus * 1;
        fprintf(stderr, "kernel_launch: cus %d per_cu %d grid %d\n", cus, per_cu, grid);
    }
    if (grid < 0) return;
    hipMemsetAsync((char*)d_ws + WS_CTL, 0, CTL_BYTES, stream);
    Args a{};
    for (int i = 0; i < N_IN; ++i) a.in[i] = (const float*)d_in[i];
    a.out = (float*)d_out; a.ws = (unsigned char*)d_ws;
#if MK_MULTI
    for (int s = 0; s < NSTEPS; ++s) { a.lo = s; a.hi = s + 1; hipLaunchKernelGGL(mega_fwd, dim3(grid), dim3(NT), LDS_BYTES, stream, a); }
#else
    a.lo = 0; a.hi = NSTEPS;
    void* args[] = {&a};
    hipError_t e = hipLaunchCooperativeKernel((const void*)mega_fwd, dim3(grid), dim3(NT), args, LDS_BYTES, stream);
    if (e != hipSuccess) fprintf(stderr, "cooperative launch failed: %s (grid %d)\n", hipGetErrorString(e), grid);
#endif
}
```

```cpp
#include <hip/hip_runtime.h>
#include <hip/hip_cooperative_groups.h>
#include <cstdio>
#include <cstdint>
namespace cg = cooperative_groups;
__device__ __forceinline__ int ltid() { int t = (int)threadIdx.x; asm volatile("" : "+v"(t)); return t; }
__device__ __forceinline__ float shx(float v, int o) { const int l = ltid() & 63; return __int_as_float(__builtin_amdgcn_ds_bpermute((l ^ o) << 2, __float_as_int(v))); }
__device__ __forceinline__ int lbid() { int b = (int)blockIdx.x; asm volatile("" : "+s"(b)); return b; }
namespace pg8 {
#define PG8_LAS __attribute__((address_space(3)))
typedef unsigned short bf16_t;
typedef short bf16x8 __attribute__((ext_vector_type(8)));
typedef float f32x4 __attribute__((ext_vector_type(4)));
typedef unsigned u32x4 __attribute__((ext_vector_type(4)));
constexpr int BM = 256, BK = 64, HALF = 128, HTB = HALF * BK * 2  , STAGE_BYTES = 8 * HTB, NXCD = 8, WGM = 8;

__host__ __device__ __forceinline__ int lds_byte(int r, int c) { const int st = (r >> 4) * 2 + (c >> 5), rr = r & 15, cc = c & 31, ob = rr * 64 + cc * 2; return st * 1024 + (ob ^ (((ob >> 9) & 1) << 5)); }
__host__ __device__ __forceinline__ void stage_rc(int b, int& R, int& C) { const int st = b / 1024, sb = b % 1024, swz = sb ^ (((sb >> 9) & 1) << 5); R = (st >> 1) * 16 + swz / 64; C = (st & 1) * 32 + (swz % 64) / 2; }
__host__ __device__ __forceinline__ int perm32(int rho) { const int n = rho >> 4, i = rho & 15; return 8 * (i >> 2) + 4 * n + (i & 3); }

struct Unit { int pm, pn; };
struct Gemm { const bf16_t* A; const bf16_t* Bt; int M, N, K; };

struct StaticOrder {
    int nM, nN, nwg, G, c;
    __host__ __device__ void init(int M, int N, int G_, int c_) { nM = M / BM; nN = N / BM; nwg = nM * nN; G = G_; c = c_; }
    __host__ __device__ bool next(int i, Unit& u) const {
        const long L = (long)i * G + c; if (L >= nwg) return false;
        int wgid = (int)L; { const int q = nwg / NXCD, r = nwg % NXCD, xcd = wgid % NXCD, off = wgid / NXCD; wgid = (xcd < r ? xcd * (q + 1) : r * (q + 1) + (xcd - r) * q) + off; }
        const int nig = WGM * nN, gid = wgid / nig, fm = gid * WGM, gsz = (nM - fm) < WGM ? (nM - fm) : WGM;
        u.pm = fm + ((wgid % nig) % gsz); u.pn = (wgid % nig) / gsz; return true;
    }
    __device__ __forceinline__ void a_ready(const Unit&) const {}
    __device__ __forceinline__ void done(const Unit&) const {}
};

__device__ __forceinline__ unsigned cvt_pk_bf16(float lo, float hi) { unsigned r; asm volatile("v_cvt_pk_bf16_f32 %0, %1, %2" : "=v"(r) : "v"(lo), "v"(hi)); return r; }
template <class Epi, class Sched, bool ALIGN_EPI = false, bool SP2 = false>
__device__ __forceinline__ void gemm_phase(PG8_LAS unsigned char* lds, const Gemm g, const Sched& S, const Epi& E) {
    const int tid = ltid(), wid = __builtin_amdgcn_readfirstlane(tid >> 6), lane = tid & 63, wr = wid >> 2, wc = wid & 3, fr = lane & 15, fq = lane >> 4;
    const int K = g.K, nt = K / BK;
    unsigned voffA[2], voffB[2];
#pragma unroll
    for (int i = 0; i < 2; ++i) { int R, C; stage_rc(tid * 16 + i * 8192, R, C); const int Rb = Epi::PERM ? ((R & ~31) + perm32(R & 31)) : R;
        voffA[i] = (unsigned)(R * K + C) * 2u; voffB[i] = (unsigned)(Rb * K + C) * 2u; }
    const size_t kstep = (size_t)(BK * 2);
    const size_t hstep = (size_t)HALF * K * 2;
    const size_t tstep = 2 * hstep;
    const unsigned ldsw = (unsigned)wid * 1024u;
    const int aoff = lds_byte(wr * 64 + fr, fq * 8), boff = lds_byte(wc * 32 + fr, fq * 8);
#define PG8_SA(b, h) (((b) * 2 + (h)) * HTB)
#define PG8_SB(b, h) ((4 + (b) * 2 + (h)) * HTB)
#define PG8_STAGE(bufoff, gbase, voff) do { _Pragma("unroll") for (int _i = 0; _i < 2; ++_i) \
        __builtin_amdgcn_global_load_lds((const unsigned*)((const char*)(gbase) + (voff)[_i]), (PG8_LAS unsigned*)(lds + (bufoff) + ldsw + _i * 8192), 16, 0, 0); } while (0)
#define PG8_LDA(dst, b, h) do { _Pragma("unroll") for (int m = 0; m < 4; ++m) _Pragma("unroll") for (int k = 0; k < 2; ++k) dst[m][k] = *(const PG8_LAS bf16x8*)(lds + PG8_SA(b, h) + aoff + m * 2048 + k * 1024); } while (0)
#define PG8_LDB(dst, b, h) do { _Pragma("unroll") for (int n = 0; n < 2; ++n) _Pragma("unroll") for (int k = 0; k < 2; ++k) dst[n][k] = *(const PG8_LAS bf16x8*)(lds + PG8_SB(b, h) + boff + n * 2048 + k * 1024); } while (0)
#define PG8_MMA(ai, bj, At, Bt) do { __builtin_amdgcn_s_setprio(1); _Pragma("unroll") for (int m = 0; m < 4; ++m) _Pragma("unroll") for (int n = 0; n < 2; ++n) _Pragma("unroll") for (int k = 0; k < 2; ++k) \
        acc[ai][bj][m][n] = __builtin_amdgcn_mfma_f32_16x16x32_bf16(Bt[n][k], At[m][k], acc[ai][bj][m][n], 0, 0, 0); __builtin_amdgcn_s_setprio(0); } while (0)
#define PG8_WAIT_V(n) asm volatile("s_waitcnt vmcnt(" #n ")" ::: "memory")
#define PG8_WAIT_L(n) asm volatile("s_waitcnt lgkmcnt(" #n ")" ::: "memory")
#define PG8_BAR __builtin_amdgcn_s_barrier()
#define PG8_SCHED __builtin_amdgcn_sched_barrier(0)
    Unit cur, nxt; int ui = 0;
    if (!S.next(0, cur)) return;
    f32x4 acc[2][2][4][2];
#pragma unroll
    for (int a = 0; a < 2; ++a)
#pragma unroll
        for (int b = 0; b < 2; ++b)
#pragma unroll
            for (int m = 0; m < 4; ++m)
#pragma unroll
                for (int n = 0; n < 2; ++n) acc[a][b][m][n] = (f32x4){0.f, 0.f, 0.f, 0.f};
    bf16x8 At[4][2], B0[2][2], B1[2][2];
    const char* cA = (const char*)g.A + (size_t)cur.pm * tstep; const char* cB = (const char*)g.Bt + (size_t)cur.pn * tstep;
    S.a_ready(cur);
    if constexpr (SP2) {
        PG8_STAGE(PG8_SB(0, 0), cB, voffB); PG8_STAGE(PG8_SB(0, 1), cB + hstep, voffB); PG8_STAGE(PG8_SA(0, 0), cA, voffA); PG8_STAGE(PG8_SA(0, 1), cA + hstep, voffA);
        if (wr == 1) PG8_BAR;
        PG8_WAIT_V(2); PG8_BAR;
        PG8_STAGE(PG8_SB(1, 0), cB + kstep, voffB); PG8_STAGE(PG8_SA(1, 0), cA + kstep, voffA); PG8_STAGE(PG8_SB(1, 1), cB + hstep + kstep, voffB);
        PG8_WAIT_V(6); PG8_BAR;
    } else {
        PG8_STAGE(PG8_SB(0, 0), cB, voffB); PG8_STAGE(PG8_SA(0, 0), cA, voffA); PG8_STAGE(PG8_SB(0, 1), cB + hstep, voffB); PG8_STAGE(PG8_SA(0, 1), cA + hstep, voffA);
        if (wr == 1) PG8_BAR;
        PG8_WAIT_V(4); PG8_BAR;
        PG8_STAGE(PG8_SB(1, 0), cB + kstep, voffB); PG8_STAGE(PG8_SA(1, 0), cA + kstep, voffA); PG8_STAGE(PG8_SB(1, 1), cB + hstep + kstep, voffB);
        PG8_WAIT_V(6); PG8_BAR;
    }
    for (;;) {
        const bool has_next = S.next(ui + 1, nxt);
        const char* nA = has_next ? (const char*)g.A + (size_t)nxt.pm * tstep : cA; const char* nB = has_next ? (const char*)g.Bt + (size_t)nxt.pn * tstep : cB;
        for (int t = 0; t < nt; t += 2) {
            const bool last = (t == nt - 2);
            const char* a1 = cA + (size_t)(t + 1) * kstep;
            const char* a2 = last ? nA : cA + (size_t)(t + 2) * kstep; const char* b2 = last ? nB : cB + (size_t)(t + 2) * kstep;
            const char* a3 = a2 + kstep; const char* b3 = b2 + kstep;
            if (last && has_next) S.a_ready(nxt);
            if constexpr (SP2) {
            PG8_LDB(B0, 0, 0); PG8_LDB(B1, 0, 1); PG8_SCHED; PG8_LDA(At, 0, 0); PG8_STAGE(PG8_SA(1, 1), a1 + hstep, voffA);
            PG8_WAIT_V(8); PG8_WAIT_L(0); PG8_BAR; PG8_MMA(0, 0, At, B0); PG8_MMA(0, 1, At, B1); PG8_BAR; PG8_SCHED;
            PG8_LDA(At, 0, 1); PG8_STAGE(PG8_SB(0, 0), b2, voffB); PG8_STAGE(PG8_SB(0, 1), b2 + hstep, voffB); PG8_STAGE(PG8_SA(0, 0), a2, voffA);
            PG8_WAIT_V(8); PG8_WAIT_L(0); PG8_BAR; PG8_MMA(1, 0, At, B0); PG8_MMA(1, 1, At, B1); PG8_BAR; PG8_SCHED;
            PG8_LDB(B0, 1, 0); PG8_LDB(B1, 1, 1); PG8_SCHED; PG8_LDA(At, 1, 0); PG8_STAGE(PG8_SA(0, 1), a2 + hstep, voffA);
            PG8_WAIT_V(8); PG8_WAIT_L(0); PG8_BAR; PG8_MMA(0, 0, At, B0); PG8_MMA(0, 1, At, B1); PG8_BAR; PG8_SCHED;
            PG8_LDA(At, 1, 1); PG8_STAGE(PG8_SB(1, 0), b3, voffB); PG8_STAGE(PG8_SB(1, 1), b3 + hstep, voffB); PG8_STAGE(PG8_SA(1, 0), a3, voffA);
            PG8_WAIT_V(8); PG8_WAIT_L(0); PG8_BAR; PG8_MMA(1, 0, At, B0); PG8_MMA(1, 1, At, B1); PG8_BAR; PG8_SCHED;
            } else {
            PG8_LDB(B0, 0, 0); PG8_SCHED; PG8_LDA(At, 0, 0); PG8_STAGE(PG8_SA(1, 1), a1 + hstep, voffA);
            PG8_WAIT_L(8); PG8_BAR; PG8_WAIT_L(0); PG8_MMA(0, 0, At, B0); PG8_BAR; PG8_SCHED;
            PG8_LDB(B1, 0, 1); PG8_STAGE(PG8_SB(0, 0), b2, voffB);
            PG8_BAR; PG8_WAIT_L(0); PG8_MMA(0, 1, At, B1); PG8_BAR;
            PG8_LDA(At, 0, 1); PG8_STAGE(PG8_SA(0, 0), a2, voffA);
            PG8_BAR; PG8_WAIT_L(0); PG8_MMA(1, 0, At, B0); PG8_BAR; PG8_SCHED;
            PG8_STAGE(PG8_SB(0, 1), b2 + hstep, voffB);
            PG8_WAIT_V(6); PG8_BAR; PG8_MMA(1, 1, At, B1); PG8_BAR;
            PG8_LDB(B0, 1, 0); PG8_SCHED; PG8_LDA(At, 1, 0); PG8_STAGE(PG8_SA(0, 1), a2 + hstep, voffA);
            PG8_WAIT_L(8); PG8_BAR; PG8_WAIT_L(0); PG8_MMA(0, 0, At, B0); PG8_BAR; PG8_SCHED;
            PG8_LDB(B1, 1, 1); PG8_STAGE(PG8_SB(1, 0), b3, voffB);
            PG8_BAR; PG8_WAIT_L(0); PG8_MMA(0, 1, At, B1); PG8_BAR;
            PG8_LDA(At, 1, 1); PG8_STAGE(PG8_SA(1, 0), a3, voffA);
            PG8_BAR; PG8_WAIT_L(0); PG8_MMA(1, 0, At, B0); PG8_BAR; PG8_SCHED;
            PG8_STAGE(PG8_SB(1, 1), b3 + hstep, voffB);
            PG8_WAIT_V(6); PG8_BAR; PG8_MMA(1, 1, At, B1); PG8_BAR;
            }
        }
        if constexpr (ALIGN_EPI) { if (wr == 0) PG8_BAR; }
        if constexpr (!Epi::AFTER_DRAIN) { E(acc, cur, wr, wc, fr, fq); S.done(cur); }
        if (!has_next) break;
#pragma unroll
        for (int a = 0; a < 2; ++a)
#pragma unroll
            for (int b = 0; b < 2; ++b)
#pragma unroll
                for (int m = 0; m < 4; ++m)
#pragma unroll
                    for (int n = 0; n < 2; ++n) acc[a][b][m][n] = (f32x4){0.f, 0.f, 0.f, 0.f};
        cur = nxt; cA = nA; cB = nB; ++ui;
        if constexpr (ALIGN_EPI) { if (wr == 1) PG8_BAR; }
    }
    PG8_WAIT_V(0);
    if constexpr (!ALIGN_EPI) { if (wr == 0) PG8_BAR; }
    PG8_BAR;
    if constexpr (Epi::AFTER_DRAIN) { E.fused(acc, cur, wr, wc, fr, fq, lds, wid, lane); S.done(cur); }
#undef PG8_SA
#undef PG8_SB
#undef PG8_STAGE
#undef PG8_LDA
#undef PG8_LDB
#undef PG8_MMA
#undef PG8_WAIT_V
#undef PG8_WAIT_L
#undef PG8_BAR
#undef PG8_SCHED
}
__device__ __forceinline__ float bf2f(unsigned short h) { return __uint_as_float(((unsigned)h) << 16); }
__device__ __forceinline__ float fast_sigmoid(float x) { return __builtin_amdgcn_rcpf(1.0f + __builtin_amdgcn_exp2f(-1.4426950408889634f * x)); }
struct EpiG1 {
    static constexpr bool PERM = true, AFTER_DRAIN = false;
    bf16_t* U; bf16_t* G; const float* bias; const float* ssq;
    __device__ __forceinline__ void operator()(const f32x4 (&acc)[2][2][4][2], const Unit& u, int wr, int wc, int fr, int fq) const {
        const int row0 = u.pm * BM + wr * 64 + fr; int colt = u.pn * BM; const bool isg = colt >= 5376;
        bf16_t* base = U; int ldc = 5376; if (isg) { colt -= 5376; base = G; ldc = 3072; }
        const int col0 = colt + wc * 32 + 8 * fq;
        f32x4 bv[2][2];
#pragma unroll
        for (int bj = 0; bj < 2; ++bj)
#pragma unroll
            for (int n = 0; n < 2; ++n) bv[bj][n] = isg ? *(const f32x4*)(bias + col0 + bj * HALF + 4 * n) : (f32x4){0.f, 0.f, 0.f, 0.f};
        float rsq[2][4];
#pragma unroll
        for (int ai = 0; ai < 2; ++ai)
#pragma unroll
            for (int m = 0; m < 4; ++m) rsq[ai][m] = ssq ? __builtin_amdgcn_rsqf(ssq[row0 + ai * HALF + m * 16] * (1.0f / 1024.0f) + 1e-6f) : 1.0f;
#pragma unroll
        for (int ai = 0; ai < 2; ++ai)
#pragma unroll
            for (int m = 0; m < 4; ++m) { bf16_t* rowp = base + (size_t)(row0 + ai * HALF + m * 16) * ldc + col0;
                const float rs = rsq[ai][m];
#pragma unroll
                for (int bj = 0; bj < 2; ++bj) { f32x4 v0 = acc[ai][bj][m][0] * rs + bv[bj][0], v1 = acc[ai][bj][m][1] * rs + bv[bj][1];
                    if (isg) {
#pragma unroll
                        for (int e = 0; e < 4; ++e) { v0[e] = fast_sigmoid(v0[e]); v1[e] = fast_sigmoid(v1[e]); } }
                    u32x4 w; w.x = cvt_pk_bf16(v0[0], v0[1]); w.y = cvt_pk_bf16(v0[2], v0[3]); w.z = cvt_pk_bf16(v1[0], v1[1]); w.w = cvt_pk_bf16(v1[2], v1[3]);
                    *(u32x4*)(rowp + bj * HALF) = w; } }
    }
};
struct EpiG2 {
    static constexpr bool PERM = true, AFTER_DRAIN = false;
    const bf16_t* G; float* T; bf16_t* Mg; int npan;
    __device__ __forceinline__ void operator()(const f32x4 (&acc)[2][2][4][2], const Unit& u, int wr, int wc, int fr, int fq) const {
        const int b = u.pm / npan, pm = u.pm - b * npan, pn = u.pn & 3;
        const int row0 = pm * BM + wr * 64 + fr, col0 = pn * BM + wc * 32 + 8 * fq;
#pragma unroll
        for (int ai = 0; ai < 2; ++ai)
#pragma unroll
          for (int mh = 0; mh < 2; ++mh) {
            u32x4 gq[4][2], tq[4][2];
#pragma unroll
            for (int m = 2 * mh; m < 2 * mh + 2; ++m)
#pragma unroll
                for (int bj = 0; bj < 2; ++bj) { const size_t row = (size_t)(row0 + ai * HALF + m * 16); const int col = col0 + bj * HALF;
                    gq[m][bj] = *(const u32x4*)(G + row * 3072 + b * 1024 + col);
                    tq[m][bj] = (b > 0) ? *(const u32x4*)(Mg + row * 1024 + col) : (u32x4){0u, 0u, 0u, 0u}; }
            __builtin_amdgcn_sched_barrier(0);
#pragma unroll
            for (int m = 2 * mh; m < 2 * mh + 2; ++m)
#pragma unroll
                for (int bj = 0; bj < 2; ++bj) { const size_t row = (size_t)(row0 + ai * HALF + m * 16); const int col = col0 + bj * HALF; const u32x4 g = gq[m][bj], t = tq[m][bj];
                    f32x4 v0 = acc[ai][bj][m][0], v1 = acc[ai][bj][m][1];
                    v0[0] = v0[0] * __uint_as_float(g.x << 16) + __uint_as_float(t.x << 16); v0[1] = v0[1] * __uint_as_float(g.x & 0xffff0000u) + __uint_as_float(t.x & 0xffff0000u);
                    v0[2] = v0[2] * __uint_as_float(g.y << 16) + __uint_as_float(t.y << 16); v0[3] = v0[3] * __uint_as_float(g.y & 0xffff0000u) + __uint_as_float(t.y & 0xffff0000u);
                    v1[0] = v1[0] * __uint_as_float(g.z << 16) + __uint_as_float(t.z << 16); v1[1] = v1[1] * __uint_as_float(g.z & 0xffff0000u) + __uint_as_float(t.z & 0xffff0000u);
                    v1[2] = v1[2] * __uint_as_float(g.w << 16) + __uint_as_float(t.w << 16); v1[3] = v1[3] * __uint_as_float(g.w & 0xffff0000u) + __uint_as_float(t.w & 0xffff0000u);
                    u32x4 w; w.x = cvt_pk_bf16(v0[0], v0[1]); w.y = cvt_pk_bf16(v0[2], v0[3]); w.z = cvt_pk_bf16(v1[0], v1[1]); w.w = cvt_pk_bf16(v1[2], v1[3]);
                    *(u32x4*)(Mg + row * 1024 + col) = w; }
            __builtin_amdgcn_sched_barrier(0); }
    }
};
struct OrderG2 {
    int npan, G, c;
    __device__ bool next(int i, Unit& u) const { const int ti = i / 3, b = i - 3 * ti, t = ti * G + c; if (t >= npan * 4) return false;
        const int pm = t >> 2, pn = t & 3; u.pm = b * npan + pm; u.pn = b * 4 + pn; return true; }
    __device__ __forceinline__ void a_ready(const Unit&) const {}
    __device__ __forceinline__ void done(const Unit&) const {}
};
struct EpiG3 {
    static constexpr bool PERM = true, AFTER_DRAIN = false;
    const float* X; float* O; const float* gn; bf16_t* HN; float* ssq; int fuse;
    __device__ __forceinline__ void operator()(const f32x4 (&acc)[2][2][4][2], const Unit& u, int wr, int wc, int fr, int fq) const {
        const int row0 = u.pm * BM + wr * 64 + fr, col0 = u.pn * BM + wc * 32 + 8 * fq;
        f32x4 gv[2][2];
#pragma unroll
        for (int bj = 0; bj < 2; ++bj)
#pragma unroll
            for (int n = 0; n < 2; ++n) gv[bj][n] = fuse ? *(const f32x4*)(gn + col0 + bj * HALF + 4 * n) : (f32x4){0.f, 0.f, 0.f, 0.f};
#pragma unroll
        for (int ai = 0; ai < 2; ++ai)
#pragma unroll
         for (int mh = 0; mh < 2; ++mh) {
          f32x4 xq[4][2][2];
#pragma unroll
          for (int m = 2 * mh; m < 2 * mh + 2; ++m)
#pragma unroll
              for (int bj = 0; bj < 2; ++bj) { const size_t p = (size_t)(row0 + ai * HALF + m * 16) * 1024 + col0 + bj * HALF; xq[m][bj][0] = *(const f32x4*)(X + p); xq[m][bj][1] = *(const f32x4*)(X + p + 4); }
          __builtin_amdgcn_sched_barrier(0);
#pragma unroll
            for (int m = 2 * mh; m < 2 * mh + 2; ++m) { const size_t row = (size_t)(row0 + ai * HALF + m * 16); float sq = 0.f;
#pragma unroll
                for (int bj = 0; bj < 2; ++bj) { const size_t p = row * 1024 + col0 + bj * HALF;
                    const f32x4 x0 = xq[m][bj][0], x1 = xq[m][bj][1];
                    const f32x4 o0 = x0 + acc[ai][bj][m][0], o1 = x1 + acc[ai][bj][m][1];
                    *(f32x4*)(O + p) = o0; *(f32x4*)(O + p + 4) = o1;
                    if (fuse) { const f32x4 h0 = o0 * gv[bj][0], h1 = o1 * gv[bj][1];
                        u32x4 w; w.x = cvt_pk_bf16(h0[0], h0[1]); w.y = cvt_pk_bf16(h0[2], h0[3]); w.z = cvt_pk_bf16(h1[0], h1[1]); w.w = cvt_pk_bf16(h1[2], h1[3]);
                        *(u32x4*)(HN + p) = w;
                        sq += (o0[0] * o0[0] + o0[1] * o0[1]) + (o0[2] * o0[2] + o0[3] * o0[3]) + (o1[0] * o1[0] + o1[1] * o1[1]) + (o1[2] * o1[2] + o1[3] * o1[3]); } }
                if (fuse) { sq += shx(sq, 16); sq += shx(sq, 32); if (fq == 0) atomicAdd(ssq + row, sq); } }
          __builtin_amdgcn_sched_barrier(0); }
    }
};
struct EpiAll {
    static constexpr bool PERM = true, AFTER_DRAIN = false;
    int mode; EpiG1 e1; EpiG2 e2; EpiG3 e3;
    __device__ __forceinline__ void operator()(const f32x4 (&acc)[2][2][4][2], const Unit& u, int wr, int wc, int fr, int fq) const {
        if (mode == 1) e1(acc, u, wr, wc, fr, fq); else if (mode == 2) e2(acc, u, wr, wc, fr, fq); else e3(acc, u, wr, wc, fr, fq); }
};
struct OrderAll {
    int mode; StaticOrder so; OrderG2 o2;
    __device__ __forceinline__ bool next(int i, Unit& u) const { return mode == 2 ? o2.next(i, u) : so.next(i, u); }
    __device__ __forceinline__ void a_ready(const Unit&) const {}
    __device__ __forceinline__ void done(const Unit&) const {}
};
}
#ifndef DUP_MASK
#define DUP_MASK 0
#endif
#ifndef EN_MASK
#define EN_MASK 0xffff
#endif
#define EN(i) ((EN_MASK >> (i)) & 1)
#define LAS __attribute__((address_space(3)))
typedef unsigned short bf16;
typedef float f32x4 __attribute__((ext_vector_type(4)));
typedef float f32x2 __attribute__((ext_vector_type(2)));
typedef unsigned u32x4 __attribute__((ext_vector_type(4)));
typedef unsigned u32x2 __attribute__((ext_vector_type(2)));
constexpr int DM = 1024, NTOK_P = 65536, NTOK_S = 32768, NTOK = NTOK_P + NTOK_S, LP = 8192, LS = 2048;
constexpr int CH = 16384, NCHUNK = NTOK / CH, NCH_P = NTOK_P / CH;
constexpr int UP = 5376, NCAT = 8448, GP = 3072;
constexpr int C_X0 = 0, C_X1 = 512, C_HV = 1024, C_HG = 1536, C_GQ = 2048, C_GK = 2560, C_GV = 2688, C_GG = 2816, C_DQ = 3328, C_DK = 3840, C_DV = 4352, C_DG = 4864;
constexpr float EPS = 1e-6f, LOG2E = 1.4426950408889634f;
constexpr int NT = 512, NWAVES = 8;
enum { I_XP = 0, I_XS, I_RELB, I_NORMG, I_WIN, I_CONVW, I_CONVB, I_FW1, I_FB1, I_FW2, I_FB2, I_FWOUT, I_FFREQ, I_HYBIAS, I_QNG, I_KNG, I_LQ1, I_LK1, I_LQ2, I_LK2, I_SUBLN, I_WBHY, I_WBGQ, I_WBDF, I_WMERGE, I_BMERGE, I_WOUT, I_FINALG, N_IN };
constexpr size_t MiB = 1u << 20;
constexpr size_t WS_CTL = 0, CTL_BYTES = 64 * 1024;
constexpr size_t WS_TW = 1 * MiB;
constexpr size_t WS_WCAT = 2 * MiB, WCAT_BYTES = (size_t)NCAT * 1024 * 2;
constexpr size_t WS_WBT = 40 * MiB, WBT_BYTES = (size_t)3 * 1024 * 512 * 2;
constexpr size_t WS_WOT = 46 * MiB, WOT_BYTES = (size_t)1024 * 1024 * 2;
constexpr int SPS_P = LP + 16, SPS_S = LS + 16;
constexpr size_t SPEC_P_BYTES = (size_t)256 * SPS_P * 8, SPEC_S_BYTES = (size_t)256 * SPS_S * 8;
constexpr size_t SPEC_LAYER = 2 * SPEC_P_BYTES + 2 * SPEC_S_BYTES;
constexpr size_t WS_SPEC = 52 * MiB;
constexpr size_t WS_HN = 140 * MiB, WS_U = 172 * MiB, WS_G = 340 * MiB, WS_Y = 436 * MiB, WS_MG = 484 * MiB, WS_TMP = 516 * MiB, WS_DT = 580 * MiB, WS_HVP = 612 * MiB, WS_PMP = 644 * MiB, WS_ROPE = 676 * MiB, WS_HN0 = 680 * MiB, WS_END = 872 * MiB;
constexpr size_t HF_P_BYTES = (size_t)LP * 1024 * 4, HF_S_BYTES = (size_t)LS * 1024 * 4;
static_assert(WS_WCAT + 2 * WCAT_BYTES <= WS_WBT && WS_WBT + 2 * WBT_BYTES <= WS_WOT && WS_WOT + 2 * WOT_BYTES <= WS_SPEC && WS_SPEC + 2 * SPEC_LAYER <= WS_HN, "ws map");
static_assert(WS_HN + (size_t)CH * 1024 * 2 <= WS_U && WS_U + (size_t)CH * UP * 2 <= WS_G && WS_G + (size_t)CH * GP * 2 <= WS_Y && WS_Y + (size_t)3 * CH * 512 * 2 <= WS_MG && WS_MG + (size_t)CH * 1024 * 2 <= WS_TMP && WS_TMP + (size_t)CH * 1024 * 4 <= WS_DT && WS_DT + (size_t)CH * 512 * 4 <= WS_END, "ws map 2");
static_assert(2 * (HF_P_BYTES + HF_S_BYTES) <= (size_t)CH * UP * 2, "hf overlay");
constexpr size_t WS_SSQ = WS_TMP;
constexpr int LDS_MAIN = 139264, LDS_BYTES = LDS_MAIN + 1024;
constexpr int CW_BAR = 4096;

struct Args { const float* in[N_IN]; float* out; unsigned char* ws; int lo, hi; };
typedef const __attribute__((address_space(4))) unsigned long long* kargp_t;
struct AV { kargp_t p; };
#define AIN(i) ((const float*)(a.p[(i)]))
#define AOUT ((float*)(a.p[N_IN]))
#define AWS ((unsigned char*)(a.p[N_IN + 1]))


__device__ __forceinline__ float bf2f(unsigned short h) { return __uint_as_float(((unsigned)h) << 16); }
__device__ __forceinline__ float bflo(unsigned w) { return __uint_as_float(w << 16); }
__device__ __forceinline__ float bfhi(unsigned w) { return __uint_as_float(w & 0xffff0000u); }
__device__ __forceinline__ unsigned f2bf(float f) { unsigned u = __builtin_bit_cast(unsigned, f); return (u + 0x7fffu + ((u >> 16) & 1u)) >> 16; }
__device__ __forceinline__ unsigned pk2(float lo, float hi) { return f2bf(lo) | (f2bf(hi) << 16); }
__device__ __forceinline__ float silu(float x) { return x * __builtin_amdgcn_rcpf(1.0f + __builtin_amdgcn_exp2f(-LOG2E * x)); }
__device__ __forceinline__ float wave_sum(float v) {
#pragma unroll
    for (int o = 1; o < 64; o <<= 1) v += shx(v, o);
    return v;
}
__device__ __forceinline__ double kd(double v) { asm volatile("" : "+s"(v)); return v; }
__device__ __forceinline__ void sincos_rev(double r, float& s, float& c) {
    r -= __builtin_rint(r);
    const double k = __builtin_rint(r * 4.0);
    const double x = (r - k * 0.25) * kd(6.283185307179586476925);
    const double x2 = x * x;
    double sp = kd(1.0 / 6227020800.0); sp = sp * x2 + kd(-1.0 / 39916800); sp = sp * x2 + kd(1.0 / 362880); sp = sp * x2 + kd(-1.0 / 5040); sp = sp * x2 + kd(1.0 / 120); sp = sp * x2 + kd(-1.0 / 6); sp = sp * x2 + 1.0; sp *= x;
    double cp = kd(-1.0 / 87178291200.0); cp = cp * x2 + kd(1.0 / 479001600.0); cp = cp * x2 + kd(-1.0 / 3628800); cp = cp * x2 + kd(1.0 / 40320); cp = cp * x2 + kd(-1.0 / 720); cp = cp * x2 + kd(1.0 / 24); cp = cp * x2 + (-0.5); cp = cp * x2 + 1.0;
    const int q = ((int)k) & 3;
    const float sf = (float)sp, cf = (float)cp;
    s = (q == 0) ? sf : (q == 1) ? cf : (q == 2) ? -sf : -cf;
    c = (q == 0) ? cf : (q == 1) ? -sf : (q == 2) ? -cf : sf;
}
__device__ __forceinline__ float sin_acc(float x) { float s, c; sincos_rev((double)x * 0.15915494309189533577, s, c); return s; }

__device__ __forceinline__ void transpose_item(const float* W, int K, int N, bf16* WT, int row_off, LAS float* scr, int item, int lane) {
    const int nblk = N / 32, kb = item / nblk, nb = item % nblk, k0 = 64 * kb, n0 = 32 * nb;
#pragma unroll 8
    for (int i = 0; i < 32; ++i) { const int kk = 2 * i + (lane >> 5); scr[kk * 33 + (lane & 31)] = W[(size_t)(k0 + kk) * N + n0 + (lane & 31)]; }
    asm volatile("s_waitcnt lgkmcnt(0)" ::: "memory");
    const int c = lane & 7;
#pragma unroll
    for (int j = 0; j < 4; ++j) { const int n = (lane >> 3) + 8 * j; const LAS float* s = scr + (8 * c) * 33 + n;
        u32x4 o; o.x = pk2(s[0 * 33], s[1 * 33]); o.y = pk2(s[2 * 33], s[3 * 33]); o.z = pk2(s[4 * 33], s[5 * 33]); o.w = pk2(s[6 * 33], s[7 * 33]);
        *(u32x4*)(WT + (size_t)(row_off + n0 + n) * K + k0 + 8 * c) = o; }
    asm volatile("s_waitcnt lgkmcnt(0)" ::: "memory");
}

__device__ __forceinline__ f32x2 cmul(f32x2 a, f32x2 b) { return (f32x2){a.x * b.x - a.y * b.y, a.x * b.y + a.y * b.x}; }
__device__ __forceinline__ f32x2 cmulc(f32x2 a, f32x2 b) { return (f32x2){a.x * b.x + a.y * b.y, a.y * b.x - a.x * b.y}; }
__device__ __forceinline__ f32x2 cconj(f32x2 a) { return (f32x2){a.x, -a.y}; }
template <int LOG4> __device__ __forceinline__ int digitrev(int k) { unsigned x = __builtin_bitreverse32((unsigned)k) >> (32 - 2 * LOG4); return (int)(((x & 0x55555555u) << 1) | ((x >> 1) & 0x55555555u)); }
__device__ __forceinline__ unsigned cvtpk(float lo, float hi);
#define PADI(i) ((i) + ((i) >> 4))
#define W16C 0.92387953251128674f
#define W16S 0.38268343236508977f
#define W16H 0.70710678118654752f
__device__ __forceinline__ f32x2 w16(int m) { return m == 0 ? (f32x2){1.f, 0.f} : m == 1 ? (f32x2){W16C, -W16S} : m == 2 ? (f32x2){W16H, -W16H} : m == 3 ? (f32x2){W16S, -W16C} : m == 4 ? (f32x2){0.f, -1.f} : m == 6 ? (f32x2){-W16H, -W16H} : (f32x2){-W16C, W16S}; }
__device__ __forceinline__ void bfly_fwd(f32x2& a0, f32x2& a1, f32x2& a2, f32x2& a3) {
    const f32x2 t0 = a0 + a2, t1 = a0 - a2, t2 = a1 + a3, t3 = a1 - a3;
    a0 = t0 + t2; a2 = t0 - t2; a1 = (f32x2){t1.x + t3.y, t1.y - t3.x}; a3 = (f32x2){t1.x - t3.y, t1.y + t3.x};
}
__device__ __forceinline__ void bfly_inv(f32x2& b0, f32x2& b1, f32x2& b2, f32x2& b3) {
    const f32x2 t0 = b0 + b2, t1 = b0 - b2, t2 = b1 + b3, t3 = b1 - b3;
    b0 = t0 + t2; b2 = t0 - t2; b1 = (f32x2){t1.x - t3.y, t1.y + t3.x}; b3 = (f32x2){t1.x + t3.y, t1.y - t3.x};
}
__device__ __forceinline__ void tail_fwd(f32x2 (&x)[16]) {
#pragma unroll
    for (int jj = 0; jj < 4; ++jj) { bfly_fwd(x[jj], x[jj + 4], x[jj + 8], x[jj + 12]); if (jj) { x[jj + 4] = cmul(x[jj + 4], w16(jj)); x[jj + 8] = cmul(x[jj + 8], w16(2 * jj)); x[jj + 12] = cmul(x[jj + 12], w16(3 * jj)); } }
#pragma unroll
    for (int q = 0; q < 4; ++q) bfly_fwd(x[4 * q], x[4 * q + 1], x[4 * q + 2], x[4 * q + 3]);
}
__device__ __forceinline__ void tail_inv(f32x2 (&x)[16]) {
#pragma unroll
    for (int q = 0; q < 4; ++q) bfly_inv(x[4 * q], x[4 * q + 1], x[4 * q + 2], x[4 * q + 3]);
#pragma unroll
    for (int jj = 0; jj < 4; ++jj) { if (jj) { x[jj + 4] = cmulc(x[jj + 4], w16(jj)); x[jj + 8] = cmulc(x[jj + 8], w16(2 * jj)); x[jj + 12] = cmulc(x[jj + 12], w16(3 * jj)); } bfly_inv(x[jj], x[jj + 4], x[jj + 8], x[jj + 12]); }
}
__device__ __forceinline__ void pair_mul(f32x2& z1, f32x2& z2, f32x2 P, f32x2 M) { const f32x2 a = z1, b = z2; z1 = cmul(a, P) + cmul(cconj(b), M); z2 = cmulc(b, P) + cmulc(cconj(a), M); }
template <int LOG4, int BATCH> __device__ __forceinline__ void fft_tail_mul_tail(LAS f32x2* buf, const f32x2* __restrict__ Pg, const f32x2* __restrict__ Mg, int sps, int tid) {
    constexpr int N = 1 << (2 * LOG4), NB = N / 16, NI = NB / 2, NPAD = N + N / 16, TOT = BATCH * NI, IT = (TOT + NT - 1) / NT;
#define RR(e_) ((((e_) & 3) << 2) | ((e_) >> 2))
#pragma unroll 1
    for (int i = 0; i < IT; ++i) { const int ig = tid + i * NT; if (TOT % NT != 0 && ig >= TOT) break;
        const int bt = ig / NI, u = ig - bt * NI; if (u == 0) continue;
        const f32x2* P = Pg + (size_t)bt * sps; const f32x2* M = Mg + (size_t)bt * sps;
        const int bA = ((u >> 1) << 2) | (u & 1), bB = digitrev<LOG4 - 2>(NB - digitrev<LOG4 - 2>(bA));
        LAS f32x2* xa = buf + bt * NPAD + 17 * bA; LAS f32x2* xb = buf + bt * NPAD + 17 * bB;
        f32x2 x[16], y[16];
#pragma unroll
        for (int e = 0; e < 16; ++e) { x[e] = xa[e]; y[e] = xb[e]; }
        tail_fwd(x); tail_fwd(y);
#pragma unroll
        for (int e = 0; e < 16; ++e) if ((e & 3) < 2) { const int Re = RR(e), ep = RR(15 - Re);
            pair_mul(x[e], y[ep], P[bA * 8 + Re], M[bA * 8 + Re]);
            pair_mul(y[e], x[ep], P[bB * 8 + Re], M[bB * 8 + Re]);
            if ((e & 7) == 5) __builtin_amdgcn_sched_barrier(0); }
        tail_inv(x); tail_inv(y);
#pragma unroll
        for (int e = 0; e < 16; ++e) { xa[e] = x[e]; xb[e] = y[e]; }
    }
    if (tid < 2 * BATCH) {
        const int bt = tid >> 1, sel = tid & 1; const f32x2* P = Pg + (size_t)bt * sps; const f32x2* M = Mg + (size_t)bt * sps;
        LAS f32x2* xa = buf + bt * NPAD + 17 * digitrev<LOG4 - 2>(sel ? NB / 2 : 0);
        f32x2 x[16];
#pragma unroll
        for (int e = 0; e < 16; ++e) x[e] = xa[e];
        tail_fwd(x);
        if (sel == 0) {
            { f32x2 t = x[0]; pair_mul(x[0], t, P[0], M[0]); }
            { f32x2 t = x[2]; pair_mul(x[2], t, P[N / 2], M[N / 2]); }
#pragma unroll
            for (int e = 1; e < 16; ++e) if ((e & 3) < 2) { const int Re = RR(e), ep = RR(16 - Re); pair_mul(x[e], x[ep], P[Re], M[Re]); }
        } else {
#pragma unroll
            for (int e = 0; e < 16; ++e) if ((e & 3) < 2) { const int Re = RR(e), ep = RR(15 - Re); const int sl = digitrev<LOG4 - 2>(NB / 2) * 8 + Re; pair_mul(x[e], x[ep], P[sl], M[sl]); }
        }
        tail_inv(x);
#pragma unroll
        for (int e = 0; e < 16; ++e) xa[e] = x[e];
    }
#undef RR
    __syncthreads();
}
template <int LOG4, int BATCH = 1, int PS0 = 0, bool TAIL = true> __device__ __forceinline__ void fft_fwd(LAS f32x2* buf, const f32x2* __restrict__ tw, int tid) {
    constexpr int N = 1 << (2 * LOG4), TWS = 16384 / N;
    constexpr int NPAD = N + N / 16, NLEV = LOG4 - 2, NP16 = NLEV / 2;
#pragma unroll 1
    for (int ps = PS0; ps < NP16; ++ps) {
        const int lq4 = 2 * (LOG4 - 2 * ps) - 2, lq16 = lq4 - 2, q4 = 1 << lq4, q16 = 1 << lq16, tsA = TWS << (4 * ps), tsB = tsA << 2;
        constexpr int TOT = BATCH * N / 16, IT = (TOT + NT - 1) / NT;
#pragma unroll
        for (int i = 0; i < IT; ++i) { const int jg = tid + i * NT; if (TOT % NT != 0 && jg >= TOT) break; const int bo = (jg >> (2 * LOG4 - 4)) * NPAD, j = jg & (N / 16 - 1);
            const int blk = j >> lq16, jj = j & (q16 - 1), base = (blk << (lq4 + 2)) + jj;
            f32x2 wa[4], wb = tw[jj * tsB];
#pragma unroll
            for (int b = 0; b < 4; ++b) wa[b] = tw[(jj + b * q16) * tsA];
            f32x2 e[4][4];
#pragma unroll
            for (int a = 0; a < 4; ++a)
#pragma unroll
                for (int b = 0; b < 4; ++b) e[a][b] = buf[bo + PADI(base + b * q16 + a * q4)];
#pragma unroll
            for (int b = 0; b < 4; ++b) { bfly_fwd(e[0][b], e[1][b], e[2][b], e[3][b]); const f32x2 w2 = cmul(wa[b], wa[b]), w3 = cmul(w2, wa[b]); e[1][b] = cmul(e[1][b], wa[b]); e[2][b] = cmul(e[2][b], w2); e[3][b] = cmul(e[3][b], w3); }
            { const f32x2 w2 = cmul(wb, wb), w3 = cmul(w2, wb);
#pragma unroll
              for (int a = 0; a < 4; ++a) { bfly_fwd(e[a][0], e[a][1], e[a][2], e[a][3]); e[a][1] = cmul(e[a][1], wb); e[a][2] = cmul(e[a][2], w2); e[a][3] = cmul(e[a][3], w3); } }
#pragma unroll
            for (int a = 0; a < 4; ++a)
#pragma unroll
                for (int b = 0; b < 4; ++b) buf[bo + PADI(base + b * q16 + a * q4)] = e[a][b];
        }
        __syncthreads();
    }
#pragma unroll 1
    for (int pass = 2 * NP16; pass < NLEV; ++pass) {
        const int lq = 2 * (LOG4 - pass) - 2, q4 = 1 << lq, n = q4 << 2, tstep = TWS << (2 * pass);
        constexpr int IT = BATCH * N / 4 / NT;
        f32x2 wl[IT];
#pragma unroll
        for (int i = 0; i < IT; ++i) wl[i] = tw[((tid + i * NT) & (q4 - 1)) * tstep];
#pragma unroll
        for (int i = 0; i < IT; ++i) { const int jg = tid + i * NT, bo = (jg >> (2 * LOG4 - 2)) * NPAD, j = jg & (N / 4 - 1);
            const int blk = j >> lq, jj = j & (q4 - 1), base = blk * n + jj;
            const int i0 = bo + PADI(base), i1 = bo + PADI(base + q4), i2 = bo + PADI(base + 2 * q4), i3 = bo + PADI(base + 3 * q4);
            const f32x2 w1 = wl[i];
            f32x2 a0 = buf[i0], a1 = buf[i1], a2 = buf[i2], a3 = buf[i3];
            bfly_fwd(a0, a1, a2, a3);
            const f32x2 w2 = cmul(w1, w1), w3 = cmul(w2, w1);
            buf[i0] = a0; buf[i1] = cmul(a1, w1); buf[i2] = cmul(a2, w2); buf[i3] = cmul(a3, w3);
        }
        __syncthreads();
    }
    if constexpr (TAIL) {
#pragma unroll 1
    for (int b = tid; b < BATCH * N / 16; b += NT) {
        LAS f32x2* xb = buf + 17 * b; f32x2 x[16];
#pragma unroll
        for (int e = 0; e < 16; ++e) x[e] = xb[e];
        tail_fwd(x);
#pragma unroll
        for (int e = 0; e < 16; ++e) xb[e] = x[e];
    }
    __syncthreads(); }
}
template <int LOG4, int BATCH = 1, int PS0 = 0, bool TAIL = true> __device__ __forceinline__ void fft_inv(LAS f32x2* buf, const f32x2* __restrict__ tw, int tid) {
    constexpr int N = 1 << (2 * LOG4), TWS = 16384 / N;
    if constexpr (TAIL) {
#pragma unroll 1
    for (int b = tid; b < BATCH * N / 16; b += NT) {
        LAS f32x2* xb = buf + 17 * b; f32x2 x[16];
#pragma unroll
        for (int e = 0; e < 16; ++e) x[e] = xb[e];
        tail_inv(x);
#pragma unroll
        for (int e = 0; e < 16; ++e) xb[e] = x[e];
    }
    __syncthreads(); }
    constexpr int NPAD = N + N / 16, NLEV = LOG4 - 2, NP16 = NLEV / 2;
#pragma unroll 1
    for (int pass = NLEV - 1; pass >= 2 * NP16; --pass) {
        const int lq = 2 * (LOG4 - pass) - 2, q4 = 1 << lq, n = q4 << 2, tstep = TWS << (2 * pass);
        constexpr int IT = BATCH * N / 4 / NT;
        f32x2 wl[IT];
#pragma unroll
        for (int i = 0; i < IT; ++i) wl[i] = tw[((tid + i * NT) & (q4 - 1)) * tstep];
#pragma unroll
        for (int i = 0; i < IT; ++i) { const int jg = tid + i * NT, bo = (jg >> (2 * LOG4 - 2)) * NPAD, j = jg & (N / 4 - 1);
            const int blk = j >> lq, jj = j & (q4 - 1), base = blk * n + jj;
            const int i0 = bo + PADI(base), i1 = bo + PADI(base + q4), i2 = bo + PADI(base + 2 * q4), i3 = bo + PADI(base + 3 * q4);
            const f32x2 w1 = wl[i];
            const f32x2 w2 = cmul(w1, w1), w3 = cmul(w2, w1);
            f32x2 b0 = buf[i0], b1 = cmulc(buf[i1], w1), b2 = cmulc(buf[i2], w2), b3 = cmulc(buf[i3], w3);
            bfly_inv(b0, b1, b2, b3);
            buf[i0] = b0; buf[i1] = b1; buf[i2] = b2; buf[i3] = b3;
        }
        __syncthreads();
    }
#pragma unroll 1
    for (int ps = NP16 - 1; ps >= PS0; --ps) {
        const int lq4 = 2 * (LOG4 - 2 * ps) - 2, lq16 = lq4 - 2, q4 = 1 << lq4, q16 = 1 << lq16, tsA = TWS << (4 * ps), tsB = tsA << 2;
        constexpr int TOT = BATCH * N / 16, IT = (TOT + NT - 1) / NT;
#pragma unroll
        for (int i = 0; i < IT; ++i) { const int jg = tid + i * NT; if (TOT % NT != 0 && jg >= TOT) break; const int bo = (jg >> (2 * LOG4 - 4)) * NPAD, j = jg & (N / 16 - 1);
            const int blk = j >> lq16, jj = j & (q16 - 1), base = (blk << (lq4 + 2)) + jj;
            f32x2 wa[4], wb = tw[jj * tsB];
#pragma unroll
            for (int b = 0; b < 4; ++b) wa[b] = tw[(jj + b * q16) * tsA];
            f32x2 e[4][4];
#pragma unroll
            for (int a = 0; a < 4; ++a)
#pragma unroll
                for (int b = 0; b < 4; ++b) e[a][b] = buf[bo + PADI(base + b * q16 + a * q4)];
            { const f32x2 w2 = cmul(wb, wb), w3 = cmul(w2, wb);
#pragma unroll
              for (int a = 0; a < 4; ++a) { e[a][1] = cmulc(e[a][1], wb); e[a][2] = cmulc(e[a][2], w2); e[a][3] = cmulc(e[a][3], w3); bfly_inv(e[a][0], e[a][1], e[a][2], e[a][3]); } }
#pragma unroll
            for (int b = 0; b < 4; ++b) { const f32x2 w2 = cmul(wa[b], wa[b]), w3 = cmul(w2, wa[b]); e[1][b] = cmulc(e[1][b], wa[b]); e[2][b] = cmulc(e[2][b], w2); e[3][b] = cmulc(e[3][b], w3); bfly_inv(e[0][b], e[1][b], e[2][b], e[3][b]); }
#pragma unroll
            for (int a = 0; a < 4; ++a)
#pragma unroll
                for (int b = 0; b < 4; ++b) buf[bo + PADI(base + b * q16 + a * q4)] = e[a][b];
        }
        __syncthreads();
    }
}
template <int LOG4> __device__ __forceinline__ void fft_first_from_global(LAS f32x2* buf, const f32x2* __restrict__ tw, const f32x2* __restrict__ src, int tid) {
    constexpr int N = 1 << (2 * LOG4), TWS = 16384 / N, q4 = N / 4, q16 = N / 16, IT = N / 16 / NT;
    static_assert(N / 16 % NT == 0, "one or more items per thread");
#pragma unroll
    for (int i = 0; i < IT; ++i) { const int jj = tid + i * NT;
        f32x2 wa[4], wb = tw[jj * (TWS << 2)];
#pragma unroll
        for (int b = 0; b < 4; ++b) wa[b] = tw[(jj + b * q16) * TWS];
        f32x2 e[4][4];
#pragma unroll
        for (int b = 0; b < 4; ++b) { e[0][b] = src[jj + b * q16]; e[1][b] = src[jj + b * q16 + q4]; e[2][b] = (f32x2){0.f, 0.f}; e[3][b] = (f32x2){0.f, 0.f}; }
#pragma unroll
        for (int b = 0; b < 4; ++b) { bfly_fwd(e[0][b], e[1][b], e[2][b], e[3][b]); const f32x2 w2 = cmul(wa[b], wa[b]), w3 = cmul(w2, wa[b]); e[1][b] = cmul(e[1][b], wa[b]); e[2][b] = cmul(e[2][b], w2); e[3][b] = cmul(e[3][b], w3); }
        { const f32x2 w2 = cmul(wb, wb), w3 = cmul(w2, wb);
#pragma unroll
          for (int a = 0; a < 4; ++a) { bfly_fwd(e[a][0], e[a][1], e[a][2], e[a][3]); e[a][1] = cmul(e[a][1], wb); e[a][2] = cmul(e[a][2], w2); e[a][3] = cmul(e[a][3], w3); } }
#pragma unroll
        for (int a = 0; a < 4; ++a)
#pragma unroll
            for (int b = 0; b < 4; ++b) buf[PADI(jj + b * q16 + a * q4)] = e[a][b];
    }
    __syncthreads();
}
template <int LOG4> __device__ __forceinline__ void fft_last_to_global(const LAS f32x2* buf, const f32x2* __restrict__ tw, const f32x2* __restrict__ pm, bf16* Yc, int tid) {
    constexpr int N = 1 << (2 * LOG4), TWS = 16384 / N, q4 = N / 4, q16 = N / 16, IT = N / 16 / NT;
#pragma unroll
    for (int i = 0; i < IT; ++i) { const int jj = tid + i * NT;
        f32x2 wa[4], wb = tw[jj * (TWS << 2)];
#pragma unroll
        for (int b = 0; b < 4; ++b) wa[b] = tw[(jj + b * q16) * TWS];
        f32x2 pmv[2][4];
#pragma unroll
        for (int a = 0; a < 2; ++a)
#pragma unroll
            for (int b = 0; b < 4; ++b) pmv[a][b] = pm[jj + b * q16 + a * q4];
        f32x2 e[4][4];
#pragma unroll
        for (int a = 0; a < 4; ++a)
#pragma unroll
            for (int b = 0; b < 4; ++b) e[a][b] = buf[PADI(jj + b * q16 + a * q4)];
        { const f32x2 w2 = cmul(wb, wb), w3 = cmul(w2, wb);
#pragma unroll
          for (int a = 0; a < 4; ++a) { e[a][1] = cmulc(e[a][1], wb); e[a][2] = cmulc(e[a][2], w2); e[a][3] = cmulc(e[a][3], w3); bfly_inv(e[a][0], e[a][1], e[a][2], e[a][3]); } }
#pragma unroll
        for (int b = 0; b < 4; ++b) { const f32x2 w2 = cmul(wa[b], wa[b]), w3 = cmul(w2, wa[b]); e[1][b] = cmulc(e[1][b], wa[b]); e[2][b] = cmulc(e[2][b], w2); e[3][b] = cmulc(e[3][b], w3); bfly_inv(e[0][b], e[1][b], e[2][b], e[3][b]); }
#pragma unroll
        for (int a = 0; a < 2; ++a)
#pragma unroll
            for (int b = 0; b < 4; ++b) { const int t = jj + b * q16 + a * q4; *(unsigned*)(Yc + (size_t)t * 512) = cvtpk(e[a][b].x * pmv[a][b].x, e[a][b].y * pmv[a][b].y); }
    }
}
__device__ const double ROPE_IF[16] = {1.0, 0.5623413251903491, 0.31622776601683794, 0.1778279410038923, 0.1, 0.05623413251903491, 0.03162277660168379, 0.01778279410038923,
    0.01, 0.005623413251903491, 0.0031622776601683794, 0.0017782794100389228, 0.001, 0.0005623413251903491, 0.00031622776601683794, 0.00017782794100389227};
struct Chunk { int tok0, L, nseq; };
__device__ __forceinline__ Chunk chunk_of(int c) { Chunk k; k.tok0 = c * CH; if (c < NCH_P) { k.L = LP; k.nseq = CH / LP; } else { k.L = LS; k.nseq = CH / LS; } return k; }
__device__ __forceinline__ const float* xin_rows(const AV& a, int tok0) { return tok0 < NTOK_P ? AIN(I_XP) + (size_t)tok0 * DM : AIN(I_XS) + (size_t)(tok0 - NTOK_P) * DM; }
__device__ __forceinline__ void hf_group(LAS float* sm, const AV& a, int layer, int L, int t0, float* hf, int tid) {
    LAS float* zs = sm; LAS float* A = sm + 512; LAS float* B = sm + 1024;
    const float* w1 = AIN(I_FW1) + layer * 33 * 64; const float* b1 = AIN(I_FB1) + layer * 64;
    const float* w2 = AIN(I_FW2) + layer * 2 * 64 * 64; const float* b2 = AIN(I_FB2) + layer * 2 * 64;
    const float* wo = AIN(I_FWOUT) + layer * 64 * 1024; const float* fr = AIN(I_FFREQ) + layer * 64;
    const int tt = tid >> 6, j = tid & 63, t = t0 + tt;
    const float t01 = (float)t / (float)(L - 1);
    if (j < 33) {
        float v;
        if (j == 0) v = t01;
        else { const int k = (j - 1) & 15; const double f = kd(1e-4) + (double)k * kd((15.0 - 1e-4) / 15.0); float s, c; sincos_rev(f * (double)t / (double)L, s, c); v = (j <= 16) ? c : -s; }
        zs[tt * 40 + j] = v;
    }
    __syncthreads();
    const float fq = fr[j];
    { float acc = b1[j]; for (int i = 0; i < 33; ++i) acc += zs[tt * 40 + i] * w1[i * 64 + j]; A[tt * 64 + j] = sin_acc(fq * acc); }
    __syncthreads();
    { float acc = b2[j]; for (int i = 0; i < 64; ++i) acc += A[tt * 64 + i] * w2[i * 64 + j]; B[tt * 64 + j] = sin_acc(fq * acc); }
    __syncthreads();
    { float acc = b2[64 + j]; for (int i = 0; i < 64; ++i) acc += B[tt * 64 + i] * w2[4096 + i * 64 + j]; A[tt * 64 + j] = sin_acc(fq * acc); }
    __syncthreads();
    { float acc0[8], acc1[8];
#pragma unroll
      for (int q = 0; q < 8; ++q) { acc0[q] = 0.f; acc1[q] = 0.f; }
#pragma unroll 8
      for (int i = 0; i < 64; ++i) { const float wa = wo[i * 1024 + tid], wb = wo[i * 1024 + 512 + tid];
#pragma unroll
          for (int q = 0; q < 8; ++q) { const float av = A[q * 64 + i]; acc0[q] += av * wa; acc1[q] += av * wb; } }
      const float ad = 3.070113457325394f + (float)tid * ((15.350567286626973f - 3.070113457325394f) / 511.0f);
#pragma unroll
      for (int q = 0; q < 8; ++q) { const float tq = (float)(t0 + q) / (float)(L - 1); const float win = __expf(-tq * ad);
          hf[(size_t)(t0 + q) * 1024 + tid] = acc0[q] * win; hf[(size_t)(t0 + q) * 1024 + 512 + tid] = acc1[q] * win; } }
    __syncthreads();
}
__device__ __forceinline__ void step_pro_a(const AV& a, LAS unsigned char* lds) {
    const int tid = ltid(), lane = tid & 63, wave = tid >> 6, G = gridDim.x;
    unsigned char* ws = AWS;
    { f32x2* tw = (f32x2*)(ws + WS_TW); for (int m = lbid() * NT + tid; m < 16384; m += G * NT) { float s, c; sincos_rev((double)m / 16384.0, s, c); tw[m] = (f32x2){c, -s}; } }
    { f32x2* rt = (f32x2*)(ws + WS_ROPE);
      for (int e = lbid() * NT + tid; e < 8192 * 32; e += G * NT) { const int pos = e >> 5, i = e & 31; const int pp = (i < 16) ? (pos >> 6) : (pos & 63);
          const double inv = ROPE_IF[i & 15]; float sn, cs; sincos_rev((double)pp * inv * 0.15915494309189533577, sn, cs); rt[e] = (f32x2){cs, sn}; } }
    { const float* g = AIN(I_NORMG); bf16* HN0 = (bf16*)(ws + WS_HN0); f32x4 gv[4];
#pragma unroll
      for (int j = 0; j < 4; ++j) gv[j] = *((const f32x4*)g + lane + 64 * j);
      for (int m = lbid() * NWAVES + wave; m < NTOK; m += G * NWAVES) {
          const f32x4* xr = (const f32x4*)(xin_rows(a, m)) + lane; f32x4 v[4]; float ssum = 0.f;
#pragma unroll
          for (int j = 0; j < 4; ++j) { v[j] = xr[64 * j]; ssum += (v[j].x * v[j].x + v[j].y * v[j].y) + (v[j].z * v[j].z + v[j].w * v[j].w); }
          const float rs = 1.0f / sqrtf(wave_sum(ssum) * (1.0f / DM) + EPS);
          u32x2* o8 = (u32x2*)(HN0 + (size_t)m * DM) + lane;
#pragma unroll
          for (int j = 0; j < 4; ++j) { u32x2 w; w.x = pk2(v[j].x * rs * gv[j].x, v[j].y * rs * gv[j].y); w.y = pk2(v[j].z * rs * gv[j].z, v[j].w * rs * gv[j].w); o8[64 * j] = w; } } }
    { LAS float* scr = (LAS float*)(lds + wave * 16384);
      constexpr int I_IN = 16 * (UP / 32), I_MG = 16 * (GP / 32), I_BR = 8 * 32, I_OU = 16 * 32, PER = I_IN + I_MG + 3 * I_BR + I_OU;
      for (int it = lbid() * NWAVES + wave; it < 2 * PER; it += G * NWAVES) {
          const int l = it / PER; int r = it - l * PER;
          bf16* wcat = (bf16*)(ws + WS_WCAT + l * WCAT_BYTES); bf16* wbt = (bf16*)(ws + WS_WBT + l * WBT_BYTES); bf16* wot = (bf16*)(ws + WS_WOT + l * WOT_BYTES);
          if (r < I_IN) { transpose_item(AIN(I_WIN) + (size_t)l * 1024 * UP, 1024, UP, wcat, 0, scr, r, lane); continue; } r -= I_IN;
          if (r < I_MG) { transpose_item(AIN(I_WMERGE) + (size_t)l * 1024 * GP, 1024, GP, wcat, UP, scr, r, lane); continue; } r -= I_MG;
          if (r < I_BR) { transpose_item(AIN(I_WBHY) + (size_t)l * 512 * 1024, 512, 1024, wbt, 0, scr, r, lane); continue; } r -= I_BR;
          if (r < I_BR) { transpose_item(AIN(I_WBGQ) + (size_t)l * 512 * 1024, 512, 1024, wbt, 1024, scr, r, lane); continue; } r -= I_BR;
          if (r < I_BR) { transpose_item(AIN(I_WBDF) + (size_t)l * 512 * 1024, 512, 1024, wbt, 2048, scr, r, lane); continue; } r -= I_BR;
          transpose_item(AIN(I_WOUT) + (size_t)l * 1024 * 1024, 1024, 1024, wot, 0, scr, r, lane);
      } }
}
__device__ __forceinline__ void step_pro_a2(const AV& a, LAS unsigned char* lds) {
    const int tid = ltid(), G = gridDim.x; unsigned char* ws = AWS;
    { constexpr int GPL = LP / 8 + LS / 8;
      for (int g = lbid(); g < 2 * GPL; g += G) { const int l = g / GPL; int r = g - l * GPL;
          float* hfp = (float*)(ws + WS_U + l * (HF_P_BYTES + HF_S_BYTES));
          if (r < LP / 8) hf_group((LAS float*)lds, a, l, LP, r * 8, hfp, tid);
          else hf_group((LAS float*)lds, a, l, LS, (r - LP / 8) * 8, (float*)((unsigned char*)hfp + HF_P_BYTES), tid); } }
}
template <int LOG4> __device__ __forceinline__ void filt_unit(const AV& a, LAS unsigned char* lds, int layer, int pr, const float* hf, f32x2* Pg, f32x2* Mg) {
    constexpr int N = 1 << (2 * LOG4), L = N / 2;
    const int tid = ltid(); LAS f32x2* buf = (LAS f32x2*)lds; const int c0 = 2 * pr;
    for (int n = tid; n < N; n += NT) { f32x2 v = (f32x2){0.f, 0.f};
        if (n < L) v = *(const f32x2*)(hf + (size_t)n * 1024 + c0); else if (n > L) v = *(const f32x2*)(hf + (size_t)(N - n) * 1024 + 512 + c0);
        buf[PADI(n)] = v; }
    __syncthreads();
    fft_fwd<LOG4>(buf, (const f32x2*)(AWS + WS_TW), tid);
    const float ba = AIN(I_HYBIAS)[layer * 512 + c0], bb = AIN(I_HYBIAS)[layer * 512 + c0 + 1]; const float sc = 1.0f / (float)N;
    for (int k = tid; k <= L; k += NT) { const int q1 = digitrev<LOG4>(k), q2 = digitrev<LOG4>((N - k) & (N - 1)); const f32x2 z1 = buf[PADI(q1)], z2 = buf[PADI(q2)];
        f32x2 ca = (f32x2){0.5f * (z1.x + z2.x), 0.5f * (z1.y - z2.y)}; const float dx = z1.x - z2.x, dy = z1.y + z2.y; f32x2 cb = (f32x2){0.5f * dy, -0.5f * dx};
        ca.x += ba; cb.x += bb;
        const int slot = (k == L) ? L : digitrev<LOG4 - 2>(k & (N / 16 - 1)) * 8 + (k >> (2 * LOG4 - 4));
        Pg[slot] = (f32x2){0.5f * sc * (ca.x + cb.x), 0.5f * sc * (ca.y + cb.y)}; Mg[slot] = (f32x2){0.5f * sc * (ca.x - cb.x), 0.5f * sc * (ca.y - cb.y)}; }
    __syncthreads();
}
__device__ __forceinline__ void step_pro_b(const AV& a, LAS unsigned char* lds) {
    for (int u = lbid(); u < 1024; u += gridDim.x) { const int l = u >> 9, r = u & 511; unsigned char* sp = AWS + WS_SPEC + l * SPEC_LAYER; const float* hfp = (const float*)(AWS + WS_U + l * (HF_P_BYTES + HF_S_BYTES));
        if (r < 256) filt_unit<7>(a, lds, l, r, hfp, (f32x2*)sp + (size_t)r * SPS_P, (f32x2*)(sp + SPEC_P_BYTES) + (size_t)r * SPS_P);
        else { const int pr = r - 256; filt_unit<6>(a, lds, l, pr, (const float*)((const unsigned char*)hfp + HF_P_BYTES), (f32x2*)(sp + 2 * SPEC_P_BYTES) + (size_t)pr * SPS_S, (f32x2*)(sp + 2 * SPEC_P_BYTES + SPEC_S_BYTES) + (size_t)pr * SPS_S); } }
}
__device__ __forceinline__ void step_norm(const AV& a, int c, int layer) {
    const int tid = ltid(), lane = tid & 63, wave = tid >> 6; const Chunk ck = chunk_of(c);
    const float* X = layer == 0 ? xin_rows(a, ck.tok0) : AOUT + (size_t)ck.tok0 * DM; bf16* HN = (bf16*)(AWS + WS_HN); const float* g = AIN(I_NORMG) + layer * DM;
    f32x4 gv[4];
#pragma unroll
    for (int j = 0; j < 4; ++j) gv[j] = *((const f32x4*)g + lane + 64 * j);
    for (int m = lbid() * NWAVES + wave; m < CH; m += gridDim.x * NWAVES) {
        const f32x4* xr = (const f32x4*)(X + (size_t)m * DM) + lane; f32x4 v[4]; float s = 0.f;
#pragma unroll
        for (int j = 0; j < 4; ++j) { v[j] = xr[64 * j]; s += (v[j].x * v[j].x + v[j].y * v[j].y) + (v[j].z * v[j].z + v[j].w * v[j].w); }
        const float rs = 1.0f / sqrtf(wave_sum(s) * (1.0f / DM) + EPS);
        u32x2* o8 = (u32x2*)(HN + (size_t)m * DM) + lane;
#pragma unroll
        for (int j = 0; j < 4; ++j) { u32x2 w; w.x = pk2(v[j].x * rs * gv[j].x, v[j].y * rs * gv[j].y); w.y = pk2(v[j].z * rs * gv[j].z, v[j].w * rs * gv[j].w); o8[64 * j] = w; }
    }
}
__device__ __forceinline__ void step_final(const AV& a, int row0, int row1) {
    const int tid = ltid(), lane = tid & 63, wave = tid >> 6; const float* g = AIN(I_FINALG);
    f32x4 gv[4];
#pragma unroll
    for (int j = 0; j < 4; ++j) gv[j] = *((const f32x4*)g + lane + 64 * j);
    for (int m = row0 + lbid() * NWAVES + wave; m < row1; m += gridDim.x * NWAVES) {
        f32x4* xr = (f32x4*)(AOUT + (size_t)m * DM) + lane; f32x4 v[4]; float s = 0.f;
#pragma unroll
        for (int j = 0; j < 4; ++j) { v[j] = xr[64 * j]; s += (v[j].x * v[j].x + v[j].y * v[j].y) + (v[j].z * v[j].z + v[j].w * v[j].w); }
        const float rs = 1.0f / sqrtf(wave_sum(s) * (1.0f / DM) + EPS);
#pragma unroll
        for (int j = 0; j < 4; ++j) xr[64 * j] = v[j] * rs * gv[j];
    }
}
__device__ __forceinline__ void step_prep(const AV& a, int c, int layer) {
    const Chunk ck = chunk_of(c); bf16* U = (bf16*)(AWS + WS_U);
    for (int it = lbid() * NT + ltid(); it < CH * 10; it += gridDim.x * NT) {
        const int tok = it / 10, hd = it - tok * 10; const int pos = tok & (ck.L - 1);
        bf16* p = U + (size_t)tok * UP + (hd < 8 ? C_GQ + 64 * hd : C_GK + 64 * (hd - 8));
        const float* g = (hd < 8 ? AIN(I_QNG) : AIN(I_KNG)) + layer * 64;
        float x[64];
#pragma unroll
        for (int i = 0; i < 8; ++i) { const u32x4 w = *((const u32x4*)p + i);
            x[8 * i + 0] = bflo(w.x); x[8 * i + 1] = bfhi(w.x); x[8 * i + 2] = bflo(w.y); x[8 * i + 3] = bfhi(w.y); x[8 * i + 4] = bflo(w.z); x[8 * i + 5] = bfhi(w.z); x[8 * i + 6] = bflo(w.w); x[8 * i + 7] = bfhi(w.w); }
        float ss = 0.f;
#pragma unroll
        for (int i = 0; i < 64; ++i) ss += x[i] * x[i];
        const float rs = (1.0f / sqrtf(ss * (1.0f / 64.0f) + EPS)) * (hd < 8 ? 0.125f * LOG2E : 1.0f);
#pragma unroll
        for (int i = 0; i < 64; ++i) x[i] = x[i] * rs * g[i];
        const f32x4* rt = (const f32x4*)(AWS + WS_ROPE) + (size_t)pos * 16;
#pragma unroll
        for (int i2 = 0; i2 < 16; ++i2) { const f32x4 cs2 = rt[i2];
#pragma unroll
            for (int e = 0; e < 2; ++e) { const int i = 2 * i2 + e; const float cs = e ? cs2.z : cs2.x, sn = e ? cs2.w : cs2.y; const float x1 = x[i], x2 = x[i + 32]; x[i] = x1 * cs - x2 * sn; x[i + 32] = x2 * cs + x1 * sn; } }
#pragma unroll
        for (int i = 0; i < 8; ++i) { u32x4 w; w.x = pk2(x[8 * i], x[8 * i + 1]); w.y = pk2(x[8 * i + 2], x[8 * i + 3]); w.z = pk2(x[8 * i + 4], x[8 * i + 5]); w.w = pk2(x[8 * i + 6], x[8 * i + 7]); *((u32x4*)p + i) = w; }
    }
}
__device__ __forceinline__ void step_prep_hy(const AV& a, LAS unsigned char* lds, int c, int layer) {
    const Chunk ck = chunk_of(c); const bf16* U = (const bf16*)(AWS + WS_U);
    f32x2* HVP = (f32x2*)(AWS + WS_HVP); f32x2* PMP = (f32x2*)(AWS + WS_PMP);
    const int tid = ltid(), lane = tid & 63, wave = tid >> 6;
    LAS f32x2* th = (LAS f32x2*)(lds + wave * 17408); LAS f32x2* tp = th + 64 * 17;
    const float* cw = AIN(I_CONVW) + layer * 3 * 1536; const float* cb = AIN(I_CONVB) + layer * 1536;
    for (int it = lbid() * NWAVES + wave; it < (CH / 16) * 4; it += gridDim.x * NWAVES) {
        const int cbk = it & 3, tg = it >> 2, t0 = tg * 16, ch = cbk * 128 + 2 * lane;
        const int pos0 = t0 & (ck.L - 1);
        float w[3][3][2], bb[3][2];
#pragma unroll
        for (int ar = 0; ar < 3; ++ar) {
#pragma unroll
            for (int j = 0; j < 3; ++j) { const f32x2 v = *(const f32x2*)(cw + j * 1536 + ar * 512 + ch); w[ar][j][0] = v.x; w[ar][j][1] = v.y; }
            const f32x2 v = *(const f32x2*)(cb + ar * 512 + ch); bb[ar][0] = v.x; bb[ar][1] = v.y; }
        const bf16* r0 = U + (size_t)t0 * UP + ch;
        unsigned pv[3], cv[3], nv[3];
#pragma unroll
        for (int ar = 0; ar < 3; ++ar) { pv[ar] = pos0 > 0 ? *(const unsigned*)(r0 - UP + ar * 512) : 0u; cv[ar] = *(const unsigned*)(r0 + ar * 512); }
#pragma unroll 4
        for (int t = 0; t < 16; ++t) {
            const bf16* rt = r0 + (size_t)t * UP; const bool last = (pos0 + t + 1 >= ck.L);
#pragma unroll
            for (int ar = 0; ar < 3; ++ar) nv[ar] = last ? 0u : *(const unsigned*)(rt + UP + ar * 512);
            const unsigned gw = *(const unsigned*)(rt + C_HG);
            float o[3][2];
#pragma unroll
            for (int ar = 0; ar < 3; ++ar) { o[ar][0] = w[ar][0][0] * bflo(pv[ar]) + w[ar][1][0] * bflo(cv[ar]) + w[ar][2][0] * bflo(nv[ar]) + bb[ar][0];
                o[ar][1] = w[ar][0][1] * bfhi(pv[ar]) + w[ar][1][1] * bfhi(cv[ar]) + w[ar][2][1] * bfhi(nv[ar]) + bb[ar][1]; pv[ar] = cv[ar]; cv[ar] = nv[ar]; }
            th[lane * 17 + t] = (f32x2){o[2][0] * o[1][0], o[2][1] * o[1][1]};
            tp[lane * 17 + t] = (f32x2){o[0][0] * silu(bflo(gw)), o[0][1] * silu(bfhi(gw))};
        }
        asm volatile("s_waitcnt lgkmcnt(0)" ::: "memory");
#pragma unroll 4
        for (int i = 0; i < 16; ++i) { const int pl = 4 * i + (lane >> 4), tt = lane & 15; const size_t o = (size_t)(cbk * 64 + pl) * CH + t0 + tt;
            HVP[o] = th[pl * 17 + tt]; PMP[o] = tp[pl * 17 + tt]; }
        asm volatile("s_waitcnt lgkmcnt(0)" ::: "memory");
    }
}
typedef short bf16x8 __attribute__((ext_vector_type(8)));
typedef short s16x4 __attribute__((ext_vector_type(4)));
typedef float f32x16 __attribute__((ext_vector_type(16)));
typedef float f32x2_t __attribute__((ext_vector_type(2)));
typedef __bf16 bf16x2_t __attribute__((ext_vector_type(2)));
__device__ __forceinline__ unsigned cvtpk(float lo, float hi) { f32x2_t v = {lo, hi}; bf16x2_t b = __builtin_convertvector(v, bf16x2_t); return __builtin_bit_cast(unsigned, b); }
__device__ __forceinline__ int crow(int r, int hi) { return (r & 3) + 8 * (r >> 2) + 4 * hi; }
__device__ __forceinline__ s16x4 vtr(const LAS unsigned char* p) { return __builtin_bit_cast(s16x4, __builtin_amdgcn_ds_read_tr16_b64_v4i16((LAS s16x4*)p)); }
constexpr int ATT_K = 0;
constexpr int ATT_TB_DIFF = 4 * 8192 + 4 * 16384;
constexpr float C1 = 0.125f * LOG2E;
__device__ __forceinline__ void glds16(const void* gsrc, unsigned lds_dst) { unsigned keep;
    asm volatile("s_mov_b32 %0, m0\n\ts_mov_b32 m0, %2\n\ts_nop 0\n\tglobal_load_lds_dwordx4 %1, off\n\ts_mov_b32 m0, %0" : "=&s"(keep) : "v"(gsrc), "s"(lds_dst) : "memory"); }

template <int VD, bool BIAS, bool OMAX, int G>
__device__ __forceinline__ void flash_pass(LAS unsigned char* lds, const bf16* Qrow, const bf16* Kg, const bf16* Vg, int L, int qpos, int qw0, float bl, float br, f32x16 (&o)[VD / 32], float& l_out) {
    const int tid = ltid(), lane = tid & 63, r32 = lane & 31, hi = lane >> 5;
    constexpr int VROW = VD * 2, VT = 64 * VROW, NVL = VD / 64, NSL = 2 * G, ATT_V = NSL * 8192, ATT_TB = ATT_V + NSL * VT;
    const LAS float* tb = (const LAS float*)(lds + ATT_TB);
    typedef const __attribute__((address_space(1))) u32x4* g4p;
    const int wv = __builtin_amdgcn_readfirstlane(tid >> 6); const int ldsa = (int)(unsigned)(uintptr_t)lds;
    const bf16* ksrc; { const int X = wv * 1024 + lane * 16, line = X >> 8, c16 = ((X >> 4) & 15) ^ (line & 15), key = 2 * line + (c16 >> 3), ch = c16 & 7; ksrc = Kg + (size_t)key * UP + ch * 8; }
    const bf16* vsrc[NVL];
#pragma unroll
    for (int i = 0; i < NVL; ++i) { const int X = i * 8192 + wv * 1024 + lane * 16; const int key = (VD == 64) ? (X >> 7) : (X >> 8), posb = (VD == 64) ? (X & 127) : (X & 255);
        const int swz = (VD == 64) ? (((key >> 1) & 1) << 6) : ((key & 3) << 6); vsrc[i] = Vg + (size_t)key * UP + ((posb ^ swz) >> 1); }
#define ATT_DMA(tt_, sl_) do { const size_t go_ = (size_t)(tt_) * 64 * UP; \
        glds16(ksrc + go_, (unsigned)__builtin_amdgcn_readfirstlane(ldsa + ATT_K + (sl_) * 8192 + wv * 1024)); \
        _Pragma("unroll") for (int i_ = 0; i_ < NVL; ++i_) glds16(vsrc[i_] + go_, (unsigned)__builtin_amdgcn_readfirstlane(ldsa + ATT_V + (sl_) * VT + i_ * 8192 + wv * 1024)); } while (0)
#define ATT_DMAGROUP(g_) do { _Pragma("unroll") for (int j_ = 0; j_ < G; ++j_) { const int tt_ = (g_) * G + j_; ATT_DMA(tt_, tt_ & (NSL - 1)); } } while (0)
#define ATT_BAR() do { __builtin_amdgcn_s_barrier(); asm volatile("" ::: "memory"); } while (0)
    int koff[2][4];
#pragma unroll
    for (int kb = 0; kb < 2; ++kb)
#pragma unroll
        for (int s = 0; s < 4; ++s) { const int key = 32 * kb + r32, line = key >> 1, c16 = ((key & 1) << 3) | (2 * s + hi); koff[kb][s] = line * 256 + ((c16 ^ (line & 15)) << 4); }
    const int q4 = (lane & 15) >> 2, p4 = lane & 3, g1 = (lane >> 4) & 1;
    const int vsw = (VD == 64) ? ((q4 >> 1) & 1) : q4;
    const int vbase = (4 * hi + q4) * VROW + 32 * g1 + 8 * p4;
    bf16x8 qf[4];
#pragma unroll
    for (int s = 0; s < 4; ++s) qf[s] = __builtin_bit_cast(bf16x8, *(g4p)(Qrow + 16 * s + 8 * hi));
    float m_run = OMAX ? -1e30f : 0.f, l_run = 0.f;
    const int nt = L >> 6;
    asm volatile("" :: "v"(qf[0]), "v"(qf[1]), "v"(qf[2]), "v"(qf[3]) : "memory");
    asm volatile("s_waitcnt vmcnt(0)" ::: "memory");
    const int ng = nt / G;
    ATT_DMAGROUP(0); if (ng > 1) ATT_DMAGROUP(1);
    if (ng > 1) { if (G * (1 + NVL) == 8) asm volatile("s_waitcnt vmcnt(8)" ::: "memory"); else asm volatile("s_waitcnt vmcnt(6)" ::: "memory"); } else asm volatile("s_waitcnt vmcnt(0)" ::: "memory");
    static_assert(G * (1 + NVL) == 8 || G * (1 + NVL) == 6, "vmcnt immediates above");
    ATT_BAR();
#pragma unroll 1
    for (int t = 0; t < nt; ++t) {
        const int cur = t & (NSL - 1);
        const LAS unsigned char* kbuf = lds + ATT_K + cur * 8192; const LAS unsigned char* vbuf = lds + ATT_V + cur * VT;
        f32x16 p[2];
        { bf16x8 kf[2][4];
#pragma unroll
          for (int kb = 0; kb < 2; ++kb)
#pragma unroll
            for (int s = 0; s < 4; ++s) kf[kb][s] = *(const LAS bf16x8*)(kbuf + koff[kb][s]);
          __builtin_amdgcn_sched_barrier(0);
#pragma unroll
          for (int kb = 0; kb < 2; ++kb) { f32x16 acc;
#pragma unroll
            for (int r = 0; r < 16; ++r) acc[r] = 0.f;
#pragma unroll
            for (int s = 0; s < 4; ++s) acc = __builtin_amdgcn_mfma_f32_32x32x16_bf16(kf[kb][s], qf[s], acc, 0, 0, 0);
            p[kb] = acc; } }
        s16x4 vlo[2][4], vhi[2][4];
#define VREAD(buf_, db_) do { const int cofs_ = (((db_) ^ vsw) << 6); _Pragma("unroll") for (int kb = 0; kb < 2; ++kb) _Pragma("unroll") for (int ss = 0; ss < 2; ++ss) { \
            const LAS unsigned char* vp_ = vbuf + vbase + (32 * kb + 16 * ss) * VROW + cofs_; vlo[buf_][2 * kb + ss] = vtr(vp_); vhi[buf_][2 * kb + ss] = vtr(vp_ + 8 * VROW); } } while (0)
        VREAD(0, 0);
        __builtin_amdgcn_sched_barrier(0);
        const int k0 = t * 64; float mulc, bconst, mx = -3e38f; bool nearT = false;
        const bool domax = (t & 7) == 0;
        if (BIAS) { const int rlo = k0 - qw0 - 31, rhi = k0 + 63 - qw0; nearT = !(rhi <= -128 || rlo >= 128); }
        if (BIAS && nearT) {
#pragma unroll
            for (int kb = 0; kb < 2; ++kb)
#pragma unroll
                for (int r4 = 0; r4 < 4; ++r4) {
#pragma unroll
                    for (int e = 0; e < 4; ++e) { const int r = 4 * r4 + e; int rel = k0 + 32 * kb + crow(r, hi) - qpos; rel = rel < -128 ? -128 : (rel > 128 ? 128 : rel); const float v = p[kb][r] * C1 + tb[rel + 128]; p[kb][r] = v; mx = fmaxf(mx, v); }
                    __builtin_amdgcn_sched_barrier(0); }
            mulc = 1.0f; bconst = 0.f;
        } else {
            if (OMAX && domax) {
#pragma unroll
                for (int kb = 0; kb < 2; ++kb)
#pragma unroll
                    for (int r = 0; r < 16; ++r) mx = fmaxf(mx, p[kb][r]); }
            bconst = BIAS ? (k0 < qw0 ? bl : br) : 0.f; mx = mx * C1 + bconst; mulc = C1;
        }
        if (OMAX && (domax || (BIAS && nearT))) {
            mx = fmaxf(mx, shx(mx, 32));
            if (__any(mx > m_run)) { const float mn = fmaxf(m_run, mx), al = __builtin_amdgcn_exp2f(m_run - mn); l_run *= al;
#pragma unroll
                for (int db = 0; db < VD / 32; ++db) o[db] *= al;
                m_run = mn; }
        }
        const f32x2 mul2 = (f32x2){mulc, mulc}, add2 = (f32x2){bconst - m_run, bconst - m_run}; f32x2 ls2 = (f32x2){0.f, 0.f};
#pragma unroll
        for (int kb = 0; kb < 2; ++kb)
#pragma unroll
            for (int r = 0; r < 16; r += 2) { f32x2 v = (f32x2){p[kb][r], p[kb][r + 1]}; v = v * mul2 + add2; f32x2 e; e.x = __builtin_amdgcn_exp2f(v.x); e.y = __builtin_amdgcn_exp2f(v.y); ls2 += e; p[kb][r] = e.x; p[kb][r + 1] = e.y; }
        l_run += ls2.x + ls2.y;
        bf16x8 pk[2][2];
#pragma unroll
        for (int kb = 0; kb < 2; ++kb)
#pragma unroll
            for (int ss = 0; ss < 2; ++ss) { u32x4 w; w.x = cvtpk(p[kb][8 * ss + 0], p[kb][8 * ss + 1]); w.y = cvtpk(p[kb][8 * ss + 2], p[kb][8 * ss + 3]); w.z = cvtpk(p[kb][8 * ss + 4], p[kb][8 * ss + 5]); w.w = cvtpk(p[kb][8 * ss + 6], p[kb][8 * ss + 7]);
                pk[kb][ss] = __builtin_bit_cast(bf16x8, w); }
        __builtin_amdgcn_sched_barrier(0);
#pragma unroll
        for (int db = 0; db < VD / 32; ++db) {
            if (db + 1 < VD / 32) { if ((db + 1) & 1) VREAD(1, db + 1); else VREAD(0, db + 1); }
#pragma unroll
            for (int kb = 0; kb < 2; ++kb)
#pragma unroll
                for (int ss = 0; ss < 2; ++ss) { const bf16x8 vf = (db & 1) ? __builtin_shufflevector(vlo[1][2 * kb + ss], vhi[1][2 * kb + ss], 0, 1, 2, 3, 4, 5, 6, 7) : __builtin_shufflevector(vlo[0][2 * kb + ss], vhi[0][2 * kb + ss], 0, 1, 2, 3, 4, 5, 6, 7);
                    o[db] = __builtin_amdgcn_mfma_f32_32x32x16_bf16(vf, pk[kb][ss], o[db], 0, 0, 0); }
            __builtin_amdgcn_sched_barrier(0); }
#undef VREAD
        if (((t + 1) & (G - 1)) == 0) {
            asm volatile("s_waitcnt vmcnt(0)" ::: "memory"); ATT_BAR();
            const int g2 = (t + 1) / G + 1; if (g2 < ng) ATT_DMAGROUP(g2); }
    }
#undef ATT_DMA
#undef ATT_DMAGROUP
#undef ATT_BAR
    l_out = l_run + shx(l_run, 32);
}
__device__ __forceinline__ void gqa_unit(const AV& a, LAS unsigned char* lds, int seqrow0, int L, int h, int qb) {
    const int tid = ltid(), lane = tid & 63, r32 = lane & 31, hi = lane >> 5;
    const bf16* U = (const bf16*)(AWS + WS_U); bf16* Y = (bf16*)(AWS + WS_Y) + (size_t)1 * CH * 512;
    constexpr int G = 4, NSL = 2 * G, VROW = 128, VT = 8192, ATT_V = NSL * 8192;
    typedef const __attribute__((address_space(1))) u32x4* g4p;
    const int wv = __builtin_amdgcn_readfirstlane(tid >> 6); const int ldsa = (int)(unsigned)(uintptr_t)lds;
    const int qw0 = qb * 512 + wv * 64;
    const bf16* Kg = U + (size_t)seqrow0 * UP + C_GK + 64 * (h >> 2); const bf16* Vg = U + (size_t)seqrow0 * UP + C_GV + 64 * (h >> 2);
    const bf16* ksrc; { const int X = wv * 1024 + lane * 16, line = X >> 8, c16 = ((X >> 4) & 15) ^ (line & 15), key = 2 * line + (c16 >> 3), ch = c16 & 7; ksrc = Kg + (size_t)key * UP + ch * 8; }
    const bf16* vsrc; { const int X = wv * 1024 + lane * 16, key = X >> 7, posb = X & 127, swz = ((key >> 1) & 1) << 6; vsrc = Vg + (size_t)key * UP + ((posb ^ swz) >> 1); }
#define GQ_DMA(tt_, sl_) do { const size_t go_ = (size_t)(tt_) * 64 * UP; \
        glds16(ksrc + go_, (unsigned)__builtin_amdgcn_readfirstlane(ldsa + ATT_K + (sl_) * 8192 + wv * 1024)); \
        glds16(vsrc + go_, (unsigned)__builtin_amdgcn_readfirstlane(ldsa + ATT_V + (sl_) * VT + wv * 1024)); } while (0)
#define GQ_DMAGROUP(g_) do { _Pragma("unroll") for (int j_ = 0; j_ < G; ++j_) { const int tt_ = (g_) * G + j_; GQ_DMA(tt_, tt_ & (NSL - 1)); } } while (0)
#define GQ_BAR() do { __builtin_amdgcn_s_barrier(); asm volatile("" ::: "memory"); } while (0)
    int koff[2][4];
#pragma unroll
    for (int kb = 0; kb < 2; ++kb)
#pragma unroll
        for (int s = 0; s < 4; ++s) { const int key = 32 * kb + r32, line = key >> 1, c16 = ((key & 1) << 3) | (2 * s + hi); koff[kb][s] = line * 256 + ((c16 ^ (line & 15)) << 4); }
    const int q4 = (lane & 15) >> 2, p4 = lane & 3, g1 = (lane >> 4) & 1;
    const int vsw = (q4 >> 1) & 1;
    const int vbase = (4 * hi + q4) * VROW + 32 * g1 + 8 * p4;
    bf16x8 qf[2][4];
#pragma unroll
    for (int j = 0; j < 2; ++j)
#pragma unroll
        for (int s = 0; s < 4; ++s) qf[j][s] = __builtin_bit_cast(bf16x8, *(g4p)(U + (size_t)(seqrow0 + qw0 + 32 * j + r32) * UP + C_GQ + 64 * h + 16 * s + 8 * hi));
    f32x16 o[2][2];
#pragma unroll
    for (int j = 0; j < 2; ++j)
#pragma unroll
        for (int db = 0; db < 2; ++db)
#pragma unroll
            for (int r = 0; r < 16; ++r) o[j][db][r] = 0.f;
    float lrun[2] = {0.f, 0.f};
    const int nt = L >> 6, ng = nt / G;
    asm volatile("" :: "v"(qf[0][0]), "v"(qf[0][1]), "v"(qf[0][2]), "v"(qf[0][3]), "v"(qf[1][0]), "v"(qf[1][1]), "v"(qf[1][2]), "v"(qf[1][3]) : "memory");
    asm volatile("s_waitcnt vmcnt(0)" ::: "memory");
    GQ_DMAGROUP(0); if (ng > 1) GQ_DMAGROUP(1);
    if (ng > 1) asm volatile("s_waitcnt vmcnt(8)" ::: "memory"); else asm volatile("s_waitcnt vmcnt(0)" ::: "memory");
    GQ_BAR();
#pragma unroll 1
    for (int t = 0; t < nt; ++t) {
        const int cur = t & (NSL - 1);
        const LAS unsigned char* kbuf = lds + ATT_K + cur * 8192; const LAS unsigned char* vbuf = lds + ATT_V + cur * VT;
        f32x16 p[2][2];
        { bf16x8 kf[2][4];
#pragma unroll
          for (int kb = 0; kb < 2; ++kb)
#pragma unroll
            for (int s = 0; s < 4; ++s) kf[kb][s] = *(const LAS bf16x8*)(kbuf + koff[kb][s]);
          __builtin_amdgcn_sched_barrier(0);
#pragma unroll
          for (int kb = 0; kb < 2; ++kb)
#pragma unroll
            for (int j = 0; j < 2; ++j) { f32x16 acc;
#pragma unroll
              for (int r = 0; r < 16; ++r) acc[r] = 0.f;
#pragma unroll
              for (int s = 0; s < 4; ++s) acc = __builtin_amdgcn_mfma_f32_32x32x16_bf16(kf[kb][s], qf[j][s], acc, 0, 0, 0);
              p[j][kb] = acc; } }
        s16x4 vlo[2][4], vhi[2][4];
#define GQ_VREAD(buf_, db_) do { const int cofs_ = (((db_) ^ vsw) << 6); _Pragma("unroll") for (int kb = 0; kb < 2; ++kb) _Pragma("unroll") for (int ss = 0; ss < 2; ++ss) { \
            const LAS unsigned char* vp_ = vbuf + vbase + (32 * kb + 16 * ss) * VROW + cofs_; vlo[buf_][2 * kb + ss] = vtr(vp_); vhi[buf_][2 * kb + ss] = vtr(vp_ + 8 * VROW); } } while (0)
        bf16x8 pk[2][2][2];
#pragma unroll
        for (int j = 0; j < 2; ++j) { float ls0 = 0.f, ls1 = 0.f;
#pragma unroll
            for (int kb = 0; kb < 2; ++kb) {
#pragma unroll
                for (int r = 0; r < 16; r += 2) { const float e0 = __builtin_amdgcn_exp2f(p[j][kb][r]), e1 = __builtin_amdgcn_exp2f(p[j][kb][r + 1]); ls0 += e0; ls1 += e1; p[j][kb][r] = e0; p[j][kb][r + 1] = e1; }
#pragma unroll
                for (int ss = 0; ss < 2; ++ss) { u32x4 w; w.x = cvtpk(p[j][kb][8 * ss + 0], p[j][kb][8 * ss + 1]); w.y = cvtpk(p[j][kb][8 * ss + 2], p[j][kb][8 * ss + 3]); w.z = cvtpk(p[j][kb][8 * ss + 4], p[j][kb][8 * ss + 5]); w.w = cvtpk(p[j][kb][8 * ss + 6], p[j][kb][8 * ss + 7]);
                    pk[j][kb][ss] = __builtin_bit_cast(bf16x8, w); } }
            lrun[j] += ls0 + ls1; }
        __builtin_amdgcn_sched_barrier(0);
        GQ_VREAD(0, 0); GQ_VREAD(1, 1);
#pragma unroll
        for (int db = 0; db < 2; ++db) {
#pragma unroll
            for (int kb = 0; kb < 2; ++kb)
#pragma unroll
                for (int ss = 0; ss < 2; ++ss) { const bf16x8 vf = db ? __builtin_shufflevector(vlo[1][2 * kb + ss], vhi[1][2 * kb + ss], 0, 1, 2, 3, 4, 5, 6, 7) : __builtin_shufflevector(vlo[0][2 * kb + ss], vhi[0][2 * kb + ss], 0, 1, 2, 3, 4, 5, 6, 7);
#pragma unroll
                    for (int j = 0; j < 2; ++j) o[j][db] = __builtin_amdgcn_mfma_f32_32x32x16_bf16(vf, pk[j][kb][ss], o[j][db], 0, 0, 0); }
            __builtin_amdgcn_sched_barrier(0); }
#undef GQ_VREAD
        if (((t + 1) & (G - 1)) == 0) { asm volatile("s_waitcnt vmcnt(0)" ::: "memory"); GQ_BAR(); const int g2 = (t + 1) / G + 1; if (g2 < ng) GQ_DMAGROUP(g2); }
    }
#undef GQ_DMA
#undef GQ_DMAGROUP
#undef GQ_BAR
#pragma unroll
    for (int j = 0; j < 2; ++j) { const int lane2 = ltid() & 63, r32b = lane2 & 31, hib = lane2 >> 5;
        const float l = lrun[j] + shx(lrun[j], 32); const float inv = 1.0f / l; const size_t row = (size_t)(seqrow0 + qw0 + 32 * j + r32b);
#pragma unroll
        for (int db = 0; db < 2; ++db)
#pragma unroll
            for (int g = 0; g < 4; ++g) { const int d = 32 * db + 8 * g + 4 * hib; const u32x2 gw = *(const u32x2*)(U + row * UP + C_GG + 64 * h + d);
                const float y0 = o[j][db][4 * g] * inv * silu(bflo(gw.x)), y1 = o[j][db][4 * g + 1] * inv * silu(bfhi(gw.x)), y2 = o[j][db][4 * g + 2] * inv * silu(bflo(gw.y)), y3 = o[j][db][4 * g + 3] * inv * silu(bfhi(gw.y));
                u32x2 w; w.x = cvtpk(y0, y1); w.y = cvtpk(y2, y3); *(u32x2*)(Y + row * 512 + 64 * h + d) = w; } }
}
__device__ __forceinline__ void diff_unit(const AV& a, LAS unsigned char* lds, int seqrow0, int L, int h, int qb, int layer) {
    const int tid = ltid(), lane = tid & 63, wave = tid >> 6, r32 = lane & 31, hi = lane >> 5;
    const bf16* U = (const bf16*)(AWS + WS_U); bf16* Y = (bf16*)(AWS + WS_Y) + (size_t)2 * CH * 512; float* DT = (float*)(AWS + WS_DT);
    const float* relb = AIN(I_RELB);
    LAS float* tb = (LAS float*)(lds + ATT_TB_DIFF);
    for (int i = tid; i < 257; i += NT) { const int rel = i - 128, n = rel < 0 ? -rel : rel; int b = rel > 0 ? 16 : 0;
        if (n < 8) b += n; else { const int v = 8 + (31 - __builtin_clz((unsigned)(n * n))) - 6; b += v < 15 ? v : 15; }
        tb[i] = relb[b * 4 + h] * LOG2E; }
    const float bl = relb[15 * 4 + h] * LOG2E, br = relb[31 * 4 + h] * LOG2E;
    float lyf = (float)layer; asm volatile("" : "+v"(lyf));
    const float li = 0.8f - 0.6f * __expf(-0.3f * lyf);
    float d1, d2; { const float q1 = AIN(I_LQ1)[layer * 64 + lane], k1 = AIN(I_LK1)[layer * 64 + lane], q2 = AIN(I_LQ2)[layer * 64 + lane], k2 = AIN(I_LK2)[layer * 64 + lane]; d1 = wave_sum(q1 * k1); d2 = wave_sum(q2 * k2); }
    const float lam = __expf(d1) - __expf(d2) + li;
    const int qw0 = qb * 256 + wave * 32, qpos = qw0 + r32; const size_t row = (size_t)(seqrow0 + qpos);
    __syncthreads();
    f32x16 o[4]; float l; float ss = 0.f;
#pragma unroll 1
    for (int c = 0; c < 2; ++c) {
#pragma unroll
        for (int db = 0; db < 4; ++db)
#pragma unroll
            for (int r = 0; r < 16; ++r) o[db][r] = 0.f;
        flash_pass<128, true, true, 2>(lds, U + row * UP + C_DQ + 128 * h + 64 * c, U + (size_t)seqrow0 * UP + C_DK + 128 * h + 64 * c, U + (size_t)seqrow0 * UP + C_DV + 128 * h, L, qpos, qw0, bl, br, o, l);
        if (c == 0) { const float inv = 1.0f / l;
#pragma unroll
            for (int db = 0; db < 4; ++db)
#pragma unroll
                for (int g = 0; g < 4; ++g) { const int d = 32 * db + 8 * g + 4 * hi; *(f32x4*)(DT + row * 512 + 128 * h + d) = (f32x4){o[db][4 * g] * inv, o[db][4 * g + 1] * inv, o[db][4 * g + 2] * inv, o[db][4 * g + 3] * inv}; }
        } else { const float inv = lam / l;
#pragma unroll
            for (int db = 0; db < 4; ++db)
#pragma unroll
                for (int g = 0; g < 4; ++g) { const int d = 32 * db + 8 * g + 4 * hi; const f32x4 o0 = *(const f32x4*)(DT + row * 512 + 128 * h + d);
#pragma unroll
                    for (int e = 0; e < 4; ++e) { const float v = o0[e] - o[db][4 * g + e] * inv; o[db][4 * g + e] = v; ss += v * v; } }
        }
    }
    ss += shx(ss, 32);
    const float rs = (1.0f / sqrtf(ss * (1.0f / 128.0f) + EPS)) * (1.0f - li);
    const float* sg = AIN(I_SUBLN) + layer * 128;
#pragma unroll
    for (int db = 0; db < 4; ++db)
#pragma unroll
        for (int g = 0; g < 4; ++g) { const int d = 32 * db + 8 * g + 4 * hi; const u32x2 gw = *(const u32x2*)(U + row * UP + C_DG + 128 * h + d); const f32x4 gn = *(const f32x4*)(sg + d);
            const float y0 = o[db][4 * g] * rs * gn.x * silu(bflo(gw.x)), y1 = o[db][4 * g + 1] * rs * gn.y * silu(bfhi(gw.x)), y2 = o[db][4 * g + 2] * rs * gn.z * silu(bflo(gw.y)), y3 = o[db][4 * g + 3] * rs * gn.w * silu(bfhi(gw.y));
            u32x2 w; w.x = cvtpk(y0, y1); w.y = cvtpk(y2, y3); *(u32x2*)(Y + row * 512 + 128 * h + d) = w; }
}
template <int LOG4, int BATCH> __device__ __forceinline__ void hyena_unit(const AV& a, LAS unsigned char* lds, int seqrow0, int pr0, int layer) {
    constexpr int N = 1 << (2 * LOG4), L = N / 2, NPAD = N + N / 16;
    const int tid = ltid(); LAS f32x2* buf = (LAS f32x2*)lds;
    bf16* Y = (bf16*)(AWS + WS_Y) + (size_t)seqrow0 * 512;
    const unsigned char* sp = AWS + WS_SPEC + layer * SPEC_LAYER;
    constexpr int SPS = (LOG4 == 7) ? SPS_P : SPS_S;
    const f32x2* Pg = ((LOG4 == 7) ? (const f32x2*)sp : (const f32x2*)(sp + 2 * SPEC_P_BYTES)) + (size_t)pr0 * SPS;
    const f32x2* Mg = ((LOG4 == 7) ? (const f32x2*)(sp + SPEC_P_BYTES) : (const f32x2*)(sp + 2 * SPEC_P_BYTES + SPEC_S_BYTES)) + (size_t)pr0 * SPS;
    const f32x2* hvp = (const f32x2*)(AWS + WS_HVP) + (size_t)pr0 * CH + seqrow0; const f32x2* pmp = (const f32x2*)(AWS + WS_PMP) + (size_t)pr0 * CH + seqrow0;
    const f32x2* tw = (const f32x2*)(AWS + WS_TW);
    if constexpr (BATCH == 1) { fft_first_from_global<LOG4>(buf, tw, hvp, tid); fft_fwd<LOG4, 1, 1, false>(buf, tw, tid); }
    else {
#pragma unroll
        for (int b = 0; b < BATCH; ++b)
            for (int t = tid; t < L; t += NT) { buf[b * NPAD + PADI(t)] = hvp[(size_t)b * CH + t]; buf[b * NPAD + PADI(t + L)] = (f32x2){0.f, 0.f}; }
        __syncthreads();
        fft_fwd<LOG4, BATCH, 0, false>(buf, tw, tid);
    }
    fft_tail_mul_tail<LOG4, BATCH>(buf, Pg, Mg, SPS, ltid());
    if constexpr (BATCH == 1) { fft_inv<LOG4, 1, 1, false>(buf, tw, ltid()); fft_last_to_global<LOG4>(buf, tw, pmp, Y + 2 * pr0, ltid()); }
    else { fft_inv<LOG4, BATCH, 0, false>(buf, tw, ltid());
    for (int t = tid; t < L; t += NT) { unsigned w[BATCH];
#pragma unroll
        for (int b = 0; b < BATCH; ++b) { const f32x2 y = buf[b * NPAD + PADI(t)], m = pmp[(size_t)b * CH + t]; w[b] = cvtpk(y.x * m.x, y.y * m.y); }
        if (BATCH == 4) *(u32x4*)(Y + (size_t)t * 512 + 2 * pr0) = (u32x4){w[0], w[BATCH > 1 ? 1 : 0], w[BATCH > 2 ? 2 : 0], w[BATCH > 3 ? 3 : 0]};
        else *(unsigned*)(Y + (size_t)t * 512 + 2 * pr0) = w[0]; } }
    __syncthreads();
}
#define XB_TMO      128
#define XB_XCNT(j)  (256  + 64 * (j))
#define XB_XSUB(j)  (1280 + 64 * (j))
#define XB_XGEN(j)  (2304 + 64 * (j))
#define XB_TOP      3328
#define XB_TOPGEN   3392
#define XCD_BAR_WORDS 3456
#define XB_SPIN_CAP (1u << 18)

__device__ __forceinline__ unsigned xb_ld(unsigned* p)              { return __hip_atomic_load(p, __ATOMIC_RELAXED, __HIP_MEMORY_SCOPE_AGENT); }
__device__ __forceinline__ unsigned xb_add(unsigned* p, unsigned v) { return __hip_atomic_fetch_add(p, v, __ATOMIC_RELAXED, __HIP_MEMORY_SCOPE_AGENT); }
__device__ __forceinline__ unsigned xb_xcc_id() { return (unsigned)__builtin_amdgcn_s_getreg((3 << 11) | 20) & 0xFu; }
#define XB_SPIN(cond, bar) do { unsigned _sp = 0; while (cond) { __builtin_amdgcn_s_sleep(1); \
    if ((++_sp & 255u) == 0u) { if (xb_ld(&(bar)[XB_TMO])) break; if (_sp > XB_SPIN_CAP) { atomicAdd(&(bar)[XB_TMO], 1u); break; } } } } while (0)

struct XcdBarrier {
    unsigned* bar; unsigned x;
    volatile LAS unsigned* st;
};

__device__ __forceinline__ XcdBarrier xcd_barrier_post(unsigned* bar, volatile LAS unsigned* st) {
    XcdBarrier b; b.bar = bar; b.x = xb_xcc_id(); b.st = st;
    if (threadIdx.x == 0) (void)xb_add(&bar[XB_XCNT(b.x)], 1u);
    return b;
}
__device__ __forceinline__ void xcd_barrier_complete(unsigned* bar, unsigned x, unsigned& nloc, unsigned& nx) {
    const unsigned G = gridDim.x * gridDim.y * gridDim.z;
    unsigned sum, cnt, mine, sp = 0u;
    for (;;) {
        sum = 0u; cnt = 0u; mine = 0u;
#pragma unroll
        for (unsigned j = 0; j < 16; ++j) { const unsigned c = xb_ld(&bar[XB_XCNT(j)]); sum += c; cnt += (c > 0u) ? 1u : 0u; mine = (j == x) ? c : mine; }
        if (sum == G) break;
        __builtin_amdgcn_s_sleep(1);
        if ((++sp & 255u) == 0u) { if (xb_ld(&bar[XB_TMO])) break; if (sp > XB_SPIN_CAP) { atomicAdd(&bar[XB_TMO], 1u); break; } }
    }
    nloc = mine > 0u ? mine : 1u; nx = cnt > 0u ? cnt : 1u;
}

__device__ __forceinline__ void xcd_barrier(const XcdBarrier& b) {
    asm volatile("s_waitcnt vmcnt(0)" ::: "memory");
    __syncthreads();
    if (threadIdx.x == 0) {
        unsigned* bar = b.bar;
        __builtin_amdgcn_s_waitcnt(0);
        unsigned nloc = b.st[0], nx = b.st[1];
        if (nloc == 0u) { xcd_barrier_complete(bar, b.x, nloc, nx); b.st[0] = nloc; b.st[1] = nx; }
        const unsigned old = xb_add(&bar[XB_XSUB(b.x)], 1u);
        const unsigned gen = old / nloc;
        if (old + 1u == (gen + 1u) * nloc) {
            __builtin_amdgcn_fence(__ATOMIC_RELEASE, "agent");
            asm volatile("s_waitcnt vmcnt(0)" ::: "memory");
            const unsigned og = xb_add(&bar[XB_TOP], 1u);
            const unsigned tg = og / nx;
            if (og + 1u == (tg + 1u) * nx) xb_add(&bar[XB_TOPGEN], 1u);
            else XB_SPIN(xb_ld(&bar[XB_TOPGEN]) == tg, bar);
            __builtin_amdgcn_fence(__ATOMIC_ACQUIRE, "agent");
            xb_add(&bar[XB_XGEN(b.x)], 1u);
            asm volatile("s_waitcnt vmcnt(0)" ::: "memory");
        } else {
            XB_SPIN(xb_ld(&bar[XB_XGEN(b.x)]) == gen, bar);
            __builtin_amdgcn_fence(__ATOMIC_ACQUIRE, "agent");
            asm volatile("s_waitcnt vmcnt(0)" ::: "memory");
        }
    }
    __syncthreads();
}

__device__ __forceinline__ void step_mix(const AV& a, LAS unsigned char* lds, int c, int layer, unsigned* ctr, int tmask) {
    const Chunk ck = chunk_of(c); const int nqb = ck.L / 256, nqg = ck.L / 512, nD = ck.nseq * 4 * nqb, nG = ck.nseq * 8 * nqg, nF = (ck.L == LP) ? ck.nseq * 256 : ck.nseq * 64, total = nD + nG + nF;
    volatile LAS unsigned* wq = (volatile LAS unsigned*)(lds + LDS_MAIN);
    for (;;) {
        if (ltid() == 0) wq[0] = atomicAdd(ctr, 1u);
        __syncthreads();
        const int u = (int)wq[0];
        __syncthreads();
        if (u >= total) break;
        if (u < nD) { if (tmask & 1) { const int qb = u % nqb, sh = u / nqb, h = sh & 3, s = sh >> 2; diff_unit(a, lds, s * ck.L, ck.L, h, qb, layer); } }
        else if (u < nD + nG) { if (tmask & 2) { const int v = u - nD, qb = v % nqg, sh = v / nqg, h = sh & 7, s = sh >> 3; gqa_unit(a, lds, s * ck.L, ck.L, h, qb); } }
        else { if (tmask & 4) { const int v = u - nD - nG; if (ck.L == LP) hyena_unit<7, 1>(a, lds, (v >> 8) * LP, v & 255, layer); else hyena_unit<6, 4>(a, lds, (v >> 6) * LS, (v & 63) * 4, layer); } }
    }
}
constexpr int STEPS_PER = 6, NPRO = 3, NSTEPS = NPRO + NCHUNK * 2 * STEPS_PER + 1;
__global__ void __launch_bounds__(NT, 2) mega_fwd(Args kargs) {
    extern __shared__ __attribute__((aligned(16))) unsigned char lds_raw[];
    LAS unsigned char* lds = (LAS unsigned char*)lds_raw;
    kargp_t kp = (kargp_t)__builtin_amdgcn_kernarg_segment_ptr();
    { volatile LAS unsigned* misc = (volatile LAS unsigned*)(lds + LDS_MAIN + 64); if (ltid() < 16) misc[ltid()] = 0u; }
    __syncthreads();
    XcdBarrier xbar = xcd_barrier_post((unsigned*)(kargs.ws + WS_CTL) + CW_BAR, (volatile LAS unsigned*)(lds + LDS_MAIN + 64 + 32));
    const int step_lo = kargs.lo, step_hi = kargs.hi;
#pragma unroll 1
    for (int step = step_lo; step < step_hi; ++step) {
        asm volatile("" : "+s"(kp));
        AV a; a.p = kp; unsigned char* ws = AWS;
        if (step == 0) { if (EN(0)) step_pro_a(a, lds); }
        else if (step == 1) { if (EN(11)) { step_pro_a2(a, lds); if (DUP_MASK & 32) { xcd_barrier(xbar); step_pro_a2(a, lds); } } }
        else if (step == 2) { if (EN(1)) { step_pro_b(a, lds); if (DUP_MASK & 64) { xcd_barrier(xbar); step_pro_b(a, lds); } } }
        else if (step == NSTEPS - 1) { if (DUP_MASK & 256) { for (int q = 0; q < 100; ++q) xcd_barrier(xbar); } if (EN(2)) step_final(a, (NCHUNK - 1) * CH, NTOK); }
        else {
            const int s2 = step - NPRO, cl = s2 / STEPS_PER, k = s2 - cl * STEPS_PER, c = cl >> 1, layer = cl & 1;
            const Chunk ck = chunk_of(c);
            if (k == 0) { if (layer == 0) { if (c > 0 && EN(2)) step_final(a, (c - 1) * CH, c * CH); } continue;     }
            else if (k == 2) { if (EN(5)) { step_prep(a, c, layer); step_prep_hy(a, lds, c, layer); if (layer == 0) { float* q = (float*)(ws + WS_SSQ); for (int i = lbid() * NT + ltid(); i < CH; i += (int)gridDim.x * NT) q[i] = 0.f; } } }
            else if (k == 3) {
#pragma unroll 1
                for (int rep = 0; rep < ((DUP_MASK & 7) ? 2 : 1); ++rep) { if (rep) xcd_barrier(xbar); step_mix(a, lds, c, layer, (unsigned*)(ws + WS_CTL) + step * 16 + 4 * rep, rep ? (DUP_MASK & 7) : 7); } }
            else { if (EN(4)) {
                pg8::Gemm g; pg8::OrderAll S; pg8::EpiAll E; const int G = (int)gridDim.x, bid = lbid();
                S.so.init(CH, k == 1 ? NCAT : 1024, G, bid); S.o2 = pg8::OrderG2{CH / 256, G, bid}; S.mode = (k == 4) ? 2 : 1;
                float* O = AOUT + (size_t)ck.tok0 * DM; const float* X = layer == 0 ? xin_rows(a, ck.tok0) : O;
                E.mode = (k == 1) ? 1 : (k == 4) ? 2 : 3;
                E.e1 = pg8::EpiG1{(pg8::bf16_t*)(ws + WS_U), (pg8::bf16_t*)(ws + WS_G), AIN(I_BMERGE) + layer * GP, layer == 1 ? (const float*)(ws + WS_SSQ) : (const float*)nullptr};
                E.e2 = pg8::EpiG2{(const pg8::bf16_t*)(ws + WS_G), (float*)(ws + WS_TMP), (pg8::bf16_t*)(ws + WS_MG), CH / 256};
                E.e3 = pg8::EpiG3{X, O, AIN(I_NORMG) + DM, (pg8::bf16_t*)(ws + WS_HN), (float*)(ws + WS_SSQ), layer == 0 ? 1 : 0};
                if (k == 1) g = pg8::Gemm{layer == 0 ? (const pg8::bf16_t*)(ws + WS_HN0) + (size_t)ck.tok0 * DM : (const pg8::bf16_t*)(ws + WS_HN), (const pg8::bf16_t*)(ws + WS_WCAT + layer * WCAT_BYTES), CH, NCAT, 1024};
                else if (k == 4) g = pg8::Gemm{(const pg8::bf16_t*)(ws + WS_Y), (const pg8::bf16_t*)(ws + WS_WBT + layer * WBT_BYTES), 3 * CH, 3072, 512};
                else g = pg8::Gemm{(const pg8::bf16_t*)(ws + WS_MG), (const pg8::bf16_t*)(ws + WS_WOT + layer * WOT_BYTES), CH, 1024, 1024};
                const int nrep = (((DUP_MASK & 8) && k == 1) || ((DUP_MASK & 16) && k == 4)) ? 2 : 1;
#pragma unroll 1
                for (int rep = 0; rep < nrep; ++rep) { if (rep) xcd_barrier(xbar); pg8::gemm_phase<pg8::EpiAll, pg8::OrderAll, true, true>(lds, g, S, E); }
            } }
        }
        if (step + 1 < step_hi) { if (step == 0) cg::this_grid().sync(); else xcd_barrier(xbar); }
    }
}
#ifndef MK_MULTI
#define MK_MULTI 0
#endif
extern "C" void kernel_launch(void* const* d_in, const int* in_sizes, int n_in, void* d_out, int out_size, void* d_ws, size_t ws_size, hipStream_t stream) {
    static int grid = 0;
    if (grid == 0) {
        if (n_in != N_IN || out_size != NTOK * DM || ws_size < WS_END) { fprintf(stderr, "kernel_launch: unexpected shapes (n_in %d, out %d, ws %zu)\n", n_in, out_size, ws_size); grid = -1; return; }
        int dev = 0, cus = 0, per_cu = 0;
        hipGetDevice(&dev); hipDeviceGetAttribute(&cus, hipDeviceAttributeMultiprocessorCount, dev);
        if (hipFuncSetAttribute((const void*)mega_fwd, hipFuncAttributeMaxDynamicSharedMemorySize, LDS_BYTES) != hipSuccess) { fprintf(stderr, "kernel_launch: hipFuncSetAttribute failed\n"); grid = -1; return; }
        hipOccupancyMaxActiveBlocksPerMultiprocessor(&per_cu, (const void*)mega_fwd, NT, LDS_BYTES);
        (void)hipGetLastError();
        if (per_cu < 1) per_cu = 1;
        grid = cus * 1;
        fprintf(stderr, "kernel_launch: cus %d per_cu %d grid %d\n", cus, per_cu, grid);
    }
    if (grid < 0) return;
    hipMemsetAsync((char*)d_ws + WS_CTL, 0, CTL_BYTES, stream);
    Args a{};
    for (int i = 0; i < N_IN; ++i) a.in[i] = (const float*)d_in[i];
    a.out = (float*)d_out; a.ws = (unsigned char*)d_ws;
#if MK_MULTI
    for (int s = 0; s < NSTEPS; ++s) { a.lo = s; a.hi = s + 1; hipLaunchKernelGGL(mega_fwd, dim3(grid), dim3(NT), LDS_BYTES, stream, a); }
#else
    a.lo = 0; a.hi = NSTEPS;
    void* args[] = {&a};
    hipError_t e = hipLaunchCooperativeKernel((const void*)mega_fwd, dim3(grid), dim3(NT), args, LDS_BYTES, stream);
    if (e != hipSuccess) fprintf(stderr, "cooperative launch failed: %s (grid %d)\n", hipGetErrorString(e), grid);
#endif
}
```

```cpp
#include <hip/hip_runtime.h>
#include <hip/hip_cooperative_groups.h>
#include <cstdio>
#include <cstdint>
namespace cg = cooperative_groups;
__device__ __forceinline__ int ltid() { int t = (int)threadIdx.x; asm volatile("" : "+v"(t)); return t; }
__device__ __forceinline__ float shx(float v, int o) { const int l = ltid() & 63; return __int_as_float(__builtin_amdgcn_ds_bpermute((l ^ o) << 2, __float_as_int(v))); }
__device__ __forceinline__ int lbid() { int b = (int)blockIdx.x; asm volatile("" : "+s"(b)); return b; }
namespace pg8 {
#define PG8_LAS __attribute__((address_space(3)))
typedef unsigned short bf16_t;
typedef short bf16x8 __attribute__((ext_vector_type(8)));
typedef float f32x4 __attribute__((ext_vector_type(4)));
typedef unsigned u32x4 __attribute__((ext_vector_type(4)));
constexpr int BM = 256, BK = 64, HALF = 128, HTB = HALF * BK * 2  , STAGE_BYTES = 8 * HTB, NXCD = 8, WGM = 8;

__host__ __device__ __forceinline__ int lds_byte(int r, int c) { const int st = (r >> 4) * 2 + (c >> 5), rr = r & 15, cc = c & 31, ob = rr * 64 + cc * 2; return st * 1024 + (ob ^ (((ob >> 9) & 1) << 5)); }
__host__ __device__ __forceinline__ void stage_rc(int b, int& R, int& C) { const int st = b / 1024, sb = b % 1024, swz = sb ^ (((sb >> 9) & 1) << 5); R = (st >> 1) * 16 + swz / 64; C = (st & 1) * 32 + (swz % 64) / 2; }
__host__ __device__ __forceinline__ int perm32(int rho) { const int n = rho >> 4, i = rho & 15; return 8 * (i >> 2) + 4 * n + (i & 3); }

struct Unit { int pm, pn; };
struct Gemm { const bf16_t* A; const bf16_t* Bt; int M, N, K; };

struct StaticOrder {
    int nM, nN, nwg, G, c;
    __host__ __device__ void init(int M, int N, int G_, int c_) { nM = M / BM; nN = N / BM; nwg = nM * nN; G = G_; c = c_; }
    __host__ __device__ bool next(int i, Unit& u) const {
        const long L = (long)i * G + c; if (L >= nwg) return false;
        int wgid = (int)L; { const int q = nwg / NXCD, r = nwg % NXCD, xcd = wgid % NXCD, off = wgid / NXCD; wgid = (xcd < r ? xcd * (q + 1) : r * (q + 1) + (xcd - r) * q) + off; }
        const int nig = WGM * nN, gid = wgid / nig, fm = gid * WGM, gsz = (nM - fm) < WGM ? (nM - fm) : WGM;
        u.pm = fm + ((wgid % nig) % gsz); u.pn = (wgid % nig) / gsz; return true;
    }
    __device__ __forceinline__ void a_ready(const Unit&) const {}
    __device__ __forceinline__ void done(const Unit&) const {}
};

__device__ __forceinline__ unsigned cvt_pk_bf16(float lo, float hi) { unsigned r; asm volatile("v_cvt_pk_bf16_f32 %0, %1, %2" : "=v"(r) : "v"(lo), "v"(hi)); return r; }
template <class Epi, class Sched, bool ALIGN_EPI = false, bool SP2 = false>
__device__ __forceinline__ void gemm_phase(PG8_LAS unsigned char* lds, const Gemm g, const Sched& S, const Epi& E) {
    const int tid = ltid(), wid = __builtin_amdgcn_readfirstlane(tid >> 6), lane = tid & 63, wr = wid >> 2, wc = wid & 3, fr = lane & 15, fq = lane >> 4;
    const int K = g.K, nt = K / BK;
    unsigned voffA[2], voffB[2];
#pragma unroll
    for (int i = 0; i < 2; ++i) { int R, C; stage_rc(tid * 16 + i * 8192, R, C); const int Rb = Epi::PERM ? ((R & ~31) + perm32(R & 31)) : R;
        voffA[i] = (unsigned)(R * K + C) * 2u; voffB[i] = (unsigned)(Rb * K + C) * 2u; }
    const size_t kstep = (size_t)(BK * 2);
    const size_t hstep = (size_t)HALF * K * 2;
    const size_t tstep = 2 * hstep;
    const unsigned ldsw = (unsigned)wid * 1024u;
    const int aoff = lds_byte(wr * 64 + fr, fq * 8), boff = lds_byte(wc * 32 + fr, fq * 8);
#define PG8_SA(b, h) (((b) * 2 + (h)) * HTB)
#define PG8_SB(b, h) ((4 + (b) * 2 + (h)) * HTB)
#define PG8_STAGE(bufoff, gbase, voff) do { _Pragma("unroll") for (int _i = 0; _i < 2; ++_i) \
        __builtin_amdgcn_global_load_lds((const unsigned*)((const char*)(gbase) + (voff)[_i]), (PG8_LAS unsigned*)(lds + (bufoff) + ldsw + _i * 8192), 16, 0, 0); } while (0)
#define PG8_LDA(dst, b, h) do { _Pragma("unroll") for (int m = 0; m < 4; ++m) _Pragma("unroll") for (int k = 0; k < 2; ++k) dst[m][k] = *(const PG8_LAS bf16x8*)(lds + PG8_SA(b, h) + aoff + m * 2048 + k * 1024); } while (0)
#define PG8_LDB(dst, b, h) do { _Pragma("unroll") for (int n = 0; n < 2; ++n) _Pragma("unroll") for (int k = 0; k < 2; ++k) dst[n][k] = *(const PG8_LAS bf16x8*)(lds + PG8_SB(b, h) + boff + n * 2048 + k * 1024); } while (0)
#define PG8_MMA(ai, bj, At, Bt) do { __builtin_amdgcn_s_setprio(1); _Pragma("unroll") for (int m = 0; m < 4; ++m) _Pragma("unroll") for (int n = 0; n < 2; ++n) _Pragma("unroll") for (int k = 0; k < 2; ++k) \
        acc[ai][bj][m][n] = __builtin_amdgcn_mfma_f32_16x16x32_bf16(Bt[n][k], At[m][k], acc[ai][bj][m][n], 0, 0, 0); __builtin_amdgcn_s_setprio(0); } while (0)
#define PG8_WAIT_V(n) asm volatile("s_waitcnt vmcnt(" #n ")" ::: "memory")
#define PG8_WAIT_L(n) asm volatile("s_waitcnt lgkmcnt(" #n ")" ::: "memory")
#define PG8_BAR __builtin_amdgcn_s_barrier()
#define PG8_SCHED __builtin_amdgcn_sched_barrier(0)
    Unit cur, nxt; int ui = 0;
    if (!S.next(0, cur)) return;
    f32x4 acc[2][2][4][2];
#pragma unroll
    for (int a = 0; a < 2; ++a)
#pragma unroll
        for (int b = 0; b < 2; ++b)
#pragma unroll
            for (int m = 0; m < 4; ++m)
#pragma unroll
                for (int n = 0; n < 2; ++n) acc[a][b][m][n] = (f32x4){0.f, 0.f, 0.f, 0.f};
    bf16x8 At[4][2], B0[2][2], B1[2][2];
    const char* cA = (const char*)g.A + (size_t)cur.pm * tstep; const char* cB = (const char*)g.Bt + (size_t)cur.pn * tstep;
    S.a_ready(cur);
    if constexpr (SP2) {
        PG8_STAGE(PG8_SB(0, 0), cB, voffB); PG8_STAGE(PG8_SB(0, 1), cB + hstep, voffB); PG8_STAGE(PG8_SA(0, 0), cA, voffA); PG8_STAGE(PG8_SA(0, 1), cA + hstep, voffA);
        if (wr == 1) PG8_BAR;
        PG8_WAIT_V(2); PG8_BAR;
        PG8_STAGE(PG8_SB(1, 0), cB + kstep, voffB); PG8_STAGE(PG8_SA(1, 0), cA + kstep, voffA); PG8_STAGE(PG8_SB(1, 1), cB + hstep + kstep, voffB);
        PG8_WAIT_V(6); PG8_BAR;
    } else {
        PG8_STAGE(PG8_SB(0, 0), cB, voffB); PG8_STAGE(PG8_SA(0, 0), cA, voffA); PG8_STAGE(PG8_SB(0, 1), cB + hstep, voffB); PG8_STAGE(PG8_SA(0, 1), cA + hstep, voffA);
        if (wr == 1) PG8_BAR;
        PG8_WAIT_V(4); PG8_BAR;
        PG8_STAGE(PG8_SB(1, 0), cB + kstep, voffB); PG8_STAGE(PG8_SA(1, 0), cA + kstep, voffA); PG8_STAGE(PG8_SB(1, 1), cB + hstep + kstep, voffB);
        PG8_WAIT_V(6); PG8_BAR;
    }
    for (;;) {
        const bool has_next = S.next(ui + 1, nxt);
        const char* nA = has_next ? (const char*)g.A + (size_t)nxt.pm * tstep : cA; const char* nB = has_next ? (const char*)g.Bt + (size_t)nxt.pn * tstep : cB;
        for (int t = 0; t < nt; t += 2) {
            const bool last = (t == nt - 2);
            const char* a1 = cA + (size_t)(t + 1) * kstep;
            const char* a2 = last ? nA : cA + (size_t)(t + 2) * kstep; const char* b2 = last ? nB : cB + (size_t)(t + 2) * kstep;
            const char* a3 = a2 + kstep; const char* b3 = b2 + kstep;
            if (last && has_next) S.a_ready(nxt);
            if constexpr (SP2) {
            PG8_LDB(B0, 0, 0); PG8_LDB(B1, 0, 1); PG8_SCHED; PG8_LDA(At, 0, 0); PG8_STAGE(PG8_SA(1, 1), a1 + hstep, voffA);
            PG8_WAIT_V(8); PG8_WAIT_L(0); PG8_BAR; PG8_MMA(0, 0, At, B0); PG8_MMA(0, 1, At, B1); PG8_BAR; PG8_SCHED;
            PG8_LDA(At, 0, 1); PG8_STAGE(PG8_SB(0, 0), b2, voffB); PG8_STAGE(PG8_SB(0, 1), b2 + hstep, voffB); PG8_STAGE(PG8_SA(0, 0), a2, voffA);
            PG8_WAIT_V(8); PG8_WAIT_L(0); PG8_BAR; PG8_MMA(1, 0, At, B0); PG8_MMA(1, 1, At, B1); PG8_BAR; PG8_SCHED;
            PG8_LDB(B0, 1, 0); PG8_LDB(B1, 1, 1); PG8_SCHED; PG8_LDA(At, 1, 0); PG8_STAGE(PG8_SA(0, 1), a2 + hstep, voffA);
            PG8_WAIT_V(8); PG8_WAIT_L(0); PG8_BAR; PG8_MMA(0, 0, At, B0); PG8_MMA(0, 1, At, B1); PG8_BAR; PG8_SCHED;
            PG8_LDA(At, 1, 1); PG8_STAGE(PG8_SB(1, 0), b3, voffB); PG8_STAGE(PG8_SB(1, 1), b3 + hstep, voffB); PG8_STAGE(PG8_SA(1, 0), a3, voffA);
            PG8_WAIT_V(8); PG8_WAIT_L(0); PG8_BAR; PG8_MMA(1, 0, At, B0); PG8_MMA(1, 1, At, B1); PG8_BAR; PG8_SCHED;
            } else {
            PG8_LDB(B0, 0, 0); PG8_SCHED; PG8_LDA(At, 0, 0); PG8_STAGE(PG8_SA(1, 1), a1 + hstep, voffA);
            PG8_WAIT_L(8); PG8_BAR; PG8_WAIT_L(0); PG8_MMA(0, 0, At, B0); PG8_BAR; PG8_SCHED;
            PG8_LDB(B1, 0, 1); PG8_STAGE(PG8_SB(0, 0), b2, voffB);
            PG8_BAR; PG8_WAIT_L(0); PG8_MMA(0, 1, At, B1); PG8_BAR;
            PG8_LDA(At, 0, 1); PG8_STAGE(PG8_SA(0, 0), a2, voffA);
            PG8_BAR; PG8_WAIT_L(0); PG8_MMA(1, 0, At, B0); PG8_BAR; PG8_SCHED;
            PG8_STAGE(PG8_SB(0, 1), b2 + hstep, voffB);
            PG8_WAIT_V(6); PG8_BAR; PG8_MMA(1, 1, At, B1); PG8_BAR;
            PG8_LDB(B0, 1, 0); PG8_SCHED; PG8_LDA(At, 1, 0); PG8_STAGE(PG8_SA(0, 1), a2 + hstep, voffA);
            PG8_WAIT_L(8); PG8_BAR; PG8_WAIT_L(0); PG8_MMA(0, 0, At, B0); PG8_BAR; PG8_SCHED;
            PG8_LDB(B1, 1, 1); PG8_STAGE(PG8_SB(1, 0), b3, voffB);
            PG8_BAR; PG8_WAIT_L(0); PG8_MMA(0, 1, At, B1); PG8_BAR;
            PG8_LDA(At, 1, 1); PG8_STAGE(PG8_SA(1, 0), a3, voffA);
            PG8_BAR; PG8_WAIT_L(0); PG8_MMA(1, 0, At, B0); PG8_BAR; PG8_SCHED;
            PG8_STAGE(PG8_SB(1, 1), b3 + hstep, voffB);
            PG8_WAIT_V(6); PG8_BAR; PG8_MMA(1, 1, At, B1); PG8_BAR;
            }
        }
        if constexpr (ALIGN_EPI) { if (wr == 0) PG8_BAR; }
        if constexpr (!Epi::AFTER_DRAIN) { E(acc, cur, wr, wc, fr, fq); S.done(cur); }
        if (!has_next) break;
#pragma unroll
        for (int a = 0; a < 2; ++a)
#pragma unroll
            for (int b = 0; b < 2; ++b)
#pragma unroll
                for (int m = 0; m < 4; ++m)
#pragma unroll
                    for (int n = 0; n < 2; ++n) acc[a][b][m][n] = (f32x4){0.f, 0.f, 0.f, 0.f};
        cur = nxt; cA = nA; cB = nB; ++ui;
        if constexpr (ALIGN_EPI) { if (wr == 1) PG8_BAR; }
    }
    PG8_WAIT_V(0);
    if constexpr (!ALIGN_EPI) { if (wr == 0) PG8_BAR; }
    PG8_BAR;
    if constexpr (Epi::AFTER_DRAIN) { E.fused(acc, cur, wr, wc, fr, fq, lds, wid, lane); S.done(cur); }
#undef PG8_SA
#undef PG8_SB
#undef PG8_STAGE
#undef PG8_LDA
#undef PG8_LDB
#undef PG8_MMA
#undef PG8_WAIT_V
#undef PG8_WAIT_L
#undef PG8_BAR
#undef PG8_SCHED
}
__device__ __forceinline__ float bf2f(unsigned short h) { return __uint_as_float(((unsigned)h) << 16); }
__device__ __forceinline__ float fast_sigmoid(float x) { return __builtin_amdgcn_rcpf(1.0f + __builtin_amdgcn_exp2f(-1.4426950408889634f * x)); }
struct EpiG1 {
    static constexpr bool PERM = true, AFTER_DRAIN = false;
    bf16_t* U; bf16_t* G; const float* bias; const float* ssq;
    __device__ __forceinline__ void operator()(const f32x4 (&acc)[2][2][4][2], const Unit& u, int wr, int wc, int fr, int fq) const {
        const int row0 = u.pm * BM + wr * 64 + fr; int colt = u.pn * BM; const bool isg = colt >= 5376;
        bf16_t* base = U; int ldc = 5376; if (isg) { colt -= 5376; base = G; ldc = 3072; }
        const int col0 = colt + wc * 32 + 8 * fq;
        f32x4 bv[2][2];
#pragma unroll
        for (int bj = 0; bj < 2; ++bj)
#pragma unroll
            for (int n = 0; n < 2; ++n) bv[bj][n] = isg ? *(const f32x4*)(bias + col0 + bj * HALF + 4 * n) : (f32x4){0.f, 0.f, 0.f, 0.f};
        float rsq[2][4];
#pragma unroll
        for (int ai = 0; ai < 2; ++ai)
#pragma unroll
            for (int m = 0; m < 4; ++m) rsq[ai][m] = ssq ? __builtin_amdgcn_rsqf(ssq[row0 + ai * HALF + m * 16] * (1.0f / 1024.0f) + 1e-6f) : 1.0f;
#pragma unroll
        for (int ai = 0; ai < 2; ++ai)
#pragma unroll
            for (int m = 0; m < 4; ++m) { bf16_t* rowp = base + (size_t)(row0 + ai * HALF + m * 16) * ldc + col0;
                const float rs = rsq[ai][m];
#pragma unroll
                for (int bj = 0; bj < 2; ++bj) { f32x4 v0 = acc[ai][bj][m][0] * rs + bv[bj][0], v1 = acc[ai][bj][m][1] * rs + bv[bj][1];
                    if (isg) {
#pragma unroll
                        for (int e = 0; e < 4; ++e) { v0[e] = fast_sigmoid(v0[e]); v1[e] = fast_sigmoid(v1[e]); } }
                    u32x4 w; w.x = cvt_pk_bf16(v0[0], v0[1]); w.y = cvt_pk_bf16(v0[2], v0[3]); w.z = cvt_pk_bf16(v1[0], v1[1]); w.w = cvt_pk_bf16(v1[2], v1[3]);
                    *(u32x4*)(rowp + bj * HALF) = w; } }
    }
};
struct EpiG2 {
    static constexpr bool PERM = true, AFTER_DRAIN = false;
    const bf16_t* G; float* T; bf16_t* Mg; int npan;
    __device__ __forceinline__ void operator()(const f32x4 (&acc)[2][2][4][2], const Unit& u, int wr, int wc, int fr, int fq) const {
        const int b = u.pm / npan, pm = u.pm - b * npan, pn = u.pn & 3;
        const int row0 = pm * BM + wr * 64 + fr, col0 = pn * BM + wc * 32 + 8 * fq;
#pragma unroll
        for (int ai = 0; ai < 2; ++ai)
#pragma unroll
          for (int mh = 0; mh < 2; ++mh) {
            u32x4 gq[4][2], tq[4][2];
#pragma unroll
            for (int m = 2 * mh; m < 2 * mh + 2; ++m)
#pragma unroll
                for (int bj = 0; bj < 2; ++bj) { const size_t row = (size_t)(row0 + ai * HALF + m * 16); const int col = col0 + bj * HALF;
                    gq[m][bj] = *(const u32x4*)(G + row * 3072 + b * 1024 + col);
                    tq[m][bj] = (b > 0) ? *(const u32x4*)(Mg + row * 1024 + col) : (u32x4){0u, 0u, 0u, 0u}; }
            __builtin_amdgcn_sched_barrier(0);
#pragma unroll
            for (int m = 2 * mh; m < 2 * mh + 2; ++m)
#pragma unroll
                for (int bj = 0; bj < 2; ++bj) { const size_t row = (size_t)(row0 + ai * HALF + m * 16); const int col = col0 + bj * HALF; const u32x4 g = gq[m][bj], t = tq[m][bj];
                    f32x4 v0 = acc[ai][bj][m][0], v1 = acc[ai][bj][m][1];
                    v0[0] = v0[0] * __uint_as_float(g.x << 16) + __uint_as_float(t.x << 16); v0[1] = v0[1] * __uint_as_float(g.x & 0xffff0000u) + __uint_as_float(t.x & 0xffff0000u);
                    v0[2] = v0[2] * __uint_as_float(g.y << 16) + __uint_as_float(t.y << 16); v0[3] = v0[3] * __uint_as_float(g.y & 0xffff0000u) + __uint_as_float(t.y & 0xffff0000u);
                    v1[0] = v1[0] * __uint_as_float(g.z << 16) + __uint_as_float(t.z << 16); v1[1] = v1[1] * __uint_as_float(g.z & 0xffff0000u) + __uint_as_float(t.z & 0xffff0000u);
                    v1[2] = v1[2] * __uint_as_float(g.w << 16) + __uint_as_float(t.w << 16); v1[3] = v1[3] * __uint_as_float(g.w & 0xffff0000u) + __uint_as_float(t.w & 0xffff0000u);
                    u32x4 w; w.x = cvt_pk_bf16(v0[0], v0[1]); w.y = cvt_pk_bf16(v0[2], v0[3]); w.z = cvt_pk_bf16(v1[0], v1[1]); w.w = cvt_pk_bf16(v1[2], v1[3]);
                    *(u32x4*)(Mg + row * 1024 + col) = w; }
            __builtin_amdgcn_sched_barrier(0); }
    }
};
struct OrderG2 {
    int npan, G, c;
    __device__ bool next(int i, Unit& u) const { const int ti = i / 3, b = i - 3 * ti, t = ti * G + c; if (t >= npan * 4) return false;
        const int pm = t >> 2, pn = t & 3; u.pm = b * npan + pm; u.pn = b * 4 + pn; return true; }
    __device__ __forceinline__ void a_ready(const Unit&) const {}
    __device__ __forceinline__ void done(const Unit&) const {}
};
struct EpiG3 {
    static constexpr bool PERM = true, AFTER_DRAIN = false;
    const float* X; float* O; const float* gn; bf16_t* HN; float* ssq; int fuse;
    __device__ __forceinline__ void operator()(const f32x4 (&acc)[2][2][4][2], const Unit& u, int wr, int wc, int fr, int fq) const {
        const int row0 = u.pm * BM + wr * 64 + fr, col0 = u.pn * BM + wc * 32 + 8 * fq;
        f32x4 gv[2][2];
#pragma unroll
        for (int bj = 0; bj < 2; ++bj)
#pragma unroll
            for (int n = 0; n < 2; ++n) gv[bj][n] = fuse ? *(const f32x4*)(gn + col0 + bj * HALF + 4 * n) : (f32x4){0.f, 0.f, 0.f, 0.f};
#pragma unroll
        for (int ai = 0; ai < 2; ++ai)
#pragma unroll
         for (int mh = 0; mh < 2; ++mh) {
          f32x4 xq[4][2][2];
#pragma unroll
          for (int m = 2 * mh; m < 2 * mh + 2; ++m)
#pragma unroll
              for (int bj = 0; bj < 2; ++bj) { const size_t p = (size_t)(row0 + ai * HALF + m * 16) * 1024 + col0 + bj * HALF; xq[m][bj][0] = *(const f32x4*)(X + p); xq[m][bj][1] = *(const f32x4*)(X + p + 4); }
          __builtin_amdgcn_sched_barrier(0);
#pragma unroll
            for (int m = 2 * mh; m < 2 * mh + 2; ++m) { const size_t row = (size_t)(row0 + ai * HALF + m * 16); float sq = 0.f;
#pragma unroll
                for (int bj = 0; bj < 2; ++bj) { const size_t p = row * 1024 + col0 + bj * HALF;
                    const f32x4 x0 = xq[m][bj][0], x1 = xq[m][bj][1];
                    const f32x4 o0 = x0 + acc[ai][bj][m][0], o1 = x1 + acc[ai][bj][m][1];
                    *(f32x4*)(O + p) = o0; *(f32x4*)(O + p + 4) = o1;
                    if (fuse) { const f32x4 h0 = o0 * gv[bj][0], h1 = o1 * gv[bj][1];
                        u32x4 w; w.x = cvt_pk_bf16(h0[0], h0[1]); w.y = cvt_pk_bf16(h0[2], h0[3]); w.z = cvt_pk_bf16(h1[0], h1[1]); w.w = cvt_pk_bf16(h1[2], h1[3]);
                        *(u32x4*)(HN + p) = w;
                        sq += (o0[0] * o0[0] + o0[1] * o0[1]) + (o0[2] * o0[2] + o0[3] * o0[3]) + (o1[0] * o1[0] + o1[1] * o1[1]) + (o1[2] * o1[2] + o1[3] * o1[3]); } }
                if (fuse) { sq += shx(sq, 16); sq += shx(sq, 32); if (fq == 0) atomicAdd(ssq + row, sq); } }
          __builtin_amdgcn_sched_barrier(0); }
    }
};
struct EpiAll {
    static constexpr bool PERM = true, AFTER_DRAIN = false;
    int mode; EpiG1 e1; EpiG2 e2; EpiG3 e3;
    __device__ __forceinline__ void operator()(const f32x4 (&acc)[2][2][4][2], const Unit& u, int wr, int wc, int fr, int fq) const {
        if (mode == 1) e1(acc, u, wr, wc, fr, fq); else if (mode == 2) e2(acc, u, wr, wc, fr, fq); else e3(acc, u, wr, wc, fr, fq); }
};
struct OrderAll {
    int mode; StaticOrder so; OrderG2 o2;
    __device__ __forceinline__ bool next(int i, Unit& u) const { return mode == 2 ? o2.next(i, u) : so.next(i, u); }
    __device__ __forceinline__ void a_ready(const Unit&) const {}
    __device__ __forceinline__ void done(const Unit&) const {}
};
}
#ifndef DUP_MASK
#define DUP_MASK 0
#endif
#ifndef EN_MASK
#define EN_MASK 0xffff
#endif
#define EN(i) ((EN_MASK >> (i)) & 1)
#define LAS __attribute__((address_space(3)))
typedef unsigned short bf16;
typedef float f32x4 __attribute__((ext_vector_type(4)));
typedef float f32x2 __attribute__((ext_vector_type(2)));
typedef unsigned u32x4 __attribute__((ext_vector_type(4)));
typedef unsigned u32x2 __attribute__((ext_vector_type(2)));
constexpr int DM = 1024, NTOK_P = 65536, NTOK_S = 32768, NTOK = NTOK_P + NTOK_S, LP = 8192, LS = 2048;
constexpr int CH = 16384, NCHUNK = NTOK / CH, NCH_P = NTOK_P / CH;
constexpr int UP = 5376, NCAT = 8448, GP = 3072;
constexpr int C_X0 = 0, C_X1 = 512, C_HV = 1024, C_HG = 1536, C_GQ = 2048, C_GK = 2560, C_GV = 2688, C_GG = 2816, C_DQ = 3328, C_DK = 3840, C_DV = 4352, C_DG = 4864;
constexpr float EPS = 1e-6f, LOG2E = 1.4426950408889634f;
constexpr int NT = 512, NWAVES = 8;
enum { I_XP = 0, I_XS, I_RELB, I_NORMG, I_WIN, I_CONVW, I_CONVB, I_FW1, I_FB1, I_FW2, I_FB2, I_FWOUT, I_FFREQ, I_HYBIAS, I_QNG, I_KNG, I_LQ1, I_LK1, I_LQ2, I_LK2, I_SUBLN, I_WBHY, I_WBGQ, I_WBDF, I_WMERGE, I_BMERGE, I_WOUT, I_FINALG, N_IN };
constexpr size_t MiB = 1u << 20;
constexpr size_t WS_CTL = 0, CTL_BYTES = 64 * 1024;
constexpr size_t WS_TW = 1 * MiB;
constexpr size_t WS_WCAT = 2 * MiB, WCAT_BYTES = (size_t)NCAT * 1024 * 2;
constexpr size_t WS_WBT = 40 * MiB, WBT_BYTES = (size_t)3 * 1024 * 512 * 2;
constexpr size_t WS_WOT = 46 * MiB, WOT_BYTES = (size_t)1024 * 1024 * 2;
constexpr int SPS_P = LP + 16, SPS_S = LS + 16;
constexpr size_t SPEC_P_BYTES = (size_t)256 * SPS_P * 8, SPEC_S_BYTES = (size_t)256 * SPS_S * 8;
constexpr size_t SPEC_LAYER = 2 * SPEC_P_BYTES + 2 * SPEC_S_BYTES;
constexpr size_t WS_SPEC = 52 * MiB;
constexpr size_t WS_HN = 140 * MiB, WS_U = 172 * MiB, WS_G = 340 * MiB, WS_Y = 436 * MiB, WS_MG = 484 * MiB, WS_TMP = 516 * MiB, WS_DT = 580 * MiB, WS_HVP = 612 * MiB, WS_PMP = 644 * MiB, WS_ROPE = 676 * MiB, WS_HN0 = 680 * MiB, WS_HF = 872 * MiB, WS_END = 952 * MiB;
constexpr size_t HF_P_BYTES = (size_t)LP * 1024 * 4, HF_S_BYTES = (size_t)LS * 1024 * 4;
static_assert(WS_WCAT + 2 * WCAT_BYTES <= WS_WBT && WS_WBT + 2 * WBT_BYTES <= WS_WOT && WS_WOT + 2 * WOT_BYTES <= WS_SPEC && WS_SPEC + 2 * SPEC_LAYER <= WS_HN, "ws map");
static_assert(WS_HN + (size_t)CH * 1024 * 2 <= WS_U && WS_U + (size_t)CH * UP * 2 <= WS_G && WS_G + (size_t)CH * GP * 2 <= WS_Y && WS_Y + (size_t)3 * CH * 512 * 2 <= WS_MG && WS_MG + (size_t)CH * 1024 * 2 <= WS_TMP && WS_TMP + (size_t)CH * 1024 * 4 <= WS_DT && WS_DT + (size_t)CH * 512 * 4 <= WS_END, "ws map 2");
static_assert(WS_HF + 2 * (HF_P_BYTES + HF_S_BYTES) <= WS_END, "hf region");
constexpr size_t WS_SSQ = WS_TMP;
constexpr int LDS_MAIN = 139264, LDS_BYTES = LDS_MAIN + 1024;
constexpr int CW_BAR = 4096;

struct Args { const float* in[N_IN]; float* out; unsigned char* ws; int lo, hi; };
typedef const __attribute__((address_space(4))) unsigned long long* kargp_t;
struct AV { kargp_t p; };
#define AIN(i) ((const float*)(a.p[(i)]))
#define AOUT ((float*)(a.p[N_IN]))
#define AWS ((unsigned char*)(a.p[N_IN + 1]))


__device__ __forceinline__ float bf2f(unsigned short h) { return __uint_as_float(((unsigned)h) << 16); }
__device__ __forceinline__ float bflo(unsigned w) { return __uint_as_float(w << 16); }
__device__ __forceinline__ float bfhi(unsigned w) { return __uint_as_float(w & 0xffff0000u); }
__device__ __forceinline__ unsigned f2bf(float f) { unsigned u = __builtin_bit_cast(unsigned, f); return (u + 0x7fffu + ((u >> 16) & 1u)) >> 16; }
__device__ __forceinline__ unsigned pk2(float lo, float hi) { return f2bf(lo) | (f2bf(hi) << 16); }
__device__ __forceinline__ float silu(float x) { return x * __builtin_amdgcn_rcpf(1.0f + __builtin_amdgcn_exp2f(-LOG2E * x)); }
__device__ __forceinline__ float wave_sum(float v) {
#pragma unroll
    for (int o = 1; o < 64; o <<= 1) v += shx(v, o);
    return v;
}
__device__ __forceinline__ double kd(double v) { asm volatile("" : "+s"(v)); return v; }
__device__ __forceinline__ void sincos_rev(double r, float& s, float& c) {
    r -= __builtin_rint(r);
    const double k = __builtin_rint(r * 4.0);
    const double x = (r - k * 0.25) * kd(6.283185307179586476925);
    const double x2 = x * x;
    double sp = kd(1.0 / 6227020800.0); sp = sp * x2 + kd(-1.0 / 39916800); sp = sp * x2 + kd(1.0 / 362880); sp = sp * x2 + kd(-1.0 / 5040); sp = sp * x2 + kd(1.0 / 120); sp = sp * x2 + kd(-1.0 / 6); sp = sp * x2 + 1.0; sp *= x;
    double cp = kd(-1.0 / 87178291200.0); cp = cp * x2 + kd(1.0 / 479001600.0); cp = cp * x2 + kd(-1.0 / 3628800); cp = cp * x2 + kd(1.0 / 40320); cp = cp * x2 + kd(-1.0 / 720); cp = cp * x2 + kd(1.0 / 24); cp = cp * x2 + (-0.5); cp = cp * x2 + 1.0;
    const int q = ((int)k) & 3;
    const float sf = (float)sp, cf = (float)cp;
    s = (q == 0) ? sf : (q == 1) ? cf : (q == 2) ? -sf : -cf;
    c = (q == 0) ? cf : (q == 1) ? -sf : (q == 2) ? -cf : sf;
}
__device__ __forceinline__ float sin_acc(float x) { float s, c; sincos_rev((double)x * 0.15915494309189533577, s, c); return s; }

__device__ __forceinline__ void transpose_item(const float* W, int K, int N, bf16* WT, int row_off, LAS float* scr, int item, int lane) {
    const int nblk = N / 32, kb = item / nblk, nb = item % nblk, k0 = 64 * kb, n0 = 32 * nb;
#pragma unroll 8
    for (int i = 0; i < 32; ++i) { const int kk = 2 * i + (lane >> 5); scr[kk * 33 + (lane & 31)] = W[(size_t)(k0 + kk) * N + n0 + (lane & 31)]; }
    asm volatile("s_waitcnt lgkmcnt(0)" ::: "memory");
    const int c = lane & 7;
#pragma unroll
    for (int j = 0; j < 4; ++j) { const int n = (lane >> 3) + 8 * j; const LAS float* s = scr + (8 * c) * 33 + n;
        u32x4 o; o.x = pk2(s[0 * 33], s[1 * 33]); o.y = pk2(s[2 * 33], s[3 * 33]); o.z = pk2(s[4 * 33], s[5 * 33]); o.w = pk2(s[6 * 33], s[7 * 33]);
        *(u32x4*)(WT + (size_t)(row_off + n0 + n) * K + k0 + 8 * c) = o; }
    asm volatile("s_waitcnt lgkmcnt(0)" ::: "memory");
}

__device__ __forceinline__ f32x2 cmul(f32x2 a, f32x2 b) { return (f32x2){a.x * b.x - a.y * b.y, a.x * b.y + a.y * b.x}; }
__device__ __forceinline__ f32x2 cmulc(f32x2 a, f32x2 b) { return (f32x2){a.x * b.x + a.y * b.y, a.y * b.x - a.x * b.y}; }
__device__ __forceinline__ f32x2 cconj(f32x2 a) { return (f32x2){a.x, -a.y}; }
template <int LOG4> __device__ __forceinline__ int digitrev(int k) { unsigned x = __builtin_bitreverse32((unsigned)k) >> (32 - 2 * LOG4); return (int)(((x & 0x55555555u) << 1) | ((x >> 1) & 0x55555555u)); }
__device__ __forceinline__ unsigned cvtpk(float lo, float hi);
#define PADI(i) ((i) + ((i) >> 4))
#define W16C 0.92387953251128674f
#define W16S 0.38268343236508977f
#define W16H 0.70710678118654752f
__device__ __forceinline__ f32x2 w16(int m) { return m == 0 ? (f32x2){1.f, 0.f} : m == 1 ? (f32x2){W16C, -W16S} : m == 2 ? (f32x2){W16H, -W16H} : m == 3 ? (f32x2){W16S, -W16C} : m == 4 ? (f32x2){0.f, -1.f} : m == 6 ? (f32x2){-W16H, -W16H} : (f32x2){-W16C, W16S}; }
__device__ __forceinline__ void bfly_fwd(f32x2& a0, f32x2& a1, f32x2& a2, f32x2& a3) {
    const f32x2 t0 = a0 + a2, t1 = a0 - a2, t2 = a1 + a3, t3 = a1 - a3;
    a0 = t0 + t2; a2 = t0 - t2; a1 = (f32x2){t1.x + t3.y, t1.y - t3.x}; a3 = (f32x2){t1.x - t3.y, t1.y + t3.x};
}
__device__ __forceinline__ void bfly_inv(f32x2& b0, f32x2& b1, f32x2& b2, f32x2& b3) {
    const f32x2 t0 = b0 + b2, t1 = b0 - b2, t2 = b1 + b3, t3 = b1 - b3;
    b0 = t0 + t2; b2 = t0 - t2; b1 = (f32x2){t1.x - t3.y, t1.y + t3.x}; b3 = (f32x2){t1.x + t3.y, t1.y - t3.x};
}
__device__ __forceinline__ void tail_fwd(f32x2 (&x)[16]) {
#pragma unroll
    for (int jj = 0; jj < 4; ++jj) { bfly_fwd(x[jj], x[jj + 4], x[jj + 8], x[jj + 12]); if (jj) { x[jj + 4] = cmul(x[jj + 4], w16(jj)); x[jj + 8] = cmul(x[jj + 8], w16(2 * jj)); x[jj + 12] = cmul(x[jj + 12], w16(3 * jj)); } }
#pragma unroll
    for (int q = 0; q < 4; ++q) bfly_fwd(x[4 * q], x[4 * q + 1], x[4 * q + 2], x[4 * q + 3]);
}
__device__ __forceinline__ void tail_inv(f32x2 (&x)[16]) {
#pragma unroll
    for (int q = 0; q < 4; ++q) bfly_inv(x[4 * q], x[4 * q + 1], x[4 * q + 2], x[4 * q + 3]);
#pragma unroll
    for (int jj = 0; jj < 4; ++jj) { if (jj) { x[jj + 4] = cmulc(x[jj + 4], w16(jj)); x[jj + 8] = cmulc(x[jj + 8], w16(2 * jj)); x[jj + 12] = cmulc(x[jj + 12], w16(3 * jj)); } bfly_inv(x[jj], x[jj + 4], x[jj + 8], x[jj + 12]); }
}
__device__ __forceinline__ void pair_mul(f32x2& z1, f32x2& z2, f32x2 P, f32x2 M) { const f32x2 a = z1, b = z2; z1 = cmul(a, P) + cmul(cconj(b), M); z2 = cmulc(b, P) + cmulc(cconj(a), M); }
template <int LOG4, int BATCH> __device__ __forceinline__ void fft_tail_mul_tail(LAS f32x2* buf, const f32x2* __restrict__ Pg, const f32x2* __restrict__ Mg, int sps, int tid) {
    constexpr int N = 1 << (2 * LOG4), NB = N / 16, NI = NB / 2, NPAD = N + N / 16, TOT = BATCH * NI, IT = (TOT + NT - 1) / NT;
#define RR(e_) ((((e_) & 3) << 2) | ((e_) >> 2))
#pragma unroll 1
    for (int i = 0; i < IT; ++i) { const int ig = tid + i * NT; if (TOT % NT != 0 && ig >= TOT) break;
        const int bt = ig / NI, u = ig - bt * NI; if (u == 0) continue;
        const f32x2* P = Pg + (size_t)bt * sps; const f32x2* M = Mg + (size_t)bt * sps;
        const int bA = ((u >> 1) << 2) | (u & 1), bB = digitrev<LOG4 - 2>(NB - digitrev<LOG4 - 2>(bA));
        LAS f32x2* xa = buf + bt * NPAD + 17 * bA; LAS f32x2* xb = buf + bt * NPAD + 17 * bB;
        f32x2 x[16], y[16];
#pragma unroll
        for (int e = 0; e < 16; ++e) { x[e] = xa[e]; y[e] = xb[e]; }
        tail_fwd(x); tail_fwd(y);
#pragma unroll
        for (int e = 0; e < 16; ++e) if ((e & 3) < 2) { const int Re = RR(e), ep = RR(15 - Re);
            pair_mul(x[e], y[ep], P[bA * 8 + Re], M[bA * 8 + Re]);
            pair_mul(y[e], x[ep], P[bB * 8 + Re], M[bB * 8 + Re]);
            if ((e & 7) == 5) __builtin_amdgcn_sched_barrier(0); }
        tail_inv(x); tail_inv(y);
#pragma unroll
        for (int e = 0; e < 16; ++e) { xa[e] = x[e]; xb[e] = y[e]; }
    }
    if (tid < 2 * BATCH) {
        const int bt = tid >> 1, sel = tid & 1; const f32x2* P = Pg + (size_t)bt * sps; const f32x2* M = Mg + (size_t)bt * sps;
        LAS f32x2* xa = buf + bt * NPAD + 17 * digitrev<LOG4 - 2>(sel ? NB / 2 : 0);
        f32x2 x[16];
#pragma unroll
        for (int e = 0; e < 16; ++e) x[e] = xa[e];
        tail_fwd(x);
        if (sel == 0) {
            { f32x2 t = x[0]; pair_mul(x[0], t, P[0], M[0]); }
            { f32x2 t = x[2]; pair_mul(x[2], t, P[N / 2], M[N / 2]); }
#pragma unroll
            for (int e = 1; e < 16; ++e) if ((e & 3) < 2) { const int Re = RR(e), ep = RR(16 - Re); pair_mul(x[e], x[ep], P[Re], M[Re]); }
        } else {
#pragma unroll
            for (int e = 0; e < 16; ++e) if ((e & 3) < 2) { const int Re = RR(e), ep = RR(15 - Re); const int sl = digitrev<LOG4 - 2>(NB / 2) * 8 + Re; pair_mul(x[e], x[ep], P[sl], M[sl]); }
        }
        tail_inv(x);
#pragma unroll
        for (int e = 0; e < 16; ++e) xa[e] = x[e];
    }
#undef RR
    __syncthreads();
}
template <int LOG4, int BATCH = 1, int PS0 = 0, bool TAIL = true> __device__ __forceinline__ void fft_fwd(LAS f32x2* buf, const f32x2* __restrict__ tw, int tid) {
    constexpr int N = 1 << (2 * LOG4), TWS = 16384 / N;
    constexpr int NPAD = N + N / 16, NLEV = LOG4 - 2, NP16 = NLEV / 2;
#pragma unroll 1
    for (int ps = PS0; ps < NP16; ++ps) {
        const int lq4 = 2 * (LOG4 - 2 * ps) - 2, lq16 = lq4 - 2, q4 = 1 << lq4, q16 = 1 << lq16, tsA = TWS << (4 * ps), tsB = tsA << 2;
        constexpr int TOT = BATCH * N / 16, IT = (TOT + NT - 1) / NT;
#pragma unroll
        for (int i = 0; i < IT; ++i) { const int jg = tid + i * NT; if (TOT % NT != 0 && jg >= TOT) break; const int bo = (jg >> (2 * LOG4 - 4)) * NPAD, j = jg & (N / 16 - 1);
            const int blk = j >> lq16, jj = j & (q16 - 1), base = (blk << (lq4 + 2)) + jj;
            f32x2 wa[4], wb = tw[jj * tsB];
#pragma unroll
            for (int b = 0; b < 4; ++b) wa[b] = tw[(jj + b * q16) * tsA];
            f32x2 e[4][4];
#pragma unroll
            for (int a = 0; a < 4; ++a)
#pragma unroll
                for (int b = 0; b < 4; ++b) e[a][b] = buf[bo + PADI(base + b * q16 + a * q4)];
#pragma unroll
            for (int b = 0; b < 4; ++b) { bfly_fwd(e[0][b], e[1][b], e[2][b], e[3][b]); const f32x2 w2 = cmul(wa[b], wa[b]), w3 = cmul(w2, wa[b]); e[1][b] = cmul(e[1][b], wa[b]); e[2][b] = cmul(e[2][b], w2); e[3][b] = cmul(e[3][b], w3); }
            { const f32x2 w2 = cmul(wb, wb), w3 = cmul(w2, wb);
#pragma unroll
              for (int a = 0; a < 4; ++a) { bfly_fwd(e[a][0], e[a][1], e[a][2], e[a][3]); e[a][1] = cmul(e[a][1], wb); e[a][2] = cmul(e[a][2], w2); e[a][3] = cmul(e[a][3], w3); } }
#pragma unroll
            for (int a = 0; a < 4; ++a)
#pragma unroll
                for (int b = 0; b < 4; ++b) buf[bo + PADI(base + b * q16 + a * q4)] = e[a][b];
        }
        __syncthreads();
    }
#pragma unroll 1
    for (int pass = 2 * NP16; pass < NLEV; ++pass) {
        const int lq = 2 * (LOG4 - pass) - 2, q4 = 1 << lq, n = q4 << 2, tstep = TWS << (2 * pass);
        constexpr int IT = BATCH * N / 4 / NT;
        f32x2 wl[IT];
#pragma unroll
        for (int i = 0; i < IT; ++i) wl[i] = tw[((tid + i * NT) & (q4 - 1)) * tstep];
#pragma unroll
        for (int i = 0; i < IT; ++i) { const int jg = tid + i * NT, bo = (jg >> (2 * LOG4 - 2)) * NPAD, j = jg & (N / 4 - 1);
            const int blk = j >> lq, jj = j & (q4 - 1), base = blk * n + jj;
            const int i0 = bo + PADI(base), i1 = bo + PADI(base + q4), i2 = bo + PADI(base + 2 * q4), i3 = bo + PADI(base + 3 * q4);
            const f32x2 w1 = wl[i];
            f32x2 a0 = buf[i0], a1 = buf[i1], a2 = buf[i2], a3 = buf[i3];
            bfly_fwd(a0, a1, a2, a3);
            const f32x2 w2 = cmul(w1, w1), w3 = cmul(w2, w1);
            buf[i0] = a0; buf[i1] = cmul(a1, w1); buf[i2] = cmul(a2, w2); buf[i3] = cmul(a3, w3);
        }
        __syncthreads();
    }
    if constexpr (TAIL) {
#pragma unroll 1
    for (int b = tid; b < BATCH * N / 16; b += NT) {
        LAS f32x2* xb = buf + 17 * b; f32x2 x[16];
#pragma unroll
        for (int e = 0; e < 16; ++e) x[e] = xb[e];
        tail_fwd(x);
#pragma unroll
        for (int e = 0; e < 16; ++e) xb[e] = x[e];
    }
    __syncthreads(); }
}
template <int LOG4, int BATCH = 1, int PS0 = 0, bool TAIL = true> __device__ __forceinline__ void fft_inv(LAS f32x2* buf, const f32x2* __restrict__ tw, int tid) {
    constexpr int N = 1 << (2 * LOG4), TWS = 16384 / N;
    if constexpr (TAIL) {
#pragma unroll 1
    for (int b = tid; b < BATCH * N / 16; b += NT) {
        LAS f32x2* xb = buf + 17 * b; f32x2 x[16];
#pragma unroll
        for (int e = 0; e < 16; ++e) x[e] = xb[e];
        tail_inv(x);
#pragma unroll
        for (int e = 0; e < 16; ++e) xb[e] = x[e];
    }
    __syncthreads(); }
    constexpr int NPAD = N + N / 16, NLEV = LOG4 - 2, NP16 = NLEV / 2;
#pragma unroll 1
    for (int pass = NLEV - 1; pass >= 2 * NP16; --pass) {
        const int lq = 2 * (LOG4 - pass) - 2, q4 = 1 << lq, n = q4 << 2, tstep = TWS << (2 * pass);
        constexpr int IT = BATCH * N / 4 / NT;
        f32x2 wl[IT];
#pragma unroll
        for (int i = 0; i < IT; ++i) wl[i] = tw[((tid + i * NT) & (q4 - 1)) * tstep];
#pragma unroll
        for (int i = 0; i < IT; ++i) { const int jg = tid + i * NT, bo = (jg >> (2 * LOG4 - 2)) * NPAD, j = jg & (N / 4 - 1);
            const int blk = j >> lq, jj = j & (q4 - 1), base = blk * n + jj;
            const int i0 = bo + PADI(base), i1 = bo + PADI(base + q4), i2 = bo + PADI(base + 2 * q4), i3 = bo + PADI(base + 3 * q4);
            const f32x2 w1 = wl[i];
            const f32x2 w2 = cmul(w1, w1), w3 = cmul(w2, w1);
            f32x2 b0 = buf[i0], b1 = cmulc(buf[i1], w1), b2 = cmulc(buf[i2], w2), b3 = cmulc(buf[i3], w3);
            bfly_inv(b0, b1, b2, b3);
            buf[i0] = b0; buf[i1] = b1; buf[i2] = b2; buf[i3] = b3;
        }
        __syncthreads();
    }
#pragma unroll 1
    for (int ps = NP16 - 1; ps >= PS0; --ps) {
        const int lq4 = 2 * (LOG4 - 2 * ps) - 2, lq16 = lq4 - 2, q4 = 1 << lq4, q16 = 1 << lq16, tsA = TWS << (4 * ps), tsB = tsA << 2;
        constexpr int TOT = BATCH * N / 16, IT = (TOT + NT - 1) / NT;
#pragma unroll
        for (int i = 0; i < IT; ++i) { const int jg = tid + i * NT; if (TOT % NT != 0 && jg >= TOT) break; const int bo = (jg >> (2 * LOG4 - 4)) * NPAD, j = jg & (N / 16 - 1);
            const int blk = j >> lq16, jj = j & (q16 - 1), base = (blk << (lq4 + 2)) + jj;
            f32x2 wa[4], wb = tw[jj * tsB];
#pragma unroll
            for (int b = 0; b < 4; ++b) wa[b] = tw[(jj + b * q16) * tsA];
            f32x2 e[4][4];
#pragma unroll
            for (int a = 0; a < 4; ++a)
#pragma unroll
                for (int b = 0; b < 4; ++b) e[a][b] = buf[bo + PADI(base + b * q16 + a * q4)];
            { const f32x2 w2 = cmul(wb, wb), w3 = cmul(w2, wb);
#pragma unroll
              for (int a = 0; a < 4; ++a) { e[a][1] = cmulc(e[a][1], wb); e[a][2] = cmulc(e[a][2], w2); e[a][3] = cmulc(e[a][3], w3); bfly_inv(e[a][0], e[a][1], e[a][2], e[a][3]); } }
#pragma unroll
            for (int b = 0; b < 4; ++b) { const f32x2 w2 = cmul(wa[b], wa[b]), w3 = cmul(w2, wa[b]); e[1][b] = cmulc(e[1][b], wa[b]); e[2][b] = cmulc(e[2][b], w2); e[3][b] = cmulc(e[3][b], w3); bfly_inv(e[0][b], e[1][b], e[2][b], e[3][b]); }
#pragma unroll
            for (int a = 0; a < 4; ++a)
#pragma unroll
                for (int b = 0; b < 4; ++b) buf[bo + PADI(base + b * q16 + a * q4)] = e[a][b];
        }
        __syncthreads();
    }
}
template <int LOG4> __device__ __forceinline__ void fft_first_from_global(LAS f32x2* buf, const f32x2* __restrict__ tw, const f32x2* __restrict__ src, int tid) {
    constexpr int N = 1 << (2 * LOG4), TWS = 16384 / N, q4 = N / 4, q16 = N / 16, IT = N / 16 / NT;
    static_assert(N / 16 % NT == 0, "one or more items per thread");
#pragma unroll
    for (int i = 0; i < IT; ++i) { const int jj = tid + i * NT;
        f32x2 wa[4], wb = tw[jj * (TWS << 2)];
#pragma unroll
        for (int b = 0; b < 4; ++b) wa[b] = tw[(jj + b * q16) * TWS];
        f32x2 e[4][4];
#pragma unroll
        for (int b = 0; b < 4; ++b) { e[0][b] = src[jj + b * q16]; e[1][b] = src[jj + b * q16 + q4]; e[2][b] = (f32x2){0.f, 0.f}; e[3][b] = (f32x2){0.f, 0.f}; }
#pragma unroll
        for (int b = 0; b < 4; ++b) { bfly_fwd(e[0][b], e[1][b], e[2][b], e[3][b]); const f32x2 w2 = cmul(wa[b], wa[b]), w3 = cmul(w2, wa[b]); e[1][b] = cmul(e[1][b], wa[b]); e[2][b] = cmul(e[2][b], w2); e[3][b] = cmul(e[3][b], w3); }
        { const f32x2 w2 = cmul(wb, wb), w3 = cmul(w2, wb);
#pragma unroll
          for (int a = 0; a < 4; ++a) { bfly_fwd(e[a][0], e[a][1], e[a][2], e[a][3]); e[a][1] = cmul(e[a][1], wb); e[a][2] = cmul(e[a][2], w2); e[a][3] = cmul(e[a][3], w3); } }
#pragma unroll
        for (int a = 0; a < 4; ++a)
#pragma unroll
            for (int b = 0; b < 4; ++b) buf[PADI(jj + b * q16 + a * q4)] = e[a][b];
    }
    __syncthreads();
}
template <int LOG4> __device__ __forceinline__ void fft_last_to_global(const LAS f32x2* buf, const f32x2* __restrict__ tw, const f32x2* __restrict__ pm, bf16* Yc, int tid) {
    constexpr int N = 1 << (2 * LOG4), TWS = 16384 / N, q4 = N / 4, q16 = N / 16, IT = N / 16 / NT;
#pragma unroll
    for (int i = 0; i < IT; ++i) { const int jj = tid + i * NT;
        f32x2 wa[4], wb = tw[jj * (TWS << 2)];
#pragma unroll
        for (int b = 0; b < 4; ++b) wa[b] = tw[(jj + b * q16) * TWS];
        f32x2 pmv[2][4];
#pragma unroll
        for (int a = 0; a < 2; ++a)
#pragma unroll
            for (int b = 0; b < 4; ++b) pmv[a][b] = pm[jj + b * q16 + a * q4];
        f32x2 e[4][4];
#pragma unroll
        for (int a = 0; a < 4; ++a)
#pragma unroll
            for (int b = 0; b < 4; ++b) e[a][b] = buf[PADI(jj + b * q16 + a * q4)];
        { const f32x2 w2 = cmul(wb, wb), w3 = cmul(w2, wb);
#pragma unroll
          for (int a = 0; a < 4; ++a) { e[a][1] = cmulc(e[a][1], wb); e[a][2] = cmulc(e[a][2], w2); e[a][3] = cmulc(e[a][3], w3); bfly_inv(e[a][0], e[a][1], e[a][2], e[a][3]); } }
#pragma unroll
        for (int b = 0; b < 4; ++b) { const f32x2 w2 = cmul(wa[b], wa[b]), w3 = cmul(w2, wa[b]); e[1][b] = cmulc(e[1][b], wa[b]); e[2][b] = cmulc(e[2][b], w2); e[3][b] = cmulc(e[3][b], w3); bfly_inv(e[0][b], e[1][b], e[2][b], e[3][b]); }
#pragma unroll
        for (int a = 0; a < 2; ++a)
#pragma unroll
            for (int b = 0; b < 4; ++b) { const int t = jj + b * q16 + a * q4; *(unsigned*)(Yc + (size_t)t * 512) = cvtpk(e[a][b].x * pmv[a][b].x, e[a][b].y * pmv[a][b].y); }
    }
}
__device__ const double ROPE_IF[16] = {1.0, 0.5623413251903491, 0.31622776601683794, 0.1778279410038923, 0.1, 0.05623413251903491, 0.03162277660168379, 0.01778279410038923,
    0.01, 0.005623413251903491, 0.0031622776601683794, 0.0017782794100389228, 0.001, 0.0005623413251903491, 0.00031622776601683794, 0.00017782794100389227};
struct Chunk { int tok0, L, nseq; };
__device__ __forceinline__ Chunk chunk_of(int c) { Chunk k; k.tok0 = c * CH; if (c < NCH_P) { k.L = LP; k.nseq = CH / LP; } else { k.L = LS; k.nseq = CH / LS; } return k; }
__device__ __forceinline__ const float* xin_rows(const AV& a, int tok0) { return tok0 < NTOK_P ? AIN(I_XP) + (size_t)tok0 * DM : AIN(I_XS) + (size_t)(tok0 - NTOK_P) * DM; }
__device__ __forceinline__ void hf_group(LAS float* sm, const AV& a, int layer, int L, int t0, float* hf, int tid) {
    LAS float* zs = sm; LAS float* A = sm + 512; LAS float* B = sm + 1024;
    const float* w1 = AIN(I_FW1) + layer * 33 * 64; const float* b1 = AIN(I_FB1) + layer * 64;
    const float* w2 = AIN(I_FW2) + layer * 2 * 64 * 64; const float* b2 = AIN(I_FB2) + layer * 2 * 64;
    const float* wo = AIN(I_FWOUT) + layer * 64 * 1024; const float* fr = AIN(I_FFREQ) + layer * 64;
    const int tt = tid >> 6, j = tid & 63, t = t0 + tt;
    const float t01 = (float)t / (float)(L - 1);
    if (j < 33) {
        float v;
        if (j == 0) v = t01;
        else { const int k = (j - 1) & 15; const double f = kd(1e-4) + (double)k * kd((15.0 - 1e-4) / 15.0); float s, c; sincos_rev(f * (double)t / (double)L, s, c); v = (j <= 16) ? c : -s; }
        zs[tt * 40 + j] = v;
    }
    __syncthreads();
    const float fq = fr[j];
    { float acc = b1[j]; for (int i = 0; i < 33; ++i) acc += zs[tt * 40 + i] * w1[i * 64 + j]; A[tt * 64 + j] = sin_acc(fq * acc); }
    __syncthreads();
    { float acc = b2[j]; for (int i = 0; i < 64; ++i) acc += A[tt * 64 + i] * w2[i * 64 + j]; B[tt * 64 + j] = sin_acc(fq * acc); }
    __syncthreads();
    { float acc = b2[64 + j]; for (int i = 0; i < 64; ++i) acc += B[tt * 64 + i] * w2[4096 + i * 64 + j]; A[tt * 64 + j] = sin_acc(fq * acc); }
    __syncthreads();
    { float acc0[8], acc1[8];
#pragma unroll
      for (int q = 0; q < 8; ++q) { acc0[q] = 0.f; acc1[q] = 0.f; }
#pragma unroll 8
      for (int i = 0; i < 64; ++i) { const float wa = wo[i * 1024 + tid], wb = wo[i * 1024 + 512 + tid];
#pragma unroll
          for (int q = 0; q < 8; ++q) { const float av = A[q * 64 + i]; acc0[q] += av * wa; acc1[q] += av * wb; } }
      const float ad = 3.070113457325394f + (float)tid * ((15.350567286626973f - 3.070113457325394f) / 511.0f);
#pragma unroll
      for (int q = 0; q < 8; ++q) { const float tq = (float)(t0 + q) / (float)(L - 1); const float win = __expf(-tq * ad);
          hf[(size_t)(t0 + q) * 1024 + tid] = acc0[q] * win; hf[(size_t)(t0 + q) * 1024 + 512 + tid] = acc1[q] * win; } }
    __syncthreads();
}
__device__ __forceinline__ void step_pro_a(const AV& a, LAS unsigned char* lds) {
    const int tid = ltid(), lane = tid & 63, wave = tid >> 6, G = gridDim.x;
    unsigned char* ws = AWS;
    { f32x2* tw = (f32x2*)(ws + WS_TW); for (int m = lbid() * NT + tid; m < 16384; m += G * NT) { float s, c; sincos_rev((double)m / 16384.0, s, c); tw[m] = (f32x2){c, -s}; } }
    { f32x2* rt = (f32x2*)(ws + WS_ROPE);
      for (int e = lbid() * NT + tid; e < 8192 * 32; e += G * NT) { const int pos = e >> 5, i = e & 31; const int pp = (i < 16) ? (pos >> 6) : (pos & 63);
          const double inv = ROPE_IF[i & 15]; float sn, cs; sincos_rev((double)pp * inv * 0.15915494309189533577, sn, cs); rt[e] = (f32x2){cs, sn}; } }
    { const float* g = AIN(I_NORMG); bf16* HN0 = (bf16*)(ws + WS_HN0); f32x4 gv[4];
#pragma unroll
      for (int j = 0; j < 4; ++j) gv[j] = *((const f32x4*)g + lane + 64 * j);
      for (int m = lbid() * NWAVES + wave; m < NTOK; m += G * NWAVES) {
          const f32x4* xr = (const f32x4*)(xin_rows(a, m)) + lane; f32x4 v[4]; float ssum = 0.f;
#pragma unroll
          for (int j = 0; j < 4; ++j) { v[j] = xr[64 * j]; ssum += (v[j].x * v[j].x + v[j].y * v[j].y) + (v[j].z * v[j].z + v[j].w * v[j].w); }
          const float rs = 1.0f / sqrtf(wave_sum(ssum) * (1.0f / DM) + EPS);
          u32x2* o8 = (u32x2*)(HN0 + (size_t)m * DM) + lane;
#pragma unroll
          for (int j = 0; j < 4; ++j) { u32x2 w; w.x = pk2(v[j].x * rs * gv[j].x, v[j].y * rs * gv[j].y); w.y = pk2(v[j].z * rs * gv[j].z, v[j].w * rs * gv[j].w); o8[64 * j] = w; } } }
    { LAS float* scr = (LAS float*)(lds + wave * 16384);
      constexpr int I_IN = 16 * (UP / 32), I_MG = 16 * (GP / 32), I_BR = 8 * 32, I_OU = 16 * 32, PER = I_IN + I_MG + 3 * I_BR + I_OU;
      for (int it = lbid() * NWAVES + wave; it < 2 * PER; it += G * NWAVES) {
          const int l = it / PER; int r = it - l * PER;
          bf16* wcat = (bf16*)(ws + WS_WCAT + l * WCAT_BYTES); bf16* wbt = (bf16*)(ws + WS_WBT + l * WBT_BYTES); bf16* wot = (bf16*)(ws + WS_WOT + l * WOT_BYTES);
          if (r < I_IN) { transpose_item(AIN(I_WIN) + (size_t)l * 1024 * UP, 1024, UP, wcat, 0, scr, r, lane); continue; } r -= I_IN;
          if (r < I_MG) { transpose_item(AIN(I_WMERGE) + (size_t)l * 1024 * GP, 1024, GP, wcat, UP, scr, r, lane); continue; } r -= I_MG;
          if (r < I_BR) { transpose_item(AIN(I_WBHY) + (size_t)l * 512 * 1024, 512, 1024, wbt, 0, scr, r, lane); continue; } r -= I_BR;
          if (r < I_BR) { transpose_item(AIN(I_WBGQ) + (size_t)l * 512 * 1024, 512, 1024, wbt, 1024, scr, r, lane); continue; } r -= I_BR;
          if (r < I_BR) { transpose_item(AIN(I_WBDF) + (size_t)l * 512 * 1024, 512, 1024, wbt, 2048, scr, r, lane); continue; } r -= I_BR;
          transpose_item(AIN(I_WOUT) + (size_t)l * 1024 * 1024, 1024, 1024, wot, 0, scr, r, lane);
      } }
}
__device__ __forceinline__ void step_pro_a2(const AV& a, LAS unsigned char* lds) {
    const int tid = ltid(), G = gridDim.x; unsigned char* ws = AWS;
    { constexpr int GPL = LP / 8 + LS / 8;
      for (int g = lbid(); g < 2 * GPL; g += G) { const int l = g / GPL; int r = g - l * GPL;
          float* hfp = (float*)(ws + WS_HF + l * (HF_P_BYTES + HF_S_BYTES));
          if (r < LP / 8) hf_group((LAS float*)lds, a, l, LP, r * 8, hfp, tid);
          else hf_group((LAS float*)lds, a, l, LS, (r - LP / 8) * 8, (float*)((unsigned char*)hfp + HF_P_BYTES), tid); } }
}
template <int LOG4> __device__ __forceinline__ void filt_unit(const AV& a, LAS unsigned char* lds, int layer, int pr, const float* hf, f32x2* Pg, f32x2* Mg) {
    constexpr int N = 1 << (2 * LOG4), L = N / 2;
    const int tid = ltid(); LAS f32x2* buf = (LAS f32x2*)lds; const int c0 = 2 * pr;
    for (int n = tid; n < N; n += NT) { f32x2 v = (f32x2){0.f, 0.f};
        if (n < L) v = *(const f32x2*)(hf + (size_t)n * 1024 + c0); else if (n > L) v = *(const f32x2*)(hf + (size_t)(N - n) * 1024 + 512 + c0);
        buf[PADI(n)] = v; }
    __syncthreads();
    fft_fwd<LOG4>(buf, (const f32x2*)(AWS + WS_TW), tid);
    const float ba = AIN(I_HYBIAS)[layer * 512 + c0], bb = AIN(I_HYBIAS)[layer * 512 + c0 + 1]; const float sc = 1.0f / (float)N;
    for (int k = tid; k <= L; k += NT) { const int q1 = digitrev<LOG4>(k), q2 = digitrev<LOG4>((N - k) & (N - 1)); const f32x2 z1 = buf[PADI(q1)], z2 = buf[PADI(q2)];
        f32x2 ca = (f32x2){0.5f * (z1.x + z2.x), 0.5f * (z1.y - z2.y)}; const float dx = z1.x - z2.x, dy = z1.y + z2.y; f32x2 cb = (f32x2){0.5f * dy, -0.5f * dx};
        ca.x += ba; cb.x += bb;
        const int slot = (k == L) ? L : digitrev<LOG4 - 2>(k & (N / 16 - 1)) * 8 + (k >> (2 * LOG4 - 4));
        Pg[slot] = (f32x2){0.5f * sc * (ca.x + cb.x), 0.5f * sc * (ca.y + cb.y)}; Mg[slot] = (f32x2){0.5f * sc * (ca.x - cb.x), 0.5f * sc * (ca.y - cb.y)}; }
    __syncthreads();
}
__device__ __forceinline__ void step_pro_b(const AV& a, LAS unsigned char* lds) {
    for (int u = lbid(); u < 1024; u += gridDim.x) { const int l = u >> 9, r = u & 511; unsigned char* sp = AWS + WS_SPEC + l * SPEC_LAYER; const float* hfp = (const float*)(AWS + WS_HF + l * (HF_P_BYTES + HF_S_BYTES));
        if (r < 256) filt_unit<7>(a, lds, l, r, hfp, (f32x2*)sp + (size_t)r * SPS_P, (f32x2*)(sp + SPEC_P_BYTES) + (size_t)r * SPS_P);
        else { const int pr = r - 256; filt_unit<6>(a, lds, l, pr, (const float*)((const unsigned char*)hfp + HF_P_BYTES), (f32x2*)(sp + 2 * SPEC_P_BYTES) + (size_t)pr * SPS_S, (f32x2*)(sp + 2 * SPEC_P_BYTES + SPEC_S_BYTES) + (size_t)pr * SPS_S); } }
}
__device__ __forceinline__ void step_norm(const AV& a, int c, int layer) {
    const int tid = ltid(), lane = tid & 63, wave = tid >> 6; const Chunk ck = chunk_of(c);
    const float* X = layer == 0 ? xin_rows(a, ck.tok0) : AOUT + (size_t)ck.tok0 * DM; bf16* HN = (bf16*)(AWS + WS_HN); const float* g = AIN(I_NORMG) + layer * DM;
    f32x4 gv[4];
#pragma unroll
    for (int j = 0; j < 4; ++j) gv[j] = *((const f32x4*)g + lane + 64 * j);
    for (int m = lbid() * NWAVES + wave; m < CH; m += gridDim.x * NWAVES) {
        const f32x4* xr = (const f32x4*)(X + (size_t)m * DM) + lane; f32x4 v[4]; float s = 0.f;
#pragma unroll
        for (int j = 0; j < 4; ++j) { v[j] = xr[64 * j]; s += (v[j].x * v[j].x + v[j].y * v[j].y) + (v[j].z * v[j].z + v[j].w * v[j].w); }
        const float rs = 1.0f / sqrtf(wave_sum(s) * (1.0f / DM) + EPS);
        u32x2* o8 = (u32x2*)(HN + (size_t)m * DM) + lane;
#pragma unroll
        for (int j = 0; j < 4; ++j) { u32x2 w; w.x = pk2(v[j].x * rs * gv[j].x, v[j].y * rs * gv[j].y); w.y = pk2(v[j].z * rs * gv[j].z, v[j].w * rs * gv[j].w); o8[64 * j] = w; }
    }
}
__device__ __forceinline__ void step_final(const AV& a, int row0, int row1) {
    const int tid = ltid(), lane = tid & 63, wave = tid >> 6; const float* g = AIN(I_FINALG);
    f32x4 gv[4];
#pragma unroll
    for (int j = 0; j < 4; ++j) gv[j] = *((const f32x4*)g + lane + 64 * j);
    for (int m = row0 + lbid() * NWAVES + wave; m < row1; m += gridDim.x * NWAVES) {
        f32x4* xr = (f32x4*)(AOUT + (size_t)m * DM) + lane; f32x4 v[4]; float s = 0.f;
#pragma unroll
        for (int j = 0; j < 4; ++j) { v[j] = xr[64 * j]; s += (v[j].x * v[j].x + v[j].y * v[j].y) + (v[j].z * v[j].z + v[j].w * v[j].w); }
        const float rs = 1.0f / sqrtf(wave_sum(s) * (1.0f / DM) + EPS);
#pragma unroll
        for (int j = 0; j < 4; ++j) xr[64 * j] = v[j] * rs * gv[j];
    }
}
__device__ __forceinline__ void step_prep(const AV& a, int c, int layer) {
    const Chunk ck = chunk_of(c); bf16* U = (bf16*)(AWS + WS_U);
    for (int it = lbid() * NT + ltid(); it < CH * 10; it += gridDim.x * NT) {
        const int tok = it / 10, hd = it - tok * 10; const int pos = tok & (ck.L - 1);
        bf16* p = U + (size_t)tok * UP + (hd < 8 ? C_GQ + 64 * hd : C_GK + 64 * (hd - 8));
        const float* g = (hd < 8 ? AIN(I_QNG) : AIN(I_KNG)) + layer * 64;
        float x[64];
#pragma unroll
        for (int i = 0; i < 8; ++i) { const u32x4 w = *((const u32x4*)p + i);
            x[8 * i + 0] = bflo(w.x); x[8 * i + 1] = bfhi(w.x); x[8 * i + 2] = bflo(w.y); x[8 * i + 3] = bfhi(w.y); x[8 * i + 4] = bflo(w.z); x[8 * i + 5] = bfhi(w.z); x[8 * i + 6] = bflo(w.w); x[8 * i + 7] = bfhi(w.w); }
        float ss = 0.f;
#pragma unroll
        for (int i = 0; i < 64; ++i) ss += x[i] * x[i];
        const float rs = (1.0f / sqrtf(ss * (1.0f / 64.0f) + EPS)) * (hd < 8 ? 0.125f * LOG2E : 1.0f);
#pragma unroll
        for (int i = 0; i < 64; ++i) x[i] = x[i] * rs * g[i];
        const f32x4* rt = (const f32x4*)(AWS + WS_ROPE) + (size_t)pos * 16;
#pragma unroll
        for (int i2 = 0; i2 < 16; ++i2) { const f32x4 cs2 = rt[i2];
#pragma unroll
            for (int e = 0; e < 2; ++e) { const int i = 2 * i2 + e; const float cs = e ? cs2.z : cs2.x, sn = e ? cs2.w : cs2.y; const float x1 = x[i], x2 = x[i + 32]; x[i] = x1 * cs - x2 * sn; x[i + 32] = x2 * cs + x1 * sn; } }
#pragma unroll
        for (int i = 0; i < 8; ++i) { u32x4 w; w.x = pk2(x[8 * i], x[8 * i + 1]); w.y = pk2(x[8 * i + 2], x[8 * i + 3]); w.z = pk2(x[8 * i + 4], x[8 * i + 5]); w.w = pk2(x[8 * i + 6], x[8 * i + 7]); *((u32x4*)p + i) = w; }
    }
}
__device__ __forceinline__ void step_prep_hy(const AV& a, LAS unsigned char* lds, int c, int layer) {
    const Chunk ck = chunk_of(c); const bf16* U = (const bf16*)(AWS + WS_U);
    f32x2* HVP = (f32x2*)(AWS + WS_HVP); f32x2* PMP = (f32x2*)(AWS + WS_PMP);
    const int tid = ltid(), lane = tid & 63, wave = tid >> 6;
    LAS f32x2* th = (LAS f32x2*)(lds + wave * 17408); LAS f32x2* tp = th + 64 * 17;
    const float* cw = AIN(I_CONVW) + layer * 3 * 1536; const float* cb = AIN(I_CONVB) + layer * 1536;
    for (int it = lbid() * NWAVES + wave; it < (CH / 16) * 4; it += gridDim.x * NWAVES) {
        const int cbk = it & 3, tg = it >> 2, t0 = tg * 16, ch = cbk * 128 + 2 * lane;
        const int pos0 = t0 & (ck.L - 1);
        float w[3][3][2], bb[3][2];
#pragma unroll
        for (int ar = 0; ar < 3; ++ar) {
#pragma unroll
            for (int j = 0; j < 3; ++j) { const f32x2 v = *(const f32x2*)(cw + j * 1536 + ar * 512 + ch); w[ar][j][0] = v.x; w[ar][j][1] = v.y; }
            const f32x2 v = *(const f32x2*)(cb + ar * 512 + ch); bb[ar][0] = v.x; bb[ar][1] = v.y; }
        const bf16* r0 = U + (size_t)t0 * UP + ch;
        unsigned pv[3], cv[3], nv[3];
#pragma unroll
        for (int ar = 0; ar < 3; ++ar) { pv[ar] = pos0 > 0 ? *(const unsigned*)(r0 - UP + ar * 512) : 0u; cv[ar] = *(const unsigned*)(r0 + ar * 512); }
#pragma unroll 4
        for (int t = 0; t < 16; ++t) {
            const bf16* rt = r0 + (size_t)t * UP; const bool last = (pos0 + t + 1 >= ck.L);
#pragma unroll
            for (int ar = 0; ar < 3; ++ar) nv[ar] = last ? 0u : *(const unsigned*)(rt + UP + ar * 512);
            const unsigned gw = *(const unsigned*)(rt + C_HG);
            float o[3][2];
#pragma unroll
            for (int ar = 0; ar < 3; ++ar) { o[ar][0] = w[ar][0][0] * bflo(pv[ar]) + w[ar][1][0] * bflo(cv[ar]) + w[ar][2][0] * bflo(nv[ar]) + bb[ar][0];
                o[ar][1] = w[ar][0][1] * bfhi(pv[ar]) + w[ar][1][1] * bfhi(cv[ar]) + w[ar][2][1] * bfhi(nv[ar]) + bb[ar][1]; pv[ar] = cv[ar]; cv[ar] = nv[ar]; }
            th[lane * 17 + t] = (f32x2){o[2][0] * o[1][0], o[2][1] * o[1][1]};
            tp[lane * 17 + t] = (f32x2){o[0][0] * silu(bflo(gw)), o[0][1] * silu(bfhi(gw))};
        }
        asm volatile("s_waitcnt lgkmcnt(0)" ::: "memory");
#pragma unroll 4
        for (int i = 0; i < 16; ++i) { const int pl = 4 * i + (lane >> 4), tt = lane & 15; const size_t o = (size_t)(cbk * 64 + pl) * CH + t0 + tt;
            HVP[o] = th[pl * 17 + tt]; PMP[o] = tp[pl * 17 + tt]; }
        asm volatile("s_waitcnt lgkmcnt(0)" ::: "memory");
    }
}
typedef short bf16x8 __attribute__((ext_vector_type(8)));
typedef short s16x4 __attribute__((ext_vector_type(4)));
typedef float f32x16 __attribute__((ext_vector_type(16)));
typedef float f32x2_t __attribute__((ext_vector_type(2)));
typedef __bf16 bf16x2_t __attribute__((ext_vector_type(2)));
__device__ __forceinline__ unsigned cvtpk(float lo, float hi) { f32x2_t v = {lo, hi}; bf16x2_t b = __builtin_convertvector(v, bf16x2_t); return __builtin_bit_cast(unsigned, b); }
__device__ __forceinline__ int crow(int r, int hi) { return (r & 3) + 8 * (r >> 2) + 4 * hi; }
__device__ __forceinline__ s16x4 vtr(const LAS unsigned char* p) { return __builtin_bit_cast(s16x4, __builtin_amdgcn_ds_read_tr16_b64_v4i16((LAS s16x4*)p)); }
constexpr int ATT_K = 0;
constexpr int ATT_TB_DIFF = 4 * 8192 + 4 * 16384;
constexpr float C1 = 0.125f * LOG2E;
__device__ __forceinline__ void glds16(const void* gsrc, unsigned lds_dst) { unsigned keep;
    asm volatile("s_mov_b32 %0, m0\n\ts_mov_b32 m0, %2\n\ts_nop 0\n\tglobal_load_lds_dwordx4 %1, off\n\ts_mov_b32 m0, %0" : "=&s"(keep) : "v"(gsrc), "s"(lds_dst) : "memory"); }

template <int VD, bool BIAS, bool OMAX, int G>
__device__ __forceinline__ void flash_pass(LAS unsigned char* lds, const bf16* Qrow, const bf16* Kg, const bf16* Vg, int L, int qpos, int qw0, float bl, float br, f32x16 (&o)[VD / 32], float& l_out) {
    const int tid = ltid(), lane = tid & 63, r32 = lane & 31, hi = lane >> 5;
    constexpr int VROW = VD * 2, VT = 64 * VROW, NVL = VD / 64, NSL = 2 * G, ATT_V = NSL * 8192, ATT_TB = ATT_V + NSL * VT;
    const LAS float* tb = (const LAS float*)(lds + ATT_TB);
    typedef const __attribute__((address_space(1))) u32x4* g4p;
    const int wv = __builtin_amdgcn_readfirstlane(tid >> 6); const int ldsa = (int)(unsigned)(uintptr_t)lds;
    const bf16* ksrc; { const int X = wv * 1024 + lane * 16, line = X >> 8, c16 = ((X >> 4) & 15) ^ (line & 15), key = 2 * line + (c16 >> 3), ch = c16 & 7; ksrc = Kg + (size_t)key * UP + ch * 8; }
    const bf16* vsrc[NVL];
#pragma unroll
    for (int i = 0; i < NVL; ++i) { const int X = i * 8192 + wv * 1024 + lane * 16; const int key = (VD == 64) ? (X >> 7) : (X >> 8), posb = (VD == 64) ? (X & 127) : (X & 255);
        const int swz = (VD == 64) ? (((key >> 1) & 1) << 6) : ((key & 3) << 6); vsrc[i] = Vg + (size_t)key * UP + ((posb ^ swz) >> 1); }
#define ATT_DMA(tt_, sl_) do { const size_t go_ = (size_t)(tt_) * 64 * UP; \
        glds16(ksrc + go_, (unsigned)__builtin_amdgcn_readfirstlane(ldsa + ATT_K + (sl_) * 8192 + wv * 1024)); \
        _Pragma("unroll") for (int i_ = 0; i_ < NVL; ++i_) glds16(vsrc[i_] + go_, (unsigned)__builtin_amdgcn_readfirstlane(ldsa + ATT_V + (sl_) * VT + i_ * 8192 + wv * 1024)); } while (0)
#define ATT_DMAGROUP(g_) do { _Pragma("unroll") for (int j_ = 0; j_ < G; ++j_) { const int tt_ = (g_) * G + j_; ATT_DMA(tt_, tt_ & (NSL - 1)); } } while (0)
#define ATT_BAR() do { __builtin_amdgcn_s_barrier(); asm volatile("" ::: "memory"); } while (0)
    int koff[2][4];
#pragma unroll
    for (int kb = 0; kb < 2; ++kb)
#pragma unroll
        for (int s = 0; s < 4; ++s) { const int key = 32 * kb + r32, line = key >> 1, c16 = ((key & 1) << 3) | (2 * s + hi); koff[kb][s] = line * 256 + ((c16 ^ (line & 15)) << 4); }
    const int q4 = (lane & 15) >> 2, p4 = lane & 3, g1 = (lane >> 4) & 1;
    const int vsw = (VD == 64) ? ((q4 >> 1) & 1) : q4;
    const int vbase = (4 * hi + q4) * VROW + 32 * g1 + 8 * p4;
    bf16x8 qf[4];
#pragma unroll
    for (int s = 0; s < 4; ++s) qf[s] = __builtin_bit_cast(bf16x8, *(g4p)(Qrow + 16 * s + 8 * hi));
    float m_run = OMAX ? -1e30f : 0.f, l_run = 0.f;
    const int nt = L >> 6;
    asm volatile("" :: "v"(qf[0]), "v"(qf[1]), "v"(qf[2]), "v"(qf[3]) : "memory");
    asm volatile("s_waitcnt vmcnt(0)" ::: "memory");
    const int ng = nt / G;
    ATT_DMAGROUP(0); if (ng > 1) ATT_DMAGROUP(1);
    if (ng > 1) { if (G * (1 + NVL) == 8) asm volatile("s_waitcnt vmcnt(8)" ::: "memory"); else asm volatile("s_waitcnt vmcnt(6)" ::: "memory"); } else asm volatile("s_waitcnt vmcnt(0)" ::: "memory");
    static_assert(G * (1 + NVL) == 8 || G * (1 + NVL) == 6, "vmcnt immediates above");
    ATT_BAR();
#pragma unroll 1
    for (int t = 0; t < nt; ++t) {
        const int cur = t & (NSL - 1);
        const LAS unsigned char* kbuf = lds + ATT_K + cur * 8192; const LAS unsigned char* vbuf = lds + ATT_V + cur * VT;
        f32x16 p[2];
        { bf16x8 kf[2][4];
#pragma unroll
          for (int kb = 0; kb < 2; ++kb)
#pragma unroll
            for (int s = 0; s < 4; ++s) kf[kb][s] = *(const LAS bf16x8*)(kbuf + koff[kb][s]);
          __builtin_amdgcn_sched_barrier(0);
#pragma unroll
          for (int kb = 0; kb < 2; ++kb) { f32x16 acc;
#pragma unroll
            for (int r = 0; r < 16; ++r) acc[r] = 0.f;
#pragma unroll
            for (int s = 0; s < 4; ++s) acc = __builtin_amdgcn_mfma_f32_32x32x16_bf16(kf[kb][s], qf[s], acc, 0, 0, 0);
            p[kb] = acc; } }
        s16x4 vlo[2][4], vhi[2][4];
#define VREAD(buf_, db_) do { const int cofs_ = (((db_) ^ vsw) << 6); _Pragma("unroll") for (int kb = 0; kb < 2; ++kb) _Pragma("unroll") for (int ss = 0; ss < 2; ++ss) { \
            const LAS unsigned char* vp_ = vbuf + vbase + (32 * kb + 16 * ss) * VROW + cofs_; vlo[buf_][2 * kb + ss] = vtr(vp_); vhi[buf_][2 * kb + ss] = vtr(vp_ + 8 * VROW); } } while (0)
        VREAD(0, 0);
        __builtin_amdgcn_sched_barrier(0);
        const int k0 = t * 64; float mulc, bconst, mx = -3e38f; bool nearT = false;
        const bool domax = (t & 7) == 0;
        if (BIAS) { const int rlo = k0 - qw0 - 31, rhi = k0 + 63 - qw0; nearT = !(rhi <= -128 || rlo >= 128); }
        if (BIAS && nearT) {
#pragma unroll
            for (int kb = 0; kb < 2; ++kb)
#pragma unroll
                for (int r4 = 0; r4 < 4; ++r4) {
#pragma unroll
                    for (int e = 0; e < 4; ++e) { const int r = 4 * r4 + e; int rel = k0 + 32 * kb + crow(r, hi) - qpos; rel = rel < -128 ? -128 : (rel > 128 ? 128 : rel); const float v = p[kb][r] * C1 + tb[rel + 128]; p[kb][r] = v; mx = fmaxf(mx, v); }
                    __builtin_amdgcn_sched_barrier(0); }
            mulc = 1.0f; bconst = 0.f;
        } else {
            if (OMAX && domax) {
#pragma unroll
                for (int kb = 0; kb < 2; ++kb)
#pragma unroll
                    for (int r = 0; r < 16; ++r) mx = fmaxf(mx, p[kb][r]); }
            bconst = BIAS ? (k0 < qw0 ? bl : br) : 0.f; mx = mx * C1 + bconst; mulc = C1;
        }
        if (OMAX && (domax || (BIAS && nearT))) {
            mx = fmaxf(mx, shx(mx, 32));
            if (__any(mx > m_run)) { const float mn = fmaxf(m_run, mx), al = __builtin_amdgcn_exp2f(m_run - mn); l_run *= al;
#pragma unroll
                for (int db = 0; db < VD / 32; ++db) o[db] *= al;
                m_run = mn; }
        }
        const f32x2 mul2 = (f32x2){mulc, mulc}, add2 = (f32x2){bconst - m_run, bconst - m_run}; f32x2 ls2 = (f32x2){0.f, 0.f};
#pragma unroll
        for (int kb = 0; kb < 2; ++kb)
#pragma unroll
            for (int r = 0; r < 16; r += 2) { f32x2 v = (f32x2){p[kb][r], p[kb][r + 1]}; v = v * mul2 + add2; f32x2 e; e.x = __builtin_amdgcn_exp2f(v.x); e.y = __builtin_amdgcn_exp2f(v.y); ls2 += e; p[kb][r] = e.x; p[kb][r + 1] = e.y; }
        l_run += ls2.x + ls2.y;
        bf16x8 pk[2][2];
#pragma unroll
        for (int kb = 0; kb < 2; ++kb)
#pragma unroll
            for (int ss = 0; ss < 2; ++ss) { u32x4 w; w.x = cvtpk(p[kb][8 * ss + 0], p[kb][8 * ss + 1]); w.y = cvtpk(p[kb][8 * ss + 2], p[kb][8 * ss + 3]); w.z = cvtpk(p[kb][8 * ss + 4], p[kb][8 * ss + 5]); w.w = cvtpk(p[kb][8 * ss + 6], p[kb][8 * ss + 7]);
                pk[kb][ss] = __builtin_bit_cast(bf16x8, w); }
        __builtin_amdgcn_sched_barrier(0);
#pragma unroll
        for (int db = 0; db < VD / 32; ++db) {
            if (db + 1 < VD / 32) { if ((db + 1) & 1) VREAD(1, db + 1); else VREAD(0, db + 1); }
#pragma unroll
            for (int kb = 0; kb < 2; ++kb)
#pragma unroll
                for (int ss = 0; ss < 2; ++ss) { const bf16x8 vf = (db & 1) ? __builtin_shufflevector(vlo[1][2 * kb + ss], vhi[1][2 * kb + ss], 0, 1, 2, 3, 4, 5, 6, 7) : __builtin_shufflevector(vlo[0][2 * kb + ss], vhi[0][2 * kb + ss], 0, 1, 2, 3, 4, 5, 6, 7);
                    o[db] = __builtin_amdgcn_mfma_f32_32x32x16_bf16(vf, pk[kb][ss], o[db], 0, 0, 0); }
            __builtin_amdgcn_sched_barrier(0); }
#undef VREAD
        if (((t + 1) & (G - 1)) == 0) {
            asm volatile("s_waitcnt vmcnt(0)" ::: "memory"); ATT_BAR();
            const int g2 = (t + 1) / G + 1; if (g2 < ng) ATT_DMAGROUP(g2); }
    }
#undef ATT_DMA
#undef ATT_DMAGROUP
#undef ATT_BAR
    l_out = l_run + shx(l_run, 32);
}
__device__ __forceinline__ void gqa_unit(const AV& a, LAS unsigned char* lds, int seqrow0, int L, int h, int qb) {
    const int tid = ltid(), lane = tid & 63, r32 = lane & 31, hi = lane >> 5;
    const bf16* U = (const bf16*)(AWS + WS_U); bf16* Y = (bf16*)(AWS + WS_Y) + (size_t)1 * CH * 512;
    constexpr int G = 4, NSL = 2 * G, VROW = 128, VT = 8192, ATT_V = NSL * 8192;
    typedef const __attribute__((address_space(1))) u32x4* g4p;
    const int wv = __builtin_amdgcn_readfirstlane(tid >> 6); const int ldsa = (int)(unsigned)(uintptr_t)lds;
    const int qw0 = qb * 512 + wv * 64;
    const bf16* Kg = U + (size_t)seqrow0 * UP + C_GK + 64 * (h >> 2); const bf16* Vg = U + (size_t)seqrow0 * UP + C_GV + 64 * (h >> 2);
    const bf16* ksrc; { const int X = wv * 1024 + lane * 16, line = X >> 8, c16 = ((X >> 4) & 15) ^ (line & 15), key = 2 * line + (c16 >> 3), ch = c16 & 7; ksrc = Kg + (size_t)key * UP + ch * 8; }
    const bf16* vsrc; { const int X = wv * 1024 + lane * 16, key = X >> 7, posb = X & 127, swz = ((key >> 1) & 1) << 6; vsrc = Vg + (size_t)key * UP + ((posb ^ swz) >> 1); }
#define GQ_DMA(tt_, sl_) do { const size_t go_ = (size_t)(tt_) * 64 * UP; \
        glds16(ksrc + go_, (unsigned)__builtin_amdgcn_readfirstlane(ldsa + ATT_K + (sl_) * 8192 + wv * 1024)); \
        glds16(vsrc + go_, (unsigned)__builtin_amdgcn_readfirstlane(ldsa + ATT_V + (sl_) * VT + wv * 1024)); } while (0)
#define GQ_DMAGROUP(g_) do { _Pragma("unroll") for (int j_ = 0; j_ < G; ++j_) { const int tt_ = (g_) * G + j_; GQ_DMA(tt_, tt_ & (NSL - 1)); } } while (0)
#define GQ_BAR() do { __builtin_amdgcn_s_barrier(); asm volatile("" ::: "memory"); } while (0)
    int koff[2][4];
#pragma unroll
    for (int kb = 0; kb < 2; ++kb)
#pragma unroll
        for (int s = 0; s < 4; ++s) { const int key = 32 * kb + r32, line = key >> 1, c16 = ((key & 1) << 3) | (2 * s + hi); koff[kb][s] = line * 256 + ((c16 ^ (line & 15)) << 4); }
    const int q4 = (lane & 15) >> 2, p4 = lane & 3, g1 = (lane >> 4) & 1;
    const int vsw = (q4 >> 1) & 1;
    const int vbase = (4 * hi + q4) * VROW + 32 * g1 + 8 * p4;
    bf16x8 qf[2][4];
#pragma unroll
    for (int j = 0; j < 2; ++j)
#pragma unroll
        for (int s = 0; s < 4; ++s) qf[j][s] = __builtin_bit_cast(bf16x8, *(g4p)(U + (size_t)(seqrow0 + qw0 + 32 * j + r32) * UP + C_GQ + 64 * h + 16 * s + 8 * hi));
    f32x16 o[2][2];
#pragma unroll
    for (int j = 0; j < 2; ++j)
#pragma unroll
        for (int db = 0; db < 2; ++db)
#pragma unroll
            for (int r = 0; r < 16; ++r) o[j][db][r] = 0.f;
    float lrun[2] = {0.f, 0.f};
    const int nt = L >> 6, ng = nt / G;
    asm volatile("" :: "v"(qf[0][0]), "v"(qf[0][1]), "v"(qf[0][2]), "v"(qf[0][3]), "v"(qf[1][0]), "v"(qf[1][1]), "v"(qf[1][2]), "v"(qf[1][3]) : "memory");
    asm volatile("s_waitcnt vmcnt(0)" ::: "memory");
    GQ_DMAGROUP(0); if (ng > 1) GQ_DMAGROUP(1);
    if (ng > 1) asm volatile("s_waitcnt vmcnt(8)" ::: "memory"); else asm volatile("s_waitcnt vmcnt(0)" ::: "memory");
    GQ_BAR();
#pragma unroll 1
    for (int t = 0; t < nt; ++t) {
        const int cur = t & (NSL - 1);
        const LAS unsigned char* kbuf = lds + ATT_K + cur * 8192; const LAS unsigned char* vbuf = lds + ATT_V + cur * VT;
        f32x16 p[2][2];
        { bf16x8 kf[2][4];
#pragma unroll
          for (int kb = 0; kb < 2; ++kb)
#pragma unroll
            for (int s = 0; s < 4; ++s) kf[kb][s] = *(const LAS bf16x8*)(kbuf + koff[kb][s]);
          __builtin_amdgcn_sched_barrier(0);
#pragma unroll
          for (int kb = 0; kb < 2; ++kb)
#pragma unroll
            for (int j = 0; j < 2; ++j) { f32x16 acc;
#pragma unroll
              for (int r = 0; r < 16; ++r) acc[r] = 0.f;
#pragma unroll
              for (int s = 0; s < 4; ++s) acc = __builtin_amdgcn_mfma_f32_32x32x16_bf16(kf[kb][s], qf[j][s], acc, 0, 0, 0);
              p[j][kb] = acc; } }
        s16x4 vlo[2][4], vhi[2][4];
#define GQ_VREAD(buf_, db_) do { const int cofs_ = (((db_) ^ vsw) << 6); _Pragma("unroll") for (int kb = 0; kb < 2; ++kb) _Pragma("unroll") for (int ss = 0; ss < 2; ++ss) { \
            const LAS unsigned char* vp_ = vbuf + vbase + (32 * kb + 16 * ss) * VROW + cofs_; vlo[buf_][2 * kb + ss] = vtr(vp_); vhi[buf_][2 * kb + ss] = vtr(vp_ + 8 * VROW); } } while (0)
        bf16x8 pk[2][2][2];
#pragma unroll
        for (int j = 0; j < 2; ++j) { float ls0 = 0.f, ls1 = 0.f;
#pragma unroll
            for (int kb = 0; kb < 2; ++kb) {
#pragma unroll
                for (int r = 0; r < 16; r += 2) { const float e0 = __builtin_amdgcn_exp2f(p[j][kb][r]), e1 = __builtin_amdgcn_exp2f(p[j][kb][r + 1]); ls0 += e0; ls1 += e1; p[j][kb][r] = e0; p[j][kb][r + 1] = e1; }
#pragma unroll
                for (int ss = 0; ss < 2; ++ss) { u32x4 w; w.x = cvtpk(p[j][kb][8 * ss + 0], p[j][kb][8 * ss + 1]); w.y = cvtpk(p[j][kb][8 * ss + 2], p[j][kb][8 * ss + 3]); w.z = cvtpk(p[j][kb][8 * ss + 4], p[j][kb][8 * ss + 5]); w.w = cvtpk(p[j][kb][8 * ss + 6], p[j][kb][8 * ss + 7]);
                    pk[j][kb][ss] = __builtin_bit_cast(bf16x8, w); } }
            lrun[j] += ls0 + ls1; }
        __builtin_amdgcn_sched_barrier(0);
        GQ_VREAD(0, 0); GQ_VREAD(1, 1);
#pragma unroll
        for (int db = 0; db < 2; ++db) {
#pragma unroll
            for (int kb = 0; kb < 2; ++kb)
#pragma unroll
                for (int ss = 0; ss < 2; ++ss) { const bf16x8 vf = db ? __builtin_shufflevector(vlo[1][2 * kb + ss], vhi[1][2 * kb + ss], 0, 1, 2, 3, 4, 5, 6, 7) : __builtin_shufflevector(vlo[0][2 * kb + ss], vhi[0][2 * kb + ss], 0, 1, 2, 3, 4, 5, 6, 7);
#pragma unroll
                    for (int j = 0; j < 2; ++j) o[j][db] = __builtin_amdgcn_mfma_f32_32x32x16_bf16(vf, pk[j][kb][ss], o[j][db], 0, 0, 0); }
            __builtin_amdgcn_sched_barrier(0); }
#undef GQ_VREAD
        if (((t + 1) & (G - 1)) == 0) { asm volatile("s_waitcnt vmcnt(0)" ::: "memory"); GQ_BAR(); const int g2 = (t + 1) / G + 1; if (g2 < ng) GQ_DMAGROUP(g2); }
    }
#undef GQ_DMA
#undef GQ_DMAGROUP
#undef GQ_BAR
#pragma unroll
    for (int j = 0; j < 2; ++j) { const int lane2 = ltid() & 63, r32b = lane2 & 31, hib = lane2 >> 5;
        const float l = lrun[j] + shx(lrun[j], 32); const float inv = 1.0f / l; const size_t row = (size_t)(seqrow0 + qw0 + 32 * j + r32b);
#pragma unroll
        for (int db = 0; db < 2; ++db)
#pragma unroll
            for (int g = 0; g < 4; ++g) { const int d = 32 * db + 8 * g + 4 * hib; const u32x2 gw = *(const u32x2*)(U + row * UP + C_GG + 64 * h + d);
                const float y0 = o[j][db][4 * g] * inv * silu(bflo(gw.x)), y1 = o[j][db][4 * g + 1] * inv * silu(bfhi(gw.x)), y2 = o[j][db][4 * g + 2] * inv * silu(bflo(gw.y)), y3 = o[j][db][4 * g + 3] * inv * silu(bfhi(gw.y));
                u32x2 w; w.x = cvtpk(y0, y1); w.y = cvtpk(y2, y3); *(u32x2*)(Y + row * 512 + 64 * h + d) = w; } }
}
__device__ __forceinline__ void diff_unit(const AV& a, LAS unsigned char* lds, int seqrow0, int L, int h, int qb, int layer) {
    const int tid = ltid(), lane = tid & 63, wave = tid >> 6, r32 = lane & 31, hi = lane >> 5;
    const bf16* U = (const bf16*)(AWS + WS_U); bf16* Y = (bf16*)(AWS + WS_Y) + (size_t)2 * CH * 512; float* DT = (float*)(AWS + WS_DT);
    const float* relb = AIN(I_RELB);
    LAS float* tb = (LAS float*)(lds + ATT_TB_DIFF);
    for (int i = tid; i < 257; i += NT) { const int rel = i - 128, n = rel < 0 ? -rel : rel; int b = rel > 0 ? 16 : 0;
        if (n < 8) b += n; else { const int v = 8 + (31 - __builtin_clz((unsigned)(n * n))) - 6; b += v < 15 ? v : 15; }
        tb[i] = relb[b * 4 + h] * LOG2E; }
    const float bl = relb[15 * 4 + h] * LOG2E, br = relb[31 * 4 + h] * LOG2E;
    float lyf = (float)layer; asm volatile("" : "+v"(lyf));
    const float li = 0.8f - 0.6f * __expf(-0.3f * lyf);
    float d1, d2; { const float q1 = AIN(I_LQ1)[layer * 64 + lane], k1 = AIN(I_LK1)[layer * 64 + lane], q2 = AIN(I_LQ2)[layer * 64 + lane], k2 = AIN(I_LK2)[layer * 64 + lane]; d1 = wave_sum(q1 * k1); d2 = wave_sum(q2 * k2); }
    const float lam = __expf(d1) - __expf(d2) + li;
    const int qw0 = qb * 256 + wave * 32, qpos = qw0 + r32; const size_t row = (size_t)(seqrow0 + qpos);
    __syncthreads();
    f32x16 o[4]; float l; float ss = 0.f;
#pragma unroll 1
    for (int c = 0; c < 2; ++c) {
#pragma unroll
        for (int db = 0; db < 4; ++db)
#pragma unroll
            for (int r = 0; r < 16; ++r) o[db][r] = 0.f;
        flash_pass<128, true, true, 2>(lds, U + row * UP + C_DQ + 128 * h + 64 * c, U + (size_t)seqrow0 * UP + C_DK + 128 * h + 64 * c, U + (size_t)seqrow0 * UP + C_DV + 128 * h, L, qpos, qw0, bl, br, o, l);
        if (c == 0) { const float inv = 1.0f / l;
#pragma unroll
            for (int db = 0; db < 4; ++db)
#pragma unroll
                for (int g = 0; g < 4; ++g) { const int d = 32 * db + 8 * g + 4 * hi; *(f32x4*)(DT + row * 512 + 128 * h + d) = (f32x4){o[db][4 * g] * inv, o[db][4 * g + 1] * inv, o[db][4 * g + 2] * inv, o[db][4 * g + 3] * inv}; }
        } else { const float inv = lam / l;
#pragma unroll
            for (int db = 0; db < 4; ++db)
#pragma unroll
                for (int g = 0; g < 4; ++g) { const int d = 32 * db + 8 * g + 4 * hi; const f32x4 o0 = *(const f32x4*)(DT + row * 512 + 128 * h + d);
#pragma unroll
                    for (int e = 0; e < 4; ++e) { const float v = o0[e] - o[db][4 * g + e] * inv; o[db][4 * g + e] = v; ss += v * v; } }
        }
    }
    ss += shx(ss, 32);
    const float rs = (1.0f / sqrtf(ss * (1.0f / 128.0f) + EPS)) * (1.0f - li);
    const float* sg = AIN(I_SUBLN) + layer * 128;
#pragma unroll
    for (int db = 0; db < 4; ++db)
#pragma unroll
        for (int g = 0; g < 4; ++g) { const int d = 32 * db + 8 * g + 4 * hi; const u32x2 gw = *(const u32x2*)(U + row * UP + C_DG + 128 * h + d); const f32x4 gn = *(const f32x4*)(sg + d);
            const float y0 = o[db][4 * g] * rs * gn.x * silu(bflo(gw.x)), y1 = o[db][4 * g + 1] * rs * gn.y * silu(bfhi(gw.x)), y2 = o[db][4 * g + 2] * rs * gn.z * silu(bflo(gw.y)), y3 = o[db][4 * g + 3] * rs * gn.w * silu(bfhi(gw.y));
            u32x2 w; w.x = cvtpk(y0, y1); w.y = cvtpk(y2, y3); *(u32x2*)(Y + row * 512 + 128 * h + d) = w; }
}
template <int LOG4, int BATCH> __device__ __forceinline__ void hyena_unit(const AV& a, LAS unsigned char* lds, int seqrow0, int pr0, int layer) {
    constexpr int N = 1 << (2 * LOG4), L = N / 2, NPAD = N + N / 16;
    const int tid = ltid(); LAS f32x2* buf = (LAS f32x2*)lds;
    bf16* Y = (bf16*)(AWS + WS_Y) + (size_t)seqrow0 * 512;
    const unsigned char* sp = AWS + WS_SPEC + layer * SPEC_LAYER;
    constexpr int SPS = (LOG4 == 7) ? SPS_P : SPS_S;
    const f32x2* Pg = ((LOG4 == 7) ? (const f32x2*)sp : (const f32x2*)(sp + 2 * SPEC_P_BYTES)) + (size_t)pr0 * SPS;
    const f32x2* Mg = ((LOG4 == 7) ? (const f32x2*)(sp + SPEC_P_BYTES) : (const f32x2*)(sp + 2 * SPEC_P_BYTES + SPEC_S_BYTES)) + (size_t)pr0 * SPS;
    const f32x2* hvp = (const f32x2*)(AWS + WS_HVP) + (size_t)pr0 * CH + seqrow0; const f32x2* pmp = (const f32x2*)(AWS + WS_PMP) + (size_t)pr0 * CH + seqrow0;
    const f32x2* tw = (const f32x2*)(AWS + WS_TW);
    if constexpr (BATCH == 1) { fft_first_from_global<LOG4>(buf, tw, hvp, tid); fft_fwd<LOG4, 1, 1, false>(buf, tw, tid); }
    else {
#pragma unroll
        for (int b = 0; b < BATCH; ++b)
            for (int t = tid; t < L; t += NT) { buf[b * NPAD + PADI(t)] = hvp[(size_t)b * CH + t]; buf[b * NPAD + PADI(t + L)] = (f32x2){0.f, 0.f}; }
        __syncthreads();
        fft_fwd<LOG4, BATCH, 0, false>(buf, tw, tid);
    }
    fft_tail_mul_tail<LOG4, BATCH>(buf, Pg, Mg, SPS, ltid());
    if constexpr (BATCH == 1) { fft_inv<LOG4, 1, 1, false>(buf, tw, ltid()); fft_last_to_global<LOG4>(buf, tw, pmp, Y + 2 * pr0, ltid()); }
    else { fft_inv<LOG4, BATCH, 0, false>(buf, tw, ltid());
    for (int t = tid; t < L; t += NT) { unsigned w[BATCH];
#pragma unroll
        for (int b = 0; b < BATCH; ++b) { const f32x2 y = buf[b * NPAD + PADI(t)], m = pmp[(size_t)b * CH + t]; w[b] = cvtpk(y.x * m.x, y.y * m.y); }
        if (BATCH == 4) *(u32x4*)(Y + (size_t)t * 512 + 2 * pr0) = (u32x4){w[0], w[BATCH > 1 ? 1 : 0], w[BATCH > 2 ? 2 : 0], w[BATCH > 3 ? 3 : 0]};
        else *(unsigned*)(Y + (size_t)t * 512 + 2 * pr0) = w[0]; } }
    __syncthreads();
}
#define XB_TMO      128
#define XB_XCNT(j)  (256  + 64 * (j))
#define XB_XSUB(j)  (1280 + 64 * (j))
#define XB_XGEN(j)  (2304 + 64 * (j))
#define XB_TOP      3328
#define XB_TOPGEN   3392
#define XCD_BAR_WORDS 3456
#define XB_SPIN_CAP (1u << 18)

__device__ __forceinline__ unsigned xb_ld(unsigned* p)              { return __hip_atomic_load(p, __ATOMIC_RELAXED, __HIP_MEMORY_SCOPE_AGENT); }
__device__ __forceinline__ unsigned xb_add(unsigned* p, unsigned v) { return __hip_atomic_fetch_add(p, v, __ATOMIC_RELAXED, __HIP_MEMORY_SCOPE_AGENT); }
__device__ __forceinline__ unsigned xb_xcc_id() { return (unsigned)__builtin_amdgcn_s_getreg((3 << 11) | 20) & 0xFu; }
#define XB_SPIN(cond, bar) do { unsigned _sp = 0; while (cond) { __builtin_amdgcn_s_sleep(1); \
    if ((++_sp & 255u) == 0u) { if (xb_ld(&(bar)[XB_TMO])) break; if (_sp > XB_SPIN_CAP) { atomicAdd(&(bar)[XB_TMO], 1u); break; } } } } while (0)

struct XcdBarrier {
    unsigned* bar; unsigned x;
    volatile LAS unsigned* st;
};

__device__ __forceinline__ XcdBarrier xcd_barrier_post(unsigned* bar, volatile LAS unsigned* st) {
    XcdBarrier b; b.bar = bar; b.x = xb_xcc_id(); b.st = st;
    if (threadIdx.x == 0) (void)xb_add(&bar[XB_XCNT(b.x)], 1u);
    return b;
}
__device__ __forceinline__ void xcd_barrier_complete(unsigned* bar, unsigned x, unsigned& nloc, unsigned& nx) {
    const unsigned G = gridDim.x * gridDim.y * gridDim.z;
    unsigned sum, cnt, mine, sp = 0u;
    for (;;) {
        sum = 0u; cnt = 0u; mine = 0u;
#pragma unroll
        for (unsigned j = 0; j < 16; ++j) { const unsigned c = xb_ld(&bar[XB_XCNT(j)]); sum += c; cnt += (c > 0u) ? 1u : 0u; mine = (j == x) ? c : mine; }
        if (sum == G) break;
        __builtin_amdgcn_s_sleep(1);
        if ((++sp & 255u) == 0u) { if (xb_ld(&bar[XB_TMO])) break; if (sp > XB_SPIN_CAP) { atomicAdd(&bar[XB_TMO], 1u); break; } }
    }
    nloc = mine > 0u ? mine : 1u; nx = cnt > 0u ? cnt : 1u;
}

__device__ __forceinline__ void xcd_barrier(const XcdBarrier& b) {
    asm volatile("s_waitcnt vmcnt(0)" ::: "memory");
    __syncthreads();
    if (threadIdx.x == 0) {
        unsigned* bar = b.bar;
        __builtin_amdgcn_s_waitcnt(0);
        unsigned nloc = b.st[0], nx = b.st[1];
        if (nloc == 0u) { xcd_barrier_complete(bar, b.x, nloc, nx); b.st[0] = nloc; b.st[1] = nx; }
        const unsigned old = xb_add(&bar[XB_XSUB(b.x)], 1u);
        const unsigned gen = old / nloc;
        if (old + 1u == (gen + 1u) * nloc) {
            __builtin_amdgcn_fence(__ATOMIC_RELEASE, "agent");
            asm volatile("s_waitcnt vmcnt(0)" ::: "memory");
            const unsigned og = xb_add(&bar[XB_TOP], 1u);
            const unsigned tg = og / nx;
            if (og + 1u == (tg + 1u) * nx) xb_add(&bar[XB_TOPGEN], 1u);
            else XB_SPIN(xb_ld(&bar[XB_TOPGEN]) == tg, bar);
            __builtin_amdgcn_fence(__ATOMIC_ACQUIRE, "agent");
            xb_add(&bar[XB_XGEN(b.x)], 1u);
            asm volatile("s_waitcnt vmcnt(0)" ::: "memory");
        } else {
            XB_SPIN(xb_ld(&bar[XB_XGEN(b.x)]) == gen, bar);
            __builtin_amdgcn_fence(__ATOMIC_ACQUIRE, "agent");
            asm volatile("s_waitcnt vmcnt(0)" ::: "memory");
        }
    }
    __syncthreads();
}

__device__ __forceinline__ void step_mix(const AV& a, LAS unsigned char* lds, int c, int layer, unsigned* ctr, int tmask) {
    const Chunk ck = chunk_of(c); const int nqb = ck.L / 256, nqg = ck.L / 512, nD = ck.nseq * 4 * nqb, nG = ck.nseq * 8 * nqg, nF = (ck.L == LP) ? ck.nseq * 256 : ck.nseq * 64, total = nD + nG + nF;
    volatile LAS unsigned* wq = (volatile LAS unsigned*)(lds + LDS_MAIN);
    for (;;) {
        if (ltid() == 0) wq[0] = atomicAdd(ctr, 1u);
        __syncthreads();
        const int u = (int)wq[0];
        __syncthreads();
        if (u >= total) break;
        if (u < nD) { if (tmask & 1) { const int qb = u % nqb, sh = u / nqb, h = sh & 3, s = sh >> 2; diff_unit(a, lds, s * ck.L, ck.L, h, qb, layer); } }
        else if (u < nD + nG) { if (tmask & 2) { const int v = u - nD, qb = v % nqg, sh = v / nqg, h = sh & 7, s = sh >> 3; gqa_unit(a, lds, s * ck.L, ck.L, h, qb); } }
        else { if (tmask & 4) { const int v = u - nD - nG; if (ck.L == LP) hyena_unit<7, 1>(a, lds, (v >> 8) * LP, v & 255, layer); else hyena_unit<6, 4>(a, lds, (v >> 6) * LS, (v & 63) * 4, layer); } }
    }
}
constexpr int STEPS_PER = 6, NPRO = 1, NSTEPS = NPRO + NCHUNK * 2 * STEPS_PER + 1;
__global__ void __launch_bounds__(NT, 2) mega_fwd(Args kargs) {
    extern __shared__ __attribute__((aligned(16))) unsigned char lds_raw[];
    LAS unsigned char* lds = (LAS unsigned char*)lds_raw;
    kargp_t kp = (kargp_t)__builtin_amdgcn_kernarg_segment_ptr();
    { volatile LAS unsigned* misc = (volatile LAS unsigned*)(lds + LDS_MAIN + 64); if (ltid() < 16) misc[ltid()] = 0u; }
    __syncthreads();
    XcdBarrier xbar = xcd_barrier_post((unsigned*)(kargs.ws + WS_CTL) + CW_BAR, (volatile LAS unsigned*)(lds + LDS_MAIN + 64 + 32));
    const int step_lo = kargs.lo, step_hi = kargs.hi;
#pragma unroll 1
    for (int step = step_lo; step < step_hi; ++step) {
        asm volatile("" : "+s"(kp));
        AV a; a.p = kp; unsigned char* ws = AWS;
        if (step == 0) { if (EN(0)) step_pro_a(a, lds); __syncthreads(); if (EN(11)) step_pro_a2(a, lds); }
        else if (step == NSTEPS - 1) { if (DUP_MASK & 256) { for (int q = 0; q < 100; ++q) xcd_barrier(xbar); } if (EN(2)) step_final(a, (NCHUNK - 1) * CH, NTOK); }
        else {
            const int s2 = step - NPRO, cl = s2 / STEPS_PER, k = s2 - cl * STEPS_PER, c = cl >> 1, layer = cl & 1;
            const Chunk ck = chunk_of(c);
            if (k == 0) { if (layer == 0) { if (c > 0 && EN(2)) step_final(a, (c - 1) * CH, c * CH); } continue;     }
            else if (k == 2) { if (c == 0 && layer == 0 && EN(1)) { step_pro_b(a, lds); __syncthreads(); }
                if (EN(5)) { step_prep(a, c, layer); step_prep_hy(a, lds, c, layer); if (layer == 0) { float* q = (float*)(ws + WS_SSQ); for (int i = lbid() * NT + ltid(); i < CH; i += (int)gridDim.x * NT) q[i] = 0.f; } } }
            else if (k == 3) {
#pragma unroll 1
                for (int rep = 0; rep < ((DUP_MASK & 7) ? 2 : 1); ++rep) { if (rep) xcd_barrier(xbar); step_mix(a, lds, c, layer, (unsigned*)(ws + WS_CTL) + step * 16 + 4 * rep, rep ? (DUP_MASK & 7) : 7); } }
            else { if (EN(4)) {
                pg8::Gemm g; pg8::OrderAll S; pg8::EpiAll E; const int G = (int)gridDim.x, bid = lbid();
                S.so.init(CH, k == 1 ? NCAT : 1024, G, bid); S.o2 = pg8::OrderG2{CH / 256, G, bid}; S.mode = (k == 4) ? 2 : 1;
                float* O = AOUT + (size_t)ck.tok0 * DM; const float* X = layer == 0 ? xin_rows(a, ck.tok0) : O;
                E.mode = (k == 1) ? 1 : (k == 4) ? 2 : 3;
                E.e1 = pg8::EpiG1{(pg8::bf16_t*)(ws + WS_U), (pg8::bf16_t*)(ws + WS_G), AIN(I_BMERGE) + layer * GP, layer == 1 ? (const float*)(ws + WS_SSQ) : (const float*)nullptr};
                E.e2 = pg8::EpiG2{(const pg8::bf16_t*)(ws + WS_G), (float*)(ws + WS_TMP), (pg8::bf16_t*)(ws + WS_MG), CH / 256};
                E.e3 = pg8::EpiG3{X, O, AIN(I_NORMG) + DM, (pg8::bf16_t*)(ws + WS_HN), (float*)(ws + WS_SSQ), layer == 0 ? 1 : 0};
                if (k == 1) g = pg8::Gemm{layer == 0 ? (const pg8::bf16_t*)(ws + WS_HN0) + (size_t)ck.tok0 * DM : (const pg8::bf16_t*)(ws + WS_HN), (const pg8::bf16_t*)(ws + WS_WCAT + layer * WCAT_BYTES), CH, NCAT, 1024};
                else if (k == 4) g = pg8::Gemm{(const pg8::bf16_t*)(ws + WS_Y), (const pg8::bf16_t*)(ws + WS_WBT + layer * WBT_BYTES), 3 * CH, 3072, 512};
                else g = pg8::Gemm{(const pg8::bf16_t*)(ws + WS_MG), (const pg8::bf16_t*)(ws + WS_WOT + layer * WOT_BYTES), CH, 1024, 1024};
                const int nrep = (((DUP_MASK & 8) && k == 1) || ((DUP_MASK & 16) && k == 4)) ? 2 : 1;
#pragma unroll 1
                for (int rep = 0; rep < nrep; ++rep) { if (rep) xcd_barrier(xbar); pg8::gemm_phase<pg8::EpiAll, pg8::OrderAll, true, true>(lds, g, S, E); }
            } }
        }
        if (step + 1 < step_hi) { if (step == 0) cg::this_grid().sync(); else xcd_barrier(xbar); }
    }
}
#ifndef MK_MULTI
#define MK_MULTI 0
#endif
extern "C" void kernel_launch(void* const* d_in, const int* in_sizes, int n_in, void* d_out, int out_size, void* d_ws, size_t ws_size, hipStream_t stream) {
    static int grid = 0;
    if (grid == 0) {
        if (n_in != N_IN || out_size != NTOK * DM || ws_size < WS_END) { fprintf(stderr, "kernel_launch: unexpected shapes (n_in %d, out %d, ws %zu)\n", n_in, out_size, ws_size); grid = -1; return; }
        int dev = 0, cus = 0, per_cu = 0;
        hipGetDevice(&dev); hipDeviceGetAttribute(&cus, hipDeviceAttributeMultiprocessorCount, dev);
        if (hipFuncSetAttribute((const void*)mega_fwd, hipFuncAttributeMaxDynamicSharedMemorySize, LDS_BYTES) != hipSuccess) { fprintf(stderr, "kernel_launch: hipFuncSetAttribute failed\n"); grid = -1; return; }
        hipOccupancyMaxActiveBlocksPerMultiprocessor(&per_cu, (const void*)mega_fwd, NT, LDS_BYTES);
        (void)hipGetLastError();
        if (per_cu < 1) per_cu = 1;
        grid = cus * 1;
        fprintf(stderr, "kernel_launch: cus %d per_cu %d grid %d\n", cus, per_cu, grid);
    }
    if (grid < 0) return;
    hipMemsetAsync((char*)d_ws + WS_CTL, 0, CTL_BYTES, stream);
    Args a{};
    for (int i = 0; i < N_IN; ++i) a.in[i] = (const float*)d_in[i];
    a.out = (float*)d_out; a.ws = (unsigned char*)d_ws;
#if MK_MULTI
    for (int s = 0; s < NSTEPS; ++s) { a.lo = s; a.hi = s + 1; hipLaunchKernelGGL(mega_fwd, dim3(grid), dim3(NT), LDS_BYTES, stream, a); }
#else
    a.lo = 0; a.hi = NSTEPS;
    void* args[] = {&a};
    hipError_t e = hipLaunchCooperativeKernel((const void*)mega_fwd, dim3(grid), dim3(NT), args, LDS_BYTES, stream);
    if (e != hipSuccess) fprintf(stderr, "cooperative launch failed: %s (grid %d)\n", hipGetErrorString(e), grid);
#endif
}
```

```cpp
#include <hip/hip_runtime.h>
#include <hip/hip_cooperative_groups.h>
#include <cstdio>
#include <cstdint>
namespace cg = cooperative_groups;
__device__ __forceinline__ int ltid() { int t = (int)threadIdx.x; asm volatile("" : "+v"(t)); return t; }
__device__ __forceinline__ float shx(float v, int o) { const int l = ltid() & 63; return __int_as_float(__builtin_amdgcn_ds_bpermute((l ^ o) << 2, __float_as_int(v))); }
__device__ __forceinline__ int lbid() { int b = (int)blockIdx.x; asm volatile("" : "+s"(b)); return b; }
namespace pg8 {
#define PG8_LAS __attribute__((address_space(3)))
typedef unsigned short bf16_t;
typedef short bf16x8 __attribute__((ext_vector_type(8)));
typedef float f32x4 __attribute__((ext_vector_type(4)));
typedef unsigned u32x4 __attribute__((ext_vector_type(4)));
constexpr int BM = 256, BK = 64, HALF = 128, HTB = HALF * BK * 2  , STAGE_BYTES = 8 * HTB, NXCD = 8, WGM = 8;

__host__ __device__ __forceinline__ int lds_byte(int r, int c) { const int st = (r >> 4) * 2 + (c >> 5), rr = r & 15, cc = c & 31, ob = rr * 64 + cc * 2; return st * 1024 + (ob ^ (((ob >> 9) & 1) << 5)); }
__host__ __device__ __forceinline__ void stage_rc(int b, int& R, int& C) { const int st = b / 1024, sb = b % 1024, swz = sb ^ (((sb >> 9) & 1) << 5); R = (st >> 1) * 16 + swz / 64; C = (st & 1) * 32 + (swz % 64) / 2; }
__host__ __device__ __forceinline__ int perm32(int rho) { const int n = rho >> 4, i = rho & 15; return 8 * (i >> 2) + 4 * n + (i & 3); }

struct Unit { int pm, pn; };
struct Gemm { const bf16_t* A; const bf16_t* Bt; int M, N, K; };

struct StaticOrder {
    int nM, nN, nwg, G, c;
    __host__ __device__ void init(int M, int N, int G_, int c_) { nM = M / BM; nN = N / BM; nwg = nM * nN; G = G_; c = c_; }
    __host__ __device__ bool next(int i, Unit& u) const {
        const long L = (long)i * G + c; if (L >= nwg) return false;
        int wgid = (int)L; { const int q = nwg / NXCD, r = nwg % NXCD, xcd = wgid % NXCD, off = wgid / NXCD; wgid = (xcd < r ? xcd * (q + 1) : r * (q + 1) + (xcd - r) * q) + off; }
        const int nig = WGM * nN, gid = wgid / nig, fm = gid * WGM, gsz = (nM - fm) < WGM ? (nM - fm) : WGM;
        u.pm = fm + ((wgid % nig) % gsz); u.pn = (wgid % nig) / gsz; return true;
    }
    __device__ __forceinline__ void a_ready(const Unit&) const {}
    __device__ __forceinline__ void done(const Unit&) const {}
};

__device__ __forceinline__ unsigned cvt_pk_bf16(float lo, float hi) { unsigned r; asm volatile("v_cvt_pk_bf16_f32 %0, %1, %2" : "=v"(r) : "v"(lo), "v"(hi)); return r; }
template <class Epi, class Sched, bool ALIGN_EPI = false, bool SP2 = false>
__device__ __forceinline__ void gemm_phase(PG8_LAS unsigned char* lds, const Gemm g, const Sched& S, const Epi& E) {
    const int tid = ltid(), wid = __builtin_amdgcn_readfirstlane(tid >> 6), lane = tid & 63, wr = wid >> 2, wc = wid & 3, fr = lane & 15, fq = lane >> 4;
    const int K = g.K, nt = K / BK;
    unsigned voffA[2], voffB[2];
#pragma unroll
    for (int i = 0; i < 2; ++i) { int R, C; stage_rc(tid * 16 + i * 8192, R, C); const int Rb = Epi::PERM ? ((R & ~31) + perm32(R & 31)) : R;
        voffA[i] = (unsigned)(R * K + C) * 2u; voffB[i] = (unsigned)(Rb * K + C) * 2u; }
    const size_t kstep = (size_t)(BK * 2);
    const size_t hstep = (size_t)HALF * K * 2;
    const size_t tstep = 2 * hstep;
    const unsigned ldsw = (unsigned)wid * 1024u;
    const int aoff = lds_byte(wr * 64 + fr, fq * 8), boff = lds_byte(wc * 32 + fr, fq * 8);
#define PG8_SA(b, h) (((b) * 2 + (h)) * HTB)
#define PG8_SB(b, h) ((4 + (b) * 2 + (h)) * HTB)
#define PG8_STAGE(bufoff, gbase, voff) do { _Pragma("unroll") for (int _i = 0; _i < 2; ++_i) \
        __builtin_amdgcn_global_load_lds((const unsigned*)((const char*)(gbase) + (voff)[_i]), (PG8_LAS unsigned*)(lds + (bufoff) + ldsw + _i * 8192), 16, 0, 0); } while (0)
#define PG8_LDA(dst, b, h) do { _Pragma("unroll") for (int m = 0; m < 4; ++m) _Pragma("unroll") for (int k = 0; k < 2; ++k) dst[m][k] = *(const PG8_LAS bf16x8*)(lds + PG8_SA(b, h) + aoff + m * 2048 + k * 1024); } while (0)
#define PG8_LDB(dst, b, h) do { _Pragma("unroll") for (int n = 0; n < 2; ++n) _Pragma("unroll") for (int k = 0; k < 2; ++k) dst[n][k] = *(const PG8_LAS bf16x8*)(lds + PG8_SB(b, h) + boff + n * 2048 + k * 1024); } while (0)
#define PG8_MMA(ai, bj, At, Bt) do { __builtin_amdgcn_s_setprio(1); _Pragma("unroll") for (int m = 0; m < 4; ++m) _Pragma("unroll") for (int n = 0; n < 2; ++n) _Pragma("unroll") for (int k = 0; k < 2; ++k) \
        acc[ai][bj][m][n] = __builtin_amdgcn_mfma_f32_16x16x32_bf16(Bt[n][k], At[m][k], acc[ai][bj][m][n], 0, 0, 0); __builtin_amdgcn_s_setprio(0); } while (0)
#define PG8_WAIT_V(n) asm volatile("s_waitcnt vmcnt(" #n ")" ::: "memory")
#define PG8_WAIT_L(n) asm volatile("s_waitcnt lgkmcnt(" #n ")" ::: "memory")
#define PG8_BAR __builtin_amdgcn_s_barrier()
#define PG8_SCHED __builtin_amdgcn_sched_barrier(0)
    Unit cur, nxt; int ui = 0;
    if (!S.next(0, cur)) return;
    f32x4 acc[2][2][4][2];
#pragma unroll
    for (int a = 0; a < 2; ++a)
#pragma unroll
        for (int b = 0; b < 2; ++b)
#pragma unroll
            for (int m = 0; m < 4; ++m)
#pragma unroll
                for (int n = 0; n < 2; ++n) acc[a][b][m][n] = (f32x4){0.f, 0.f, 0.f, 0.f};
    bf16x8 At[4][2], B0[2][2], B1[2][2];
    const char* cA = (const char*)g.A + (size_t)cur.pm * tstep; const char* cB = (const char*)g.Bt + (size_t)cur.pn * tstep;
    S.a_ready(cur);
    if constexpr (SP2) {
        PG8_STAGE(PG8_SB(0, 0), cB, voffB); PG8_STAGE(PG8_SB(0, 1), cB + hstep, voffB); PG8_STAGE(PG8_SA(0, 0), cA, voffA); PG8_STAGE(PG8_SA(0, 1), cA + hstep, voffA);
        if (wr == 1) PG8_BAR;
        PG8_WAIT_V(2); PG8_BAR;
        PG8_STAGE(PG8_SB(1, 0), cB + kstep, voffB); PG8_STAGE(PG8_SA(1, 0), cA + kstep, voffA); PG8_STAGE(PG8_SB(1, 1), cB + hstep + kstep, voffB);
        PG8_WAIT_V(6); PG8_BAR;
    } else {
        PG8_STAGE(PG8_SB(0, 0), cB, voffB); PG8_STAGE(PG8_SA(0, 0), cA, voffA); PG8_STAGE(PG8_SB(0, 1), cB + hstep, voffB); PG8_STAGE(PG8_SA(0, 1), cA + hstep, voffA);
        if (wr == 1) PG8_BAR;
        PG8_WAIT_V(4); PG8_BAR;
        PG8_STAGE(PG8_SB(1, 0), cB + kstep, voffB); PG8_STAGE(PG8_SA(1, 0), cA + kstep, voffA); PG8_STAGE(PG8_SB(1, 1), cB + hstep + kstep, voffB);
        PG8_WAIT_V(6); PG8_BAR;
    }
    for (;;) {
        const bool has_next = S.next(ui + 1, nxt);
        const char* nA = has_next ? (const char*)g.A + (size_t)nxt.pm * tstep : cA; const char* nB = has_next ? (const char*)g.Bt + (size_t)nxt.pn * tstep : cB;
        for (int t = 0; t < nt; t += 2) {
            const bool last = (t == nt - 2);
            const char* a1 = cA + (size_t)(t + 1) * kstep;
            const char* a2 = last ? nA : cA + (size_t)(t + 2) * kstep; const char* b2 = last ? nB : cB + (size_t)(t + 2) * kstep;
            const char* a3 = a2 + kstep; const char* b3 = b2 + kstep;
            if (last && has_next) S.a_ready(nxt);
            if constexpr (SP2) {
            PG8_LDB(B0, 0, 0); PG8_LDB(B1, 0, 1); PG8_SCHED; PG8_LDA(At, 0, 0); PG8_STAGE(PG8_SA(1, 1), a1 + hstep, voffA);
            PG8_WAIT_V(8); PG8_WAIT_L(0); PG8_BAR; PG8_MMA(0, 0, At, B0); PG8_MMA(0, 1, At, B1); PG8_BAR; PG8_SCHED;
            PG8_LDA(At, 0, 1); PG8_STAGE(PG8_SB(0, 0), b2, voffB); PG8_STAGE(PG8_SB(0, 1), b2 + hstep, voffB); PG8_STAGE(PG8_SA(0, 0), a2, voffA);
            PG8_WAIT_V(8); PG8_WAIT_L(0); PG8_BAR; PG8_MMA(1, 0, At, B0); PG8_MMA(1, 1, At, B1); PG8_BAR; PG8_SCHED;
            PG8_LDB(B0, 1, 0); PG8_LDB(B1, 1, 1); PG8_SCHED; PG8_LDA(At, 1, 0); PG8_STAGE(PG8_SA(0, 1), a2 + hstep, voffA);
            PG8_WAIT_V(8); PG8_WAIT_L(0); PG8_BAR; PG8_MMA(0, 0, At, B0); PG8_MMA(0, 1, At, B1); PG8_BAR; PG8_SCHED;
            PG8_LDA(At, 1, 1); PG8_STAGE(PG8_SB(1, 0), b3, voffB); PG8_STAGE(PG8_SB(1, 1), b3 + hstep, voffB); PG8_STAGE(PG8_SA(1, 0), a3, voffA);
            PG8_WAIT_V(8); PG8_WAIT_L(0); PG8_BAR; PG8_MMA(1, 0, At, B0); PG8_MMA(1, 1, At, B1); PG8_BAR; PG8_SCHED;
            } else {
            PG8_LDB(B0, 0, 0); PG8_SCHED; PG8_LDA(At, 0, 0); PG8_STAGE(PG8_SA(1, 1), a1 + hstep, voffA);
            PG8_WAIT_L(8); PG8_BAR; PG8_WAIT_L(0); PG8_MMA(0, 0, At, B0); PG8_BAR; PG8_SCHED;
            PG8_LDB(B1, 0, 1); PG8_STAGE(PG8_SB(0, 0), b2, voffB);
            PG8_BAR; PG8_WAIT_L(0); PG8_MMA(0, 1, At, B1); PG8_BAR;
            PG8_LDA(At, 0, 1); PG8_STAGE(PG8_SA(0, 0), a2, voffA);
            PG8_BAR; PG8_WAIT_L(0); PG8_MMA(1, 0, At, B0); PG8_BAR; PG8_SCHED;
            PG8_STAGE(PG8_SB(0, 1), b2 + hstep, voffB);
            PG8_WAIT_V(6); PG8_BAR; PG8_MMA(1, 1, At, B1); PG8_BAR;
            PG8_LDB(B0, 1, 0); PG8_SCHED; PG8_LDA(At, 1, 0); PG8_STAGE(PG8_SA(0, 1), a2 + hstep, voffA);
            PG8_WAIT_L(8); PG8_BAR; PG8_WAIT_L(0); PG8_MMA(0, 0, At, B0); PG8_BAR; PG8_SCHED;
            PG8_LDB(B1, 1, 1); PG8_STAGE(PG8_SB(1, 0), b3, voffB);
            PG8_BAR; PG8_WAIT_L(0); PG8_MMA(0, 1, At, B1); PG8_BAR;
            PG8_LDA(At, 1, 1); PG8_STAGE(PG8_SA(1, 0), a3, voffA);
            PG8_BAR; PG8_WAIT_L(0); PG8_MMA(1, 0, At, B0); PG8_BAR; PG8_SCHED;
            PG8_STAGE(PG8_SB(1, 1), b3 + hstep, voffB);
            PG8_WAIT_V(6); PG8_BAR; PG8_MMA(1, 1, At, B1); PG8_BAR;
            }
        }
        if constexpr (ALIGN_EPI) { if (wr == 0) PG8_BAR; }
        if constexpr (!Epi::AFTER_DRAIN) { E(acc, cur, wr, wc, fr, fq); S.done(cur); }
        if (!has_next) break;
#pragma unroll
        for (int a = 0; a < 2; ++a)
#pragma unroll
            for (int b = 0; b < 2; ++b)
#pragma unroll
                for (int m = 0; m < 4; ++m)
#pragma unroll
                    for (int n = 0; n < 2; ++n) acc[a][b][m][n] = (f32x4){0.f, 0.f, 0.f, 0.f};
        cur = nxt; cA = nA; cB = nB; ++ui;
        if constexpr (ALIGN_EPI) { if (wr == 1) PG8_BAR; }
    }
    PG8_WAIT_V(0);
    if constexpr (!ALIGN_EPI) { if (wr == 0) PG8_BAR; }
    PG8_BAR;
    if constexpr (Epi::AFTER_DRAIN) { E.fused(acc, cur, wr, wc, fr, fq, lds, wid, lane); S.done(cur); }
#undef PG8_SA
#undef PG8_SB
#undef PG8_STAGE
#undef PG8_LDA
#undef PG8_LDB
#undef PG8_MMA
#undef PG8_WAIT_V
#undef PG8_WAIT_L
#undef PG8_BAR
#undef PG8_SCHED
}
__device__ __forceinline__ float bf2f(unsigned short h) { return __uint_as_float(((unsigned)h) << 16); }
__device__ __forceinline__ float fast_sigmoid(float x) { return __builtin_amdgcn_rcpf(1.0f + __builtin_amdgcn_exp2f(-1.4426950408889634f * x)); }
struct EpiG1 {
    static constexpr bool PERM = true, AFTER_DRAIN = false;
    bf16_t* U; bf16_t* G; const float* bias; const float* ssq;
    __device__ __forceinline__ void operator()(const f32x4 (&acc)[2][2][4][2], const Unit& u, int wr, int wc, int fr, int fq) const {
        const int row0 = u.pm * BM + wr * 64 + fr; int colt = u.pn * BM; const bool isg = colt >= 5376;
        bf16_t* base = U; int ldc = 5376; if (isg) { colt -= 5376; base = G; ldc = 3072; }
        const int col0 = colt + wc * 32 + 8 * fq;
        f32x4 bv[2][2];
#pragma unroll
        for (int bj = 0; bj < 2; ++bj)
#pragma unroll
            for (int n = 0; n < 2; ++n) bv[bj][n] = isg ? *(const f32x4*)(bias + col0 + bj * HALF + 4 * n) : (f32x4){0.f, 0.f, 0.f, 0.f};
        float rsq[2][4];
#pragma unroll
        for (int ai = 0; ai < 2; ++ai)
#pragma unroll
            for (int m = 0; m < 4; ++m) rsq[ai][m] = ssq ? __builtin_amdgcn_rsqf(ssq[row0 + ai * HALF + m * 16] * (1.0f / 1024.0f) + 1e-6f) : 1.0f;
#pragma unroll
        for (int ai = 0; ai < 2; ++ai)
#pragma unroll
            for (int m = 0; m < 4; ++m) { bf16_t* rowp = base + (size_t)(row0 + ai * HALF + m * 16) * ldc + col0;
                const float rs = rsq[ai][m];
#pragma unroll
                for (int bj = 0; bj < 2; ++bj) { f32x4 v0 = acc[ai][bj][m][0] * rs + bv[bj][0], v1 = acc[ai][bj][m][1] * rs + bv[bj][1];
                    if (isg) {
#pragma unroll
                        for (int e = 0; e < 4; ++e) { v0[e] = fast_sigmoid(v0[e]); v1[e] = fast_sigmoid(v1[e]); } }
                    u32x4 w; w.x = cvt_pk_bf16(v0[0], v0[1]); w.y = cvt_pk_bf16(v0[2], v0[3]); w.z = cvt_pk_bf16(v1[0], v1[1]); w.w = cvt_pk_bf16(v1[2], v1[3]);
                    *(u32x4*)(rowp + bj * HALF) = w; } }
    }
};
struct EpiG2 {
    static constexpr bool PERM = true, AFTER_DRAIN = false;
    const bf16_t* G; float* T; bf16_t* Mg; int npan;
    __device__ __forceinline__ void operator()(const f32x4 (&acc)[2][2][4][2], const Unit& u, int wr, int wc, int fr, int fq) const {
        const int b = u.pm / npan, pm = u.pm - b * npan, pn = u.pn & 3;
        const int row0 = pm * BM + wr * 64 + fr, col0 = pn * BM + wc * 32 + 8 * fq;
#pragma unroll
        for (int ai = 0; ai < 2; ++ai)
#pragma unroll
          for (int mh = 0; mh < 2; ++mh) {
            u32x4 gq[4][2], tq[4][2];
#pragma unroll
            for (int m = 2 * mh; m < 2 * mh + 2; ++m)
#pragma unroll
                for (int bj = 0; bj < 2; ++bj) { const size_t row = (size_t)(row0 + ai * HALF + m * 16); const int col = col0 + bj * HALF;
                    gq[m][bj] = *(const u32x4*)(G + row * 3072 + b * 1024 + col);
                    tq[m][bj] = (b > 0) ? *(const u32x4*)(Mg + row * 1024 + col) : (u32x4){0u, 0u, 0u, 0u}; }
            __builtin_amdgcn_sched_barrier(0);
#pragma unroll
            for (int m = 2 * mh; m < 2 * mh + 2; ++m)
#pragma unroll
                for (int bj = 0; bj < 2; ++bj) { const size_t row = (size_t)(row0 + ai * HALF + m * 16); const int col = col0 + bj * HALF; const u32x4 g = gq[m][bj], t = tq[m][bj];
                    f32x4 v0 = acc[ai][bj][m][0], v1 = acc[ai][bj][m][1];
                    v0[0] = v0[0] * __uint_as_float(g.x << 16) + __uint_as_float(t.x << 16); v0[1] = v0[1] * __uint_as_float(g.x & 0xffff0000u) + __uint_as_float(t.x & 0xffff0000u);
                    v0[2] = v0[2] * __uint_as_float(g.y << 16) + __uint_as_float(t.y << 16); v0[3] = v0[3] * __uint_as_float(g.y & 0xffff0000u) + __uint_as_float(t.y & 0xffff0000u);
                    v1[0] = v1[0] * __uint_as_float(g.z << 16) + __uint_as_float(t.z << 16); v1[1] = v1[1] * __uint_as_float(g.z & 0xffff0000u) + __uint_as_float(t.z & 0xffff0000u);
                    v1[2] = v1[2] * __uint_as_float(g.w << 16) + __uint_as_float(t.w << 16); v1[3] = v1[3] * __uint_as_float(g.w & 0xffff0000u) + __uint_as_float(t.w & 0xffff0000u);
                    u32x4 w; w.x = cvt_pk_bf16(v0[0], v0[1]); w.y = cvt_pk_bf16(v0[2], v0[3]); w.z = cvt_pk_bf16(v1[0], v1[1]); w.w = cvt_pk_bf16(v1[2], v1[3]);
                    *(u32x4*)(Mg + row * 1024 + col) = w; }
            __builtin_amdgcn_sched_barrier(0); }
    }
};
struct OrderG2 {
    int npan, G, c;
    __device__ bool next(int i, Unit& u) const { const int ti = i / 3, b = i - 3 * ti, t = ti * G + c; if (t >= npan * 4) return false;
        const int pm = t >> 2, pn = t & 3; u.pm = b * npan + pm; u.pn = b * 4 + pn; return true; }
    __device__ __forceinline__ void a_ready(const Unit&) const {}
    __device__ __forceinline__ void done(const Unit&) const {}
};
struct EpiG3 {
    static constexpr bool PERM = true, AFTER_DRAIN = false;
    const float* X; float* O; const float* gn; bf16_t* HN; float* ssq; int fuse;
    __device__ __forceinline__ void operator()(const f32x4 (&acc)[2][2][4][2], const Unit& u, int wr, int wc, int fr, int fq) const {
        const int row0 = u.pm * BM + wr * 64 + fr, col0 = u.pn * BM + wc * 32 + 8 * fq;
        f32x4 gv[2][2];
#pragma unroll
        for (int bj = 0; bj < 2; ++bj)
#pragma unroll
            for (int n = 0; n < 2; ++n) gv[bj][n] = fuse ? *(const f32x4*)(gn + col0 + bj * HALF + 4 * n) : (f32x4){0.f, 0.f, 0.f, 0.f};
#pragma unroll
        for (int ai = 0; ai < 2; ++ai)
#pragma unroll
         for (int mh = 0; mh < 2; ++mh) {
          f32x4 xq[4][2][2];
#pragma unroll
          for (int m = 2 * mh; m < 2 * mh + 2; ++m)
#pragma unroll
              for (int bj = 0; bj < 2; ++bj) { const size_t p = (size_t)(row0 + ai * HALF + m * 16) * 1024 + col0 + bj * HALF; xq[m][bj][0] = *(const f32x4*)(X + p); xq[m][bj][1] = *(const f32x4*)(X + p + 4); }
          __builtin_amdgcn_sched_barrier(0);
#pragma unroll
            for (int m = 2 * mh; m < 2 * mh + 2; ++m) { const size_t row = (size_t)(row0 + ai * HALF + m * 16); float sq = 0.f;
#pragma unroll
                for (int bj = 0; bj < 2; ++bj) { const size_t p = row * 1024 + col0 + bj * HALF;
                    const f32x4 x0 = xq[m][bj][0], x1 = xq[m][bj][1];
                    const f32x4 o0 = x0 + acc[ai][bj][m][0], o1 = x1 + acc[ai][bj][m][1];
                    *(f32x4*)(O + p) = o0; *(f32x4*)(O + p + 4) = o1;
                    if (fuse) { const f32x4 h0 = o0 * gv[bj][0], h1 = o1 * gv[bj][1];
                        u32x4 w; w.x = cvt_pk_bf16(h0[0], h0[1]); w.y = cvt_pk_bf16(h0[2], h0[3]); w.z = cvt_pk_bf16(h1[0], h1[1]); w.w = cvt_pk_bf16(h1[2], h1[3]);
                        *(u32x4*)(HN + p) = w;
                        sq += (o0[0] * o0[0] + o0[1] * o0[1]) + (o0[2] * o0[2] + o0[3] * o0[3]) + (o1[0] * o1[0] + o1[1] * o1[1]) + (o1[2] * o1[2] + o1[3] * o1[3]); } }
                if (fuse) { sq += shx(sq, 16); sq += shx(sq, 32); if (fq == 0) atomicAdd(ssq + row, sq); } }
          __builtin_amdgcn_sched_barrier(0); }
    }
};
struct EpiAll {
    static constexpr bool PERM = true, AFTER_DRAIN = false;
    int mode; EpiG1 e1; EpiG2 e2; EpiG3 e3;
    __device__ __forceinline__ void operator()(const f32x4 (&acc)[2][2][4][2], const Unit& u, int wr, int wc, int fr, int fq) const {
        if (mode == 1) e1(acc, u, wr, wc, fr, fq); else if (mode == 2) e2(acc, u, wr, wc, fr, fq); else e3(acc, u, wr, wc, fr, fq); }
};
struct OrderAll {
    int mode; StaticOrder so; OrderG2 o2;
    __device__ __forceinline__ bool next(int i, Unit& u) const { return mode == 2 ? o2.next(i, u) : so.next(i, u); }
    __device__ __forceinline__ void a_ready(const Unit&) const {}
    __device__ __forceinline__ void done(const Unit&) const {}
};
}
#ifndef DUP_MASK
#define DUP_MASK 0
#endif
#ifndef EN_MASK
#define EN_MASK 0xffff
#endif
#define EN(i) ((EN_MASK >> (i)) & 1)
#define LAS __attribute__((address_space(3)))
typedef unsigned short bf16;
typedef float f32x4 __attribute__((ext_vector_type(4)));
typedef float f32x2 __attribute__((ext_vector_type(2)));
typedef unsigned u32x4 __attribute__((ext_vector_type(4)));
typedef unsigned u32x2 __attribute__((ext_vector_type(2)));
constexpr int DM = 1024, NTOK_P = 65536, NTOK_S = 32768, NTOK = NTOK_P + NTOK_S, LP = 8192, LS = 2048;
constexpr int CH = 16384, NCHUNK = NTOK / CH, NCH_P = NTOK_P / CH;
constexpr int UP = 5376, NCAT = 8448, GP = 3072;
constexpr int C_X0 = 0, C_X1 = 512, C_HV = 1024, C_HG = 1536, C_GQ = 2048, C_GK = 2560, C_GV = 2688, C_GG = 2816, C_DQ = 3328, C_DK = 3840, C_DV = 4352, C_DG = 4864;
constexpr float EPS = 1e-6f, LOG2E = 1.4426950408889634f;
constexpr int NT = 512, NWAVES = 8;
enum { I_XP = 0, I_XS, I_RELB, I_NORMG, I_WIN, I_CONVW, I_CONVB, I_FW1, I_FB1, I_FW2, I_FB2, I_FWOUT, I_FFREQ, I_HYBIAS, I_QNG, I_KNG, I_LQ1, I_LK1, I_LQ2, I_LK2, I_SUBLN, I_WBHY, I_WBGQ, I_WBDF, I_WMERGE, I_BMERGE, I_WOUT, I_FINALG, N_IN };
constexpr size_t MiB = 1u << 20;
constexpr size_t WS_CTL = 0, CTL_BYTES = 64 * 1024;
constexpr size_t WS_TW = 1 * MiB;
constexpr size_t WS_WCAT = 2 * MiB, WCAT_BYTES = (size_t)NCAT * 1024 * 2;
constexpr size_t WS_WBT = 40 * MiB, WBT_BYTES = (size_t)3 * 1024 * 512 * 2;
constexpr size_t WS_WOT = 46 * MiB, WOT_BYTES = (size_t)1024 * 1024 * 2;
constexpr int SPS_P = LP + 16, SPS_S = LS + 16;
constexpr size_t SPEC_P_BYTES = (size_t)256 * SPS_P * 8, SPEC_S_BYTES = (size_t)256 * SPS_S * 8;
constexpr size_t SPEC_LAYER = 2 * SPEC_P_BYTES + 2 * SPEC_S_BYTES;
constexpr size_t WS_SPEC = 52 * MiB;
constexpr size_t WS_HN = 140 * MiB, WS_U = 172 * MiB, WS_G = 340 * MiB, WS_Y = 436 * MiB, WS_MG = 484 * MiB, WS_TMP = 516 * MiB, WS_DT = 580 * MiB, WS_HVP = 612 * MiB, WS_PMP = 644 * MiB, WS_ROPE = 676 * MiB, WS_HN0 = 680 * MiB, WS_HF = 872 * MiB, WS_END = 952 * MiB;
constexpr size_t HF_P_BYTES = (size_t)LP * 1024 * 4, HF_S_BYTES = (size_t)LS * 1024 * 4;
static_assert(WS_WCAT + 2 * WCAT_BYTES <= WS_WBT && WS_WBT + 2 * WBT_BYTES <= WS_WOT && WS_WOT + 2 * WOT_BYTES <= WS_SPEC && WS_SPEC + 2 * SPEC_LAYER <= WS_HN, "ws map");
static_assert(WS_HN + (size_t)CH * 1024 * 2 <= WS_U && WS_U + (size_t)CH * UP * 2 <= WS_G && WS_G + (size_t)CH * GP * 2 <= WS_Y && WS_Y + (size_t)3 * CH * 512 * 2 <= WS_MG && WS_MG + (size_t)CH * 1024 * 2 <= WS_TMP && WS_TMP + (size_t)CH * 1024 * 4 <= WS_DT && WS_DT + (size_t)CH * 512 * 4 <= WS_END, "ws map 2");
static_assert(WS_HF + 2 * (HF_P_BYTES + HF_S_BYTES) <= WS_END, "hf region");
constexpr size_t WS_SSQ = WS_TMP;
constexpr int LDS_MAIN = 139264, LDS_BYTES = LDS_MAIN + 1024;
constexpr int CW_BAR = 4096;

struct Args { const float* in[N_IN]; float* out; unsigned char* ws; int lo, hi; };
typedef const __attribute__((address_space(4))) unsigned long long* kargp_t;
struct AV { kargp_t p; };
#define AIN(i) ((const float*)(a.p[(i)]))
#define AOUT ((float*)(a.p[N_IN]))
#define AWS ((unsigned char*)(a.p[N_IN + 1]))


__device__ __forceinline__ float bf2f(unsigned short h) { return __uint_as_float(((unsigned)h) << 16); }
__device__ __forceinline__ float bflo(unsigned w) { return __uint_as_float(w << 16); }
__device__ __forceinline__ float bfhi(unsigned w) { return __uint_as_float(w & 0xffff0000u); }
__device__ __forceinline__ unsigned f2bf(float f) { unsigned u = __builtin_bit_cast(unsigned, f); return (u + 0x7fffu + ((u >> 16) & 1u)) >> 16; }
__device__ __forceinline__ unsigned pk2(float lo, float hi) { return f2bf(lo) | (f2bf(hi) << 16); }
__device__ __forceinline__ float silu(float x) { return x * __builtin_amdgcn_rcpf(1.0f + __builtin_amdgcn_exp2f(-LOG2E * x)); }
__device__ __forceinline__ float wave_sum(float v) {
#pragma unroll
    for (int o = 1; o < 64; o <<= 1) v += shx(v, o);
    return v;
}
__device__ __forceinline__ double kd(double v) { asm volatile("" : "+s"(v)); return v; }
__device__ __forceinline__ void sincos_rev(double r, float& s, float& c) {
    r -= __builtin_rint(r);
    const double k = __builtin_rint(r * 4.0);
    const double x = (r - k * 0.25) * kd(6.283185307179586476925);
    const double x2 = x * x;
    double sp = kd(1.0 / 6227020800.0); sp = sp * x2 + kd(-1.0 / 39916800); sp = sp * x2 + kd(1.0 / 362880); sp = sp * x2 + kd(-1.0 / 5040); sp = sp * x2 + kd(1.0 / 120); sp = sp * x2 + kd(-1.0 / 6); sp = sp * x2 + 1.0; sp *= x;
    double cp = kd(-1.0 / 87178291200.0); cp = cp * x2 + kd(1.0 / 479001600.0); cp = cp * x2 + kd(-1.0 / 3628800); cp = cp * x2 + kd(1.0 / 40320); cp = cp * x2 + kd(-1.0 / 720); cp = cp * x2 + kd(1.0 / 24); cp = cp * x2 + (-0.5); cp = cp * x2 + 1.0;
    const int q = ((int)k) & 3;
    const float sf = (float)sp, cf = (float)cp;
    s = (q == 0) ? sf : (q == 1) ? cf : (q == 2) ? -sf : -cf;
    c = (q == 0) ? cf : (q == 1) ? -sf : (q == 2) ? -cf : sf;
}
__device__ __forceinline__ float sin_acc(float x) { float s, c; sincos_rev((double)x * 0.15915494309189533577, s, c); return s; }

__device__ __forceinline__ void transpose_item(const float* W, int K, int N, bf16* WT, int row_off, LAS float* scr, int item, int lane) {
    const int nblk = N / 32, kb = item / nblk, nb = item % nblk, k0 = 64 * kb, n0 = 32 * nb;
#pragma unroll 8
    for (int i = 0; i < 32; ++i) { const int kk = 2 * i + (lane >> 5); scr[kk * 33 + (lane & 31)] = W[(size_t)(k0 + kk) * N + n0 + (lane & 31)]; }
    asm volatile("s_waitcnt lgkmcnt(0)" ::: "memory");
    const int c = lane & 7;
#pragma unroll
    for (int j = 0; j < 4; ++j) { const int n = (lane >> 3) + 8 * j; const LAS float* s = scr + (8 * c) * 33 + n;
        u32x4 o; o.x = pk2(s[0 * 33], s[1 * 33]); o.y = pk2(s[2 * 33], s[3 * 33]); o.z = pk2(s[4 * 33], s[5 * 33]); o.w = pk2(s[6 * 33], s[7 * 33]);
        *(u32x4*)(WT + (size_t)(row_off + n0 + n) * K + k0 + 8 * c) = o; }
    asm volatile("s_waitcnt lgkmcnt(0)" ::: "memory");
}

__device__ __forceinline__ f32x2 cmul(f32x2 a, f32x2 b) { return (f32x2){a.x * b.x - a.y * b.y, a.x * b.y + a.y * b.x}; }
__device__ __forceinline__ f32x2 cmulc(f32x2 a, f32x2 b) { return (f32x2){a.x * b.x + a.y * b.y, a.y * b.x - a.x * b.y}; }
__device__ __forceinline__ f32x2 cconj(f32x2 a) { return (f32x2){a.x, -a.y}; }
template <int LOG4> __device__ __forceinline__ int digitrev(int k) { unsigned x = __builtin_bitreverse32((unsigned)k) >> (32 - 2 * LOG4); return (int)(((x & 0x55555555u) << 1) | ((x >> 1) & 0x55555555u)); }
__device__ __forceinline__ unsigned cvtpk(float lo, float hi);
#define PADI(i) ((i) + ((i) >> 4))
#define W16C 0.92387953251128674f
#define W16S 0.38268343236508977f
#define W16H 0.70710678118654752f
__device__ __forceinline__ f32x2 w16(int m) { return m == 0 ? (f32x2){1.f, 0.f} : m == 1 ? (f32x2){W16C, -W16S} : m == 2 ? (f32x2){W16H, -W16H} : m == 3 ? (f32x2){W16S, -W16C} : m == 4 ? (f32x2){0.f, -1.f} : m == 6 ? (f32x2){-W16H, -W16H} : (f32x2){-W16C, W16S}; }
__device__ __forceinline__ void bfly_fwd(f32x2& a0, f32x2& a1, f32x2& a2, f32x2& a3) {
    const f32x2 t0 = a0 + a2, t1 = a0 - a2, t2 = a1 + a3, t3 = a1 - a3;
    a0 = t0 + t2; a2 = t0 - t2; a1 = (f32x2){t1.x + t3.y, t1.y - t3.x}; a3 = (f32x2){t1.x - t3.y, t1.y + t3.x};
}
__device__ __forceinline__ void bfly_inv(f32x2& b0, f32x2& b1, f32x2& b2, f32x2& b3) {
    const f32x2 t0 = b0 + b2, t1 = b0 - b2, t2 = b1 + b3, t3 = b1 - b3;
    b0 = t0 + t2; b2 = t0 - t2; b1 = (f32x2){t1.x - t3.y, t1.y + t3.x}; b3 = (f32x2){t1.x + t3.y, t1.y - t3.x};
}
__device__ __forceinline__ void tail_fwd(f32x2 (&x)[16]) {
#pragma unroll
    for (int jj = 0; jj < 4; ++jj) { bfly_fwd(x[jj], x[jj + 4], x[jj + 8], x[jj + 12]); if (jj) { x[jj + 4] = cmul(x[jj + 4], w16(jj)); x[jj + 8] = cmul(x[jj + 8], w16(2 * jj)); x[jj + 12] = cmul(x[jj + 12], w16(3 * jj)); } }
#pragma unroll
    for (int q = 0; q < 4; ++q) bfly_fwd(x[4 * q], x[4 * q + 1], x[4 * q + 2], x[4 * q + 3]);
}
__device__ __forceinline__ void tail_inv(f32x2 (&x)[16]) {
#pragma unroll
    for (int q = 0; q < 4; ++q) bfly_inv(x[4 * q], x[4 * q + 1], x[4 * q + 2], x[4 * q + 3]);
#pragma unroll
    for (int jj = 0; jj < 4; ++jj) { if (jj) { x[jj + 4] = cmulc(x[jj + 4], w16(jj)); x[jj + 8] = cmulc(x[jj + 8], w16(2 * jj)); x[jj + 12] = cmulc(x[jj + 12], w16(3 * jj)); } bfly_inv(x[jj], x[jj + 4], x[jj + 8], x[jj + 12]); }
}
__device__ __forceinline__ void pair_mul(f32x2& z1, f32x2& z2, f32x2 P, f32x2 M) { const f32x2 a = z1, b = z2; z1 = cmul(a, P) + cmul(cconj(b), M); z2 = cmulc(b, P) + cmulc(cconj(a), M); }
template <int LOG4, int BATCH> __device__ __forceinline__ void fft_tail_mul_tail(LAS f32x2* buf, const f32x2* __restrict__ Pg, const f32x2* __restrict__ Mg, int sps, int tid) {
    constexpr int N = 1 << (2 * LOG4), NB = N / 16, NI = NB / 2, NPAD = N + N / 16, TOT = BATCH * NI, IT = (TOT + NT - 1) / NT;
#define RR(e_) ((((e_) & 3) << 2) | ((e_) >> 2))
#pragma unroll 1
    for (int i = 0; i < IT; ++i) { const int ig = tid + i * NT; if (TOT % NT != 0 && ig >= TOT) break;
        const int bt = ig / NI, u = ig - bt * NI; if (u == 0) continue;
        const f32x2* P = Pg + (size_t)bt * sps; const f32x2* M = Mg + (size_t)bt * sps;
        const int bA = ((u >> 1) << 2) | (u & 1), bB = digitrev<LOG4 - 2>(NB - digitrev<LOG4 - 2>(bA));
        LAS f32x2* xa = buf + bt * NPAD + 17 * bA; LAS f32x2* xb = buf + bt * NPAD + 17 * bB;
        f32x2 x[16], y[16];
#pragma unroll
        for (int e = 0; e < 16; ++e) { x[e] = xa[e]; y[e] = xb[e]; }
        tail_fwd(x); tail_fwd(y);
#pragma unroll
        for (int e = 0; e < 16; ++e) if ((e & 3) < 2) { const int Re = RR(e), ep = RR(15 - Re);
            pair_mul(x[e], y[ep], P[bA * 8 + Re], M[bA * 8 + Re]);
            pair_mul(y[e], x[ep], P[bB * 8 + Re], M[bB * 8 + Re]);
            if ((e & 7) == 5) __builtin_amdgcn_sched_barrier(0); }
        tail_inv(x); tail_inv(y);
#pragma unroll
        for (int e = 0; e < 16; ++e) { xa[e] = x[e]; xb[e] = y[e]; }
    }
    if (tid < 2 * BATCH) {
        const int bt = tid >> 1, sel = tid & 1; const f32x2* P = Pg + (size_t)bt * sps; const f32x2* M = Mg + (size_t)bt * sps;
        LAS f32x2* xa = buf + bt * NPAD + 17 * digitrev<LOG4 - 2>(sel ? NB / 2 : 0);
        f32x2 x[16];
#pragma unroll
        for (int e = 0; e < 16; ++e) x[e] = xa[e];
        tail_fwd(x);
        if (sel == 0) {
            { f32x2 t = x[0]; pair_mul(x[0], t, P[0], M[0]); }
            { f32x2 t = x[2]; pair_mul(x[2], t, P[N / 2], M[N / 2]); }
#pragma unroll
            for (int e = 1; e < 16; ++e) if ((e & 3) < 2) { const int Re = RR(e), ep = RR(16 - Re); pair_mul(x[e], x[ep], P[Re], M[Re]); }
        } else {
#pragma unroll
            for (int e = 0; e < 16; ++e) if ((e & 3) < 2) { const int Re = RR(e), ep = RR(15 - Re); const int sl = digitrev<LOG4 - 2>(NB / 2) * 8 + Re; pair_mul(x[e], x[ep], P[sl], M[sl]); }
        }
        tail_inv(x);
#pragma unroll
        for (int e = 0; e < 16; ++e) xa[e] = x[e];
    }
#undef RR
    __syncthreads();
}
template <int LOG4, int BATCH = 1, int PS0 = 0, bool TAIL = true> __device__ __forceinline__ void fft_fwd(LAS f32x2* buf, const f32x2* __restrict__ tw, int tid) {
    constexpr int N = 1 << (2 * LOG4), TWS = 16384 / N;
    constexpr int NPAD = N + N / 16, NLEV = LOG4 - 2, NP16 = NLEV / 2;
#pragma unroll 1
    for (int ps = PS0; ps < NP16; ++ps) {
        const int lq4 = 2 * (LOG4 - 2 * ps) - 2, lq16 = lq4 - 2, q4 = 1 << lq4, q16 = 1 << lq16, tsA = TWS << (4 * ps), tsB = tsA << 2;
        constexpr int TOT = BATCH * N / 16, IT = (TOT + NT - 1) / NT;
#pragma unroll
        for (int i = 0; i < IT; ++i) { const int jg = tid + i * NT; if (TOT % NT != 0 && jg >= TOT) break; const int bo = (jg >> (2 * LOG4 - 4)) * NPAD, j = jg & (N / 16 - 1);
            const int blk = j >> lq16, jj = j & (q16 - 1), base = (blk << (lq4 + 2)) + jj;
            f32x2 wa[4], wb = tw[jj * tsB];
#pragma unroll
            for (int b = 0; b < 4; ++b) wa[b] = tw[(jj + b * q16) * tsA];
            f32x2 e[4][4];
#pragma unroll
            for (int a = 0; a < 4; ++a)
#pragma unroll
                for (int b = 0; b < 4; ++b) e[a][b] = buf[bo + PADI(base + b * q16 + a * q4)];
#pragma unroll
            for (int b = 0; b < 4; ++b) { bfly_fwd(e[0][b], e[1][b], e[2][b], e[3][b]); const f32x2 w2 = cmul(wa[b], wa[b]), w3 = cmul(w2, wa[b]); e[1][b] = cmul(e[1][b], wa[b]); e[2][b] = cmul(e[2][b], w2); e[3][b] = cmul(e[3][b], w3); }
            { const f32x2 w2 = cmul(wb, wb), w3 = cmul(w2, wb);
#pragma unroll
              for (int a = 0; a < 4; ++a) { bfly_fwd(e[a][0], e[a][1], e[a][2], e[a][3]); e[a][1] = cmul(e[a][1], wb); e[a][2] = cmul(e[a][2], w2); e[a][3] = cmul(e[a][3], w3); } }
#pragma unroll
            for (int a = 0; a < 4; ++a)
#pragma unroll
                for (int b = 0; b < 4; ++b) buf[bo + PADI(base + b * q16 + a * q4)] = e[a][b];
        }
        __syncthreads();
    }
#pragma unroll 1
    for (int pass = 2 * NP16; pass < NLEV; ++pass) {
        const int lq = 2 * (LOG4 - pass) - 2, q4 = 1 << lq, n = q4 << 2, tstep = TWS << (2 * pass);
        constexpr int IT = BATCH * N / 4 / NT;
        f32x2 wl[IT];
#pragma unroll
        for (int i = 0; i < IT; ++i) wl[i] = tw[((tid + i * NT) & (q4 - 1)) * tstep];
#pragma unroll
        for (int i = 0; i < IT; ++i) { const int jg = tid + i * NT, bo = (jg >> (2 * LOG4 - 2)) * NPAD, j = jg & (N / 4 - 1);
            const int blk = j >> lq, jj = j & (q4 - 1), base = blk * n + jj;
            const int i0 = bo + PADI(base), i1 = bo + PADI(base + q4), i2 = bo + PADI(base + 2 * q4), i3 = bo + PADI(base + 3 * q4);
            const f32x2 w1 = wl[i];
            f32x2 a0 = buf[i0], a1 = buf[i1], a2 = buf[i2], a3 = buf[i3];
            bfly_fwd(a0, a1, a2, a3);
            const f32x2 w2 = cmul(w1, w1), w3 = cmul(w2, w1);
            buf[i0] = a0; buf[i1] = cmul(a1, w1); buf[i2] = cmul(a2, w2); buf[i3] = cmul(a3, w3);
        }
        __syncthreads();
    }
    if constexpr (TAIL) {
#pragma unroll 1
    for (int b = tid; b < BATCH * N / 16; b += NT) {
        LAS f32x2* xb = buf + 17 * b; f32x2 x[16];
#pragma unroll
        for (int e = 0; e < 16; ++e) x[e] = xb[e];
        tail_fwd(x);
#pragma unroll
        for (int e = 0; e < 16; ++e) xb[e] = x[e];
    }
    __syncthreads(); }
}
template <int LOG4, int BATCH = 1, int PS0 = 0, bool TAIL = true> __device__ __forceinline__ void fft_inv(LAS f32x2* buf, const f32x2* __restrict__ tw, int tid) {
    constexpr int N = 1 << (2 * LOG4), TWS = 16384 / N;
    if constexpr (TAIL) {
#pragma unroll 1
    for (int b = tid; b < BATCH * N / 16; b += NT) {
        LAS f32x2* xb = buf + 17 * b; f32x2 x[16];
#pragma unroll
        for (int e = 0; e < 16; ++e) x[e] = xb[e];
        tail_inv(x);
#pragma unroll
        for (int e = 0; e < 16; ++e) xb[e] = x[e];
    }
    __syncthreads(); }
    constexpr int NPAD = N + N / 16, NLEV = LOG4 - 2, NP16 = NLEV / 2;
#pragma unroll 1
    for (int pass = NLEV - 1; pass >= 2 * NP16; --pass) {
        const int lq = 2 * (LOG4 - pass) - 2, q4 = 1 << lq, n = q4 << 2, tstep = TWS << (2 * pass);
        constexpr int IT = BATCH * N / 4 / NT;
        f32x2 wl[IT];
#pragma unroll
        for (int i = 0; i < IT; ++i) wl[i] = tw[((tid + i * NT) & (q4 - 1)) * tstep];
#pragma unroll
        for (int i = 0; i < IT; ++i) { const int jg = tid + i * NT, bo = (jg >> (2 * LOG4 - 2)) * NPAD, j = jg & (N / 4 - 1);
            const int blk = j >> lq, jj = j & (q4 - 1), base = blk * n + jj;
            const int i0 = bo + PADI(base), i1 = bo + PADI(base + q4), i2 = bo + PADI(base + 2 * q4), i3 = bo + PADI(base + 3 * q4);
            const f32x2 w1 = wl[i];
            const f32x2 w2 = cmul(w1, w1), w3 = cmul(w2, w1);
            f32x2 b0 = buf[i0], b1 = cmulc(buf[i1], w1), b2 = cmulc(buf[i2], w2), b3 = cmulc(buf[i3], w3);
            bfly_inv(b0, b1, b2, b3);
            buf[i0] = b0; buf[i1] = b1; buf[i2] = b2; buf[i3] = b3;
        }
        __syncthreads();
    }
#pragma unroll 1
    for (int ps = NP16 - 1; ps >= PS0; --ps) {
        const int lq4 = 2 * (LOG4 - 2 * ps) - 2, lq16 = lq4 - 2, q4 = 1 << lq4, q16 = 1 << lq16, tsA = TWS << (4 * ps), tsB = tsA << 2;
        constexpr int TOT = BATCH * N / 16, IT = (TOT + NT - 1) / NT;
#pragma unroll
        for (int i = 0; i < IT; ++i) { const int jg = tid + i * NT; if (TOT % NT != 0 && jg >= TOT) break; const int bo = (jg >> (2 * LOG4 - 4)) * NPAD, j = jg & (N / 16 - 1);
            const int blk = j >> lq16, jj = j & (q16 - 1), base = (blk << (lq4 + 2)) + jj;
            f32x2 wa[4], wb = tw[jj * tsB];
#pragma unroll
            for (int b = 0; b < 4; ++b) wa[b] = tw[(jj + b * q16) * tsA];
            f32x2 e[4][4];
#pragma unroll
            for (int a = 0; a < 4; ++a)
#pragma unroll
                for (int b = 0; b < 4; ++b) e[a][b] = buf[bo + PADI(base + b * q16 + a * q4)];
            { const f32x2 w2 = cmul(wb, wb), w3 = cmul(w2, wb);
#pragma unroll
              for (int a = 0; a < 4; ++a) { e[a][1] = cmulc(e[a][1], wb); e[a][2] = cmulc(e[a][2], w2); e[a][3] = cmulc(e[a][3], w3); bfly_inv(e[a][0], e[a][1], e[a][2], e[a][3]); } }
#pragma unroll
            for (int b = 0; b < 4; ++b) { const f32x2 w2 = cmul(wa[b], wa[b]), w3 = cmul(w2, wa[b]); e[1][b] = cmulc(e[1][b], wa[b]); e[2][b] = cmulc(e[2][b], w2); e[3][b] = cmulc(e[3][b], w3); bfly_inv(e[0][b], e[1][b], e[2][b], e[3][b]); }
#pragma unroll
            for (int a = 0; a < 4; ++a)
#pragma unroll
                for (int b = 0; b < 4; ++b) buf[bo + PADI(base + b * q16 + a * q4)] = e[a][b];
        }
        __syncthreads();
    }
}
template <int LOG4, int BATCH> __device__ __forceinline__ void fft_first_from_global(LAS f32x2* buf, const f32x2* __restrict__ tw, const f32x2* __restrict__ src, size_t src_stride, int tid) {
    constexpr int N = 1 << (2 * LOG4), TWS = 16384 / N, q4 = N / 4, q16 = N / 16, NPAD = N + N / 16, IT = BATCH * N / 16 / NT;
    static_assert(BATCH * N / 16 % NT == 0, "one or more items per thread");
#pragma unroll
    for (int i = 0; i < IT; ++i) { const int ig = tid + i * NT, bt = ig >> (2 * LOG4 - 4), jj = ig & (N / 16 - 1); const f32x2* sp = src + (size_t)bt * src_stride; LAS f32x2* bb = buf + bt * NPAD;
        f32x2 wa[4], wb = tw[jj * (TWS << 2)];
#pragma unroll
        for (int b = 0; b < 4; ++b) wa[b] = tw[(jj + b * q16) * TWS];
        f32x2 e[4][4];
#pragma unroll
        for (int b = 0; b < 4; ++b) { e[0][b] = sp[jj + b * q16]; e[1][b] = sp[jj + b * q16 + q4]; e[2][b] = (f32x2){0.f, 0.f}; e[3][b] = (f32x2){0.f, 0.f}; }
#pragma unroll
        for (int b = 0; b < 4; ++b) { bfly_fwd(e[0][b], e[1][b], e[2][b], e[3][b]); const f32x2 w2 = cmul(wa[b], wa[b]), w3 = cmul(w2, wa[b]); e[1][b] = cmul(e[1][b], wa[b]); e[2][b] = cmul(e[2][b], w2); e[3][b] = cmul(e[3][b], w3); }
        { const f32x2 w2 = cmul(wb, wb), w3 = cmul(w2, wb);
#pragma unroll
          for (int a = 0; a < 4; ++a) { bfly_fwd(e[a][0], e[a][1], e[a][2], e[a][3]); e[a][1] = cmul(e[a][1], wb); e[a][2] = cmul(e[a][2], w2); e[a][3] = cmul(e[a][3], w3); } }
#pragma unroll
        for (int a = 0; a < 4; ++a)
#pragma unroll
            for (int b = 0; b < 4; ++b) bb[PADI(jj + b * q16 + a * q4)] = e[a][b];
    }
    __syncthreads();
}
template <int LOG4> __device__ __forceinline__ void fft_last_to_global(const LAS f32x2* buf, const f32x2* __restrict__ tw, const f32x2* __restrict__ pm, bf16* Yc, int tid) {
    constexpr int N = 1 << (2 * LOG4), TWS = 16384 / N, q4 = N / 4, q16 = N / 16, IT = N / 16 / NT;
#pragma unroll
    for (int i = 0; i < IT; ++i) { const int jj = tid + i * NT;
        f32x2 wa[4], wb = tw[jj * (TWS << 2)];
#pragma unroll
        for (int b = 0; b < 4; ++b) wa[b] = tw[(jj + b * q16) * TWS];
        f32x2 pmv[2][4];
#pragma unroll
        for (int a = 0; a < 2; ++a)
#pragma unroll
            for (int b = 0; b < 4; ++b) pmv[a][b] = pm[jj + b * q16 + a * q4];
        f32x2 e[4][4];
#pragma unroll
        for (int a = 0; a < 4; ++a)
#pragma unroll
            for (int b = 0; b < 4; ++b) e[a][b] = buf[PADI(jj + b * q16 + a * q4)];
        { const f32x2 w2 = cmul(wb, wb), w3 = cmul(w2, wb);
#pragma unroll
          for (int a = 0; a < 4; ++a) { e[a][1] = cmulc(e[a][1], wb); e[a][2] = cmulc(e[a][2], w2); e[a][3] = cmulc(e[a][3], w3); bfly_inv(e[a][0], e[a][1], e[a][2], e[a][3]); } }
#pragma unroll
        for (int b = 0; b < 4; ++b) { const f32x2 w2 = cmul(wa[b], wa[b]), w3 = cmul(w2, wa[b]); e[1][b] = cmulc(e[1][b], wa[b]); e[2][b] = cmulc(e[2][b], w2); e[3][b] = cmulc(e[3][b], w3); bfly_inv(e[0][b], e[1][b], e[2][b], e[3][b]); }
#pragma unroll
        for (int a = 0; a < 2; ++a)
#pragma unroll
            for (int b = 0; b < 4; ++b) { const int t = jj + b * q16 + a * q4; *(unsigned*)(Yc + (size_t)t * 512) = cvtpk(e[a][b].x * pmv[a][b].x, e[a][b].y * pmv[a][b].y); }
    }
}
__device__ const double ROPE_IF[16] = {1.0, 0.5623413251903491, 0.31622776601683794, 0.1778279410038923, 0.1, 0.05623413251903491, 0.03162277660168379, 0.01778279410038923,
    0.01, 0.005623413251903491, 0.0031622776601683794, 0.0017782794100389228, 0.001, 0.0005623413251903491, 0.00031622776601683794, 0.00017782794100389227};
struct Chunk { int tok0, L, nseq; };
__device__ __forceinline__ Chunk chunk_of(int c) { Chunk k; k.tok0 = c * CH; if (c < NCH_P) { k.L = LP; k.nseq = CH / LP; } else { k.L = LS; k.nseq = CH / LS; } return k; }
__device__ __forceinline__ const float* xin_rows(const AV& a, int tok0) { return tok0 < NTOK_P ? AIN(I_XP) + (size_t)tok0 * DM : AIN(I_XS) + (size_t)(tok0 - NTOK_P) * DM; }
__device__ __forceinline__ void hf_group(LAS float* sm, const AV& a, int layer, int L, int t0, float* hf, int tid) {
    LAS float* zs = sm; LAS float* A = sm + 512; LAS float* B = sm + 1024;
    const float* w1 = AIN(I_FW1) + layer * 33 * 64; const float* b1 = AIN(I_FB1) + layer * 64;
    const float* w2 = AIN(I_FW2) + layer * 2 * 64 * 64; const float* b2 = AIN(I_FB2) + layer * 2 * 64;
    const float* wo = AIN(I_FWOUT) + layer * 64 * 1024; const float* fr = AIN(I_FFREQ) + layer * 64;
    const int tt = tid >> 6, j = tid & 63, t = t0 + tt;
    const float t01 = (float)t / (float)(L - 1);
    if (j < 33) {
        float v;
        if (j == 0) v = t01;
        else { const int k = (j - 1) & 15; const double f = kd(1e-4) + (double)k * kd((15.0 - 1e-4) / 15.0); float s, c; sincos_rev(f * (double)t / (double)L, s, c); v = (j <= 16) ? c : -s; }
        zs[tt * 40 + j] = v;
    }
    __syncthreads();
    const float fq = fr[j];
    { float acc = b1[j]; for (int i = 0; i < 33; ++i) acc += zs[tt * 40 + i] * w1[i * 64 + j]; A[tt * 64 + j] = sin_acc(fq * acc); }
    __syncthreads();
    { float acc = b2[j]; for (int i = 0; i < 64; ++i) acc += A[tt * 64 + i] * w2[i * 64 + j]; B[tt * 64 + j] = sin_acc(fq * acc); }
    __syncthreads();
    { float acc = b2[64 + j]; for (int i = 0; i < 64; ++i) acc += B[tt * 64 + i] * w2[4096 + i * 64 + j]; A[tt * 64 + j] = sin_acc(fq * acc); }
    __syncthreads();
    { float acc0[8], acc1[8];
#pragma unroll
      for (int q = 0; q < 8; ++q) { acc0[q] = 0.f; acc1[q] = 0.f; }
#pragma unroll 8
      for (int i = 0; i < 64; ++i) { const float wa = wo[i * 1024 + tid], wb = wo[i * 1024 + 512 + tid];
#pragma unroll
          for (int q = 0; q < 8; ++q) { const float av = A[q * 64 + i]; acc0[q] += av * wa; acc1[q] += av * wb; } }
      const float ad = 3.070113457325394f + (float)tid * ((15.350567286626973f - 3.070113457325394f) / 511.0f);
#pragma unroll
      for (int q = 0; q < 8; ++q) { const float tq = (float)(t0 + q) / (float)(L - 1); const float win = __expf(-tq * ad);
          hf[(size_t)(t0 + q) * 1024 + tid] = acc0[q] * win; hf[(size_t)(t0 + q) * 1024 + 512 + tid] = acc1[q] * win; } }
    __syncthreads();
}
__device__ __forceinline__ void step_pro_a(const AV& a, LAS unsigned char* lds) {
    const int tid = ltid(), lane = tid & 63, wave = tid >> 6, G = gridDim.x;
    unsigned char* ws = AWS;
    { f32x2* tw = (f32x2*)(ws + WS_TW); for (int m = lbid() * NT + tid; m < 16384; m += G * NT) { float s, c; sincos_rev((double)m / 16384.0, s, c); tw[m] = (f32x2){c, -s}; } }
    { f32x2* rt = (f32x2*)(ws + WS_ROPE);
      for (int e = lbid() * NT + tid; e < 8192 * 32; e += G * NT) { const int pos = e >> 5, i = e & 31; const int pp = (i < 16) ? (pos >> 6) : (pos & 63);
          const double inv = ROPE_IF[i & 15]; float sn, cs; sincos_rev((double)pp * inv * 0.15915494309189533577, sn, cs); rt[e] = (f32x2){cs, sn}; } }
    { const float* g = AIN(I_NORMG); bf16* HN0 = (bf16*)(ws + WS_HN0); f32x4 gv[4];
#pragma unroll
      for (int j = 0; j < 4; ++j) gv[j] = *((const f32x4*)g + lane + 64 * j);
      for (int m = lbid() * NWAVES + wave; m < NTOK; m += G * NWAVES) {
          const f32x4* xr = (const f32x4*)(xin_rows(a, m)) + lane; f32x4 v[4]; float ssum = 0.f;
#pragma unroll
          for (int j = 0; j < 4; ++j) { v[j] = xr[64 * j]; ssum += (v[j].x * v[j].x + v[j].y * v[j].y) + (v[j].z * v[j].z + v[j].w * v[j].w); }
          const float rs = 1.0f / sqrtf(wave_sum(ssum) * (1.0f / DM) + EPS);
          u32x2* o8 = (u32x2*)(HN0 + (size_t)m * DM) + lane;
#pragma unroll
          for (int j = 0; j < 4; ++j) { u32x2 w; w.x = pk2(v[j].x * rs * gv[j].x, v[j].y * rs * gv[j].y); w.y = pk2(v[j].z * rs * gv[j].z, v[j].w * rs * gv[j].w); o8[64 * j] = w; } } }
    { LAS float* scr = (LAS float*)(lds + wave * 16384);
      constexpr int I_IN = 16 * (UP / 32), I_MG = 16 * (GP / 32), I_BR = 8 * 32, I_OU = 16 * 32, PER = I_IN + I_MG + 3 * I_BR + I_OU;
      for (int it = lbid() * NWAVES + wave; it < 2 * PER; it += G * NWAVES) {
          const int l = it / PER; int r = it - l * PER;
          bf16* wcat = (bf16*)(ws + WS_WCAT + l * WCAT_BYTES); bf16* wbt = (bf16*)(ws + WS_WBT + l * WBT_BYTES); bf16* wot = (bf16*)(ws + WS_WOT + l * WOT_BYTES);
          if (r < I_IN) { transpose_item(AIN(I_WIN) + (size_t)l * 1024 * UP, 1024, UP, wcat, 0, scr, r, lane); continue; } r -= I_IN;
          if (r < I_MG) { transpose_item(AIN(I_WMERGE) + (size_t)l * 1024 * GP, 1024, GP, wcat, UP, scr, r, lane); continue; } r -= I_MG;
          if (r < I_BR) { transpose_item(AIN(I_WBHY) + (size_t)l * 512 * 1024, 512, 1024, wbt, 0, scr, r, lane); continue; } r -= I_BR;
          if (r < I_BR) { transpose_item(AIN(I_WBGQ) + (size_t)l * 512 * 1024, 512, 1024, wbt, 1024, scr, r, lane); continue; } r -= I_BR;
          if (r < I_BR) { transpose_item(AIN(I_WBDF) + (size_t)l * 512 * 1024, 512, 1024, wbt, 2048, scr, r, lane); continue; } r -= I_BR;
          transpose_item(AIN(I_WOUT) + (size_t)l * 1024 * 1024, 1024, 1024, wot, 0, scr, r, lane);
      } }
}
__device__ __forceinline__ void step_pro_a2(const AV& a, LAS unsigned char* lds) {
    const int tid = ltid(), G = gridDim.x; unsigned char* ws = AWS;
    { constexpr int GPL = LP / 8 + LS / 8;
      for (int g = lbid(); g < 2 * GPL; g += G) { const int l = g / GPL; int r = g - l * GPL;
          float* hfp = (float*)(ws + WS_HF + l * (HF_P_BYTES + HF_S_BYTES));
          if (r < LP / 8) hf_group((LAS float*)lds, a, l, LP, r * 8, hfp, tid);
          else hf_group((LAS float*)lds, a, l, LS, (r - LP / 8) * 8, (float*)((unsigned char*)hfp + HF_P_BYTES), tid); } }
}
template <int LOG4> __device__ __forceinline__ void filt_unit(const AV& a, LAS unsigned char* lds, int layer, int pr, const float* hf, f32x2* Pg, f32x2* Mg) {
    constexpr int N = 1 << (2 * LOG4), L = N / 2;
    const int tid = ltid(); LAS f32x2* buf = (LAS f32x2*)lds; const int c0 = 2 * pr;
    for (int n = tid; n < N; n += NT) { f32x2 v = (f32x2){0.f, 0.f};
        if (n < L) v = *(const f32x2*)(hf + (size_t)n * 1024 + c0); else if (n > L) v = *(const f32x2*)(hf + (size_t)(N - n) * 1024 + 512 + c0);
        buf[PADI(n)] = v; }
    __syncthreads();
    fft_fwd<LOG4>(buf, (const f32x2*)(AWS + WS_TW), tid);
    const float ba = AIN(I_HYBIAS)[layer * 512 + c0], bb = AIN(I_HYBIAS)[layer * 512 + c0 + 1]; const float sc = 1.0f / (float)N;
    for (int k = tid; k <= L; k += NT) { const int q1 = digitrev<LOG4>(k), q2 = digitrev<LOG4>((N - k) & (N - 1)); const f32x2 z1 = buf[PADI(q1)], z2 = buf[PADI(q2)];
        f32x2 ca = (f32x2){0.5f * (z1.x + z2.x), 0.5f * (z1.y - z2.y)}; const float dx = z1.x - z2.x, dy = z1.y + z2.y; f32x2 cb = (f32x2){0.5f * dy, -0.5f * dx};
        ca.x += ba; cb.x += bb;
        const int slot = (k == L) ? L : digitrev<LOG4 - 2>(k & (N / 16 - 1)) * 8 + (k >> (2 * LOG4 - 4));
        Pg[slot] = (f32x2){0.5f * sc * (ca.x + cb.x), 0.5f * sc * (ca.y + cb.y)}; Mg[slot] = (f32x2){0.5f * sc * (ca.x - cb.x), 0.5f * sc * (ca.y - cb.y)}; }
    __syncthreads();
}
__device__ __forceinline__ void step_pro_b(const AV& a, LAS unsigned char* lds) {
    for (int u = lbid(); u < 1024; u += gridDim.x) { const int l = u >> 9, r = u & 511; unsigned char* sp = AWS + WS_SPEC + l * SPEC_LAYER; const float* hfp = (const float*)(AWS + WS_HF + l * (HF_P_BYTES + HF_S_BYTES));
        if (r < 256) filt_unit<7>(a, lds, l, r, hfp, (f32x2*)sp + (size_t)r * SPS_P, (f32x2*)(sp + SPEC_P_BYTES) + (size_t)r * SPS_P);
        else { const int pr = r - 256; filt_unit<6>(a, lds, l, pr, (const float*)((const unsigned char*)hfp + HF_P_BYTES), (f32x2*)(sp + 2 * SPEC_P_BYTES) + (size_t)pr * SPS_S, (f32x2*)(sp + 2 * SPEC_P_BYTES + SPEC_S_BYTES) + (size_t)pr * SPS_S); } }
}
__device__ __forceinline__ void step_norm(const AV& a, int c, int layer) {
    const int tid = ltid(), lane = tid & 63, wave = tid >> 6; const Chunk ck = chunk_of(c);
    const float* X = layer == 0 ? xin_rows(a, ck.tok0) : AOUT + (size_t)ck.tok0 * DM; bf16* HN = (bf16*)(AWS + WS_HN); const float* g = AIN(I_NORMG) + layer * DM;
    f32x4 gv[4];
#pragma unroll
    for (int j = 0; j < 4; ++j) gv[j] = *((const f32x4*)g + lane + 64 * j);
    for (int m = lbid() * NWAVES + wave; m < CH; m += gridDim.x * NWAVES) {
        const f32x4* xr = (const f32x4*)(X + (size_t)m * DM) + lane; f32x4 v[4]; float s = 0.f;
#pragma unroll
        for (int j = 0; j < 4; ++j) { v[j] = xr[64 * j]; s += (v[j].x * v[j].x + v[j].y * v[j].y) + (v[j].z * v[j].z + v[j].w * v[j].w); }
        const float rs = 1.0f / sqrtf(wave_sum(s) * (1.0f / DM) + EPS);
        u32x2* o8 = (u32x2*)(HN + (size_t)m * DM) + lane;
#pragma unroll
        for (int j = 0; j < 4; ++j) { u32x2 w; w.x = pk2(v[j].x * rs * gv[j].x, v[j].y * rs * gv[j].y); w.y = pk2(v[j].z * rs * gv[j].z, v[j].w * rs * gv[j].w); o8[64 * j] = w; }
    }
}
__device__ __forceinline__ void step_final(const AV& a, int row0, int row1) {
    const int tid = ltid(), lane = tid & 63, wave = tid >> 6; const float* g = AIN(I_FINALG);
    f32x4 gv[4];
#pragma unroll
    for (int j = 0; j < 4; ++j) gv[j] = *((const f32x4*)g + lane + 64 * j);
    for (int m = row0 + lbid() * NWAVES + wave; m < row1; m += gridDim.x * NWAVES) {
        f32x4* xr = (f32x4*)(AOUT + (size_t)m * DM) + lane; f32x4 v[4]; float s = 0.f;
#pragma unroll
        for (int j = 0; j < 4; ++j) { v[j] = xr[64 * j]; s += (v[j].x * v[j].x + v[j].y * v[j].y) + (v[j].z * v[j].z + v[j].w * v[j].w); }
        const float rs = 1.0f / sqrtf(wave_sum(s) * (1.0f / DM) + EPS);
#pragma unroll
        for (int j = 0; j < 4; ++j) xr[64 * j] = v[j] * rs * gv[j];
    }
}
__device__ __forceinline__ void step_prep(const AV& a, int c, int layer) {
    const Chunk ck = chunk_of(c); bf16* U = (bf16*)(AWS + WS_U);
    for (int it = lbid() * NT + ltid(); it < CH * 10; it += gridDim.x * NT) {
        const int tok = it / 10, hd = it - tok * 10; const int pos = tok & (ck.L - 1);
        bf16* p = U + (size_t)tok * UP + (hd < 8 ? C_GQ + 64 * hd : C_GK + 64 * (hd - 8));
        const float* g = (hd < 8 ? AIN(I_QNG) : AIN(I_KNG)) + layer * 64;
        float x[64];
#pragma unroll
        for (int i = 0; i < 8; ++i) { const u32x4 w = *((const u32x4*)p + i);
            x[8 * i + 0] = bflo(w.x); x[8 * i + 1] = bfhi(w.x); x[8 * i + 2] = bflo(w.y); x[8 * i + 3] = bfhi(w.y); x[8 * i + 4] = bflo(w.z); x[8 * i + 5] = bfhi(w.z); x[8 * i + 6] = bflo(w.w); x[8 * i + 7] = bfhi(w.w); }
        float ss = 0.f;
#pragma unroll
        for (int i = 0; i < 64; ++i) ss += x[i] * x[i];
        const float rs = (1.0f / sqrtf(ss * (1.0f / 64.0f) + EPS)) * (hd < 8 ? 0.125f * LOG2E : 1.0f);
#pragma unroll
        for (int i = 0; i < 64; ++i) x[i] = x[i] * rs * g[i];
        const f32x4* rt = (const f32x4*)(AWS + WS_ROPE) + (size_t)pos * 16;
#pragma unroll
        for (int i2 = 0; i2 < 16; ++i2) { const f32x4 cs2 = rt[i2];
#pragma unroll
            for (int e = 0; e < 2; ++e) { const int i = 2 * i2 + e; const float cs = e ? cs2.z : cs2.x, sn = e ? cs2.w : cs2.y; const float x1 = x[i], x2 = x[i + 32]; x[i] = x1 * cs - x2 * sn; x[i + 32] = x2 * cs + x1 * sn; } }
#pragma unroll
        for (int i = 0; i < 8; ++i) { u32x4 w; w.x = pk2(x[8 * i], x[8 * i + 1]); w.y = pk2(x[8 * i + 2], x[8 * i + 3]); w.z = pk2(x[8 * i + 4], x[8 * i + 5]); w.w = pk2(x[8 * i + 6], x[8 * i + 7]); *((u32x4*)p + i) = w; }
    }
}
__device__ __forceinline__ void step_prep_hy(const AV& a, LAS unsigned char* lds, int c, int layer) {
    const Chunk ck = chunk_of(c); const bf16* U = (const bf16*)(AWS + WS_U);
    f32x2* HVP = (f32x2*)(AWS + WS_HVP); f32x2* PMP = (f32x2*)(AWS + WS_PMP);
    const int tid = ltid(), lane = tid & 63, wave = tid >> 6;
    LAS f32x2* th = (LAS f32x2*)(lds + wave * 17408); LAS f32x2* tp = th + 64 * 17;
    const float* cw = AIN(I_CONVW) + layer * 3 * 1536; const float* cb = AIN(I_CONVB) + layer * 1536;
    for (int it = lbid() * NWAVES + wave; it < (CH / 16) * 4; it += gridDim.x * NWAVES) {
        const int cbk = it & 3, tg = it >> 2, t0 = tg * 16, ch = cbk * 128 + 2 * lane;
        const int pos0 = t0 & (ck.L - 1);
        float w[3][3][2], bb[3][2];
#pragma unroll
        for (int ar = 0; ar < 3; ++ar) {
#pragma unroll
            for (int j = 0; j < 3; ++j) { const f32x2 v = *(const f32x2*)(cw + j * 1536 + ar * 512 + ch); w[ar][j][0] = v.x; w[ar][j][1] = v.y; }
            const f32x2 v = *(const f32x2*)(cb + ar * 512 + ch); bb[ar][0] = v.x; bb[ar][1] = v.y; }
        const bf16* r0 = U + (size_t)t0 * UP + ch;
        unsigned pv[3], cv[3], nv[3];
#pragma unroll
        for (int ar = 0; ar < 3; ++ar) { pv[ar] = pos0 > 0 ? *(const unsigned*)(r0 - UP + ar * 512) : 0u; cv[ar] = *(const unsigned*)(r0 + ar * 512); }
#pragma unroll 4
        for (int t = 0; t < 16; ++t) {
            const bf16* rt = r0 + (size_t)t * UP; const bool last = (pos0 + t + 1 >= ck.L);
#pragma unroll
            for (int ar = 0; ar < 3; ++ar) nv[ar] = last ? 0u : *(const unsigned*)(rt + UP + ar * 512);
            const unsigned gw = *(const unsigned*)(rt + C_HG);
            float o[3][2];
#pragma unroll
            for (int ar = 0; ar < 3; ++ar) { o[ar][0] = w[ar][0][0] * bflo(pv[ar]) + w[ar][1][0] * bflo(cv[ar]) + w[ar][2][0] * bflo(nv[ar]) + bb[ar][0];
                o[ar][1] = w[ar][0][1] * bfhi(pv[ar]) + w[ar][1][1] * bfhi(cv[ar]) + w[ar][2][1] * bfhi(nv[ar]) + bb[ar][1]; pv[ar] = cv[ar]; cv[ar] = nv[ar]; }
            th[lane * 17 + t] = (f32x2){o[2][0] * o[1][0], o[2][1] * o[1][1]};
            tp[lane * 17 + t] = (f32x2){o[0][0] * silu(bflo(gw)), o[0][1] * silu(bfhi(gw))};
        }
        asm volatile("s_waitcnt lgkmcnt(0)" ::: "memory");
#pragma unroll 4
        for (int i = 0; i < 16; ++i) { const int pl = 4 * i + (lane >> 4), tt = lane & 15; const size_t o = (size_t)(cbk * 64 + pl) * CH + t0 + tt;
            HVP[o] = th[pl * 17 + tt]; PMP[o] = tp[pl * 17 + tt]; }
        asm volatile("s_waitcnt lgkmcnt(0)" ::: "memory");
    }
}
typedef short bf16x8 __attribute__((ext_vector_type(8)));
typedef short s16x4 __attribute__((ext_vector_type(4)));
typedef float f32x16 __attribute__((ext_vector_type(16)));
typedef float f32x2_t __attribute__((ext_vector_type(2)));
typedef __bf16 bf16x2_t __attribute__((ext_vector_type(2)));
__device__ __forceinline__ unsigned cvtpk(float lo, float hi) { f32x2_t v = {lo, hi}; bf16x2_t b = __builtin_convertvector(v, bf16x2_t); return __builtin_bit_cast(unsigned, b); }
__device__ __forceinline__ int crow(int r, int hi) { return (r & 3) + 8 * (r >> 2) + 4 * hi; }
__device__ __forceinline__ s16x4 vtr(const LAS unsigned char* p) { return __builtin_bit_cast(s16x4, __builtin_amdgcn_ds_read_tr16_b64_v4i16((LAS s16x4*)p)); }
constexpr int ATT_K = 0;
constexpr int ATT_TB_DIFF = 4 * 8192 + 4 * 16384;
constexpr float C1 = 0.125f * LOG2E;
__device__ __forceinline__ void glds16(const void* gsrc, unsigned lds_dst) { unsigned keep;
    asm volatile("s_mov_b32 %0, m0\n\ts_mov_b32 m0, %2\n\ts_nop 0\n\tglobal_load_lds_dwordx4 %1, off\n\ts_mov_b32 m0, %0" : "=&s"(keep) : "v"(gsrc), "s"(lds_dst) : "memory"); }

template <int VD, bool BIAS, bool OMAX, int G>
__device__ __forceinline__ void flash_pass(LAS unsigned char* lds, const bf16* Qrow, const bf16* Kg, const bf16* Vg, int L, int qpos, int qw0, float bl, float br, f32x16 (&o)[VD / 32], float& l_out) {
    const int tid = ltid(), lane = tid & 63, r32 = lane & 31, hi = lane >> 5;
    constexpr int VROW = VD * 2, VT = 64 * VROW, NVL = VD / 64, NSL = 2 * G, ATT_V = NSL * 8192, ATT_TB = ATT_V + NSL * VT;
    const LAS float* tb = (const LAS float*)(lds + ATT_TB);
    typedef const __attribute__((address_space(1))) u32x4* g4p;
    const int wv = __builtin_amdgcn_readfirstlane(tid >> 6); const int ldsa = (int)(unsigned)(uintptr_t)lds;
    const bf16* ksrc; { const int X = wv * 1024 + lane * 16, line = X >> 8, c16 = ((X >> 4) & 15) ^ (line & 15), key = 2 * line + (c16 >> 3), ch = c16 & 7; ksrc = Kg + (size_t)key * UP + ch * 8; }
    const bf16* vsrc[NVL];
#pragma unroll
    for (int i = 0; i < NVL; ++i) { const int X = i * 8192 + wv * 1024 + lane * 16; const int key = (VD == 64) ? (X >> 7) : (X >> 8), posb = (VD == 64) ? (X & 127) : (X & 255);
        const int swz = (VD == 64) ? (((key >> 1) & 1) << 6) : ((key & 3) << 6); vsrc[i] = Vg + (size_t)key * UP + ((posb ^ swz) >> 1); }
#define ATT_DMA(tt_, sl_) do { const size_t go_ = (size_t)(tt_) * 64 * UP; \
        glds16(ksrc + go_, (unsigned)__builtin_amdgcn_readfirstlane(ldsa + ATT_K + (sl_) * 8192 + wv * 1024)); \
        _Pragma("unroll") for (int i_ = 0; i_ < NVL; ++i_) glds16(vsrc[i_] + go_, (unsigned)__builtin_amdgcn_readfirstlane(ldsa + ATT_V + (sl_) * VT + i_ * 8192 + wv * 1024)); } while (0)
#define ATT_DMAGROUP(g_) do { _Pragma("unroll") for (int j_ = 0; j_ < G; ++j_) { const int tt_ = (g_) * G + j_; ATT_DMA(tt_, tt_ & (NSL - 1)); } } while (0)
#define ATT_BAR() do { __builtin_amdgcn_s_barrier(); asm volatile("" ::: "memory"); } while (0)
    int koff[2][4];
#pragma unroll
    for (int kb = 0; kb < 2; ++kb)
#pragma unroll
        for (int s = 0; s < 4; ++s) { const int key = 32 * kb + r32, line = key >> 1, c16 = ((key & 1) << 3) | (2 * s + hi); koff[kb][s] = line * 256 + ((c16 ^ (line & 15)) << 4); }
    const int q4 = (lane & 15) >> 2, p4 = lane & 3, g1 = (lane >> 4) & 1;
    const int vsw = (VD == 64) ? ((q4 >> 1) & 1) : q4;
    const int vbase = (4 * hi + q4) * VROW + 32 * g1 + 8 * p4;
    bf16x8 qf[4];
#pragma unroll
    for (int s = 0; s < 4; ++s) qf[s] = __builtin_bit_cast(bf16x8, *(g4p)(Qrow + 16 * s + 8 * hi));
    float m_run = OMAX ? -1e30f : 0.f, l_run = 0.f;
    const int nt = L >> 6;
    asm volatile("" :: "v"(qf[0]), "v"(qf[1]), "v"(qf[2]), "v"(qf[3]) : "memory");
    asm volatile("s_waitcnt vmcnt(0)" ::: "memory");
    const int ng = nt / G;
    ATT_DMAGROUP(0); if (ng > 1) ATT_DMAGROUP(1);
    if (ng > 1) { if (G * (1 + NVL) == 8) asm volatile("s_waitcnt vmcnt(8)" ::: "memory"); else asm volatile("s_waitcnt vmcnt(6)" ::: "memory"); } else asm volatile("s_waitcnt vmcnt(0)" ::: "memory");
    static_assert(G * (1 + NVL) == 8 || G * (1 + NVL) == 6, "vmcnt immediates above");
    ATT_BAR();
#pragma unroll 1
    for (int t = 0; t < nt; ++t) {
        const int cur = t & (NSL - 1);
        const LAS unsigned char* kbuf = lds + ATT_K + cur * 8192; const LAS unsigned char* vbuf = lds + ATT_V + cur * VT;
        f32x16 p[2];
        { bf16x8 kf[2][4];
#pragma unroll
          for (int kb = 0; kb < 2; ++kb)
#pragma unroll
            for (int s = 0; s < 4; ++s) kf[kb][s] = *(const LAS bf16x8*)(kbuf + koff[kb][s]);
          __builtin_amdgcn_sched_barrier(0);
#pragma unroll
          for (int kb = 0; kb < 2; ++kb) { f32x16 acc;
#pragma unroll
            for (int r = 0; r < 16; ++r) acc[r] = 0.f;
#pragma unroll
            for (int s = 0; s < 4; ++s) acc = __builtin_amdgcn_mfma_f32_32x32x16_bf16(kf[kb][s], qf[s], acc, 0, 0, 0);
            p[kb] = acc; } }
        s16x4 vlo[2][4], vhi[2][4];
#define VREAD(buf_, db_) do { const int cofs_ = (((db_) ^ vsw) << 6); _Pragma("unroll") for (int kb = 0; kb < 2; ++kb) _Pragma("unroll") for (int ss = 0; ss < 2; ++ss) { \
            const LAS unsigned char* vp_ = vbuf + vbase + (32 * kb + 16 * ss) * VROW + cofs_; vlo[buf_][2 * kb + ss] = vtr(vp_); vhi[buf_][2 * kb + ss] = vtr(vp_ + 8 * VROW); } } while (0)
        VREAD(0, 0);
        __builtin_amdgcn_sched_barrier(0);
        const int k0 = t * 64; float mulc, bconst, mx = -3e38f; bool nearT = false;
        const bool domax = (t & 7) == 0;
        if (BIAS) { const int rlo = k0 - qw0 - 31, rhi = k0 + 63 - qw0; nearT = !(rhi <= -128 || rlo >= 128); }
        if (BIAS && nearT) {
#pragma unroll
            for (int kb = 0; kb < 2; ++kb)
#pragma unroll
                for (int r4 = 0; r4 < 4; ++r4) {
#pragma unroll
                    for (int e = 0; e < 4; ++e) { const int r = 4 * r4 + e; int rel = k0 + 32 * kb + crow(r, hi) - qpos; rel = rel < -128 ? -128 : (rel > 128 ? 128 : rel); const float v = p[kb][r] * C1 + tb[rel + 128]; p[kb][r] = v; mx = fmaxf(mx, v); }
                    __builtin_amdgcn_sched_barrier(0); }
            mulc = 1.0f; bconst = 0.f;
        } else {
            if (OMAX && domax) {
#pragma unroll
                for (int kb = 0; kb < 2; ++kb)
#pragma unroll
                    for (int r = 0; r < 16; ++r) mx = fmaxf(mx, p[kb][r]); }
            bconst = BIAS ? (k0 < qw0 ? bl : br) : 0.f; mx = mx * C1 + bconst; mulc = C1;
        }
        if (OMAX && (domax || (BIAS && nearT))) {
            mx = fmaxf(mx, shx(mx, 32));
            if (__any(mx > m_run)) { const float mn = fmaxf(m_run, mx), al = __builtin_amdgcn_exp2f(m_run - mn); l_run *= al;
#pragma unroll
                for (int db = 0; db < VD / 32; ++db) o[db] *= al;
                m_run = mn; }
        }
        const f32x2 mul2 = (f32x2){mulc, mulc}, add2 = (f32x2){bconst - m_run, bconst - m_run}; f32x2 ls2 = (f32x2){0.f, 0.f};
#pragma unroll
        for (int kb = 0; kb < 2; ++kb)
#pragma unroll
            for (int r = 0; r < 16; r += 2) { f32x2 v = (f32x2){p[kb][r], p[kb][r + 1]}; v = v * mul2 + add2; f32x2 e; e.x = __builtin_amdgcn_exp2f(v.x); e.y = __builtin_amdgcn_exp2f(v.y); ls2 += e; p[kb][r] = e.x; p[kb][r + 1] = e.y; }
        l_run += ls2.x + ls2.y;
        bf16x8 pk[2][2];
#pragma unroll
        for (int kb = 0; kb < 2; ++kb)
#pragma unroll
            for (int ss = 0; ss < 2; ++ss) { u32x4 w; w.x = cvtpk(p[kb][8 * ss + 0], p[kb][8 * ss + 1]); w.y = cvtpk(p[kb][8 * ss + 2], p[kb][8 * ss + 3]); w.z = cvtpk(p[kb][8 * ss + 4], p[kb][8 * ss + 5]); w.w = cvtpk(p[kb][8 * ss + 6], p[kb][8 * ss + 7]);
                pk[kb][ss] = __builtin_bit_cast(bf16x8, w); }
        __builtin_amdgcn_sched_barrier(0);
#pragma unroll
        for (int db = 0; db < VD / 32; ++db) {
            if (db + 1 < VD / 32) { if ((db + 1) & 1) VREAD(1, db + 1); else VREAD(0, db + 1); }
#pragma unroll
            for (int kb = 0; kb < 2; ++kb)
#pragma unroll
                for (int ss = 0; ss < 2; ++ss) { const bf16x8 vf = (db & 1) ? __builtin_shufflevector(vlo[1][2 * kb + ss], vhi[1][2 * kb + ss], 0, 1, 2, 3, 4, 5, 6, 7) : __builtin_shufflevector(vlo[0][2 * kb + ss], vhi[0][2 * kb + ss], 0, 1, 2, 3, 4, 5, 6, 7);
                    o[db] = __builtin_amdgcn_mfma_f32_32x32x16_bf16(vf, pk[kb][ss], o[db], 0, 0, 0); }
            __builtin_amdgcn_sched_barrier(0); }
#undef VREAD
        if (((t + 1) & (G - 1)) == 0) {
            asm volatile("s_waitcnt vmcnt(0)" ::: "memory"); ATT_BAR();
            const int g2 = (t + 1) / G + 1; if (g2 < ng) ATT_DMAGROUP(g2); }
    }
#undef ATT_DMA
#undef ATT_DMAGROUP
#undef ATT_BAR
    l_out = l_run + shx(l_run, 32);
}
__device__ __forceinline__ void gqa_unit(const AV& a, LAS unsigned char* lds, int seqrow0, int L, int h, int qb) {
    const int tid = ltid(), lane = tid & 63, r32 = lane & 31, hi = lane >> 5;
    const bf16* U = (const bf16*)(AWS + WS_U); bf16* Y = (bf16*)(AWS + WS_Y) + (size_t)1 * CH * 512;
    constexpr int G = 4, NSL = 2 * G, VROW = 128, VT = 8192, ATT_V = NSL * 8192;
    typedef const __attribute__((address_space(1))) u32x4* g4p;
    const int wv = __builtin_amdgcn_readfirstlane(tid >> 6); const int ldsa = (int)(unsigned)(uintptr_t)lds;
    const int qw0 = qb * 512 + wv * 64;
    const bf16* Kg = U + (size_t)seqrow0 * UP + C_GK + 64 * (h >> 2); const bf16* Vg = U + (size_t)seqrow0 * UP + C_GV + 64 * (h >> 2);
    const bf16* ksrc; { const int X = wv * 1024 + lane * 16, line = X >> 8, c16 = ((X >> 4) & 15) ^ (line & 15), key = 2 * line + (c16 >> 3), ch = c16 & 7; ksrc = Kg + (size_t)key * UP + ch * 8; }
    const bf16* vsrc; { const int X = wv * 1024 + lane * 16, key = X >> 7, posb = X & 127, swz = ((key >> 1) & 1) << 6; vsrc = Vg + (size_t)key * UP + ((posb ^ swz) >> 1); }
#define GQ_DMA(tt_, sl_) do { const size_t go_ = (size_t)(tt_) * 64 * UP; \
        glds16(ksrc + go_, (unsigned)__builtin_amdgcn_readfirstlane(ldsa + ATT_K + (sl_) * 8192 + wv * 1024)); \
        glds16(vsrc + go_, (unsigned)__builtin_amdgcn_readfirstlane(ldsa + ATT_V + (sl_) * VT + wv * 1024)); } while (0)
#define GQ_DMAGROUP(g_) do { _Pragma("unroll") for (int j_ = 0; j_ < G; ++j_) { const int tt_ = (g_) * G + j_; GQ_DMA(tt_, tt_ & (NSL - 1)); } } while (0)
#define GQ_BAR() do { __builtin_amdgcn_s_barrier(); asm volatile("" ::: "memory"); } while (0)
    int koff[2][4];
#pragma unroll
    for (int kb = 0; kb < 2; ++kb)
#pragma unroll
        for (int s = 0; s < 4; ++s) { const int key = 32 * kb + r32, line = key >> 1, c16 = ((key & 1) << 3) | (2 * s + hi); koff[kb][s] = line * 256 + ((c16 ^ (line & 15)) << 4); }
    const int q4 = (lane & 15) >> 2, p4 = lane & 3, g1 = (lane >> 4) & 1;
    const int vsw = (q4 >> 1) & 1;
    const int vbase = (4 * hi + q4) * VROW + 32 * g1 + 8 * p4;
    bf16x8 qf[2][4];
#pragma unroll
    for (int j = 0; j < 2; ++j)
#pragma unroll
        for (int s = 0; s < 4; ++s) qf[j][s] = __builtin_bit_cast(bf16x8, *(g4p)(U + (size_t)(seqrow0 + qw0 + 32 * j + r32) * UP + C_GQ + 64 * h + 16 * s + 8 * hi));
    f32x16 o[2][2];
#pragma unroll
    for (int j = 0; j < 2; ++j)
#pragma unroll
        for (int db = 0; db < 2; ++db)
#pragma unroll
            for (int r = 0; r < 16; ++r) o[j][db][r] = 0.f;
    float lrun[2] = {0.f, 0.f};
    const int nt = L >> 6, ng = nt / G;
    asm volatile("" :: "v"(qf[0][0]), "v"(qf[0][1]), "v"(qf[0][2]), "v"(qf[0][3]), "v"(qf[1][0]), "v"(qf[1][1]), "v"(qf[1][2]), "v"(qf[1][3]) : "memory");
    asm volatile("s_waitcnt vmcnt(0)" ::: "memory");
    GQ_DMAGROUP(0); if (ng > 1) GQ_DMAGROUP(1);
    if (ng > 1) asm volatile("s_waitcnt vmcnt(8)" ::: "memory"); else asm volatile("s_waitcnt vmcnt(0)" ::: "memory");
    GQ_BAR();
#pragma unroll 1
    for (int t = 0; t < nt; ++t) {
        const int cur = t & (NSL - 1);
        const LAS unsigned char* kbuf = lds + ATT_K + cur * 8192; const LAS unsigned char* vbuf = lds + ATT_V + cur * VT;
        f32x16 p[2][2];
        { bf16x8 kf[2][4];
#pragma unroll
          for (int kb = 0; kb < 2; ++kb)
#pragma unroll
            for (int s = 0; s < 4; ++s) kf[kb][s] = *(const LAS bf16x8*)(kbuf + koff[kb][s]);
          __builtin_amdgcn_sched_barrier(0);
#pragma unroll
          for (int kb = 0; kb < 2; ++kb)
#pragma unroll
            for (int j = 0; j < 2; ++j) { f32x16 acc;
#pragma unroll
              for (int r = 0; r < 16; ++r) acc[r] = 0.f;
#pragma unroll
              for (int s = 0; s < 4; ++s) acc = __builtin_amdgcn_mfma_f32_32x32x16_bf16(kf[kb][s], qf[j][s], acc, 0, 0, 0);
              p[j][kb] = acc; } }
        s16x4 vlo[2][4], vhi[2][4];
#define GQ_VREAD(buf_, db_) do { const int cofs_ = (((db_) ^ vsw) << 6); _Pragma("unroll") for (int kb = 0; kb < 2; ++kb) _Pragma("unroll") for (int ss = 0; ss < 2; ++ss) { \
            const LAS unsigned char* vp_ = vbuf + vbase + (32 * kb + 16 * ss) * VROW + cofs_; vlo[buf_][2 * kb + ss] = vtr(vp_); vhi[buf_][2 * kb + ss] = vtr(vp_ + 8 * VROW); } } while (0)
        bf16x8 pk[2][2][2];
#pragma unroll
        for (int j = 0; j < 2; ++j) { float ls0 = 0.f, ls1 = 0.f;
#pragma unroll
            for (int kb = 0; kb < 2; ++kb) {
#pragma unroll
                for (int r = 0; r < 16; r += 2) { const float e0 = __builtin_amdgcn_exp2f(p[j][kb][r]), e1 = __builtin_amdgcn_exp2f(p[j][kb][r + 1]); ls0 += e0; ls1 += e1; p[j][kb][r] = e0; p[j][kb][r + 1] = e1; }
#pragma unroll
                for (int ss = 0; ss < 2; ++ss) { u32x4 w; w.x = cvtpk(p[j][kb][8 * ss + 0], p[j][kb][8 * ss + 1]); w.y = cvtpk(p[j][kb][8 * ss + 2], p[j][kb][8 * ss + 3]); w.z = cvtpk(p[j][kb][8 * ss + 4], p[j][kb][8 * ss + 5]); w.w = cvtpk(p[j][kb][8 * ss + 6], p[j][kb][8 * ss + 7]);
                    pk[j][kb][ss] = __builtin_bit_cast(bf16x8, w); } }
            lrun[j] += ls0 + ls1; }
        __builtin_amdgcn_sched_barrier(0);
        GQ_VREAD(0, 0); GQ_VREAD(1, 1);
#pragma unroll
        for (int db = 0; db < 2; ++db) {
#pragma unroll
            for (int kb = 0; kb < 2; ++kb)
#pragma unroll
                for (int ss = 0; ss < 2; ++ss) { const bf16x8 vf = db ? __builtin_shufflevector(vlo[1][2 * kb + ss], vhi[1][2 * kb + ss], 0, 1, 2, 3, 4, 5, 6, 7) : __builtin_shufflevector(vlo[0][2 * kb + ss], vhi[0][2 * kb + ss], 0, 1, 2, 3, 4, 5, 6, 7);
#pragma unroll
                    for (int j = 0; j < 2; ++j) o[j][db] = __builtin_amdgcn_mfma_f32_32x32x16_bf16(vf, pk[j][kb][ss], o[j][db], 0, 0, 0); }
            __builtin_amdgcn_sched_barrier(0); }
#undef GQ_VREAD
        if (((t + 1) & (G - 1)) == 0) { asm volatile("s_waitcnt vmcnt(0)" ::: "memory"); GQ_BAR(); const int g2 = (t + 1) / G + 1; if (g2 < ng) GQ_DMAGROUP(g2); }
    }
#undef GQ_DMA
#undef GQ_DMAGROUP
#undef GQ_BAR
#pragma unroll
    for (int j = 0; j < 2; ++j) { const int lane2 = ltid() & 63, r32b = lane2 & 31, hib = lane2 >> 5;
        const float l = lrun[j] + shx(lrun[j], 32); const float inv = 1.0f / l; const size_t row = (size_t)(seqrow0 + qw0 + 32 * j + r32b);
#pragma unroll
        for (int db = 0; db < 2; ++db)
#pragma unroll
            for (int g = 0; g < 4; ++g) { const int d = 32 * db + 8 * g + 4 * hib; const u32x2 gw = *(const u32x2*)(U + row * UP + C_GG + 64 * h + d);
                const float y0 = o[j][db][4 * g] * inv * silu(bflo(gw.x)), y1 = o[j][db][4 * g + 1] * inv * silu(bfhi(gw.x)), y2 = o[j][db][4 * g + 2] * inv * silu(bflo(gw.y)), y3 = o[j][db][4 * g + 3] * inv * silu(bfhi(gw.y));
                u32x2 w; w.x = cvtpk(y0, y1); w.y = cvtpk(y2, y3); *(u32x2*)(Y + row * 512 + 64 * h + d) = w; } }
}
__device__ __forceinline__ void diff_unit(const AV& a, LAS unsigned char* lds, int seqrow0, int L, int h, int qb, int layer) {
    const int tid = ltid(), lane = tid & 63, wave = tid >> 6, r32 = lane & 31, hi = lane >> 5;
    const bf16* U = (const bf16*)(AWS + WS_U); bf16* Y = (bf16*)(AWS + WS_Y) + (size_t)2 * CH * 512; float* DT = (float*)(AWS + WS_DT);
    const float* relb = AIN(I_RELB);
    LAS float* tb = (LAS float*)(lds + ATT_TB_DIFF);
    for (int i = tid; i < 257; i += NT) { const int rel = i - 128, n = rel < 0 ? -rel : rel; int b = rel > 0 ? 16 : 0;
        if (n < 8) b += n; else { const int v = 8 + (31 - __builtin_clz((unsigned)(n * n))) - 6; b += v < 15 ? v : 15; }
        tb[i] = relb[b * 4 + h] * LOG2E; }
    const float bl = relb[15 * 4 + h] * LOG2E, br = relb[31 * 4 + h] * LOG2E;
    float lyf = (float)layer; asm volatile("" : "+v"(lyf));
    const float li = 0.8f - 0.6f * __expf(-0.3f * lyf);
    float d1, d2; { const float q1 = AIN(I_LQ1)[layer * 64 + lane], k1 = AIN(I_LK1)[layer * 64 + lane], q2 = AIN(I_LQ2)[layer * 64 + lane], k2 = AIN(I_LK2)[layer * 64 + lane]; d1 = wave_sum(q1 * k1); d2 = wave_sum(q2 * k2); }
    const float lam = __expf(d1) - __expf(d2) + li;
    const int qw0 = qb * 256 + wave * 32, qpos = qw0 + r32; const size_t row = (size_t)(seqrow0 + qpos);
    __syncthreads();
    f32x16 o[4]; float l; float ss = 0.f;
#pragma unroll 1
    for (int c = 0; c < 2; ++c) {
#pragma unroll
        for (int db = 0; db < 4; ++db)
#pragma unroll
            for (int r = 0; r < 16; ++r) o[db][r] = 0.f;
        flash_pass<128, true, true, 2>(lds, U + row * UP + C_DQ + 128 * h + 64 * c, U + (size_t)seqrow0 * UP + C_DK + 128 * h + 64 * c, U + (size_t)seqrow0 * UP + C_DV + 128 * h, L, qpos, qw0, bl, br, o, l);
        if (c == 0) { const float inv = 1.0f / l;
#pragma unroll
            for (int db = 0; db < 4; ++db)
#pragma unroll
                for (int g = 0; g < 4; ++g) { const int d = 32 * db + 8 * g + 4 * hi; *(f32x4*)(DT + row * 512 + 128 * h + d) = (f32x4){o[db][4 * g] * inv, o[db][4 * g + 1] * inv, o[db][4 * g + 2] * inv, o[db][4 * g + 3] * inv}; }
        } else { const float inv = lam / l;
#pragma unroll
            for (int db = 0; db < 4; ++db)
#pragma unroll
                for (int g = 0; g < 4; ++g) { const int d = 32 * db + 8 * g + 4 * hi; const f32x4 o0 = *(const f32x4*)(DT + row * 512 + 128 * h + d);
#pragma unroll
                    for (int e = 0; e < 4; ++e) { const float v = o0[e] - o[db][4 * g + e] * inv; o[db][4 * g + e] = v; ss += v * v; } }
        }
    }
    ss += shx(ss, 32);
    const float rs = (1.0f / sqrtf(ss * (1.0f / 128.0f) + EPS)) * (1.0f - li);
    const float* sg = AIN(I_SUBLN) + layer * 128;
#pragma unroll
    for (int db = 0; db < 4; ++db)
#pragma unroll
        for (int g = 0; g < 4; ++g) { const int d = 32 * db + 8 * g + 4 * hi; const u32x2 gw = *(const u32x2*)(U + row * UP + C_DG + 128 * h + d); const f32x4 gn = *(const f32x4*)(sg + d);
            const float y0 = o[db][4 * g] * rs * gn.x * silu(bflo(gw.x)), y1 = o[db][4 * g + 1] * rs * gn.y * silu(bfhi(gw.x)), y2 = o[db][4 * g + 2] * rs * gn.z * silu(bflo(gw.y)), y3 = o[db][4 * g + 3] * rs * gn.w * silu(bfhi(gw.y));
            u32x2 w; w.x = cvtpk(y0, y1); w.y = cvtpk(y2, y3); *(u32x2*)(Y + row * 512 + 128 * h + d) = w; }
}
template <int LOG4, int BATCH> __device__ __forceinline__ void hyena_unit(const AV& a, LAS unsigned char* lds, int seqrow0, int pr0, int layer) {
    constexpr int N = 1 << (2 * LOG4), L = N / 2, NPAD = N + N / 16;
    const int tid = ltid(); LAS f32x2* buf = (LAS f32x2*)lds;
    bf16* Y = (bf16*)(AWS + WS_Y) + (size_t)seqrow0 * 512;
    const unsigned char* sp = AWS + WS_SPEC + layer * SPEC_LAYER;
    constexpr int SPS = (LOG4 == 7) ? SPS_P : SPS_S;
    const f32x2* Pg = ((LOG4 == 7) ? (const f32x2*)sp : (const f32x2*)(sp + 2 * SPEC_P_BYTES)) + (size_t)pr0 * SPS;
    const f32x2* Mg = ((LOG4 == 7) ? (const f32x2*)(sp + SPEC_P_BYTES) : (const f32x2*)(sp + 2 * SPEC_P_BYTES + SPEC_S_BYTES)) + (size_t)pr0 * SPS;
    const f32x2* hvp = (const f32x2*)(AWS + WS_HVP) + (size_t)pr0 * CH + seqrow0; const f32x2* pmp = (const f32x2*)(AWS + WS_PMP) + (size_t)pr0 * CH + seqrow0;
    const f32x2* tw = (const f32x2*)(AWS + WS_TW);
    fft_first_from_global<LOG4, BATCH>(buf, tw, hvp, (size_t)CH, tid); fft_fwd<LOG4, BATCH, 1, false>(buf, tw, tid);
    fft_tail_mul_tail<LOG4, BATCH>(buf, Pg, Mg, SPS, ltid());
    if constexpr (BATCH == 1) { fft_inv<LOG4, 1, 1, false>(buf, tw, ltid()); fft_last_to_global<LOG4>(buf, tw, pmp, Y + 2 * pr0, ltid()); }
    else { fft_inv<LOG4, BATCH, 0, false>(buf, tw, ltid());
    for (int t = tid; t < L; t += NT) { unsigned w[BATCH];
#pragma unroll
        for (int b = 0; b < BATCH; ++b) { const f32x2 y = buf[b * NPAD + PADI(t)], m = pmp[(size_t)b * CH + t]; w[b] = cvtpk(y.x * m.x, y.y * m.y); }
        if (BATCH == 4) *(u32x4*)(Y + (size_t)t * 512 + 2 * pr0) = (u32x4){w[0], w[BATCH > 1 ? 1 : 0], w[BATCH > 2 ? 2 : 0], w[BATCH > 3 ? 3 : 0]};
        else *(unsigned*)(Y + (size_t)t * 512 + 2 * pr0) = w[0]; } }
    __syncthreads();
}
#define XB_TMO      128
#define XB_XCNT(j)  (256  + 64 * (j))
#define XB_XSUB(j)  (1280 + 64 * (j))
#define XB_XGEN(j)  (2304 + 64 * (j))
#define XB_TOP      3328
#define XB_TOPGEN   3392
#define XCD_BAR_WORDS 3456
#define XB_SPIN_CAP (1u << 18)

__device__ __forceinline__ unsigned xb_ld(unsigned* p)              { return __hip_atomic_load(p, __ATOMIC_RELAXED, __HIP_MEMORY_SCOPE_AGENT); }
__device__ __forceinline__ unsigned xb_add(unsigned* p, unsigned v) { return __hip_atomic_fetch_add(p, v, __ATOMIC_RELAXED, __HIP_MEMORY_SCOPE_AGENT); }
__device__ __forceinline__ unsigned xb_xcc_id() { return (unsigned)__builtin_amdgcn_s_getreg((3 << 11) | 20) & 0xFu; }
#define XB_SPIN(cond, bar) do { unsigned _sp = 0; while (cond) { __builtin_amdgcn_s_sleep(1); \
    if ((++_sp & 255u) == 0u) { if (xb_ld(&(bar)[XB_TMO])) break; if (_sp > XB_SPIN_CAP) { atomicAdd(&(bar)[XB_TMO], 1u); break; } } } } while (0)

struct XcdBarrier {
    unsigned* bar; unsigned x;
    volatile LAS unsigned* st;
};

__device__ __forceinline__ XcdBarrier xcd_barrier_post(unsigned* bar, volatile LAS unsigned* st) {
    XcdBarrier b; b.bar = bar; b.x = xb_xcc_id(); b.st = st;
    if (threadIdx.x == 0) (void)xb_add(&bar[XB_XCNT(b.x)], 1u);
    return b;
}
__device__ __forceinline__ void xcd_barrier_complete(unsigned* bar, unsigned x, unsigned& nloc, unsigned& nx) {
    const unsigned G = gridDim.x * gridDim.y * gridDim.z;
    unsigned sum, cnt, mine, sp = 0u;
    for (;;) {
        sum = 0u; cnt = 0u; mine = 0u;
#pragma unroll
        for (unsigned j = 0; j < 16; ++j) { const unsigned c = xb_ld(&bar[XB_XCNT(j)]); sum += c; cnt += (c > 0u) ? 1u : 0u; mine = (j == x) ? c : mine; }
        if (sum == G) break;
        __builtin_amdgcn_s_sleep(1);
        if ((++sp & 255u) == 0u) { if (xb_ld(&bar[XB_TMO])) break; if (sp > XB_SPIN_CAP) { atomicAdd(&bar[XB_TMO], 1u); break; } }
    }
    nloc = mine > 0u ? mine : 1u; nx = cnt > 0u ? cnt : 1u;
}

__device__ __forceinline__ void xcd_barrier(const XcdBarrier& b) {
    asm volatile("s_waitcnt vmcnt(0)" ::: "memory");
    __syncthreads();
    if (threadIdx.x == 0) {
        unsigned* bar = b.bar;
        __builtin_amdgcn_s_waitcnt(0);
        unsigned nloc = b.st[0], nx = b.st[1];
        if (nloc == 0u) { xcd_barrier_complete(bar, b.x, nloc, nx); b.st[0] = nloc; b.st[1] = nx; }
        const unsigned old = xb_add(&bar[XB_XSUB(b.x)], 1u);
        const unsigned gen = old / nloc;
        if (old + 1u == (gen + 1u) * nloc) {
            __builtin_amdgcn_fence(__ATOMIC_RELEASE, "agent");
            asm volatile("s_waitcnt vmcnt(0)" ::: "memory");
            const unsigned og = xb_add(&bar[XB_TOP], 1u);
            const unsigned tg = og / nx;
            if (og + 1u == (tg + 1u) * nx) xb_add(&bar[XB_TOPGEN], 1u);
            else XB_SPIN(xb_ld(&bar[XB_TOPGEN]) == tg, bar);
            __builtin_amdgcn_fence(__ATOMIC_ACQUIRE, "agent");
            xb_add(&bar[XB_XGEN(b.x)], 1u);
            asm volatile("s_waitcnt vmcnt(0)" ::: "memory");
        } else {
            XB_SPIN(xb_ld(&bar[XB_XGEN(b.x)]) == gen, bar);
            __builtin_amdgcn_fence(__ATOMIC_ACQUIRE, "agent");
            asm volatile("s_waitcnt vmcnt(0)" ::: "memory");
        }
    }
    __syncthreads();
}

__device__ __forceinline__ void step_mix(const AV& a, LAS unsigned char* lds, int c, int layer, unsigned* ctr, int tmask) {
    const Chunk ck = chunk_of(c); const int nqb = ck.L / 256, nqg = ck.L / 512, nD = ck.nseq * 4 * nqb, nG = ck.nseq * 8 * nqg, nF = (ck.L == LP) ? ck.nseq * 256 : ck.nseq * 64, total = nD + nG + nF;
    volatile LAS unsigned* wq = (volatile LAS unsigned*)(lds + LDS_MAIN);
    for (;;) {
        if (ltid() == 0) wq[0] = atomicAdd(ctr, 1u);
        __syncthreads();
        const int u = (int)wq[0];
        __syncthreads();
        if (u >= total) break;
        if (u < nD) { if (tmask & 1) { const int qb = u % nqb, sh = u / nqb, h = sh & 3, s = sh >> 2; diff_unit(a, lds, s * ck.L, ck.L, h, qb, layer); } }
        else if (u < nD + nG) { if (tmask & 2) { const int v = u - nD, qb = v % nqg, sh = v / nqg, h = sh & 7, s = sh >> 3; gqa_unit(a, lds, s * ck.L, ck.L, h, qb); } }
        else { if (tmask & 4) { const int v = u - nD - nG; if (ck.L == LP) hyena_unit<7, 1>(a, lds, (v >> 8) * LP, v & 255, layer); else hyena_unit<6, 4>(a, lds, (v >> 6) * LS, (v & 63) * 4, layer); } }
    }
}
constexpr int STEPS_PER = 6, NPRO = 1, NSTEPS = NPRO + NCHUNK * 2 * STEPS_PER + 1;
__global__ void __launch_bounds__(NT, 2) mega_fwd(Args kargs) {
    extern __shared__ __attribute__((aligned(16))) unsigned char lds_raw[];
    LAS unsigned char* lds = (LAS unsigned char*)lds_raw;
    kargp_t kp = (kargp_t)__builtin_amdgcn_kernarg_segment_ptr();
    { volatile LAS unsigned* misc = (volatile LAS unsigned*)(lds + LDS_MAIN + 64); if (ltid() < 16) misc[ltid()] = 0u; }
    __syncthreads();
    XcdBarrier xbar = xcd_barrier_post((unsigned*)(kargs.ws + WS_CTL) + CW_BAR, (volatile LAS unsigned*)(lds + LDS_MAIN + 64 + 32));
    const int step_lo = kargs.lo, step_hi = kargs.hi;
#pragma unroll 1
    for (int step = step_lo; step < step_hi; ++step) {
        asm volatile("" : "+s"(kp));
        AV a; a.p = kp; unsigned char* ws = AWS;
        if (step == 0) { if (EN(0)) step_pro_a(a, lds); __syncthreads(); if (EN(11)) step_pro_a2(a, lds); }
        else if (step == NSTEPS - 1) { if (DUP_MASK & 256) { for (int q = 0; q < 100; ++q) xcd_barrier(xbar); } if (EN(2)) step_final(a, (NCHUNK - 1) * CH, NTOK); }
        else {
            const int s2 = step - NPRO, cl = s2 / STEPS_PER, k = s2 - cl * STEPS_PER, c = cl >> 1, layer = cl & 1;
            const Chunk ck = chunk_of(c);
            if (k == 0) { if (layer == 0) { if (c > 0 && EN(2)) step_final(a, (c - 1) * CH, c * CH); } continue;     }
            else if (k == 2) { if (c == 0 && layer == 0 && EN(1)) { step_pro_b(a, lds); __syncthreads(); }
                if (EN(5)) { step_prep(a, c, layer); step_prep_hy(a, lds, c, layer); if (layer == 0) { float* q = (float*)(ws + WS_SSQ); for (int i = lbid() * NT + ltid(); i < CH; i += (int)gridDim.x * NT) q[i] = 0.f; } } }
            else if (k == 3) {
#pragma unroll 1
                for (int rep = 0; rep < ((DUP_MASK & 7) ? 2 : 1); ++rep) { if (rep) xcd_barrier(xbar); step_mix(a, lds, c, layer, (unsigned*)(ws + WS_CTL) + step * 16 + 4 * rep, rep ? (DUP_MASK & 7) : 7); } }
            else { if (EN(4)) {
                pg8::Gemm g; pg8::OrderAll S; pg8::EpiAll E; const int G = (int)gridDim.x, bid = lbid();
                S.so.init(CH, k == 1 ? NCAT : 1024, G, bid); S.o2 = pg8::OrderG2{CH / 256, G, bid}; S.mode = (k == 4) ? 2 : 1;
                float* O = AOUT + (size_t)ck.tok0 * DM; const float* X = layer == 0 ? xin_rows(a, ck.tok0) : O;
                E.mode = (k == 1) ? 1 : (k == 4) ? 2 : 3;
                E.e1 = pg8::EpiG1{(pg8::bf16_t*)(ws + WS_U), (pg8::bf16_t*)(ws + WS_G), AIN(I_BMERGE) + layer * GP, layer == 1 ? (const float*)(ws + WS_SSQ) : (const float*)nullptr};
                E.e2 = pg8::EpiG2{(const pg8::bf16_t*)(ws + WS_G), (float*)(ws + WS_TMP), (pg8::bf16_t*)(ws + WS_MG), CH / 256};
                E.e3 = pg8::EpiG3{X, O, AIN(I_NORMG) + DM, (pg8::bf16_t*)(ws + WS_HN), (float*)(ws + WS_SSQ), layer == 0 ? 1 : 0};
                if (k == 1) g = pg8::Gemm{layer == 0 ? (const pg8::bf16_t*)(ws + WS_HN0) + (size_t)ck.tok0 * DM : (const pg8::bf16_t*)(ws + WS_HN), (const pg8::bf16_t*)(ws + WS_WCAT + layer * WCAT_BYTES), CH, NCAT, 1024};
                else if (k == 4) g = pg8::Gemm{(const pg8::bf16_t*)(ws + WS_Y), (const pg8::bf16_t*)(ws + WS_WBT + layer * WBT_BYTES), 3 * CH, 3072, 512};
                else g = pg8::Gemm{(const pg8::bf16_t*)(ws + WS_MG), (const pg8::bf16_t*)(ws + WS_WOT + layer * WOT_BYTES), CH, 1024, 1024};
                const int nrep = (((DUP_MASK & 8) && k == 1) || ((DUP_MASK & 16) && k == 4)) ? 2 : 1;
#pragma unroll 1
                for (int rep = 0; rep < nrep; ++rep) { if (rep) xcd_barrier(xbar); pg8::gemm_phase<pg8::EpiAll, pg8::OrderAll, true, true>(lds, g, S, E); }
            } }
        }
        if (step + 1 < step_hi) { if (step == 0) cg::this_grid().sync(); else xcd_barrier(xbar); }
    }
}
#ifndef MK_MULTI
#define MK_MULTI 0
#endif
extern "C" void kernel_launch(void* const* d_in, const int* in_sizes, int n_in, void* d_out, int out_size, void* d_ws, size_t ws_size, hipStream_t stream) {
    static int grid = 0;
    if (grid == 0) {
        if (n_in != N_IN || out_size != NTOK * DM || ws_size < WS_END) { fprintf(stderr, "kernel_launch: unexpected shapes (n_in %d, out %d, ws %zu)\n", n_in, out_size, ws_size); grid = -1; return; }
        int dev = 0, cus = 0, per_cu = 0;
        hipGetDevice(&dev); hipDeviceGetAttribute(&cus, hipDeviceAttributeMultiprocessorCount, dev);
        if (hipFuncSetAttribute((const void*)mega_fwd, hipFuncAttributeMaxDynamicSharedMemorySize, LDS_BYTES) != hipSuccess) { fprintf(stderr, "kernel_launch: hipFuncSetAttribute failed\n"); grid = -1; return; }
        hipOccupancyMaxActiveBlocksPerMultiprocessor(&per_cu, (const void*)mega_fwd, NT, LDS_BYTES);
        (void)hipGetLastError();
        if (per_cu < 1) per_cu = 1;
        grid = cus * 1;
        fprintf(stderr, "kernel_launch: cus %d per_cu %d grid %d\n", cus, per_cu, grid);
    }
    if (grid < 0) return;
    hipMemsetAsync((char*)d_ws + WS_CTL, 0, CTL_BYTES, stream);
    Args a{};
    for (int i = 0; i < N_IN; ++i) a.in[i] = (const float*)d_in[i];
    a.out = (float*)d_out; a.ws = (unsigned char*)d_ws;
#if MK_MULTI
    for (int s = 0; s < NSTEPS; ++s) { a.lo = s; a.hi = s + 1; hipLaunchKernelGGL(mega_fwd, dim3(grid), dim3(NT), LDS_BYTES, stream, a); }
#else
    a.lo = 0; a.hi = NSTEPS;
    void* args[] = {&a};
    hipError_t e = hipLaunchCooperativeKernel((const void*)mega_fwd, dim3(grid), dim3(NT), args, LDS_BYTES, stream);
    if (e != hipSuccess) fprintf(stderr, "cooperative launch failed: %s (grid %d)\n", hipGetErrorString(e), grid);
#endif
}
```
